# Optimizing an MI355X kernel written in HIP

```python
import math
import jax, jax.numpy as jnp
from jax import lax
import numpy as np

D_MODEL = 2048
BATCH = 8
SEQ = 2048
DEPTH = 1

MIX_WIDTH = D_MODEL
POOL_WIDTH = MIX_WIDTH // 2
POOL_WINDOWS = (2, 4, 8, 16)
POOL_GROUPS = len(POOL_WINDOWS)
POOL_GROUP_DIM = POOL_WIDTH // POOL_GROUPS
NSA_HEADS = 16
NSA_HEAD_DIM = (MIX_WIDTH - POOL_WIDTH) // NSA_HEADS
NSA_KV_GROUPS = 4
NSA_Q_PER_KV = NSA_HEADS // NSA_KV_GROUPS
KV_WIDTH = NSA_KV_GROUPS * NSA_HEAD_DIM
N_BRANCH = 3
CMP_BLOCK = 32
CMP_STRIDE = 16
CMP_HIDDEN = 256
SEL_BLOCK = 64
N_SEL = 8
WINDOW = 512
Q_BLOCK = 128
FORCE_SCORE = 1e4
IN_SPLITS = (POOL_WIDTH, NSA_HEADS * NSA_HEAD_DIM) + (KV_WIDTH,) * 6 + (NSA_HEADS * N_BRANCH,)
IN_WIDTH = sum(IN_SPLITS)
REL_BUCKETS = 32
REL_MAX_DIST = 128
PEER_HEADS = 8
PEER_N_KEYS = 128
PEER_N_EXPERTS = PEER_N_KEYS * PEER_N_KEYS
PEER_QUERY_DIM = 256
PEER_TOPK = 16
PEER_CHUNK = 128
PLE_DIM = 256
RMS_EPS = 1e-6
NEG_INF = -1e30

kernel_name = 'hybrid_pool_nsa_peer_block'


def rmsnorm(x, w):
    xf = x.astype(jnp.float32)
    y = xf * lax.rsqrt(jnp.mean(xf * xf, axis=-1, keepdims=True) + RMS_EPS)
    return (y * w.astype(jnp.float32)).astype(x.dtype)


def masked_softmax(logits, mask):
    logits = jnp.where(mask, logits.astype(jnp.float32), NEG_INF)
    m = jnp.max(logits, axis=-1, keepdims=True)
    e = jnp.exp(logits - m) * mask
    return e / jnp.maximum(jnp.sum(e, axis=-1, keepdims=True), 1e-30)


def t5_bucket(rel):
    rel = jnp.maximum(rel, 0)
    exact = REL_BUCKETS // 2
    logr = jnp.log(jnp.maximum(rel, 1).astype(jnp.float32) / exact)
    large = exact + (logr / math.log(REL_MAX_DIST / exact) * (REL_BUCKETS - exact)).astype(jnp.int32)
    return jnp.where(rel < exact, rel, jnp.minimum(large, REL_BUCKETS - 1))


def pool_mixer(u, pool_w, pool_scale):
    B, S, _ = u.shape
    ug = u.reshape(B, S, POOL_GROUPS, POOL_GROUP_DIM).astype(jnp.float32)
    csum = jnp.concatenate([jnp.zeros_like(ug[:, :1]), jnp.cumsum(ug, axis=1)], axis=1)
    t = jnp.arange(S)
    pooled = []
    for g, w in enumerate(POOL_WINDOWS):
        lo = jnp.maximum(t + 1 - w, 0)
        cnt = (t + 1 - lo).astype(jnp.float32)
        cg = csum[:, :, g]
        pooled.append((cg[:, 1:] - cg[:, lo]) / cnt[None, :, None])
    mixed = (jnp.stack(pooled, axis=2) - ug).astype(u.dtype)
    y = jnp.einsum('bsgc,gcd->bsgd', mixed, pool_w).reshape(B, S, POOL_WIDTH)
    return y * pool_scale


def compress(kv, pos, w1, b1, w2):
    B, S, G, dk = kv.shape
    r = CMP_BLOCK // CMP_STRIDE
    nc = S // CMP_STRIDE - r + 1
    seg = kv.reshape(B, S // CMP_STRIDE, CMP_STRIDE, G, dk)
    blocks = jnp.concatenate([seg[:, i:i + nc] for i in range(r)], axis=2)
    blocks = blocks + pos[None, None, :, None, :]
    flat = blocks.transpose(0, 1, 3, 2, 4).reshape(B, nc, G, CMP_BLOCK * dk)
    h = jax.nn.gelu(flat @ w1 + b1, approximate=False)
    return h @ w2


def nsa_attention(q, k_cmp, v_cmp, k_slc, v_slc, k_win, v_win, gates, rel_bias):
    B, S, H, dk = q.shape
    G, R = NSA_KV_GROUPS, NSA_Q_PER_KV
    f32 = jnp.float32
    nc = k_cmp.shape[1]
    nsb = S // SEL_BLOCK
    n_sel = min(N_SEL, nsb)
    q = q.reshape(B, S, G, R, dk)
    gates = gates.reshape(B, S, G, R, N_BRANCH)
    bias_t = rel_bias.T.reshape(G, R, REL_BUCKETS).astype(f32)
    cmp_end = jnp.arange(nc) * CMP_STRIDE + CMP_BLOCK - 1
    c_start = np.arange(nc)[:, None] * CMP_STRIDE
    s_start = np.arange(nsb)[None, :] * SEL_BLOCK
    overlap = np.clip(np.minimum(c_start + CMP_BLOCK, s_start + SEL_BLOCK) - np.maximum(c_start, s_start), 0, None) / CMP_STRIDE
    overlap = jnp.asarray(overlap, f32)
    ks_blk = k_slc.reshape(B, nsb, SEL_BLOCK, G, dk).transpose(0, 3, 1, 2, 4)
    vs_blk = v_slc.reshape(B, nsb, SEL_BLOCK, G, dk).transpose(0, 3, 1, 2, 4)
    kw_pad = jnp.pad(k_win, ((0, 0), (WINDOW, 0), (0, 0), (0, 0)))
    vw_pad = jnp.pad(v_win, ((0, 0), (WINDOW, 0), (0, 0), (0, 0)))
    kc = k_cmp.astype(f32)
    vc = v_cmp.astype(f32)
    b_idx = jnp.arange(B)[:, None, None, None]
    g_idx = jnp.arange(G)[None, :, None, None]
    gi5 = jnp.arange(G)[None, :, None, None, None]
    ri5 = jnp.arange(R)[None, None, :, None, None]
    blk = jnp.arange(nsb)
    scale = dk ** -0.5

    def block_fn(qi):
        q0 = qi * Q_BLOCK
        t = q0 + jnp.arange(Q_BLOCK)
        qf = lax.dynamic_slice_in_dim(q, q0, Q_BLOCK, axis=1).astype(f32) * scale
        gb = lax.dynamic_slice_in_dim(gates, q0, Q_BLOCK, axis=1).astype(f32)
        rel_c = t[:, None] - cmp_end[None, :]
        logit_c = jnp.einsum('bqgrd,bcgd->bgrqc', qf, kc) + bias_t[:, :, t5_bucket(rel_c)]
        p_c = masked_softmax(logit_c, rel_c >= 0)
        o_c = jnp.einsum('bgrqc,bcgd->bqgrd', p_c, vc)
        imp = jnp.einsum('bgqc,cj->bgqj', p_c.sum(axis=2), overlap)
        cur = (t // SEL_BLOCK)[:, None]
        forced = (blk[None, :] == 0) | (blk[None, :] == cur) | (blk[None, :] == cur - 1)
        imp = jnp.where(forced, FORCE_SCORE, jnp.where(blk[None, :] <= cur, imp, NEG_INF))
        _, sel = lax.top_k(imp, n_sel)
        n_k = n_sel * SEL_BLOCK
        ks = ks_blk[b_idx, g_idx, sel].reshape(B, G, Q_BLOCK, n_k, dk).astype(f32)
        vs = vs_blk[b_idx, g_idx, sel].reshape(B, G, Q_BLOCK, n_k, dk).astype(f32)
        pos_s = (sel[..., None] * SEL_BLOCK + jnp.arange(SEL_BLOCK)).reshape(B, G, Q_BLOCK, n_k)
        rel_s = t[None, None, :, None] - pos_s
        bias_s = bias_t[gi5, ri5, t5_bucket(rel_s)[:, :, None]]
        logit_s = jnp.einsum('bqgrd,bgqkd->bgrqk', qf, ks) + bias_s
        p_s = masked_softmax(logit_s, (rel_s >= 0)[:, :, None])
        o_s = jnp.einsum('bgrqk,bgqkd->bqgrd', p_s, vs)
        kw = lax.dynamic_slice_in_dim(kw_pad, q0, WINDOW + Q_BLOCK, axis=1).astype(f32)
        vw = lax.dynamic_slice_in_dim(vw_pad, q0, WINDOW + Q_BLOCK, axis=1).astype(f32)
        pos_w = q0 - WINDOW + jnp.arange(WINDOW + Q_BLOCK)
        rel_w = t[:, None] - pos_w[None, :]
        mask_w = (pos_w[None, :] >= 0) & (rel_w >= 0) & (rel_w < WINDOW)
        logit_w = jnp.einsum('bqgrd,bkgd->bgrqk', qf, kw) + bias_t[:, :, t5_bucket(rel_w)]
        p_w = masked_softmax(logit_w, mask_w)
        o_w = jnp.einsum('bgrqk,bkgd->bqgrd', p_w, vw)
        o = gb[..., 0:1] * o_c + gb[..., 1:2] * o_s + gb[..., 2:3] * o_w
        return o.reshape(B, Q_BLOCK, H * dk).astype(q.dtype)

    out = lax.map(block_fn, jnp.arange(S // Q_BLOCK))
    return out.transpose(1, 0, 2, 3).reshape(B, S, H * dk)


def peer_ffn(xn, w_q, sub_keys, u_tab, v_tab):
    B, S, D = xn.shape
    T = B * S
    xt = xn.reshape(T, D)
    qp = (xt @ w_q).reshape(T, PEER_HEADS, 2, PEER_QUERY_DIM // 2).astype(jnp.float32)
    scores = jnp.einsum('thpd,hpkd->thpk', qp, sub_keys.astype(jnp.float32))
    s_top, i_top = lax.top_k(scores, PEER_TOPK)
    n_cand = PEER_TOPK * PEER_TOPK
    cand_s = (s_top[:, :, 0, :, None] + s_top[:, :, 1, None, :]).reshape(T, PEER_HEADS, n_cand)
    cand_i = (i_top[:, :, 0, :, None] * PEER_N_KEYS + i_top[:, :, 1, None, :]).reshape(T, PEER_HEADS, n_cand)
    best_s, best_pos = lax.top_k(cand_s, PEER_TOPK)
    idx = jnp.take_along_axis(cand_i, best_pos, axis=-1)
    g = jax.nn.softmax(best_s, axis=-1).astype(xn.dtype)
    n_chunks = T // PEER_CHUNK

    def chunk_fn(args):
        xc, ic, gc = args
        h = jax.nn.gelu(jnp.einsum('td,thkd->thk', xc, u_tab[ic]), approximate=False)
        return jnp.einsum('thk,thkd->td', gc * h, v_tab[ic])

    out = lax.map(chunk_fn, (xt.reshape(n_chunks, PEER_CHUNK, D),
                             idx.reshape(n_chunks, PEER_CHUNK, PEER_HEADS, PEER_TOPK),
                             g.reshape(n_chunks, PEER_CHUNK, PEER_HEADS, PEER_TOPK)))
    return out.reshape(B, S, D)


def setup_inputs(seed: int = 0) -> dict:
    key = jax.random.key(seed)
    ks = jax.random.split(key, 26)
    f32 = jnp.float32

    def nrm(k, shape, scale):
        return jax.random.normal(k, shape, f32) * scale

    def gain(k, shape):
        return 1.0 + 0.02 * jax.random.normal(k, shape, f32)

    L, D, dk = DEPTH, D_MODEL, NSA_HEAD_DIM
    cmp_in = CMP_BLOCK * dk
    return {
        'x': nrm(ks[0], (BATCH, SEQ, D), 1.0),
        'p': nrm(ks[1], (L, BATCH, SEQ, PLE_DIM), 1.0),
        'rel_bias': nrm(ks[2], (REL_BUCKETS, NSA_HEADS), 0.5),
        'mix_norm_w': gain(ks[3], (L, D)),
        'w_in': nrm(ks[4], (L, D, IN_WIDTH), D ** -0.5),
        'q_norm_w': gain(ks[5], (L, dk)),
        'k_norm_w': gain(ks[6], (L, dk)),
        'cmp_k_pos': nrm(ks[7], (L, CMP_BLOCK, dk), 0.1),
        'cmp_k_w1': nrm(ks[8], (L, cmp_in, CMP_HIDDEN), cmp_in ** -0.5),
        'cmp_k_b1': nrm(ks[9], (L, CMP_HIDDEN), 0.01),
        'cmp_k_w2': nrm(ks[10], (L, CMP_HIDDEN, dk), CMP_HIDDEN ** -0.5),
        'cmp_v_pos': nrm(ks[11], (L, CMP_BLOCK, dk), 0.1),
        'cmp_v_w1': nrm(ks[12], (L, cmp_in, CMP_HIDDEN), cmp_in ** -0.5),
        'cmp_v_b1': nrm(ks[13], (L, CMP_HIDDEN), 0.01),
        'cmp_v_w2': nrm(ks[14], (L, CMP_HIDDEN, dk), CMP_HIDDEN ** -0.5),
        'pool_w': nrm(ks[15], (L, POOL_GROUPS, POOL_GROUP_DIM, POOL_GROUP_DIM), POOL_GROUP_DIM ** -0.5),
        'pool_scale': gain(ks[16], (L, POOL_WIDTH)),
        'w_out': nrm(ks[17], (L, MIX_WIDTH, D), MIX_WIDTH ** -0.5),
        'ffn_norm_w': gain(ks[18], (L, D)),
        'peer_w_q': nrm(ks[19], (L, D, PEER_HEADS * PEER_QUERY_DIM), D ** -0.5),
        'peer_sub_keys': nrm(ks[20], (L, PEER_HEADS, 2, PEER_N_KEYS, PEER_QUERY_DIM // 2), (PEER_QUERY_DIM // 2) ** -0.5),
        'peer_u': nrm(ks[21], (L, PEER_N_EXPERTS, D), D ** -0.5),
        'peer_v': nrm(ks[22], (L, PEER_N_EXPERTS, D), PEER_HEADS ** -0.5),
        'ple_norm_w': gain(ks[23], (L, D)),
        'ple_w_gate': nrm(ks[24], (L, D, D), D ** -0.5),
        'ple_w_proj': nrm(ks[25], (L, PLE_DIM, D), PLE_DIM ** -0.5),
    }


def reference(x, p, rel_bias, mix_norm_w, w_in, q_norm_w, k_norm_w,
              cmp_k_pos, cmp_k_w1, cmp_k_b1, cmp_k_w2,
              cmp_v_pos, cmp_v_w1, cmp_v_b1, cmp_v_w2,
              pool_w, pool_scale, w_out, ffn_norm_w,
              peer_w_q, peer_sub_keys, peer_u, peer_v,
              ple_norm_w, ple_w_gate, ple_w_proj):
    B, S, _ = x.shape
    H, G, dk = NSA_HEADS, NSA_KV_GROUPS, NSA_HEAD_DIM
    offsets = [int(o) for o in np.cumsum(IN_SPLITS)[:-1]]
    for i in range(DEPTH):
        hn = rmsnorm(x, mix_norm_w[i])
        u, q, kc, vc, ksl, vsl, kwn, vwn, gl = jnp.split(hn @ w_in[i], offsets, axis=-1)
        q = rmsnorm(q.reshape(B, S, H, dk), q_norm_w[i])
        k_cmp = rmsnorm(compress(kc.reshape(B, S, G, dk), cmp_k_pos[i], cmp_k_w1[i], cmp_k_b1[i], cmp_k_w2[i]), k_norm_w[i])
        v_cmp = compress(vc.reshape(B, S, G, dk), cmp_v_pos[i], cmp_v_w1[i], cmp_v_b1[i], cmp_v_w2[i])
        k_slc = rmsnorm(ksl.reshape(B, S, G, dk), k_norm_w[i])
        v_slc = vsl.reshape(B, S, G, dk)
        k_win = rmsnorm(kwn.reshape(B, S, G, dk), k_norm_w[i])
        v_win = vwn.reshape(B, S, G, dk)
        gates = jax.nn.sigmoid(gl.reshape(B, S, H, N_BRANCH))
        attn = nsa_attention(q, k_cmp, v_cmp, k_slc, v_slc, k_win, v_win, gates, rel_bias)
        pool = pool_mixer(u, pool_w[i], pool_scale[i])
        x = x + jnp.concatenate([pool, attn], axis=-1) @ w_out[i]
        x = x + peer_ffn(rmsnorm(x, ffn_norm_w[i]), peer_w_q[i], peer_sub_keys[i], peer_u[i], peer_v[i])
        gate = jax.nn.sigmoid(rmsnorm(x, ple_norm_w[i]) @ ple_w_gate[i])
        x = x + gate * (p[i] @ ple_w_proj[i])
    return x
```

```cpp
#include <hip/hip_runtime.h>
#include <cstdio>
#include <cstdint>

#define PROBE_REP0 1
#define PROBE_DUP4 0
#define PROBE_REP2 1
#define PROBE_DUPU 0
#define PROBE_REP5 1
#define PROBE_REP7 1
#define PROBE_REP9 1
#ifndef MK_ONE_LAUNCH
#define MK_ONE_LAUNCH 1
#endif

#define GAS __attribute__((address_space(1)))
#define LAS __attribute__((address_space(3)))
typedef _Float16 f16;
typedef _Float16 f16x8 __attribute__((ext_vector_type(8)));
typedef _Float16 f16x4 __attribute__((ext_vector_type(4)));
typedef _Float16 f16x2 __attribute__((ext_vector_type(2)));
typedef float f32x2 __attribute__((ext_vector_type(2)));
typedef float f32x4 __attribute__((ext_vector_type(4)));
typedef float f32x16 __attribute__((ext_vector_type(16)));
typedef unsigned u32x2 __attribute__((ext_vector_type(2)));
typedef unsigned u32x4 __attribute__((ext_vector_type(4)));
typedef GAS unsigned gu32;
typedef _Float16 f16x32 __attribute__((ext_vector_type(32)));
typedef unsigned u32x6 __attribute__((ext_vector_type(6)));
#define RLX_AGENT __ATOMIC_RELAXED, __HIP_MEMORY_SCOPE_AGENT
#define LDS_WAIT() asm volatile("s_waitcnt lgkmcnt(0)" ::: "memory")
#define VM_WAIT() asm volatile("s_waitcnt vmcnt(0)" ::: "memory")

constexpr int BATCH = 8, SEQ = 2048, D = 2048, M = BATCH * SEQ;
constexpr int NIN = 3632, NINP = 3840;
constexpr int OFF_U = 0, OFF_Q = 1024, OFF_KC = 2048, OFF_VC = 2304, OFF_KS = 2560, OFF_VS = 2816, OFF_KW = 3072, OFF_VW = 3328, OFF_G = 3584;
constexpr int NCMP = 127, NCROWS = BATCH * NCMP * 4;
constexpr float RMS_EPS = 1e-6f;
constexpr float LOG2E = 1.4426950408889634f;

constexpr size_t MiB = 1u << 20;
constexpr size_t WS_CTL = 0, CTL_ZERO_BYTES = 1 * MiB;
constexpr size_t WS_WIN = 2 * MiB, WS_WOUT = 17 * MiB, WS_WQ = 25 * MiB, WS_WG = 33 * MiB, WS_WPJ = 41 * MiB, WS_W1C = 42 * MiB, WS_POOLT = 44 * MiB, WS_KEYS = 45 * MiB;
constexpr size_t WS_CBIAS = 46 * MiB, WS_GATES = 47 * MiB, WS_HC = 50 * MiB, WS_KCMP = 54 * MiB, WS_VCMPT = 54 * MiB + 512 * 1024, WS_P16 = 56 * MiB;
constexpr size_t WS_XN = 64 * MiB;
constexpr size_t WS_Y = 128 * MiB, WS_QP = 128 * MiB, WS_PJ = 192 * MiB;
constexpr size_t WS_MIXED = 256 * MiB, WS_CAT = 288 * MiB, WS_KN = 352 * MiB, WS_VT = 368 * MiB, WS_FLATA = 384 * MiB;
constexpr size_t WS_U6 = 256 * MiB, WS_V6 = 288 * MiB, WS_SU = 320 * MiB, WS_SV = 321 * MiB;
constexpr size_t WS_LIDX = 322 * MiB, WS_LG = 330 * MiB, WS_SSP = 338 * MiB, WS_PD = 340 * MiB, WS_HW = 404 * MiB;
constexpr size_t SLICE6 = (size_t)16384 * 192;
constexpr size_t WS_XR = 416 * MiB;
constexpr size_t WS_SS0 = 768 * 1024, WS_SS1 = 256 * 1024, WS_SS2 = 512 * 1024;
constexpr size_t WS_QN = 480 * MiB;
constexpr size_t WS_END = 512 * MiB;
constexpr int CW_TMO = 0, CW_CODE = 1, CW_BAR = 4096;

constexpr int RING_BYTES = 131072;
constexpr int LDSCTL_OFF = RING_BYTES, MISC_OFF = LDSCTL_OFF + 320;
constexpr int LDS_BYTES = 147456;
constexpr int NWAVES = 8;

__device__ __forceinline__ unsigned pk_f16(float lo, float hi) { f16x2 v; v.x = (f16)lo; v.y = (f16)hi; return __builtin_bit_cast(unsigned, v); }
__device__ __forceinline__ f16x2 ash2(unsigned u) { return __builtin_bit_cast(f16x2, u); }
template <int CTRL> __device__ __forceinline__ float dpp_f(float v) { return __int_as_float(__builtin_amdgcn_update_dpp(0, __float_as_int(v), CTRL, 0xF, 0xF, true)); }
__device__ __forceinline__ float rl_f(float v, int l) { return __int_as_float(__builtin_amdgcn_readlane(__float_as_int(v), l)); }
__device__ __forceinline__ float sum8(float v) { v += dpp_f<0x141>(v); v += dpp_f<0xB1>(v); v += dpp_f<0x4E>(v); return v; }
__device__ __forceinline__ float wave_sum(float v) { v = sum8(v); v += dpp_f<0x140>(v); return (rl_f(v, 0) + rl_f(v, 16)) + (rl_f(v, 32) + rl_f(v, 48)); }
__device__ __forceinline__ float wave_max(float v) { v = fmaxf(v, dpp_f<0x141>(v)); v = fmaxf(v, dpp_f<0xB1>(v)); v = fmaxf(v, dpp_f<0x4E>(v)); v = fmaxf(v, dpp_f<0x140>(v));
    return fmaxf(fmaxf(rl_f(v, 0), rl_f(v, 16)), fmaxf(rl_f(v, 32), rl_f(v, 48))); }

__device__ __forceinline__ unsigned other8u(unsigned x) { return (unsigned)__builtin_amdgcn_update_dpp(0, (int)x, 0x128, 0xF, 0xF, true); }
__device__ __forceinline__ unsigned other16u(unsigned x, bool b4) { const auto r = __builtin_amdgcn_permlane16_swap(x, x, false, false); return b4 ? r[0] : r[1]; }
__device__ __forceinline__ unsigned other32u(unsigned x, bool b5) { const auto r = __builtin_amdgcn_permlane32_swap(x, x, false, false); return b5 ? r[0] : r[1]; }
namespace pg8 {
constexpr int BM = 256, BK = 64, HALF = 128, HTB = HALF * BK * 2, STAGE_BYTES = 8 * HTB, NXCD = 8, WGM = 8;
__host__ __device__ __forceinline__ int lds_byte(int r, int c) { const int st = (r >> 4) * 2 + (c >> 5), rr = r & 15, cc = c & 31, ob = rr * 64 + cc * 2; return st * 1024 + (ob ^ (((ob >> 9) & 1) << 5)); }
__host__ __device__ __forceinline__ void stage_rc(int b, int& R, int& C) { const int st = b / 1024, sb = b % 1024, swz = sb ^ (((sb >> 9) & 1) << 5); R = (st >> 1) * 16 + swz / 64; C = (st & 1) * 32 + (swz % 64) / 2; }
__host__ __device__ __forceinline__ int perm32(int rho) { const int n = rho >> 4, i = rho & 15; return 8 * (i >> 2) + 4 * n + (i & 3); }

struct Unit { int pm, pn; };
struct Gemm { const f16* A; const f16* Bt; int M, N, K, lda, ldb; int a_pn_off; int b_pm_split; size_t b_split_off; int b_pn_k = 0;
    __device__ __forceinline__ const char* aptr(const Unit& u) const { return (const char*)A + ((size_t)u.pm * BM * lda + (size_t)u.pn * a_pn_off) * 2; }
    __device__ __forceinline__ const char* bptr(const Unit& u) const { return (const char*)Bt + (b_pn_k ? (size_t)u.pn * b_pn_k * 2 : (size_t)u.pn * BM * ldb * 2) + (u.pm >= b_pm_split ? b_split_off : (size_t)0); }
};
struct StaticOrder {
    int nM, nN, nwg, G, c;
    __host__ __device__ void init(int M_, int N_, int G_, int c_) { nM = M_ / BM; nN = N_ / BM; nwg = nM * nN; G = G_; c = c_; }
    __host__ __device__ bool next(int i, Unit& u) const {
        const long L = (long)i * G + c; if (L >= nwg) return false;
        int wgid = (int)L; { const int q = nwg / NXCD, r = nwg % NXCD, xcd = wgid % NXCD, off = wgid / NXCD; wgid = (xcd < r ? xcd * (q + 1) : r * (q + 1) + (xcd - r) * q) + off; }
        const int nig = WGM * nN, gid = wgid / nig, fm = gid * WGM, gsz = (nM - fm) < WGM ? (nM - fm) : WGM;
        u.pm = fm + ((wgid % nig) % gsz); u.pn = (wgid % nig) / gsz; return true;
    }
};

__device__ __forceinline__ f32x2 gelu_pk(f32x2 v) {
    const f32x2 av = __builtin_elementwise_abs(v), d = av * 0.2316418882f + 1.0f;
    f32x2 t; t.x = __builtin_amdgcn_rcpf(d.x); t.y = __builtin_amdgcn_rcpf(d.y);
    f32x2 q = t * 0.5307027145f + (-0.7265760135f); q = q * t + 0.7107068705f; q = q * t + (-0.142248368f); q = q * t + 0.127414796f; q = q * t;
    const f32x2 s = (v * v) * (-0.72134752044f);
    f32x2 e; e.x = __builtin_amdgcn_exp2f(s.x); e.y = __builtin_amdgcn_exp2f(s.y);
    const f32x2 m = v * (q * e), r = v - m;
    f32x2 o; o.x = v.x < 0.f ? m.x : r.x; o.y = v.y < 0.f ? m.y : r.y; return o;
}
__device__ __forceinline__ float gelu1(float v) { f32x2 r = gelu_pk((f32x2){v, v}); return r.x; }

template <int ACT> struct EpiF16 {
    static constexpr bool PERM = true;
    f16* O; int ldc; const float* bias; int bias_pm_split; int bias_split_off;
    __device__ __forceinline__ void operator()(const f32x4 (&acc)[2][2][4][2], const Unit& u, int wr, int wc, int fr, int fq) const {
        const int row0 = u.pm * BM + wr * 64 + fr; const int col0 = u.pn * BM + wc * 32 + 8 * fq;
        const float* bp = bias ? bias + (u.pm >= bias_pm_split ? bias_split_off : 0) : nullptr;
        f32x4 bv[2][2];
#pragma unroll
        for (int bj = 0; bj < 2; ++bj)
#pragma unroll
            for (int n = 0; n < 2; ++n) bv[bj][n] = bp ? *(const f32x4*)(bp + col0 + bj * HALF + 4 * n) : (f32x4){0.f, 0.f, 0.f, 0.f};
#pragma unroll
        for (int ai = 0; ai < 2; ++ai)
#pragma unroll
            for (int m = 0; m < 4; ++m) { f16* rowp = O + (size_t)(row0 + ai * HALF + m * 16) * ldc + col0;
#pragma unroll
                for (int bj = 0; bj < 2; ++bj) { f32x4 v0 = acc[ai][bj][m][0] + bv[bj][0], v1 = acc[ai][bj][m][1] + bv[bj][1];
                    if (ACT == 1) { f32x2 a = gelu_pk((f32x2){v0[0], v0[1]}), b = gelu_pk((f32x2){v0[2], v0[3]}), c = gelu_pk((f32x2){v1[0], v1[1]}), d = gelu_pk((f32x2){v1[2], v1[3]});
                        v0 = (f32x4){a.x, a.y, b.x, b.y}; v1 = (f32x4){c.x, c.y, d.x, d.y}; }
                    u32x4 w; w.x = pk_f16(v0[0], v0[1]); w.y = pk_f16(v0[2], v0[3]); w.z = pk_f16(v1[0], v1[1]); w.w = pk_f16(v1[2], v1[3]);
                    *(u32x4*)(rowp + bj * HALF) = w; } }
    }
};
struct EpiRawF32 {
    static constexpr bool PERM = false;
    float* C; int ldc;
    __device__ __forceinline__ void operator()(const f32x4 (&acc)[2][2][4][2], const Unit& u, int wr, int wc, int fr, int fq) const {
        const int row0 = u.pm * BM + wr * 64 + fr, col0 = u.pn * BM + wc * 32 + 4 * fq;
#pragma unroll
        for (int ai = 0; ai < 2; ++ai)
#pragma unroll
            for (int m = 0; m < 4; ++m) { float* rowp = C + (size_t)(row0 + ai * HALF + m * 16) * ldc + col0;
#pragma unroll
                for (int bj = 0; bj < 2; ++bj)
#pragma unroll
                    for (int n = 0; n < 2; ++n) *(f32x4*)(rowp + bj * HALF + n * 16) = acc[ai][bj][m][n]; }
    }
};
struct EpiRes16 {
    static constexpr bool PERM = true;
    f16* XR; float* SS;
    __device__ __forceinline__ void operator()(const f32x4 (&acc)[2][2][4][2], const Unit& u, int wr, int wc, int fr, int fq) const {
        const int row0 = u.pm * BM + wr * 64 + fr; const int col0 = u.pn * BM + wc * 32 + 8 * fq;
#pragma unroll
        for (int ai = 0; ai < 2; ++ai) {
            f16x8 xb[4][2];
#pragma unroll
            for (int m = 0; m < 4; ++m)
#pragma unroll
                for (int bj = 0; bj < 2; ++bj) xb[m][bj] = *(const f16x8*)(XR + (size_t)(row0 + ai * HALF + m * 16) * D + col0 + bj * HALF);
            asm volatile("" ::: "memory");
#pragma unroll
            for (int m = 0; m < 4; ++m) { const int row = row0 + ai * HALF + m * 16; const size_t off = (size_t)row * D + col0; float ss = 0.f;
#pragma unroll
                for (int bj = 0; bj < 2; ++bj) { const f16x8 xv = xb[m][bj];
                    f32x4 v0 = acc[ai][bj][m][0], v1 = acc[ai][bj][m][1];
                    v0[0] += (float)xv[0]; v0[1] += (float)xv[1]; v0[2] += (float)xv[2]; v0[3] += (float)xv[3]; v1[0] += (float)xv[4]; v1[1] += (float)xv[5]; v1[2] += (float)xv[6]; v1[3] += (float)xv[7];
                    ss += ((v0[0] * v0[0] + v0[1] * v0[1]) + (v0[2] * v0[2] + v0[3] * v0[3])) + ((v1[0] * v1[0] + v1[1] * v1[1]) + (v1[2] * v1[2] + v1[3] * v1[3]));
                    u32x4 o; o.x = pk_f16(v0[0], v0[1]); o.y = pk_f16(v0[2], v0[3]); o.z = pk_f16(v1[0], v1[1]); o.w = pk_f16(v1[2], v1[3]);
                    *(u32x4*)(XR + off + bj * HALF) = o; }
                ss += __shfl_xor(ss, 16); ss += __shfl_xor(ss, 32);
                if (fq == 0) atomicAdd(SS + row, ss); }
            asm volatile("" ::: "memory"); }
    }
};
struct EpiF16Row {
    static constexpr bool PERM = true;
    f16* O; int ldc; const float* SS;
    __device__ __forceinline__ void operator()(const f32x4 (&acc)[2][2][4][2], const Unit& u, int wr, int wc, int fr, int fq) const {
        const int row0 = u.pm * BM + wr * 64 + fr; const int col0 = u.pn * BM + wc * 32 + 8 * fq;
#pragma unroll
        for (int ai = 0; ai < 2; ++ai)
#pragma unroll
            for (int m = 0; m < 4; ++m) { const int row = row0 + ai * HALF + m * 16; f16* rowp = O + (size_t)row * ldc + col0;
                const float rs = 1.f / sqrtf(SS[row] * (1.f / D) + RMS_EPS);
#pragma unroll
                for (int bj = 0; bj < 2; ++bj) { const f32x4 v0 = acc[ai][bj][m][0] * rs, v1 = acc[ai][bj][m][1] * rs;
                    u32x4 o; o.x = pk_f16(v0[0], v0[1]); o.y = pk_f16(v0[2], v0[3]); o.z = pk_f16(v1[0], v1[1]); o.w = pk_f16(v1[2], v1[3]);
                    *(u32x4*)(rowp + bj * HALF) = o; } }
    }
};
struct EpiFinal {
    static constexpr bool PERM = true;
    const f16* XR; const f16* PJ; float* C; const float* SS;
    __device__ __forceinline__ void operator()(const f32x4 (&acc)[2][2][4][2], const Unit& u, int wr, int wc, int fr, int fq) const {
        const int row0 = u.pm * BM + wr * 64 + fr; const int col0 = u.pn * BM + wc * 32 + 8 * fq;
#pragma unroll
        for (int ai = 0; ai < 2; ++ai)
#pragma unroll
            for (int mh = 0; mh < 2; ++mh) {
                f16x8 xb[2][2], pb[2][2]; float ssv[2];
#pragma unroll
                for (int mm = 0; mm < 2; ++mm) { const int row = row0 + ai * HALF + (2 * mh + mm) * 16; ssv[mm] = SS[row];
#pragma unroll
                    for (int bj = 0; bj < 2; ++bj) { xb[mm][bj] = *(const f16x8*)(XR + (size_t)row * D + col0 + bj * HALF); pb[mm][bj] = *(const f16x8*)(PJ + (size_t)row * D + col0 + bj * HALF); } }
                asm volatile("" ::: "memory");
#pragma unroll
                for (int mm = 0; mm < 2; ++mm) { const int m = 2 * mh + mm; const int row = row0 + ai * HALF + m * 16; const size_t off = (size_t)row * D + col0;
                    const float nrs = -LOG2E / sqrtf(ssv[mm] * (1.f / D) + RMS_EPS);
#pragma unroll
                    for (int bj = 0; bj < 2; ++bj) { const f16x8 xv = xb[mm][bj], pv = pb[mm][bj];
                        const f32x4 a0 = acc[ai][bj][m][0], a1 = acc[ai][bj][m][1]; f32x4 o0, o1;
#pragma unroll
                        for (int j = 0; j < 4; ++j) { o0[j] = (float)xv[j] + (float)pv[j] * __builtin_amdgcn_rcpf(1.0f + __builtin_amdgcn_exp2f(nrs * a0[j]));
                            o1[j] = (float)xv[4 + j] + (float)pv[4 + j] * __builtin_amdgcn_rcpf(1.0f + __builtin_amdgcn_exp2f(nrs * a1[j])); }
                        *(f32x4*)(C + off + bj * HALF) = o0; *(f32x4*)(C + off + bj * HALF + 4) = o1; } }
                asm volatile("" ::: "memory"); }
    }
};
template <int MODE> struct EpiF32 {
    static constexpr bool PERM = false;
    const float* base; float* C; int ldc; const f16* pj; const float* ssp;
    __device__ __forceinline__ void operator()(const f32x4 (&acc)[2][2][4][2], const Unit& u, int wr, int wc, int fr, int fq) const {
        const int row0 = u.pm * BM + wr * 64 + fr, col0 = u.pn * BM + wc * 32 + 4 * fq;
#pragma unroll
        for (int ai = 0; ai < 2; ++ai)
#pragma unroll
            for (int m = 0; m < 4; ++m) { const size_t off = (size_t)(row0 + ai * HALF + m * 16) * ldc + col0;
                float nrs = -LOG2E;
                if (MODE == 1) { const f32x4 s0 = *(const f32x4*)(ssp + (size_t)(row0 + ai * HALF + m * 16) * 8), s1 = *(const f32x4*)(ssp + (size_t)(row0 + ai * HALF + m * 16) * 8 + 4);
                    nrs = -LOG2E / sqrtf((((s0.x + s0.y) + (s0.z + s0.w)) + ((s1.x + s1.y) + (s1.z + s1.w))) * (1.f / D) + RMS_EPS); }
#pragma unroll
                for (int bj = 0; bj < 2; ++bj)
#pragma unroll
                    for (int n = 0; n < 2; ++n) { const size_t o2 = off + bj * HALF + n * 16; const f32x4 bs = *(const f32x4*)(base + o2); f32x4 a = acc[ai][bj][m][n];
                        if (MODE == 1) { const f16x4 pv = *(const f16x4*)(pj + o2);
#pragma unroll
                            for (int j = 0; j < 4; ++j) a[j] = (float)pv[j] * __builtin_amdgcn_rcpf(1.0f + __builtin_amdgcn_exp2f(nrs * a[j])); }
                        *(f32x4*)(C + o2) = bs + a; }
                asm volatile("" ::: "memory"); }
    }
};

template <class Epi, class Sched>
__device__ __forceinline__ void gemm_phase(LAS unsigned char* lds, const Gemm g, const Sched& S, const Epi& E) {
    const int tid = threadIdx.x, wid = __builtin_amdgcn_readfirstlane(tid >> 6), lane = tid & 63, wr = wid >> 2, wc = wid & 3, fr = lane & 15, fq = lane >> 4;
    const int K = g.K, nt = K / BK;
    unsigned voffA[2], voffB[2];
#pragma unroll
    for (int i = 0; i < 2; ++i) { int R, C; stage_rc(tid * 16 + i * 8192, R, C); const int Rb = Epi::PERM ? ((R & ~31) + perm32(R & 31)) : R;
        voffA[i] = (unsigned)(R * g.lda + C) * 2u; voffB[i] = (unsigned)(Rb * g.ldb + C) * 2u; }
    const size_t kstep = (size_t)(BK * 2);
    const size_t hstepA = (size_t)HALF * g.lda * 2, hstepB = (size_t)HALF * g.ldb * 2;
    const unsigned ldsw = (unsigned)wid * 1024u;
    const int aoff = lds_byte(wr * 64 + fr, fq * 8), boff = lds_byte(wc * 32 + fr, fq * 8);
#define PG8_SA(b, h) (((b) * 2 + (h)) * HTB)
#define PG8_SB(b, h) ((4 + (b) * 2 + (h)) * HTB)
#define PG8_STAGE(bufoff, gbase, voff) do { _Pragma("unroll") for (int _i = 0; _i < 2; ++_i) \
        __builtin_amdgcn_global_load_lds((const unsigned*)((const char*)(gbase) + (voff)[_i]), (LAS unsigned*)(lds + (bufoff) + ldsw + _i * 8192), 16, 0, 0); } while (0)
#define PG8_LDA(dst, b, h) do { _Pragma("unroll") for (int m = 0; m < 4; ++m) _Pragma("unroll") for (int k = 0; k < 2; ++k) dst[m][k] = *(const LAS f16x8*)(lds + PG8_SA(b, h) + aoff + m * 2048 + k * 1024); } while (0)
#define PG8_LDB(dst, b, h) do { _Pragma("unroll") for (int n = 0; n < 2; ++n) _Pragma("unroll") for (int k = 0; k < 2; ++k) dst[n][k] = *(const LAS f16x8*)(lds + PG8_SB(b, h) + boff + n * 2048 + k * 1024); } while (0)
#define PG8_MMA(ai, bj, At, Bt) do { __builtin_amdgcn_s_setprio(1); _Pragma("unroll") for (int m = 0; m < 4; ++m) _Pragma("unroll") for (int n = 0; n < 2; ++n) _Pragma("unroll") for (int k = 0; k < 2; ++k) \
        acc[ai][bj][m][n] = __builtin_amdgcn_mfma_f32_16x16x32_f16(Bt[n][k], At[m][k], acc[ai][bj][m][n], 0, 0, 0); __builtin_amdgcn_s_setprio(0); } while (0)
#define PG8_WAIT_V(n) asm volatile("s_waitcnt vmcnt(" #n ")" ::: "memory")
#define PG8_WAIT_L(n) asm volatile("s_waitcnt lgkmcnt(" #n ")" ::: "memory")
#define PG8_BAR __builtin_amdgcn_s_barrier()
#define PG8_SCHED __builtin_amdgcn_sched_barrier(0)
    Unit cur, nxt; int ui = 0;
    if (!S.next(0, cur)) return;
    f32x4 acc[2][2][4][2];
#pragma unroll
    for (int a = 0; a < 2; ++a)
#pragma unroll
        for (int b = 0; b < 2; ++b)
#pragma unroll
            for (int m = 0; m < 4; ++m)
#pragma unroll
                for (int n = 0; n < 2; ++n) acc[a][b][m][n] = (f32x4){0.f, 0.f, 0.f, 0.f};
    f16x8 At[4][2], B0[2][2], B1[2][2];
    const char* cA = g.aptr(cur); const char* cB = g.bptr(cur);
    PG8_STAGE(PG8_SB(0, 0), cB, voffB); PG8_STAGE(PG8_SB(0, 1), cB + hstepB, voffB); PG8_STAGE(PG8_SA(0, 0), cA, voffA); PG8_STAGE(PG8_SA(0, 1), cA + hstepA, voffA);
    if (wr == 1) PG8_BAR;
    PG8_WAIT_V(2); PG8_BAR;
    PG8_STAGE(PG8_SB(1, 0), cB + kstep, voffB); PG8_STAGE(PG8_SA(1, 0), cA + kstep, voffA); PG8_STAGE(PG8_SB(1, 1), cB + hstepB + kstep, voffB);
    PG8_WAIT_V(6); PG8_BAR;
    for (;;) {
        const bool has_next = S.next(ui + 1, nxt);
        const char* nA = has_next ? g.aptr(nxt) : cA; const char* nB = has_next ? g.bptr(nxt) : cB;
        for (int t = 0; t < nt; t += 2) {
            const bool last = (t == nt - 2);
            const char* a1 = cA + (size_t)(t + 1) * kstep;
            const char* a2 = last ? nA : cA + (size_t)(t + 2) * kstep; const char* b2 = last ? nB : cB + (size_t)(t + 2) * kstep;
            const char* a3 = a2 + kstep; const char* b3 = b2 + kstep;
            PG8_LDB(B0, 0, 0); PG8_LDB(B1, 0, 1); PG8_SCHED; PG8_LDA(At, 0, 0); PG8_STAGE(PG8_SA(1, 1), a1 + hstepA, voffA);
            PG8_WAIT_V(8); PG8_WAIT_L(0); PG8_BAR; PG8_MMA(0, 0, At, B0); PG8_MMA(0, 1, At, B1); PG8_BAR; PG8_SCHED;
            PG8_LDA(At, 0, 1); PG8_STAGE(PG8_SB(0, 0), b2, voffB); PG8_STAGE(PG8_SB(0, 1), b2 + hstepB, voffB); PG8_STAGE(PG8_SA(0, 0), a2, voffA);
            PG8_WAIT_V(8); PG8_WAIT_L(0); PG8_BAR; PG8_MMA(1, 0, At, B0); PG8_MMA(1, 1, At, B1); PG8_BAR; PG8_SCHED;
            PG8_LDB(B0, 1, 0); PG8_LDB(B1, 1, 1); PG8_SCHED; PG8_LDA(At, 1, 0); PG8_STAGE(PG8_SA(0, 1), a2 + hstepA, voffA);
            PG8_WAIT_V(8); PG8_WAIT_L(0); PG8_BAR; PG8_MMA(0, 0, At, B0); PG8_MMA(0, 1, At, B1); PG8_BAR; PG8_SCHED;
            PG8_LDA(At, 1, 1); PG8_STAGE(PG8_SB(1, 0), b3, voffB); PG8_STAGE(PG8_SB(1, 1), b3 + hstepB, voffB); PG8_STAGE(PG8_SA(1, 0), a3, voffA);
            PG8_WAIT_V(8); PG8_WAIT_L(0); PG8_BAR; PG8_MMA(1, 0, At, B0); PG8_MMA(1, 1, At, B1); PG8_BAR; PG8_SCHED;
        }
        if (wr == 0) PG8_BAR;
        E(acc, cur, wr, wc, fr, fq);
        if (!has_next) break;
#pragma unroll
        for (int a = 0; a < 2; ++a)
#pragma unroll
            for (int b = 0; b < 2; ++b)
#pragma unroll
                for (int m = 0; m < 4; ++m)
#pragma unroll
                    for (int n = 0; n < 2; ++n) acc[a][b][m][n] = (f32x4){0.f, 0.f, 0.f, 0.f};
        cur = nxt; cA = nA; cB = nB; ++ui;
        if (wr == 1) PG8_BAR;
    }
    PG8_WAIT_V(0);
    PG8_BAR;
#undef PG8_SA
#undef PG8_SB
#undef PG8_STAGE
#undef PG8_LDA
#undef PG8_LDB
#undef PG8_MMA
#undef PG8_WAIT_V
#undef PG8_WAIT_L
#undef PG8_BAR
#undef PG8_SCHED
}
}

#define XB_TMO      128
#define XB_XCNT(j)  (256  + 64 * (j))
#define XB_XSUB(j)  (1280 + 64 * (j))
#define XB_XGEN(j)  (2304 + 64 * (j))
#define XB_TOP      3328
#define XB_TOPGEN   3392
#define XCD_BAR_WORDS 3456
#define XB_SPIN_CAP (1u << 18)
__device__ __forceinline__ unsigned xb_ld(unsigned* p)              { return __hip_atomic_load(p, __ATOMIC_RELAXED, __HIP_MEMORY_SCOPE_AGENT); }
__device__ __forceinline__ unsigned xb_add(unsigned* p, unsigned v) { return __hip_atomic_fetch_add(p, v, __ATOMIC_RELAXED, __HIP_MEMORY_SCOPE_AGENT); }
__device__ __forceinline__ unsigned xb_xcc_id() { return (unsigned)__builtin_amdgcn_s_getreg((3 << 11) | 20) & 0xFu; }
#define XB_SPIN(cond, bar) do { unsigned _sp = 0; while (cond) { __builtin_amdgcn_s_sleep(1); \
    if ((++_sp & 255u) == 0u) { if (xb_ld(&(bar)[XB_TMO])) break; if (_sp > XB_SPIN_CAP) { atomicAdd(&(bar)[XB_TMO], 1u); break; } } } } while (0)
struct XcdBarrier { unsigned* bar; unsigned x; volatile LAS unsigned* st; };
__device__ __forceinline__ XcdBarrier xcd_barrier_post(unsigned* bar, volatile LAS unsigned* st) {
    XcdBarrier b; b.bar = bar; b.x = xb_xcc_id(); b.st = st;
    if (threadIdx.x == 0) (void)xb_add(&bar[XB_XCNT(b.x)], 1u);
    return b;
}
__device__ __forceinline__ void xcd_barrier_complete(unsigned* bar, unsigned x, unsigned& nloc, unsigned& nx) {
    const unsigned G = gridDim.x * gridDim.y * gridDim.z;
    unsigned sum, cnt, mine, sp = 0u;
    for (;;) {
        sum = 0u; cnt = 0u; mine = 0u;
#pragma unroll
        for (unsigned j = 0; j < 16; ++j) { const unsigned c = xb_ld(&bar[XB_XCNT(j)]); sum += c; cnt += (c > 0u) ? 1u : 0u; mine = (j == x) ? c : mine; }
        if (sum == G) break;
        __builtin_amdgcn_s_sleep(1);
        if ((++sp & 255u) == 0u) { if (xb_ld(&bar[XB_TMO])) break; if (sp > XB_SPIN_CAP) { atomicAdd(&bar[XB_TMO], 1u); break; } }
    }
    nloc = mine > 0u ? mine : 1u; nx = cnt > 0u ? cnt : 1u;
}
__device__ __forceinline__ void xcd_barrier(const XcdBarrier& b) {
    asm volatile("s_waitcnt vmcnt(0)" ::: "memory");
    __syncthreads();
    if (threadIdx.x == 0) {
        unsigned* bar = b.bar;
        __builtin_amdgcn_s_waitcnt(0);
        unsigned nloc = b.st[0], nx = b.st[1];
        if (nloc == 0u) { xcd_barrier_complete(bar, b.x, nloc, nx); b.st[0] = nloc; b.st[1] = nx; }
        const unsigned old = xb_add(&bar[XB_XSUB(b.x)], 1u);
        const unsigned gen = old / nloc;
        if (old + 1u == (gen + 1u) * nloc) {
            __builtin_amdgcn_fence(__ATOMIC_RELEASE, "agent");
            asm volatile("s_waitcnt vmcnt(0)" ::: "memory");
            const unsigned og = xb_add(&bar[XB_TOP], 1u);
            const unsigned tg = og / nx;
            if (og + 1u == (tg + 1u) * nx) xb_add(&bar[XB_TOPGEN], 1u);
            else XB_SPIN(xb_ld(&bar[XB_TOPGEN]) == tg, bar);
            __builtin_amdgcn_fence(__ATOMIC_ACQUIRE, "agent");
            xb_add(&bar[XB_XGEN(b.x)], 1u);
            asm volatile("s_waitcnt vmcnt(0)" ::: "memory");
        } else {
            XB_SPIN(xb_ld(&bar[XB_XGEN(b.x)]) == gen, bar);
            __builtin_amdgcn_fence(__ATOMIC_ACQUIRE, "agent");
            asm volatile("s_waitcnt vmcnt(0)" ::: "memory");
        }
    }
    __syncthreads();
}

struct Frame {
    LAS unsigned char* lds;
    volatile LAS unsigned* MISC;
    int tid, lane, wave;
    int vcu, G;
    const float* in[26];
    float* out;
    unsigned char* ws;
};
enum { I_X = 0, I_P, I_RELB, I_MIXNW, I_WIN, I_QNW, I_KNW, I_CKPOS, I_CKW1, I_CKB1, I_CKW2, I_CVPOS, I_CVW1, I_CVB1, I_CVW2, I_POOLW, I_POOLS, I_WOUT, I_FFNNW, I_PWQ, I_PKEYS, I_PU, I_PV, I_PLENW, I_PLEWG, I_PLEWP };

__device__ __forceinline__ void p0_transpose_item(const float* W, int K, int N, int Npad, const float* colscale, f16* WT, LAS float* scr, int item, int lane, const float* kscale = nullptr) {
    const int nblk = Npad / 32, kb = item / nblk, nb = item % nblk, k0 = 64 * kb, n0 = 32 * nb;
    const int nn = n0 + (lane & 31); const bool ok = nn < N;
#pragma unroll 8
    for (int i = 0; i < 32; ++i) { const int kk = 2 * i + (lane >> 5); scr[kk * 33 + (lane & 31)] = ok ? W[(size_t)(k0 + kk) * N + nn] * (kscale ? kscale[k0 + kk] : 1.f) : 0.f; }
    LDS_WAIT(); asm volatile("" ::: "memory");
    const int c = lane & 7;
#pragma unroll
    for (int j = 0; j < 4; ++j) { const int n = (lane >> 3) + 8 * j; const LAS float* s = scr + (8 * c) * 33 + n; const float sc = (colscale && n0 + n < N) ? colscale[n0 + n] : 1.f;
        u32x4 o; o.x = pk_f16(s[0 * 33] * sc, s[1 * 33] * sc); o.y = pk_f16(s[2 * 33] * sc, s[3 * 33] * sc); o.z = pk_f16(s[4 * 33] * sc, s[5 * 33] * sc); o.w = pk_f16(s[6 * 33] * sc, s[7 * 33] * sc);
        *(GAS u32x4*)(WT + (size_t)(n0 + n) * K + k0 + 8 * c) = o; }
    LDS_WAIT(); asm volatile("" ::: "memory");
}
__device__ __forceinline__ void rms_row_to_f16(const float* xrow, const float* w, f16* orow, int lane, f16* x16row = nullptr) {
    const GAS f32x4* xr = (const GAS f32x4*)xrow + lane; const GAS f32x4* wr = (const GAS f32x4*)w + lane;
    f32x4 v[8]; float s = 0.f;
#pragma unroll
    for (int j = 0; j < 8; ++j) { v[j] = xr[64 * j]; s += (v[j].x * v[j].x + v[j].y * v[j].y) + (v[j].z * v[j].z + v[j].w * v[j].w); }
    const float rstd = 1.f / sqrtf(wave_sum(s) * (1.f / D) + RMS_EPS);
    GAS u32x2* o8 = (GAS u32x2*)orow + lane;
#pragma unroll
    for (int j = 0; j < 8; ++j) { const f32x4 g = wr[64 * j]; u32x2 o; o.x = pk_f16(v[j].x * rstd * g.x, v[j].y * rstd * g.y); o.y = pk_f16(v[j].z * rstd * g.z, v[j].w * rstd * g.w); o8[64 * j] = o; }
    if (x16row) { GAS u32x2* x8 = (GAS u32x2*)x16row + lane;
#pragma unroll
        for (int j = 0; j < 8; ++j) { u32x2 o; o.x = pk_f16(v[j].x, v[j].y); o.y = pk_f16(v[j].z, v[j].w); x8[64 * j] = o; } }
}
__device__ __forceinline__ void rms_2rows_to_f16(const float* x0, const float* x1, const float* w, f16* o0, f16* o1, f16* h0, f16* h1, int lane) {
    const GAS f32x4* xa = (const GAS f32x4*)x0 + lane; const GAS f32x4* xb = (const GAS f32x4*)x1 + lane; const GAS f32x4* wr = (const GAS f32x4*)w + lane;
    f32x4 va[8], vb[8]; float sa = 0.f, sb = 0.f;
#pragma unroll
    for (int j = 0; j < 8; ++j) { va[j] = __builtin_nontemporal_load(xa + 64 * j); vb[j] = __builtin_nontemporal_load(xb + 64 * j); }
#pragma unroll
    for (int j = 0; j < 8; ++j) { sa += (va[j].x * va[j].x + va[j].y * va[j].y) + (va[j].z * va[j].z + va[j].w * va[j].w); sb += (vb[j].x * vb[j].x + vb[j].y * vb[j].y) + (vb[j].z * vb[j].z + vb[j].w * vb[j].w); }
    const float ra = 1.f / sqrtf(wave_sum(sa) * (1.f / D) + RMS_EPS), rb = 1.f / sqrtf(wave_sum(sb) * (1.f / D) + RMS_EPS);
    GAS u32x2* pa = (GAS u32x2*)o0 + lane; GAS u32x2* pb = (GAS u32x2*)o1 + lane; GAS u32x2* qa = (GAS u32x2*)h0 + lane; GAS u32x2* qb = (GAS u32x2*)h1 + lane;
#pragma unroll
    for (int j = 0; j < 8; ++j) { const f32x4 g = wr[64 * j]; u32x2 o;
        o.x = pk_f16(va[j].x * ra * g.x, va[j].y * ra * g.y); o.y = pk_f16(va[j].z * ra * g.z, va[j].w * ra * g.w); pa[64 * j] = o;
        o.x = pk_f16(vb[j].x * rb * g.x, vb[j].y * rb * g.y); o.y = pk_f16(vb[j].z * rb * g.z, vb[j].w * rb * g.w); pb[64 * j] = o;
        o.x = pk_f16(va[j].x, va[j].y); o.y = pk_f16(va[j].z, va[j].w); qa[64 * j] = o;
        o.x = pk_f16(vb[j].x, vb[j].y); o.y = pk_f16(vb[j].z, vb[j].w); qb[64 * j] = o; }
}
__device__ __forceinline__ void x16_2rows(const float* x0, const float* x1, f16* h0, f16* h1, float* ss0, float* ss1, int lane) {
    const GAS f32x4* xa = (const GAS f32x4*)x0 + lane; const GAS f32x4* xb = (const GAS f32x4*)x1 + lane;
    f32x4 va[8], vb[8]; float sa = 0.f, sb = 0.f;
#pragma unroll
    for (int j = 0; j < 8; ++j) { va[j] = __builtin_nontemporal_load(xa + 64 * j); vb[j] = __builtin_nontemporal_load(xb + 64 * j); }
    GAS u32x2* qa = (GAS u32x2*)h0 + lane; GAS u32x2* qb = (GAS u32x2*)h1 + lane;
#pragma unroll
    for (int j = 0; j < 8; ++j) { sa += (va[j].x * va[j].x + va[j].y * va[j].y) + (va[j].z * va[j].z + va[j].w * va[j].w); sb += (vb[j].x * vb[j].x + vb[j].y * vb[j].y) + (vb[j].z * vb[j].z + vb[j].w * vb[j].w);
        u32x2 o; o.x = pk_f16(va[j].x, va[j].y); o.y = pk_f16(va[j].z, va[j].w); qa[64 * j] = o;
        o.x = pk_f16(vb[j].x, vb[j].y); o.y = pk_f16(vb[j].z, vb[j].w); qb[64 * j] = o; }
    sa = wave_sum(sa); sb = wave_sum(sb);
    if (lane == 0) { *ss0 = sa; *ss1 = sb; }
}
__device__ __forceinline__ void cvt_f32_f16(Frame& F, const float* src, f16* dst, size_t n) {
    const size_t gt = (size_t)F.vcu * 512 + F.tid, GT = (size_t)F.G * 512;
    for (size_t i = gt; i < n / 8; i += GT) { const f32x4 a = *(const GAS f32x4*)(src + i * 8), b = *(const GAS f32x4*)(src + i * 8 + 4);
        u32x4 o; o.x = pk_f16(a.x, a.y); o.y = pk_f16(a.z, a.w); o.z = pk_f16(b.x, b.y); o.w = pk_f16(b.z, b.w); *(GAS u32x4*)(dst + i * 8) = o; }
}

__device__ __forceinline__ void p0_prologue(Frame& F) {
    LAS float* scr = (LAS float*)(F.lds + F.wave * 16384);
    const int gw = F.vcu * NWAVES + F.wave, NGW = F.G * NWAVES;
    unsigned char* ws = F.ws;
    constexpr int I_IN = (D / 64) * (NINP / 32), I_SQ = (D / 64) * (D / 32), I_PJ = (256 / 64) * (D / 32), I_C1 = (D / 64) * (256 / 32), I_PL = (256 / 64) * (256 / 32);
    constexpr int NITEMS = I_IN + 3 * I_SQ + I_PJ + 2 * I_C1 + 4 * I_PL;
    for (int it = gw; it < NITEMS; it += NGW) {
        int r = it;
        if (r < I_IN) { p0_transpose_item(F.in[I_WIN], D, NIN, NINP, nullptr, (f16*)(ws + WS_WIN), scr, r, F.lane, F.in[I_MIXNW]); continue; } r -= I_IN;
        if (r < I_SQ) { p0_transpose_item(F.in[I_WOUT], D, D, D, nullptr, (f16*)(ws + WS_WOUT), scr, r, F.lane); continue; } r -= I_SQ;
        if (r < I_SQ) { p0_transpose_item(F.in[I_PWQ], D, D, D, nullptr, (f16*)(ws + WS_WQ), scr, r, F.lane, F.in[I_FFNNW]); continue; } r -= I_SQ;
        if (r < I_SQ) { p0_transpose_item(F.in[I_PLEWG], D, D, D, nullptr, (f16*)(ws + WS_WG), scr, r, F.lane, F.in[I_PLENW]); continue; } r -= I_SQ;
        if (r < I_PJ) { p0_transpose_item(F.in[I_PLEWP], 256, D, D, nullptr, (f16*)(ws + WS_WPJ), scr, r, F.lane); continue; } r -= I_PJ;
        if (r < I_C1) { p0_transpose_item(F.in[I_CKW1], D, 256, 256, nullptr, (f16*)(ws + WS_W1C), scr, r, F.lane); continue; } r -= I_C1;
        if (r < I_C1) { p0_transpose_item(F.in[I_CVW1], D, 256, 256, nullptr, (f16*)(ws + WS_W1C) + 256 * D, scr, r, F.lane); continue; } r -= I_C1;
        { const int g = r / I_PL; r -= g * I_PL;
          p0_transpose_item(F.in[I_POOLW] + (size_t)g * 65536, 256, 256, 256, F.in[I_POOLS] + g * 256, (f16*)(ws + WS_POOLT) + (size_t)g * 65536, scr, r, F.lane); }
    }
    { float* SS0 = (float*)(ws + WS_SS0); f16* XR = (f16*)(ws + WS_XR);
      for (int m = gw; m < M; m += 2 * NGW) { const int m2 = m + NGW < M ? m + NGW : m;
          x16_2rows(F.in[I_X] + (size_t)m * D, F.in[I_X] + (size_t)m2 * D, XR + (size_t)m * D, XR + (size_t)m2 * D, SS0 + m, SS0 + m2, F.lane); } }
    cvt_f32_f16(F, F.in[I_P], (f16*)(ws + WS_P16), (size_t)M * 256);
    cvt_f32_f16(F, F.in[I_PKEYS], (f16*)(ws + WS_KEYS), (size_t)8 * 2 * 128 * 128);
    for (int task = gw; task < 512; task += NGW) { const int mat = task >> 8, n = task & 255;
        const float* pos = F.in[mat ? I_CVPOS : I_CKPOS]; const float* w1 = F.in[mat ? I_CVW1 : I_CKW1]; float s = 0.f;
#pragma unroll
        for (int i = 0; i < 32; ++i) { const int k = F.lane + 64 * i; s += pos[k] * w1[(size_t)k * 256 + n]; }
        s = wave_sum(s);
        if (F.lane == 0) ((float*)(ws + WS_CBIAS))[task] = s + F.in[mat ? I_CVB1 : I_CKB1][n]; }
}

template <int W> __device__ __forceinline__ void pool_mix_tile(const f16* up, f16* mp, size_t mb, int s0) {
    f16x2 prev[16], cur[16]; f32x2 sum = {0.f, 0.f};
#pragma unroll
    for (int i = 0; i < 16; ++i) { const int sp = s0 - 16 + i; prev[i] = sp >= 0 ? *(const GAS f16x2*)(up + (mb + sp) * NINP) : (f16x2){(f16)0.f, (f16)0.f}; }
#pragma unroll
    for (int i = 16 - W; i < 16; ++i) { sum.x += (float)prev[i].x; sum.y += (float)prev[i].y; }
#pragma unroll 1
    for (int blk = 0; blk < 4; ++blk) { const int sb = s0 + blk * 16;
#pragma unroll
        for (int i = 0; i < 16; ++i) cur[i] = *(const GAS f16x2*)(up + (mb + sb + i) * NINP);
#pragma unroll
        for (int i = 0; i < 16; ++i) { const int s = sb + i; const f16x2 o = (i - W >= 0) ? cur[(i - W >= 0) ? i - W : 0] : prev[(i - W >= 0) ? 0 : 16 + i - W];
            sum.x += (float)cur[i].x - (float)o.x; sum.y += (float)cur[i].y - (float)o.y;
            const float ic = 1.f / (float)(s + 1 < W ? s + 1 : W);
            *(GAS unsigned*)(mp + (mb + s) * 1024) = pk_f16(sum.x * ic - (float)cur[i].x, sum.y * ic - (float)cur[i].y); }
#pragma unroll
        for (int i = 0; i < 16; ++i) prev[i] = cur[i]; }
}
__device__ __forceinline__ void p2_post(Frame& F) {
    unsigned char* ws = F.ws;
    f16* Y = (f16*)(ws + WS_Y);
    const float* qnw = F.in[I_QNW]; const float* knw = F.in[I_KNW];
    LAS f16* vl = (LAS f16*)F.lds;
    constexpr int VLP = 264;
    for (int tt = F.vcu; tt < M / 64; tt += F.G) {
        const int b = tt >> 5, s0 = (tt & 31) * 64, m0 = tt * 64;
        for (int tk = F.wave; tk < 64; tk += NWAVES) {
            const int m = m0 + tk, s = s0 + tk; f16* yr = Y + (size_t)m * NINP;
#pragma unroll
            for (int pass = 0; pass < 2; ++pass) { const int ch = pass * 64 + F.lane; f16* pq = yr + OFF_Q + ch * 8; const f16x8 v = *(const GAS f16x8*)pq;
                float ss = 0.f;
#pragma unroll
                for (int e = 0; e < 8; ++e) ss += (float)v[e] * (float)v[e];
                ss = sum8(ss);
                const float rs = (1.f / sqrtf(ss * (1.f / 64.f) + RMS_EPS)) * (0.125f * LOG2E); const float* w = qnw + (ch & 7) * 8;
                u32x4 o; o.x = pk_f16((float)v[0] * rs * w[0], (float)v[1] * rs * w[1]); o.y = pk_f16((float)v[2] * rs * w[2], (float)v[3] * rs * w[3]);
                o.z = pk_f16((float)v[4] * rs * w[4], (float)v[5] * rs * w[5]); o.w = pk_f16((float)v[6] * rs * w[6], (float)v[7] * rs * w[7]);
                *(GAS u32x4*)((f16*)(ws + WS_QN) + (size_t)m * 1024 + ch * 8) = o; }
            { const int br = F.lane >> 5, ch = F.lane & 31, g = ch >> 3, dc = ch & 7; const f16x8 v = *(const GAS f16x8*)(yr + (br ? OFF_KW : OFF_KS) + ch * 8);
                float ss = 0.f;
#pragma unroll
                for (int e = 0; e < 8; ++e) ss += (float)v[e] * (float)v[e];
                ss = sum8(ss);
                const float rs = 1.f / sqrtf(ss * (1.f / 64.f) + RMS_EPS); const float* w = knw + dc * 8;
                u32x4 o; o.x = pk_f16((float)v[0] * rs * w[0], (float)v[1] * rs * w[1]); o.y = pk_f16((float)v[2] * rs * w[2], (float)v[3] * rs * w[3]);
                o.z = pk_f16((float)v[4] * rs * w[4], (float)v[5] * rs * w[5]); o.w = pk_f16((float)v[6] * rs * w[6], (float)v[7] * rs * w[7]);
                *(GAS u32x4*)((f16*)(ws + WS_KN) + (size_t)br * (BATCH * 4 * SEQ * 64) + ((size_t)(b * 4 + g) * 64 + (s >> 5)) * 2048 + (dc >> 1) * 512 + ((dc & 1) * 32 + (s & 31)) * 8) = o; }
            { const int mat = F.lane >> 5, ch = F.lane & 31, g = ch >> 3, dc = ch & 7; const u32x4 v = *(const GAS u32x4*)(yr + (mat ? OFF_VC : OFF_KC) + ch * 8);
                const int i1 = s >> 4, jj = s & 15; f16* fa = (f16*)(ws + WS_FLATA) + (size_t)mat * 4096 * 2048;
                if (i1 <= NCMP - 1) *(GAS u32x4*)(fa + (size_t)((b * NCMP + i1) * 4 + g) * 2048 + jj * 64 + dc * 8) = v;
                if (i1 >= 1) *(GAS u32x4*)(fa + (size_t)((b * NCMP + i1 - 1) * 4 + g) * 2048 + (16 + jj) * 64 + dc * 8) = v; }
        }
        for (int idx = F.tid; idx < 64 * 48; idx += 512) { const int tk = idx / 48, c = idx - tk * 48; const float v = (float)Y[(size_t)(m0 + tk) * NINP + OFF_G + c];
            ((float*)(ws + WS_GATES))[(size_t)(m0 + tk) * 48 + c] = 1.f / (1.f + __expf(-v)); }
        { const int gg = F.tid >> 7;
          if (gg == 0) pool_mix_tile<2>(Y + OFF_U + F.tid * 2, (f16*)(ws + WS_MIXED) + F.tid * 2, (size_t)b * SEQ, s0);
          else if (gg == 1) pool_mix_tile<4>(Y + OFF_U + F.tid * 2, (f16*)(ws + WS_MIXED) + F.tid * 2, (size_t)b * SEQ, s0);
          else if (gg == 2) pool_mix_tile<8>(Y + OFF_U + F.tid * 2, (f16*)(ws + WS_MIXED) + F.tid * 2, (size_t)b * SEQ, s0);
          else pool_mix_tile<16>(Y + OFF_U + F.tid * 2, (f16*)(ws + WS_MIXED) + F.tid * 2, (size_t)b * SEQ, s0); }
        __syncthreads();
        for (int idx = F.tid; idx < 2 * 64 * 32; idx += 512) { const int br = idx >> 11, tk = (idx >> 5) & 63, ch = idx & 31;
            *(LAS u32x4*)(vl + (br * 64 + tk) * VLP + ch * 8) = *(const GAS u32x4*)(Y + (size_t)(m0 + tk) * NINP + (br ? OFF_VW : OFF_VS) + ch * 8); }
        __syncthreads();
        for (int idx = F.tid; idx < 2 * 256 * 8; idx += 512) { const int br = idx >> 11, row = (idx >> 3) & 255, cc = idx & 7, grp = cc >> 1, hh = cc & 1;
            f16x8 o;
#pragma unroll
            for (int j = 0; j < 8; ++j) { const int kap = 16 * grp + 8 * (j >> 2) + 4 * hh + (j & 3); o[j] = vl[(br * 64 + kap) * VLP + row]; }
            const int g = row >> 6, d = row & 63;
            *(GAS f16x8*)((f16*)(ws + WS_VT) + (size_t)br * (BATCH * 4 * 64 * SEQ) + ((size_t)(b * 4 + g) * 64 + (s0 >> 5) + (cc >> 2)) * 2048 + ((d >> 5) * 2 + ((cc >> 1) & 1)) * 512 + ((cc & 1) * 32 + (d & 31)) * 8) = o; }
        __syncthreads();
    }
}

__device__ __forceinline__ void p4_compress2(Frame& F) {
    unsigned char* ws = F.ws;
    f16* kc = (f16*)(ws + WS_KCMP); f16* vt = (f16*)(ws + WS_VCMPT);
    const int nhalf = F.G >> 1, mat = F.vcu & 1, wgr = F.vcu >> 1;
    if (nhalf == 0) return;
    LAS float* w2l = (LAS float*)F.lds;
    { const float* w2g = F.in[mat ? I_CVW2 : I_CKW2];
      for (int idx = F.tid; idx < 256 * 16; idx += 512) { const int k = idx >> 4, d4 = (idx & 15) * 4; const f32x4 v = *(const GAS f32x4*)(w2g + (size_t)k * 64 + d4);
          LAS float* q = w2l + ((k >> 2) * 64 + d4) * 4 + (k & 3); q[0] = v.x; q[4] = v.y; q[8] = v.z; q[12] = v.w; } }
    __syncthreads();
    const int rstep = nhalf * NWAVES, r0 = (F.vcu >= 2 * nhalf ? 4096 : wgr * NWAVES + F.wave);
#pragma unroll 1
    for (int rb = r0; rb < 4096; rb += 4 * rstep) {
        f32x4 hs[4];
#pragma unroll
        for (int q = 0; q < 4; ++q) { const int r = rb + q * rstep < 4096 ? rb + q * rstep : rb; const int bg = r >> 7, i = r & 127, ic = i < NCMP ? i : 0;
            const float* hp = (const float*)(ws + WS_Y) + ((size_t)mat * 4096 + (size_t)((bg >> 2) * NCMP + ic) * 4 + (bg & 3)) * 1024 + F.lane * 4;
            hs[q] = *(const GAS f32x4*)(((const float*)(ws + WS_CBIAS)) + mat * 256 + F.lane * 4);
#pragma unroll
            for (int ks = 0; ks < 4; ++ks) hs[q] = hs[q] + *(const GAS f32x4*)(hp + ks * 256); }
        float hh_[4][4], ac[4][4];
#pragma unroll
        for (int q = 0; q < 4; ++q) { const f32x2 ga = pg8::gelu_pk((f32x2){hs[q].x, hs[q].y}), gb = pg8::gelu_pk((f32x2){hs[q].z, hs[q].w});
            hh_[q][0] = ga.x; hh_[q][1] = ga.y; hh_[q][2] = gb.x; hh_[q][3] = gb.y; ac[q][0] = 0.f; ac[q][1] = 0.f; ac[q][2] = 0.f; ac[q][3] = 0.f; }
#pragma unroll 8
        for (int kk = 0; kk < 64; ++kk) { const f32x4 wv = *(const LAS f32x4*)(w2l + (kk * 64 + F.lane) * 4);
#pragma unroll
            for (int q = 0; q < 4; ++q) { ac[q][0] += rl_f(hh_[q][0], kk) * wv.x; ac[q][1] += rl_f(hh_[q][1], kk) * wv.y; ac[q][2] += rl_f(hh_[q][2], kk) * wv.z; ac[q][3] += rl_f(hh_[q][3], kk) * wv.w; } }
#pragma unroll
        for (int q = 0; q < 4; ++q) { const int r = rb + q * rstep; if (r < 4096) {
            const int bg = r >> 7, i = r & 127;
            const float acc = i < NCMP ? (ac[q][0] + ac[q][1]) + (ac[q][2] + ac[q][3]) : 0.f;
            if (mat == 0) { const float ss = wave_sum(acc * acc); const float rs = 1.f / sqrtf(ss * (1.f / 64.f) + RMS_EPS);
                const int d = F.lane, dc = d >> 3;
                kc[((size_t)bg * 4 + (i >> 5)) * 2048 + (dc >> 1) * 512 + ((dc & 1) * 32 + (i & 31)) * 8 + (d & 7)] = (f16)(i < NCMP ? acc * rs * F.in[I_KNW][F.lane] : 0.f); }
            else { const int kap = i & 15, pp = ((kap >> 2) & 1) * 8 + (kap >> 3) * 4 + (kap & 3);
                const int d = F.lane;
                vt[((size_t)bg * 4 + (i >> 5)) * 2048 + ((d >> 5) * 2 + ((i >> 4) & 1)) * 512 + ((pp >> 3) * 32 + (d & 31)) * 8 + (pp & 7)] = (f16)acc; } } }
    }
    __syncthreads();
}

__device__ __forceinline__ int t5_bucket(int rel) {
    if (rel < 16) return rel;
    int b = 16;
    b += rel >= 19; b += rel >= 21; b += rel >= 24; b += rel >= 27; b += rel >= 31; b += rel >= 35; b += rel >= 40; b += rel >= 46;
    b += rel >= 52; b += rel >= 59; b += rel >= 67; b += rel >= 77; b += rel >= 87; b += rel >= 99; b += rel >= 113;
    return b;
}
__device__ __forceinline__ int med3i(int a, int lo, int hi) { return a < lo ? lo : (a > hi ? hi : a); }
__device__ __forceinline__ float other_half_max(float x) { const auto r = __builtin_amdgcn_permlane32_swap(__float_as_uint(x), __float_as_uint(x), false, false); return fmaxf(__uint_as_float(r[0]), __uint_as_float(r[1])); }
__device__ __forceinline__ float both_halves_sum(float x) { const auto r = __builtin_amdgcn_permlane32_swap(__float_as_uint(x), __float_as_uint(x), false, false); return __uint_as_float(r[0]) + __uint_as_float(r[1]); }
struct AFrag { f16x8 k[4]; f16x8 v[2][2]; };
__device__ __forceinline__ void attn_load(AFrag& f, const f16* Kp, const f16* Vp, int kt, int r31, int hh) {
    const f16* kp = Kp + (size_t)kt * 2048 + (hh * 32 + r31) * 8; const f16* vp = Vp + (size_t)kt * 2048 + (hh * 32 + r31) * 8;
#pragma unroll
    for (int ks = 0; ks < 4; ++ks) f.k[ks] = *(const GAS f16x8*)(kp + ks * 512);
#pragma unroll
    for (int dt = 0; dt < 2; ++dt)
#pragma unroll
        for (int s2 = 0; s2 < 2; ++s2) f.v[dt][s2] = *(const GAS f16x8*)(vp + (dt * 2 + s2) * 512);
}
__device__ __forceinline__ f16x8 pack8(const f32x16& c, int s2) {
    f16x8 o;
#pragma unroll
    for (int j = 0; j < 8; ++j) o[j] = (f16)c[8 * s2 + j];
    return o;
}
__device__ __forceinline__ void attn_tile(const AFrag& f, const f16x8 (&bq)[4], int kt, int t0, int t, int hh, int wlim, unsigned selm, float cfar, const LAS float* lutr,
                                          float& mrun, float& lrun, f32x16& O0, f32x16& O1) {
    f32x16 S;
#pragma unroll
    for (int i = 0; i < 16; ++i) S[i] = 0.f;
#pragma unroll
    for (int ks = 0; ks < 4; ++ks) S = __builtin_amdgcn_mfma_f32_32x32x16_f16(f.k[ks], bq[ks], S, 0, 0, 0);
    const int k0 = kt * 32, minrel = t0 - (k0 + 31), maxrel = t0 + 7 - k0;
    const bool selbit = ((selm >> (kt >> 1)) & 1u) != 0u;
    if (minrel >= 113 && maxrel < wlim) {
        const float addc = selbit ? cfar : -2e30f;
#pragma unroll
        for (int i = 0; i < 16; ++i) S[i] += addc;
    } else {
        const unsigned wl = selbit ? (unsigned)wlim : 0u; const int relb = t - k0 - 4 * hh;
        float bias[16];
#pragma unroll
        for (int i = 0; i < 16; ++i) bias[i] = lutr[med3i(relb - ((i & 3) + 8 * (i >> 2)), 0, 127)];
#pragma unroll
        for (int i = 0; i < 16; ++i) asm volatile("" : "+v"(bias[i]));
#pragma unroll
        for (int i = 0; i < 16; ++i) { const int rel = relb - ((i & 3) + 8 * (i >> 2)); S[i] = ((unsigned)rel < wl) ? S[i] + bias[i] : -2e30f; }
    }
    float tmax = S[0];
#pragma unroll
    for (int i = 1; i < 16; ++i) tmax = fmaxf(tmax, S[i]);
    tmax = other_half_max(tmax);
    const float mnew = fmaxf(mrun, tmax), alpha = __builtin_amdgcn_exp2f(mrun - mnew);
    mrun = mnew; lrun *= alpha;
#pragma unroll
    for (int i = 0; i < 16; ++i) { O0[i] *= alpha; O1[i] *= alpha; }
#pragma unroll
    for (int i = 0; i < 16; ++i) { const float pv = __builtin_amdgcn_exp2f(S[i] - mnew); lrun += pv; S[i] = pv; }
#pragma unroll
    for (int s2 = 0; s2 < 2; ++s2) { const f16x8 pb = pack8(S, s2);
        O0 = __builtin_amdgcn_mfma_f32_32x32x16_f16(f.v[0][s2], pb, O0, 0, 0, 0); O1 = __builtin_amdgcn_mfma_f32_32x32x16_f16(f.v[1][s2], pb, O1, 0, 0, 0); }
}
__device__ __forceinline__ void attn_branch(const f16* Kp, const f16* Vp, unsigned long long tm, const f16x8 (&bq)[4], int t0, int t, int r31, int hh, int wlim, unsigned selm, float cfar,
                                            const LAS float* lutr, float gate, LAS float* TL) {
    float mrun = -1e30f, lrun = 0.f; f32x16 O0, O1;
#pragma unroll
    for (int i = 0; i < 16; ++i) { O0[i] = 0.f; O1[i] = 0.f; }
    AFrag fA, fB;
    int ktA = __builtin_ctzll(tm), ktB;
    attn_load(fA, Kp, Vp, ktA, r31, hh);
    for (;;) {
        tm &= tm - 1; const bool hasB = tm != 0ull; ktB = hasB ? __builtin_ctzll(tm) : ktA; attn_load(fB, Kp, Vp, ktB, r31, hh);
        attn_tile(fA, bq, ktA, t0, t, hh, wlim, selm, cfar, lutr, mrun, lrun, O0, O1);
        if (!hasB) break;
        tm &= tm - 1; const bool hasA = tm != 0ull; ktA = hasA ? __builtin_ctzll(tm) : ktB; attn_load(fA, Kp, Vp, ktA, r31, hh);
        attn_tile(fB, bq, ktB, t0, t, hh, wlim, selm, cfar, lutr, mrun, lrun, O0, O1);
        if (!hasA) break;
    }
    lrun = both_halves_sum(lrun);
    const float sc = gate / fmaxf(lrun, 1e-30f);
#pragma unroll
    for (int i = 0; i < 16; ++i) { TL[i * 64] += O0[i] * sc; TL[(16 + i) * 64] += O1[i] * sc; }
}
__device__ __forceinline__ void p5_attention(Frame& F) {
    unsigned char* ws = F.ws;
    const f16* Y = (const f16*)(ws + WS_Y);
    const float* gates = (const float*)(ws + WS_GATES);
    f16* CAT = (f16*)(ws + WS_CAT);
    LAS float* wl = (LAS float*)(F.lds + F.wave * 8192);
    LAS float* LUT = wl;
    const int gw = F.vcu * NWAVES + F.wave, NW = F.G * NWAVES;
    const bool snake = (8192 % (2 * NW)) == 0;
    int lut_g = -1;
    LAS unsigned* SELM = (LAS unsigned*)(wl + 1280);
    for (int it = gw, rr = 0; it < 8192; it += NW, ++rr) {
        const int n = (snake && (rr & 1)) ? (rr * NW + (NW - 1 - gw)) : it;
        const int bg = n >> 8, pos = n & 255, b = bg >> 2, g = bg & 3, t0 = pos * 8;
        int lane = F.lane; asm volatile("" : "+v"(lane));
        const int r31 = lane & 31, hh = lane >> 5, tok8 = r31 >> 2, r = r31 & 3;
        const LAS float* lutr = LUT + r * 128;
        if (g != lut_g) {
            LDS_WAIT(); asm volatile("" ::: "memory");
#pragma unroll
            for (int e = 0; e < 2; ++e) { const int rel = lane + 64 * e, bk = t5_bucket(rel);
#pragma unroll
                for (int r4 = 0; r4 < 4; ++r4) LUT[r4 * 128 + rel] = F.in[I_RELB][bk * 16 + 4 * g + r4] * LOG2E; }
            LDS_WAIT(); asm volatile("" ::: "memory");
            lut_g = g;
        }
        const int t = t0 + tok8, head = 4 * g + r; const size_t m = (size_t)b * SEQ + t;
        f16x8 bq[4];
#pragma unroll
        for (int ks = 0; ks < 4; ++ks) bq[ks] = *(const GAS f16x8*)((const f16*)(ws + WS_QN) + m * 1024 + head * 64 + ks * 16 + hh * 8);
        const float g_c = gates[m * 48 + head * 3 + 0], g_s = gates[m * 48 + head * 3 + 1], g_w = gates[m * 48 + head * 3 + 2];
        const float cfar = lutr[127];
        LAS float* TL = (LAS float*)(F.lds + 65536 + F.wave * 8192) + lane;
        {
            const f16* kc = (const f16*)(ws + WS_KCMP) + (size_t)bg * 128 * 64;
            const f16* vc = (const f16*)(ws + WS_VCMPT) + (size_t)bg * 64 * 128;
            f32x16 c[4];
#pragma unroll
            for (int kt = 0; kt < 4; ++kt) {
#pragma unroll
                for (int i = 0; i < 16; ++i) c[kt][i] = 0.f;
#pragma unroll
                for (int ks = 0; ks < 4; ++ks) { const f16x8 a = *(const GAS f16x8*)(kc + kt * 2048 + ks * 512 + (hh * 32 + r31) * 8); c[kt] = __builtin_amdgcn_mfma_f32_32x32x16_f16(a, bq[ks], c[kt], 0, 0, 0); }
                asm volatile("" ::: "memory");
            }
            const int relb = t - 31 - 64 * hh; float mx = -1e30f;
#pragma unroll
            for (int kt = 0; kt < 4; ++kt) { float bias[16];
#pragma unroll
                for (int i = 0; i < 16; ++i) { const int rel = relb - 16 * (kt * 32 + (i & 3) + 8 * (i >> 2)); bias[i] = lutr[med3i(rel, 0, 127)]; }
#pragma unroll
                for (int i = 0; i < 16; ++i) asm volatile("" : "+v"(bias[i]));
#pragma unroll
                for (int i = 0; i < 16; ++i) { const int rel = relb - 16 * (kt * 32 + (i & 3) + 8 * (i >> 2));
                    const float sv = rel >= 0 ? c[kt][i] + bias[i] : -2e30f; c[kt][i] = sv; mx = fmaxf(mx, sv); }
                asm volatile("" ::: "memory"); }
            mx = other_half_max(mx);
            float l = 0.f;
#pragma unroll
            for (int kt = 0; kt < 4; ++kt)
#pragma unroll
                for (int i = 0; i < 16; ++i) { const float pv = __builtin_amdgcn_exp2f(c[kt][i] - mx); c[kt][i] = pv; l += pv; }
            l = both_halves_sum(l);
            const float inv = 1.f / fmaxf(l, 1e-30f);
#pragma unroll
            for (int kt = 0; kt < 4; ++kt)
#pragma unroll
                for (int jj = 0; jj < 4; ++jj) { float own = (2.f * (c[kt][4 * jj] + c[kt][4 * jj + 1] + c[kt][4 * jj + 2]) + c[kt][4 * jj + 3]) * inv, p3 = c[kt][4 * jj + 3] * inv;
                    own += dpp_f<0xB1>(own); own += dpp_f<0x4E>(own); p3 += dpp_f<0xB1>(p3); p3 += dpp_f<0x4E>(p3);
                    if (r == 0) { const int j = kt * 8 + 2 * jj + hh; wl[512 + tok8 * 32 + j] = own; wl[768 + tok8 * 32 + j] = p3; } }
            f32x16 O0, O1;
#pragma unroll
            for (int i = 0; i < 16; ++i) { O0[i] = 0.f; O1[i] = 0.f; }
#pragma unroll
            for (int kt = 0; kt < 4; ++kt)
#pragma unroll
                for (int s2 = 0; s2 < 2; ++s2) { const f16x8 pb = pack8(c[kt], s2);
                    const f16x8 a0 = *(const GAS f16x8*)(vc + kt * 2048 + s2 * 512 + (hh * 32 + r31) * 8), a1 = *(const GAS f16x8*)(vc + kt * 2048 + (2 + s2) * 512 + (hh * 32 + r31) * 8);
                    O0 = __builtin_amdgcn_mfma_f32_32x32x16_f16(a0, pb, O0, 0, 0, 0); O1 = __builtin_amdgcn_mfma_f32_32x32x16_f16(a1, pb, O1, 0, 0, 0); asm volatile("" ::: "memory"); }
            const float sc = inv * g_c;
#pragma unroll
            for (int i = 0; i < 16; ++i) { TL[i * 64] = O0[i] * sc; TL[(16 + i) * 64] = O1[i] * sc; }
        }
        LDS_WAIT(); asm volatile("" ::: "memory");
        int lane2 = lane; asm volatile("" : "+v"(lane2));
        LAS float* OWN = wl + 512 + (lane2 >> 5) * 32 + (lane2 & 31); LAS float* P3 = OWN + 256; LAS float* VAL = OWN + 512;
#pragma unroll
        for (int pp = 0; pp < 4; ++pp) { const int tk = 2 * pp + hh, j = r31, cur = (t0 + tk) >> 6;
            const float impv = OWN[pp * 64] + (j > 0 ? P3[pp * 64 - (j > 0 ? 1 : 0)] : 0.f);
            VAL[pp * 64] = (j == 0 || j == cur || j == cur - 1) ? 1e4f : (j <= cur ? impv : -1e30f); }
        LDS_WAIT(); asm volatile("" ::: "memory");
#pragma unroll
        for (int pp = 0; pp < 4; ++pp) { const int tk = 2 * pp + hh, j = r31, cur = (t0 + tk) >> 6; const float v = VAL[pp * 64]; int cnt = 0; const LAS float* vrow = VAL + pp * 64 - j;
#pragma unroll
            for (int j2 = 0; j2 < 32; ++j2) { const float o = vrow[j2]; cnt += (o > v || (o == v && j2 < j)) ? 1 : 0; }
            const unsigned long long bm = __ballot(cnt < 8 && j <= cur);
            const unsigned mym = hh ? (unsigned)(bm >> 32) : (unsigned)bm;
            if (j == 0) SELM[tk] = mym; }
        LDS_WAIT(); asm volatile("" ::: "memory");
        const unsigned selm = SELM[tok8];
        unsigned um = 0u;
#pragma unroll
        for (int i = 0; i < 8; ++i) um |= SELM[i];
        um = (unsigned)__builtin_amdgcn_readfirstlane((int)um);
        const int kthi = (t0 + 7) >> 5;
        const unsigned long long causal = (kthi >= 63) ? ~0ull : ((1ull << (kthi + 1)) - 1ull);
        {
            unsigned long long x = um;
            x = (x | (x << 16)) & 0x0000FFFF0000FFFFull; x = (x | (x << 8)) & 0x00FF00FF00FF00FFull; x = (x | (x << 4)) & 0x0F0F0F0F0F0F0F0Full;
            x = (x | (x << 2)) & 0x3333333333333333ull; x = (x | (x << 1)) & 0x5555555555555555ull;
            const unsigned long long tm = (x | (x << 1)) & causal;
            attn_branch((const f16*)(ws + WS_KN) + (size_t)bg * SEQ * 64, (const f16*)(ws + WS_VT) + (size_t)bg * 64 * SEQ, tm, bq, t0, t, r31, hh, 1 << 30, selm, cfar, lutr, g_s, TL);
        }
        {
            const int lo = t0 - 511 > 0 ? (t0 - 511) >> 5 : 0;
            const unsigned long long tm = causal & ~((1ull << lo) - 1ull);
            attn_branch((const f16*)(ws + WS_KN) + (size_t)(BATCH * 4 + bg) * SEQ * 64, (const f16*)(ws + WS_VT) + (size_t)(BATCH * 4 + bg) * 64 * SEQ, tm, bq, t0, t, r31, hh, 512, 0xFFFFFFFFu, cfar, lutr, g_w, TL);
        }
        f16* orow = CAT + m * D + 1024 + head * 64 + 4 * hh;
#pragma unroll
        for (int jj = 0; jj < 4; ++jj) {
            u32x2 o0; o0.x = pk_f16(TL[(4 * jj) * 64], TL[(4 * jj + 1) * 64]); o0.y = pk_f16(TL[(4 * jj + 2) * 64], TL[(4 * jj + 3) * 64]); *(GAS u32x2*)(orow + 8 * jj) = o0;
            u32x2 o1; o1.x = pk_f16(TL[(16 + 4 * jj) * 64], TL[(16 + 4 * jj + 1) * 64]); o1.y = pk_f16(TL[(16 + 4 * jj + 2) * 64], TL[(16 + 4 * jj + 3) * 64]); *(GAS u32x2*)(orow + 32 + 8 * jj) = o1; }
    }
}

__device__ __forceinline__ void cvt_row_fp6(const f32x4 (&v)[8], int row, unsigned char* dst6, float* scales, int lane) {
    float amax = 0.f;
#pragma unroll
    for (int c = 0; c < 8; ++c) amax = fmaxf(amax, fmaxf(fmaxf(fabsf(v[c].x), fabsf(v[c].y)), fmaxf(fabsf(v[c].z), fabsf(v[c].w))));
    amax = wave_max(amax);
    const float scale = amax > 0.f ? amax * (1.f / 7.5f) : 1.f, inv = 1.f / scale;
    f16x32 h;
#pragma unroll
    for (int c = 0; c < 8; ++c) { h[4 * c] = (f16)(v[c].x * inv); h[4 * c + 1] = (f16)(v[c].y * inv); h[4 * c + 2] = (f16)(v[c].z * inv); h[4 * c + 3] = (f16)(v[c].w * inv); }
    const u32x6 pk = __builtin_amdgcn_cvt_scalef32_pk32_fp6_f16(h, 1.0f);
    unsigned char* d = dst6 + (size_t)(lane >> 3) * SLICE6;
    *(GAS u32x4*)(d + (size_t)row * 128 + (lane & 7) * 16) = (u32x4){pk[0], pk[1], pk[2], pk[3]}; *(GAS u32x2*)(d + 2097152 + (size_t)row * 64 + (lane & 7) * 8) = (u32x2){pk[4], pk[5]};
    if (lane == 0) scales[row] = scale;
}
__device__ __forceinline__ void cvt_table_fp6(Frame& F, const float* src, unsigned char* dst6, float* scales, const float* colw) {
    const int gw = F.vcu * NWAVES + F.wave, NGW = F.G * NWAVES, lane = F.lane;
    int row = gw;
    for (; row + NGW < 16384; row += 2 * NGW) {
        f32x4 va[8], vb[8];
#pragma unroll
        for (int c = 0; c < 8; ++c) { va[c] = __builtin_nontemporal_load((const GAS f32x4*)(src + (size_t)row * D + c * 256 + lane * 4)); vb[c] = __builtin_nontemporal_load((const GAS f32x4*)(src + (size_t)(row + NGW) * D + c * 256 + lane * 4)); }
        if (colw) {
#pragma unroll
            for (int c = 0; c < 8; ++c) { const f32x4 wv = *(const GAS f32x4*)(colw + c * 256 + lane * 4); va[c] = va[c] * wv; vb[c] = vb[c] * wv; } }
        cvt_row_fp6(va, row, dst6, scales, lane); cvt_row_fp6(vb, row + NGW, dst6, scales, lane);
    }
    for (; row < 16384; row += NGW) { f32x4 va[8];
#pragma unroll
        for (int c = 0; c < 8; ++c) { va[c] = *(const GAS f32x4*)(src + (size_t)row * D + c * 256 + lane * 4); if (colw) va[c] = va[c] * *(const GAS f32x4*)(colw + c * 256 + lane * 4); }
        cvt_row_fp6(va, row, dst6, scales, lane); }
}
__device__ __forceinline__ void p7_tables(Frame& F) {
    cvt_table_fp6(F, F.in[I_PU], F.ws + WS_U6, (float*)(F.ws + WS_SU), F.in[I_FFNNW]);
    cvt_table_fp6(F, F.in[I_PV], F.ws + WS_V6, (float*)(F.ws + WS_SV), nullptr);
}

__device__ __forceinline__ void bitonic_sort16_desc(float (&a)[16]) {
#pragma unroll
    for (int k = 2; k <= 16; k <<= 1)
#pragma unroll
        for (int j = k >> 1; j > 0; j >>= 1)
#pragma unroll
            for (int i = 0; i < 16; ++i) { const int l = i ^ j; if (l > i) { const float hi = fmaxf(a[i], a[l]), lo = fminf(a[i], a[l]); if ((i & k) == 0) { a[i] = hi; a[l] = lo; } else { a[i] = lo; a[l] = hi; } } }
}
__device__ __forceinline__ void bitonic_merge16_desc(float (&a)[16]) {
#pragma unroll
    for (int dist = 8; dist >= 1; dist >>= 1)
#pragma unroll
        for (int i = 0; i < 16; ++i) if ((i & dist) == 0) { const float hi = fmaxf(a[i], a[i + dist]), lo = fminf(a[i], a[i + dist]); a[i] = hi; a[i + dist] = lo; }
}
#define INS16(top, v) do { _Pragma("unroll") for (int _j = 0; _j < 16; ++_j) { const float _h = fmaxf(top[_j], v); v = fminf(top[_j], v); top[_j] = _h; } } while (0)
#define INS16P(tv, ti, v, i) do { _Pragma("unroll") for (int _j = 0; _j < 16; ++_j) { const bool _c = v > tv[_j]; const float _nv = _c ? tv[_j] : v; const unsigned _ni = _c ? ti[_j] : i; \
        tv[_j] = _c ? v : tv[_j]; ti[_j] = _c ? i : ti[_j]; v = _nv; i = _ni; } } while (0)
typedef unsigned v4u_t __attribute__((__vector_size__(16)));
typedef unsigned v2u_t __attribute__((__vector_size__(8)));
__device__ __forceinline__ void p9a_topk(Frame& F) {
    unsigned char* ws = F.ws;
    const f16* QP = (const f16*)(ws + WS_QP); const f16* KEYS = (const f16*)(ws + WS_KEYS);
    unsigned* LIDX = (unsigned*)(ws + WS_LIDX); float* LG = (float*)(ws + WS_LG);
    const int lane = F.lane, r31 = lane & 31, hh = lane >> 5;
    const float NINF = -__builtin_inff();
    for (int unit = F.vcu; unit < M / 32; unit += F.G) {
        const int m0 = unit * 32;
        {
            const int h = F.wave;
            float sl[2][16];
#pragma unroll
            for (int p = 0; p < 2; ++p) {
                f16x8 bq[8];
#pragma unroll
                for (int ks = 0; ks < 8; ++ks) bq[ks] = *(const GAS f16x8*)(QP + (size_t)(m0 + r31) * D + (h * 2 + p) * 128 + ks * 16 + hh * 8);
                float top[16];
#pragma unroll
                for (int j = 0; j < 16; ++j) top[j] = NINF;
#pragma unroll 1
                for (int kt = 0; kt < 4; ++kt) {
                    f32x16 c;
#pragma unroll
                    for (int i = 0; i < 16; ++i) c[i] = 0.f;
                    const f16* kp = KEYS + ((size_t)((h * 2 + p) * 128 + kt * 32 + r31)) * 128 + hh * 8;
#pragma unroll
                    for (int ks = 0; ks < 8; ++ks) { const f16x8 a = *(const GAS f16x8*)(kp + ks * 16); c = __builtin_amdgcn_mfma_f32_32x32x16_f16(a, bq[ks], c, 0, 0, 0); }
                    const unsigned k4 = (unsigned)(kt * 32 + 4 * hh);
                    float nv[16];
#pragma unroll
                    for (int reg = 0; reg < 16; ++reg) { const unsigned key = k4 + (unsigned)((reg & 3) + 8 * (reg >> 2)); nv[reg] = __uint_as_float((__float_as_uint(c[reg]) & ~127u) | key); }
                    bitonic_sort16_desc(nv);
#pragma unroll
                    for (int j = 0; j < 16; ++j) top[j] = fmaxf(top[j], nv[15 - j]);
                    bitonic_merge16_desc(top);
                }
                float cm[16];
#pragma unroll
                for (int j = 0; j < 16; ++j) cm[j] = fmaxf(top[j], __uint_as_float(other32u(__float_as_uint(top[15 - j]), hh != 0)));
#pragma unroll
                for (int dist = 8; dist >= 1; dist >>= 1)
#pragma unroll
                    for (int i = 0; i < 16; ++i) if ((i & dist) == 0) { const float hi = fmaxf(cm[i], cm[i + dist]), lo = fminf(cm[i], cm[i + dist]); cm[i] = hi; cm[i + dist] = lo; }
#pragma unroll
                for (int j = 0; j < 16; ++j) sl[p][j] = cm[j];
            }
            float vx[16], vy[16]; unsigned ix[16], iy[16];
#pragma unroll
            for (int j = 0; j < 16; ++j) { const unsigned bx = __float_as_uint(hh ? sl[1][j] : sl[0][j]), by = __float_as_uint(hh ? sl[0][j] : sl[1][j]);
                vx[j] = __uint_as_float(bx & ~127u); vy[j] = __uint_as_float(by & ~127u); ix[j] = (bx & 127u) * (hh ? 1u : 128u); iy[j] = (by & 127u) * (hh ? 128u : 1u); }
            float tv[16]; unsigned ti[16];
#pragma unroll
            for (int j = 0; j < 16; ++j) { const int jb = j + 1 < 16 ? j + 1 : 15;
                const float v0 = vx[0] + vy[j], v1 = (j < 15) ? vx[0] + vy[jb] : NINF; const unsigned i0 = ix[0] + iy[j], i1 = ix[0] + iy[jb];
                tv[j] = hh ? v1 : v0; ti[j] = hh ? i1 : i0; }
#pragma unroll
            for (int a = 1; a < 4; ++a) { const int bmax = (a == 1) ? 7 : (a == 2 ? 4 : 3);
#pragma unroll
                for (int b = a; b <= bmax; ++b) { float v = vx[a] + vy[b]; if (a == b) v = hh ? NINF : v; unsigned i = ix[a] + iy[b]; INS16P(tv, ti, v, i); } }
            float mv[16]; unsigned mi[16];
#pragma unroll
            for (int j = 0; j < 16; ++j) { const float pv = __uint_as_float(other32u(__float_as_uint(tv[15 - j]), hh != 0)); const unsigned pi = other32u(ti[15 - j], hh != 0); const bool c = pv > tv[j]; mv[j] = c ? pv : tv[j]; mi[j] = c ? pi : ti[j]; }
            float mx = mv[0];
#pragma unroll
            for (int j = 1; j < 16; ++j) mx = fmaxf(mx, mv[j]);
            float sum = 0.f;
#pragma unroll
            for (int j = 0; j < 16; ++j) { mv[j] = __builtin_amdgcn_exp2f((mv[j] - mx) * LOG2E); sum += mv[j]; }
            const float inv = 1.f / sum;
#pragma unroll
            for (int j = 0; j < 8; ++j) { { const int e_ = h * 16 + hh * 8 + j, pos_ = (e_ & 63) * 2 + (e_ >> 6); LIDX[(size_t)(m0 + r31) * 128 + pos_] = mi[j]; LG[(size_t)(m0 + r31) * 128 + pos_] = mv[j] * inv; } }
        }
    }
}
struct Seg6 { v4u_t a; v2u_t b; };
__device__ __forceinline__ f16x32 seg6_decode(const Seg6& r) { const u32x6 p = {r.a[0], r.a[1], r.a[2], r.a[3], r.b[0], r.b[1]}; return __builtin_amdgcn_cvt_scalef32_pk32_f16_fp6(p, 1.0f); }
__device__ __forceinline__ f16x32 seg6_dec2(const v4u_t& a, const v2u_t& b) { const u32x6 p = {a[0], a[1], a[2], a[3], b[0], b[1]}; return __builtin_amdgcn_cvt_scalef32_pk32_f16_fp6(p, 1.0f); }
#define SEG_DECL(P) v4u_t P##a0, P##a1, P##a2, P##a3, P##a4, P##a5, P##a6, P##a7; v2u_t P##b0, P##b1, P##b2, P##b3, P##b4, P##b5, P##b6, P##b7
#define SEG_L1(P, G, idxv) do { const int e_ = __shfl(idxv, 8 * G + sub); P##a##G = __builtin_amdgcn_raw_buffer_load_b128(rs, e_ * 128 + ch * 16, 0, 0); P##b##G = __builtin_amdgcn_raw_buffer_load_b64(rs, 2097152 + e_ * 64 + ch * 8, 0, 0); } while (0)
#define SEG_LOAD(P, idxv) do { SEG_L1(P, 0, idxv); SEG_L1(P, 1, idxv); SEG_L1(P, 2, idxv); SEG_L1(P, 3, idxv); SEG_L1(P, 4, idxv); SEG_L1(P, 5, idxv); SEG_L1(P, 6, idxv); SEG_L1(P, 7, idxv); } while (0)
__device__ __forceinline__ float u_one(const v4u_t& a, const v2u_t& b, const f16x2 (&xp)[16]) {
    const f16x32 hv = seg6_dec2(a, b); float sdot = 0.f;
#pragma unroll
    for (int k = 0; k < 16; ++k) { f16x2 hp; hp.x = hv[2 * k]; hp.y = hv[2 * k + 1]; sdot = __builtin_amdgcn_fdot2(hp, xp[k], sdot, false); }
    return sum8(sdot);
}
#define SEG_LE(P, G, ev) do { const int e_ = (ev); P##a##G = __builtin_amdgcn_raw_buffer_load_b128(rs, e_ * 128 + ch * 16, 0, 0); P##b##G = __builtin_amdgcn_raw_buffer_load_b64(rs, 2097152 + e_ * 64 + ch * 8, 0, 0); } while (0)
#define EN_GATHER(en, iA, iB) do { _Pragma("unroll") for (int g_ = 0; g_ < 8; ++g_) { en[g_] = __shfl(iA, 8 * g_ + sub); en[8 + g_] = __shfl(iB, 8 * g_ + sub); } } while (0)
#define U_ROLL1(P, G, res, eo) do { const float d_ = u_one(P##a##G, P##b##G, xp); res = (ch == G) ? d_ : res; SEG_LE(P, G, en[(eo) + G]); } while (0)
#define U_ROLL(P, res, idxn) do { U_ROLL1(P, 0, res, idxn); U_ROLL1(P, 1, res, idxn); U_ROLL1(P, 2, res, idxn); U_ROLL1(P, 3, res, idxn); U_ROLL1(P, 4, res, idxn); U_ROLL1(P, 5, res, idxn); U_ROLL1(P, 6, res, idxn); U_ROLL1(P, 7, res, idxn); } while (0)
#define V_ROLL1(P, G, hwv, eo) do { v_one(P##a##G, P##b##G, acc, hq[(eo) + G]); SEG_LE(P, G, en[(eo) + G]); } while (0)
#define V_ROLL(P, hwv, idxn) do { V_ROLL1(P, 0, hwv, idxn); V_ROLL1(P, 1, hwv, idxn); V_ROLL1(P, 2, hwv, idxn); V_ROLL1(P, 3, hwv, idxn); V_ROLL1(P, 4, hwv, idxn); V_ROLL1(P, 5, hwv, idxn); V_ROLL1(P, 6, hwv, idxn); V_ROLL1(P, 7, hwv, idxn); } while (0)
#define FMIXV_LO(a, h, w) asm("v_fma_mix_f32 %0, %1, %2, %0 op_sel_hi:[1,0,0]" : "+v"(a) : "v"(h), "v"(w))
#define FMIXV_HI(a, h, w) asm("v_fma_mix_f32 %0, %1, %2, %0 op_sel:[1,0,0] op_sel_hi:[1,0,0]" : "+v"(a) : "v"(h), "v"(w))
__device__ __forceinline__ void v_one(const v4u_t& a, const v2u_t& b, f16x2 (&acc)[16], f16x2 wq) {
    const f16x32 hv = seg6_dec2(a, b);
#pragma unroll
    for (int k = 0; k < 16; ++k) { f16x2 hp; hp.x = hv[2 * k]; hp.y = hv[2 * k + 1]; acc[k] = __builtin_elementwise_fma(hp, wq, acc[k]); }
}
#define V_HALF(P, hwv) do { v_one(P##a0, P##b0, acc, hwv, sub); v_one(P##a1, P##b1, acc, hwv, 8 + sub); v_one(P##a2, P##b2, acc, hwv, 16 + sub); v_one(P##a3, P##b3, acc, hwv, 24 + sub); \
        v_one(P##a4, P##b4, acc, hwv, 32 + sub); v_one(P##a5, P##b5, acc, hwv, 40 + sub); v_one(P##a6, P##b6, acc, hwv, 48 + sub); v_one(P##a7, P##b7, acc, hwv, 56 + sub); } while (0)
__device__ __forceinline__ void p9b_upass(Frame& F, bool probe_slice0) {
    unsigned char* ws = F.ws;
    const int x = blockIdx.x & 7, rank = blockIdx.x >> 3, cnt = (F.G - x + 7) >> 3;
    const int lane = F.lane, sub = lane >> 3, ch = lane & 7;
    const __amdgpu_buffer_rsrc_t rs = __builtin_amdgcn_make_buffer_rsrc((void*)(ws + WS_U6 + (size_t)(probe_slice0 ? 0 : x) * SLICE6), 0, (int)SLICE6, 0x00020000);
    const f16* XN = (const f16*)(ws + WS_XR) + x * 32 + (lane >> 3) * 256 + (lane & 7) * 4;
    const u32x2* LI2 = (const u32x2*)(ws + WS_LIDX); LAS unsigned char* xl = F.lds + F.wave * 512;
    const int tstep = cnt * NWAVES; int t = rank * NWAVES + F.wave;
    if (t >= M) return;
    int cA, cB, nA, nB; { const u32x2 c2 = LI2[(size_t)t * 64 + lane]; cA = (int)c2.x; cB = (int)c2.y; }
    const int t1c = (t + tstep < M) ? t + tstep : t;
    { const u32x2 n2 = LI2[(size_t)t1c * 64 + lane]; nA = (int)n2.x; nB = (int)n2.y; }
    u32x2 xcur = *(const GAS u32x2*)(XN + (size_t)t * D);
    f16x2 xp[16];
    SEG_DECL(bA); SEG_DECL(bB);
    { const int li_ = cA; SEG_LOAD(bA, li_); } { const int li_ = cB; SEG_LOAD(bB, li_); }
#pragma unroll 1
    for (;;) {
        const int tn = t + tstep, tnn = tn + tstep; const bool hn = tn < M, hnn = tnn < M;
        const int tnc = hn ? tn : t, tnnc = hnn ? tnn : t;
        const u32x2 m2 = LI2[(size_t)tnnc * 64 + lane]; const int mA = (int)m2.x, mB = (int)m2.y;
        const u32x2 xnext = *(const GAS u32x2*)(XN + (size_t)tnc * D);
        *(LAS u32x2*)(xl + ((lane & 7) * 8 + (lane >> 3)) * 8) = xcur;
        LDS_WAIT(); asm volatile("" ::: "memory");
#pragma unroll
        for (int q = 0; q < 4; ++q) { const u32x4 tv = *(const LAS u32x4*)(xl + ch * 64 + q * 16); xp[4 * q] = ash2(tv.x); xp[4 * q + 1] = ash2(tv.y); xp[4 * q + 2] = ash2(tv.z); xp[4 * q + 3] = ash2(tv.w); }
        LDS_WAIT(); asm volatile("" ::: "memory");
        { const int lA_ = hn ? nA : cA, lB_ = hn ? nB : cB; int en[16]; EN_GATHER(en, lA_, lB_);
          float rA = 0.f, rB = 0.f; U_ROLL(bA, rA, 0); U_ROLL(bB, rB, 8);
          float* pd = (float*)(ws + WS_PD) + ((size_t)t * 8 + x) * 128 + 8 * ch + sub; pd[0] = rA; pd[64] = rB; }
        if (!hn) break;
        xcur = xnext;
        cA = nA; cB = nB; nA = mA; nB = mB; t = tn;
    }
}
__device__ __forceinline__ void p9h_weights(Frame& F) {
    unsigned char* ws = F.ws;
    const unsigned* LIDX = (const unsigned*)(ws + WS_LIDX); const float* LG = (const float*)(ws + WS_LG); const float* PD = (const float*)(ws + WS_PD);
    const float* SU = (const float*)(ws + WS_SU); const float* SV = (const float*)(ws + WS_SV); float* HW = (float*)(ws + WS_HW);
    const int gw = F.vcu * NWAVES + F.wave, NGW = F.G * NWAVES, lane = F.lane;
#pragma unroll 1
    for (int t0 = gw; t0 < M; t0 += 2 * NGW) {
        const int t1 = t0 + NGW < M ? t0 + NGW : t0;
        int iA[2], iB[2]; float pa[2][8], pb[2][8], lgA[2], lgB[2], s1[2];
#pragma unroll
        for (int q = 0; q < 2; ++q) { const int t = q ? t1 : t0; { const u32x2 i2 = ((const u32x2*)LIDX)[(size_t)t * 64 + lane]; iA[q] = (int)i2.x; iB[q] = (int)i2.y; }
#pragma unroll
            for (int xs = 0; xs < 8; ++xs) { pa[q][xs] = PD[((size_t)t * 8 + xs) * 128 + lane]; pb[q][xs] = PD[((size_t)t * 8 + xs) * 128 + 64 + lane]; }
            { const f32x2 g2 = ((const f32x2*)LG)[(size_t)t * 64 + lane]; lgA[q] = g2.x; lgB[q] = g2.y; } s1[q] = ((const float*)(ws + WS_SS1))[t]; }
#pragma unroll
        for (int q = 0; q < 2; ++q) { const int t = q ? t1 : t0; float zA = 0.f, zB = 0.f;
#pragma unroll
            for (int xs = 0; xs < 8; ++xs) { zA += pa[q][xs]; zB += pb[q][xs]; }
            const float rs1 = 1.f / sqrtf(s1[q] * (1.f / D) + RMS_EPS);
            ((f32x2*)HW)[(size_t)t * 64 + lane] = (f32x2){pg8::gelu1(zA * rs1 * SU[iA[q]]) * lgA[q] * SV[iA[q]], pg8::gelu1(zB * rs1 * SU[iB[q]]) * lgB[q] * SV[iB[q]]}; }
    }
}
__device__ __forceinline__ void p9c_vpass(Frame& F) {
    unsigned char* ws = F.ws;
    const int x = blockIdx.x & 7, rank = blockIdx.x >> 3, cnt = (F.G - x + 7) >> 3;
    const int lane = F.lane, sub = lane >> 3, ch = lane & 7;
    const __amdgpu_buffer_rsrc_t rs = __builtin_amdgcn_make_buffer_rsrc((void*)(ws + WS_V6 + (size_t)x * SLICE6), 0, (int)SLICE6, 0x00020000);
    const u32x2* LI2 = (const u32x2*)(ws + WS_LIDX);
    f16* XR = (f16*)(ws + WS_XR); float* SS2 = (float*)(ws + WS_SS2);
    const bool b3 = (lane & 8) != 0, b4 = (lane & 16) != 0, b5 = (lane & 32) != 0;
    const int col = ((b3 ? 4 : 0) + (b4 ? 2 : 0) + (b5 ? 1 : 0)) * 256 + x * 32 + ch * 4;
    const int tstep = cnt * NWAVES; int t = rank * NWAVES + F.wave;
    if (t >= M) return;
    int cA, cB, nA, nB; { const u32x2 c2 = LI2[(size_t)t * 64 + lane]; cA = (int)c2.x; cB = (int)c2.y; }
    const int t1c = (t + tstep < M) ? t + tstep : t;
    { const u32x2 n2 = LI2[(size_t)t1c * 64 + lane]; nA = (int)n2.x; nB = (int)n2.y; }
    const f32x2* HW2 = (const f32x2*)(ws + WS_HW);
    float hwA, hwB; { const f32x2 h2 = HW2[(size_t)t * 64 + lane]; hwA = h2.x; hwB = h2.y; }
    SEG_DECL(bA); SEG_DECL(bB);
    { const int li_ = cA; SEG_LOAD(bA, li_); } { const int li_ = cB; SEG_LOAD(bB, li_); }
#pragma unroll 1
    for (;;) {
        const int tn = t + tstep, tnn = tn + tstep; const bool hn = tn < M, hnn = tnn < M;
        const int tnc = hn ? tn : t, tnnc = hnn ? tnn : t;
        const u32x2 m2 = LI2[(size_t)tnnc * 64 + lane]; const int mA = (int)m2.x, mB = (int)m2.y;
        const f32x2 hn2 = HW2[(size_t)tnc * 64 + lane]; const float hwAn = hn2.x, hwBn = hn2.y;
        f16* orow = XR + (size_t)t * D + col; const u32x2 x1r = *(const GAS u32x2*)orow;
        f16x2 acc[16];
#pragma unroll
        for (int i = 0; i < 16; ++i) { acc[i].x = (f16)0.f; acc[i].y = (f16)0.f; }
        { const int lA_ = hn ? nA : cA, lB_ = hn ? nB : cB; int en[16]; EN_GATHER(en, lA_, lB_); f16x2 hq[16];
#pragma unroll
          for (int g_ = 0; g_ < 8; ++g_) { const float qa = __shfl(hwA, 8 * g_ + sub) * 64.f, qb = __shfl(hwB, 8 * g_ + sub) * 64.f;
              hq[g_].x = (f16)qa; hq[g_].y = (f16)qa; hq[8 + g_].x = (f16)qb; hq[8 + g_].y = (f16)qb; }
          V_ROLL(bA, hwA, 0); V_ROLL(bB, hwB, 8); }
        f16x2 q8[8];
#pragma unroll
        for (int i = 0; i < 8; ++i) { const f16x2 keep = b3 ? acc[8 + i] : acc[i], send = b3 ? acc[i] : acc[8 + i]; q8[i] = keep + ash2(other8u(__builtin_bit_cast(unsigned, send))); }
        f16x2 q4[4];
#pragma unroll
        for (int i = 0; i < 4; ++i) { const f16x2 keep = b4 ? q8[4 + i] : q8[i], send = b4 ? q8[i] : q8[4 + i]; q4[i] = keep + ash2(other16u(__builtin_bit_cast(unsigned, send), b4)); }
        float r4[4];
        { const f16x2 k0 = b5 ? q4[2] : q4[0], k1 = b5 ? q4[3] : q4[1], s0 = b5 ? q4[0] : q4[2], s1 = b5 ? q4[1] : q4[3];
          const f16x2 p0 = ash2(other32u(__builtin_bit_cast(unsigned, s0), b5)), p1 = ash2(other32u(__builtin_bit_cast(unsigned, s1), b5));
          r4[0] = ((float)k0.x + (float)p0.x) * (1.f / 64.f); r4[1] = ((float)k0.y + (float)p0.y) * (1.f / 64.f); r4[2] = ((float)k1.x + (float)p1.x) * (1.f / 64.f); r4[3] = ((float)k1.y + (float)p1.y) * (1.f / 64.f); }
        const f16x2 x1a = ash2(x1r.x), x1b = ash2(x1r.y);
        const f32x4 x2 = {(float)x1a.x + r4[0], (float)x1a.y + r4[1], (float)x1b.x + r4[2], (float)x1b.y + r4[3]};
        { u32x2 o2; o2.x = pk_f16(x2.x, x2.y); o2.y = pk_f16(x2.z, x2.w); *(GAS u32x2*)orow = o2; }
        const float ss = wave_sum((x2.x * x2.x + x2.y * x2.y) + (x2.z * x2.z + x2.w * x2.w));
        if (lane == 0) atomicAdd(SS2 + t, ss);
        if (!hn) break;
        cA = nA; cB = nB; nA = mA; nB = mB; t = tn; hwA = hwAn; hwB = hwBn;
    }
}
#undef FMIXV_LO
#undef FMIXV_HI

constexpr int NPH = 13;
struct Args { const float* in[26]; float* out; unsigned char* ws; int ph_lo, ph_hi; int rep[16]; };
__global__ void __launch_bounds__(NWAVES * 64, 2) fwd_kernel(Args args) {
    extern __shared__ __attribute__((aligned(16))) unsigned char lds[];
    Frame F;
    F.lds = (LAS unsigned char*)lds;
    F.MISC = (volatile LAS unsigned*)(F.lds + MISC_OFF);
    F.tid = threadIdx.x; F.lane = F.tid & 63; F.wave = __builtin_amdgcn_readfirstlane(F.tid >> 6);
    F.G = gridDim.x; { const int bx = blockIdx.x; F.vcu = (F.G % 8 == 0) ? (bx % 8) * (F.G / 8) + bx / 8 : bx; }
#pragma unroll
    for (int i = 0; i < 26; ++i) F.in[i] = args.in[i];
    F.out = args.out; F.ws = args.ws;
    unsigned char* ws = args.ws;
    gu32* ctl = (gu32*)(ws + WS_CTL);
    for (int u = F.tid; u < (LDS_BYTES - LDSCTL_OFF) / 4; u += NWAVES * 64) ((LAS unsigned*)(F.lds + LDSCTL_OFF))[u] = 0u;
    __syncthreads();
    XcdBarrier bar; bar.bar = (unsigned*)(ctl + CW_BAR); bar.x = 0; bar.st = nullptr;
    if (MK_ONE_LAUNCH) bar = xcd_barrier_post((unsigned*)(ctl + CW_BAR), F.MISC + 8);
#define GRID_BAR() do { if (MK_ONE_LAUNCH) xcd_barrier(bar); } while (0)
    const int lo = args.ph_lo, hi = args.ph_hi;
#define IN(k) (lo <= (k) && (k) < hi)
#define BOTH(k) (IN(k) && IN((k) + 1))

    if (IN(0)) { for (int rp = 0; rp < args.rep[0]; ++rp) p0_prologue(F); if (BOTH(0)) GRID_BAR(); }

    if (IN(1)) {
        pg8::Gemm g{(const f16*)(ws + WS_XR), (const f16*)(ws + WS_WIN), M, NINP, D, D, D, 0, 1 << 30, 0};
        pg8::StaticOrder S; S.init(M, NINP, F.G, (int)blockIdx.x);
        pg8::EpiF16Row E{(f16*)(ws + WS_Y), NINP, (const float*)(ws + WS_SS0)};
        pg8::gemm_phase(F.lds, g, S, E);
        if (BOTH(1)) GRID_BAR();
    }

    if (IN(2)) { for (int rp = 0; rp < PROBE_REP2; ++rp) p2_post(F); if (BOTH(2)) GRID_BAR(); }

    if (IN(3)) {
        { pg8::Gemm g{(const f16*)(ws + WS_FLATA), (const f16*)(ws + WS_W1C), 8192, 1024, 512, D, D, 512, 16, (size_t)256 * D * 2, 512};
          pg8::StaticOrder S; S.init(8192, 1024, F.G, (int)blockIdx.x);
          pg8::EpiRawF32 E{(float*)(ws + WS_Y), 1024};
          pg8::gemm_phase(F.lds, g, S, E); }
        { pg8::Gemm g{(const f16*)(ws + WS_MIXED), (const f16*)(ws + WS_POOLT), M, 1024, 256, 1024, 256, 256, 1 << 30, 0};
          pg8::StaticOrder S; S.init(M, 1024, F.G, (int)((blockIdx.x + 128) % F.G));
          pg8::EpiF16<0> E{(f16*)(ws + WS_CAT), D, nullptr, 1 << 30, 0};
          pg8::gemm_phase(F.lds, g, S, E); }
        if (BOTH(3)) GRID_BAR();
    }

    if (IN(4)) { p4_compress2(F); if (PROBE_DUP4) p4_compress2(F); if (BOTH(4)) GRID_BAR(); }

    if (IN(5)) { for (int rp = 0; rp < args.rep[5]; ++rp) p5_attention(F); if (BOTH(5)) GRID_BAR(); }

    if (IN(6)) {
        pg8::Gemm g{(const f16*)(ws + WS_CAT), (const f16*)(ws + WS_WOUT), M, D, D, D, D, 0, 1 << 30, 0};
        pg8::StaticOrder S; S.init(M, D, F.G, (int)blockIdx.x);
        pg8::EpiRes16 E{(f16*)(ws + WS_XR), (float*)(ws + WS_SS1)};
        pg8::gemm_phase(F.lds, g, S, E);
        if (BOTH(6)) GRID_BAR();
    }

    if (IN(7)) {
        { pg8::Gemm g{(const f16*)(ws + WS_XR), (const f16*)(ws + WS_WQ), M, D, D, D, D, 0, 1 << 30, 0};
          pg8::StaticOrder S; S.init(M, D, F.G, (int)blockIdx.x);
          pg8::EpiF16Row E{(f16*)(ws + WS_QP), D, (const float*)(ws + WS_SS1)};
          pg8::gemm_phase(F.lds, g, S, E); }
        { pg8::Gemm g{(const f16*)(ws + WS_P16), (const f16*)(ws + WS_WPJ), M, D, 256, 256, 256, 0, 1 << 30, 0};
          pg8::StaticOrder S; S.init(M, D, F.G, (int)blockIdx.x);
          pg8::EpiF16<0> E{(f16*)(ws + WS_PJ), D, nullptr, 1 << 30, 0};
          pg8::gemm_phase(F.lds, g, S, E); }
        for (int rp = 0; rp < args.rep[7]; ++rp) p7_tables(F);
        if (BOTH(7)) GRID_BAR();
    }

    if (IN(8)) { p9a_topk(F); if (BOTH(8)) GRID_BAR(); }
    if (IN(9)) { if (PROBE_DUPU) p9b_upass(F, false); p9b_upass(F, false); if (BOTH(9)) GRID_BAR(); }
    if (IN(10)) { p9h_weights(F); if (BOTH(10)) GRID_BAR(); }
    if (IN(11)) { p9c_vpass(F); if (BOTH(11)) GRID_BAR(); }

    if (IN(12)) {
        pg8::Gemm g{(const f16*)(ws + WS_XR), (const f16*)(ws + WS_WG), M, D, D, D, D, 0, 1 << 30, 0};
        pg8::StaticOrder S; S.init(M, D, F.G, (int)blockIdx.x);
        pg8::EpiFinal E{(const f16*)(ws + WS_XR), (const f16*)(ws + WS_PJ), F.out, (const float*)(ws + WS_SS2)};
        pg8::gemm_phase(F.lds, g, S, E);
    }
#undef IN
#undef BOTH
}

extern "C" void kernel_launch(void* const* d_in, const int* in_sizes, int n_in, void* d_out, int out_size, void* d_ws, size_t ws_size, hipStream_t stream) {
    static int grid = 0;
    if (grid == 0) {
        if (n_in != 26 || out_size != M * D || ws_size < WS_END) { fprintf(stderr, "kernel_launch: unexpected sizes n_in %d out %d ws %zu\n", n_in, out_size, ws_size); grid = -1; return; }
        int dev = 0, cus = 0, per_cu = 0;
        if (hipGetDevice(&dev) != hipSuccess || hipDeviceGetAttribute(&cus, hipDeviceAttributeMultiprocessorCount, dev) != hipSuccess) { grid = -1; return; }
        if (hipFuncSetAttribute((const void*)fwd_kernel, hipFuncAttributeMaxDynamicSharedMemorySize, LDS_BYTES) != hipSuccess) { fprintf(stderr, "kernel_launch: hipFuncSetAttribute failed\n"); grid = -1; return; }
        if (hipOccupancyMaxActiveBlocksPerMultiprocessor(&per_cu, (const void*)fwd_kernel, NWAVES * 64, LDS_BYTES) != hipSuccess || per_cu < 1)
            fprintf(stderr, "kernel_launch: occupancy query reports %d\n", per_cu);
        (void)hipGetLastError();
        grid = cus;
    }
    if (grid < 0) return;
    (void)hipMemsetAsync((char*)d_ws + WS_CTL, 0, CTL_ZERO_BYTES, stream);
    Args a{};
    for (int i = 0; i < 16; ++i) a.rep[i] = 1;
    a.rep[5] = PROBE_REP5; a.rep[0] = PROBE_REP0; a.rep[7] = PROBE_REP7;
    for (int i = 0; i < 26; ++i) a.in[i] = (const float*)d_in[i];
    a.out = (float*)d_out; a.ws = (unsigned char*)d_ws;
    if (MK_ONE_LAUNCH) { a.ph_lo = 0; a.ph_hi = NPH; hipLaunchKernelGGL(fwd_kernel, dim3(grid), dim3(NWAVES * 64), LDS_BYTES, stream, a); }
    else for (int p = 0; p < NPH; ++p) { a.ph_lo = p; a.ph_hi = p + 1; hipLaunchKernelGGL(fwd_kernel, dim3(grid), dim3(NWAVES * 64), LDS_BYTES, stream, a); }
}
```

```cpp
#include <hip/hip_runtime.h>
#include <cstdio>
#include <cstdint>

#define PROBE_REP0 1
#define PROBE_REP2 1
#define PROBE_DUPU 0
#define PROBE_REP5 1
#define PROBE_REP7 1
#define PROBE_REP9 1
#ifndef MK_ONE_LAUNCH
#define MK_ONE_LAUNCH 1
#endif

#define GAS __attribute__((address_space(1)))
#define LAS __attribute__((address_space(3)))
typedef _Float16 f16;
typedef _Float16 f16x8 __attribute__((ext_vector_type(8)));
typedef _Float16 f16x4 __attribute__((ext_vector_type(4)));
typedef _Float16 f16x2 __attribute__((ext_vector_type(2)));
typedef float f32x2 __attribute__((ext_vector_type(2)));
typedef float f32x4 __attribute__((ext_vector_type(4)));
typedef float f32x16 __attribute__((ext_vector_type(16)));
typedef unsigned u32x2 __attribute__((ext_vector_type(2)));
typedef unsigned u32x4 __attribute__((ext_vector_type(4)));
typedef GAS unsigned gu32;
typedef _Float16 f16x32 __attribute__((ext_vector_type(32)));
typedef unsigned u32x6 __attribute__((ext_vector_type(6)));
#define RLX_AGENT __ATOMIC_RELAXED, __HIP_MEMORY_SCOPE_AGENT
#define LDS_WAIT() asm volatile("s_waitcnt lgkmcnt(0)" ::: "memory")
#define VM_WAIT() asm volatile("s_waitcnt vmcnt(0)" ::: "memory")

constexpr int BATCH = 8, SEQ = 2048, D = 2048, M = BATCH * SEQ;
constexpr int NIN = 3632, NINP = 3840;
constexpr int OFF_U = 0, OFF_Q = 1024, OFF_KC = 2048, OFF_VC = 2304, OFF_KS = 2560, OFF_VS = 2816, OFF_KW = 3072, OFF_VW = 3328, OFF_G = 3584;
constexpr int NCMP = 127, NCROWS = BATCH * NCMP * 4;
constexpr float RMS_EPS = 1e-6f;
constexpr float LOG2E = 1.4426950408889634f;

constexpr size_t MiB = 1u << 20;
constexpr size_t WS_CTL = 0, CTL_ZERO_BYTES = 1 * MiB;
constexpr size_t WS_WIN = 2 * MiB, WS_WOUT = 17 * MiB, WS_WQ = 25 * MiB, WS_WG = 33 * MiB, WS_WPJ = 41 * MiB, WS_W1C = 42 * MiB, WS_POOLT = 44 * MiB, WS_KEYS = 45 * MiB;
constexpr size_t WS_CBIAS = 46 * MiB, WS_GATES = 47 * MiB, WS_HC = 50 * MiB, WS_KCMP = 54 * MiB, WS_VCMPT = 54 * MiB + 512 * 1024, WS_P16 = 56 * MiB;
constexpr size_t WS_XN = 64 * MiB;
constexpr size_t WS_Y = 128 * MiB, WS_QP = 128 * MiB, WS_PJ = 192 * MiB;
constexpr size_t WS_MIXED = 256 * MiB, WS_CAT = 288 * MiB, WS_KN = 352 * MiB, WS_VT = 368 * MiB, WS_FLATA = 384 * MiB;
constexpr size_t WS_U6 = 256 * MiB, WS_V6 = 288 * MiB, WS_SU = 320 * MiB, WS_SV = 321 * MiB;
constexpr size_t WS_LIDX = 322 * MiB, WS_LG = 330 * MiB, WS_SSP = 338 * MiB, WS_PD = 340 * MiB, WS_HW = 404 * MiB;
constexpr size_t SLICE6 = (size_t)16384 * 192;
constexpr size_t WS_XR = 416 * MiB;
constexpr size_t WS_SS0 = 768 * 1024, WS_SS1 = 256 * 1024, WS_SS2 = 512 * 1024;
constexpr size_t WS_QN = 480 * MiB;
constexpr size_t WS_END = 512 * MiB;
constexpr int CW_TMO = 0, CW_CODE = 1, CW_BAR = 4096;

constexpr int RING_BYTES = 131072;
constexpr int LDSCTL_OFF = RING_BYTES, MISC_OFF = LDSCTL_OFF + 320;
constexpr int LDS_BYTES = 147456;
constexpr int NWAVES = 8;

__device__ __forceinline__ unsigned pk_f16(float lo, float hi) { f16x2 v; v.x = (f16)lo; v.y = (f16)hi; return __builtin_bit_cast(unsigned, v); }
__device__ __forceinline__ f16x2 ash2(unsigned u) { return __builtin_bit_cast(f16x2, u); }
template <int CTRL> __device__ __forceinline__ float dpp_f(float v) { return __int_as_float(__builtin_amdgcn_update_dpp(0, __float_as_int(v), CTRL, 0xF, 0xF, true)); }
__device__ __forceinline__ float rl_f(float v, int l) { return __int_as_float(__builtin_amdgcn_readlane(__float_as_int(v), l)); }
__device__ __forceinline__ float sum8(float v) { v += dpp_f<0x141>(v); v += dpp_f<0xB1>(v); v += dpp_f<0x4E>(v); return v; }
__device__ __forceinline__ float wave_sum(float v) { v = sum8(v); v += dpp_f<0x140>(v); return (rl_f(v, 0) + rl_f(v, 16)) + (rl_f(v, 32) + rl_f(v, 48)); }
__device__ __forceinline__ float wave_max(float v) { v = fmaxf(v, dpp_f<0x141>(v)); v = fmaxf(v, dpp_f<0xB1>(v)); v = fmaxf(v, dpp_f<0x4E>(v)); v = fmaxf(v, dpp_f<0x140>(v));
    return fmaxf(fmaxf(rl_f(v, 0), rl_f(v, 16)), fmaxf(rl_f(v, 32), rl_f(v, 48))); }

__device__ __forceinline__ unsigned other8u(unsigned x) { return (unsigned)__builtin_amdgcn_update_dpp(0, (int)x, 0x128, 0xF, 0xF, true); }
__device__ __forceinline__ unsigned other16u(unsigned x, bool b4) { const auto r = __builtin_amdgcn_permlane16_swap(x, x, false, false); return b4 ? r[0] : r[1]; }
__device__ __forceinline__ unsigned other32u(unsigned x, bool b5) { const auto r = __builtin_amdgcn_permlane32_swap(x, x, false, false); return b5 ? r[0] : r[1]; }
namespace pg8 {
constexpr int BM = 256, BK = 64, HALF = 128, HTB = HALF * BK * 2, STAGE_BYTES = 8 * HTB, NXCD = 8, WGM = 8;
__host__ __device__ __forceinline__ int lds_byte(int r, int c) { const int st = (r >> 4) * 2 + (c >> 5), rr = r & 15, cc = c & 31, ob = rr * 64 + cc * 2; return st * 1024 + (ob ^ (((ob >> 9) & 1) << 5)); }
__host__ __device__ __forceinline__ void stage_rc(int b, int& R, int& C) { const int st = b / 1024, sb = b % 1024, swz = sb ^ (((sb >> 9) & 1) << 5); R = (st >> 1) * 16 + swz / 64; C = (st & 1) * 32 + (swz % 64) / 2; }
__host__ __device__ __forceinline__ int perm32(int rho) { const int n = rho >> 4, i = rho & 15; return 8 * (i >> 2) + 4 * n + (i & 3); }

struct Unit { int pm, pn; };
struct Gemm { const f16* A; const f16* Bt; int M, N, K, lda, ldb; int a_pn_off; int b_pm_split; size_t b_split_off; int b_pn_k = 0;
    __device__ __forceinline__ const char* aptr(const Unit& u) const { return (const char*)A + ((size_t)u.pm * BM * lda + (size_t)u.pn * a_pn_off) * 2; }
    __device__ __forceinline__ const char* bptr(const Unit& u) const { return (const char*)Bt + (b_pn_k ? (size_t)u.pn * b_pn_k * 2 : (size_t)u.pn * BM * ldb * 2) + (u.pm >= b_pm_split ? b_split_off : (size_t)0); }
};
struct StaticOrder {
    int nM, nN, nwg, G, c;
    __host__ __device__ void init(int M_, int N_, int G_, int c_) { nM = M_ / BM; nN = N_ / BM; nwg = nM * nN; G = G_; c = c_; }
    __host__ __device__ bool next(int i, Unit& u) const {
        const long L = (long)i * G + c; if (L >= nwg) return false;
        int wgid = (int)L; { const int q = nwg / NXCD, r = nwg % NXCD, xcd = wgid % NXCD, off = wgid / NXCD; wgid = (xcd < r ? xcd * (q + 1) : r * (q + 1) + (xcd - r) * q) + off; }
        const int nig = WGM * nN, gid = wgid / nig, fm = gid * WGM, gsz = (nM - fm) < WGM ? (nM - fm) : WGM;
        u.pm = fm + ((wgid % nig) % gsz); u.pn = (wgid % nig) / gsz; return true;
    }
};

__device__ __forceinline__ f32x2 gelu_pk(f32x2 v) {
    const f32x2 av = __builtin_elementwise_abs(v), d = av * 0.2316418882f + 1.0f;
    f32x2 t; t.x = __builtin_amdgcn_rcpf(d.x); t.y = __builtin_amdgcn_rcpf(d.y);
    f32x2 q = t * 0.5307027145f + (-0.7265760135f); q = q * t + 0.7107068705f; q = q * t + (-0.142248368f); q = q * t + 0.127414796f; q = q * t;
    const f32x2 s = (v * v) * (-0.72134752044f);
    f32x2 e; e.x = __builtin_amdgcn_exp2f(s.x); e.y = __builtin_amdgcn_exp2f(s.y);
    const f32x2 m = v * (q * e), r = v - m;
    f32x2 o; o.x = v.x < 0.f ? m.x : r.x; o.y = v.y < 0.f ? m.y : r.y; return o;
}
__device__ __forceinline__ float gelu1(float v) { f32x2 r = gelu_pk((f32x2){v, v}); return r.x; }

template <int ACT> struct EpiF16 {
    static constexpr bool PERM = true;
    f16* O; int ldc; const float* bias; int bias_pm_split; int bias_split_off;
    __device__ __forceinline__ void operator()(const f32x4 (&acc)[2][2][4][2], const Unit& u, int wr, int wc, int fr, int fq) const {
        const int row0 = u.pm * BM + wr * 64 + fr; const int col0 = u.pn * BM + wc * 32 + 8 * fq;
        const float* bp = bias ? bias + (u.pm >= bias_pm_split ? bias_split_off : 0) : nullptr;
        f32x4 bv[2][2];
#pragma unroll
        for (int bj = 0; bj < 2; ++bj)
#pragma unroll
            for (int n = 0; n < 2; ++n) bv[bj][n] = bp ? *(const f32x4*)(bp + col0 + bj * HALF + 4 * n) : (f32x4){0.f, 0.f, 0.f, 0.f};
#pragma unroll
        for (int ai = 0; ai < 2; ++ai)
#pragma unroll
            for (int m = 0; m < 4; ++m) { f16* rowp = O + (size_t)(row0 + ai * HALF + m * 16) * ldc + col0;
#pragma unroll
                for (int bj = 0; bj < 2; ++bj) { f32x4 v0 = acc[ai][bj][m][0] + bv[bj][0], v1 = acc[ai][bj][m][1] + bv[bj][1];
                    if (ACT == 1) { f32x2 a = gelu_pk((f32x2){v0[0], v0[1]}), b = gelu_pk((f32x2){v0[2], v0[3]}), c = gelu_pk((f32x2){v1[0], v1[1]}), d = gelu_pk((f32x2){v1[2], v1[3]});
                        v0 = (f32x4){a.x, a.y, b.x, b.y}; v1 = (f32x4){c.x, c.y, d.x, d.y}; }
                    u32x4 w; w.x = pk_f16(v0[0], v0[1]); w.y = pk_f16(v0[2], v0[3]); w.z = pk_f16(v1[0], v1[1]); w.w = pk_f16(v1[2], v1[3]);
                    *(u32x4*)(rowp + bj * HALF) = w; } }
    }
};
struct EpiRawF32 {
    static constexpr bool PERM = false;
    float* C; int ldc;
    __device__ __forceinline__ void operator()(const f32x4 (&acc)[2][2][4][2], const Unit& u, int wr, int wc, int fr, int fq) const {
        const int row0 = u.pm * BM + wr * 64 + fr, col0 = u.pn * BM + wc * 32 + 4 * fq;
#pragma unroll
        for (int ai = 0; ai < 2; ++ai)
#pragma unroll
            for (int m = 0; m < 4; ++m) { float* rowp = C + (size_t)(row0 + ai * HALF + m * 16) * ldc + col0;
#pragma unroll
                for (int bj = 0; bj < 2; ++bj)
#pragma unroll
                    for (int n = 0; n < 2; ++n) *(f32x4*)(rowp + bj * HALF + n * 16) = acc[ai][bj][m][n]; }
    }
};
struct EpiRes16 {
    static constexpr bool PERM = true;
    f16* XR; float* SS;
    __device__ __forceinline__ void operator()(const f32x4 (&acc)[2][2][4][2], const Unit& u, int wr, int wc, int fr, int fq) const {
        const int row0 = u.pm * BM + wr * 64 + fr; const int col0 = u.pn * BM + wc * 32 + 8 * fq;
#pragma unroll
        for (int ai = 0; ai < 2; ++ai) {
            f16x8 xb[4][2];
#pragma unroll
            for (int m = 0; m < 4; ++m)
#pragma unroll
                for (int bj = 0; bj < 2; ++bj) xb[m][bj] = *(const f16x8*)(XR + (size_t)(row0 + ai * HALF + m * 16) * D + col0 + bj * HALF);
            asm volatile("" ::: "memory");
#pragma unroll
            for (int m = 0; m < 4; ++m) { const int row = row0 + ai * HALF + m * 16; const size_t off = (size_t)row * D + col0; float ss = 0.f;
#pragma unroll
                for (int bj = 0; bj < 2; ++bj) { const f16x8 xv = xb[m][bj];
                    f32x4 v0 = acc[ai][bj][m][0], v1 = acc[ai][bj][m][1];
                    v0[0] += (float)xv[0]; v0[1] += (float)xv[1]; v0[2] += (float)xv[2]; v0[3] += (float)xv[3]; v1[0] += (float)xv[4]; v1[1] += (float)xv[5]; v1[2] += (float)xv[6]; v1[3] += (float)xv[7];
                    ss += ((v0[0] * v0[0] + v0[1] * v0[1]) + (v0[2] * v0[2] + v0[3] * v0[3])) + ((v1[0] * v1[0] + v1[1] * v1[1]) + (v1[2] * v1[2] + v1[3] * v1[3]));
                    u32x4 o; o.x = pk_f16(v0[0], v0[1]); o.y = pk_f16(v0[2], v0[3]); o.z = pk_f16(v1[0], v1[1]); o.w = pk_f16(v1[2], v1[3]);
                    *(u32x4*)(XR + off + bj * HALF) = o; }
                ss += __shfl_xor(ss, 16); ss += __shfl_xor(ss, 32);
                if (fq == 0) atomicAdd(SS + row, ss); }
            asm volatile("" ::: "memory"); }
    }
};
struct EpiF16Row {
    static constexpr bool PERM = true;
    f16* O; int ldc; const float* SS;
    __device__ __forceinline__ void operator()(const f32x4 (&acc)[2][2][4][2], const Unit& u, int wr, int wc, int fr, int fq) const {
        const int row0 = u.pm * BM + wr * 64 + fr; const int col0 = u.pn * BM + wc * 32 + 8 * fq;
#pragma unroll
        for (int ai = 0; ai < 2; ++ai)
#pragma unroll
            for (int m = 0; m < 4; ++m) { const int row = row0 + ai * HALF + m * 16; f16* rowp = O + (size_t)row * ldc + col0;
                const float rs = 1.f / sqrtf(SS[row] * (1.f / D) + RMS_EPS);
#pragma unroll
                for (int bj = 0; bj < 2; ++bj) { const f32x4 v0 = acc[ai][bj][m][0] * rs, v1 = acc[ai][bj][m][1] * rs;
                    u32x4 o; o.x = pk_f16(v0[0], v0[1]); o.y = pk_f16(v0[2], v0[3]); o.z = pk_f16(v1[0], v1[1]); o.w = pk_f16(v1[2], v1[3]);
                    *(u32x4*)(rowp + bj * HALF) = o; } }
    }
};
struct EpiFinal {
    static constexpr bool PERM = true;
    const f16* XR; const f16* PJ; float* C; const float* SS;
    __device__ __forceinline__ void operator()(const f32x4 (&acc)[2][2][4][2], const Unit& u, int wr, int wc, int fr, int fq) const {
        const int row0 = u.pm * BM + wr * 64 + fr; const int col0 = u.pn * BM + wc * 32 + 8 * fq;
#pragma unroll
        for (int ai = 0; ai < 2; ++ai)
#pragma unroll
            for (int mh = 0; mh < 2; ++mh) {
                f16x8 xb[2][2], pb[2][2]; float ssv[2];
#pragma unroll
                for (int mm = 0; mm < 2; ++mm) { const int row = row0 + ai * HALF + (2 * mh + mm) * 16; ssv[mm] = SS[row];
#pragma unroll
                    for (int bj = 0; bj < 2; ++bj) { xb[mm][bj] = *(const f16x8*)(XR + (size_t)row * D + col0 + bj * HALF); pb[mm][bj] = *(const f16x8*)(PJ + (size_t)row * D + col0 + bj * HALF); } }
                asm volatile("" ::: "memory");
#pragma unroll
                for (int mm = 0; mm < 2; ++mm) { const int m = 2 * mh + mm; const int row = row0 + ai * HALF + m * 16; const size_t off = (size_t)row * D + col0;
                    const float nrs = -LOG2E / sqrtf(ssv[mm] * (1.f / D) + RMS_EPS);
#pragma unroll
                    for (int bj = 0; bj < 2; ++bj) { const f16x8 xv = xb[mm][bj], pv = pb[mm][bj];
                        const f32x4 a0 = acc[ai][bj][m][0], a1 = acc[ai][bj][m][1]; f32x4 o0, o1;
#pragma unroll
                        for (int j = 0; j < 4; ++j) { o0[j] = (float)xv[j] + (float)pv[j] * __builtin_amdgcn_rcpf(1.0f + __builtin_amdgcn_exp2f(nrs * a0[j]));
                            o1[j] = (float)xv[4 + j] + (float)pv[4 + j] * __builtin_amdgcn_rcpf(1.0f + __builtin_amdgcn_exp2f(nrs * a1[j])); }
                        *(f32x4*)(C + off + bj * HALF) = o0; *(f32x4*)(C + off + bj * HALF + 4) = o1; } }
                asm volatile("" ::: "memory"); }
    }
};
template <int MODE> struct EpiF32 {
    static constexpr bool PERM = false;
    const float* base; float* C; int ldc; const f16* pj; const float* ssp;
    __device__ __forceinline__ void operator()(const f32x4 (&acc)[2][2][4][2], const Unit& u, int wr, int wc, int fr, int fq) const {
        const int row0 = u.pm * BM + wr * 64 + fr, col0 = u.pn * BM + wc * 32 + 4 * fq;
#pragma unroll
        for (int ai = 0; ai < 2; ++ai)
#pragma unroll
            for (int m = 0; m < 4; ++m) { const size_t off = (size_t)(row0 + ai * HALF + m * 16) * ldc + col0;
                float nrs = -LOG2E;
                if (MODE == 1) { const f32x4 s0 = *(const f32x4*)(ssp + (size_t)(row0 + ai * HALF + m * 16) * 8), s1 = *(const f32x4*)(ssp + (size_t)(row0 + ai * HALF + m * 16) * 8 + 4);
                    nrs = -LOG2E / sqrtf((((s0.x + s0.y) + (s0.z + s0.w)) + ((s1.x + s1.y) + (s1.z + s1.w))) * (1.f / D) + RMS_EPS); }
#pragma unroll
                for (int bj = 0; bj < 2; ++bj)
#pragma unroll
                    for (int n = 0; n < 2; ++n) { const size_t o2 = off + bj * HALF + n * 16; const f32x4 bs = *(const f32x4*)(base + o2); f32x4 a = acc[ai][bj][m][n];
                        if (MODE == 1) { const f16x4 pv = *(const f16x4*)(pj + o2);
#pragma unroll
                            for (int j = 0; j < 4; ++j) a[j] = (float)pv[j] * __builtin_amdgcn_rcpf(1.0f + __builtin_amdgcn_exp2f(nrs * a[j])); }
                        *(f32x4*)(C + o2) = bs + a; }
                asm volatile("" ::: "memory"); }
    }
};

template <class Epi, class Sched>
__device__ __forceinline__ void gemm_phase(LAS unsigned char* lds, const Gemm g, const Sched& S, const Epi& E) {
    const int tid = threadIdx.x, wid = __builtin_amdgcn_readfirstlane(tid >> 6), lane = tid & 63, wr = wid >> 2, wc = wid & 3, fr = lane & 15, fq = lane >> 4;
    const int K = g.K, nt = K / BK;
    unsigned voffA[2], voffB[2];
#pragma unroll
    for (int i = 0; i < 2; ++i) { int R, C; stage_rc(tid * 16 + i * 8192, R, C); const int Rb = Epi::PERM ? ((R & ~31) + perm32(R & 31)) : R;
        voffA[i] = (unsigned)(R * g.lda + C) * 2u; voffB[i] = (unsigned)(Rb * g.ldb + C) * 2u; }
    const size_t kstep = (size_t)(BK * 2);
    const size_t hstepA = (size_t)HALF * g.lda * 2, hstepB = (size_t)HALF * g.ldb * 2;
    const unsigned ldsw = (unsigned)wid * 1024u;
    const int aoff = lds_byte(wr * 64 + fr, fq * 8), boff = lds_byte(wc * 32 + fr, fq * 8);
#define PG8_SA(b, h) (((b) * 2 + (h)) * HTB)
#define PG8_SB(b, h) ((4 + (b) * 2 + (h)) * HTB)
#define PG8_STAGE(bufoff, gbase, voff) do { _Pragma("unroll") for (int _i = 0; _i < 2; ++_i) \
        __builtin_amdgcn_global_load_lds((const unsigned*)((const char*)(gbase) + (voff)[_i]), (LAS unsigned*)(lds + (bufoff) + ldsw + _i * 8192), 16, 0, 0); } while (0)
#define PG8_LDA(dst, b, h) do { _Pragma("unroll") for (int m = 0; m < 4; ++m) _Pragma("unroll") for (int k = 0; k < 2; ++k) dst[m][k] = *(const LAS f16x8*)(lds + PG8_SA(b, h) + aoff + m * 2048 + k * 1024); } while (0)
#define PG8_LDB(dst, b, h) do { _Pragma("unroll") for (int n = 0; n < 2; ++n) _Pragma("unroll") for (int k = 0; k < 2; ++k) dst[n][k] = *(const LAS f16x8*)(lds + PG8_SB(b, h) + boff + n * 2048 + k * 1024); } while (0)
#define PG8_MMA(ai, bj, At, Bt) do { __builtin_amdgcn_s_setprio(1); _Pragma("unroll") for (int m = 0; m < 4; ++m) _Pragma("unroll") for (int n = 0; n < 2; ++n) _Pragma("unroll") for (int k = 0; k < 2; ++k) \
        acc[ai][bj][m][n] = __builtin_amdgcn_mfma_f32_16x16x32_f16(Bt[n][k], At[m][k], acc[ai][bj][m][n], 0, 0, 0); __builtin_amdgcn_s_setprio(0); } while (0)
#define PG8_WAIT_V(n) asm volatile("s_waitcnt vmcnt(" #n ")" ::: "memory")
#define PG8_WAIT_L(n) asm volatile("s_waitcnt lgkmcnt(" #n ")" ::: "memory")
#define PG8_BAR __builtin_amdgcn_s_barrier()
#define PG8_SCHED __builtin_amdgcn_sched_barrier(0)
    Unit cur, nxt; int ui = 0;
    if (!S.next(0, cur)) return;
    f32x4 acc[2][2][4][2];
#pragma unroll
    for (int a = 0; a < 2; ++a)
#pragma unroll
        for (int b = 0; b < 2; ++b)
#pragma unroll
            for (int m = 0; m < 4; ++m)
#pragma unroll
                for (int n = 0; n < 2; ++n) acc[a][b][m][n] = (f32x4){0.f, 0.f, 0.f, 0.f};
    f16x8 At[4][2], B0[2][2], B1[2][2];
    const char* cA = g.aptr(cur); const char* cB = g.bptr(cur);
    PG8_STAGE(PG8_SB(0, 0), cB, voffB); PG8_STAGE(PG8_SB(0, 1), cB + hstepB, voffB); PG8_STAGE(PG8_SA(0, 0), cA, voffA); PG8_STAGE(PG8_SA(0, 1), cA + hstepA, voffA);
    if (wr == 1) PG8_BAR;
    PG8_WAIT_V(2); PG8_BAR;
    PG8_STAGE(PG8_SB(1, 0), cB + kstep, voffB); PG8_STAGE(PG8_SA(1, 0), cA + kstep, voffA); PG8_STAGE(PG8_SB(1, 1), cB + hstepB + kstep, voffB);
    PG8_WAIT_V(6); PG8_BAR;
    for (;;) {
        const bool has_next = S.next(ui + 1, nxt);
        const char* nA = has_next ? g.aptr(nxt) : cA; const char* nB = has_next ? g.bptr(nxt) : cB;
        for (int t = 0; t < nt; t += 2) {
            const bool last = (t == nt - 2);
            const char* a1 = cA + (size_t)(t + 1) * kstep;
            const char* a2 = last ? nA : cA + (size_t)(t + 2) * kstep; const char* b2 = last ? nB : cB + (size_t)(t + 2) * kstep;
            const char* a3 = a2 + kstep; const char* b3 = b2 + kstep;
            PG8_LDB(B0, 0, 0); PG8_LDB(B1, 0, 1); PG8_SCHED; PG8_LDA(At, 0, 0); PG8_STAGE(PG8_SA(1, 1), a1 + hstepA, voffA);
            PG8_WAIT_V(8); PG8_WAIT_L(0); PG8_BAR; PG8_MMA(0, 0, At, B0); PG8_MMA(0, 1, At, B1); PG8_BAR; PG8_SCHED;
            PG8_LDA(At, 0, 1); PG8_STAGE(PG8_SB(0, 0), b2, voffB); PG8_STAGE(PG8_SB(0, 1), b2 + hstepB, voffB); PG8_STAGE(PG8_SA(0, 0), a2, voffA);
            PG8_WAIT_V(8); PG8_WAIT_L(0); PG8_BAR; PG8_MMA(1, 0, At, B0); PG8_MMA(1, 1, At, B1); PG8_BAR; PG8_SCHED;
            PG8_LDB(B0, 1, 0); PG8_LDB(B1, 1, 1); PG8_SCHED; PG8_LDA(At, 1, 0); PG8_STAGE(PG8_SA(0, 1), a2 + hstepA, voffA);
            PG8_WAIT_V(8); PG8_WAIT_L(0); PG8_BAR; PG8_MMA(0, 0, At, B0); PG8_MMA(0, 1, At, B1); PG8_BAR; PG8_SCHED;
            PG8_LDA(At, 1, 1); PG8_STAGE(PG8_SB(1, 0), b3, voffB); PG8_STAGE(PG8_SB(1, 1), b3 + hstepB, voffB); PG8_STAGE(PG8_SA(1, 0), a3, voffA);
            PG8_WAIT_V(8); PG8_WAIT_L(0); PG8_BAR; PG8_MMA(1, 0, At, B0); PG8_MMA(1, 1, At, B1); PG8_BAR; PG8_SCHED;
        }
        if (wr == 0) PG8_BAR;
        E(acc, cur, wr, wc, fr, fq);
        if (!has_next) break;
#pragma unroll
        for (int a = 0; a < 2; ++a)
#pragma unroll
            for (int b = 0; b < 2; ++b)
#pragma unroll
                for (int m = 0; m < 4; ++m)
#pragma unroll
                    for (int n = 0; n < 2; ++n) acc[a][b][m][n] = (f32x4){0.f, 0.f, 0.f, 0.f};
        cur = nxt; cA = nA; cB = nB; ++ui;
        if (wr == 1) PG8_BAR;
    }
    PG8_WAIT_V(0);
    PG8_BAR;
#undef PG8_SA
#undef PG8_SB
#undef PG8_STAGE
#undef PG8_LDA
#undef PG8_LDB
#undef PG8_MMA
#undef PG8_WAIT_V
#undef PG8_WAIT_L
#undef PG8_BAR
#undef PG8_SCHED
}
}

#define XB_TMO      128
#define XB_XCNT(j)  (256  + 64 * (j))
#define XB_XSUB(j)  (1280 + 64 * (j))
#define XB_XGEN(j)  (2304 + 64 * (j))
#define XB_TOP      3328
#define XB_TOPGEN   3392
#define XCD_BAR_WORDS 3456
#define XB_SPIN_CAP (1u << 18)
__device__ __forceinline__ unsigned xb_ld(unsigned* p)              { return __hip_atomic_load(p, __ATOMIC_RELAXED, __HIP_MEMORY_SCOPE_AGENT); }
__device__ __forceinline__ unsigned xb_add(unsigned* p, unsigned v) { return __hip_atomic_fetch_add(p, v, __ATOMIC_RELAXED, __HIP_MEMORY_SCOPE_AGENT); }
__device__ __forceinline__ unsigned xb_xcc_id() { return (unsigned)__builtin_amdgcn_s_getreg((3 << 11) | 20) & 0xFu; }
#define XB_SPIN(cond, bar) do { unsigned _sp = 0; while (cond) { __builtin_amdgcn_s_sleep(1); \
    if ((++_sp & 255u) == 0u) { if (xb_ld(&(bar)[XB_TMO])) break; if (_sp > XB_SPIN_CAP) { atomicAdd(&(bar)[XB_TMO], 1u); break; } } } } while (0)
struct XcdBarrier { unsigned* bar; unsigned x; volatile LAS unsigned* st; };
__device__ __forceinline__ XcdBarrier xcd_barrier_post(unsigned* bar, volatile LAS unsigned* st) {
    XcdBarrier b; b.bar = bar; b.x = xb_xcc_id(); b.st = st;
    if (threadIdx.x == 0) (void)xb_add(&bar[XB_XCNT(b.x)], 1u);
    return b;
}
__device__ __forceinline__ void xcd_barrier_complete(unsigned* bar, unsigned x, unsigned& nloc, unsigned& nx) {
    const unsigned G = gridDim.x * gridDim.y * gridDim.z;
    unsigned sum, cnt, mine, sp = 0u;
    for (;;) {
        sum = 0u; cnt = 0u; mine = 0u;
#pragma unroll
        for (unsigned j = 0; j < 16; ++j) { const unsigned c = xb_ld(&bar[XB_XCNT(j)]); sum += c; cnt += (c > 0u) ? 1u : 0u; mine = (j == x) ? c : mine; }
        if (sum == G) break;
        __builtin_amdgcn_s_sleep(1);
        if ((++sp & 255u) == 0u) { if (xb_ld(&bar[XB_TMO])) break; if (sp > XB_SPIN_CAP) { atomicAdd(&bar[XB_TMO], 1u); break; } }
    }
    nloc = mine > 0u ? mine : 1u; nx = cnt > 0u ? cnt : 1u;
}
__device__ __forceinline__ void xcd_barrier(const XcdBarrier& b) {
    asm volatile("s_waitcnt vmcnt(0)" ::: "memory");
    __syncthreads();
    if (threadIdx.x == 0) {
        unsigned* bar = b.bar;
        __builtin_amdgcn_s_waitcnt(0);
        unsigned nloc = b.st[0], nx = b.st[1];
        if (nloc == 0u) { xcd_barrier_complete(bar, b.x, nloc, nx); b.st[0] = nloc; b.st[1] = nx; }
        const unsigned old = xb_add(&bar[XB_XSUB(b.x)], 1u);
        const unsigned gen = old / nloc;
        if (old + 1u == (gen + 1u) * nloc) {
            __builtin_amdgcn_fence(__ATOMIC_RELEASE, "agent");
            asm volatile("s_waitcnt vmcnt(0)" ::: "memory");
            const unsigned og = xb_add(&bar[XB_TOP], 1u);
            const unsigned tg = og / nx;
            if (og + 1u == (tg + 1u) * nx) xb_add(&bar[XB_TOPGEN], 1u);
            else XB_SPIN(xb_ld(&bar[XB_TOPGEN]) == tg, bar);
            __builtin_amdgcn_fence(__ATOMIC_ACQUIRE, "agent");
            xb_add(&bar[XB_XGEN(b.x)], 1u);
            asm volatile("s_waitcnt vmcnt(0)" ::: "memory");
        } else {
            XB_SPIN(xb_ld(&bar[XB_XGEN(b.x)]) == gen, bar);
            __builtin_amdgcn_fence(__ATOMIC_ACQUIRE, "agent");
            asm volatile("s_waitcnt vmcnt(0)" ::: "memory");
        }
    }
    __syncthreads();
}

struct Frame {
    LAS unsigned char* lds;
    volatile LAS unsigned* MISC;
    int tid, lane, wave;
    int vcu, G;
    const float* in[26];
    float* out;
    unsigned char* ws;
};
enum { I_X = 0, I_P, I_RELB, I_MIXNW, I_WIN, I_QNW, I_KNW, I_CKPOS, I_CKW1, I_CKB1, I_CKW2, I_CVPOS, I_CVW1, I_CVB1, I_CVW2, I_POOLW, I_POOLS, I_WOUT, I_FFNNW, I_PWQ, I_PKEYS, I_PU, I_PV, I_PLENW, I_PLEWG, I_PLEWP };

__device__ __forceinline__ void p0_transpose_item(const float* W, int K, int N, int Npad, const float* colscale, f16* WT, LAS float* scr, int item, int lane, const float* kscale = nullptr) {
    const int nblk = Npad / 32, kb = item / nblk, nb = item % nblk, k0 = 64 * kb, n0 = 32 * nb;
    const int nn = n0 + (lane & 31); const bool ok = nn < N;
#pragma unroll 8
    for (int i = 0; i < 32; ++i) { const int kk = 2 * i + (lane >> 5); scr[kk * 33 + (lane & 31)] = ok ? W[(size_t)(k0 + kk) * N + nn] * (kscale ? kscale[k0 + kk] : 1.f) : 0.f; }
    LDS_WAIT(); asm volatile("" ::: "memory");
    const int c = lane & 7;
#pragma unroll
    for (int j = 0; j < 4; ++j) { const int n = (lane >> 3) + 8 * j; const LAS float* s = scr + (8 * c) * 33 + n; const float sc = (colscale && n0 + n < N) ? colscale[n0 + n] : 1.f;
        u32x4 o; o.x = pk_f16(s[0 * 33] * sc, s[1 * 33] * sc); o.y = pk_f16(s[2 * 33] * sc, s[3 * 33] * sc); o.z = pk_f16(s[4 * 33] * sc, s[5 * 33] * sc); o.w = pk_f16(s[6 * 33] * sc, s[7 * 33] * sc);
        *(GAS u32x4*)(WT + (size_t)(n0 + n) * K + k0 + 8 * c) = o; }
    LDS_WAIT(); asm volatile("" ::: "memory");
}
__device__ __forceinline__ void rms_row_to_f16(const float* xrow, const float* w, f16* orow, int lane, f16* x16row = nullptr) {
    const GAS f32x4* xr = (const GAS f32x4*)xrow + lane; const GAS f32x4* wr = (const GAS f32x4*)w + lane;
    f32x4 v[8]; float s = 0.f;
#pragma unroll
    for (int j = 0; j < 8; ++j) { v[j] = xr[64 * j]; s += (v[j].x * v[j].x + v[j].y * v[j].y) + (v[j].z * v[j].z + v[j].w * v[j].w); }
    const float rstd = 1.f / sqrtf(wave_sum(s) * (1.f / D) + RMS_EPS);
    GAS u32x2* o8 = (GAS u32x2*)orow + lane;
#pragma unroll
    for (int j = 0; j < 8; ++j) { const f32x4 g = wr[64 * j]; u32x2 o; o.x = pk_f16(v[j].x * rstd * g.x, v[j].y * rstd * g.y); o.y = pk_f16(v[j].z * rstd * g.z, v[j].w * rstd * g.w); o8[64 * j] = o; }
    if (x16row) { GAS u32x2* x8 = (GAS u32x2*)x16row + lane;
#pragma unroll
        for (int j = 0; j < 8; ++j) { u32x2 o; o.x = pk_f16(v[j].x, v[j].y); o.y = pk_f16(v[j].z, v[j].w); x8[64 * j] = o; } }
}
__device__ __forceinline__ void rms_2rows_to_f16(const float* x0, const float* x1, const float* w, f16* o0, f16* o1, f16* h0, f16* h1, int lane) {
    const GAS f32x4* xa = (const GAS f32x4*)x0 + lane; const GAS f32x4* xb = (const GAS f32x4*)x1 + lane; const GAS f32x4* wr = (const GAS f32x4*)w + lane;
    f32x4 va[8], vb[8]; float sa = 0.f, sb = 0.f;
#pragma unroll
    for (int j = 0; j < 8; ++j) { va[j] = __builtin_nontemporal_load(xa + 64 * j); vb[j] = __builtin_nontemporal_load(xb + 64 * j); }
#pragma unroll
    for (int j = 0; j < 8; ++j) { sa += (va[j].x * va[j].x + va[j].y * va[j].y) + (va[j].z * va[j].z + va[j].w * va[j].w); sb += (vb[j].x * vb[j].x + vb[j].y * vb[j].y) + (vb[j].z * vb[j].z + vb[j].w * vb[j].w); }
    const float ra = 1.f / sqrtf(wave_sum(sa) * (1.f / D) + RMS_EPS), rb = 1.f / sqrtf(wave_sum(sb) * (1.f / D) + RMS_EPS);
    GAS u32x2* pa = (GAS u32x2*)o0 + lane; GAS u32x2* pb = (GAS u32x2*)o1 + lane; GAS u32x2* qa = (GAS u32x2*)h0 + lane; GAS u32x2* qb = (GAS u32x2*)h1 + lane;
#pragma unroll
    for (int j = 0; j < 8; ++j) { const f32x4 g = wr[64 * j]; u32x2 o;
        o.x = pk_f16(va[j].x * ra * g.x, va[j].y * ra * g.y); o.y = pk_f16(va[j].z * ra * g.z, va[j].w * ra * g.w); pa[64 * j] = o;
        o.x = pk_f16(vb[j].x * rb * g.x, vb[j].y * rb * g.y); o.y = pk_f16(vb[j].z * rb * g.z, vb[j].w * rb * g.w); pb[64 * j] = o;
        o.x = pk_f16(va[j].x, va[j].y); o.y = pk_f16(va[j].z, va[j].w); qa[64 * j] = o;
        o.x = pk_f16(vb[j].x, vb[j].y); o.y = pk_f16(vb[j].z, vb[j].w); qb[64 * j] = o; }
}
__device__ __forceinline__ void x16_2rows(const float* x0, const float* x1, f16* h0, f16* h1, float* ss0, float* ss1, int lane) {
    const GAS f32x4* xa = (const GAS f32x4*)x0 + lane; const GAS f32x4* xb = (const GAS f32x4*)x1 + lane;
    f32x4 va[8], vb[8]; float sa = 0.f, sb = 0.f;
#pragma unroll
    for (int j = 0; j < 8; ++j) { va[j] = __builtin_nontemporal_load(xa + 64 * j); vb[j] = __builtin_nontemporal_load(xb + 64 * j); }
    GAS u32x2* qa = (GAS u32x2*)h0 + lane; GAS u32x2* qb = (GAS u32x2*)h1 + lane;
#pragma unroll
    for (int j = 0; j < 8; ++j) { sa += (va[j].x * va[j].x + va[j].y * va[j].y) + (va[j].z * va[j].z + va[j].w * va[j].w); sb += (vb[j].x * vb[j].x + vb[j].y * vb[j].y) + (vb[j].z * vb[j].z + vb[j].w * vb[j].w);
        u32x2 o; o.x = pk_f16(va[j].x, va[j].y); o.y = pk_f16(va[j].z, va[j].w); qa[64 * j] = o;
        o.x = pk_f16(vb[j].x, vb[j].y); o.y = pk_f16(vb[j].z, vb[j].w); qb[64 * j] = o; }
    sa = wave_sum(sa); sb = wave_sum(sb);
    if (lane == 0) { *ss0 = sa; *ss1 = sb; }
}
__device__ __forceinline__ void cvt_f32_f16(Frame& F, const float* src, f16* dst, size_t n) {
    const size_t gt = (size_t)F.vcu * 512 + F.tid, GT = (size_t)F.G * 512;
    for (size_t i = gt; i < n / 8; i += GT) { const f32x4 a = *(const GAS f32x4*)(src + i * 8), b = *(const GAS f32x4*)(src + i * 8 + 4);
        u32x4 o; o.x = pk_f16(a.x, a.y); o.y = pk_f16(a.z, a.w); o.z = pk_f16(b.x, b.y); o.w = pk_f16(b.z, b.w); *(GAS u32x4*)(dst + i * 8) = o; }
}

__device__ __forceinline__ void p0_prologue(Frame& F) {
    LAS float* scr = (LAS float*)(F.lds + F.wave * 16384);
    const int gw = F.vcu * NWAVES + F.wave, NGW = F.G * NWAVES;
    unsigned char* ws = F.ws;
    constexpr int I_IN = (D / 64) * (NINP / 32), I_SQ = (D / 64) * (D / 32), I_PJ = (256 / 64) * (D / 32), I_C1 = (D / 64) * (256 / 32), I_PL = (256 / 64) * (256 / 32);
    constexpr int NITEMS = I_IN + 3 * I_SQ + I_PJ + 2 * I_C1 + 4 * I_PL;
    for (int it = gw; it < NITEMS; it += NGW) {
        int r = it;
        if (r < I_IN) { p0_transpose_item(F.in[I_WIN], D, NIN, NINP, nullptr, (f16*)(ws + WS_WIN), scr, r, F.lane, F.in[I_MIXNW]); continue; } r -= I_IN;
        if (r < I_SQ) { p0_transpose_item(F.in[I_WOUT], D, D, D, nullptr, (f16*)(ws + WS_WOUT), scr, r, F.lane); continue; } r -= I_SQ;
        if (r < I_SQ) { p0_transpose_item(F.in[I_PWQ], D, D, D, nullptr, (f16*)(ws + WS_WQ), scr, r, F.lane, F.in[I_FFNNW]); continue; } r -= I_SQ;
        if (r < I_SQ) { p0_transpose_item(F.in[I_PLEWG], D, D, D, nullptr, (f16*)(ws + WS_WG), scr, r, F.lane, F.in[I_PLENW]); continue; } r -= I_SQ;
        if (r < I_PJ) { p0_transpose_item(F.in[I_PLEWP], 256, D, D, nullptr, (f16*)(ws + WS_WPJ), scr, r, F.lane); continue; } r -= I_PJ;
        if (r < I_C1) { p0_transpose_item(F.in[I_CKW1], D, 256, 256, nullptr, (f16*)(ws + WS_W1C), scr, r, F.lane); continue; } r -= I_C1;
        if (r < I_C1) { p0_transpose_item(F.in[I_CVW1], D, 256, 256, nullptr, (f16*)(ws + WS_W1C) + 256 * D, scr, r, F.lane); continue; } r -= I_C1;
        { const int g = r / I_PL; r -= g * I_PL;
          p0_transpose_item(F.in[I_POOLW] + (size_t)g * 65536, 256, 256, 256, F.in[I_POOLS] + g * 256, (f16*)(ws + WS_POOLT) + (size_t)g * 65536, scr, r, F.lane); }
    }
    { float* SS0 = (float*)(ws + WS_SS0); f16* XR = (f16*)(ws + WS_XR);
      for (int m = gw; m < M; m += 2 * NGW) { const int m2 = m + NGW < M ? m + NGW : m;
          x16_2rows(F.in[I_X] + (size_t)m * D, F.in[I_X] + (size_t)m2 * D, XR + (size_t)m * D, XR + (size_t)m2 * D, SS0 + m, SS0 + m2, F.lane); } }
    cvt_f32_f16(F, F.in[I_P], (f16*)(ws + WS_P16), (size_t)M * 256);
    cvt_f32_f16(F, F.in[I_PKEYS], (f16*)(ws + WS_KEYS), (size_t)8 * 2 * 128 * 128);
    for (int task = gw; task < 512; task += NGW) { const int mat = task >> 8, n = task & 255;
        const float* pos = F.in[mat ? I_CVPOS : I_CKPOS]; const float* w1 = F.in[mat ? I_CVW1 : I_CKW1]; float s = 0.f;
#pragma unroll
        for (int i = 0; i < 32; ++i) { const int k = F.lane + 64 * i; s += pos[k] * w1[(size_t)k * 256 + n]; }
        s = wave_sum(s);
        if (F.lane == 0) ((float*)(ws + WS_CBIAS))[task] = s + F.in[mat ? I_CVB1 : I_CKB1][n]; }
}

template <int W> __device__ __forceinline__ void pool_mix_tile(const f16* up, f16* mp, size_t mb, int s0) {
    f16x2 prev[16], cur[16]; f32x2 sum = {0.f, 0.f};
#pragma unroll
    for (int i = 0; i < 16; ++i) { const int sp = s0 - 16 + i; prev[i] = sp >= 0 ? *(const GAS f16x2*)(up + (mb + sp) * NINP) : (f16x2){(f16)0.f, (f16)0.f}; }
#pragma unroll
    for (int i = 16 - W; i < 16; ++i) { sum.x += (float)prev[i].x; sum.y += (float)prev[i].y; }
#pragma unroll 1
    for (int blk = 0; blk < 4; ++blk) { const int sb = s0 + blk * 16;
#pragma unroll
        for (int i = 0; i < 16; ++i) cur[i] = *(const GAS f16x2*)(up + (mb + sb + i) * NINP);
#pragma unroll
        for (int i = 0; i < 16; ++i) { const int s = sb + i; const f16x2 o = (i - W >= 0) ? cur[(i - W >= 0) ? i - W : 0] : prev[(i - W >= 0) ? 0 : 16 + i - W];
            sum.x += (float)cur[i].x - (float)o.x; sum.y += (float)cur[i].y - (float)o.y;
            const float ic = 1.f / (float)(s + 1 < W ? s + 1 : W);
            *(GAS unsigned*)(mp + (mb + s) * 1024) = pk_f16(sum.x * ic - (float)cur[i].x, sum.y * ic - (float)cur[i].y); }
#pragma unroll
        for (int i = 0; i < 16; ++i) prev[i] = cur[i]; }
}
__device__ __forceinline__ void p2_post(Frame& F) {
    unsigned char* ws = F.ws;
    f16* Y = (f16*)(ws + WS_Y);
    const float* qnw = F.in[I_QNW]; const float* knw = F.in[I_KNW];
    LAS f16* vl = (LAS f16*)F.lds;
    constexpr int VLP = 264;
    for (int tt = F.vcu; tt < M / 64; tt += F.G) {
        const int b = tt >> 5, s0 = (tt & 31) * 64, m0 = tt * 64;
        for (int tk = F.wave; tk < 64; tk += NWAVES) {
            const int m = m0 + tk, s = s0 + tk; f16* yr = Y + (size_t)m * NINP;
#pragma unroll
            for (int pass = 0; pass < 2; ++pass) { const int ch = pass * 64 + F.lane; f16* pq = yr + OFF_Q + ch * 8; const f16x8 v = *(const GAS f16x8*)pq;
                float ss = 0.f;
#pragma unroll
                for (int e = 0; e < 8; ++e) ss += (float)v[e] * (float)v[e];
                ss = sum8(ss);
                const float rs = (1.f / sqrtf(ss * (1.f / 64.f) + RMS_EPS)) * (0.125f * LOG2E); const float* w = qnw + (ch & 7) * 8;
                u32x4 o; o.x = pk_f16((float)v[0] * rs * w[0], (float)v[1] * rs * w[1]); o.y = pk_f16((float)v[2] * rs * w[2], (float)v[3] * rs * w[3]);
                o.z = pk_f16((float)v[4] * rs * w[4], (float)v[5] * rs * w[5]); o.w = pk_f16((float)v[6] * rs * w[6], (float)v[7] * rs * w[7]);
                *(GAS u32x4*)((f16*)(ws + WS_QN) + (size_t)m * 1024 + ch * 8) = o; }
            { const int br = F.lane >> 5, ch = F.lane & 31, g = ch >> 3, dc = ch & 7; const f16x8 v = *(const GAS f16x8*)(yr + (br ? OFF_KW : OFF_KS) + ch * 8);
                float ss = 0.f;
#pragma unroll
                for (int e = 0; e < 8; ++e) ss += (float)v[e] * (float)v[e];
                ss = sum8(ss);
                const float rs = 1.f / sqrtf(ss * (1.f / 64.f) + RMS_EPS); const float* w = knw + dc * 8;
                u32x4 o; o.x = pk_f16((float)v[0] * rs * w[0], (float)v[1] * rs * w[1]); o.y = pk_f16((float)v[2] * rs * w[2], (float)v[3] * rs * w[3]);
                o.z = pk_f16((float)v[4] * rs * w[4], (float)v[5] * rs * w[5]); o.w = pk_f16((float)v[6] * rs * w[6], (float)v[7] * rs * w[7]);
                *(GAS u32x4*)((f16*)(ws + WS_KN) + (size_t)br * (BATCH * 4 * SEQ * 64) + ((size_t)(b * 4 + g) * 64 + (s >> 5)) * 2048 + (dc >> 1) * 512 + ((dc & 1) * 32 + (s & 31)) * 8) = o; }
            { const int mat = F.lane >> 5, ch = F.lane & 31, g = ch >> 3, dc = ch & 7; const u32x4 v = *(const GAS u32x4*)(yr + (mat ? OFF_VC : OFF_KC) + ch * 8);
                const int i1 = s >> 4, jj = s & 15; f16* fa = (f16*)(ws + WS_FLATA) + (size_t)mat * 4096 * 2048;
                if (i1 <= NCMP - 1) *(GAS u32x4*)(fa + (size_t)((b * NCMP + i1) * 4 + g) * 2048 + jj * 64 + dc * 8) = v;
                if (i1 >= 1) *(GAS u32x4*)(fa + (size_t)((b * NCMP + i1 - 1) * 4 + g) * 2048 + (16 + jj) * 64 + dc * 8) = v; }
        }
        for (int idx = F.tid; idx < 64 * 48; idx += 512) { const int tk = idx / 48, c = idx - tk * 48; const float v = (float)Y[(size_t)(m0 + tk) * NINP + OFF_G + c];
            ((float*)(ws + WS_GATES))[(size_t)(m0 + tk) * 48 + c] = 1.f / (1.f + __expf(-v)); }
        { const int gg = F.tid >> 7;
          if (gg == 0) pool_mix_tile<2>(Y + OFF_U + F.tid * 2, (f16*)(ws + WS_MIXED) + F.tid * 2, (size_t)b * SEQ, s0);
          else if (gg == 1) pool_mix_tile<4>(Y + OFF_U + F.tid * 2, (f16*)(ws + WS_MIXED) + F.tid * 2, (size_t)b * SEQ, s0);
          else if (gg == 2) pool_mix_tile<8>(Y + OFF_U + F.tid * 2, (f16*)(ws + WS_MIXED) + F.tid * 2, (size_t)b * SEQ, s0);
          else pool_mix_tile<16>(Y + OFF_U + F.tid * 2, (f16*)(ws + WS_MIXED) + F.tid * 2, (size_t)b * SEQ, s0); }
        __syncthreads();
        for (int idx = F.tid; idx < 2 * 64 * 32; idx += 512) { const int br = idx >> 11, tk = (idx >> 5) & 63, ch = idx & 31;
            *(LAS u32x4*)(vl + (br * 64 + tk) * VLP + ch * 8) = *(const GAS u32x4*)(Y + (size_t)(m0 + tk) * NINP + (br ? OFF_VW : OFF_VS) + ch * 8); }
        __syncthreads();
        for (int idx = F.tid; idx < 2 * 256 * 8; idx += 512) { const int br = idx >> 11, row = (idx >> 3) & 255, cc = idx & 7, grp = cc >> 1, hh = cc & 1;
            f16x8 o;
#pragma unroll
            for (int j = 0; j < 8; ++j) { const int kap = 16 * grp + 8 * (j >> 2) + 4 * hh + (j & 3); o[j] = vl[(br * 64 + kap) * VLP + row]; }
            const int g = row >> 6, d = row & 63;
            *(GAS f16x8*)((f16*)(ws + WS_VT) + (size_t)br * (BATCH * 4 * 64 * SEQ) + ((size_t)(b * 4 + g) * 64 + (s0 >> 5) + (cc >> 2)) * 2048 + ((d >> 5) * 2 + ((cc >> 1) & 1)) * 512 + ((cc & 1) * 32 + (d & 31)) * 8) = o; }
        __syncthreads();
    }
}

__device__ __forceinline__ void p4_compress2(Frame& F) {
    unsigned char* ws = F.ws;
    f16* kc = (f16*)(ws + WS_KCMP); f16* vt = (f16*)(ws + WS_VCMPT);
    const int nhalf = F.G >> 1, mat = F.vcu & 1, wgr = F.vcu >> 1;
    if (nhalf == 0) return;
    LAS float* w2l = (LAS float*)F.lds;
    { const float* w2g = F.in[mat ? I_CVW2 : I_CKW2];
      for (int idx = F.tid; idx < 256 * 16; idx += 512) { const int k = idx >> 4, d4 = (idx & 15) * 4; const f32x4 v = *(const GAS f32x4*)(w2g + (size_t)k * 64 + d4);
          LAS float* q = w2l + ((k >> 2) * 64 + d4) * 4 + (k & 3); q[0] = v.x; q[4] = v.y; q[8] = v.z; q[12] = v.w; } }
    __syncthreads();
    const int rstep = nhalf * NWAVES, r0 = (F.vcu >= 2 * nhalf ? 4096 : wgr * NWAVES + F.wave);
#pragma unroll 1
    for (int rb = r0; rb < 4096; rb += 4 * rstep) {
        f32x4 hs[4];
#pragma unroll
        for (int q = 0; q < 4; ++q) { const int r = rb + q * rstep < 4096 ? rb + q * rstep : rb; const int bg = r >> 7, i = r & 127, ic = i < NCMP ? i : 0;
            const float* hp = (const float*)(ws + WS_Y) + ((size_t)mat * 4096 + (size_t)((bg >> 2) * NCMP + ic) * 4 + (bg & 3)) * 1024 + F.lane * 4;
            hs[q] = *(const GAS f32x4*)(((const float*)(ws + WS_CBIAS)) + mat * 256 + F.lane * 4);
#pragma unroll
            for (int ks = 0; ks < 4; ++ks) hs[q] = hs[q] + *(const GAS f32x4*)(hp + ks * 256); }
        float hh_[4][4], ac[4][4];
#pragma unroll
        for (int q = 0; q < 4; ++q) { const f32x2 ga = pg8::gelu_pk((f32x2){hs[q].x, hs[q].y}), gb = pg8::gelu_pk((f32x2){hs[q].z, hs[q].w});
            hh_[q][0] = ga.x; hh_[q][1] = ga.y; hh_[q][2] = gb.x; hh_[q][3] = gb.y; ac[q][0] = 0.f; ac[q][1] = 0.f; ac[q][2] = 0.f; ac[q][3] = 0.f; }
#pragma unroll 8
        for (int kk = 0; kk < 64; ++kk) { const f32x4 wv = *(const LAS f32x4*)(w2l + (kk * 64 + F.lane) * 4);
#pragma unroll
            for (int q = 0; q < 4; ++q) { ac[q][0] += rl_f(hh_[q][0], kk) * wv.x; ac[q][1] += rl_f(hh_[q][1], kk) * wv.y; ac[q][2] += rl_f(hh_[q][2], kk) * wv.z; ac[q][3] += rl_f(hh_[q][3], kk) * wv.w; } }
#pragma unroll
        for (int q = 0; q < 4; ++q) { const int r = rb + q * rstep; if (r < 4096) {
            const int bg = r >> 7, i = r & 127;
            const float acc = i < NCMP ? (ac[q][0] + ac[q][1]) + (ac[q][2] + ac[q][3]) : 0.f;
            if (mat == 0) { const float ss = wave_sum(acc * acc); const float rs = 1.f / sqrtf(ss * (1.f / 64.f) + RMS_EPS);
                const int d = F.lane, dc = d >> 3;
                kc[((size_t)bg * 4 + (i >> 5)) * 2048 + (dc >> 1) * 512 + ((dc & 1) * 32 + (i & 31)) * 8 + (d & 7)] = (f16)(i < NCMP ? acc * rs * F.in[I_KNW][F.lane] : 0.f); }
            else { const int kap = i & 15, pp = ((kap >> 2) & 1) * 8 + (kap >> 3) * 4 + (kap & 3);
                const int d = F.lane;
                vt[((size_t)bg * 4 + (i >> 5)) * 2048 + ((d >> 5) * 2 + ((i >> 4) & 1)) * 512 + ((pp >> 3) * 32 + (d & 31)) * 8 + (pp & 7)] = (f16)acc; } } }
    }
    __syncthreads();
}

__device__ __forceinline__ int t5_bucket(int rel) {
    if (rel < 16) return rel;
    int b = 16;
    b += rel >= 19; b += rel >= 21; b += rel >= 24; b += rel >= 27; b += rel >= 31; b += rel >= 35; b += rel >= 40; b += rel >= 46;
    b += rel >= 52; b += rel >= 59; b += rel >= 67; b += rel >= 77; b += rel >= 87; b += rel >= 99; b += rel >= 113;
    return b;
}
__device__ __forceinline__ int med3i(int a, int lo, int hi) { return a < lo ? lo : (a > hi ? hi : a); }
__device__ __forceinline__ float other_half_max(float x) { const auto r = __builtin_amdgcn_permlane32_swap(__float_as_uint(x), __float_as_uint(x), false, false); return fmaxf(__uint_as_float(r[0]), __uint_as_float(r[1])); }
__device__ __forceinline__ float both_halves_sum(float x) { const auto r = __builtin_amdgcn_permlane32_swap(__float_as_uint(x), __float_as_uint(x), false, false); return __uint_as_float(r[0]) + __uint_as_float(r[1]); }
struct AFrag { f16x8 k[4]; f16x8 v[2][2]; };
__device__ __forceinline__ void attn_load(AFrag& f, const f16* Kp, const f16* Vp, int kt, int r31, int hh) {
    const f16* kp = Kp + (size_t)kt * 2048 + (hh * 32 + r31) * 8; const f16* vp = Vp + (size_t)kt * 2048 + (hh * 32 + r31) * 8;
#pragma unroll
    for (int ks = 0; ks < 4; ++ks) f.k[ks] = *(const GAS f16x8*)(kp + ks * 512);
#pragma unroll
    for (int dt = 0; dt < 2; ++dt)
#pragma unroll
        for (int s2 = 0; s2 < 2; ++s2) f.v[dt][s2] = *(const GAS f16x8*)(vp + (dt * 2 + s2) * 512);
}
__device__ __forceinline__ f16x8 pack8(const f32x16& c, int s2) {
    f16x8 o;
#pragma unroll
    for (int j = 0; j < 8; ++j) o[j] = (f16)c[8 * s2 + j];
    return o;
}
__device__ __forceinline__ void attn_tile(const AFrag& f, const f16x8 (&bq)[4], int kt, int t0, int t, int hh, int wlim, unsigned selm, float cfar, const LAS float* lutr,
                                          float& mrun, float& lrun, f32x16& O0, f32x16& O1) {
    f32x16 S;
#pragma unroll
    for (int i = 0; i < 16; ++i) S[i] = 0.f;
#pragma unroll
    for (int ks = 0; ks < 4; ++ks) S = __builtin_amdgcn_mfma_f32_32x32x16_f16(f.k[ks], bq[ks], S, 0, 0, 0);
    const int k0 = kt * 32, minrel = t0 - (k0 + 31), maxrel = t0 + 7 - k0;
    const bool selbit = ((selm >> (kt >> 1)) & 1u) != 0u;
    if (minrel >= 113 && maxrel < wlim) {
        const float addc = selbit ? cfar : -2e30f;
#pragma unroll
        for (int i = 0; i < 16; ++i) S[i] += addc;
    } else {
        const unsigned wl = selbit ? (unsigned)wlim : 0u; const int relb = t - k0 - 4 * hh;
        float bias[16];
#pragma unroll
        for (int i = 0; i < 16; ++i) bias[i] = lutr[med3i(relb - ((i & 3) + 8 * (i >> 2)), 0, 127)];
#pragma unroll
        for (int i = 0; i < 16; ++i) asm volatile("" : "+v"(bias[i]));
#pragma unroll
        for (int i = 0; i < 16; ++i) { const int rel = relb - ((i & 3) + 8 * (i >> 2)); S[i] = ((unsigned)rel < wl) ? S[i] + bias[i] : -2e30f; }
    }
    float tmax = S[0];
#pragma unroll
    for (int i = 1; i < 16; ++i) tmax = fmaxf(tmax, S[i]);
    tmax = other_half_max(tmax);
    const float mnew = fmaxf(mrun, tmax), alpha = __builtin_amdgcn_exp2f(mrun - mnew);
    mrun = mnew; lrun *= alpha;
#pragma unroll
    for (int i = 0; i < 16; ++i) { O0[i] *= alpha; O1[i] *= alpha; }
#pragma unroll
    for (int i = 0; i < 16; ++i) { const float pv = __builtin_amdgcn_exp2f(S[i] - mnew); lrun += pv; S[i] = pv; }
#pragma unroll
    for (int s2 = 0; s2 < 2; ++s2) { const f16x8 pb = pack8(S, s2);
        O0 = __builtin_amdgcn_mfma_f32_32x32x16_f16(f.v[0][s2], pb, O0, 0, 0, 0); O1 = __builtin_amdgcn_mfma_f32_32x32x16_f16(f.v[1][s2], pb, O1, 0, 0, 0); }
}
__device__ __forceinline__ void attn_branch(const f16* Kp, const f16* Vp, unsigned long long tm, const f16x8 (&bq)[4], int t0, int t, int r31, int hh, int wlim, unsigned selm, float cfar,
                                            const LAS float* lutr, float gate, LAS float* TL) {
    float mrun = -1e30f, lrun = 0.f; f32x16 O0, O1;
#pragma unroll
    for (int i = 0; i < 16; ++i) { O0[i] = 0.f; O1[i] = 0.f; }
    AFrag fA, fB;
    int ktA = __builtin_ctzll(tm), ktB;
    attn_load(fA, Kp, Vp, ktA, r31, hh);
    for (;;) {
        tm &= tm - 1; const bool hasB = tm != 0ull; ktB = hasB ? __builtin_ctzll(tm) : ktA; attn_load(fB, Kp, Vp, ktB, r31, hh);
        attn_tile(fA, bq, ktA, t0, t, hh, wlim, selm, cfar, lutr, mrun, lrun, O0, O1);
        if (!hasB) break;
        tm &= tm - 1; const bool hasA = tm != 0ull; ktA = hasA ? __builtin_ctzll(tm) : ktB; attn_load(fA, Kp, Vp, ktA, r31, hh);
        attn_tile(fB, bq, ktB, t0, t, hh, wlim, selm, cfar, lutr, mrun, lrun, O0, O1);
        if (!hasA) break;
    }
    lrun = both_halves_sum(lrun);
    const float sc = gate / fmaxf(lrun, 1e-30f);
#pragma unroll
    for (int i = 0; i < 16; ++i) { TL[i * 64] += O0[i] * sc; TL[(16 + i) * 64] += O1[i] * sc; }
}
__device__ __forceinline__ void p5_attention(Frame& F) {
    unsigned char* ws = F.ws;
    const f16* Y = (const f16*)(ws + WS_Y);
    const float* gates = (const float*)(ws + WS_GATES);
    f16* CAT = (f16*)(ws + WS_CAT);
    LAS float* wl = (LAS float*)(F.lds + F.wave * 8192);
    LAS float* LUT = wl;
    const int gw = F.vcu * NWAVES + F.wave, NW = F.G * NWAVES;
    const bool snake = (8192 % (2 * NW)) == 0;
    int lut_g = -1;
    LAS unsigned* SELM = (LAS unsigned*)(wl + 1280);
    for (int it = gw, rr = 0; it < 8192; it += NW, ++rr) {
        const int n = (snake && (rr & 1)) ? (rr * NW + (NW - 1 - gw)) : it;
        const int bg = n >> 8, pos = n & 255, b = bg >> 2, g = bg & 3, t0 = pos * 8;
        int lane = F.lane; asm volatile("" : "+v"(lane));
        const int r31 = lane & 31, hh = lane >> 5, tok8 = r31 >> 2, r = r31 & 3;
        const LAS float* lutr = LUT + r * 128;
        if (g != lut_g) {
            LDS_WAIT(); asm volatile("" ::: "memory");
#pragma unroll
            for (int e = 0; e < 2; ++e) { const int rel = lane + 64 * e, bk = t5_bucket(rel);
#pragma unroll
                for (int r4 = 0; r4 < 4; ++r4) LUT[r4 * 128 + rel] = F.in[I_RELB][bk * 16 + 4 * g + r4] * LOG2E; }
            LDS_WAIT(); asm volatile("" ::: "memory");
            lut_g = g;
        }
        const int t = t0 + tok8, head = 4 * g + r; const size_t m = (size_t)b * SEQ + t;
        f16x8 bq[4];
#pragma unroll
        for (int ks = 0; ks < 4; ++ks) bq[ks] = *(const GAS f16x8*)((const f16*)(ws + WS_QN) + m * 1024 + head * 64 + ks * 16 + hh * 8);
        const float g_c = gates[m * 48 + head * 3 + 0], g_s = gates[m * 48 + head * 3 + 1], g_w = gates[m * 48 + head * 3 + 2];
        const float cfar = lutr[127];
        LAS float* TL = (LAS float*)(F.lds + 65536 + F.wave * 8192) + lane;
        {
            const f16* kc = (const f16*)(ws + WS_KCMP) + (size_t)bg * 128 * 64;
            const f16* vc = (const f16*)(ws + WS_VCMPT) + (size_t)bg * 64 * 128;
            f32x16 c[4];
#pragma unroll
            for (int kt = 0; kt < 4; ++kt) {
#pragma unroll
                for (int i = 0; i < 16; ++i) c[kt][i] = 0.f;
#pragma unroll
                for (int ks = 0; ks < 4; ++ks) { const f16x8 a = *(const GAS f16x8*)(kc + kt * 2048 + ks * 512 + (hh * 32 + r31) * 8); c[kt] = __builtin_amdgcn_mfma_f32_32x32x16_f16(a, bq[ks], c[kt], 0, 0, 0); }
                asm volatile("" ::: "memory");
            }
            const int relb = t - 31 - 64 * hh; float mx = -1e30f;
#pragma unroll
            for (int kt = 0; kt < 4; ++kt) { float bias[16];
#pragma unroll
                for (int i = 0; i < 16; ++i) { const int rel = relb - 16 * (kt * 32 + (i & 3) + 8 * (i >> 2)); bias[i] = lutr[med3i(rel, 0, 127)]; }
#pragma unroll
                for (int i = 0; i < 16; ++i) asm volatile("" : "+v"(bias[i]));
#pragma unroll
                for (int i = 0; i < 16; ++i) { const int rel = relb - 16 * (kt * 32 + (i & 3) + 8 * (i >> 2));
                    const float sv = rel >= 0 ? c[kt][i] + bias[i] : -2e30f; c[kt][i] = sv; mx = fmaxf(mx, sv); }
                asm volatile("" ::: "memory"); }
            mx = other_half_max(mx);
            float l = 0.f;
#pragma unroll
            for (int kt = 0; kt < 4; ++kt)
#pragma unroll
                for (int i = 0; i < 16; ++i) { const float pv = __builtin_amdgcn_exp2f(c[kt][i] - mx); c[kt][i] = pv; l += pv; }
            l = both_halves_sum(l);
            const float inv = 1.f / fmaxf(l, 1e-30f);
#pragma unroll
            for (int kt = 0; kt < 4; ++kt)
#pragma unroll
                for (int jj = 0; jj < 4; ++jj) { float own = (2.f * (c[kt][4 * jj] + c[kt][4 * jj + 1] + c[kt][4 * jj + 2]) + c[kt][4 * jj + 3]) * inv, p3 = c[kt][4 * jj + 3] * inv;
                    own += dpp_f<0xB1>(own); own += dpp_f<0x4E>(own); p3 += dpp_f<0xB1>(p3); p3 += dpp_f<0x4E>(p3);
                    if (r == 0) { const int j = kt * 8 + 2 * jj + hh; wl[512 + tok8 * 32 + j] = own; wl[768 + tok8 * 32 + j] = p3; } }
            f32x16 O0, O1;
#pragma unroll
            for (int i = 0; i < 16; ++i) { O0[i] = 0.f; O1[i] = 0.f; }
#pragma unroll
            for (int kt = 0; kt < 4; ++kt)
#pragma unroll
                for (int s2 = 0; s2 < 2; ++s2) { const f16x8 pb = pack8(c[kt], s2);
                    const f16x8 a0 = *(const GAS f16x8*)(vc + kt * 2048 + s2 * 512 + (hh * 32 + r31) * 8), a1 = *(const GAS f16x8*)(vc + kt * 2048 + (2 + s2) * 512 + (hh * 32 + r31) * 8);
                    O0 = __builtin_amdgcn_mfma_f32_32x32x16_f16(a0, pb, O0, 0, 0, 0); O1 = __builtin_amdgcn_mfma_f32_32x32x16_f16(a1, pb, O1, 0, 0, 0); asm volatile("" ::: "memory"); }
            const float sc = inv * g_c;
#pragma unroll
            for (int i = 0; i < 16; ++i) { TL[i * 64] = O0[i] * sc; TL[(16 + i) * 64] = O1[i] * sc; }
        }
        LDS_WAIT(); asm volatile("" ::: "memory");
        int lane2 = lane; asm volatile("" : "+v"(lane2));
        LAS float* OWN = wl + 512 + (lane2 >> 5) * 32 + (lane2 & 31); LAS float* P3 = OWN + 256; LAS float* VAL = OWN + 512;
#pragma unroll
        for (int pp = 0; pp < 4; ++pp) { const int tk = 2 * pp + hh, j = r31, cur = (t0 + tk) >> 6;
            const float impv = OWN[pp * 64] + (j > 0 ? P3[pp * 64 - (j > 0 ? 1 : 0)] : 0.f);
            VAL[pp * 64] = (j == 0 || j == cur || j == cur - 1) ? 1e4f : (j <= cur ? impv : -1e30f); }
        LDS_WAIT(); asm volatile("" ::: "memory");
#pragma unroll
        for (int pp = 0; pp < 4; ++pp) { const int tk = 2 * pp + hh, j = r31, cur = (t0 + tk) >> 6; const float v = VAL[pp * 64]; int cnt = 0; const LAS float* vrow = VAL + pp * 64 - j;
#pragma unroll
            for (int j2 = 0; j2 < 32; ++j2) { const float o = vrow[j2]; cnt += (o > v || (o == v && j2 < j)) ? 1 : 0; }
            const unsigned long long bm = __ballot(cnt < 8 && j <= cur);
            const unsigned mym = hh ? (unsigned)(bm >> 32) : (unsigned)bm;
            if (j == 0) SELM[tk] = mym; }
        LDS_WAIT(); asm volatile("" ::: "memory");
        const unsigned selm = SELM[tok8];
        unsigned um = 0u;
#pragma unroll
        for (int i = 0; i < 8; ++i) um |= SELM[i];
        um = (unsigned)__builtin_amdgcn_readfirstlane((int)um);
        const int kthi = (t0 + 7) >> 5;
        const unsigned long long causal = (kthi >= 63) ? ~0ull : ((1ull << (kthi + 1)) - 1ull);
        {
            unsigned long long x = um;
            x = (x | (x << 16)) & 0x0000FFFF0000FFFFull; x = (x | (x << 8)) & 0x00FF00FF00FF00FFull; x = (x | (x << 4)) & 0x0F0F0F0F0F0F0F0Full;
            x = (x | (x << 2)) & 0x3333333333333333ull; x = (x | (x << 1)) & 0x5555555555555555ull;
            const unsigned long long tm = (x | (x << 1)) & causal;
            attn_branch((const f16*)(ws + WS_KN) + (size_t)bg * SEQ * 64, (const f16*)(ws + WS_VT) + (size_t)bg * 64 * SEQ, tm, bq, t0, t, r31, hh, 1 << 30, selm, cfar, lutr, g_s, TL);
        }
        {
            const int lo = t0 - 511 > 0 ? (t0 - 511) >> 5 : 0;
            const unsigned long long tm = causal & ~((1ull << lo) - 1ull);
            attn_branch((const f16*)(ws + WS_KN) + (size_t)(BATCH * 4 + bg) * SEQ * 64, (const f16*)(ws + WS_VT) + (size_t)(BATCH * 4 + bg) * 64 * SEQ, tm, bq, t0, t, r31, hh, 512, 0xFFFFFFFFu, cfar, lutr, g_w, TL);
        }
        f16* orow = CAT + m * D + 1024 + head * 64 + 4 * hh;
#pragma unroll
        for (int jj = 0; jj < 4; ++jj) {
            u32x2 o0; o0.x = pk_f16(TL[(4 * jj) * 64], TL[(4 * jj + 1) * 64]); o0.y = pk_f16(TL[(4 * jj + 2) * 64], TL[(4 * jj + 3) * 64]); *(GAS u32x2*)(orow + 8 * jj) = o0;
            u32x2 o1; o1.x = pk_f16(TL[(16 + 4 * jj) * 64], TL[(16 + 4 * jj + 1) * 64]); o1.y = pk_f16(TL[(16 + 4 * jj + 2) * 64], TL[(16 + 4 * jj + 3) * 64]); *(GAS u32x2*)(orow + 32 + 8 * jj) = o1; }
    }
}

__device__ __forceinline__ void cvt_row_fp6(const f32x4 (&v)[8], int row, unsigned char* dst6, float* scales, int lane) {
    float amax = 0.f;
#pragma unroll
    for (int c = 0; c < 8; ++c) amax = fmaxf(amax, fmaxf(fmaxf(fabsf(v[c].x), fabsf(v[c].y)), fmaxf(fabsf(v[c].z), fabsf(v[c].w))));
    amax = wave_max(amax);
    const float scale = amax > 0.f ? amax * (1.f / 7.5f) : 1.f, inv = 1.f / scale;
    f16x32 h;
#pragma unroll
    for (int c = 0; c < 8; ++c) { h[4 * c] = (f16)(v[c].x * inv); h[4 * c + 1] = (f16)(v[c].y * inv); h[4 * c + 2] = (f16)(v[c].z * inv); h[4 * c + 3] = (f16)(v[c].w * inv); }
    const u32x6 pk = __builtin_amdgcn_cvt_scalef32_pk32_fp6_f16(h, 1.0f);
    unsigned char* d = dst6 + (size_t)(lane >> 3) * SLICE6;
    *(GAS u32x4*)(d + (size_t)row * 128 + (lane & 7) * 16) = (u32x4){pk[0], pk[1], pk[2], pk[3]}; *(GAS u32x2*)(d + 2097152 + (size_t)row * 64 + (lane & 7) * 8) = (u32x2){pk[4], pk[5]};
    if (lane == 0) scales[row] = scale;
}
__device__ __forceinline__ void cvt_table_fp6(Frame& F, const float* src, unsigned char* dst6, float* scales, const float* colw) {
    const int gw = F.vcu * NWAVES + F.wave, NGW = F.G * NWAVES, lane = F.lane;
    int row = gw;
    for (; row + NGW < 16384; row += 2 * NGW) {
        f32x4 va[8], vb[8];
#pragma unroll
        for (int c = 0; c < 8; ++c) { va[c] = __builtin_nontemporal_load((const GAS f32x4*)(src + (size_t)row * D + c * 256 + lane * 4)); vb[c] = __builtin_nontemporal_load((const GAS f32x4*)(src + (size_t)(row + NGW) * D + c * 256 + lane * 4)); }
        if (colw) {
#pragma unroll
            for (int c = 0; c < 8; ++c) { const f32x4 wv = *(const GAS f32x4*)(colw + c * 256 + lane * 4); va[c] = va[c] * wv; vb[c] = vb[c] * wv; } }
        cvt_row_fp6(va, row, dst6, scales, lane); cvt_row_fp6(vb, row + NGW, dst6, scales, lane);
    }
    for (; row < 16384; row += NGW) { f32x4 va[8];
#pragma unroll
        for (int c = 0; c < 8; ++c) { va[c] = *(const GAS f32x4*)(src + (size_t)row * D + c * 256 + lane * 4); if (colw) va[c] = va[c] * *(const GAS f32x4*)(colw + c * 256 + lane * 4); }
        cvt_row_fp6(va, row, dst6, scales, lane); }
}
__device__ __forceinline__ void p7_tables(Frame& F) {
    cvt_table_fp6(F, F.in[I_PU], F.ws + WS_U6, (float*)(F.ws + WS_SU), F.in[I_FFNNW]);
    cvt_table_fp6(F, F.in[I_PV], F.ws + WS_V6, (float*)(F.ws + WS_SV), nullptr);
}

__device__ __forceinline__ void bitonic_sort16_desc(float (&a)[16]) {
#pragma unroll
    for (int k = 2; k <= 16; k <<= 1)
#pragma unroll
        for (int j = k >> 1; j > 0; j >>= 1)
#pragma unroll
            for (int i = 0; i < 16; ++i) { const int l = i ^ j; if (l > i) { const float hi = fmaxf(a[i], a[l]), lo = fminf(a[i], a[l]); if ((i & k) == 0) { a[i] = hi; a[l] = lo; } else { a[i] = lo; a[l] = hi; } } }
}
__device__ __forceinline__ void bitonic_merge16_desc(float (&a)[16]) {
#pragma unroll
    for (int dist = 8; dist >= 1; dist >>= 1)
#pragma unroll
        for (int i = 0; i < 16; ++i) if ((i & dist) == 0) { const float hi = fmaxf(a[i], a[i + dist]), lo = fminf(a[i], a[i + dist]); a[i] = hi; a[i + dist] = lo; }
}
#define INS16(top, v) do { _Pragma("unroll") for (int _j = 0; _j < 16; ++_j) { const float _h = fmaxf(top[_j], v); v = fminf(top[_j], v); top[_j] = _h; } } while (0)
#define INS16P(tv, ti, v, i) do { _Pragma("unroll") for (int _j = 0; _j < 16; ++_j) { const bool _c = v > tv[_j]; const float _nv = _c ? tv[_j] : v; const unsigned _ni = _c ? ti[_j] : i; \
        tv[_j] = _c ? v : tv[_j]; ti[_j] = _c ? i : ti[_j]; v = _nv; i = _ni; } } while (0)
typedef unsigned v4u_t __attribute__((__vector_size__(16)));
typedef unsigned v2u_t __attribute__((__vector_size__(8)));
__device__ __forceinline__ void p9a_topk(Frame& F) {
    unsigned char* ws = F.ws;
    const f16* QP = (const f16*)(ws + WS_QP); const f16* KEYS = (const f16*)(ws + WS_KEYS);
    unsigned* LIDX = (unsigned*)(ws + WS_LIDX); float* LG = (float*)(ws + WS_LG);
    const int lane = F.lane, r31 = lane & 31, hh = lane >> 5;
    const float NINF = -__builtin_inff();
    for (int unit = F.vcu; unit < M / 32; unit += F.G) {
        const int m0 = unit * 32;
        {
            const int h = F.wave;
            float sl[2][16];
            f16x8 bq[2][8];
#pragma unroll
            for (int p = 0; p < 2; ++p)
#pragma unroll
                for (int ks = 0; ks < 8; ++ks) bq[p][ks] = *(const GAS f16x8*)(QP + (size_t)(m0 + r31) * D + (h * 2 + p) * 128 + ks * 16 + hh * 8);
            f16x8 ka[2][8];
#pragma unroll
            for (int ks = 0; ks < 8; ++ks) ka[0][ks] = *(const GAS f16x8*)(KEYS + ((size_t)((h * 2) * 128 + r31)) * 128 + hh * 8 + ks * 16);
            float top[16];
#pragma unroll
            for (int st = 0; st < 8; ++st) { const int p = st >> 2, kt = st & 3;
                if (kt == 0) {
#pragma unroll
                    for (int j = 0; j < 16; ++j) top[j] = NINF; }
                if (st + 1 < 8) { const int pn = (st + 1) >> 2, ktn = (st + 1) & 3;
#pragma unroll
                    for (int ks = 0; ks < 8; ++ks) ka[(st + 1) & 1][ks] = *(const GAS f16x8*)(KEYS + ((size_t)((h * 2 + pn) * 128 + ktn * 32 + r31)) * 128 + hh * 8 + ks * 16); }
                f32x16 c;
#pragma unroll
                for (int i = 0; i < 16; ++i) c[i] = 0.f;
#pragma unroll
                for (int ks = 0; ks < 8; ++ks) c = __builtin_amdgcn_mfma_f32_32x32x16_f16(ka[st & 1][ks], bq[p][ks], c, 0, 0, 0);
                const unsigned k4 = (unsigned)(kt * 32 + 4 * hh);
                float nv[16];
#pragma unroll
                for (int reg = 0; reg < 16; ++reg) { const unsigned key = k4 + (unsigned)((reg & 3) + 8 * (reg >> 2)); nv[reg] = __uint_as_float((__float_as_uint(c[reg]) & ~127u) | key); }
                bitonic_sort16_desc(nv);
#pragma unroll
                for (int j = 0; j < 16; ++j) top[j] = fmaxf(top[j], nv[15 - j]);
                bitonic_merge16_desc(top);
                if (kt == 3) {
                    float cm[16];
#pragma unroll
                    for (int j = 0; j < 16; ++j) cm[j] = fmaxf(top[j], __uint_as_float(other32u(__float_as_uint(top[15 - j]), hh != 0)));
                    bitonic_merge16_desc(cm);
#pragma unroll
                    for (int j = 0; j < 16; ++j) sl[p][j] = cm[j]; }
            }
            float vx[16], vy[16]; unsigned ix[16], iy[16];
#pragma unroll
            for (int j = 0; j < 16; ++j) { const unsigned bx = __float_as_uint(hh ? sl[1][j] : sl[0][j]), by = __float_as_uint(hh ? sl[0][j] : sl[1][j]);
                vx[j] = __uint_as_float(bx & ~127u); vy[j] = __uint_as_float(by & ~127u); ix[j] = (bx & 127u) * (hh ? 1u : 128u); iy[j] = (by & 127u) * (hh ? 128u : 1u); }
            float tv[16]; unsigned ti[16];
#pragma unroll
            for (int j = 0; j < 16; ++j) { const int jb = j + 1 < 16 ? j + 1 : 15;
                const float v0 = vx[0] + vy[j], v1 = (j < 15) ? vx[0] + vy[jb] : NINF; const unsigned i0 = ix[0] + iy[j], i1 = ix[0] + iy[jb];
                tv[j] = hh ? v1 : v0; ti[j] = hh ? i1 : i0; }
#pragma unroll
            for (int a = 1; a < 4; ++a) { const int bmax = (a == 1) ? 7 : (a == 2 ? 4 : 3);
#pragma unroll
                for (int b = a; b <= bmax; ++b) { float v = vx[a] + vy[b]; if (a == b) v = hh ? NINF : v; unsigned i = ix[a] + iy[b]; INS16P(tv, ti, v, i); } }
            float mv[16]; unsigned mi[16];
#pragma unroll
            for (int j = 0; j < 16; ++j) { const float pv = __uint_as_float(other32u(__float_as_uint(tv[15 - j]), hh != 0)); const unsigned pi = other32u(ti[15 - j], hh != 0); const bool c = pv > tv[j]; mv[j] = c ? pv : tv[j]; mi[j] = c ? pi : ti[j]; }
            float mx = mv[0];
#pragma unroll
            for (int j = 1; j < 16; ++j) mx = fmaxf(mx, mv[j]);
            float sum = 0.f;
#pragma unroll
            for (int j = 0; j < 16; ++j) { mv[j] = __builtin_amdgcn_exp2f((mv[j] - mx) * LOG2E); sum += mv[j]; }
            const float inv = 1.f / sum;
#pragma unroll
            for (int j = 0; j < 8; ++j) { { const int e_ = h * 16 + hh * 8 + j, pos_ = (e_ & 63) * 2 + (e_ >> 6); LIDX[(size_t)(m0 + r31) * 128 + pos_] = mi[j]; LG[(size_t)(m0 + r31) * 128 + pos_] = mv[j] * inv; } }
        }
    }
}
struct Seg6 { v4u_t a; v2u_t b; };
__device__ __forceinline__ f16x32 seg6_decode(const Seg6& r) { const u32x6 p = {r.a[0], r.a[1], r.a[2], r.a[3], r.b[0], r.b[1]}; return __builtin_amdgcn_cvt_scalef32_pk32_f16_fp6(p, 1.0f); }
__device__ __forceinline__ f16x32 seg6_dec2(const v4u_t& a, const v2u_t& b) { const u32x6 p = {a[0], a[1], a[2], a[3], b[0], b[1]}; return __builtin_amdgcn_cvt_scalef32_pk32_f16_fp6(p, 1.0f); }
#define SEG_DECL(P) v4u_t P##a0, P##a1, P##a2, P##a3, P##a4, P##a5, P##a6, P##a7; v2u_t P##b0, P##b1, P##b2, P##b3, P##b4, P##b5, P##b6, P##b7
#define SEG_L1(P, G, idxv) do { const int e_ = __shfl(idxv, 8 * G + sub); P##a##G = __builtin_amdgcn_raw_buffer_load_b128(rs, e_ * 128 + ch * 16, 0, 0); P##b##G = __builtin_amdgcn_raw_buffer_load_b64(rs, 2097152 + e_ * 64 + ch * 8, 0, 0); } while (0)
#define SEG_LOAD(P, idxv) do { SEG_L1(P, 0, idxv); SEG_L1(P, 1, idxv); SEG_L1(P, 2, idxv); SEG_L1(P, 3, idxv); SEG_L1(P, 4, idxv); SEG_L1(P, 5, idxv); SEG_L1(P, 6, idxv); SEG_L1(P, 7, idxv); } while (0)
__device__ __forceinline__ float u_one(const v4u_t& a, const v2u_t& b, const f16x2 (&xp)[16]) {
    const f16x32 hv = seg6_dec2(a, b); float sdot = 0.f;
#pragma unroll
    for (int k = 0; k < 16; ++k) { f16x2 hp; hp.x = hv[2 * k]; hp.y = hv[2 * k + 1]; sdot = __builtin_amdgcn_fdot2(hp, xp[k], sdot, false); }
    return sum8(sdot);
}
#define SEG_LE(P, G, ev) do { const int e_ = (ev); P##a##G = __builtin_amdgcn_raw_buffer_load_b128(rs, e_ * 128 + ch * 16, 0, 0); P##b##G = __builtin_amdgcn_raw_buffer_load_b64(rs, 2097152 + e_ * 64 + ch * 8, 0, 0); } while (0)
#define EN_GATHER(en, iA, iB) do { _Pragma("unroll") for (int g_ = 0; g_ < 8; ++g_) { en[g_] = __shfl(iA, 8 * g_ + sub); en[8 + g_] = __shfl(iB, 8 * g_ + sub); } } while (0)
#define U_ROLL1(P, G, res, eo) do { const float d_ = u_one(P##a##G, P##b##G, xp); res = (ch == G) ? d_ : res; SEG_LE(P, G, en[(eo) + G]); } while (0)
#define U_ROLL(P, res, idxn) do { U_ROLL1(P, 0, res, idxn); U_ROLL1(P, 1, res, idxn); U_ROLL1(P, 2, res, idxn); U_ROLL1(P, 3, res, idxn); U_ROLL1(P, 4, res, idxn); U_ROLL1(P, 5, res, idxn); U_ROLL1(P, 6, res, idxn); U_ROLL1(P, 7, res, idxn); } while (0)
#define V_ROLL1(P, G, hwv, eo) do { v_one(P##a##G, P##b##G, acc, hq[(eo) + G]); SEG_LE(P, G, en[(eo) + G]); } while (0)
#define V_ROLL(P, hwv, idxn) do { V_ROLL1(P, 0, hwv, idxn); V_ROLL1(P, 1, hwv, idxn); V_ROLL1(P, 2, hwv, idxn); V_ROLL1(P, 3, hwv, idxn); V_ROLL1(P, 4, hwv, idxn); V_ROLL1(P, 5, hwv, idxn); V_ROLL1(P, 6, hwv, idxn); V_ROLL1(P, 7, hwv, idxn); } while (0)
#define FMIXV_LO(a, h, w) asm("v_fma_mix_f32 %0, %1, %2, %0 op_sel_hi:[1,0,0]" : "+v"(a) : "v"(h), "v"(w))
#define FMIXV_HI(a, h, w) asm("v_fma_mix_f32 %0, %1, %2, %0 op_sel:[1,0,0] op_sel_hi:[1,0,0]" : "+v"(a) : "v"(h), "v"(w))
__device__ __forceinline__ void v_one(const v4u_t& a, const v2u_t& b, f16x2 (&acc)[16], f16x2 wq) {
    const f16x32 hv = seg6_dec2(a, b);
#pragma unroll
    for (int k = 0; k < 16; ++k) { f16x2 hp; hp.x = hv[2 * k]; hp.y = hv[2 * k + 1]; acc[k] = __builtin_elementwise_fma(hp, wq, acc[k]); }
}
#define V_HALF(P, hwv) do { v_one(P##a0, P##b0, acc, hwv, sub); v_one(P##a1, P##b1, acc, hwv, 8 + sub); v_one(P##a2, P##b2, acc, hwv, 16 + sub); v_one(P##a3, P##b3, acc, hwv, 24 + sub); \
        v_one(P##a4, P##b4, acc, hwv, 32 + sub); v_one(P##a5, P##b5, acc, hwv, 40 + sub); v_one(P##a6, P##b6, acc, hwv, 48 + sub); v_one(P##a7, P##b7, acc, hwv, 56 + sub); } while (0)
__device__ __forceinline__ void p9b_upass(Frame& F, bool probe_slice0) {
    unsigned char* ws = F.ws;
    const int x = blockIdx.x & 7, rank = blockIdx.x >> 3, cnt = (F.G - x + 7) >> 3;
    const int lane = F.lane, sub = lane >> 3, ch = lane & 7;
    const __amdgpu_buffer_rsrc_t rs = __builtin_amdgcn_make_buffer_rsrc((void*)(ws + WS_U6 + (size_t)(probe_slice0 ? 0 : x) * SLICE6), 0, (int)SLICE6, 0x00020000);
    const f16* XN = (const f16*)(ws + WS_XR) + x * 32 + (lane >> 3) * 256 + (lane & 7) * 4;
    const u32x2* LI2 = (const u32x2*)(ws + WS_LIDX); LAS unsigned char* xl = F.lds + F.wave * 512;
    const int tstep = cnt * NWAVES; int t = rank * NWAVES + F.wave;
    if (t >= M) return;
    int cA, cB, nA, nB; { const u32x2 c2 = LI2[(size_t)t * 64 + lane]; cA = (int)c2.x; cB = (int)c2.y; }
    const int t1c = (t + tstep < M) ? t + tstep : t;
    { const u32x2 n2 = LI2[(size_t)t1c * 64 + lane]; nA = (int)n2.x; nB = (int)n2.y; }
    u32x2 xcur = *(const GAS u32x2*)(XN + (size_t)t * D);
    f16x2 xp[16];
    SEG_DECL(bA); SEG_DECL(bB);
    { const int li_ = cA; SEG_LOAD(bA, li_); } { const int li_ = cB; SEG_LOAD(bB, li_); }
#pragma unroll 1
    for (;;) {
        const int tn = t + tstep, tnn = tn + tstep; const bool hn = tn < M, hnn = tnn < M;
        const int tnc = hn ? tn : t, tnnc = hnn ? tnn : t;
        const u32x2 m2 = LI2[(size_t)tnnc * 64 + lane]; const int mA = (int)m2.x, mB = (int)m2.y;
        const u32x2 xnext = *(const GAS u32x2*)(XN + (size_t)tnc * D);
        *(LAS u32x2*)(xl + ((lane & 7) * 8 + (lane >> 3)) * 8) = xcur;
        LDS_WAIT(); asm volatile("" ::: "memory");
#pragma unroll
        for (int q = 0; q < 4; ++q) { const u32x4 tv = *(const LAS u32x4*)(xl + ch * 64 + q * 16); xp[4 * q] = ash2(tv.x); xp[4 * q + 1] = ash2(tv.y); xp[4 * q + 2] = ash2(tv.z); xp[4 * q + 3] = ash2(tv.w); }
        LDS_WAIT(); asm volatile("" ::: "memory");
        { const int lA_ = hn ? nA : cA, lB_ = hn ? nB : cB; int en[16]; EN_GATHER(en, lA_, lB_);
          float rA = 0.f, rB = 0.f; U_ROLL(bA, rA, 0); U_ROLL(bB, rB, 8);
          float* pd = (float*)(ws + WS_PD) + ((size_t)t * 8 + x) * 128 + 8 * ch + sub; pd[0] = rA; pd[64] = rB; }
        if (!hn) break;
        xcur = xnext;
        cA = nA; cB = nB; nA = mA; nB = mB; t = tn;
    }
}
__device__ __forceinline__ void p9h_weights(Frame& F) {
    unsigned char* ws = F.ws;
    const unsigned* LIDX = (const unsigned*)(ws + WS_LIDX); const float* LG = (const float*)(ws + WS_LG); const float* PD = (const float*)(ws + WS_PD);
    const float* SU = (const float*)(ws + WS_SU); const float* SV = (const float*)(ws + WS_SV); float* HW = (float*)(ws + WS_HW);
    const int gw = F.vcu * NWAVES + F.wave, NGW = F.G * NWAVES, lane = F.lane;
#pragma unroll 1
    for (int t0 = gw; t0 < M; t0 += 2 * NGW) {
        const int t1 = t0 + NGW < M ? t0 + NGW : t0;
        int iA[2], iB[2]; float pa[2][8], pb[2][8], lgA[2], lgB[2], s1[2];
#pragma unroll
        for (int q = 0; q < 2; ++q) { const int t = q ? t1 : t0; { const u32x2 i2 = ((const u32x2*)LIDX)[(size_t)t * 64 + lane]; iA[q] = (int)i2.x; iB[q] = (int)i2.y; }
#pragma unroll
            for (int xs = 0; xs < 8; ++xs) { pa[q][xs] = PD[((size_t)t * 8 + xs) * 128 + lane]; pb[q][xs] = PD[((size_t)t * 8 + xs) * 128 + 64 + lane]; }
            { const f32x2 g2 = ((const f32x2*)LG)[(size_t)t * 64 + lane]; lgA[q] = g2.x; lgB[q] = g2.y; } s1[q] = ((const float*)(ws + WS_SS1))[t]; }
#pragma unroll
        for (int q = 0; q < 2; ++q) { const int t = q ? t1 : t0; float zA = 0.f, zB = 0.f;
#pragma unroll
            for (int xs = 0; xs < 8; ++xs) { zA += pa[q][xs]; zB += pb[q][xs]; }
            const float rs1 = 1.f / sqrtf(s1[q] * (1.f / D) + RMS_EPS);
            ((f32x2*)HW)[(size_t)t * 64 + lane] = (f32x2){pg8::gelu1(zA * rs1 * SU[iA[q]]) * lgA[q] * SV[iA[q]], pg8::gelu1(zB * rs1 * SU[iB[q]]) * lgB[q] * SV[iB[q]]}; }
    }
}
__device__ __forceinline__ void p9c_vpass(Frame& F) {
    unsigned char* ws = F.ws;
    const int x = blockIdx.x & 7, rank = blockIdx.x >> 3, cnt = (F.G - x + 7) >> 3;
    const int lane = F.lane, sub = lane >> 3, ch = lane & 7;
    const __amdgpu_buffer_rsrc_t rs = __builtin_amdgcn_make_buffer_rsrc((void*)(ws + WS_V6 + (size_t)x * SLICE6), 0, (int)SLICE6, 0x00020000);
    const u32x2* LI2 = (const u32x2*)(ws + WS_LIDX);
    f16* XR = (f16*)(ws + WS_XR); float* SS2 = (float*)(ws + WS_SS2);
    const bool b3 = (lane & 8) != 0, b4 = (lane & 16) != 0, b5 = (lane & 32) != 0;
    const int col = ((b3 ? 4 : 0) + (b4 ? 2 : 0) + (b5 ? 1 : 0)) * 256 + x * 32 + ch * 4;
    const int tstep = cnt * NWAVES; int t = rank * NWAVES + F.wave;
    if (t >= M) return;
    int cA, cB, nA, nB; { const u32x2 c2 = LI2[(size_t)t * 64 + lane]; cA = (int)c2.x; cB = (int)c2.y; }
    const int t1c = (t + tstep < M) ? t + tstep : t;
    { const u32x2 n2 = LI2[(size_t)t1c * 64 + lane]; nA = (int)n2.x; nB = (int)n2.y; }
    const f32x2* HW2 = (const f32x2*)(ws + WS_HW);
    float hwA, hwB; { const f32x2 h2 = HW2[(size_t)t * 64 + lane]; hwA = h2.x; hwB = h2.y; }
    SEG_DECL(bA); SEG_DECL(bB);
    { const int li_ = cA; SEG_LOAD(bA, li_); } { const int li_ = cB; SEG_LOAD(bB, li_); }
#pragma unroll 1
    for (;;) {
        const int tn = t + tstep, tnn = tn + tstep; const bool hn = tn < M, hnn = tnn < M;
        const int tnc = hn ? tn : t, tnnc = hnn ? tnn : t;
        const u32x2 m2 = LI2[(size_t)tnnc * 64 + lane]; const int mA = (int)m2.x, mB = (int)m2.y;
        const f32x2 hn2 = HW2[(size_t)tnc * 64 + lane]; const float hwAn = hn2.x, hwBn = hn2.y;
        f16* orow = XR + (size_t)t * D + col; const u32x2 x1r = *(const GAS u32x2*)orow;
        f16x2 acc[16];
#pragma unroll
        for (int i = 0; i < 16; ++i) { acc[i].x = (f16)0.f; acc[i].y = (f16)0.f; }
        { const int lA_ = hn ? nA : cA, lB_ = hn ? nB : cB; int en[16]; EN_GATHER(en, lA_, lB_); f16x2 hq[16];
#pragma unroll
          for (int g_ = 0; g_ < 8; ++g_) { const float qa = __shfl(hwA, 8 * g_ + sub) * 64.f, qb = __shfl(hwB, 8 * g_ + sub) * 64.f;
              hq[g_].x = (f16)qa; hq[g_].y = (f16)qa; hq[8 + g_].x = (f16)qb; hq[8 + g_].y = (f16)qb; }
          V_ROLL(bA, hwA, 0); V_ROLL(bB, hwB, 8); }
        f16x2 q8[8];
#pragma unroll
        for (int i = 0; i < 8; ++i) { const f16x2 keep = b3 ? acc[8 + i] : acc[i], send = b3 ? acc[i] : acc[8 + i]; q8[i] = keep + ash2(other8u(__builtin_bit_cast(unsigned, send))); }
        f16x2 q4[4];
#pragma unroll
        for (int i = 0; i < 4; ++i) { const f16x2 keep = b4 ? q8[4 + i] : q8[i], send = b4 ? q8[i] : q8[4 + i]; q4[i] = keep + ash2(other16u(__builtin_bit_cast(unsigned, send), b4)); }
        float r4[4];
        { const f16x2 k0 = b5 ? q4[2] : q4[0], k1 = b5 ? q4[3] : q4[1], s0 = b5 ? q4[0] : q4[2], s1 = b5 ? q4[1] : q4[3];
          const f16x2 p0 = ash2(other32u(__builtin_bit_cast(unsigned, s0), b5)), p1 = ash2(other32u(__builtin_bit_cast(unsigned, s1), b5));
          r4[0] = ((float)k0.x + (float)p0.x) * (1.f / 64.f); r4[1] = ((float)k0.y + (float)p0.y) * (1.f / 64.f); r4[2] = ((float)k1.x + (float)p1.x) * (1.f / 64.f); r4[3] = ((float)k1.y + (float)p1.y) * (1.f / 64.f); }
        const f16x2 x1a = ash2(x1r.x), x1b = ash2(x1r.y);
        const f32x4 x2 = {(float)x1a.x + r4[0], (float)x1a.y + r4[1], (float)x1b.x + r4[2], (float)x1b.y + r4[3]};
        { u32x2 o2; o2.x = pk_f16(x2.x, x2.y); o2.y = pk_f16(x2.z, x2.w); *(GAS u32x2*)orow = o2; }
        const float ss = wave_sum((x2.x * x2.x + x2.y * x2.y) + (x2.z * x2.z + x2.w * x2.w));
        if (lane == 0) atomicAdd(SS2 + t, ss);
        if (!hn) break;
        cA = nA; cB = nB; nA = mA; nB = mB; t = tn; hwA = hwAn; hwB = hwBn;
    }
}
#undef FMIXV_LO
#undef FMIXV_HI

constexpr int NPH = 13;
struct Args { const float* in[26]; float* out; unsigned char* ws; int ph_lo, ph_hi; int rep[16]; };
__global__ void __launch_bounds__(NWAVES * 64, 2) fwd_kernel(Args args) {
    extern __shared__ __attribute__((aligned(16))) unsigned char lds[];
    Frame F;
    F.lds = (LAS unsigned char*)lds;
    F.MISC = (volatile LAS unsigned*)(F.lds + MISC_OFF);
    F.tid = threadIdx.x; F.lane = F.tid & 63; F.wave = __builtin_amdgcn_readfirstlane(F.tid >> 6);
    F.G = gridDim.x; { const int bx = blockIdx.x; F.vcu = (F.G % 8 == 0) ? (bx % 8) * (F.G / 8) + bx / 8 : bx; }
#pragma unroll
    for (int i = 0; i < 26; ++i) F.in[i] = args.in[i];
    F.out = args.out; F.ws = args.ws;
    unsigned char* ws = args.ws;
    gu32* ctl = (gu32*)(ws + WS_CTL);
    for (int u = F.tid; u < (LDS_BYTES - LDSCTL_OFF) / 4; u += NWAVES * 64) ((LAS unsigned*)(F.lds + LDSCTL_OFF))[u] = 0u;
    __syncthreads();
    XcdBarrier bar; bar.bar = (unsigned*)(ctl + CW_BAR); bar.x = 0; bar.st = nullptr;
    if (MK_ONE_LAUNCH) bar = xcd_barrier_post((unsigned*)(ctl + CW_BAR), F.MISC + 8);
#define GRID_BAR() do { if (MK_ONE_LAUNCH) xcd_barrier(bar); } while (0)
    const int lo = args.ph_lo, hi = args.ph_hi;
#define IN(k) (lo <= (k) && (k) < hi)
#define BOTH(k) (IN(k) && IN((k) + 1))

    if (IN(0)) { for (int rp = 0; rp < args.rep[0]; ++rp) p0_prologue(F); if (BOTH(0)) GRID_BAR(); }

    if (IN(1)) {
        pg8::Gemm g{(const f16*)(ws + WS_XR), (const f16*)(ws + WS_WIN), M, NINP, D, D, D, 0, 1 << 30, 0};
        pg8::StaticOrder S; S.init(M, NINP, F.G, (int)blockIdx.x);
        pg8::EpiF16Row E{(f16*)(ws + WS_Y), NINP, (const float*)(ws + WS_SS0)};
        pg8::gemm_phase(F.lds, g, S, E);
        if (BOTH(1)) GRID_BAR();
    }

    if (IN(2)) { for (int rp = 0; rp < PROBE_REP2; ++rp) p2_post(F); if (BOTH(2)) GRID_BAR(); }

    if (IN(3)) {
        { pg8::Gemm g{(const f16*)(ws + WS_FLATA), (const f16*)(ws + WS_W1C), 8192, 1024, 512, D, D, 512, 16, (size_t)256 * D * 2, 512};
          pg8::StaticOrder S; S.init(8192, 1024, F.G, (int)blockIdx.x);
          pg8::EpiRawF32 E{(float*)(ws + WS_Y), 1024};
          pg8::gemm_phase(F.lds, g, S, E); }
        { pg8::Gemm g{(const f16*)(ws + WS_MIXED), (const f16*)(ws + WS_POOLT), M, 1024, 256, 1024, 256, 256, 1 << 30, 0};
          pg8::StaticOrder S; S.init(M, 1024, F.G, (int)((blockIdx.x + 128) % F.G));
          pg8::EpiF16<0> E{(f16*)(ws + WS_CAT), D, nullptr, 1 << 30, 0};
          pg8::gemm_phase(F.lds, g, S, E); }
        if (BOTH(3)) GRID_BAR();
    }

    if (IN(4)) { p4_compress2(F); if (BOTH(4)) GRID_BAR(); }

    if (IN(5)) { for (int rp = 0; rp < args.rep[5]; ++rp) p5_attention(F); if (BOTH(5)) GRID_BAR(); }

    if (IN(6)) {
        pg8::Gemm g{(const f16*)(ws + WS_CAT), (const f16*)(ws + WS_WOUT), M, D, D, D, D, 0, 1 << 30, 0};
        pg8::StaticOrder S; S.init(M, D, F.G, (int)blockIdx.x);
        pg8::EpiRes16 E{(f16*)(ws + WS_XR), (float*)(ws + WS_SS1)};
        pg8::gemm_phase(F.lds, g, S, E);
        if (BOTH(6)) GRID_BAR();
    }

    if (IN(7)) {
        { pg8::Gemm g{(const f16*)(ws + WS_XR), (const f16*)(ws + WS_WQ), M, D, D, D, D, 0, 1 << 30, 0};
          pg8::StaticOrder S; S.init(M, D, F.G, (int)blockIdx.x);
          pg8::EpiF16Row E{(f16*)(ws + WS_QP), D, (const float*)(ws + WS_SS1)};
          pg8::gemm_phase(F.lds, g, S, E); }
        { pg8::Gemm g{(const f16*)(ws + WS_P16), (const f16*)(ws + WS_WPJ), M, D, 256, 256, 256, 0, 1 << 30, 0};
          pg8::StaticOrder S; S.init(M, D, F.G, (int)blockIdx.x);
          pg8::EpiF16<0> E{(f16*)(ws + WS_PJ), D, nullptr, 1 << 30, 0};
          pg8::gemm_phase(F.lds, g, S, E); }
        for (int rp = 0; rp < args.rep[7]; ++rp) p7_tables(F);
        if (BOTH(7)) GRID_BAR();
    }

    if (IN(8)) { p9a_topk(F); if (BOTH(8)) GRID_BAR(); }
    if (IN(9)) { if (PROBE_DUPU) p9b_upass(F, false); p9b_upass(F, false); if (BOTH(9)) GRID_BAR(); }
    if (IN(10)) { p9h_weights(F); if (BOTH(10)) GRID_BAR(); }
    if (IN(11)) { p9c_vpass(F); if (BOTH(11)) GRID_BAR(); }

    if (IN(12)) {
        pg8::Gemm g{(const f16*)(ws + WS_XR), (const f16*)(ws + WS_WG), M, D, D, D, D, 0, 1 << 30, 0};
        pg8::StaticOrder S; S.init(M, D, F.G, (int)blockIdx.x);
        pg8::EpiFinal E{(const f16*)(ws + WS_XR), (const f16*)(ws + WS_PJ), F.out, (const float*)(ws + WS_SS2)};
        pg8::gemm_phase(F.lds, g, S, E);
    }
#undef IN
#undef BOTH
}

extern "C" void kernel_launch(void* const* d_in, const int* in_sizes, int n_in, void* d_out, int out_size, void* d_ws, size_t ws_size, hipStream_t stream) {
    static int grid = 0;
    if (grid == 0) {
        if (n_in != 26 || out_size != M * D || ws_size < WS_END) { fprintf(stderr, "kernel_launch: unexpected sizes n_in %d out %d ws %zu\n", n_in, out_size, ws_size); grid = -1; return; }
        int dev = 0, cus = 0, per_cu = 0;
        if (hipGetDevice(&dev) != hipSuccess || hipDeviceGetAttribute(&cus, hipDeviceAttributeMultiprocessorCount, dev) != hipSuccess) { grid = -1; return; }
        if (hipFuncSetAttribute((const void*)fwd_kernel, hipFuncAttributeMaxDynamicSharedMemorySize, LDS_BYTES) != hipSuccess) { fprintf(stderr, "kernel_launch: hipFuncSetAttribute failed\n"); grid = -1; return; }
        if (hipOccupancyMaxActiveBlocksPerMultiprocessor(&per_cu, (const void*)fwd_kernel, NWAVES * 64, LDS_BYTES) != hipSuccess || per_cu < 1)
            fprintf(stderr, "kernel_launch: occupancy query reports %d\n", per_cu);
        (void)hipGetLastError();
        grid = cus;
    }
    if (grid < 0) return;
    (void)hipMemsetAsync((char*)d_ws + WS_CTL, 0, CTL_ZERO_BYTES, stream);
    Args a{};
    for (int i = 0; i < 16; ++i) a.rep[i] = 1;
    a.rep[5] = PROBE_REP5; a.rep[0] = PROBE_REP0; a.rep[7] = PROBE_REP7;
    for (int i = 0; i < 26; ++i) a.in[i] = (const float*)d_in[i];
    a.out = (float*)d_out; a.ws = (unsigned char*)d_ws;
    if (MK_ONE_LAUNCH) { a.ph_lo = 0; a.ph_hi = NPH; hipLaunchKernelGGL(fwd_kernel, dim3(grid), dim3(NWAVES * 64), LDS_BYTES, stream, a); }
    else for (int p = 0; p < NPH; ++p) { a.ph_lo = p; a.ph_hi = p + 1; hipLaunchKernelGGL(fwd_kernel, dim3(grid), dim3(NWAVES * 64), LDS_BYTES, stream, a); }
}
```

```cpp
#include <hip/hip_runtime.h>
#include <cstdio>
#include <cstdint>

#define PROBE_REP0 1
#define PROBE_REP2 1
#define PROBE_DUPU 0
#define PROBE_REP5 1
#define PROBE_REP7 1
#define PROBE_REP9 1
#ifndef MK_ONE_LAUNCH
#define MK_ONE_LAUNCH 1
#endif

#define GAS __attribute__((address_space(1)))
#define LAS __attribute__((address_space(3)))
typedef _Float16 f16;
typedef _Float16 f16x8 __attribute__((ext_vector_type(8)));
typedef _Float16 f16x4 __attribute__((ext_vector_type(4)));
typedef _Float16 f16x2 __attribute__((ext_vector_type(2)));
typedef float f32x2 __attribute__((ext_vector_type(2)));
typedef float f32x4 __attribute__((ext_vector_type(4)));
typedef float f32x16 __attribute__((ext_vector_type(16)));
typedef unsigned u32x2 __attribute__((ext_vector_type(2)));
typedef unsigned u32x4 __attribute__((ext_vector_type(4)));
typedef GAS unsigned gu32;
typedef _Float16 f16x32 __attribute__((ext_vector_type(32)));
typedef unsigned u32x6 __attribute__((ext_vector_type(6)));
#define RLX_AGENT __ATOMIC_RELAXED, __HIP_MEMORY_SCOPE_AGENT
#define LDS_WAIT() asm volatile("s_waitcnt lgkmcnt(0)" ::: "memory")
#define VM_WAIT() asm volatile("s_waitcnt vmcnt(0)" ::: "memory")

constexpr int BATCH = 8, SEQ = 2048, D = 2048, M = BATCH * SEQ;
constexpr int NIN = 3632, NINP = 3840;
constexpr int OFF_U = 0, OFF_Q = 1024, OFF_KC = 2048, OFF_VC = 2304, OFF_KS = 2560, OFF_VS = 2816, OFF_KW = 3072, OFF_VW = 3328, OFF_G = 3584;
constexpr int NCMP = 127, NCROWS = BATCH * NCMP * 4;
constexpr float RMS_EPS = 1e-6f;
constexpr float LOG2E = 1.4426950408889634f;

constexpr size_t MiB = 1u << 20;
constexpr size_t WS_CTL = 0, CTL_ZERO_BYTES = 1 * MiB;
constexpr size_t WS_WIN = 2 * MiB, WS_WOUT = 17 * MiB, WS_WQ = 25 * MiB, WS_WG = 33 * MiB, WS_WPJ = 41 * MiB, WS_W1C = 42 * MiB, WS_POOLT = 44 * MiB, WS_KEYS = 45 * MiB;
constexpr size_t WS_CBIAS = 46 * MiB, WS_GATES = 47 * MiB, WS_HC = 50 * MiB, WS_KCMP = 54 * MiB, WS_VCMPT = 54 * MiB + 512 * 1024, WS_P16 = 56 * MiB;
constexpr size_t WS_XN = 64 * MiB;
constexpr size_t WS_Y = 128 * MiB, WS_QP = 128 * MiB, WS_PJ = 192 * MiB;
constexpr size_t WS_MIXED = 256 * MiB, WS_CAT = 288 * MiB, WS_KN = 352 * MiB, WS_VT = 368 * MiB, WS_FLATA = 384 * MiB;
constexpr size_t WS_U6 = 256 * MiB, WS_V6 = 288 * MiB, WS_SU = 320 * MiB, WS_SV = 321 * MiB;
constexpr size_t WS_LIDX = 322 * MiB, WS_LG = 330 * MiB, WS_SSP = 338 * MiB, WS_PD = 340 * MiB, WS_HW = 404 * MiB;
constexpr size_t SLICE6 = (size_t)16384 * 192;
constexpr size_t WS_XR = 416 * MiB;
constexpr size_t WS_SS0 = 768 * 1024, WS_SS1 = 256 * 1024, WS_SS2 = 512 * 1024;
constexpr size_t WS_QN = 480 * MiB;
constexpr size_t WS_END = 512 * MiB;
constexpr int CW_TMO = 0, CW_CODE = 1, CW_BAR = 4096;

constexpr int RING_BYTES = 131072;
constexpr int LDSCTL_OFF = RING_BYTES, MISC_OFF = LDSCTL_OFF + 320;
constexpr int LDS_BYTES = 147456;
constexpr int NWAVES = 8;

__device__ __forceinline__ unsigned pk_f16(float lo, float hi) { f16x2 v; v.x = (f16)lo; v.y = (f16)hi; return __builtin_bit_cast(unsigned, v); }
__device__ __forceinline__ f16x2 ash2(unsigned u) { return __builtin_bit_cast(f16x2, u); }
template <int CTRL> __device__ __forceinline__ float dpp_f(float v) { return __int_as_float(__builtin_amdgcn_update_dpp(0, __float_as_int(v), CTRL, 0xF, 0xF, true)); }
__device__ __forceinline__ float rl_f(float v, int l) { return __int_as_float(__builtin_amdgcn_readlane(__float_as_int(v), l)); }
__device__ __forceinline__ float sum8(float v) { v += dpp_f<0x141>(v); v += dpp_f<0xB1>(v); v += dpp_f<0x4E>(v); return v; }
__device__ __forceinline__ float wave_sum(float v) { v = sum8(v); v += dpp_f<0x140>(v); return (rl_f(v, 0) + rl_f(v, 16)) + (rl_f(v, 32) + rl_f(v, 48)); }
__device__ __forceinline__ float wave_max(float v) { v = fmaxf(v, dpp_f<0x141>(v)); v = fmaxf(v, dpp_f<0xB1>(v)); v = fmaxf(v, dpp_f<0x4E>(v)); v = fmaxf(v, dpp_f<0x140>(v));
    return fmaxf(fmaxf(rl_f(v, 0), rl_f(v, 16)), fmaxf(rl_f(v, 32), rl_f(v, 48))); }

__device__ __forceinline__ unsigned other8u(unsigned x) { return (unsigned)__builtin_amdgcn_update_dpp(0, (int)x, 0x128, 0xF, 0xF, true); }
__device__ __forceinline__ unsigned other16u(unsigned x, bool b4) { const auto r = __builtin_amdgcn_permlane16_swap(x, x, false, false); return b4 ? r[0] : r[1]; }
__device__ __forceinline__ unsigned other32u(unsigned x, bool b5) { const auto r = __builtin_amdgcn_permlane32_swap(x, x, false, false); return b5 ? r[0] : r[1]; }
namespace pg8 {
constexpr int BM = 256, BK = 64, HALF = 128, HTB = HALF * BK * 2, STAGE_BYTES = 8 * HTB, NXCD = 8, WGM = 8;
__host__ __device__ __forceinline__ int lds_byte(int r, int c) { const int st = (r >> 4) * 2 + (c >> 5), rr = r & 15, cc = c & 31, ob = rr * 64 + cc * 2; return st * 1024 + (ob ^ (((ob >> 9) & 1) << 5)); }
__host__ __device__ __forceinline__ void stage_rc(int b, int& R, int& C) { const int st = b / 1024, sb = b % 1024, swz = sb ^ (((sb >> 9) & 1) << 5); R = (st >> 1) * 16 + swz / 64; C = (st & 1) * 32 + (swz % 64) / 2; }
__host__ __device__ __forceinline__ int perm32(int rho) { const int n = rho >> 4, i = rho & 15; return 8 * (i >> 2) + 4 * n + (i & 3); }

struct Unit { int pm, pn; };
struct Gemm { const f16* A; const f16* Bt; int M, N, K, lda, ldb; int a_pn_off; int b_pm_split; size_t b_split_off; int b_pn_k = 0;
    __device__ __forceinline__ const char* aptr(const Unit& u) const { return (const char*)A + ((size_t)u.pm * BM * lda + (size_t)u.pn * a_pn_off) * 2; }
    __device__ __forceinline__ const char* bptr(const Unit& u) const { return (const char*)Bt + (b_pn_k ? (size_t)u.pn * b_pn_k * 2 : (size_t)u.pn * BM * ldb * 2) + (u.pm >= b_pm_split ? b_split_off : (size_t)0); }
};
struct StaticOrder {
    int nM, nN, nwg, G, c;
    __host__ __device__ void init(int M_, int N_, int G_, int c_) { nM = M_ / BM; nN = N_ / BM; nwg = nM * nN; G = G_; c = c_; }
    __host__ __device__ bool next(int i, Unit& u) const {
        const long L = (long)i * G + c; if (L >= nwg) return false;
        int wgid = (int)L; { const int q = nwg / NXCD, r = nwg % NXCD, xcd = wgid % NXCD, off = wgid / NXCD; wgid = (xcd < r ? xcd * (q + 1) : r * (q + 1) + (xcd - r) * q) + off; }
        const int nig = WGM * nN, gid = wgid / nig, fm = gid * WGM, gsz = (nM - fm) < WGM ? (nM - fm) : WGM;
        u.pm = fm + ((wgid % nig) % gsz); u.pn = (wgid % nig) / gsz; return true;
    }
};

__device__ __forceinline__ f32x2 gelu_pk(f32x2 v) {
    const f32x2 av = __builtin_elementwise_abs(v), d = av * 0.2316418882f + 1.0f;
    f32x2 t; t.x = __builtin_amdgcn_rcpf(d.x); t.y = __builtin_amdgcn_rcpf(d.y);
    f32x2 q = t * 0.5307027145f + (-0.7265760135f); q = q * t + 0.7107068705f; q = q * t + (-0.142248368f); q = q * t + 0.127414796f; q = q * t;
    const f32x2 s = (v * v) * (-0.72134752044f);
    f32x2 e; e.x = __builtin_amdgcn_exp2f(s.x); e.y = __builtin_amdgcn_exp2f(s.y);
    const f32x2 m = v * (q * e), r = v - m;
    f32x2 o; o.x = v.x < 0.f ? m.x : r.x; o.y = v.y < 0.f ? m.y : r.y; return o;
}
__device__ __forceinline__ float gelu1(float v) { f32x2 r = gelu_pk((f32x2){v, v}); return r.x; }

template <int ACT> struct EpiF16 {
    static constexpr bool PERM = true;
    f16* O; int ldc; const float* bias; int bias_pm_split; int bias_split_off;
    __device__ __forceinline__ void operator()(const f32x4 (&acc)[2][2][4][2], const Unit& u, int wr, int wc, int fr, int fq) const {
        const int row0 = u.pm * BM + wr * 64 + fr; const int col0 = u.pn * BM + wc * 32 + 8 * fq;
        const float* bp = bias ? bias + (u.pm >= bias_pm_split ? bias_split_off : 0) : nullptr;
        f32x4 bv[2][2];
#pragma unroll
        for (int bj = 0; bj < 2; ++bj)
#pragma unroll
            for (int n = 0; n < 2; ++n) bv[bj][n] = bp ? *(const f32x4*)(bp + col0 + bj * HALF + 4 * n) : (f32x4){0.f, 0.f, 0.f, 0.f};
#pragma unroll
        for (int ai = 0; ai < 2; ++ai)
#pragma unroll
            for (int m = 0; m < 4; ++m) { f16* rowp = O + (size_t)(row0 + ai * HALF + m * 16) * ldc + col0;
#pragma unroll
                for (int bj = 0; bj < 2; ++bj) { f32x4 v0 = acc[ai][bj][m][0] + bv[bj][0], v1 = acc[ai][bj][m][1] + bv[bj][1];
                    if (ACT == 1) { f32x2 a = gelu_pk((f32x2){v0[0], v0[1]}), b = gelu_pk((f32x2){v0[2], v0[3]}), c = gelu_pk((f32x2){v1[0], v1[1]}), d = gelu_pk((f32x2){v1[2], v1[3]});
                        v0 = (f32x4){a.x, a.y, b.x, b.y}; v1 = (f32x4){c.x, c.y, d.x, d.y}; }
                    u32x4 w; w.x = pk_f16(v0[0], v0[1]); w.y = pk_f16(v0[2], v0[3]); w.z = pk_f16(v1[0], v1[1]); w.w = pk_f16(v1[2], v1[3]);
                    *(u32x4*)(rowp + bj * HALF) = w; } }
    }
};
struct EpiRawF32 {
    static constexpr bool PERM = false;
    float* C; int ldc;
    __device__ __forceinline__ void operator()(const f32x4 (&acc)[2][2][4][2], const Unit& u, int wr, int wc, int fr, int fq) const {
        const int row0 = u.pm * BM + wr * 64 + fr, col0 = u.pn * BM + wc * 32 + 4 * fq;
#pragma unroll
        for (int ai = 0; ai < 2; ++ai)
#pragma unroll
            for (int m = 0; m < 4; ++m) { float* rowp = C + (size_t)(row0 + ai * HALF + m * 16) * ldc + col0;
#pragma unroll
                for (int bj = 0; bj < 2; ++bj)
#pragma unroll
                    for (int n = 0; n < 2; ++n) *(f32x4*)(rowp + bj * HALF + n * 16) = acc[ai][bj][m][n]; }
    }
};
struct EpiRes16 {
    static constexpr bool PERM = true;
    f16* XR; float* SS;
    __device__ __forceinline__ void operator()(const f32x4 (&acc)[2][2][4][2], const Unit& u, int wr, int wc, int fr, int fq) const {
        const int row0 = u.pm * BM + wr * 64 + fr; const int col0 = u.pn * BM + wc * 32 + 8 * fq;
#pragma unroll
        for (int ai = 0; ai < 2; ++ai) {
            f16x8 xb[4][2];
#pragma unroll
            for (int m = 0; m < 4; ++m)
#pragma unroll
                for (int bj = 0; bj < 2; ++bj) xb[m][bj] = *(const f16x8*)(XR + (size_t)(row0 + ai * HALF + m * 16) * D + col0 + bj * HALF);
            asm volatile("" ::: "memory");
#pragma unroll
            for (int m = 0; m < 4; ++m) { const int row = row0 + ai * HALF + m * 16; const size_t off = (size_t)row * D + col0; float ss = 0.f;
#pragma unroll
                for (int bj = 0; bj < 2; ++bj) { const f16x8 xv = xb[m][bj];
                    f32x4 v0 = acc[ai][bj][m][0], v1 = acc[ai][bj][m][1];
                    v0[0] += (float)xv[0]; v0[1] += (float)xv[1]; v0[2] += (float)xv[2]; v0[3] += (float)xv[3]; v1[0] += (float)xv[4]; v1[1] += (float)xv[5]; v1[2] += (float)xv[6]; v1[3] += (float)xv[7];
                    ss += ((v0[0] * v0[0] + v0[1] * v0[1]) + (v0[2] * v0[2] + v0[3] * v0[3])) + ((v1[0] * v1[0] + v1[1] * v1[1]) + (v1[2] * v1[2] + v1[3] * v1[3]));
                    u32x4 o; o.x = pk_f16(v0[0], v0[1]); o.y = pk_f16(v0[2], v0[3]); o.z = pk_f16(v1[0], v1[1]); o.w = pk_f16(v1[2], v1[3]);
                    *(u32x4*)(XR + off + bj * HALF) = o; }
                ss += __shfl_xor(ss, 16); ss += __shfl_xor(ss, 32);
                if (fq == 0) atomicAdd(SS + row, ss); }
            asm volatile("" ::: "memory"); }
    }
};
struct EpiF16Row {
    static constexpr bool PERM = true;
    f16* O; int ldc; const float* SS;
    __device__ __forceinline__ void operator()(const f32x4 (&acc)[2][2][4][2], const Unit& u, int wr, int wc, int fr, int fq) const {
        const int row0 = u.pm * BM + wr * 64 + fr; const int col0 = u.pn * BM + wc * 32 + 8 * fq;
#pragma unroll
        for (int ai = 0; ai < 2; ++ai)
#pragma unroll
            for (int m = 0; m < 4; ++m) { const int row = row0 + ai * HALF + m * 16; f16* rowp = O + (size_t)row * ldc + col0;
                const float rs = 1.f / sqrtf(SS[row] * (1.f / D) + RMS_EPS);
#pragma unroll
                for (int bj = 0; bj < 2; ++bj) { const f32x4 v0 = acc[ai][bj][m][0] * rs, v1 = acc[ai][bj][m][1] * rs;
                    u32x4 o; o.x = pk_f16(v0[0], v0[1]); o.y = pk_f16(v0[2], v0[3]); o.z = pk_f16(v1[0], v1[1]); o.w = pk_f16(v1[2], v1[3]);
                    *(u32x4*)(rowp + bj * HALF) = o; } }
    }
};
struct EpiFinal {
    static constexpr bool PERM = true;
    const f16* XR; const f16* PJ; float* C; const float* SS;
    __device__ __forceinline__ void operator()(const f32x4 (&acc)[2][2][4][2], const Unit& u, int wr, int wc, int fr, int fq) const {
        const int row0 = u.pm * BM + wr * 64 + fr; const int col0 = u.pn * BM + wc * 32 + 8 * fq;
#pragma unroll
        for (int ai = 0; ai < 2; ++ai)
#pragma unroll
            for (int mh = 0; mh < 2; ++mh) {
                f16x8 xb[2][2], pb[2][2]; float ssv[2];
#pragma unroll
                for (int mm = 0; mm < 2; ++mm) { const int row = row0 + ai * HALF + (2 * mh + mm) * 16; ssv[mm] = SS[row];
#pragma unroll
                    for (int bj = 0; bj < 2; ++bj) { xb[mm][bj] = *(const f16x8*)(XR + (size_t)row * D + col0 + bj * HALF); pb[mm][bj] = *(const f16x8*)(PJ + (size_t)row * D + col0 + bj * HALF); } }
                asm volatile("" ::: "memory");
#pragma unroll
                for (int mm = 0; mm < 2; ++mm) { const int m = 2 * mh + mm; const int row = row0 + ai * HALF + m * 16; const size_t off = (size_t)row * D + col0;
                    const float nrs = -LOG2E / sqrtf(ssv[mm] * (1.f / D) + RMS_EPS);
#pragma unroll
                    for (int bj = 0; bj < 2; ++bj) { const f16x8 xv = xb[mm][bj], pv = pb[mm][bj];
                        const f32x4 a0 = acc[ai][bj][m][0], a1 = acc[ai][bj][m][1]; f32x4 o0, o1;
#pragma unroll
                        for (int j = 0; j < 4; ++j) { o0[j] = (float)xv[j] + (float)pv[j] * __builtin_amdgcn_rcpf(1.0f + __builtin_amdgcn_exp2f(nrs * a0[j]));
                            o1[j] = (float)xv[4 + j] + (float)pv[4 + j] * __builtin_amdgcn_rcpf(1.0f + __builtin_amdgcn_exp2f(nrs * a1[j])); }
                        *(f32x4*)(C + off + bj * HALF) = o0; *(f32x4*)(C + off + bj * HALF + 4) = o1; } }
                asm volatile("" ::: "memory"); }
    }
};
template <int MODE> struct EpiF32 {
    static constexpr bool PERM = false;
    const float* base; float* C; int ldc; const f16* pj; const float* ssp;
    __device__ __forceinline__ void operator()(const f32x4 (&acc)[2][2][4][2], const Unit& u, int wr, int wc, int fr, int fq) const {
        const int row0 = u.pm * BM + wr * 64 + fr, col0 = u.pn * BM + wc * 32 + 4 * fq;
#pragma unroll
        for (int ai = 0; ai < 2; ++ai)
#pragma unroll
            for (int m = 0; m < 4; ++m) { const size_t off = (size_t)(row0 + ai * HALF + m * 16) * ldc + col0;
                float nrs = -LOG2E;
                if (MODE == 1) { const f32x4 s0 = *(const f32x4*)(ssp + (size_t)(row0 + ai * HALF + m * 16) * 8), s1 = *(const f32x4*)(ssp + (size_t)(row0 + ai * HALF + m * 16) * 8 + 4);
                    nrs = -LOG2E / sqrtf((((s0.x + s0.y) + (s0.z + s0.w)) + ((s1.x + s1.y) + (s1.z + s1.w))) * (1.f / D) + RMS_EPS); }
#pragma unroll
                for (int bj = 0; bj < 2; ++bj)
#pragma unroll
                    for (int n = 0; n < 2; ++n) { const size_t o2 = off + bj * HALF + n * 16; const f32x4 bs = *(const f32x4*)(base + o2); f32x4 a = acc[ai][bj][m][n];
                        if (MODE == 1) { const f16x4 pv = *(const f16x4*)(pj + o2);
#pragma unroll
                            for (int j = 0; j < 4; ++j) a[j] = (float)pv[j] * __builtin_amdgcn_rcpf(1.0f + __builtin_amdgcn_exp2f(nrs * a[j])); }
                        *(f32x4*)(C + o2) = bs + a; }
                asm volatile("" ::: "memory"); }
    }
};

template <class Epi, class Sched>
__device__ __forceinline__ void gemm_phase(LAS unsigned char* lds, const Gemm g, const Sched& S, const Epi& E) {
    int tid = threadIdx.x; asm volatile("" : "+v"(tid));
    const int wid = __builtin_amdgcn_readfirstlane(tid >> 6), lane = tid & 63, wr = wid >> 2, wc = wid & 3, fr = lane & 15, fq = lane >> 4;
    const int K = g.K, nt = K / BK;
    unsigned voffA[2], voffB[2];
#pragma unroll
    for (int i = 0; i < 2; ++i) { int R, C; stage_rc(tid * 16 + i * 8192, R, C); const int Rb = Epi::PERM ? ((R & ~31) + perm32(R & 31)) : R;
        voffA[i] = (unsigned)(R * g.lda + C) * 2u; voffB[i] = (unsigned)(Rb * g.ldb + C) * 2u; }
    const size_t kstep = (size_t)(BK * 2);
    const size_t hstepA = (size_t)HALF * g.lda * 2, hstepB = (size_t)HALF * g.ldb * 2;
    const unsigned ldsw = (unsigned)wid * 1024u;
    const int aoff = lds_byte(wr * 64 + fr, fq * 8), boff = lds_byte(wc * 32 + fr, fq * 8);
#define PG8_SA(b, h) (((b) * 2 + (h)) * HTB)
#define PG8_SB(b, h) ((4 + (b) * 2 + (h)) * HTB)
#define PG8_STAGE(bufoff, gbase, voff) do { _Pragma("unroll") for (int _i = 0; _i < 2; ++_i) \
        __builtin_amdgcn_global_load_lds((const unsigned*)((const char*)(gbase) + (voff)[_i]), (LAS unsigned*)(lds + (bufoff) + ldsw + _i * 8192), 16, 0, 0); } while (0)
#define PG8_LDA(dst, b, h) do { _Pragma("unroll") for (int m = 0; m < 4; ++m) _Pragma("unroll") for (int k = 0; k < 2; ++k) dst[m][k] = *(const LAS f16x8*)(lds + PG8_SA(b, h) + aoff + m * 2048 + k * 1024); } while (0)
#define PG8_LDB(dst, b, h) do { _Pragma("unroll") for (int n = 0; n < 2; ++n) _Pragma("unroll") for (int k = 0; k < 2; ++k) dst[n][k] = *(const LAS f16x8*)(lds + PG8_SB(b, h) + boff + n * 2048 + k * 1024); } while (0)
#define PG8_MMA(ai, bj, At, Bt) do { __builtin_amdgcn_s_setprio(1); _Pragma("unroll") for (int m = 0; m < 4; ++m) _Pragma("unroll") for (int n = 0; n < 2; ++n) _Pragma("unroll") for (int k = 0; k < 2; ++k) \
        acc[ai][bj][m][n] = __builtin_amdgcn_mfma_f32_16x16x32_f16(Bt[n][k], At[m][k], acc[ai][bj][m][n], 0, 0, 0); __builtin_amdgcn_s_setprio(0); } while (0)
#define PG8_WAIT_V(n) asm volatile("s_waitcnt vmcnt(" #n ")" ::: "memory")
#define PG8_WAIT_L(n) asm volatile("s_waitcnt lgkmcnt(" #n ")" ::: "memory")
#define PG8_BAR __builtin_amdgcn_s_barrier()
#define PG8_SCHED __builtin_amdgcn_sched_barrier(0)
    Unit cur, nxt; int ui = 0;
    if (!S.next(0, cur)) return;
    f32x4 acc[2][2][4][2];
#pragma unroll
    for (int a = 0; a < 2; ++a)
#pragma unroll
        for (int b = 0; b < 2; ++b)
#pragma unroll
            for (int m = 0; m < 4; ++m)
#pragma unroll
                for (int n = 0; n < 2; ++n) acc[a][b][m][n] = (f32x4){0.f, 0.f, 0.f, 0.f};
    f16x8 At[4][2], B0[2][2], B1[2][2];
    const char* cA = g.aptr(cur); const char* cB = g.bptr(cur);
    PG8_STAGE(PG8_SB(0, 0), cB, voffB); PG8_STAGE(PG8_SB(0, 1), cB + hstepB, voffB); PG8_STAGE(PG8_SA(0, 0), cA, voffA); PG8_STAGE(PG8_SA(0, 1), cA + hstepA, voffA);
    if (wr == 1) PG8_BAR;
    PG8_WAIT_V(2); PG8_BAR;
    PG8_STAGE(PG8_SB(1, 0), cB + kstep, voffB); PG8_STAGE(PG8_SA(1, 0), cA + kstep, voffA); PG8_STAGE(PG8_SB(1, 1), cB + hstepB + kstep, voffB);
    PG8_WAIT_V(6); PG8_BAR;
    for (;;) {
        const bool has_next = S.next(ui + 1, nxt);
        const char* nA = has_next ? g.aptr(nxt) : cA; const char* nB = has_next ? g.bptr(nxt) : cB;
        for (int t = 0; t < nt; t += 2) {
            const bool last = (t == nt - 2);
            const char* a1 = cA + (size_t)(t + 1) * kstep;
            const char* a2 = last ? nA : cA + (size_t)(t + 2) * kstep; const char* b2 = last ? nB : cB + (size_t)(t + 2) * kstep;
            const char* a3 = a2 + kstep; const char* b3 = b2 + kstep;
            PG8_LDB(B0, 0, 0); PG8_LDB(B1, 0, 1); PG8_SCHED; PG8_LDA(At, 0, 0); PG8_STAGE(PG8_SA(1, 1), a1 + hstepA, voffA);
            PG8_WAIT_V(8); PG8_WAIT_L(0); PG8_BAR; PG8_MMA(0, 0, At, B0); PG8_MMA(0, 1, At, B1); PG8_BAR; PG8_SCHED;
            PG8_LDA(At, 0, 1); PG8_STAGE(PG8_SB(0, 0), b2, voffB); PG8_STAGE(PG8_SB(0, 1), b2 + hstepB, voffB); PG8_STAGE(PG8_SA(0, 0), a2, voffA);
            PG8_WAIT_V(8); PG8_WAIT_L(0); PG8_BAR; PG8_MMA(1, 0, At, B0); PG8_MMA(1, 1, At, B1); PG8_BAR; PG8_SCHED;
            PG8_LDB(B0, 1, 0); PG8_LDB(B1, 1, 1); PG8_SCHED; PG8_LDA(At, 1, 0); PG8_STAGE(PG8_SA(0, 1), a2 + hstepA, voffA);
            PG8_WAIT_V(8); PG8_WAIT_L(0); PG8_BAR; PG8_MMA(0, 0, At, B0); PG8_MMA(0, 1, At, B1); PG8_BAR; PG8_SCHED;
            PG8_LDA(At, 1, 1); PG8_STAGE(PG8_SB(1, 0), b3, voffB); PG8_STAGE(PG8_SB(1, 1), b3 + hstepB, voffB); PG8_STAGE(PG8_SA(1, 0), a3, voffA);
            PG8_WAIT_V(8); PG8_WAIT_L(0); PG8_BAR; PG8_MMA(1, 0, At, B0); PG8_MMA(1, 1, At, B1); PG8_BAR; PG8_SCHED;
        }
        if (wr == 0) PG8_BAR;
        E(acc, cur, wr, wc, fr, fq);
        if (!has_next) break;
#pragma unroll
        for (int a = 0; a < 2; ++a)
#pragma unroll
            for (int b = 0; b < 2; ++b)
#pragma unroll
                for (int m = 0; m < 4; ++m)
#pragma unroll
                    for (int n = 0; n < 2; ++n) acc[a][b][m][n] = (f32x4){0.f, 0.f, 0.f, 0.f};
        cur = nxt; cA = nA; cB = nB; ++ui;
        if (wr == 1) PG8_BAR;
    }
    PG8_WAIT_V(0);
    PG8_BAR;
#undef PG8_SA
#undef PG8_SB
#undef PG8_STAGE
#undef PG8_LDA
#undef PG8_LDB
#undef PG8_MMA
#undef PG8_WAIT_V
#undef PG8_WAIT_L
#undef PG8_BAR
#undef PG8_SCHED
}
}

#define XB_TMO      128
#define XB_XCNT(j)  (256  + 64 * (j))
#define XB_XSUB(j)  (1280 + 64 * (j))
#define XB_XGEN(j)  (2304 + 64 * (j))
#define XB_TOP      3328
#define XB_TOPGEN   3392
#define XCD_BAR_WORDS 3456
#define XB_SPIN_CAP (1u << 18)
__device__ __forceinline__ unsigned xb_ld(unsigned* p)              { return __hip_atomic_load(p, __ATOMIC_RELAXED, __HIP_MEMORY_SCOPE_AGENT); }
__device__ __forceinline__ unsigned xb_add(unsigned* p, unsigned v) { return __hip_atomic_fetch_add(p, v, __ATOMIC_RELAXED, __HIP_MEMORY_SCOPE_AGENT); }
__device__ __forceinline__ unsigned xb_xcc_id() { return (unsigned)__builtin_amdgcn_s_getreg((3 << 11) | 20) & 0xFu; }
#define XB_SPIN(cond, bar) do { unsigned _sp = 0; while (cond) { __builtin_amdgcn_s_sleep(1); \
    if ((++_sp & 255u) == 0u) { if (xb_ld(&(bar)[XB_TMO])) break; if (_sp > XB_SPIN_CAP) { atomicAdd(&(bar)[XB_TMO], 1u); break; } } } } while (0)
struct XcdBarrier { unsigned* bar; unsigned x; volatile LAS unsigned* st; };
__device__ __forceinline__ XcdBarrier xcd_barrier_post(unsigned* bar, volatile LAS unsigned* st) {
    XcdBarrier b; b.bar = bar; b.x = xb_xcc_id(); b.st = st;
    if (threadIdx.x == 0) (void)xb_add(&bar[XB_XCNT(b.x)], 1u);
    return b;
}
__device__ __forceinline__ void xcd_barrier_complete(unsigned* bar, unsigned x, unsigned& nloc, unsigned& nx) {
    const unsigned G = gridDim.x * gridDim.y * gridDim.z;
    unsigned sum, cnt, mine, sp = 0u;
    for (;;) {
        sum = 0u; cnt = 0u; mine = 0u;
#pragma unroll
        for (unsigned j = 0; j < 16; ++j) { const unsigned c = xb_ld(&bar[XB_XCNT(j)]); sum += c; cnt += (c > 0u) ? 1u : 0u; mine = (j == x) ? c : mine; }
        if (sum == G) break;
        __builtin_amdgcn_s_sleep(1);
        if ((++sp & 255u) == 0u) { if (xb_ld(&bar[XB_TMO])) break; if (sp > XB_SPIN_CAP) { atomicAdd(&bar[XB_TMO], 1u); break; } }
    }
    nloc = mine > 0u ? mine : 1u; nx = cnt > 0u ? cnt : 1u;
}
__device__ __forceinline__ void xcd_barrier(const XcdBarrier& b) {
    asm volatile("s_waitcnt vmcnt(0)" ::: "memory");
    __syncthreads();
    if (threadIdx.x == 0) {
        unsigned* bar = b.bar;
        __builtin_amdgcn_s_waitcnt(0);
        unsigned nloc = b.st[0], nx = b.st[1];
        if (nloc == 0u) { xcd_barrier_complete(bar, b.x, nloc, nx); b.st[0] = nloc; b.st[1] = nx; }
        const unsigned old = xb_add(&bar[XB_XSUB(b.x)], 1u);
        const unsigned gen = old / nloc;
        if (old + 1u == (gen + 1u) * nloc) {
            __builtin_amdgcn_fence(__ATOMIC_RELEASE, "agent");
            asm volatile("s_waitcnt vmcnt(0)" ::: "memory");
            const unsigned og = xb_add(&bar[XB_TOP], 1u);
            const unsigned tg = og / nx;
            if (og + 1u == (tg + 1u) * nx) xb_add(&bar[XB_TOPGEN], 1u);
            else XB_SPIN(xb_ld(&bar[XB_TOPGEN]) == tg, bar);
            __builtin_amdgcn_fence(__ATOMIC_ACQUIRE, "agent");
            xb_add(&bar[XB_XGEN(b.x)], 1u);
            asm volatile("s_waitcnt vmcnt(0)" ::: "memory");
        } else {
            XB_SPIN(xb_ld(&bar[XB_XGEN(b.x)]) == gen, bar);
            __builtin_amdgcn_fence(__ATOMIC_ACQUIRE, "agent");
            asm volatile("s_waitcnt vmcnt(0)" ::: "memory");
        }
    }
    __syncthreads();
}

struct Frame {
    LAS unsigned char* lds;
    volatile LAS unsigned* MISC;
    int tid, lane, wave;
    int vcu, G;
    const float* in[26];
    float* out;
    unsigned char* ws;
};
enum { I_X = 0, I_P, I_RELB, I_MIXNW, I_WIN, I_QNW, I_KNW, I_CKPOS, I_CKW1, I_CKB1, I_CKW2, I_CVPOS, I_CVW1, I_CVB1, I_CVW2, I_POOLW, I_POOLS, I_WOUT, I_FFNNW, I_PWQ, I_PKEYS, I_PU, I_PV, I_PLENW, I_PLEWG, I_PLEWP };

__device__ __forceinline__ void p0_transpose_item(const float* W, int K, int N, int Npad, const float* colscale, f16* WT, LAS float* scr, int item, int lane, const float* kscale = nullptr) {
    const int nblk = Npad / 32, kb = item / nblk, nb = item % nblk, k0 = 64 * kb, n0 = 32 * nb;
    const int nn = n0 + (lane & 31); const bool ok = nn < N;
#pragma unroll
    for (int hgrp = 0; hgrp < 2; ++hgrp) { float wv[16];
#pragma unroll
        for (int i = 0; i < 16; ++i) { const int kk = 2 * (16 * hgrp + i) + (lane >> 5); wv[i] = ok ? W[(size_t)(k0 + kk) * N + nn] : 0.f; }
        if (kscale) {
#pragma unroll
            for (int i = 0; i < 16; ++i) wv[i] *= kscale[k0 + 2 * (16 * hgrp + i) + (lane >> 5)]; }
#pragma unroll
        for (int i = 0; i < 16; ++i) { const int kk = 2 * (16 * hgrp + i) + (lane >> 5); scr[kk * 33 + (lane & 31)] = wv[i]; }
        asm volatile("" ::: "memory"); }
    LDS_WAIT(); asm volatile("" ::: "memory");
    const int c = lane & 7;
#pragma unroll
    for (int j = 0; j < 4; ++j) { const int n = (lane >> 3) + 8 * j; const LAS float* s = scr + (8 * c) * 33 + n; const float sc = (colscale && n0 + n < N) ? colscale[n0 + n] : 1.f;
        u32x4 o; o.x = pk_f16(s[0 * 33] * sc, s[1 * 33] * sc); o.y = pk_f16(s[2 * 33] * sc, s[3 * 33] * sc); o.z = pk_f16(s[4 * 33] * sc, s[5 * 33] * sc); o.w = pk_f16(s[6 * 33] * sc, s[7 * 33] * sc);
        *(GAS u32x4*)(WT + (size_t)(n0 + n) * K + k0 + 8 * c) = o; }
    LDS_WAIT(); asm volatile("" ::: "memory");
}
__device__ __forceinline__ void rms_row_to_f16(const float* xrow, const float* w, f16* orow, int lane, f16* x16row = nullptr) {
    const GAS f32x4* xr = (const GAS f32x4*)xrow + lane; const GAS f32x4* wr = (const GAS f32x4*)w + lane;
    f32x4 v[8]; float s = 0.f;
#pragma unroll
    for (int j = 0; j < 8; ++j) { v[j] = xr[64 * j]; s += (v[j].x * v[j].x + v[j].y * v[j].y) + (v[j].z * v[j].z + v[j].w * v[j].w); }
    const float rstd = 1.f / sqrtf(wave_sum(s) * (1.f / D) + RMS_EPS);
    GAS u32x2* o8 = (GAS u32x2*)orow + lane;
#pragma unroll
    for (int j = 0; j < 8; ++j) { const f32x4 g = wr[64 * j]; u32x2 o; o.x = pk_f16(v[j].x * rstd * g.x, v[j].y * rstd * g.y); o.y = pk_f16(v[j].z * rstd * g.z, v[j].w * rstd * g.w); o8[64 * j] = o; }
    if (x16row) { GAS u32x2* x8 = (GAS u32x2*)x16row + lane;
#pragma unroll
        for (int j = 0; j < 8; ++j) { u32x2 o; o.x = pk_f16(v[j].x, v[j].y); o.y = pk_f16(v[j].z, v[j].w); x8[64 * j] = o; } }
}
__device__ __forceinline__ void rms_2rows_to_f16(const float* x0, const float* x1, const float* w, f16* o0, f16* o1, f16* h0, f16* h1, int lane) {
    const GAS f32x4* xa = (const GAS f32x4*)x0 + lane; const GAS f32x4* xb = (const GAS f32x4*)x1 + lane; const GAS f32x4* wr = (const GAS f32x4*)w + lane;
    f32x4 va[8], vb[8]; float sa = 0.f, sb = 0.f;
#pragma unroll
    for (int j = 0; j < 8; ++j) { va[j] = __builtin_nontemporal_load(xa + 64 * j); vb[j] = __builtin_nontemporal_load(xb + 64 * j); }
#pragma unroll
    for (int j = 0; j < 8; ++j) { sa += (va[j].x * va[j].x + va[j].y * va[j].y) + (va[j].z * va[j].z + va[j].w * va[j].w); sb += (vb[j].x * vb[j].x + vb[j].y * vb[j].y) + (vb[j].z * vb[j].z + vb[j].w * vb[j].w); }
    const float ra = 1.f / sqrtf(wave_sum(sa) * (1.f / D) + RMS_EPS), rb = 1.f / sqrtf(wave_sum(sb) * (1.f / D) + RMS_EPS);
    GAS u32x2* pa = (GAS u32x2*)o0 + lane; GAS u32x2* pb = (GAS u32x2*)o1 + lane; GAS u32x2* qa = (GAS u32x2*)h0 + lane; GAS u32x2* qb = (GAS u32x2*)h1 + lane;
#pragma unroll
    for (int j = 0; j < 8; ++j) { const f32x4 g = wr[64 * j]; u32x2 o;
        o.x = pk_f16(va[j].x * ra * g.x, va[j].y * ra * g.y); o.y = pk_f16(va[j].z * ra * g.z, va[j].w * ra * g.w); pa[64 * j] = o;
        o.x = pk_f16(vb[j].x * rb * g.x, vb[j].y * rb * g.y); o.y = pk_f16(vb[j].z * rb * g.z, vb[j].w * rb * g.w); pb[64 * j] = o;
        o.x = pk_f16(va[j].x, va[j].y); o.y = pk_f16(va[j].z, va[j].w); qa[64 * j] = o;
        o.x = pk_f16(vb[j].x, vb[j].y); o.y = pk_f16(vb[j].z, vb[j].w); qb[64 * j] = o; }
}
__device__ __forceinline__ void x16_2rows(const float* x0, const float* x1, f16* h0, f16* h1, float* ss0, float* ss1, int lane) {
    const GAS f32x4* xa = (const GAS f32x4*)x0 + lane; const GAS f32x4* xb = (const GAS f32x4*)x1 + lane;
    f32x4 va[8], vb[8]; float sa = 0.f, sb = 0.f;
#pragma unroll
    for (int j = 0; j < 8; ++j) { va[j] = __builtin_nontemporal_load(xa + 64 * j); vb[j] = __builtin_nontemporal_load(xb + 64 * j); }
    GAS u32x2* qa = (GAS u32x2*)h0 + lane; GAS u32x2* qb = (GAS u32x2*)h1 + lane;
#pragma unroll
    for (int j = 0; j < 8; ++j) { sa += (va[j].x * va[j].x + va[j].y * va[j].y) + (va[j].z * va[j].z + va[j].w * va[j].w); sb += (vb[j].x * vb[j].x + vb[j].y * vb[j].y) + (vb[j].z * vb[j].z + vb[j].w * vb[j].w);
        u32x2 o; o.x = pk_f16(va[j].x, va[j].y); o.y = pk_f16(va[j].z, va[j].w); qa[64 * j] = o;
        o.x = pk_f16(vb[j].x, vb[j].y); o.y = pk_f16(vb[j].z, vb[j].w); qb[64 * j] = o; }
    sa = wave_sum(sa); sb = wave_sum(sb);
    if (lane == 0) { *ss0 = sa; *ss1 = sb; }
}
__device__ __forceinline__ void cvt_f32_f16(Frame& F, const float* src, f16* dst, size_t n) {
    const size_t gt = (size_t)F.vcu * 512 + F.tid, GT = (size_t)F.G * 512;
    for (size_t i = gt; i < n / 8; i += GT) { const f32x4 a = *(const GAS f32x4*)(src + i * 8), b = *(const GAS f32x4*)(src + i * 8 + 4);
        u32x4 o; o.x = pk_f16(a.x, a.y); o.y = pk_f16(a.z, a.w); o.z = pk_f16(b.x, b.y); o.w = pk_f16(b.z, b.w); *(GAS u32x4*)(dst + i * 8) = o; }
}

__device__ __forceinline__ void p0_prologue(Frame& F) {
    LAS float* scr = (LAS float*)(F.lds + F.wave * 16384);
    const int gw = F.vcu * NWAVES + F.wave, NGW = F.G * NWAVES;
    unsigned char* ws = F.ws;
    constexpr int I_IN = (D / 64) * (NINP / 32), I_SQ = (D / 64) * (D / 32), I_PJ = (256 / 64) * (D / 32), I_C1 = (D / 64) * (256 / 32), I_PL = (256 / 64) * (256 / 32);
    constexpr int NITEMS = I_IN + 3 * I_SQ + I_PJ + 2 * I_C1 + 4 * I_PL;
    for (int it = gw; it < NITEMS; it += NGW) {
        int r = it;
        if (r < I_IN) { p0_transpose_item(F.in[I_WIN], D, NIN, NINP, nullptr, (f16*)(ws + WS_WIN), scr, r, F.lane, F.in[I_MIXNW]); continue; } r -= I_IN;
        if (r < I_SQ) { p0_transpose_item(F.in[I_WOUT], D, D, D, nullptr, (f16*)(ws + WS_WOUT), scr, r, F.lane); continue; } r -= I_SQ;
        if (r < I_SQ) { p0_transpose_item(F.in[I_PWQ], D, D, D, nullptr, (f16*)(ws + WS_WQ), scr, r, F.lane, F.in[I_FFNNW]); continue; } r -= I_SQ;
        if (r < I_SQ) { p0_transpose_item(F.in[I_PLEWG], D, D, D, nullptr, (f16*)(ws + WS_WG), scr, r, F.lane, F.in[I_PLENW]); continue; } r -= I_SQ;
        if (r < I_PJ) { p0_transpose_item(F.in[I_PLEWP], 256, D, D, nullptr, (f16*)(ws + WS_WPJ), scr, r, F.lane); continue; } r -= I_PJ;
        if (r < I_C1) { p0_transpose_item(F.in[I_CKW1], D, 256, 256, nullptr, (f16*)(ws + WS_W1C), scr, r, F.lane); continue; } r -= I_C1;
        if (r < I_C1) { p0_transpose_item(F.in[I_CVW1], D, 256, 256, nullptr, (f16*)(ws + WS_W1C) + 256 * D, scr, r, F.lane); continue; } r -= I_C1;
        { const int g = r / I_PL; r -= g * I_PL;
          p0_transpose_item(F.in[I_POOLW] + (size_t)g * 65536, 256, 256, 256, F.in[I_POOLS] + g * 256, (f16*)(ws + WS_POOLT) + (size_t)g * 65536, scr, r, F.lane); }
    }
    { float* SS0 = (float*)(ws + WS_SS0); f16* XR = (f16*)(ws + WS_XR);
      for (int m = gw; m < M; m += 2 * NGW) { const int m2 = m + NGW < M ? m + NGW : m;
          x16_2rows(F.in[I_X] + (size_t)m * D, F.in[I_X] + (size_t)m2 * D, XR + (size_t)m * D, XR + (size_t)m2 * D, SS0 + m, SS0 + m2, F.lane); } }
    cvt_f32_f16(F, F.in[I_P], (f16*)(ws + WS_P16), (size_t)M * 256);
    cvt_f32_f16(F, F.in[I_PKEYS], (f16*)(ws + WS_KEYS), (size_t)8 * 2 * 128 * 128);
    for (int task = gw; task < 512; task += NGW) { const int mat = task >> 8, n = task & 255;
        const float* pos = F.in[mat ? I_CVPOS : I_CKPOS]; const float* w1 = F.in[mat ? I_CVW1 : I_CKW1]; float s = 0.f;
#pragma unroll
        for (int i = 0; i < 32; ++i) { const int k = F.lane + 64 * i; s += pos[k] * w1[(size_t)k * 256 + n]; }
        s = wave_sum(s);
        if (F.lane == 0) ((float*)(ws + WS_CBIAS))[task] = s + F.in[mat ? I_CVB1 : I_CKB1][n]; }
}

template <int W> __device__ __forceinline__ void pool_mix_tile(const f16* up, f16* mp, size_t mb, int s0) {
    f16x2 prev[16], cur[16]; f32x2 sum = {0.f, 0.f};
#pragma unroll
    for (int i = 0; i < 16; ++i) { const int sp = s0 - 16 + i; prev[i] = sp >= 0 ? *(const GAS f16x2*)(up + (mb + sp) * NINP) : (f16x2){(f16)0.f, (f16)0.f}; }
#pragma unroll
    for (int i = 16 - W; i < 16; ++i) { sum.x += (float)prev[i].x; sum.y += (float)prev[i].y; }
#pragma unroll 1
    for (int blk = 0; blk < 4; ++blk) { const int sb = s0 + blk * 16;
#pragma unroll
        for (int i = 0; i < 16; ++i) cur[i] = *(const GAS f16x2*)(up + (mb + sb + i) * NINP);
#pragma unroll
        for (int i = 0; i < 16; ++i) { const int s = sb + i; const f16x2 o = (i - W >= 0) ? cur[(i - W >= 0) ? i - W : 0] : prev[(i - W >= 0) ? 0 : 16 + i - W];
            sum.x += (float)cur[i].x - (float)o.x; sum.y += (float)cur[i].y - (float)o.y;
            const float ic = 1.f / (float)(s + 1 < W ? s + 1 : W);
            *(GAS unsigned*)(mp + (mb + s) * 1024) = pk_f16(sum.x * ic - (float)cur[i].x, sum.y * ic - (float)cur[i].y); }
#pragma unroll
        for (int i = 0; i < 16; ++i) prev[i] = cur[i]; }
}
__device__ __forceinline__ void p2_post(Frame& F) {
    unsigned char* ws = F.ws;
    f16* Y = (f16*)(ws + WS_Y);
    const float* qnw = F.in[I_QNW]; const float* knw = F.in[I_KNW];
    LAS f16* vl = (LAS f16*)F.lds;
    constexpr int VLP = 264;
    for (int tt = F.vcu; tt < M / 64; tt += F.G) {
        const int b = tt >> 5, s0 = (tt & 31) * 64, m0 = tt * 64;
        for (int tk = F.wave; tk < 64; tk += NWAVES) {
            const int m = m0 + tk, s = s0 + tk; f16* yr = Y + (size_t)m * NINP;
#pragma unroll
            for (int pass = 0; pass < 2; ++pass) { const int ch = pass * 64 + F.lane; f16* pq = yr + OFF_Q + ch * 8; const f16x8 v = *(const GAS f16x8*)pq;
                float ss = 0.f;
#pragma unroll
                for (int e = 0; e < 8; ++e) ss += (float)v[e] * (float)v[e];
                ss = sum8(ss);
                const float rs = (1.f / sqrtf(ss * (1.f / 64.f) + RMS_EPS)) * (0.125f * LOG2E); const float* w = qnw + (ch & 7) * 8;
                u32x4 o; o.x = pk_f16((float)v[0] * rs * w[0], (float)v[1] * rs * w[1]); o.y = pk_f16((float)v[2] * rs * w[2], (float)v[3] * rs * w[3]);
                o.z = pk_f16((float)v[4] * rs * w[4], (float)v[5] * rs * w[5]); o.w = pk_f16((float)v[6] * rs * w[6], (float)v[7] * rs * w[7]);
                *(GAS u32x4*)((f16*)(ws + WS_QN) + (size_t)m * 1024 + ch * 8) = o; }
            { const int br = F.lane >> 5, ch = F.lane & 31, g = ch >> 3, dc = ch & 7; const f16x8 v = *(const GAS f16x8*)(yr + (br ? OFF_KW : OFF_KS) + ch * 8);
                float ss = 0.f;
#pragma unroll
                for (int e = 0; e < 8; ++e) ss += (float)v[e] * (float)v[e];
                ss = sum8(ss);
                const float rs = 1.f / sqrtf(ss * (1.f / 64.f) + RMS_EPS); const float* w = knw + dc * 8;
                u32x4 o; o.x = pk_f16((float)v[0] * rs * w[0], (float)v[1] * rs * w[1]); o.y = pk_f16((float)v[2] * rs * w[2], (float)v[3] * rs * w[3]);
                o.z = pk_f16((float)v[4] * rs * w[4], (float)v[5] * rs * w[5]); o.w = pk_f16((float)v[6] * rs * w[6], (float)v[7] * rs * w[7]);
                *(GAS u32x4*)((f16*)(ws + WS_KN) + (size_t)br * (BATCH * 4 * SEQ * 64) + ((size_t)(b * 4 + g) * 64 + (s >> 5)) * 2048 + (dc >> 1) * 512 + ((dc & 1) * 32 + (s & 31)) * 8) = o; }
            { const int mat = F.lane >> 5, ch = F.lane & 31, g = ch >> 3, dc = ch & 7; const u32x4 v = *(const GAS u32x4*)(yr + (mat ? OFF_VC : OFF_KC) + ch * 8);
                const int i1 = s >> 4, jj = s & 15; f16* fa = (f16*)(ws + WS_FLATA) + (size_t)mat * 4096 * 2048;
                if (i1 <= NCMP - 1) *(GAS u32x4*)(fa + (size_t)((b * NCMP + i1) * 4 + g) * 2048 + jj * 64 + dc * 8) = v;
                if (i1 >= 1) *(GAS u32x4*)(fa + (size_t)((b * NCMP + i1 - 1) * 4 + g) * 2048 + (16 + jj) * 64 + dc * 8) = v; }
        }
        for (int idx = F.tid; idx < 64 * 48; idx += 512) { const int tk = idx / 48, c = idx - tk * 48; const float v = (float)Y[(size_t)(m0 + tk) * NINP + OFF_G + c];
            ((float*)(ws + WS_GATES))[(size_t)(m0 + tk) * 48 + c] = 1.f / (1.f + __expf(-v)); }
        { const int gg = F.tid >> 7;
          if (gg == 0) pool_mix_tile<2>(Y + OFF_U + F.tid * 2, (f16*)(ws + WS_MIXED) + F.tid * 2, (size_t)b * SEQ, s0);
          else if (gg == 1) pool_mix_tile<4>(Y + OFF_U + F.tid * 2, (f16*)(ws + WS_MIXED) + F.tid * 2, (size_t)b * SEQ, s0);
          else if (gg == 2) pool_mix_tile<8>(Y + OFF_U + F.tid * 2, (f16*)(ws + WS_MIXED) + F.tid * 2, (size_t)b * SEQ, s0);
          else pool_mix_tile<16>(Y + OFF_U + F.tid * 2, (f16*)(ws + WS_MIXED) + F.tid * 2, (size_t)b * SEQ, s0); }
        __syncthreads();
        for (int idx = F.tid; idx < 2 * 64 * 32; idx += 512) { const int br = idx >> 11, tk = (idx >> 5) & 63, ch = idx & 31;
            *(LAS u32x4*)(vl + (br * 64 + tk) * VLP + ch * 8) = *(const GAS u32x4*)(Y + (size_t)(m0 + tk) * NINP + (br ? OFF_VW : OFF_VS) + ch * 8); }
        __syncthreads();
        for (int idx = F.tid; idx < 2 * 256 * 8; idx += 512) { const int br = idx >> 11, row = (idx >> 3) & 255, cc = idx & 7, grp = cc >> 1, hh = cc & 1;
            f16x8 o;
#pragma unroll
            for (int j = 0; j < 8; ++j) { const int kap = 16 * grp + 8 * (j >> 2) + 4 * hh + (j & 3); o[j] = vl[(br * 64 + kap) * VLP + row]; }
            const int g = row >> 6, d = row & 63;
            *(GAS f16x8*)((f16*)(ws + WS_VT) + (size_t)br * (BATCH * 4 * 64 * SEQ) + ((size_t)(b * 4 + g) * 64 + (s0 >> 5) + (cc >> 2)) * 2048 + ((d >> 5) * 2 + ((cc >> 1) & 1)) * 512 + ((cc & 1) * 32 + (d & 31)) * 8) = o; }
        __syncthreads();
    }
}

__device__ __forceinline__ void p4_compress2(Frame& F) {
    unsigned char* ws = F.ws;
    f16* kc = (f16*)(ws + WS_KCMP); f16* vt = (f16*)(ws + WS_VCMPT);
    const int nhalf = F.G >> 1, mat = F.vcu & 1, wgr = F.vcu >> 1;
    if (nhalf == 0) return;
    LAS float* w2l = (LAS float*)F.lds;
    { const float* w2g = F.in[mat ? I_CVW2 : I_CKW2];
      for (int idx = F.tid; idx < 256 * 16; idx += 512) { const int k = idx >> 4, d4 = (idx & 15) * 4; const f32x4 v = *(const GAS f32x4*)(w2g + (size_t)k * 64 + d4);
          LAS float* q = w2l + ((k >> 2) * 64 + d4) * 4 + (k & 3); q[0] = v.x; q[4] = v.y; q[8] = v.z; q[12] = v.w; } }
    __syncthreads();
    const int rstep = nhalf * NWAVES, r0 = (F.vcu >= 2 * nhalf ? 4096 : wgr * NWAVES + F.wave);
#pragma unroll 1
    for (int rb = r0; rb < 4096; rb += 4 * rstep) {
        f32x4 hs[4];
#pragma unroll
        for (int q = 0; q < 4; ++q) { const int r = rb + q * rstep < 4096 ? rb + q * rstep : rb; const int bg = r >> 7, i = r & 127, ic = i < NCMP ? i : 0;
            const float* hp = (const float*)(ws + WS_Y) + ((size_t)mat * 4096 + (size_t)((bg >> 2) * NCMP + ic) * 4 + (bg & 3)) * 1024 + F.lane * 4;
            hs[q] = *(const GAS f32x4*)(((const float*)(ws + WS_CBIAS)) + mat * 256 + F.lane * 4);
#pragma unroll
            for (int ks = 0; ks < 4; ++ks) hs[q] = hs[q] + *(const GAS f32x4*)(hp + ks * 256); }
        float hh_[4][4], ac[4][4];
#pragma unroll
        for (int q = 0; q < 4; ++q) { const f32x2 ga = pg8::gelu_pk((f32x2){hs[q].x, hs[q].y}), gb = pg8::gelu_pk((f32x2){hs[q].z, hs[q].w});
            hh_[q][0] = ga.x; hh_[q][1] = ga.y; hh_[q][2] = gb.x; hh_[q][3] = gb.y; ac[q][0] = 0.f; ac[q][1] = 0.f; ac[q][2] = 0.f; ac[q][3] = 0.f; }
#pragma unroll 8
        for (int kk = 0; kk < 64; ++kk) { const f32x4 wv = *(const LAS f32x4*)(w2l + (kk * 64 + F.lane) * 4);
#pragma unroll
            for (int q = 0; q < 4; ++q) { ac[q][0] += rl_f(hh_[q][0], kk) * wv.x; ac[q][1] += rl_f(hh_[q][1], kk) * wv.y; ac[q][2] += rl_f(hh_[q][2], kk) * wv.z; ac[q][3] += rl_f(hh_[q][3], kk) * wv.w; } }
#pragma unroll
        for (int q = 0; q < 4; ++q) { const int r = rb + q * rstep; if (r < 4096) {
            const int bg = r >> 7, i = r & 127;
            const float acc = i < NCMP ? (ac[q][0] + ac[q][1]) + (ac[q][2] + ac[q][3]) : 0.f;
            if (mat == 0) { const float ss = wave_sum(acc * acc); const float rs = 1.f / sqrtf(ss * (1.f / 64.f) + RMS_EPS);
                const int d = F.lane, dc = d >> 3;
                kc[((size_t)bg * 4 + (i >> 5)) * 2048 + (dc >> 1) * 512 + ((dc & 1) * 32 + (i & 31)) * 8 + (d & 7)] = (f16)(i < NCMP ? acc * rs * F.in[I_KNW][F.lane] : 0.f); }
            else { const int kap = i & 15, pp = ((kap >> 2) & 1) * 8 + (kap >> 3) * 4 + (kap & 3);
                const int d = F.lane;
                vt[((size_t)bg * 4 + (i >> 5)) * 2048 + ((d >> 5) * 2 + ((i >> 4) & 1)) * 512 + ((pp >> 3) * 32 + (d & 31)) * 8 + (pp & 7)] = (f16)acc; } } }
    }
    __syncthreads();
}

__device__ __forceinline__ int t5_bucket(int rel) {
    if (rel < 16) return rel;
    int b = 16;
    b += rel >= 19; b += rel >= 21; b += rel >= 24; b += rel >= 27; b += rel >= 31; b += rel >= 35; b += rel >= 40; b += rel >= 46;
    b += rel >= 52; b += rel >= 59; b += rel >= 67; b += rel >= 77; b += rel >= 87; b += rel >= 99; b += rel >= 113;
    return b;
}
__device__ __forceinline__ int med3i(int a, int lo, int hi) { return a < lo ? lo : (a > hi ? hi : a); }
__device__ __forceinline__ float other_half_max(float x) { const auto r = __builtin_amdgcn_permlane32_swap(__float_as_uint(x), __float_as_uint(x), false, false); return fmaxf(__uint_as_float(r[0]), __uint_as_float(r[1])); }
__device__ __forceinline__ float both_halves_sum(float x) { const auto r = __builtin_amdgcn_permlane32_swap(__float_as_uint(x), __float_as_uint(x), false, false); return __uint_as_float(r[0]) + __uint_as_float(r[1]); }
struct AFrag { f16x8 k[4]; f16x8 v[2][2]; };
__device__ __forceinline__ void attn_load(AFrag& f, const f16* Kp, const f16* Vp, int kt, int r31, int hh) {
    const f16* kp = Kp + (size_t)kt * 2048 + (hh * 32 + r31) * 8; const f16* vp = Vp + (size_t)kt * 2048 + (hh * 32 + r31) * 8;
#pragma unroll
    for (int ks = 0; ks < 4; ++ks) f.k[ks] = *(const GAS f16x8*)(kp + ks * 512);
#pragma unroll
    for (int dt = 0; dt < 2; ++dt)
#pragma unroll
        for (int s2 = 0; s2 < 2; ++s2) f.v[dt][s2] = *(const GAS f16x8*)(vp + (dt * 2 + s2) * 512);
}
__device__ __forceinline__ f16x8 pack8(const f32x16& c, int s2) {
    f16x8 o;
#pragma unroll
    for (int j = 0; j < 8; ++j) o[j] = (f16)c[8 * s2 + j];
    return o;
}
__device__ __forceinline__ void attn_tile(const AFrag& f, const f16x8 (&bq)[4], int kt, int t0, int t, int hh, int wlim, unsigned selm, float cfar, const LAS float* lutr,
                                          float& mrun, float& lrun, f32x16& O0, f32x16& O1) {
    f32x16 S;
#pragma unroll
    for (int i = 0; i < 16; ++i) S[i] = 0.f;
#pragma unroll
    for (int ks = 0; ks < 4; ++ks) S = __builtin_amdgcn_mfma_f32_32x32x16_f16(f.k[ks], bq[ks], S, 0, 0, 0);
    const int k0 = kt * 32, minrel = t0 - (k0 + 31), maxrel = t0 + 7 - k0;
    const bool selbit = ((selm >> (kt >> 1)) & 1u) != 0u;
    if (minrel >= 113 && maxrel < wlim) {
        const float addc = selbit ? cfar : -2e30f;
#pragma unroll
        for (int i = 0; i < 16; ++i) S[i] += addc;
    } else {
        const unsigned wl = selbit ? (unsigned)wlim : 0u; const int relb = t - k0 - 4 * hh;
        float bias[16];
#pragma unroll
        for (int i = 0; i < 16; ++i) bias[i] = lutr[med3i(relb - ((i & 3) + 8 * (i >> 2)), 0, 127)];
#pragma unroll
        for (int i = 0; i < 16; ++i) asm volatile("" : "+v"(bias[i]));
#pragma unroll
        for (int i = 0; i < 16; ++i) { const int rel = relb - ((i & 3) + 8 * (i >> 2)); S[i] = ((unsigned)rel < wl) ? S[i] + bias[i] : -2e30f; }
    }
    float tmax = S[0];
#pragma unroll
    for (int i = 1; i < 16; ++i) tmax = fmaxf(tmax, S[i]);
    tmax = other_half_max(tmax);
    const float mnew = fmaxf(mrun, tmax), alpha = __builtin_amdgcn_exp2f(mrun - mnew);
    mrun = mnew; lrun *= alpha;
#pragma unroll
    for (int i = 0; i < 16; ++i) { O0[i] *= alpha; O1[i] *= alpha; }
#pragma unroll
    for (int i = 0; i < 16; ++i) { const float pv = __builtin_amdgcn_exp2f(S[i] - mnew); lrun += pv; S[i] = pv; }
#pragma unroll
    for (int s2 = 0; s2 < 2; ++s2) { const f16x8 pb = pack8(S, s2);
        O0 = __builtin_amdgcn_mfma_f32_32x32x16_f16(f.v[0][s2], pb, O0, 0, 0, 0); O1 = __builtin_amdgcn_mfma_f32_32x32x16_f16(f.v[1][s2], pb, O1, 0, 0, 0); }
}
__device__ __forceinline__ void attn_branch(const f16* Kp, const f16* Vp, unsigned long long tm, const f16x8 (&bq)[4], int t0, int t, int r31, int hh, int wlim, unsigned selm, float cfar,
                                            const LAS float* lutr, float gate, LAS float* TL) {
    float mrun = -1e30f, lrun = 0.f; f32x16 O0, O1;
#pragma unroll
    for (int i = 0; i < 16; ++i) { O0[i] = 0.f; O1[i] = 0.f; }
    AFrag fA, fB;
    int ktA = __builtin_ctzll(tm), ktB;
    attn_load(fA, Kp, Vp, ktA, r31, hh);
    for (;;) {
        tm &= tm - 1; const bool hasB = tm != 0ull; ktB = hasB ? __builtin_ctzll(tm) : ktA; attn_load(fB, Kp, Vp, ktB, r31, hh);
        attn_tile(fA, bq, ktA, t0, t, hh, wlim, selm, cfar, lutr, mrun, lrun, O0, O1);
        if (!hasB) break;
        tm &= tm - 1; const bool hasA = tm != 0ull; ktA = hasA ? __builtin_ctzll(tm) : ktB; attn_load(fA, Kp, Vp, ktA, r31, hh);
        attn_tile(fB, bq, ktB, t0, t, hh, wlim, selm, cfar, lutr, mrun, lrun, O0, O1);
        if (!hasA) break;
    }
    lrun = both_halves_sum(lrun);
    const float sc = gate / fmaxf(lrun, 1e-30f);
#pragma unroll
    for (int i = 0; i < 16; ++i) { TL[i * 64] += O0[i] * sc; TL[(16 + i) * 64] += O1[i] * sc; }
}
__device__ __forceinline__ void p5_attention(Frame& F) {
    unsigned char* ws = F.ws;
    const f16* Y = (const f16*)(ws + WS_Y);
    const float* gates = (const float*)(ws + WS_GATES);
    f16* CAT = (f16*)(ws + WS_CAT);
    LAS float* wl = (LAS float*)(F.lds + F.wave * 8192);
    LAS float* LUT = wl;
    const int gw = F.vcu * NWAVES + F.wave, NW = F.G * NWAVES;
    const bool snake = (8192 % (2 * NW)) == 0;
    int lut_g = -1;
    LAS unsigned* SELM = (LAS unsigned*)(wl + 1280);
    for (int it = gw, rr = 0; it < 8192; it += NW, ++rr) {
        const int n = (snake && (rr & 1)) ? (rr * NW + (NW - 1 - gw)) : it;
        const int bg = n >> 8, pos = n & 255, b = bg >> 2, g = bg & 3, t0 = pos * 8;
        int lane = F.lane; asm volatile("" : "+v"(lane));
        const int r31 = lane & 31, hh = lane >> 5, tok8 = r31 >> 2, r = r31 & 3;
        const LAS float* lutr = LUT + r * 128;
        if (g != lut_g) {
            LDS_WAIT(); asm volatile("" ::: "memory");
#pragma unroll
            for (int e = 0; e < 2; ++e) { const int rel = lane + 64 * e, bk = t5_bucket(rel);
#pragma unroll
                for (int r4 = 0; r4 < 4; ++r4) LUT[r4 * 128 + rel] = F.in[I_RELB][bk * 16 + 4 * g + r4] * LOG2E; }
            LDS_WAIT(); asm volatile("" ::: "memory");
            lut_g = g;
        }
        const int t = t0 + tok8, head = 4 * g + r; const size_t m = (size_t)b * SEQ + t;
        f16x8 bq[4];
#pragma unroll
        for (int ks = 0; ks < 4; ++ks) bq[ks] = *(const GAS f16x8*)((const f16*)(ws + WS_QN) + m * 1024 + head * 64 + ks * 16 + hh * 8);
        const float g_c = gates[m * 48 + head * 3 + 0], g_s = gates[m * 48 + head * 3 + 1], g_w = gates[m * 48 + head * 3 + 2];
        const float cfar = lutr[127];
        LAS float* TL = (LAS float*)(F.lds + 65536 + F.wave * 8192) + lane;
        {
            const f16* kc = (const f16*)(ws + WS_KCMP) + (size_t)bg * 128 * 64;
            const f16* vc = (const f16*)(ws + WS_VCMPT) + (size_t)bg * 64 * 128;
            f32x16 c[4];
#pragma unroll
            for (int kt = 0; kt < 4; ++kt) {
#pragma unroll
                for (int i = 0; i < 16; ++i) c[kt][i] = 0.f;
#pragma unroll
                for (int ks = 0; ks < 4; ++ks) { const f16x8 a = *(const GAS f16x8*)(kc + kt * 2048 + ks * 512 + (hh * 32 + r31) * 8); c[kt] = __builtin_amdgcn_mfma_f32_32x32x16_f16(a, bq[ks], c[kt], 0, 0, 0); }
                asm volatile("" ::: "memory");
            }
            const int relb = t - 31 - 64 * hh; float mx = -1e30f;
#pragma unroll
            for (int kt = 0; kt < 4; ++kt) { float bias[16];
#pragma unroll
                for (int i = 0; i < 16; ++i) { const int rel = relb - 16 * (kt * 32 + (i & 3) + 8 * (i >> 2)); bias[i] = lutr[med3i(rel, 0, 127)]; }
#pragma unroll
                for (int i = 0; i < 16; ++i) asm volatile("" : "+v"(bias[i]));
#pragma unroll
                for (int i = 0; i < 16; ++i) { const int rel = relb - 16 * (kt * 32 + (i & 3) + 8 * (i >> 2));
                    const float sv = rel >= 0 ? c[kt][i] + bias[i] : -2e30f; c[kt][i] = sv; mx = fmaxf(mx, sv); }
                asm volatile("" ::: "memory"); }
            mx = other_half_max(mx);
            float l = 0.f;
#pragma unroll
            for (int kt = 0; kt < 4; ++kt)
#pragma unroll
                for (int i = 0; i < 16; ++i) { const float pv = __builtin_amdgcn_exp2f(c[kt][i] - mx); c[kt][i] = pv; l += pv; }
            l = both_halves_sum(l);
            const float inv = 1.f / fmaxf(l, 1e-30f);
#pragma unroll
            for (int kt = 0; kt < 4; ++kt)
#pragma unroll
                for (int jj = 0; jj < 4; ++jj) { float own = (2.f * (c[kt][4 * jj] + c[kt][4 * jj + 1] + c[kt][4 * jj + 2]) + c[kt][4 * jj + 3]) * inv, p3 = c[kt][4 * jj + 3] * inv;
                    own += dpp_f<0xB1>(own); own += dpp_f<0x4E>(own); p3 += dpp_f<0xB1>(p3); p3 += dpp_f<0x4E>(p3);
                    if (r == 0) { const int j = kt * 8 + 2 * jj + hh; wl[512 + tok8 * 32 + j] = own; wl[768 + tok8 * 32 + j] = p3; } }
            f32x16 O0, O1;
#pragma unroll
            for (int i = 0; i < 16; ++i) { O0[i] = 0.f; O1[i] = 0.f; }
#pragma unroll
            for (int kt = 0; kt < 4; ++kt)
#pragma unroll
                for (int s2 = 0; s2 < 2; ++s2) { const f16x8 pb = pack8(c[kt], s2);
                    const f16x8 a0 = *(const GAS f16x8*)(vc + kt * 2048 + s2 * 512 + (hh * 32 + r31) * 8), a1 = *(const GAS f16x8*)(vc + kt * 2048 + (2 + s2) * 512 + (hh * 32 + r31) * 8);
                    O0 = __builtin_amdgcn_mfma_f32_32x32x16_f16(a0, pb, O0, 0, 0, 0); O1 = __builtin_amdgcn_mfma_f32_32x32x16_f16(a1, pb, O1, 0, 0, 0); asm volatile("" ::: "memory"); }
            const float sc = inv * g_c;
#pragma unroll
            for (int i = 0; i < 16; ++i) { TL[i * 64] = O0[i] * sc; TL[(16 + i) * 64] = O1[i] * sc; }
        }
        LDS_WAIT(); asm volatile("" ::: "memory");
        int lane2 = lane; asm volatile("" : "+v"(lane2));
        LAS float* OWN = wl + 512 + (lane2 >> 5) * 32 + (lane2 & 31); LAS float* P3 = OWN + 256; LAS float* VAL = OWN + 512;
#pragma unroll
        for (int pp = 0; pp < 4; ++pp) { const int tk = 2 * pp + hh, j = r31, cur = (t0 + tk) >> 6;
            const float impv = OWN[pp * 64] + (j > 0 ? P3[pp * 64 - (j > 0 ? 1 : 0)] : 0.f);
            VAL[pp * 64] = (j == 0 || j == cur || j == cur - 1) ? 1e4f : (j <= cur ? impv : -1e30f); }
        LDS_WAIT(); asm volatile("" ::: "memory");
#pragma unroll
        for (int pp = 0; pp < 4; ++pp) { const int tk = 2 * pp + hh, j = r31, cur = (t0 + tk) >> 6; const float v = VAL[pp * 64]; int cnt = 0; const LAS float* vrow = VAL + pp * 64 - j;
#pragma unroll
            for (int j2 = 0; j2 < 32; ++j2) { const float o = vrow[j2]; cnt += (o > v || (o == v && j2 < j)) ? 1 : 0; }
            const unsigned long long bm = __ballot(cnt < 8 && j <= cur);
            const unsigned mym = hh ? (unsigned)(bm >> 32) : (unsigned)bm;
            if (j == 0) SELM[tk] = mym; }
        LDS_WAIT(); asm volatile("" ::: "memory");
        const unsigned selm = SELM[tok8];
        unsigned um = 0u;
#pragma unroll
        for (int i = 0; i < 8; ++i) um |= SELM[i];
        um = (unsigned)__builtin_amdgcn_readfirstlane((int)um);
        const int kthi = (t0 + 7) >> 5;
        const unsigned long long causal = (kthi >= 63) ? ~0ull : ((1ull << (kthi + 1)) - 1ull);
        {
            unsigned long long x = um;
            x = (x | (x << 16)) & 0x0000FFFF0000FFFFull; x = (x | (x << 8)) & 0x00FF00FF00FF00FFull; x = (x | (x << 4)) & 0x0F0F0F0F0F0F0F0Full;
            x = (x | (x << 2)) & 0x3333333333333333ull; x = (x | (x << 1)) & 0x5555555555555555ull;
            const unsigned long long tm = (x | (x << 1)) & causal;
            attn_branch((const f16*)(ws + WS_KN) + (size_t)bg * SEQ * 64, (const f16*)(ws + WS_VT) + (size_t)bg * 64 * SEQ, tm, bq, t0, t, r31, hh, 1 << 30, selm, cfar, lutr, g_s, TL);
        }
        {
            const int lo = t0 - 511 > 0 ? (t0 - 511) >> 5 : 0;
            const unsigned long long tm = causal & ~((1ull << lo) - 1ull);
            attn_branch((const f16*)(ws + WS_KN) + (size_t)(BATCH * 4 + bg) * SEQ * 64, (const f16*)(ws + WS_VT) + (size_t)(BATCH * 4 + bg) * 64 * SEQ, tm, bq, t0, t, r31, hh, 512, 0xFFFFFFFFu, cfar, lutr, g_w, TL);
        }
        f16* orow = CAT + m * D + 1024 + head * 64 + 4 * hh;
#pragma unroll
        for (int jj = 0; jj < 4; ++jj) {
            u32x2 o0; o0.x = pk_f16(TL[(4 * jj) * 64], TL[(4 * jj + 1) * 64]); o0.y = pk_f16(TL[(4 * jj + 2) * 64], TL[(4 * jj + 3) * 64]); *(GAS u32x2*)(orow + 8 * jj) = o0;
            u32x2 o1; o1.x = pk_f16(TL[(16 + 4 * jj) * 64], TL[(16 + 4 * jj + 1) * 64]); o1.y = pk_f16(TL[(16 + 4 * jj + 2) * 64], TL[(16 + 4 * jj + 3) * 64]); *(GAS u32x2*)(orow + 32 + 8 * jj) = o1; }
    }
}

__device__ __forceinline__ void cvt_row_fp6(const f32x4 (&v)[8], int row, unsigned char* dst6, float* scales, int lane) {
    float amax = 0.f;
#pragma unroll
    for (int c = 0; c < 8; ++c) amax = fmaxf(amax, fmaxf(fmaxf(fabsf(v[c].x), fabsf(v[c].y)), fmaxf(fabsf(v[c].z), fabsf(v[c].w))));
    amax = wave_max(amax);
    const float scale = amax > 0.f ? amax * (1.f / 7.5f) : 1.f, inv = 1.f / scale;
    f16x32 h;
#pragma unroll
    for (int c = 0; c < 8; ++c) { h[4 * c] = (f16)(v[c].x * inv); h[4 * c + 1] = (f16)(v[c].y * inv); h[4 * c + 2] = (f16)(v[c].z * inv); h[4 * c + 3] = (f16)(v[c].w * inv); }
    const u32x6 pk = __builtin_amdgcn_cvt_scalef32_pk32_fp6_f16(h, 1.0f);
    unsigned char* d = dst6 + (size_t)(lane >> 3) * SLICE6;
    *(GAS u32x4*)(d + (size_t)row * 128 + (lane & 7) * 16) = (u32x4){pk[0], pk[1], pk[2], pk[3]}; *(GAS u32x2*)(d + 2097152 + (size_t)row * 64 + (lane & 7) * 8) = (u32x2){pk[4], pk[5]};
    if (lane == 0) scales[row] = scale;
}
__device__ __forceinline__ void cvt_table_fp6(Frame& F, const float* src, unsigned char* dst6, float* scales, const float* colw) {
    const int gw = F.vcu * NWAVES + F.wave, NGW = F.G * NWAVES, lane = F.lane;
    int row = gw;
    for (; row + NGW < 16384; row += 2 * NGW) {
        f32x4 va[8], vb[8];
#pragma unroll
        for (int c = 0; c < 8; ++c) { va[c] = __builtin_nontemporal_load((const GAS f32x4*)(src + (size_t)row * D + c * 256 + lane * 4)); vb[c] = __builtin_nontemporal_load((const GAS f32x4*)(src + (size_t)(row + NGW) * D + c * 256 + lane * 4)); }
        if (colw) {
#pragma unroll
            for (int c = 0; c < 8; ++c) { const f32x4 wv = *(const GAS f32x4*)(colw + c * 256 + lane * 4); va[c] = va[c] * wv; vb[c] = vb[c] * wv; } }
        cvt_row_fp6(va, row, dst6, scales, lane); cvt_row_fp6(vb, row + NGW, dst6, scales, lane);
    }
    for (; row < 16384; row += NGW) { f32x4 va[8];
#pragma unroll
        for (int c = 0; c < 8; ++c) { va[c] = *(const GAS f32x4*)(src + (size_t)row * D + c * 256 + lane * 4); if (colw) va[c] = va[c] * *(const GAS f32x4*)(colw + c * 256 + lane * 4); }
        cvt_row_fp6(va, row, dst6, scales, lane); }
}
__device__ __forceinline__ void p7_tables(Frame& F) {
    cvt_table_fp6(F, F.in[I_PU], F.ws + WS_U6, (float*)(F.ws + WS_SU), F.in[I_FFNNW]);
    cvt_table_fp6(F, F.in[I_PV], F.ws + WS_V6, (float*)(F.ws + WS_SV), nullptr);
}

__device__ __forceinline__ void bitonic_sort16_desc(float (&a)[16]) {
#pragma unroll
    for (int k = 2; k <= 16; k <<= 1)
#pragma unroll
        for (int j = k >> 1; j > 0; j >>= 1)
#pragma unroll
            for (int i = 0; i < 16; ++i) { const int l = i ^ j; if (l > i) { const float hi = fmaxf(a[i], a[l]), lo = fminf(a[i], a[l]); if ((i & k) == 0) { a[i] = hi; a[l] = lo; } else { a[i] = lo; a[l] = hi; } } }
}
__device__ __forceinline__ void bitonic_merge16_desc(float (&a)[16]) {
#pragma unroll
    for (int dist = 8; dist >= 1; dist >>= 1)
#pragma unroll
        for (int i = 0; i < 16; ++i) if ((i & dist) == 0) { const float hi = fmaxf(a[i], a[i + dist]), lo = fminf(a[i], a[i + dist]); a[i] = hi; a[i + dist] = lo; }
}
#define INS16(top, v) do { _Pragma("unroll") for (int _j = 0; _j < 16; ++_j) { const float _h = fmaxf(top[_j], v); v = fminf(top[_j], v); top[_j] = _h; } } while (0)
#define INS16P(tv, ti, v, i) do { _Pragma("unroll") for (int _j = 0; _j < 16; ++_j) { const bool _c = v > tv[_j]; const float _nv = _c ? tv[_j] : v; const unsigned _ni = _c ? ti[_j] : i; \
        tv[_j] = _c ? v : tv[_j]; ti[_j] = _c ? i : ti[_j]; v = _nv; i = _ni; } } while (0)
typedef unsigned v4u_t __attribute__((__vector_size__(16)));
typedef unsigned v2u_t __attribute__((__vector_size__(8)));
__device__ __forceinline__ void p9a_topk(Frame& F) {
    unsigned char* ws = F.ws;
    const f16* QP = (const f16*)(ws + WS_QP); const f16* KEYS = (const f16*)(ws + WS_KEYS);
    unsigned* LIDX = (unsigned*)(ws + WS_LIDX); float* LG = (float*)(ws + WS_LG);
    const int lane = F.lane, r31 = lane & 31, hh = lane >> 5;
    const float NINF = -__builtin_inff();
    for (int unit = F.vcu; unit < M / 32; unit += F.G) {
        const int m0 = unit * 32;
        {
            const int h = F.wave;
            float sl[2][16];
            f16x8 bq[2][8];
#pragma unroll
            for (int p = 0; p < 2; ++p)
#pragma unroll
                for (int ks = 0; ks < 8; ++ks) bq[p][ks] = *(const GAS f16x8*)(QP + (size_t)(m0 + r31) * D + (h * 2 + p) * 128 + ks * 16 + hh * 8);
            f16x8 ka[2][8];
#pragma unroll
            for (int ks = 0; ks < 8; ++ks) ka[0][ks] = *(const GAS f16x8*)(KEYS + ((size_t)((h * 2) * 128 + r31)) * 128 + hh * 8 + ks * 16);
            float top[16];
#pragma unroll
            for (int st = 0; st < 8; ++st) { const int p = st >> 2, kt = st & 3;
                if (kt == 0) {
#pragma unroll
                    for (int j = 0; j < 16; ++j) top[j] = NINF; }
                if (st + 1 < 8) { const int pn = (st + 1) >> 2, ktn = (st + 1) & 3;
#pragma unroll
                    for (int ks = 0; ks < 8; ++ks) ka[(st + 1) & 1][ks] = *(const GAS f16x8*)(KEYS + ((size_t)((h * 2 + pn) * 128 + ktn * 32 + r31)) * 128 + hh * 8 + ks * 16); }
                f32x16 c;
#pragma unroll
                for (int i = 0; i < 16; ++i) c[i] = 0.f;
#pragma unroll
                for (int ks = 0; ks < 8; ++ks) c = __builtin_amdgcn_mfma_f32_32x32x16_f16(ka[st & 1][ks], bq[p][ks], c, 0, 0, 0);
                const unsigned k4 = (unsigned)(kt * 32 + 4 * hh);
                float nv[16];
#pragma unroll
                for (int reg = 0; reg < 16; ++reg) { const unsigned key = k4 + (unsigned)((reg & 3) + 8 * (reg >> 2)); nv[reg] = __uint_as_float((__float_as_uint(c[reg]) & ~127u) | key); }
                bitonic_sort16_desc(nv);
#pragma unroll
                for (int j = 0; j < 16; ++j) top[j] = fmaxf(top[j], nv[15 - j]);
                bitonic_merge16_desc(top);
                if (kt == 3) {
                    float cm[16];
#pragma unroll
                    for (int j = 0; j < 16; ++j) cm[j] = fmaxf(top[j], __uint_as_float(other32u(__float_as_uint(top[15 - j]), hh != 0)));
                    bitonic_merge16_desc(cm);
#pragma unroll
                    for (int j = 0; j < 16; ++j) sl[p][j] = cm[j]; }
            }
            float vx[16], vy[16]; unsigned ix[16], iy[16];
#pragma unroll
            for (int j = 0; j < 16; ++j) { const unsigned bx = __float_as_uint(hh ? sl[1][j] : sl[0][j]), by = __float_as_uint(hh ? sl[0][j] : sl[1][j]);
                vx[j] = __uint_as_float(bx & ~127u); vy[j] = __uint_as_float(by & ~127u); ix[j] = (bx & 127u) * (hh ? 1u : 128u); iy[j] = (by & 127u) * (hh ? 128u : 1u); }
            float tv[16]; unsigned ti[16];
#pragma unroll
            for (int j = 0; j < 16; ++j) { const int jb = j + 1 < 16 ? j + 1 : 15;
                const float v0 = vx[0] + vy[j], v1 = (j < 15) ? vx[0] + vy[jb] : NINF; const unsigned i0 = ix[0] + iy[j], i1 = ix[0] + iy[jb];
                tv[j] = hh ? v1 : v0; ti[j] = hh ? i1 : i0; }
#pragma unroll
            for (int a = 1; a < 4; ++a) { const int bmax = (a == 1) ? 7 : (a == 2 ? 4 : 3);
#pragma unroll
                for (int b = a; b <= bmax; ++b) { float v = vx[a] + vy[b]; if (a == b) v = hh ? NINF : v; unsigned i = ix[a] + iy[b]; INS16P(tv, ti, v, i); } }
            float mv[16]; unsigned mi[16];
#pragma unroll
            for (int j = 0; j < 16; ++j) { const float pv = __uint_as_float(other32u(__float_as_uint(tv[15 - j]), hh != 0)); const unsigned pi = other32u(ti[15 - j], hh != 0); const bool c = pv > tv[j]; mv[j] = c ? pv : tv[j]; mi[j] = c ? pi : ti[j]; }
            float mx = mv[0];
#pragma unroll
            for (int j = 1; j < 16; ++j) mx = fmaxf(mx, mv[j]);
            float sum = 0.f;
#pragma unroll
            for (int j = 0; j < 16; ++j) { mv[j] = __builtin_amdgcn_exp2f((mv[j] - mx) * LOG2E); sum += mv[j]; }
            const float inv = 1.f / sum;
#pragma unroll
            for (int j = 0; j < 8; ++j) { { const int e_ = h * 16 + hh * 8 + j, pos_ = (e_ & 63) * 2 + (e_ >> 6); LIDX[(size_t)(m0 + r31) * 128 + pos_] = mi[j]; LG[(size_t)(m0 + r31) * 128 + pos_] = mv[j] * inv; } }
        }
    }
}
struct Seg6 { v4u_t a; v2u_t b; };
__device__ __forceinline__ f16x32 seg6_decode(const Seg6& r) { const u32x6 p = {r.a[0], r.a[1], r.a[2], r.a[3], r.b[0], r.b[1]}; return __builtin_amdgcn_cvt_scalef32_pk32_f16_fp6(p, 1.0f); }
__device__ __forceinline__ f16x32 seg6_dec2(const v4u_t& a, const v2u_t& b) { const u32x6 p = {a[0], a[1], a[2], a[3], b[0], b[1]}; return __builtin_amdgcn_cvt_scalef32_pk32_f16_fp6(p, 1.0f); }
#define SEG_DECL(P) v4u_t P##a0, P##a1, P##a2, P##a3, P##a4, P##a5, P##a6, P##a7; v2u_t P##b0, P##b1, P##b2, P##b3, P##b4, P##b5, P##b6, P##b7
#define SEG_L1(P, G, idxv) do { const int e_ = __shfl(idxv, 8 * G + sub); P##a##G = __builtin_amdgcn_raw_buffer_load_b128(rs, e_ * 128 + ch * 16, 0, 0); P##b##G = __builtin_amdgcn_raw_buffer_load_b64(rs, 2097152 + e_ * 64 + ch * 8, 0, 0); } while (0)
#define SEG_LOAD(P, idxv) do { SEG_L1(P, 0, idxv); SEG_L1(P, 1, idxv); SEG_L1(P, 2, idxv); SEG_L1(P, 3, idxv); SEG_L1(P, 4, idxv); SEG_L1(P, 5, idxv); SEG_L1(P, 6, idxv); SEG_L1(P, 7, idxv); } while (0)
__device__ __forceinline__ float u_one(const v4u_t& a, const v2u_t& b, const f16x2 (&xp)[16]) {
    const f16x32 hv = seg6_dec2(a, b); float sdot = 0.f;
#pragma unroll
    for (int k = 0; k < 16; ++k) { f16x2 hp; hp.x = hv[2 * k]; hp.y = hv[2 * k + 1]; sdot = __builtin_amdgcn_fdot2(hp, xp[k], sdot, false); }
    return sum8(sdot);
}
#define SEG_LE(P, G, ev) do { const int e_ = (ev); P##a##G = __builtin_amdgcn_raw_buffer_load_b128(rs, e_ * 128 + ch * 16, 0, 0); P##b##G = __builtin_amdgcn_raw_buffer_load_b64(rs, 2097152 + e_ * 64 + ch * 8, 0, 0); } while (0)
#define EN_GATHER(en, iA, iB) do { _Pragma("unroll") for (int g_ = 0; g_ < 8; ++g_) { en[g_] = __shfl(iA, 8 * g_ + sub); en[8 + g_] = __shfl(iB, 8 * g_ + sub); } } while (0)
#define U_ROLL1(P, G, res, eo) do { const float d_ = u_one(P##a##G, P##b##G, xp); res = (ch == G) ? d_ : res; SEG_LE(P, G, en[(eo) + G]); } while (0)
#define U_ROLL(P, res, idxn) do { U_ROLL1(P, 0, res, idxn); U_ROLL1(P, 1, res, idxn); U_ROLL1(P, 2, res, idxn); U_ROLL1(P, 3, res, idxn); U_ROLL1(P, 4, res, idxn); U_ROLL1(P, 5, res, idxn); U_ROLL1(P, 6, res, idxn); U_ROLL1(P, 7, res, idxn); } while (0)
#define V_ROLL1(P, G, hwv, eo) do { v_one(P##a##G, P##b##G, acc, hq[(eo) + G]); SEG_LE(P, G, en[(eo) + G]); } while (0)
#define V_ROLL(P, hwv, idxn) do { V_ROLL1(P, 0, hwv, idxn); V_ROLL1(P, 1, hwv, idxn); V_ROLL1(P, 2, hwv, idxn); V_ROLL1(P, 3, hwv, idxn); V_ROLL1(P, 4, hwv, idxn); V_ROLL1(P, 5, hwv, idxn); V_ROLL1(P, 6, hwv, idxn); V_ROLL1(P, 7, hwv, idxn); } while (0)
#define FMIXV_LO(a, h, w) asm("v_fma_mix_f32 %0, %1, %2, %0 op_sel_hi:[1,0,0]" : "+v"(a) : "v"(h), "v"(w))
#define FMIXV_HI(a, h, w) asm("v_fma_mix_f32 %0, %1, %2, %0 op_sel:[1,0,0] op_sel_hi:[1,0,0]" : "+v"(a) : "v"(h), "v"(w))
__device__ __forceinline__ void v_one(const v4u_t& a, const v2u_t& b, f16x2 (&acc)[16], f16x2 wq) {
    const f16x32 hv = seg6_dec2(a, b);
#pragma unroll
    for (int k = 0; k < 16; ++k) { f16x2 hp; hp.x = hv[2 * k]; hp.y = hv[2 * k + 1]; acc[k] = __builtin_elementwise_fma(hp, wq, acc[k]); }
}
#define V_HALF(P, hwv) do { v_one(P##a0, P##b0, acc, hwv, sub); v_one(P##a1, P##b1, acc, hwv, 8 + sub); v_one(P##a2, P##b2, acc, hwv, 16 + sub); v_one(P##a3, P##b3, acc, hwv, 24 + sub); \
        v_one(P##a4, P##b4, acc, hwv, 32 + sub); v_one(P##a5, P##b5, acc, hwv, 40 + sub); v_one(P##a6, P##b6, acc, hwv, 48 + sub); v_one(P##a7, P##b7, acc, hwv, 56 + sub); } while (0)
__device__ __forceinline__ void p9b_upass(Frame& F, bool probe_slice0) {
    unsigned char* ws = F.ws;
    const int x = blockIdx.x & 7, rank = blockIdx.x >> 3, cnt = (F.G - x + 7) >> 3;
    const int lane = F.lane, sub = lane >> 3, ch = lane & 7;
    const __amdgpu_buffer_rsrc_t rs = __builtin_amdgcn_make_buffer_rsrc((void*)(ws + WS_U6 + (size_t)(probe_slice0 ? 0 : x) * SLICE6), 0, (int)SLICE6, 0x00020000);
    const f16* XN = (const f16*)(ws + WS_XR) + x * 32 + (lane >> 3) * 256 + (lane & 7) * 4;
    const u32x2* LI2 = (const u32x2*)(ws + WS_LIDX); LAS unsigned char* xl = F.lds + F.wave * 512;
    const int tstep = cnt * NWAVES; int t = rank * NWAVES + F.wave;
    if (t >= M) return;
    int cA, cB, nA, nB; { const u32x2 c2 = LI2[(size_t)t * 64 + lane]; cA = (int)c2.x; cB = (int)c2.y; }
    const int t1c = (t + tstep < M) ? t + tstep : t;
    { const u32x2 n2 = LI2[(size_t)t1c * 64 + lane]; nA = (int)n2.x; nB = (int)n2.y; }
    u32x2 xcur = *(const GAS u32x2*)(XN + (size_t)t * D);
    f16x2 xp[16];
    SEG_DECL(bA); SEG_DECL(bB);
    { const int li_ = cA; SEG_LOAD(bA, li_); } { const int li_ = cB; SEG_LOAD(bB, li_); }
#pragma unroll 1
    for (;;) {
        const int tn = t + tstep, tnn = tn + tstep; const bool hn = tn < M, hnn = tnn < M;
        const int tnc = hn ? tn : t, tnnc = hnn ? tnn : t;
        const u32x2 m2 = LI2[(size_t)tnnc * 64 + lane]; const int mA = (int)m2.x, mB = (int)m2.y;
        const u32x2 xnext = *(const GAS u32x2*)(XN + (size_t)tnc * D);
        *(LAS u32x2*)(xl + ((lane & 7) * 8 + (lane >> 3)) * 8) = xcur;
        LDS_WAIT(); asm volatile("" ::: "memory");
#pragma unroll
        for (int q = 0; q < 4; ++q) { const u32x4 tv = *(const LAS u32x4*)(xl + ch * 64 + q * 16); xp[4 * q] = ash2(tv.x); xp[4 * q + 1] = ash2(tv.y); xp[4 * q + 2] = ash2(tv.z); xp[4 * q + 3] = ash2(tv.w); }
        LDS_WAIT(); asm volatile("" ::: "memory");
        { const int lA_ = hn ? nA : cA, lB_ = hn ? nB : cB; int en[16]; EN_GATHER(en, lA_, lB_);
          float rA = 0.f, rB = 0.f; U_ROLL(bA, rA, 0); U_ROLL(bB, rB, 8);
          float* pd = (float*)(ws + WS_PD) + ((size_t)t * 8 + x) * 128 + 8 * ch + sub; pd[0] = rA; pd[64] = rB; }
        if (!hn) break;
        xcur = xnext;
        cA = nA; cB = nB; nA = mA; nB = mB; t = tn;
    }
}
__device__ __forceinline__ void p9h_weights(Frame& F) {
    unsigned char* ws = F.ws;
    const unsigned* LIDX = (const unsigned*)(ws + WS_LIDX); const float* LG = (const float*)(ws + WS_LG); const float* PD = (const float*)(ws + WS_PD);
    const float* SU = (const float*)(ws + WS_SU); const float* SV = (const float*)(ws + WS_SV); float* HW = (float*)(ws + WS_HW);
    const int gw = F.vcu * NWAVES + F.wave, NGW = F.G * NWAVES, lane = F.lane;
#pragma unroll 1
    for (int t0 = gw; t0 < M; t0 += 2 * NGW) {
        const int t1 = t0 + NGW < M ? t0 + NGW : t0;
        int iA[2], iB[2]; float pa[2][8], pb[2][8], lgA[2], lgB[2], s1[2];
#pragma unroll
        for (int q = 0; q < 2; ++q) { const int t = q ? t1 : t0; { const u32x2 i2 = ((const u32x2*)LIDX)[(size_t)t * 64 + lane]; iA[q] = (int)i2.x; iB[q] = (int)i2.y; }
#pragma unroll
            for (int xs = 0; xs < 8; ++xs) { pa[q][xs] = PD[((size_t)t * 8 + xs) * 128 + lane]; pb[q][xs] = PD[((size_t)t * 8 + xs) * 128 + 64 + lane]; }
            { const f32x2 g2 = ((const f32x2*)LG)[(size_t)t * 64 + lane]; lgA[q] = g2.x; lgB[q] = g2.y; } s1[q] = ((const float*)(ws + WS_SS1))[t]; }
#pragma unroll
        for (int q = 0; q < 2; ++q) { const int t = q ? t1 : t0; float zA = 0.f, zB = 0.f;
#pragma unroll
            for (int xs = 0; xs < 8; ++xs) { zA += pa[q][xs]; zB += pb[q][xs]; }
            const float rs1 = 1.f / sqrtf(s1[q] * (1.f / D) + RMS_EPS);
            ((f32x2*)HW)[(size_t)t * 64 + lane] = (f32x2){pg8::gelu1(zA * rs1 * SU[iA[q]]) * lgA[q] * SV[iA[q]], pg8::gelu1(zB * rs1 * SU[iB[q]]) * lgB[q] * SV[iB[q]]}; }
    }
}
__device__ __forceinline__ void p9c_vpass(Frame& F) {
    unsigned char* ws = F.ws;
    const int x = blockIdx.x & 7, rank = blockIdx.x >> 3, cnt = (F.G - x + 7) >> 3;
    const int lane = F.lane, sub = lane >> 3, ch = lane & 7;
    const __amdgpu_buffer_rsrc_t rs = __builtin_amdgcn_make_buffer_rsrc((void*)(ws + WS_V6 + (size_t)x * SLICE6), 0, (int)SLICE6, 0x00020000);
    const u32x2* LI2 = (const u32x2*)(ws + WS_LIDX);
    f16* XR = (f16*)(ws + WS_XR); float* SS2 = (float*)(ws + WS_SS2);
    const bool b3 = (lane & 8) != 0, b4 = (lane & 16) != 0, b5 = (lane & 32) != 0;
    const int col = ((b3 ? 4 : 0) + (b4 ? 2 : 0) + (b5 ? 1 : 0)) * 256 + x * 32 + ch * 4;
    const int tstep = cnt * NWAVES; int t = rank * NWAVES + F.wave;
    if (t >= M) return;
    int cA, cB, nA, nB; { const u32x2 c2 = LI2[(size_t)t * 64 + lane]; cA = (int)c2.x; cB = (int)c2.y; }
    const int t1c = (t + tstep < M) ? t + tstep : t;
    { const u32x2 n2 = LI2[(size_t)t1c * 64 + lane]; nA = (int)n2.x; nB = (int)n2.y; }
    const f32x2* HW2 = (const f32x2*)(ws + WS_HW);
    float hwA, hwB; { const f32x2 h2 = HW2[(size_t)t * 64 + lane]; hwA = h2.x; hwB = h2.y; }
    SEG_DECL(bA); SEG_DECL(bB);
    { const int li_ = cA; SEG_LOAD(bA, li_); } { const int li_ = cB; SEG_LOAD(bB, li_); }
#pragma unroll 1
    for (;;) {
        const int tn = t + tstep, tnn = tn + tstep; const bool hn = tn < M, hnn = tnn < M;
        const int tnc = hn ? tn : t, tnnc = hnn ? tnn : t;
        const u32x2 m2 = LI2[(size_t)tnnc * 64 + lane]; const int mA = (int)m2.x, mB = (int)m2.y;
        const f32x2 hn2 = HW2[(size_t)tnc * 64 + lane]; const float hwAn = hn2.x, hwBn = hn2.y;
        f16* orow = XR + (size_t)t * D + col; const u32x2 x1r = *(const GAS u32x2*)orow;
        f16x2 acc[16];
#pragma unroll
        for (int i = 0; i < 16; ++i) { acc[i].x = (f16)0.f; acc[i].y = (f16)0.f; }
        { const int lA_ = hn ? nA : cA, lB_ = hn ? nB : cB; int en[16]; EN_GATHER(en, lA_, lB_); f16x2 hq[16];
#pragma unroll
          for (int g_ = 0; g_ < 8; ++g_) { const float qa = __shfl(hwA, 8 * g_ + sub) * 64.f, qb = __shfl(hwB, 8 * g_ + sub) * 64.f;
              hq[g_].x = (f16)qa; hq[g_].y = (f16)qa; hq[8 + g_].x = (f16)qb; hq[8 + g_].y = (f16)qb; }
          V_ROLL(bA, hwA, 0); V_ROLL(bB, hwB, 8); }
        f16x2 q8[8];
#pragma unroll
        for (int i = 0; i < 8; ++i) { const f16x2 keep = b3 ? acc[8 + i] : acc[i], send = b3 ? acc[i] : acc[8 + i]; q8[i] = keep + ash2(other8u(__builtin_bit_cast(unsigned, send))); }
        f16x2 q4[4];
#pragma unroll
        for (int i = 0; i < 4; ++i) { const f16x2 keep = b4 ? q8[4 + i] : q8[i], send = b4 ? q8[i] : q8[4 + i]; q4[i] = keep + ash2(other16u(__builtin_bit_cast(unsigned, send), b4)); }
        float r4[4];
        { const f16x2 k0 = b5 ? q4[2] : q4[0], k1 = b5 ? q4[3] : q4[1], s0 = b5 ? q4[0] : q4[2], s1 = b5 ? q4[1] : q4[3];
          const f16x2 p0 = ash2(other32u(__builtin_bit_cast(unsigned, s0), b5)), p1 = ash2(other32u(__builtin_bit_cast(unsigned, s1), b5));
          r4[0] = ((float)k0.x + (float)p0.x) * (1.f / 64.f); r4[1] = ((float)k0.y + (float)p0.y) * (1.f / 64.f); r4[2] = ((float)k1.x + (float)p1.x) * (1.f / 64.f); r4[3] = ((float)k1.y + (float)p1.y) * (1.f / 64.f); }
        const f16x2 x1a = ash2(x1r.x), x1b = ash2(x1r.y);
        const f32x4 x2 = {(float)x1a.x + r4[0], (float)x1a.y + r4[1], (float)x1b.x + r4[2], (float)x1b.y + r4[3]};
        { u32x2 o2; o2.x = pk_f16(x2.x, x2.y); o2.y = pk_f16(x2.z, x2.w); *(GAS u32x2*)orow = o2; }
        const float ss = wave_sum((x2.x * x2.x + x2.y * x2.y) + (x2.z * x2.z + x2.w * x2.w));
        if (lane == 0) atomicAdd(SS2 + t, ss);
        if (!hn) break;
        cA = nA; cB = nB; nA = mA; nB = mB; t = tn; hwA = hwAn; hwB = hwBn;
    }
}
#undef FMIXV_LO
#undef FMIXV_HI

constexpr int NPH = 13;
struct Args { const float* in[26]; float* out; unsigned char* ws; int ph_lo, ph_hi; int rep[16]; };
__global__ void __launch_bounds__(NWAVES * 64, 2) fwd_kernel(Args args) {
    extern __shared__ __attribute__((aligned(16))) unsigned char lds[];
    Frame F;
    F.lds = (LAS unsigned char*)lds;
    F.MISC = (volatile LAS unsigned*)(F.lds + MISC_OFF);
    F.tid = threadIdx.x; F.lane = F.tid & 63; F.wave = __builtin_amdgcn_readfirstlane(F.tid >> 6);
    F.G = gridDim.x; { const int bx = blockIdx.x; F.vcu = (F.G % 8 == 0) ? (bx % 8) * (F.G / 8) + bx / 8 : bx; }
#pragma unroll
    for (int i = 0; i < 26; ++i) F.in[i] = args.in[i];
    F.out = args.out; F.ws = args.ws;
    unsigned char* ws = args.ws;
    gu32* ctl = (gu32*)(ws + WS_CTL);
    for (int u = F.tid; u < (LDS_BYTES - LDSCTL_OFF) / 4; u += NWAVES * 64) ((LAS unsigned*)(F.lds + LDSCTL_OFF))[u] = 0u;
    __syncthreads();
    XcdBarrier bar; bar.bar = (unsigned*)(ctl + CW_BAR); bar.x = 0; bar.st = nullptr;
    if (MK_ONE_LAUNCH) bar = xcd_barrier_post((unsigned*)(ctl + CW_BAR), F.MISC + 8);
#define GRID_BAR() do { if (MK_ONE_LAUNCH) xcd_barrier(bar); } while (0)
    const int lo = args.ph_lo, hi = args.ph_hi;
#define IN(k) (lo <= (k) && (k) < hi)
#define BOTH(k) (IN(k) && IN((k) + 1))

    if (IN(0)) { for (int rp = 0; rp < args.rep[0]; ++rp) p0_prologue(F); if (BOTH(0)) GRID_BAR(); }

    if (IN(1)) {
        pg8::Gemm g{(const f16*)(ws + WS_XR), (const f16*)(ws + WS_WIN), M, NINP, D, D, D, 0, 1 << 30, 0};
        pg8::StaticOrder S; S.init(M, NINP, F.G, (int)blockIdx.x);
        pg8::EpiF16Row E{(f16*)(ws + WS_Y), NINP, (const float*)(ws + WS_SS0)};
        pg8::gemm_phase(F.lds, g, S, E);
        if (BOTH(1)) GRID_BAR();
    }

    if (IN(2)) { for (int rp = 0; rp < PROBE_REP2; ++rp) p2_post(F); if (BOTH(2)) GRID_BAR(); }

    if (IN(3)) {
        { pg8::Gemm g{(const f16*)(ws + WS_FLATA), (const f16*)(ws + WS_W1C), 8192, 1024, 512, D, D, 512, 16, (size_t)256 * D * 2, 512};
          pg8::StaticOrder S; S.init(8192, 1024, F.G, (int)blockIdx.x);
          pg8::EpiRawF32 E{(float*)(ws + WS_Y), 1024};
          pg8::gemm_phase(F.lds, g, S, E); }
        { pg8::Gemm g{(const f16*)(ws + WS_MIXED), (const f16*)(ws + WS_POOLT), M, 1024, 256, 1024, 256, 256, 1 << 30, 0};
          pg8::StaticOrder S; S.init(M, 1024, F.G, (int)((blockIdx.x + 128) % F.G));
          pg8::EpiF16<0> E{(f16*)(ws + WS_CAT), D, nullptr, 1 << 30, 0};
          pg8::gemm_phase(F.lds, g, S, E); }
        if (BOTH(3)) GRID_BAR();
    }

    if (IN(4)) { p4_compress2(F); if (BOTH(4)) GRID_BAR(); }

    if (IN(5)) { for (int rp = 0; rp < args.rep[5]; ++rp) p5_attention(F); if (BOTH(5)) GRID_BAR(); }

    if (IN(6)) {
        pg8::Gemm g{(const f16*)(ws + WS_CAT), (const f16*)(ws + WS_WOUT), M, D, D, D, D, 0, 1 << 30, 0};
        pg8::StaticOrder S; S.init(M, D, F.G, (int)blockIdx.x);
        pg8::EpiRes16 E{(f16*)(ws + WS_XR), (float*)(ws + WS_SS1)};
        pg8::gemm_phase(F.lds, g, S, E);
        if (BOTH(6)) GRID_BAR();
    }

    if (IN(7)) {
        { pg8::Gemm g{(const f16*)(ws + WS_XR), (const f16*)(ws + WS_WQ), M, D, D, D, D, 0, 1 << 30, 0};
          pg8::StaticOrder S; S.init(M, D, F.G, (int)blockIdx.x);
          pg8::EpiF16Row E{(f16*)(ws + WS_QP), D, (const float*)(ws + WS_SS1)};
          pg8::gemm_phase(F.lds, g, S, E); }
        { pg8::Gemm g{(const f16*)(ws + WS_P16), (const f16*)(ws + WS_WPJ), M, D, 256, 256, 256, 0, 1 << 30, 0};
          pg8::StaticOrder S; S.init(M, D, F.G, (int)blockIdx.x);
          pg8::EpiF16<0> E{(f16*)(ws + WS_PJ), D, nullptr, 1 << 30, 0};
          pg8::gemm_phase(F.lds, g, S, E); }
        for (int rp = 0; rp < args.rep[7]; ++rp) p7_tables(F);
        if (BOTH(7)) GRID_BAR();
    }

    if (IN(8)) { p9a_topk(F); if (BOTH(8)) GRID_BAR(); }
    if (IN(9)) { if (PROBE_DUPU) p9b_upass(F, false); p9b_upass(F, false); if (BOTH(9)) GRID_BAR(); }
    if (IN(10)) { p9h_weights(F); if (BOTH(10)) GRID_BAR(); }
    if (IN(11)) { p9c_vpass(F); if (BOTH(11)) GRID_BAR(); }

    if (IN(12)) {
        pg8::Gemm g{(const f16*)(ws + WS_XR), (const f16*)(ws + WS_WG), M, D, D, D, D, 0, 1 << 30, 0};
        pg8::StaticOrder S; S.init(M, D, F.G, (int)blockIdx.x);
        pg8::EpiFinal E{(const f16*)(ws + WS_XR), (const f16*)(ws + WS_PJ), F.out, (const float*)(ws + WS_SS2)};
        pg8::gemm_phase(F.lds, g, S, E);
    }
#undef IN
#undef BOTH
}

extern "C" void kernel_launch(void* const* d_in, const int* in_sizes, int n_in, void* d_out, int out_size, void* d_ws, size_t ws_size, hipStream_t stream) {
    static int grid = 0;
    if (grid == 0) {
        if (n_in != 26 || out_size != M * D || ws_size < WS_END) { fprintf(stderr, "kernel_launch: unexpected sizes n_in %d out %d ws %zu\n", n_in, out_size, ws_size); grid = -1; return; }
        int dev = 0, cus = 0, per_cu = 0;
        if (hipGetDevice(&dev) != hipSuccess || hipDeviceGetAttribute(&cus, hipDeviceAttributeMultiprocessorCount, dev) != hipSuccess) { grid = -1; return; }
        if (hipFuncSetAttribute((const void*)fwd_kernel, hipFuncAttributeMaxDynamicSharedMemorySize, LDS_BYTES) != hipSuccess) { fprintf(stderr, "kernel_launch: hipFuncSetAttribute failed\n"); grid = -1; return; }
        if (hipOccupancyMaxActiveBlocksPerMultiprocessor(&per_cu, (const void*)fwd_kernel, NWAVES * 64, LDS_BYTES) != hipSuccess || per_cu < 1)
            fprintf(stderr, "kernel_launch: occupancy query reports %d\n", per_cu);
        (void)hipGetLastError();
        grid = cus;
    }
    if (grid < 0) return;
    (void)hipMemsetAsync((char*)d_ws + WS_CTL, 0, CTL_ZERO_BYTES, stream);
    Args a{};
    for (int i = 0; i < 16; ++i) a.rep[i] = 1;
    a.rep[5] = PROBE_REP5; a.rep[0] = PROBE_REP0; a.rep[7] = PROBE_REP7;
    for (int i = 0; i < 26; ++i) a.in[i] = (const float*)d_in[i];
    a.out = (float*)d_out; a.ws = (unsigned char*)d_ws;
    if (MK_ONE_LAUNCH) { a.ph_lo = 0; a.ph_hi = NPH; hipLaunchKernelGGL(fwd_kernel, dim3(grid), dim3(NWAVES * 64), LDS_BYTES, stream, a); }
    else for (int p = 0; p < NPH; ++p) { a.ph_lo = p; a.ph_hi = p + 1; hipLaunchKernelGGL(fwd_kernel, dim3(grid), dim3(NWAVES * 64), LDS_BYTES, stream, a); }
}
```

```cpp
#include <hip/hip_runtime.h>
#include <cstdio>
#include <cstdint>

#define PROBE_REP0 1
#define PROBE_REP2 1
#define PROBE_DUPU 0
#define PROBE_REP5 1
#define PROBE_REP7 1
#define PROBE_REP9 1
#ifndef MK_ONE_LAUNCH
#define MK_ONE_LAUNCH 1
#endif

#define GAS __attribute__((address_space(1)))
#define LAS __attribute__((address_space(3)))
typedef _Float16 f16;
typedef _Float16 f16x8 __attribute__((ext_vector_type(8)));
typedef _Float16 f16x4 __attribute__((ext_vector_type(4)));
typedef _Float16 f16x2 __attribute__((ext_vector_type(2)));
typedef float f32x2 __attribute__((ext_vector_type(2)));
typedef float f32x4 __attribute__((ext_vector_type(4)));
typedef float f32x16 __attribute__((ext_vector_type(16)));
typedef unsigned u32x2 __attribute__((ext_vector_type(2)));
typedef unsigned u32x4 __attribute__((ext_vector_type(4)));
typedef GAS unsigned gu32;
typedef _Float16 f16x32 __attribute__((ext_vector_type(32)));
typedef unsigned u32x6 __attribute__((ext_vector_type(6)));
#define RLX_AGENT __ATOMIC_RELAXED, __HIP_MEMORY_SCOPE_AGENT
#define LDS_WAIT() asm volatile("s_waitcnt lgkmcnt(0)" ::: "memory")
#define VM_WAIT() asm volatile("s_waitcnt vmcnt(0)" ::: "memory")

constexpr int BATCH = 8, SEQ = 2048, D = 2048, M = BATCH * SEQ;
constexpr int NIN = 3632, NINP = 3840;
constexpr int OFF_U = 0, OFF_Q = 1024, OFF_KC = 2048, OFF_VC = 2304, OFF_KS = 2560, OFF_VS = 2816, OFF_KW = 3072, OFF_VW = 3328, OFF_G = 3584;
constexpr int NCMP = 127, NCROWS = BATCH * NCMP * 4;
constexpr float RMS_EPS = 1e-6f;
constexpr float LOG2E = 1.4426950408889634f;

constexpr size_t MiB = 1u << 20;
constexpr size_t WS_CTL = 0, CTL_ZERO_BYTES = 1 * MiB;
constexpr size_t WS_WIN = 2 * MiB, WS_WOUT = 17 * MiB, WS_WQ = 25 * MiB, WS_WG = 33 * MiB, WS_WPJ = 41 * MiB, WS_W1C = 42 * MiB, WS_POOLT = 44 * MiB, WS_KEYS = 45 * MiB;
constexpr size_t WS_CBIAS = 46 * MiB, WS_GATES = 47 * MiB, WS_HC = 50 * MiB, WS_KCMP = 54 * MiB, WS_VCMPT = 54 * MiB + 512 * 1024, WS_P16 = 56 * MiB;
constexpr size_t WS_XN = 64 * MiB;
constexpr size_t WS_Y = 128 * MiB, WS_QP = 128 * MiB, WS_PJ = 192 * MiB;
constexpr size_t WS_MIXED = 256 * MiB, WS_CAT = 288 * MiB, WS_KN = 352 * MiB, WS_VT = 368 * MiB, WS_FLATA = 384 * MiB;
constexpr size_t WS_U6 = 256 * MiB, WS_V6 = 288 * MiB, WS_SU = 320 * MiB, WS_SV = 321 * MiB;
constexpr size_t WS_LIDX = 322 * MiB, WS_LG = 330 * MiB, WS_SSP = 338 * MiB, WS_PD = 340 * MiB, WS_HW = 404 * MiB;
constexpr size_t SLICE6 = (size_t)16384 * 192;
constexpr size_t WS_XR = 416 * MiB;
constexpr size_t WS_SS0 = 768 * 1024, WS_SS1 = 256 * 1024, WS_SS2 = 512 * 1024;
constexpr size_t WS_QN = 480 * MiB;
constexpr size_t WS_END = 512 * MiB;
constexpr int CW_TMO = 0, CW_CODE = 1, CW_BAR = 4096;

constexpr int RING_BYTES = 131072;
constexpr int LDSCTL_OFF = RING_BYTES, MISC_OFF = LDSCTL_OFF + 320;
constexpr int LDS_BYTES = 147456;
constexpr int NWAVES = 8;

__device__ __forceinline__ unsigned pk_f16(float lo, float hi) { f16x2 v; v.x = (f16)lo; v.y = (f16)hi; return __builtin_bit_cast(unsigned, v); }
__device__ __forceinline__ f16x2 ash2(unsigned u) { return __builtin_bit_cast(f16x2, u); }
template <int CTRL> __device__ __forceinline__ float dpp_f(float v) { return __int_as_float(__builtin_amdgcn_update_dpp(0, __float_as_int(v), CTRL, 0xF, 0xF, true)); }
__device__ __forceinline__ float rl_f(float v, int l) { return __int_as_float(__builtin_amdgcn_readlane(__float_as_int(v), l)); }
__device__ __forceinline__ float sum8(float v) { v += dpp_f<0x141>(v); v += dpp_f<0xB1>(v); v += dpp_f<0x4E>(v); return v; }
__device__ __forceinline__ float wave_sum(float v) { v = sum8(v); v += dpp_f<0x140>(v); return (rl_f(v, 0) + rl_f(v, 16)) + (rl_f(v, 32) + rl_f(v, 48)); }
__device__ __forceinline__ float wave_max(float v) { v = fmaxf(v, dpp_f<0x141>(v)); v = fmaxf(v, dpp_f<0xB1>(v)); v = fmaxf(v, dpp_f<0x4E>(v)); v = fmaxf(v, dpp_f<0x140>(v));
    return fmaxf(fmaxf(rl_f(v, 0), rl_f(v, 16)), fmaxf(rl_f(v, 32), rl_f(v, 48))); }

__device__ __forceinline__ unsigned other8u(unsigned x) { return (unsigned)__builtin_amdgcn_update_dpp(0, (int)x, 0x128, 0xF, 0xF, true); }
__device__ __forceinline__ unsigned other16u(unsigned x, bool b4) { const auto r = __builtin_amdgcn_permlane16_swap(x, x, false, false); return b4 ? r[0] : r[1]; }
__device__ __forceinline__ unsigned other32u(unsigned x, bool b5) { const auto r = __builtin_amdgcn_permlane32_swap(x, x, false, false); return b5 ? r[0] : r[1]; }
namespace pg8 {
constexpr int BM = 256, BK = 64, HALF = 128, HTB = HALF * BK * 2, STAGE_BYTES = 8 * HTB, NXCD = 8, WGM = 8;
__host__ __device__ __forceinline__ int lds_byte(int r, int c) { const int st = (r >> 4) * 2 + (c >> 5), rr = r & 15, cc = c & 31, ob = rr * 64 + cc * 2; return st * 1024 + (ob ^ (((ob >> 9) & 1) << 5)); }
__host__ __device__ __forceinline__ void stage_rc(int b, int& R, int& C) { const int st = b / 1024, sb = b % 1024, swz = sb ^ (((sb >> 9) & 1) << 5); R = (st >> 1) * 16 + swz / 64; C = (st & 1) * 32 + (swz % 64) / 2; }
__host__ __device__ __forceinline__ int perm32(int rho) { const int n = rho >> 4, i = rho & 15; return 8 * (i >> 2) + 4 * n + (i & 3); }

struct Unit { int pm, pn; };
struct Gemm { const f16* A; const f16* Bt; int M, N, K, lda, ldb; int a_pn_off; int b_pm_split; size_t b_split_off; int b_pn_k = 0;
    __device__ __forceinline__ const char* aptr(const Unit& u) const { return (const char*)A + ((size_t)u.pm * BM * lda + (size_t)u.pn * a_pn_off) * 2; }
    __device__ __forceinline__ const char* bptr(const Unit& u) const { return (const char*)Bt + (b_pn_k ? (size_t)u.pn * b_pn_k * 2 : (size_t)u.pn * BM * ldb * 2) + (u.pm >= b_pm_split ? b_split_off : (size_t)0); }
};
struct StaticOrder {
    int nM, nN, nwg, G, c;
    __host__ __device__ void init(int M_, int N_, int G_, int c_) { nM = M_ / BM; nN = N_ / BM; nwg = nM * nN; G = G_; c = c_; }
    __host__ __device__ bool next(int i, Unit& u) const {
        const long L = (long)i * G + c; if (L >= nwg) return false;
        int wgid = (int)L; { const int q = nwg / NXCD, r = nwg % NXCD, xcd = wgid % NXCD, off = wgid / NXCD; wgid = (xcd < r ? xcd * (q + 1) : r * (q + 1) + (xcd - r) * q) + off; }
        const int nig = WGM * nN, gid = wgid / nig, fm = gid * WGM, gsz = (nM - fm) < WGM ? (nM - fm) : WGM;
        u.pm = fm + ((wgid % nig) % gsz); u.pn = (wgid % nig) / gsz; return true;
    }
};

__device__ __forceinline__ f32x2 gelu_pk(f32x2 v) {
    const f32x2 av = __builtin_elementwise_abs(v), d = av * 0.2316418882f + 1.0f;
    f32x2 t; t.x = __builtin_amdgcn_rcpf(d.x); t.y = __builtin_amdgcn_rcpf(d.y);
    f32x2 q = t * 0.5307027145f + (-0.7265760135f); q = q * t + 0.7107068705f; q = q * t + (-0.142248368f); q = q * t + 0.127414796f; q = q * t;
    const f32x2 s = (v * v) * (-0.72134752044f);
    f32x2 e; e.x = __builtin_amdgcn_exp2f(s.x); e.y = __builtin_amdgcn_exp2f(s.y);
    const f32x2 m = v * (q * e), r = v - m;
    f32x2 o; o.x = v.x < 0.f ? m.x : r.x; o.y = v.y < 0.f ? m.y : r.y; return o;
}
__device__ __forceinline__ float gelu1(float v) { f32x2 r = gelu_pk((f32x2){v, v}); return r.x; }

template <int ACT> struct EpiF16 {
    static constexpr bool PERM = true;
    f16* O; int ldc; const float* bias; int bias_pm_split; int bias_split_off;
    __device__ __forceinline__ void operator()(const f32x4 (&acc)[2][2][4][2], const Unit& u, int wr, int wc, int fr, int fq) const {
        const int row0 = u.pm * BM + wr * 64 + fr; const int col0 = u.pn * BM + wc * 32 + 8 * fq;
        const float* bp = bias ? bias + (u.pm >= bias_pm_split ? bias_split_off : 0) : nullptr;
        f32x4 bv[2][2];
#pragma unroll
        for (int bj = 0; bj < 2; ++bj)
#pragma unroll
            for (int n = 0; n < 2; ++n) bv[bj][n] = bp ? *(const f32x4*)(bp + col0 + bj * HALF + 4 * n) : (f32x4){0.f, 0.f, 0.f, 0.f};
#pragma unroll
        for (int ai = 0; ai < 2; ++ai)
#pragma unroll
            for (int m = 0; m < 4; ++m) { f16* rowp = O + (size_t)(row0 + ai * HALF + m * 16) * ldc + col0;
#pragma unroll
                for (int bj = 0; bj < 2; ++bj) { f32x4 v0 = acc[ai][bj][m][0] + bv[bj][0], v1 = acc[ai][bj][m][1] + bv[bj][1];
                    if (ACT == 1) { f32x2 a = gelu_pk((f32x2){v0[0], v0[1]}), b = gelu_pk((f32x2){v0[2], v0[3]}), c = gelu_pk((f32x2){v1[0], v1[1]}), d = gelu_pk((f32x2){v1[2], v1[3]});
                        v0 = (f32x4){a.x, a.y, b.x, b.y}; v1 = (f32x4){c.x, c.y, d.x, d.y}; }
                    u32x4 w; w.x = pk_f16(v0[0], v0[1]); w.y = pk_f16(v0[2], v0[3]); w.z = pk_f16(v1[0], v1[1]); w.w = pk_f16(v1[2], v1[3]);
                    *(u32x4*)(rowp + bj * HALF) = w; } }
    }
};
struct EpiRawF32 {
    static constexpr bool PERM = false;
    float* C; int ldc;
    __device__ __forceinline__ void operator()(const f32x4 (&acc)[2][2][4][2], const Unit& u, int wr, int wc, int fr, int fq) const {
        const int row0 = u.pm * BM + wr * 64 + fr, col0 = u.pn * BM + wc * 32 + 4 * fq;
#pragma unroll
        for (int ai = 0; ai < 2; ++ai)
#pragma unroll
            for (int m = 0; m < 4; ++m) { float* rowp = C + (size_t)(row0 + ai * HALF + m * 16) * ldc + col0;
#pragma unroll
                for (int bj = 0; bj < 2; ++bj)
#pragma unroll
                    for (int n = 0; n < 2; ++n) *(f32x4*)(rowp + bj * HALF + n * 16) = acc[ai][bj][m][n]; }
    }
};
struct EpiRes16 {
    static constexpr bool PERM = true;
    f16* XR; float* SS;
    __device__ __forceinline__ void operator()(const f32x4 (&acc)[2][2][4][2], const Unit& u, int wr, int wc, int fr, int fq) const {
        const int row0 = u.pm * BM + wr * 64 + fr; const int col0 = u.pn * BM + wc * 32 + 8 * fq;
#pragma unroll
        for (int ai = 0; ai < 2; ++ai) {
            f16x8 xb[4][2];
#pragma unroll
            for (int m = 0; m < 4; ++m)
#pragma unroll
                for (int bj = 0; bj < 2; ++bj) xb[m][bj] = *(const f16x8*)(XR + (size_t)(row0 + ai * HALF + m * 16) * D + col0 + bj * HALF);
            asm volatile("" ::: "memory");
#pragma unroll
            for (int m = 0; m < 4; ++m) { const int row = row0 + ai * HALF + m * 16; const size_t off = (size_t)row * D + col0; float ss = 0.f;
#pragma unroll
                for (int bj = 0; bj < 2; ++bj) { const f16x8 xv = xb[m][bj];
                    f32x4 v0 = acc[ai][bj][m][0], v1 = acc[ai][bj][m][1];
                    v0[0] += (float)xv[0]; v0[1] += (float)xv[1]; v0[2] += (float)xv[2]; v0[3] += (float)xv[3]; v1[0] += (float)xv[4]; v1[1] += (float)xv[5]; v1[2] += (float)xv[6]; v1[3] += (float)xv[7];
                    ss += ((v0[0] * v0[0] + v0[1] * v0[1]) + (v0[2] * v0[2] + v0[3] * v0[3])) + ((v1[0] * v1[0] + v1[1] * v1[1]) + (v1[2] * v1[2] + v1[3] * v1[3]));
                    u32x4 o; o.x = pk_f16(v0[0], v0[1]); o.y = pk_f16(v0[2], v0[3]); o.z = pk_f16(v1[0], v1[1]); o.w = pk_f16(v1[2], v1[3]);
                    *(u32x4*)(XR + off + bj * HALF) = o; }
                ss += __shfl_xor(ss, 16); ss += __shfl_xor(ss, 32);
                if (fq == 0) atomicAdd(SS + row, ss); }
            asm volatile("" ::: "memory"); }
    }
};
struct EpiF16Row {
    static constexpr bool PERM = true;
    f16* O; int ldc; const float* SS;
    __device__ __forceinline__ void operator()(const f32x4 (&acc)[2][2][4][2], const Unit& u, int wr, int wc, int fr, int fq) const {
        const int row0 = u.pm * BM + wr * 64 + fr; const int col0 = u.pn * BM + wc * 32 + 8 * fq;
#pragma unroll
        for (int ai = 0; ai < 2; ++ai)
#pragma unroll
            for (int m = 0; m < 4; ++m) { const int row = row0 + ai * HALF + m * 16; f16* rowp = O + (size_t)row * ldc + col0;
                const float rs = 1.f / sqrtf(SS[row] * (1.f / D) + RMS_EPS);
#pragma unroll
                for (int bj = 0; bj < 2; ++bj) { const f32x4 v0 = acc[ai][bj][m][0] * rs, v1 = acc[ai][bj][m][1] * rs;
                    u32x4 o; o.x = pk_f16(v0[0], v0[1]); o.y = pk_f16(v0[2], v0[3]); o.z = pk_f16(v1[0], v1[1]); o.w = pk_f16(v1[2], v1[3]);
                    *(u32x4*)(rowp + bj * HALF) = o; } }
    }
};
struct EpiFinal {
    static constexpr bool PERM = true;
    const f16* XR; const f16* PJ; float* C; const float* SS;
    __device__ __forceinline__ void operator()(const f32x4 (&acc)[2][2][4][2], const Unit& u, int wr, int wc, int fr, int fq) const {
        const int row0 = u.pm * BM + wr * 64 + fr; const int col0 = u.pn * BM + wc * 32 + 8 * fq;
#pragma unroll
        for (int ai = 0; ai < 2; ++ai)
#pragma unroll
            for (int mh = 0; mh < 2; ++mh) {
                f16x8 xb[2][2], pb[2][2]; float ssv[2];
#pragma unroll
                for (int mm = 0; mm < 2; ++mm) { const int row = row0 + ai * HALF + (2 * mh + mm) * 16; ssv[mm] = SS[row];
#pragma unroll
                    for (int bj = 0; bj < 2; ++bj) { xb[mm][bj] = *(const f16x8*)(XR + (size_t)row * D + col0 + bj * HALF); pb[mm][bj] = *(const f16x8*)(PJ + (size_t)row * D + col0 + bj * HALF); } }
                asm volatile("" ::: "memory");
#pragma unroll
                for (int mm = 0; mm < 2; ++mm) { const int m = 2 * mh + mm; const int row = row0 + ai * HALF + m * 16; const size_t off = (size_t)row * D + col0;
                    const float nrs = -LOG2E / sqrtf(ssv[mm] * (1.f / D) + RMS_EPS);
#pragma unroll
                    for (int bj = 0; bj < 2; ++bj) { const f16x8 xv = xb[mm][bj], pv = pb[mm][bj];
                        const f32x4 a0 = acc[ai][bj][m][0], a1 = acc[ai][bj][m][1]; f32x4 o0, o1;
#pragma unroll
                        for (int j = 0; j < 4; ++j) { o0[j] = (float)xv[j] + (float)pv[j] * __builtin_amdgcn_rcpf(1.0f + __builtin_amdgcn_exp2f(nrs * a0[j]));
                            o1[j] = (float)xv[4 + j] + (float)pv[4 + j] * __builtin_amdgcn_rcpf(1.0f + __builtin_amdgcn_exp2f(nrs * a1[j])); }
                        *(f32x4*)(C + off + bj * HALF) = o0; *(f32x4*)(C + off + bj * HALF + 4) = o1; } }
                asm volatile("" ::: "memory"); }
    }
};
template <int MODE> struct EpiF32 {
    static constexpr bool PERM = false;
    const float* base; float* C; int ldc; const f16* pj; const float* ssp;
    __device__ __forceinline__ void operator()(const f32x4 (&acc)[2][2][4][2], const Unit& u, int wr, int wc, int fr, int fq) const {
        const int row0 = u.pm * BM + wr * 64 + fr, col0 = u.pn * BM + wc * 32 + 4 * fq;
#pragma unroll
        for (int ai = 0; ai < 2; ++ai)
#pragma unroll
            for (int m = 0; m < 4; ++m) { const size_t off = (size_t)(row0 + ai * HALF + m * 16) * ldc + col0;
                float nrs = -LOG2E;
                if (MODE == 1) { const f32x4 s0 = *(const f32x4*)(ssp + (size_t)(row0 + ai * HALF + m * 16) * 8), s1 = *(const f32x4*)(ssp + (size_t)(row0 + ai * HALF + m * 16) * 8 + 4);
                    nrs = -LOG2E / sqrtf((((s0.x + s0.y) + (s0.z + s0.w)) + ((s1.x + s1.y) + (s1.z + s1.w))) * (1.f / D) + RMS_EPS); }
#pragma unroll
                for (int bj = 0; bj < 2; ++bj)
#pragma unroll
                    for (int n = 0; n < 2; ++n) { const size_t o2 = off + bj * HALF + n * 16; const f32x4 bs = *(const f32x4*)(base + o2); f32x4 a = acc[ai][bj][m][n];
                        if (MODE == 1) { const f16x4 pv = *(const f16x4*)(pj + o2);
#pragma unroll
                            for (int j = 0; j < 4; ++j) a[j] = (float)pv[j] * __builtin_amdgcn_rcpf(1.0f + __builtin_amdgcn_exp2f(nrs * a[j])); }
                        *(f32x4*)(C + o2) = bs + a; }
                asm volatile("" ::: "memory"); }
    }
};

template <class Epi, class Sched>
__device__ __forceinline__ void gemm_phase(LAS unsigned char* lds, const Gemm g, const Sched& S, const Epi& E) {
    int tid = threadIdx.x; asm volatile("" : "+v"(tid));
    const int wid = __builtin_amdgcn_readfirstlane(tid >> 6), lane = tid & 63, wr = wid >> 2, wc = wid & 3, fr = lane & 15, fq = lane >> 4;
    const int K = g.K, nt = K / BK;
    unsigned voffA[2], voffB[2];
#pragma unroll
    for (int i = 0; i < 2; ++i) { int R, C; stage_rc(tid * 16 + i * 8192, R, C); const int Rb = Epi::PERM ? ((R & ~31) + perm32(R & 31)) : R;
        voffA[i] = (unsigned)(R * g.lda + C) * 2u; voffB[i] = (unsigned)(Rb * g.ldb + C) * 2u; }
    const size_t kstep = (size_t)(BK * 2);
    const size_t hstepA = (size_t)HALF * g.lda * 2, hstepB = (size_t)HALF * g.ldb * 2;
    const unsigned ldsw = (unsigned)wid * 1024u;
    const int aoff = lds_byte(wr * 64 + fr, fq * 8), boff = lds_byte(wc * 32 + fr, fq * 8);
#define PG8_SA(b, h) (((b) * 2 + (h)) * HTB)
#define PG8_SB(b, h) ((4 + (b) * 2 + (h)) * HTB)
#define PG8_STAGE(bufoff, gbase, voff) do { _Pragma("unroll") for (int _i = 0; _i < 2; ++_i) \
        __builtin_amdgcn_global_load_lds((const unsigned*)((const char*)(gbase) + (voff)[_i]), (LAS unsigned*)(lds + (bufoff) + ldsw + _i * 8192), 16, 0, 0); } while (0)
#define PG8_LDA(dst, b, h) do { _Pragma("unroll") for (int m = 0; m < 4; ++m) _Pragma("unroll") for (int k = 0; k < 2; ++k) dst[m][k] = *(const LAS f16x8*)(lds + PG8_SA(b, h) + aoff + m * 2048 + k * 1024); } while (0)
#define PG8_LDB(dst, b, h) do { _Pragma("unroll") for (int n = 0; n < 2; ++n) _Pragma("unroll") for (int k = 0; k < 2; ++k) dst[n][k] = *(const LAS f16x8*)(lds + PG8_SB(b, h) + boff + n * 2048 + k * 1024); } while (0)
#define PG8_MMA(ai, bj, At, Bt) do { __builtin_amdgcn_s_setprio(1); _Pragma("unroll") for (int m = 0; m < 4; ++m) _Pragma("unroll") for (int n = 0; n < 2; ++n) _Pragma("unroll") for (int k = 0; k < 2; ++k) \
        acc[ai][bj][m][n] = __builtin_amdgcn_mfma_f32_16x16x32_f16(Bt[n][k], At[m][k], acc[ai][bj][m][n], 0, 0, 0); __builtin_amdgcn_s_setprio(0); } while (0)
#define PG8_WAIT_V(n) asm volatile("s_waitcnt vmcnt(" #n ")" ::: "memory")
#define PG8_WAIT_L(n) asm volatile("s_waitcnt lgkmcnt(" #n ")" ::: "memory")
#define PG8_BAR __builtin_amdgcn_s_barrier()
#define PG8_SCHED __builtin_amdgcn_sched_barrier(0)
    Unit cur, nxt; int ui = 0;
    if (!S.next(0, cur)) return;
    f32x4 acc[2][2][4][2];
#pragma unroll
    for (int a = 0; a < 2; ++a)
#pragma unroll
        for (int b = 0; b < 2; ++b)
#pragma unroll
            for (int m = 0; m < 4; ++m)
#pragma unroll
                for (int n = 0; n < 2; ++n) acc[a][b][m][n] = (f32x4){0.f, 0.f, 0.f, 0.f};
    f16x8 At[4][2], B0[2][2], B1[2][2];
    const char* cA = g.aptr(cur); const char* cB = g.bptr(cur);
    PG8_STAGE(PG8_SB(0, 0), cB, voffB); PG8_STAGE(PG8_SB(0, 1), cB + hstepB, voffB); PG8_STAGE(PG8_SA(0, 0), cA, voffA); PG8_STAGE(PG8_SA(0, 1), cA + hstepA, voffA);
    if (wr == 1) PG8_BAR;
    PG8_WAIT_V(2); PG8_BAR;
    PG8_STAGE(PG8_SB(1, 0), cB + kstep, voffB); PG8_STAGE(PG8_SA(1, 0), cA + kstep, voffA); PG8_STAGE(PG8_SB(1, 1), cB + hstepB + kstep, voffB);
    PG8_WAIT_V(6); PG8_BAR;
    for (;;) {
        const bool has_next = S.next(ui + 1, nxt);
        const char* nA = has_next ? g.aptr(nxt) : cA; const char* nB = has_next ? g.bptr(nxt) : cB;
        for (int t = 0; t < nt; t += 2) {
            const bool last = (t == nt - 2);
            const char* a1 = cA + (size_t)(t + 1) * kstep;
            const char* a2 = last ? nA : cA + (size_t)(t + 2) * kstep; const char* b2 = last ? nB : cB + (size_t)(t + 2) * kstep;
            const char* a3 = a2 + kstep; const char* b3 = b2 + kstep;
            PG8_LDB(B0, 0, 0); PG8_LDB(B1, 0, 1); PG8_SCHED; PG8_LDA(At, 0, 0); PG8_STAGE(PG8_SA(1, 1), a1 + hstepA, voffA);
            PG8_WAIT_V(8); PG8_WAIT_L(0); PG8_BAR; PG8_MMA(0, 0, At, B0); PG8_MMA(0, 1, At, B1); PG8_BAR; PG8_SCHED;
            PG8_LDA(At, 0, 1); PG8_STAGE(PG8_SB(0, 0), b2, voffB); PG8_STAGE(PG8_SB(0, 1), b2 + hstepB, voffB); PG8_STAGE(PG8_SA(0, 0), a2, voffA);
            PG8_WAIT_V(8); PG8_WAIT_L(0); PG8_BAR; PG8_MMA(1, 0, At, B0); PG8_MMA(1, 1, At, B1); PG8_BAR; PG8_SCHED;
            PG8_LDB(B0, 1, 0); PG8_LDB(B1, 1, 1); PG8_SCHED; PG8_LDA(At, 1, 0); PG8_STAGE(PG8_SA(0, 1), a2 + hstepA, voffA);
            PG8_WAIT_V(8); PG8_WAIT_L(0); PG8_BAR; PG8_MMA(0, 0, At, B0); PG8_MMA(0, 1, At, B1); PG8_BAR; PG8_SCHED;
            PG8_LDA(At, 1, 1); PG8_STAGE(PG8_SB(1, 0), b3, voffB); PG8_STAGE(PG8_SB(1, 1), b3 + hstepB, voffB); PG8_STAGE(PG8_SA(1, 0), a3, voffA);
            PG8_WAIT_V(8); PG8_WAIT_L(0); PG8_BAR; PG8_MMA(1, 0, At, B0); PG8_MMA(1, 1, At, B1); PG8_BAR; PG8_SCHED;
        }
        if (wr == 0) PG8_BAR;
        E(acc, cur, wr, wc, fr, fq);
        if (!has_next) break;
#pragma unroll
        for (int a = 0; a < 2; ++a)
#pragma unroll
            for (int b = 0; b < 2; ++b)
#pragma unroll
                for (int m = 0; m < 4; ++m)
#pragma unroll
                    for (int n = 0; n < 2; ++n) acc[a][b][m][n] = (f32x4){0.f, 0.f, 0.f, 0.f};
        cur = nxt; cA = nA; cB = nB; ++ui;
        if (wr == 1) PG8_BAR;
    }
    PG8_WAIT_V(0);
    PG8_BAR;
#undef PG8_SA
#undef PG8_SB
#undef PG8_STAGE
#undef PG8_LDA
#undef PG8_LDB
#undef PG8_MMA
#undef PG8_WAIT_V
#undef PG8_WAIT_L
#undef PG8_BAR
#undef PG8_SCHED
}
}

#define XB_TMO      128
#define XB_XCNT(j)  (256  + 64 * (j))
#define XB_XSUB(j)  (1280 + 64 * (j))
#define XB_XGEN(j)  (2304 + 64 * (j))
#define XB_TOP      3328
#define XB_TOPGEN   3392
#define XCD_BAR_WORDS 3456
#define XB_SPIN_CAP (1u << 18)
__device__ __forceinline__ unsigned xb_ld(unsigned* p)              { return __hip_atomic_load(p, __ATOMIC_RELAXED, __HIP_MEMORY_SCOPE_AGENT); }
__device__ __forceinline__ unsigned xb_add(unsigned* p, unsigned v) { return __hip_atomic_fetch_add(p, v, __ATOMIC_RELAXED, __HIP_MEMORY_SCOPE_AGENT); }
__device__ __forceinline__ unsigned xb_xcc_id() { return (unsigned)__builtin_amdgcn_s_getreg((3 << 11) | 20) & 0xFu; }
#define XB_SPIN(cond, bar) do { unsigned _sp = 0; while (cond) { __builtin_amdgcn_s_sleep(1); \
    if ((++_sp & 255u) == 0u) { if (xb_ld(&(bar)[XB_TMO])) break; if (_sp > XB_SPIN_CAP) { atomicAdd(&(bar)[XB_TMO], 1u); break; } } } } while (0)
struct XcdBarrier { unsigned* bar; unsigned x; volatile LAS unsigned* st; };
__device__ __forceinline__ XcdBarrier xcd_barrier_post(unsigned* bar, volatile LAS unsigned* st) {
    XcdBarrier b; b.bar = bar; b.x = xb_xcc_id(); b.st = st;
    if (threadIdx.x == 0) (void)xb_add(&bar[XB_XCNT(b.x)], 1u);
    return b;
}
__device__ __forceinline__ void xcd_barrier_complete(unsigned* bar, unsigned x, unsigned& nloc, unsigned& nx) {
    const unsigned G = gridDim.x * gridDim.y * gridDim.z;
    unsigned sum, cnt, mine, sp = 0u;
    for (;;) {
        sum = 0u; cnt = 0u; mine = 0u;
#pragma unroll
        for (unsigned j = 0; j < 16; ++j) { const unsigned c = xb_ld(&bar[XB_XCNT(j)]); sum += c; cnt += (c > 0u) ? 1u : 0u; mine = (j == x) ? c : mine; }
        if (sum == G) break;
        __builtin_amdgcn_s_sleep(1);
        if ((++sp & 255u) == 0u) { if (xb_ld(&bar[XB_TMO])) break; if (sp > XB_SPIN_CAP) { atomicAdd(&bar[XB_TMO], 1u); break; } }
    }
    nloc = mine > 0u ? mine : 1u; nx = cnt > 0u ? cnt : 1u;
}
__device__ __forceinline__ void xcd_barrier(const XcdBarrier& b) {
    asm volatile("s_waitcnt vmcnt(0)" ::: "memory");
    __syncthreads();
    if (threadIdx.x == 0) {
        unsigned* bar = b.bar;
        __builtin_amdgcn_s_waitcnt(0);
        unsigned nloc = b.st[0], nx = b.st[1];
        if (nloc == 0u) { xcd_barrier_complete(bar, b.x, nloc, nx); b.st[0] = nloc; b.st[1] = nx; }
        const unsigned old = xb_add(&bar[XB_XSUB(b.x)], 1u);
        const unsigned gen = old / nloc;
        if (old + 1u == (gen + 1u) * nloc) {
            __builtin_amdgcn_fence(__ATOMIC_RELEASE, "agent");
            asm volatile("s_waitcnt vmcnt(0)" ::: "memory");
            const unsigned og = xb_add(&bar[XB_TOP], 1u);
            const unsigned tg = og / nx;
            if (og + 1u == (tg + 1u) * nx) xb_add(&bar[XB_TOPGEN], 1u);
            else XB_SPIN(xb_ld(&bar[XB_TOPGEN]) == tg, bar);
            __builtin_amdgcn_fence(__ATOMIC_ACQUIRE, "agent");
            xb_add(&bar[XB_XGEN(b.x)], 1u);
            asm volatile("s_waitcnt vmcnt(0)" ::: "memory");
        } else {
            XB_SPIN(xb_ld(&bar[XB_XGEN(b.x)]) == gen, bar);
            __builtin_amdgcn_fence(__ATOMIC_ACQUIRE, "agent");
            asm volatile("s_waitcnt vmcnt(0)" ::: "memory");
        }
    }
    __syncthreads();
}

struct Frame {
    LAS unsigned char* lds;
    volatile LAS unsigned* MISC;
    int tid, lane, wave;
    int vcu, G;
    const float* in[26];
    float* out;
    unsigned char* ws;
};
enum { I_X = 0, I_P, I_RELB, I_MIXNW, I_WIN, I_QNW, I_KNW, I_CKPOS, I_CKW1, I_CKB1, I_CKW2, I_CVPOS, I_CVW1, I_CVB1, I_CVW2, I_POOLW, I_POOLS, I_WOUT, I_FFNNW, I_PWQ, I_PKEYS, I_PU, I_PV, I_PLENW, I_PLEWG, I_PLEWP };

__device__ __forceinline__ void p0_transpose_item(const float* W, int K, int N, int Npad, const float* colscale, f16* WT, LAS float* scr, int item, int lane, const float* kscale = nullptr) {
    const int nblk = Npad / 32, kb = item / nblk, nb = item % nblk, k0 = 64 * kb, n0 = 32 * nb;
    const int nn = n0 + (lane & 31); const bool ok = nn < N;
#pragma unroll
    for (int hgrp = 0; hgrp < 2; ++hgrp) { float wv[16];
#pragma unroll
        for (int i = 0; i < 16; ++i) { const int kk = 2 * (16 * hgrp + i) + (lane >> 5); wv[i] = ok ? W[(size_t)(k0 + kk) * N + nn] : 0.f; }
        if (kscale) {
#pragma unroll
            for (int i = 0; i < 16; ++i) wv[i] *= kscale[k0 + 2 * (16 * hgrp + i) + (lane >> 5)]; }
#pragma unroll
        for (int i = 0; i < 16; ++i) { const int kk = 2 * (16 * hgrp + i) + (lane >> 5); scr[kk * 33 + (lane & 31)] = wv[i]; }
        asm volatile("" ::: "memory"); }
    LDS_WAIT(); asm volatile("" ::: "memory");
    const int c = lane & 7;
#pragma unroll
    for (int j = 0; j < 4; ++j) { const int n = (lane >> 3) + 8 * j; const LAS float* s = scr + (8 * c) * 33 + n; const float sc = (colscale && n0 + n < N) ? colscale[n0 + n] : 1.f;
        u32x4 o; o.x = pk_f16(s[0 * 33] * sc, s[1 * 33] * sc); o.y = pk_f16(s[2 * 33] * sc, s[3 * 33] * sc); o.z = pk_f16(s[4 * 33] * sc, s[5 * 33] * sc); o.w = pk_f16(s[6 * 33] * sc, s[7 * 33] * sc);
        *(GAS u32x4*)(WT + (size_t)(n0 + n) * K + k0 + 8 * c) = o; }
    LDS_WAIT(); asm volatile("" ::: "memory");
}
__device__ __forceinline__ void rms_row_to_f16(const float* xrow, const float* w, f16* orow, int lane, f16* x16row = nullptr) {
    const GAS f32x4* xr = (const GAS f32x4*)xrow + lane; const GAS f32x4* wr = (const GAS f32x4*)w + lane;
    f32x4 v[8]; float s = 0.f;
#pragma unroll
    for (int j = 0; j < 8; ++j) { v[j] = xr[64 * j]; s += (v[j].x * v[j].x + v[j].y * v[j].y) + (v[j].z * v[j].z + v[j].w * v[j].w); }
    const float rstd = 1.f / sqrtf(wave_sum(s) * (1.f / D) + RMS_EPS);
    GAS u32x2* o8 = (GAS u32x2*)orow + lane;
#pragma unroll
    for (int j = 0; j < 8; ++j) { const f32x4 g = wr[64 * j]; u32x2 o; o.x = pk_f16(v[j].x * rstd * g.x, v[j].y * rstd * g.y); o.y = pk_f16(v[j].z * rstd * g.z, v[j].w * rstd * g.w); o8[64 * j] = o; }
    if (x16row) { GAS u32x2* x8 = (GAS u32x2*)x16row + lane;
#pragma unroll
        for (int j = 0; j < 8; ++j) { u32x2 o; o.x = pk_f16(v[j].x, v[j].y); o.y = pk_f16(v[j].z, v[j].w); x8[64 * j] = o; } }
}
__device__ __forceinline__ void rms_2rows_to_f16(const float* x0, const float* x1, const float* w, f16* o0, f16* o1, f16* h0, f16* h1, int lane) {
    const GAS f32x4* xa = (const GAS f32x4*)x0 + lane; const GAS f32x4* xb = (const GAS f32x4*)x1 + lane; const GAS f32x4* wr = (const GAS f32x4*)w + lane;
    f32x4 va[8], vb[8]; float sa = 0.f, sb = 0.f;
#pragma unroll
    for (int j = 0; j < 8; ++j) { va[j] = __builtin_nontemporal_load(xa + 64 * j); vb[j] = __builtin_nontemporal_load(xb + 64 * j); }
#pragma unroll
    for (int j = 0; j < 8; ++j) { sa += (va[j].x * va[j].x + va[j].y * va[j].y) + (va[j].z * va[j].z + va[j].w * va[j].w); sb += (vb[j].x * vb[j].x + vb[j].y * vb[j].y) + (vb[j].z * vb[j].z + vb[j].w * vb[j].w); }
    const float ra = 1.f / sqrtf(wave_sum(sa) * (1.f / D) + RMS_EPS), rb = 1.f / sqrtf(wave_sum(sb) * (1.f / D) + RMS_EPS);
    GAS u32x2* pa = (GAS u32x2*)o0 + lane; GAS u32x2* pb = (GAS u32x2*)o1 + lane; GAS u32x2* qa = (GAS u32x2*)h0 + lane; GAS u32x2* qb = (GAS u32x2*)h1 + lane;
#pragma unroll
    for (int j = 0; j < 8; ++j) { const f32x4 g = wr[64 * j]; u32x2 o;
        o.x = pk_f16(va[j].x * ra * g.x, va[j].y * ra * g.y); o.y = pk_f16(va[j].z * ra * g.z, va[j].w * ra * g.w); pa[64 * j] = o;
        o.x = pk_f16(vb[j].x * rb * g.x, vb[j].y * rb * g.y); o.y = pk_f16(vb[j].z * rb * g.z, vb[j].w * rb * g.w); pb[64 * j] = o;
        o.x = pk_f16(va[j].x, va[j].y); o.y = pk_f16(va[j].z, va[j].w); qa[64 * j] = o;
        o.x = pk_f16(vb[j].x, vb[j].y); o.y = pk_f16(vb[j].z, vb[j].w); qb[64 * j] = o; }
}
__device__ __forceinline__ void x16_2rows(const float* x0, const float* x1, f16* h0, f16* h1, float* ss0, float* ss1, int lane) {
    const GAS f32x4* xa = (const GAS f32x4*)x0 + lane; const GAS f32x4* xb = (const GAS f32x4*)x1 + lane;
    f32x4 va[8], vb[8]; float sa = 0.f, sb = 0.f;
#pragma unroll
    for (int j = 0; j < 8; ++j) { va[j] = __builtin_nontemporal_load(xa + 64 * j); vb[j] = __builtin_nontemporal_load(xb + 64 * j); }
    GAS u32x2* qa = (GAS u32x2*)h0 + lane; GAS u32x2* qb = (GAS u32x2*)h1 + lane;
#pragma unroll
    for (int j = 0; j < 8; ++j) { sa += (va[j].x * va[j].x + va[j].y * va[j].y) + (va[j].z * va[j].z + va[j].w * va[j].w); sb += (vb[j].x * vb[j].x + vb[j].y * vb[j].y) + (vb[j].z * vb[j].z + vb[j].w * vb[j].w);
        u32x2 o; o.x = pk_f16(va[j].x, va[j].y); o.y = pk_f16(va[j].z, va[j].w); qa[64 * j] = o;
        o.x = pk_f16(vb[j].x, vb[j].y); o.y = pk_f16(vb[j].z, vb[j].w); qb[64 * j] = o; }
    sa = wave_sum(sa); sb = wave_sum(sb);
    if (lane == 0) { *ss0 = sa; *ss1 = sb; }
}
__device__ __forceinline__ void cvt_f32_f16(Frame& F, const float* src, f16* dst, size_t n) {
    const size_t gt = (size_t)F.vcu * 512 + F.tid, GT = (size_t)F.G * 512;
    for (size_t i = gt; i < n / 8; i += GT) { const f32x4 a = *(const GAS f32x4*)(src + i * 8), b = *(const GAS f32x4*)(src + i * 8 + 4);
        u32x4 o; o.x = pk_f16(a.x, a.y); o.y = pk_f16(a.z, a.w); o.z = pk_f16(b.x, b.y); o.w = pk_f16(b.z, b.w); *(GAS u32x4*)(dst + i * 8) = o; }
}

__device__ __forceinline__ void p0_prologue(Frame& F) {
    LAS float* scr = (LAS float*)(F.lds + F.wave * 16384);
    const int gw = F.vcu * NWAVES + F.wave, NGW = F.G * NWAVES;
    unsigned char* ws = F.ws;
    constexpr int I_IN = (D / 64) * (NINP / 32), I_SQ = (D / 64) * (D / 32), I_PJ = (256 / 64) * (D / 32), I_C1 = (D / 64) * (256 / 32), I_PL = (256 / 64) * (256 / 32);
    constexpr int NITEMS = I_IN + 3 * I_SQ + I_PJ + 2 * I_C1 + 4 * I_PL;
    for (int it = gw; it < NITEMS; it += NGW) {
        int r = it;
        if (r < I_IN) { p0_transpose_item(F.in[I_WIN], D, NIN, NINP, nullptr, (f16*)(ws + WS_WIN), scr, r, F.lane, F.in[I_MIXNW]); continue; } r -= I_IN;
        if (r < I_SQ) { p0_transpose_item(F.in[I_WOUT], D, D, D, nullptr, (f16*)(ws + WS_WOUT), scr, r, F.lane); continue; } r -= I_SQ;
        if (r < I_SQ) { p0_transpose_item(F.in[I_PWQ], D, D, D, nullptr, (f16*)(ws + WS_WQ), scr, r, F.lane, F.in[I_FFNNW]); continue; } r -= I_SQ;
        if (r < I_SQ) { p0_transpose_item(F.in[I_PLEWG], D, D, D, nullptr, (f16*)(ws + WS_WG), scr, r, F.lane, F.in[I_PLENW]); continue; } r -= I_SQ;
        if (r < I_PJ) { p0_transpose_item(F.in[I_PLEWP], 256, D, D, nullptr, (f16*)(ws + WS_WPJ), scr, r, F.lane); continue; } r -= I_PJ;
        if (r < I_C1) { p0_transpose_item(F.in[I_CKW1], D, 256, 256, nullptr, (f16*)(ws + WS_W1C), scr, r, F.lane); continue; } r -= I_C1;
        if (r < I_C1) { p0_transpose_item(F.in[I_CVW1], D, 256, 256, nullptr, (f16*)(ws + WS_W1C) + 256 * D, scr, r, F.lane); continue; } r -= I_C1;
        { const int g = r / I_PL; r -= g * I_PL;
          p0_transpose_item(F.in[I_POOLW] + (size_t)g * 65536, 256, 256, 256, F.in[I_POOLS] + g * 256, (f16*)(ws + WS_POOLT) + (size_t)g * 65536, scr, r, F.lane); }
    }
    { float* SS0 = (float*)(ws + WS_SS0); f16* XR = (f16*)(ws + WS_XR);
      for (int m = gw; m < M; m += 2 * NGW) { const int m2 = m + NGW < M ? m + NGW : m;
          x16_2rows(F.in[I_X] + (size_t)m * D, F.in[I_X] + (size_t)m2 * D, XR + (size_t)m * D, XR + (size_t)m2 * D, SS0 + m, SS0 + m2, F.lane); } }
    cvt_f32_f16(F, F.in[I_P], (f16*)(ws + WS_P16), (size_t)M * 256);
    cvt_f32_f16(F, F.in[I_PKEYS], (f16*)(ws + WS_KEYS), (size_t)8 * 2 * 128 * 128);
    for (int task = gw; task < 512; task += NGW) { const int mat = task >> 8, n = task & 255;
        const float* pos = F.in[mat ? I_CVPOS : I_CKPOS]; const float* w1 = F.in[mat ? I_CVW1 : I_CKW1]; float s = 0.f;
#pragma unroll
        for (int i = 0; i < 32; ++i) { const int k = F.lane + 64 * i; s += pos[k] * w1[(size_t)k * 256 + n]; }
        s = wave_sum(s);
        if (F.lane == 0) ((float*)(ws + WS_CBIAS))[task] = s + F.in[mat ? I_CVB1 : I_CKB1][n]; }
}

template <int W> __device__ __forceinline__ void pool_mix_tile(const f16* up, f16* mp, size_t mb, int s0) {
    f16x2 prev[16], cur[16]; f32x2 sum = {0.f, 0.f};
#pragma unroll
    for (int i = 0; i < 16; ++i) { const int sp = s0 - 16 + i; prev[i] = sp >= 0 ? *(const GAS f16x2*)(up + (mb + sp) * NINP) : (f16x2){(f16)0.f, (f16)0.f}; }
#pragma unroll
    for (int i = 16 - W; i < 16; ++i) { sum.x += (float)prev[i].x; sum.y += (float)prev[i].y; }
#pragma unroll 1
    for (int blk = 0; blk < 4; ++blk) { const int sb = s0 + blk * 16;
#pragma unroll
        for (int i = 0; i < 16; ++i) cur[i] = *(const GAS f16x2*)(up + (mb + sb + i) * NINP);
#pragma unroll
        for (int i = 0; i < 16; ++i) { const int s = sb + i; const f16x2 o = (i - W >= 0) ? cur[(i - W >= 0) ? i - W : 0] : prev[(i - W >= 0) ? 0 : 16 + i - W];
            sum.x += (float)cur[i].x - (float)o.x; sum.y += (float)cur[i].y - (float)o.y;
            const float ic = 1.f / (float)(s + 1 < W ? s + 1 : W);
            *(GAS unsigned*)(mp + (mb + s) * 1024) = pk_f16(sum.x * ic - (float)cur[i].x, sum.y * ic - (float)cur[i].y); }
#pragma unroll
        for (int i = 0; i < 16; ++i) prev[i] = cur[i]; }
}
__device__ __forceinline__ void p2_post(Frame& F) {
    unsigned char* ws = F.ws;
    f16* Y = (f16*)(ws + WS_Y);
    const float* qnw = F.in[I_QNW]; const float* knw = F.in[I_KNW];
    LAS f16* vl = (LAS f16*)F.lds;
    constexpr int VLP = 264;
    for (int tt = F.vcu; tt < M / 64; tt += F.G) {
        const int b = tt >> 5, s0 = (tt & 31) * 64, m0 = tt * 64;
        for (int tk = F.wave; tk < 64; tk += NWAVES) {
            const int m = m0 + tk, s = s0 + tk; f16* yr = Y + (size_t)m * NINP;
#pragma unroll
            for (int pass = 0; pass < 2; ++pass) { const int ch = pass * 64 + F.lane; f16* pq = yr + OFF_Q + ch * 8; const f16x8 v = *(const GAS f16x8*)pq;
                float ss = 0.f;
#pragma unroll
                for (int e = 0; e < 8; ++e) ss += (float)v[e] * (float)v[e];
                ss = sum8(ss);
                const float rs = (1.f / sqrtf(ss * (1.f / 64.f) + RMS_EPS)) * (0.125f * LOG2E); const float* w = qnw + (ch & 7) * 8;
                u32x4 o; o.x = pk_f16((float)v[0] * rs * w[0], (float)v[1] * rs * w[1]); o.y = pk_f16((float)v[2] * rs * w[2], (float)v[3] * rs * w[3]);
                o.z = pk_f16((float)v[4] * rs * w[4], (float)v[5] * rs * w[5]); o.w = pk_f16((float)v[6] * rs * w[6], (float)v[7] * rs * w[7]);
                *(GAS u32x4*)((f16*)(ws + WS_QN) + (size_t)m * 1024 + ch * 8) = o; }
            { const int br = F.lane >> 5, ch = F.lane & 31, g = ch >> 3, dc = ch & 7; const f16x8 v = *(const GAS f16x8*)(yr + (br ? OFF_KW : OFF_KS) + ch * 8);
                float ss = 0.f;
#pragma unroll
                for (int e = 0; e < 8; ++e) ss += (float)v[e] * (float)v[e];
                ss = sum8(ss);
                const float rs = 1.f / sqrtf(ss * (1.f / 64.f) + RMS_EPS); const float* w = knw + dc * 8;
                u32x4 o; o.x = pk_f16((float)v[0] * rs * w[0], (float)v[1] * rs * w[1]); o.y = pk_f16((float)v[2] * rs * w[2], (float)v[3] * rs * w[3]);
                o.z = pk_f16((float)v[4] * rs * w[4], (float)v[5] * rs * w[5]); o.w = pk_f16((float)v[6] * rs * w[6], (float)v[7] * rs * w[7]);
                *(GAS u32x4*)((f16*)(ws + WS_KN) + (size_t)br * (BATCH * 4 * SEQ * 64) + ((size_t)(b * 4 + g) * 64 + (s >> 5)) * 2048 + (dc >> 1) * 512 + ((dc & 1) * 32 + (s & 31)) * 8) = o; }
            { const int mat = F.lane >> 5, ch = F.lane & 31, g = ch >> 3, dc = ch & 7; const u32x4 v = *(const GAS u32x4*)(yr + (mat ? OFF_VC : OFF_KC) + ch * 8);
                const int i1 = s >> 4, jj = s & 15; f16* fa = (f16*)(ws + WS_FLATA) + (size_t)mat * 4096 * 2048;
                if (i1 <= NCMP - 1) *(GAS u32x4*)(fa + (size_t)((b * NCMP + i1) * 4 + g) * 2048 + jj * 64 + dc * 8) = v;
                if (i1 >= 1) *(GAS u32x4*)(fa + (size_t)((b * NCMP + i1 - 1) * 4 + g) * 2048 + (16 + jj) * 64 + dc * 8) = v; }
        }
        for (int idx = F.tid; idx < 64 * 48; idx += 512) { const int tk = idx / 48, c = idx - tk * 48; const float v = (float)Y[(size_t)(m0 + tk) * NINP + OFF_G + c];
            ((float*)(ws + WS_GATES))[(size_t)(m0 + tk) * 48 + c] = 1.f / (1.f + __expf(-v)); }
        { const int gg = F.tid >> 7;
          if (gg == 0) pool_mix_tile<2>(Y + OFF_U + F.tid * 2, (f16*)(ws + WS_MIXED) + F.tid * 2, (size_t)b * SEQ, s0);
          else if (gg == 1) pool_mix_tile<4>(Y + OFF_U + F.tid * 2, (f16*)(ws + WS_MIXED) + F.tid * 2, (size_t)b * SEQ, s0);
          else if (gg == 2) pool_mix_tile<8>(Y + OFF_U + F.tid * 2, (f16*)(ws + WS_MIXED) + F.tid * 2, (size_t)b * SEQ, s0);
          else pool_mix_tile<16>(Y + OFF_U + F.tid * 2, (f16*)(ws + WS_MIXED) + F.tid * 2, (size_t)b * SEQ, s0); }
        __syncthreads();
        for (int idx = F.tid; idx < 2 * 64 * 32; idx += 512) { const int br = idx >> 11, tk = (idx >> 5) & 63, ch = idx & 31;
            *(LAS u32x4*)(vl + (br * 64 + tk) * VLP + ch * 8) = *(const GAS u32x4*)(Y + (size_t)(m0 + tk) * NINP + (br ? OFF_VW : OFF_VS) + ch * 8); }
        __syncthreads();
        for (int idx = F.tid; idx < 2 * 256 * 8; idx += 512) { const int br = idx >> 11, row = (idx >> 3) & 255, cc = idx & 7, grp = cc >> 1, hh = cc & 1;
            f16x8 o;
#pragma unroll
            for (int j = 0; j < 8; ++j) { const int kap = 16 * grp + 8 * (j >> 2) + 4 * hh + (j & 3); o[j] = vl[(br * 64 + kap) * VLP + row]; }
            const int g = row >> 6, d = row & 63;
            *(GAS f16x8*)((f16*)(ws + WS_VT) + (size_t)br * (BATCH * 4 * 64 * SEQ) + ((size_t)(b * 4 + g) * 64 + (s0 >> 5) + (cc >> 2)) * 2048 + ((d >> 5) * 2 + ((cc >> 1) & 1)) * 512 + ((cc & 1) * 32 + (d & 31)) * 8) = o; }
        __syncthreads();
    }
}

__device__ __forceinline__ void p4_compress2(Frame& F) {
    unsigned char* ws = F.ws;
    f16* kc = (f16*)(ws + WS_KCMP); f16* vt = (f16*)(ws + WS_VCMPT);
    const int nhalf = F.G >> 1, mat = F.vcu & 1, wgr = F.vcu >> 1;
    if (nhalf == 0) return;
    LAS float* w2l = (LAS float*)F.lds;
    { const float* w2g = F.in[mat ? I_CVW2 : I_CKW2];
      for (int idx = F.tid; idx < 256 * 16; idx += 512) { const int k = idx >> 4, d4 = (idx & 15) * 4; const f32x4 v = *(const GAS f32x4*)(w2g + (size_t)k * 64 + d4);
          LAS float* q = w2l + ((k >> 2) * 64 + d4) * 4 + (k & 3); q[0] = v.x; q[4] = v.y; q[8] = v.z; q[12] = v.w; } }
    __syncthreads();
    const int rstep = nhalf * NWAVES, r0 = (F.vcu >= 2 * nhalf ? 4096 : wgr * NWAVES + F.wave);
#pragma unroll 1
    for (int rb = r0; rb < 4096; rb += 4 * rstep) {
        f32x4 hs[4];
#pragma unroll
        for (int q = 0; q < 4; ++q) { const int r = rb + q * rstep < 4096 ? rb + q * rstep : rb; const int bg = r >> 7, i = r & 127, ic = i < NCMP ? i : 0;
            const float* hp = (const float*)(ws + WS_Y) + ((size_t)mat * 4096 + (size_t)((bg >> 2) * NCMP + ic) * 4 + (bg & 3)) * 1024 + F.lane * 4;
            hs[q] = *(const GAS f32x4*)(((const float*)(ws + WS_CBIAS)) + mat * 256 + F.lane * 4);
#pragma unroll
            for (int ks = 0; ks < 4; ++ks) hs[q] = hs[q] + *(const GAS f32x4*)(hp + ks * 256); }
        float hh_[4][4], ac[4][4];
#pragma unroll
        for (int q = 0; q < 4; ++q) { const f32x2 ga = pg8::gelu_pk((f32x2){hs[q].x, hs[q].y}), gb = pg8::gelu_pk((f32x2){hs[q].z, hs[q].w});
            hh_[q][0] = ga.x; hh_[q][1] = ga.y; hh_[q][2] = gb.x; hh_[q][3] = gb.y; ac[q][0] = 0.f; ac[q][1] = 0.f; ac[q][2] = 0.f; ac[q][3] = 0.f; }
#pragma unroll 8
        for (int kk = 0; kk < 64; ++kk) { const f32x4 wv = *(const LAS f32x4*)(w2l + (kk * 64 + F.lane) * 4);
#pragma unroll
            for (int q = 0; q < 4; ++q) { ac[q][0] += rl_f(hh_[q][0], kk) * wv.x; ac[q][1] += rl_f(hh_[q][1], kk) * wv.y; ac[q][2] += rl_f(hh_[q][2], kk) * wv.z; ac[q][3] += rl_f(hh_[q][3], kk) * wv.w; } }
#pragma unroll
        for (int q = 0; q < 4; ++q) { const int r = rb + q * rstep; if (r < 4096) {
            const int bg = r >> 7, i = r & 127;
            const float acc = i < NCMP ? (ac[q][0] + ac[q][1]) + (ac[q][2] + ac[q][3]) : 0.f;
            if (mat == 0) { const float ss = wave_sum(acc * acc); const float rs = 1.f / sqrtf(ss * (1.f / 64.f) + RMS_EPS);
                const int d = F.lane, dc = d >> 3;
                kc[((size_t)bg * 4 + (i >> 5)) * 2048 + (dc >> 1) * 512 + ((dc & 1) * 32 + (i & 31)) * 8 + (d & 7)] = (f16)(i < NCMP ? acc * rs * F.in[I_KNW][F.lane] : 0.f); }
            else { const int kap = i & 15, pp = ((kap >> 2) & 1) * 8 + (kap >> 3) * 4 + (kap & 3);
                const int d = F.lane;
                vt[((size_t)bg * 4 + (i >> 5)) * 2048 + ((d >> 5) * 2 + ((i >> 4) & 1)) * 512 + ((pp >> 3) * 32 + (d & 31)) * 8 + (pp & 7)] = (f16)acc; } } }
    }
    __syncthreads();
}

__device__ __forceinline__ int t5_bucket(int rel) {
    if (rel < 16) return rel;
    int b = 16;
    b += rel >= 19; b += rel >= 21; b += rel >= 24; b += rel >= 27; b += rel >= 31; b += rel >= 35; b += rel >= 40; b += rel >= 46;
    b += rel >= 52; b += rel >= 59; b += rel >= 67; b += rel >= 77; b += rel >= 87; b += rel >= 99; b += rel >= 113;
    return b;
}
__device__ __forceinline__ int med3i(int a, int lo, int hi) { return a < lo ? lo : (a > hi ? hi : a); }
__device__ __forceinline__ float other_half_max(float x) { const auto r = __builtin_amdgcn_permlane32_swap(__float_as_uint(x), __float_as_uint(x), false, false); return fmaxf(__uint_as_float(r[0]), __uint_as_float(r[1])); }
__device__ __forceinline__ float both_halves_sum(float x) { const auto r = __builtin_amdgcn_permlane32_swap(__float_as_uint(x), __float_as_uint(x), false, false); return __uint_as_float(r[0]) + __uint_as_float(r[1]); }
struct AFrag { f16x8 k[4]; f16x8 v[2][2]; };
__device__ __forceinline__ void attn_load(AFrag& f, const f16* Kp, const f16* Vp, int kt, int r31, int hh) {
    const f16* kp = Kp + (size_t)kt * 2048 + (hh * 32 + r31) * 8; const f16* vp = Vp + (size_t)kt * 2048 + (hh * 32 + r31) * 8;
#pragma unroll
    for (int ks = 0; ks < 4; ++ks) f.k[ks] = *(const GAS f16x8*)(kp + ks * 512);
#pragma unroll
    for (int dt = 0; dt < 2; ++dt)
#pragma unroll
        for (int s2 = 0; s2 < 2; ++s2) f.v[dt][s2] = *(const GAS f16x8*)(vp + (dt * 2 + s2) * 512);
}
__device__ __forceinline__ f16x8 pack8(const f32x16& c, int s2) {
    f16x8 o;
#pragma unroll
    for (int j = 0; j < 8; ++j) o[j] = (f16)c[8 * s2 + j];
    return o;
}
__device__ __forceinline__ void attn_tile(const AFrag& f, const f16x8 (&bq)[4], int kt, int t0, int t, int hh, int wlim, unsigned selm, float cfar, const LAS float* lutr,
                                          float& mrun, float& lrun, f32x16& O0, f32x16& O1) {
    f32x16 S;
#pragma unroll
    for (int i = 0; i < 16; ++i) S[i] = 0.f;
#pragma unroll
    for (int ks = 0; ks < 4; ++ks) S = __builtin_amdgcn_mfma_f32_32x32x16_f16(f.k[ks], bq[ks], S, 0, 0, 0);
    const int k0 = kt * 32, minrel = t0 - (k0 + 31), maxrel = t0 + 7 - k0;
    const bool selbit = ((selm >> (kt >> 1)) & 1u) != 0u;
    if (minrel >= 113 && maxrel < wlim) {
        const float addc = selbit ? cfar : -2e30f;
#pragma unroll
        for (int i = 0; i < 16; ++i) S[i] += addc;
    } else {
        const unsigned wl = selbit ? (unsigned)wlim : 0u; const int relb = t - k0 - 4 * hh;
        float bias[16];
#pragma unroll
        for (int i = 0; i < 16; ++i) bias[i] = lutr[med3i(relb - ((i & 3) + 8 * (i >> 2)), 0, 127)];
#pragma unroll
        for (int i = 0; i < 16; ++i) asm volatile("" : "+v"(bias[i]));
#pragma unroll
        for (int i = 0; i < 16; ++i) { const int rel = relb - ((i & 3) + 8 * (i >> 2)); S[i] = ((unsigned)rel < wl) ? S[i] + bias[i] : -2e30f; }
    }
    float tmax = S[0];
#pragma unroll
    for (int i = 1; i < 16; ++i) tmax = fmaxf(tmax, S[i]);
    tmax = other_half_max(tmax);
    const float mnew = fmaxf(mrun, tmax), alpha = __builtin_amdgcn_exp2f(mrun - mnew);
    mrun = mnew; lrun *= alpha;
#pragma unroll
    for (int i = 0; i < 16; ++i) { O0[i] *= alpha; O1[i] *= alpha; }
#pragma unroll
    for (int i = 0; i < 16; ++i) { const float pv = __builtin_amdgcn_exp2f(S[i] - mnew); lrun += pv; S[i] = pv; }
#pragma unroll
    for (int s2 = 0; s2 < 2; ++s2) { const f16x8 pb = pack8(S, s2);
        O0 = __builtin_amdgcn_mfma_f32_32x32x16_f16(f.v[0][s2], pb, O0, 0, 0, 0); O1 = __builtin_amdgcn_mfma_f32_32x32x16_f16(f.v[1][s2], pb, O1, 0, 0, 0); }
}
__device__ __forceinline__ void attn_branch(const f16* Kp, const f16* Vp, unsigned long long tm, const f16x8 (&bq)[4], int t0, int t, int r31, int hh, int wlim, unsigned selm, float cfar,
                                            const LAS float* lutr, float gate, LAS float* TL) {
    float mrun = -1e30f, lrun = 0.f; f32x16 O0, O1;
#pragma unroll
    for (int i = 0; i < 16; ++i) { O0[i] = 0.f; O1[i] = 0.f; }
    AFrag fA, fB;
    int ktA = __builtin_ctzll(tm), ktB;
    attn_load(fA, Kp, Vp, ktA, r31, hh);
    for (;;) {
        tm &= tm - 1; const bool hasB = tm != 0ull; ktB = hasB ? __builtin_ctzll(tm) : ktA; attn_load(fB, Kp, Vp, ktB, r31, hh);
        attn_tile(fA, bq, ktA, t0, t, hh, wlim, selm, cfar, lutr, mrun, lrun, O0, O1);
        if (!hasB) break;
        tm &= tm - 1; const bool hasA = tm != 0ull; ktA = hasA ? __builtin_ctzll(tm) : ktB; attn_load(fA, Kp, Vp, ktA, r31, hh);
        attn_tile(fB, bq, ktB, t0, t, hh, wlim, selm, cfar, lutr, mrun, lrun, O0, O1);
        if (!hasA) break;
    }
    lrun = both_halves_sum(lrun);
    const float sc = gate / fmaxf(lrun, 1e-30f);
#pragma unroll
    for (int i = 0; i < 16; ++i) { TL[i * 64] += O0[i] * sc; TL[(16 + i) * 64] += O1[i] * sc; }
}
__device__ __forceinline__ void p5_attention(Frame& F) {
    unsigned char* ws = F.ws;
    const f16* Y = (const f16*)(ws + WS_Y);
    const float* gates = (const float*)(ws + WS_GATES);
    f16* CAT = (f16*)(ws + WS_CAT);
    LAS float* wl = (LAS float*)(F.lds + F.wave * 8192);
    LAS float* LUT = wl;
    const int gw = F.vcu * NWAVES + F.wave, NW = F.G * NWAVES;
    const bool snake = (8192 % (2 * NW)) == 0, bal = (NW == 2048);
    int lut_g = -1;
    LAS unsigned* SELM = (LAS unsigned*)(wl + 1280);
    for (int it = gw, rr = 0; it < 8192; it += NW, ++rr) {
        int n = (snake && (rr & 1)) ? (rr * NW + (NW - 1 - gw)) : it;
        if (bal) {
            const int xq = gw >> 8, u = gw & 255;
            if (rr < 3) { const int f = rr * 256 + u, q = f / 192; n = (q * 8 + xq) * 256 + 64 + (f - q * 192); }
            else { const int c = u >> 3, w = u & 7, k = (c & 7) * 4 + (w & 3); n = ((c >> 3) * 8 + xq) * 256 + ((w & 4) ? 63 - k : k); } }
        const int bg = n >> 8, pos = n & 255, b = bg >> 2, g = bg & 3, t0 = pos * 8;
        int lane = F.lane; asm volatile("" : "+v"(lane));
        const int r31 = lane & 31, hh = lane >> 5, tok8 = r31 >> 2, r = r31 & 3;
        const LAS float* lutr = LUT + r * 128;
        if (g != lut_g) {
            LDS_WAIT(); asm volatile("" ::: "memory");
#pragma unroll
            for (int e = 0; e < 2; ++e) { const int rel = lane + 64 * e, bk = t5_bucket(rel);
#pragma unroll
                for (int r4 = 0; r4 < 4; ++r4) LUT[r4 * 128 + rel] = F.in[I_RELB][bk * 16 + 4 * g + r4] * LOG2E; }
            LDS_WAIT(); asm volatile("" ::: "memory");
            lut_g = g;
        }
        const int t = t0 + tok8, head = 4 * g + r; const size_t m = (size_t)b * SEQ + t;
        f16x8 bq[4];
#pragma unroll
        for (int ks = 0; ks < 4; ++ks) bq[ks] = *(const GAS f16x8*)((const f16*)(ws + WS_QN) + m * 1024 + head * 64 + ks * 16 + hh * 8);
        const float g_c = gates[m * 48 + head * 3 + 0], g_s = gates[m * 48 + head * 3 + 1], g_w = gates[m * 48 + head * 3 + 2];
        const float cfar = lutr[127];
        LAS float* TL = (LAS float*)(F.lds + 65536 + F.wave * 8192) + lane;
        {
            const f16* kc = (const f16*)(ws + WS_KCMP) + (size_t)bg * 128 * 64;
            const f16* vc = (const f16*)(ws + WS_VCMPT) + (size_t)bg * 64 * 128;
            f32x16 c[4];
#pragma unroll
            for (int kt = 0; kt < 4; ++kt) {
#pragma unroll
                for (int i = 0; i < 16; ++i) c[kt][i] = 0.f;
#pragma unroll
                for (int ks = 0; ks < 4; ++ks) { const f16x8 a = *(const GAS f16x8*)(kc + kt * 2048 + ks * 512 + (hh * 32 + r31) * 8); c[kt] = __builtin_amdgcn_mfma_f32_32x32x16_f16(a, bq[ks], c[kt], 0, 0, 0); }
                asm volatile("" ::: "memory");
            }
            const int relb = t - 31 - 64 * hh; float mx = -1e30f;
#pragma unroll
            for (int kt = 0; kt < 4; ++kt) { float bias[16];
#pragma unroll
                for (int i = 0; i < 16; ++i) { const int rel = relb - 16 * (kt * 32 + (i & 3) + 8 * (i >> 2)); bias[i] = lutr[med3i(rel, 0, 127)]; }
#pragma unroll
                for (int i = 0; i < 16; ++i) asm volatile("" : "+v"(bias[i]));
#pragma unroll
                for (int i = 0; i < 16; ++i) { const int rel = relb - 16 * (kt * 32 + (i & 3) + 8 * (i >> 2));
                    const float sv = rel >= 0 ? c[kt][i] + bias[i] : -2e30f; c[kt][i] = sv; mx = fmaxf(mx, sv); }
                asm volatile("" ::: "memory"); }
            mx = other_half_max(mx);
            float l = 0.f;
#pragma unroll
            for (int kt = 0; kt < 4; ++kt)
#pragma unroll
                for (int i = 0; i < 16; ++i) { const float pv = __builtin_amdgcn_exp2f(c[kt][i] - mx); c[kt][i] = pv; l += pv; }
            l = both_halves_sum(l);
            const float inv = 1.f / fmaxf(l, 1e-30f);
#pragma unroll
            for (int kt = 0; kt < 4; ++kt)
#pragma unroll
                for (int jj = 0; jj < 4; ++jj) { float own = (2.f * (c[kt][4 * jj] + c[kt][4 * jj + 1] + c[kt][4 * jj + 2]) + c[kt][4 * jj + 3]) * inv, p3 = c[kt][4 * jj + 3] * inv;
                    own += dpp_f<0xB1>(own); own += dpp_f<0x4E>(own); p3 += dpp_f<0xB1>(p3); p3 += dpp_f<0x4E>(p3);
                    if (r == 0) { const int j = kt * 8 + 2 * jj + hh; wl[512 + tok8 * 32 + j] = own; wl[768 + tok8 * 32 + j] = p3; } }
            f32x16 O0, O1;
#pragma unroll
            for (int i = 0; i < 16; ++i) { O0[i] = 0.f; O1[i] = 0.f; }
#pragma unroll
            for (int kt = 0; kt < 4; ++kt)
#pragma unroll
                for (int s2 = 0; s2 < 2; ++s2) { const f16x8 pb = pack8(c[kt], s2);
                    const f16x8 a0 = *(const GAS f16x8*)(vc + kt * 2048 + s2 * 512 + (hh * 32 + r31) * 8), a1 = *(const GAS f16x8*)(vc + kt * 2048 + (2 + s2) * 512 + (hh * 32 + r31) * 8);
                    O0 = __builtin_amdgcn_mfma_f32_32x32x16_f16(a0, pb, O0, 0, 0, 0); O1 = __builtin_amdgcn_mfma_f32_32x32x16_f16(a1, pb, O1, 0, 0, 0); asm volatile("" ::: "memory"); }
            const float sc = inv * g_c;
#pragma unroll
            for (int i = 0; i < 16; ++i) { TL[i * 64] = O0[i] * sc; TL[(16 + i) * 64] = O1[i] * sc; }
        }
        LDS_WAIT(); asm volatile("" ::: "memory");
        int lane2 = lane; asm volatile("" : "+v"(lane2));
        LAS float* OWN = wl + 512 + (lane2 >> 5) * 32 + (lane2 & 31); LAS float* P3 = OWN + 256; LAS float* VAL = OWN + 512;
#pragma unroll
        for (int pp = 0; pp < 4; ++pp) { const int tk = 2 * pp + hh, j = r31, cur = (t0 + tk) >> 6;
            const float impv = OWN[pp * 64] + (j > 0 ? P3[pp * 64 - (j > 0 ? 1 : 0)] : 0.f);
            VAL[pp * 64] = (j == 0 || j == cur || j == cur - 1) ? 1e4f : (j <= cur ? impv : -1e30f); }
        LDS_WAIT(); asm volatile("" ::: "memory");
#pragma unroll
        for (int pp = 0; pp < 4; ++pp) { const int tk = 2 * pp + hh, j = r31, cur = (t0 + tk) >> 6; const float v = VAL[pp * 64]; int cnt = 0; const LAS float* vrow = VAL + pp * 64 - j;
#pragma unroll
            for (int j2 = 0; j2 < 32; ++j2) { const float o = vrow[j2]; cnt += (o > v || (o == v && j2 < j)) ? 1 : 0; }
            const unsigned long long bm = __ballot(cnt < 8 && j <= cur);
            const unsigned mym = hh ? (unsigned)(bm >> 32) : (unsigned)bm;
            if (j == 0) SELM[tk] = mym; }
        LDS_WAIT(); asm volatile("" ::: "memory");
        const unsigned selm = SELM[tok8];
        unsigned um = 0u;
#pragma unroll
        for (int i = 0; i < 8; ++i) um |= SELM[i];
        um = (unsigned)__builtin_amdgcn_readfirstlane((int)um);
        const int kthi = (t0 + 7) >> 5;
        const unsigned long long causal = (kthi >= 63) ? ~0ull : ((1ull << (kthi + 1)) - 1ull);
        {
            unsigned long long x = um;
            x = (x | (x << 16)) & 0x0000FFFF0000FFFFull; x = (x | (x << 8)) & 0x00FF00FF00FF00FFull; x = (x | (x << 4)) & 0x0F0F0F0F0F0F0F0Full;
            x = (x | (x << 2)) & 0x3333333333333333ull; x = (x | (x << 1)) & 0x5555555555555555ull;
            const unsigned long long tm = (x | (x << 1)) & causal;
            attn_branch((const f16*)(ws + WS_KN) + (size_t)bg * SEQ * 64, (const f16*)(ws + WS_VT) + (size_t)bg * 64 * SEQ, tm, bq, t0, t, r31, hh, 1 << 30, selm, cfar, lutr, g_s, TL);
        }
        {
            const int lo = t0 - 511 > 0 ? (t0 - 511) >> 5 : 0;
            const unsigned long long tm = causal & ~((1ull << lo) - 1ull);
            attn_branch((const f16*)(ws + WS_KN) + (size_t)(BATCH * 4 + bg) * SEQ * 64, (const f16*)(ws + WS_VT) + (size_t)(BATCH * 4 + bg) * 64 * SEQ, tm, bq, t0, t, r31, hh, 512, 0xFFFFFFFFu, cfar, lutr, g_w, TL);
        }
        f16* orow = CAT + m * D + 1024 + head * 64 + 4 * hh;
#pragma unroll
        for (int jj = 0; jj < 4; ++jj) {
            u32x2 o0; o0.x = pk_f16(TL[(4 * jj) * 64], TL[(4 * jj + 1) * 64]); o0.y = pk_f16(TL[(4 * jj + 2) * 64], TL[(4 * jj + 3) * 64]); *(GAS u32x2*)(orow + 8 * jj) = o0;
            u32x2 o1; o1.x = pk_f16(TL[(16 + 4 * jj) * 64], TL[(16 + 4 * jj + 1) * 64]); o1.y = pk_f16(TL[(16 + 4 * jj + 2) * 64], TL[(16 + 4 * jj + 3) * 64]); *(GAS u32x2*)(orow + 32 + 8 * jj) = o1; }
    }
}

__device__ __forceinline__ void cvt_row_fp6(const f32x4 (&v)[8], int row, unsigned char* dst6, float* scales, int lane) {
    float amax = 0.f;
#pragma unroll
    for (int c = 0; c < 8; ++c) amax = fmaxf(amax, fmaxf(fmaxf(fabsf(v[c].x), fabsf(v[c].y)), fmaxf(fabsf(v[c].z), fabsf(v[c].w))));
    amax = wave_max(amax);
    const float scale = amax > 0.f ? amax * (1.f / 7.5f) : 1.f, inv = 1.f / scale;
    f16x32 h;
#pragma unroll
    for (int c = 0; c < 8; ++c) { h[4 * c] = (f16)(v[c].x * inv); h[4 * c + 1] = (f16)(v[c].y * inv); h[4 * c + 2] = (f16)(v[c].z * inv); h[4 * c + 3] = (f16)(v[c].w * inv); }
    const u32x6 pk = __builtin_amdgcn_cvt_scalef32_pk32_fp6_f16(h, 1.0f);
    unsigned char* d = dst6 + (size_t)(lane >> 3) * SLICE6;
    *(GAS u32x4*)(d + (size_t)row * 128 + (lane & 7) * 16) = (u32x4){pk[0], pk[1], pk[2], pk[3]}; *(GAS u32x2*)(d + 2097152 + (size_t)row * 64 + (lane & 7) * 8) = (u32x2){pk[4], pk[5]};
    if (lane == 0) scales[row] = scale;
}
__device__ __forceinline__ void cvt_table_fp6(Frame& F, const float* src, unsigned char* dst6, float* scales, const float* colw) {
    const int gw = F.vcu * NWAVES + F.wave, NGW = F.G * NWAVES, lane = F.lane;
    int row = gw;
    for (; row + NGW < 16384; row += 2 * NGW) {
        f32x4 va[8], vb[8];
#pragma unroll
        for (int c = 0; c < 8; ++c) { va[c] = __builtin_nontemporal_load((const GAS f32x4*)(src + (size_t)row * D + c * 256 + lane * 4)); vb[c] = __builtin_nontemporal_load((const GAS f32x4*)(src + (size_t)(row + NGW) * D + c * 256 + lane * 4)); }
        if (colw) {
#pragma unroll
            for (int c = 0; c < 8; ++c) { const f32x4 wv = *(const GAS f32x4*)(colw + c * 256 + lane * 4); va[c] = va[c] * wv; vb[c] = vb[c] * wv; } }
        cvt_row_fp6(va, row, dst6, scales, lane); cvt_row_fp6(vb, row + NGW, dst6, scales, lane);
    }
    for (; row < 16384; row += NGW) { f32x4 va[8];
#pragma unroll
        for (int c = 0; c < 8; ++c) { va[c] = *(const GAS f32x4*)(src + (size_t)row * D + c * 256 + lane * 4); if (colw) va[c] = va[c] * *(const GAS f32x4*)(colw + c * 256 + lane * 4); }
        cvt_row_fp6(va, row, dst6, scales, lane); }
}
__device__ __forceinline__ void p7_tables(Frame& F) {
    cvt_table_fp6(F, F.in[I_PU], F.ws + WS_U6, (float*)(F.ws + WS_SU), F.in[I_FFNNW]);
    cvt_table_fp6(F, F.in[I_PV], F.ws + WS_V6, (float*)(F.ws + WS_SV), nullptr);
}

__device__ __forceinline__ void bitonic_sort16_desc(float (&a)[16]) {
#pragma unroll
    for (int k = 2; k <= 16; k <<= 1)
#pragma unroll
        for (int j = k >> 1; j > 0; j >>= 1)
#pragma unroll
            for (int i = 0; i < 16; ++i) { const int l = i ^ j; if (l > i) { const float hi = fmaxf(a[i], a[l]), lo = fminf(a[i], a[l]); if ((i & k) == 0) { a[i] = hi; a[l] = lo; } else { a[i] = lo; a[l] = hi; } } }
}
__device__ __forceinline__ void bitonic_merge16_desc(float (&a)[16]) {
#pragma unroll
    for (int dist = 8; dist >= 1; dist >>= 1)
#pragma unroll
        for (int i = 0; i < 16; ++i) if ((i & dist) == 0) { const float hi = fmaxf(a[i], a[i + dist]), lo = fminf(a[i], a[i + dist]); a[i] = hi; a[i + dist] = lo; }
}
#define INS16(top, v) do { _Pragma("unroll") for (int _j = 0; _j < 16; ++_j) { const float _h = fmaxf(top[_j], v); v = fminf(top[_j], v); top[_j] = _h; } } while (0)
#define INS16P(tv, ti, v, i) do { _Pragma("unroll") for (int _j = 0; _j < 16; ++_j) { const bool _c = v > tv[_j]; const float _nv = _c ? tv[_j] : v; const unsigned _ni = _c ? ti[_j] : i; \
        tv[_j] = _c ? v : tv[_j]; ti[_j] = _c ? i : ti[_j]; v = _nv; i = _ni; } } while (0)
typedef unsigned v4u_t __attribute__((__vector_size__(16)));
typedef unsigned v2u_t __attribute__((__vector_size__(8)));
__device__ __forceinline__ void p9a_topk(Frame& F) {
    unsigned char* ws = F.ws;
    const f16* QP = (const f16*)(ws + WS_QP); const f16* KEYS = (const f16*)(ws + WS_KEYS);
    unsigned* LIDX = (unsigned*)(ws + WS_LIDX); float* LG = (float*)(ws + WS_LG);
    const int lane = F.lane, r31 = lane & 31, hh = lane >> 5;
    const float NINF = -__builtin_inff();
    for (int unit = F.vcu; unit < M / 32; unit += F.G) {
        const int m0 = unit * 32;
        {
            const int h = F.wave;
            float sl[2][16];
            f16x8 bq[8], ka[8];
#pragma unroll
            for (int ks = 0; ks < 8; ++ks) { bq[ks] = *(const GAS f16x8*)(QP + (size_t)(m0 + r31) * D + (h * 2) * 128 + ks * 16 + hh * 8);
                ka[ks] = *(const GAS f16x8*)(KEYS + ((size_t)((h * 2) * 128 + r31)) * 128 + hh * 8 + ks * 16); }
            float top[16];
#pragma unroll
            for (int st = 0; st < 8; ++st) { const int p = st >> 2, kt = st & 3;
                if (kt == 0) {
#pragma unroll
                    for (int j = 0; j < 16; ++j) top[j] = NINF; }
                f32x16 c;
#pragma unroll
                for (int i = 0; i < 16; ++i) c[i] = 0.f;
#pragma unroll
                for (int ks = 0; ks < 8; ++ks) c = __builtin_amdgcn_mfma_f32_32x32x16_f16(ka[ks], bq[ks], c, 0, 0, 0);
                if (st + 1 < 8) { const int pn = (st + 1) >> 2, ktn = (st + 1) & 3;
#pragma unroll
                    for (int ks = 0; ks < 8; ++ks) ka[ks] = *(const GAS f16x8*)(KEYS + ((size_t)((h * 2 + pn) * 128 + ktn * 32 + r31)) * 128 + hh * 8 + ks * 16);
                    if (st == 3) {
#pragma unroll
                        for (int ks = 0; ks < 8; ++ks) bq[ks] = *(const GAS f16x8*)(QP + (size_t)(m0 + r31) * D + (h * 2 + 1) * 128 + ks * 16 + hh * 8); } }
                const unsigned k4 = (unsigned)(kt * 32 + 4 * hh);
                float nv[16];
#pragma unroll
                for (int reg = 0; reg < 16; ++reg) { const unsigned key = k4 + (unsigned)((reg & 3) + 8 * (reg >> 2)); nv[reg] = __uint_as_float((__float_as_uint(c[reg]) & ~127u) | key); }
                bitonic_sort16_desc(nv);
#pragma unroll
                for (int j = 0; j < 16; ++j) top[j] = fmaxf(top[j], nv[15 - j]);
                bitonic_merge16_desc(top);
                if (kt == 3) {
                    float cm[16];
#pragma unroll
                    for (int j = 0; j < 16; ++j) cm[j] = fmaxf(top[j], __uint_as_float(other32u(__float_as_uint(top[15 - j]), hh != 0)));
                    bitonic_merge16_desc(cm);
#pragma unroll
                    for (int j = 0; j < 16; ++j) sl[p][j] = cm[j]; }
            }
            float vx[16], vy[16]; unsigned ix[16], iy[16];
#pragma unroll
            for (int j = 0; j < 16; ++j) { const unsigned bx = __float_as_uint(hh ? sl[1][j] : sl[0][j]), by = __float_as_uint(hh ? sl[0][j] : sl[1][j]);
                vx[j] = __uint_as_float(bx & ~127u); vy[j] = __uint_as_float(by & ~127u); ix[j] = (bx & 127u) * (hh ? 1u : 128u); iy[j] = (by & 127u) * (hh ? 128u : 1u); }
            float tv[16]; unsigned ti[16];
#pragma unroll
            for (int j = 0; j < 16; ++j) { const int jb = j + 1 < 16 ? j + 1 : 15;
                const float v0 = vx[0] + vy[j], v1 = (j < 15) ? vx[0] + vy[jb] : NINF; const unsigned i0 = ix[0] + iy[j], i1 = ix[0] + iy[jb];
                tv[j] = hh ? v1 : v0; ti[j] = hh ? i1 : i0; }
#pragma unroll
            for (int a = 1; a < 4; ++a) { const int bmax = (a == 1) ? 7 : (a == 2 ? 4 : 3);
#pragma unroll
                for (int b = a; b <= bmax; ++b) { float v = vx[a] + vy[b]; if (a == b) v = hh ? NINF : v; unsigned i = ix[a] + iy[b]; INS16P(tv, ti, v, i); } }
            float mv[16]; unsigned mi[16];
#pragma unroll
            for (int j = 0; j < 16; ++j) { const float pv = __uint_as_float(other32u(__float_as_uint(tv[15 - j]), hh != 0)); const unsigned pi = other32u(ti[15 - j], hh != 0); const bool c = pv > tv[j]; mv[j] = c ? pv : tv[j]; mi[j] = c ? pi : ti[j]; }
            float mx = mv[0];
#pragma unroll
            for (int j = 1; j < 16; ++j) mx = fmaxf(mx, mv[j]);
            float sum = 0.f;
#pragma unroll
            for (int j = 0; j < 16; ++j) { mv[j] = __builtin_amdgcn_exp2f((mv[j] - mx) * LOG2E); sum += mv[j]; }
            const float inv = 1.f / sum;
#pragma unroll
            for (int j = 0; j < 8; ++j) { { const int e_ = h * 16 + hh * 8 + j, pos_ = (e_ & 63) * 2 + (e_ >> 6); LIDX[(size_t)(m0 + r31) * 128 + pos_] = mi[j]; LG[(size_t)(m0 + r31) * 128 + pos_] = mv[j] * inv; } }
        }
    }
}
struct Seg6 { v4u_t a; v2u_t b; };
__device__ __forceinline__ f16x32 seg6_decode(const Seg6& r) { const u32x6 p = {r.a[0], r.a[1], r.a[2], r.a[3], r.b[0], r.b[1]}; return __builtin_amdgcn_cvt_scalef32_pk32_f16_fp6(p, 1.0f); }
__device__ __forceinline__ f16x32 seg6_dec2(const v4u_t& a, const v2u_t& b) { const u32x6 p = {a[0], a[1], a[2], a[3], b[0], b[1]}; return __builtin_amdgcn_cvt_scalef32_pk32_f16_fp6(p, 1.0f); }
#define SEG_DECL(P) v4u_t P##a0, P##a1, P##a2, P##a3, P##a4, P##a5, P##a6, P##a7; v2u_t P##b0, P##b1, P##b2, P##b3, P##b4, P##b5, P##b6, P##b7
#define SEG_L1(P, G, idxv) do { const int e_ = __shfl(idxv, 8 * G + sub); P##a##G = __builtin_amdgcn_raw_buffer_load_b128(rs, e_ * 128 + ch * 16, 0, 0); P##b##G = __builtin_amdgcn_raw_buffer_load_b64(rs, 2097152 + e_ * 64 + ch * 8, 0, 0); } while (0)
#define SEG_LOAD(P, idxv) do { SEG_L1(P, 0, idxv); SEG_L1(P, 1, idxv); SEG_L1(P, 2, idxv); SEG_L1(P, 3, idxv); SEG_L1(P, 4, idxv); SEG_L1(P, 5, idxv); SEG_L1(P, 6, idxv); SEG_L1(P, 7, idxv); } while (0)
__device__ __forceinline__ float u_one(const v4u_t& a, const v2u_t& b, const f16x2 (&xp)[16]) {
    const f16x32 hv = seg6_dec2(a, b); float sdot = 0.f;
#pragma unroll
    for (int k = 0; k < 16; ++k) { f16x2 hp; hp.x = hv[2 * k]; hp.y = hv[2 * k + 1]; sdot = __builtin_amdgcn_fdot2(hp, xp[k], sdot, false); }
    return sum8(sdot);
}
#define SEG_LE(P, G, ev) do { const int e_ = (ev); P##a##G = __builtin_amdgcn_raw_buffer_load_b128(rs, e_ * 128 + ch * 16, 0, 0); P##b##G = __builtin_amdgcn_raw_buffer_load_b64(rs, 2097152 + e_ * 64 + ch * 8, 0, 0); } while (0)
#define EN_GATHER(en, iA, iB) do { _Pragma("unroll") for (int g_ = 0; g_ < 8; ++g_) { en[g_] = __shfl(iA, 8 * g_ + sub); en[8 + g_] = __shfl(iB, 8 * g_ + sub); } } while (0)
#define U_ROLL1(P, G, res, eo) do { const float d_ = u_one(P##a##G, P##b##G, xp); res = (ch == G) ? d_ : res; SEG_LE(P, G, en[(eo) + G]); } while (0)
#define U_ROLL(P, res, idxn) do { U_ROLL1(P, 0, res, idxn); U_ROLL1(P, 1, res, idxn); U_ROLL1(P, 2, res, idxn); U_ROLL1(P, 3, res, idxn); U_ROLL1(P, 4, res, idxn); U_ROLL1(P, 5, res, idxn); U_ROLL1(P, 6, res, idxn); U_ROLL1(P, 7, res, idxn); } while (0)
#define V_ROLL1(P, G, hwv, eo) do { v_one(P##a##G, P##b##G, acc, hq[(eo) + G]); SEG_LE(P, G, en[(eo) + G]); } while (0)
#define V_ROLL(P, hwv, idxn) do { V_ROLL1(P, 0, hwv, idxn); V_ROLL1(P, 1, hwv, idxn); V_ROLL1(P, 2, hwv, idxn); V_ROLL1(P, 3, hwv, idxn); V_ROLL1(P, 4, hwv, idxn); V_ROLL1(P, 5, hwv, idxn); V_ROLL1(P, 6, hwv, idxn); V_ROLL1(P, 7, hwv, idxn); } while (0)
#define FMIXV_LO(a, h, w) asm("v_fma_mix_f32 %0, %1, %2, %0 op_sel_hi:[1,0,0]" : "+v"(a) : "v"(h), "v"(w))
#define FMIXV_HI(a, h, w) asm("v_fma_mix_f32 %0, %1, %2, %0 op_sel:[1,0,0] op_sel_hi:[1,0,0]" : "+v"(a) : "v"(h), "v"(w))
__device__ __forceinline__ void v_one(const v4u_t& a, const v2u_t& b, f16x2 (&acc)[16], f16x2 wq) {
    const f16x32 hv = seg6_dec2(a, b);
#pragma unroll
    for (int k = 0; k < 16; ++k) { f16x2 hp; hp.x = hv[2 * k]; hp.y = hv[2 * k + 1]; acc[k] = __builtin_elementwise_fma(hp, wq, acc[k]); }
}
#define V_HALF(P, hwv) do { v_one(P##a0, P##b0, acc, hwv, sub); v_one(P##a1, P##b1, acc, hwv, 8 + sub); v_one(P##a2, P##b2, acc, hwv, 16 + sub); v_one(P##a3, P##b3, acc, hwv, 24 + sub); \
        v_one(P##a4, P##b4, acc, hwv, 32 + sub); v_one(P##a5, P##b5, acc, hwv, 40 + sub); v_one(P##a6, P##b6, acc, hwv, 48 + sub); v_one(P##a7, P##b7, acc, hwv, 56 + sub); } while (0)
__device__ __forceinline__ void p9b_upass(Frame& F, bool probe_slice0) {
    unsigned char* ws = F.ws;
    const int x = blockIdx.x & 7, rank = blockIdx.x >> 3, cnt = (F.G - x + 7) >> 3;
    const int lane = F.lane, sub = lane >> 3, ch = lane & 7;
    const __amdgpu_buffer_rsrc_t rs = __builtin_amdgcn_make_buffer_rsrc((void*)(ws + WS_U6 + (size_t)(probe_slice0 ? 0 : x) * SLICE6), 0, (int)SLICE6, 0x00020000);
    const f16* XN = (const f16*)(ws + WS_XR) + x * 32 + (lane >> 3) * 256 + (lane & 7) * 4;
    const u32x2* LI2 = (const u32x2*)(ws + WS_LIDX); LAS unsigned char* xl = F.lds + F.wave * 512;
    const int tstep = cnt * NWAVES; int t = rank * NWAVES + F.wave;
    if (t >= M) return;
    int cA, cB, nA, nB; { const u32x2 c2 = LI2[(size_t)t * 64 + lane]; cA = (int)c2.x; cB = (int)c2.y; }
    const int t1c = (t + tstep < M) ? t + tstep : t;
    { const u32x2 n2 = LI2[(size_t)t1c * 64 + lane]; nA = (int)n2.x; nB = (int)n2.y; }
    u32x2 xcur = *(const GAS u32x2*)(XN + (size_t)t * D);
    f16x2 xp[16];
    SEG_DECL(bA); SEG_DECL(bB);
    { const int li_ = cA; SEG_LOAD(bA, li_); } { const int li_ = cB; SEG_LOAD(bB, li_); }
#pragma unroll 1
    for (;;) {
        const int tn = t + tstep, tnn = tn + tstep; const bool hn = tn < M, hnn = tnn < M;
        const int tnc = hn ? tn : t, tnnc = hnn ? tnn : t;
        const u32x2 m2 = LI2[(size_t)tnnc * 64 + lane]; const int mA = (int)m2.x, mB = (int)m2.y;
        const u32x2 xnext = *(const GAS u32x2*)(XN + (size_t)tnc * D);
        *(LAS u32x2*)(xl + ((lane & 7) * 8 + (lane >> 3)) * 8) = xcur;
        LDS_WAIT(); asm volatile("" ::: "memory");
#pragma unroll
        for (int q = 0; q < 4; ++q) { const u32x4 tv = *(const LAS u32x4*)(xl + ch * 64 + q * 16); xp[4 * q] = ash2(tv.x); xp[4 * q + 1] = ash2(tv.y); xp[4 * q + 2] = ash2(tv.z); xp[4 * q + 3] = ash2(tv.w); }
        LDS_WAIT(); asm volatile("" ::: "memory");
        { const int lA_ = hn ? nA : cA, lB_ = hn ? nB : cB; int en[16]; EN_GATHER(en, lA_, lB_);
          float rA = 0.f, rB = 0.f; U_ROLL(bA, rA, 0); U_ROLL(bB, rB, 8);
          float* pd = (float*)(ws + WS_PD) + ((size_t)t * 8 + x) * 128 + 8 * ch + sub; pd[0] = rA; pd[64] = rB; }
        if (!hn) break;
        xcur = xnext;
        cA = nA; cB = nB; nA = mA; nB = mB; t = tn;
    }
}
__device__ __forceinline__ void p9h_weights(Frame& F) {
    unsigned char* ws = F.ws;
    const unsigned* LIDX = (const unsigned*)(ws + WS_LIDX); const float* LG = (const float*)(ws + WS_LG); const float* PD = (const float*)(ws + WS_PD);
    const float* SU = (const float*)(ws + WS_SU); const float* SV = (const float*)(ws + WS_SV); float* HW = (float*)(ws + WS_HW);
    const int gw = F.vcu * NWAVES + F.wave, NGW = F.G * NWAVES, lane = F.lane;
#pragma unroll 1
    for (int t0 = gw; t0 < M; t0 += 2 * NGW) {
        const int t1 = t0 + NGW < M ? t0 + NGW : t0;
        int iA[2], iB[2]; float pa[2][8], pb[2][8], lgA[2], lgB[2], s1[2];
#pragma unroll
        for (int q = 0; q < 2; ++q) { const int t = q ? t1 : t0; { const u32x2 i2 = ((const u32x2*)LIDX)[(size_t)t * 64 + lane]; iA[q] = (int)i2.x; iB[q] = (int)i2.y; }
#pragma unroll
            for (int xs = 0; xs < 8; ++xs) { pa[q][xs] = PD[((size_t)t * 8 + xs) * 128 + lane]; pb[q][xs] = PD[((size_t)t * 8 + xs) * 128 + 64 + lane]; }
            { const f32x2 g2 = ((const f32x2*)LG)[(size_t)t * 64 + lane]; lgA[q] = g2.x; lgB[q] = g2.y; } s1[q] = ((const float*)(ws + WS_SS1))[t]; }
#pragma unroll
        for (int q = 0; q < 2; ++q) { const int t = q ? t1 : t0; float zA = 0.f, zB = 0.f;
#pragma unroll
            for (int xs = 0; xs < 8; ++xs) { zA += pa[q][xs]; zB += pb[q][xs]; }
            const float rs1 = 1.f / sqrtf(s1[q] * (1.f / D) + RMS_EPS);
            ((f32x2*)HW)[(size_t)t * 64 + lane] = (f32x2){pg8::gelu1(zA * rs1 * SU[iA[q]]) * lgA[q] * SV[iA[q]], pg8::gelu1(zB * rs1 * SU[iB[q]]) * lgB[q] * SV[iB[q]]}; }
    }
}
__device__ __forceinline__ void p9c_vpass(Frame& F) {
    unsigned char* ws = F.ws;
    const int x = blockIdx.x & 7, rank = blockIdx.x >> 3, cnt = (F.G - x + 7) >> 3;
    const int lane = F.lane, sub = lane >> 3, ch = lane & 7;
    const __amdgpu_buffer_rsrc_t rs = __builtin_amdgcn_make_buffer_rsrc((void*)(ws + WS_V6 + (size_t)x * SLICE6), 0, (int)SLICE6, 0x00020000);
    const u32x2* LI2 = (const u32x2*)(ws + WS_LIDX);
    f16* XR = (f16*)(ws + WS_XR); float* SS2 = (float*)(ws + WS_SS2);
    const bool b3 = (lane & 8) != 0, b4 = (lane & 16) != 0, b5 = (lane & 32) != 0;
    const int col = ((b3 ? 4 : 0) + (b4 ? 2 : 0) + (b5 ? 1 : 0)) * 256 + x * 32 + ch * 4;
    const int tstep = cnt * NWAVES; int t = rank * NWAVES + F.wave;
    if (t >= M) return;
    int cA, cB, nA, nB; { const u32x2 c2 = LI2[(size_t)t * 64 + lane]; cA = (int)c2.x; cB = (int)c2.y; }
    const int t1c = (t + tstep < M) ? t + tstep : t;
    { const u32x2 n2 = LI2[(size_t)t1c * 64 + lane]; nA = (int)n2.x; nB = (int)n2.y; }
    const f32x2* HW2 = (const f32x2*)(ws + WS_HW);
    float hwA, hwB; { const f32x2 h2 = HW2[(size_t)t * 64 + lane]; hwA = h2.x; hwB = h2.y; }
    SEG_DECL(bA); SEG_DECL(bB);
    { const int li_ = cA; SEG_LOAD(bA, li_); } { const int li_ = cB; SEG_LOAD(bB, li_); }
#pragma unroll 1
    for (;;) {
        const int tn = t + tstep, tnn = tn + tstep; const bool hn = tn < M, hnn = tnn < M;
        const int tnc = hn ? tn : t, tnnc = hnn ? tnn : t;
        const u32x2 m2 = LI2[(size_t)tnnc * 64 + lane]; const int mA = (int)m2.x, mB = (int)m2.y;
        const f32x2 hn2 = HW2[(size_t)tnc * 64 + lane]; const float hwAn = hn2.x, hwBn = hn2.y;
        f16* orow = XR + (size_t)t * D + col; const u32x2 x1r = *(const GAS u32x2*)orow;
        f16x2 acc[16];
#pragma unroll
        for (int i = 0; i < 16; ++i) { acc[i].x = (f16)0.f; acc[i].y = (f16)0.f; }
        { const int lA_ = hn ? nA : cA, lB_ = hn ? nB : cB; int en[16]; EN_GATHER(en, lA_, lB_); f16x2 hq[16];
#pragma unroll
          for (int g_ = 0; g_ < 8; ++g_) { const float qa = __shfl(hwA, 8 * g_ + sub) * 64.f, qb = __shfl(hwB, 8 * g_ + sub) * 64.f;
              hq[g_].x = (f16)qa; hq[g_].y = (f16)qa; hq[8 + g_].x = (f16)qb; hq[8 + g_].y = (f16)qb; }
          V_ROLL(bA, hwA, 0); V_ROLL(bB, hwB, 8); }
        f16x2 q8[8];
#pragma unroll
        for (int i = 0; i < 8; ++i) { const f16x2 keep = b3 ? acc[8 + i] : acc[i], send = b3 ? acc[i] : acc[8 + i]; q8[i] = keep + ash2(other8u(__builtin_bit_cast(unsigned, send))); }
        f16x2 q4[4];
#pragma unroll
        for (int i = 0; i < 4; ++i) { const f16x2 keep = b4 ? q8[4 + i] : q8[i], send = b4 ? q8[i] : q8[4 + i]; q4[i] = keep + ash2(other16u(__builtin_bit_cast(unsigned, send), b4)); }
        float r4[4];
        { const f16x2 k0 = b5 ? q4[2] : q4[0], k1 = b5 ? q4[3] : q4[1], s0 = b5 ? q4[0] : q4[2], s1 = b5 ? q4[1] : q4[3];
          const f16x2 p0 = ash2(other32u(__builtin_bit_cast(unsigned, s0), b5)), p1 = ash2(other32u(__builtin_bit_cast(unsigned, s1), b5));
          r4[0] = ((float)k0.x + (float)p0.x) * (1.f / 64.f); r4[1] = ((float)k0.y + (float)p0.y) * (1.f / 64.f); r4[2] = ((float)k1.x + (float)p1.x) * (1.f / 64.f); r4[3] = ((float)k1.y + (float)p1.y) * (1.f / 64.f); }
        const f16x2 x1a = ash2(x1r.x), x1b = ash2(x1r.y);
        const f32x4 x2 = {(float)x1a.x + r4[0], (float)x1a.y + r4[1], (float)x1b.x + r4[2], (float)x1b.y + r4[3]};
        { u32x2 o2; o2.x = pk_f16(x2.x, x2.y); o2.y = pk_f16(x2.z, x2.w); *(GAS u32x2*)orow = o2; }
        const float ss = wave_sum((x2.x * x2.x + x2.y * x2.y) + (x2.z * x2.z + x2.w * x2.w));
        if (lane == 0) atomicAdd(SS2 + t, ss);
        if (!hn) break;
        cA = nA; cB = nB; nA = mA; nB = mB; t = tn; hwA = hwAn; hwB = hwBn;
    }
}
#undef FMIXV_LO
#undef FMIXV_HI

constexpr int NPH = 13;
struct Args { const float* in[26]; float* out; unsigned char* ws; int ph_lo, ph_hi; int rep[16]; };
__global__ void __launch_bounds__(NWAVES * 64, 2) fwd_kernel(Args args) {
    extern __shared__ __attribute__((aligned(16))) unsigned char lds[];
    Frame F;
    F.lds = (LAS unsigned char*)lds;
    F.MISC = (volatile LAS unsigned*)(F.lds + MISC_OFF);
    F.tid = threadIdx.x; F.lane = F.tid & 63; F.wave = __builtin_amdgcn_readfirstlane(F.tid >> 6);
#define PHASE_LANES() do { int t_ = threadIdx.x; asm volatile("" : "+v"(t_)); F.tid = t_; F.lane = t_ & 63; } while (0)
    F.G = gridDim.x; { const int bx = blockIdx.x; F.vcu = (F.G % 8 == 0) ? (bx % 8) * (F.G / 8) + bx / 8 : bx; }
#pragma unroll
    for (int i = 0; i < 26; ++i) F.in[i] = args.in[i];
    F.out = args.out; F.ws = args.ws;
    unsigned char* ws = args.ws;
    gu32* ctl = (gu32*)(ws + WS_CTL);
    for (int u = F.tid; u < (LDS_BYTES - LDSCTL_OFF) / 4; u += NWAVES * 64) ((LAS unsigned*)(F.lds + LDSCTL_OFF))[u] = 0u;
    __syncthreads();
    XcdBarrier bar; bar.bar = (unsigned*)(ctl + CW_BAR); bar.x = 0; bar.st = nullptr;
    if (MK_ONE_LAUNCH) bar = xcd_barrier_post((unsigned*)(ctl + CW_BAR), F.MISC + 8);
#define GRID_BAR() do { if (MK_ONE_LAUNCH) xcd_barrier(bar); } while (0)
    const int lo = args.ph_lo, hi = args.ph_hi;
#define IN(k) (lo <= (k) && (k) < hi)
#define BOTH(k) (IN(k) && IN((k) + 1))

    if (IN(0)) { PHASE_LANES(); for (int rp = 0; rp < args.rep[0]; ++rp) p0_prologue(F); if (BOTH(0)) GRID_BAR(); }

    if (IN(1)) {
        pg8::Gemm g{(const f16*)(ws + WS_XR), (const f16*)(ws + WS_WIN), M, NINP, D, D, D, 0, 1 << 30, 0};
        pg8::StaticOrder S; S.init(M, NINP, F.G, (int)blockIdx.x);
        pg8::EpiF16Row E{(f16*)(ws + WS_Y), NINP, (const float*)(ws + WS_SS0)};
        pg8::gemm_phase(F.lds, g, S, E);
        if (BOTH(1)) GRID_BAR();
    }

    if (IN(2)) { PHASE_LANES(); for (int rp = 0; rp < PROBE_REP2; ++rp) p2_post(F); if (BOTH(2)) GRID_BAR(); }

    if (IN(3)) {
        { pg8::Gemm g{(const f16*)(ws + WS_FLATA), (const f16*)(ws + WS_W1C), 8192, 1024, 512, D, D, 512, 16, (size_t)256 * D * 2, 512};
          pg8::StaticOrder S; S.init(8192, 1024, F.G, (int)blockIdx.x);
          pg8::EpiRawF32 E{(float*)(ws + WS_Y), 1024};
          pg8::gemm_phase(F.lds, g, S, E); }
        { pg8::Gemm g{(const f16*)(ws + WS_MIXED), (const f16*)(ws + WS_POOLT), M, 1024, 256, 1024, 256, 256, 1 << 30, 0};
          pg8::StaticOrder S; S.init(M, 1024, F.G, (int)((blockIdx.x + 128) % F.G));
          pg8::EpiF16<0> E{(f16*)(ws + WS_CAT), D, nullptr, 1 << 30, 0};
          pg8::gemm_phase(F.lds, g, S, E); }
        if (BOTH(3)) GRID_BAR();
    }

    if (IN(4)) { PHASE_LANES(); p4_compress2(F); if (BOTH(4)) GRID_BAR(); }

    if (IN(5)) { PHASE_LANES(); for (int rp = 0; rp < args.rep[5]; ++rp) p5_attention(F); if (BOTH(5)) GRID_BAR(); }

    if (IN(6)) {
        pg8::Gemm g{(const f16*)(ws + WS_CAT), (const f16*)(ws + WS_WOUT), M, D, D, D, D, 0, 1 << 30, 0};
        pg8::StaticOrder S; S.init(M, D, F.G, (int)blockIdx.x);
        pg8::EpiRes16 E{(f16*)(ws + WS_XR), (float*)(ws + WS_SS1)};
        pg8::gemm_phase(F.lds, g, S, E);
        if (BOTH(6)) GRID_BAR();
    }

    if (IN(7)) {
        { pg8::Gemm g{(const f16*)(ws + WS_XR), (const f16*)(ws + WS_WQ), M, D, D, D, D, 0, 1 << 30, 0};
          pg8::StaticOrder S; S.init(M, D, F.G, (int)blockIdx.x);
          pg8::EpiF16Row E{(f16*)(ws + WS_QP), D, (const float*)(ws + WS_SS1)};
          pg8::gemm_phase(F.lds, g, S, E); }
        { pg8::Gemm g{(const f16*)(ws + WS_P16), (const f16*)(ws + WS_WPJ), M, D, 256, 256, 256, 0, 1 << 30, 0};
          pg8::StaticOrder S; S.init(M, D, F.G, (int)blockIdx.x);
          pg8::EpiF16<0> E{(f16*)(ws + WS_PJ), D, nullptr, 1 << 30, 0};
          pg8::gemm_phase(F.lds, g, S, E); }
        PHASE_LANES();
        for (int rp = 0; rp < args.rep[7]; ++rp) p7_tables(F);
        if (BOTH(7)) GRID_BAR();
    }

    if (IN(8)) { PHASE_LANES(); p9a_topk(F); if (BOTH(8)) GRID_BAR(); }
    if (IN(9)) { PHASE_LANES(); if (PROBE_DUPU) p9b_upass(F, false); p9b_upass(F, false); if (BOTH(9)) GRID_BAR(); }
    if (IN(10)) { PHASE_LANES(); p9h_weights(F); if (BOTH(10)) GRID_BAR(); }
    if (IN(11)) { PHASE_LANES(); p9c_vpass(F); if (BOTH(11)) GRID_BAR(); }

    if (IN(12)) {
        pg8::Gemm g{(const f16*)(ws + WS_XR), (const f16*)(ws + WS_WG), M, D, D, D, D, 0, 1 << 30, 0};
        pg8::StaticOrder S; S.init(M, D, F.G, (int)blockIdx.x);
        pg8::EpiFinal E{(const f16*)(ws + WS_XR), (const f16*)(ws + WS_PJ), F.out, (const float*)(ws + WS_SS2)};
        pg8::gemm_phase(F.lds, g, S, E);
    }
#undef IN
#undef BOTH
}

extern "C" void kernel_launch(void* const* d_in, const int* in_sizes, int n_in, void* d_out, int out_size, void* d_ws, size_t ws_size, hipStream_t stream) {
    static int grid = 0;
    if (grid == 0) {
        if (n_in != 26 || out_size != M * D || ws_size < WS_END) { fprintf(stderr, "kernel_launch: unexpected sizes n_in %d out %d ws %zu\n", n_in, out_size, ws_size); grid = -1; return; }
        int dev = 0, cus = 0, per_cu = 0;
        if (hipGetDevice(&dev) != hipSuccess || hipDeviceGetAttribute(&cus, hipDeviceAttributeMultiprocessorCount, dev) != hipSuccess) { grid = -1; return; }
        if (hipFuncSetAttribute((const void*)fwd_kernel, hipFuncAttributeMaxDynamicSharedMemorySize, LDS_BYTES) != hipSuccess) { fprintf(stderr, "kernel_launch: hipFuncSetAttribute failed\n"); grid = -1; return; }
        if (hipOccupancyMaxActiveBlocksPerMultiprocessor(&per_cu, (const void*)fwd_kernel, NWAVES * 64, LDS_BYTES) != hipSuccess || per_cu < 1)
            fprintf(stderr, "kernel_launch: occupancy query reports %d\n", per_cu);
        (void)hipGetLastError();
        grid = cus;
    }
    if (grid < 0) return;
    (void)hipMemsetAsync((char*)d_ws + WS_CTL, 0, CTL_ZERO_BYTES, stream);
    Args a{};
    for (int i = 0; i < 16; ++i) a.rep[i] = 1;
    a.rep[5] = PROBE_REP5; a.rep[0] = PROBE_REP0; a.rep[7] = PROBE_REP7;
    for (int i = 0; i < 26; ++i) a.in[i] = (const float*)d_in[i];
    a.out = (float*)d_out; a.ws = (unsigned char*)d_ws;
    if (MK_ONE_LAUNCH) { a.ph_lo = 0; a.ph_hi = NPH; hipLaunchKernelGGL(fwd_kernel, dim3(grid), dim3(NWAVES * 64), LDS_BYTES, stream, a); }
    else for (int p = 0; p < NPH; ++p) { a.ph_lo = p; a.ph_hi = p + 1; hipLaunchKernelGGL(fwd_kernel, dim3(grid), dim3(NWAVES * 64), LDS_BYTES, stream, a); }
}
```

```cpp
#include <hip/hip_runtime.h>
#include <cstdio>
#include <cstdint>

#define PROBE_REP0 1
#define PROBE_REP2 1
#define PROBE_DUPU 0
#define PROBE_REP5 1
#define PROBE_REP7 1
#define PROBE_REP9 1
#ifndef MK_ONE_LAUNCH
#define MK_ONE_LAUNCH 1
#endif

#define GAS __attribute__((address_space(1)))
#define LAS __attribute__((address_space(3)))
typedef _Float16 f16;
typedef _Float16 f16x8 __attribute__((ext_vector_type(8)));
typedef _Float16 f16x4 __attribute__((ext_vector_type(4)));
typedef _Float16 f16x2 __attribute__((ext_vector_type(2)));
typedef float f32x2 __attribute__((ext_vector_type(2)));
typedef float f32x4 __attribute__((ext_vector_type(4)));
typedef float f32x16 __attribute__((ext_vector_type(16)));
typedef unsigned u32x2 __attribute__((ext_vector_type(2)));
typedef unsigned u32x4 __attribute__((ext_vector_type(4)));
typedef GAS unsigned gu32;
typedef _Float16 f16x32 __attribute__((ext_vector_type(32)));
typedef unsigned u32x6 __attribute__((ext_vector_type(6)));
#define RLX_AGENT __ATOMIC_RELAXED, __HIP_MEMORY_SCOPE_AGENT
#define LDS_WAIT() asm volatile("s_waitcnt lgkmcnt(0)" ::: "memory")
__device__ __forceinline__ float mul_np(float a, float b) { float o; asm("v_mul_f32 %0, %1, %2" : "=v"(o) : "v"(a), "v"(b)); return o; }
__device__ __forceinline__ float add_np(float a, float b) { float o; asm("v_add_f32 %0, %1, %2" : "=v"(o) : "v"(a), "v"(b)); return o; }
#define VM_WAIT() asm volatile("s_waitcnt vmcnt(0)" ::: "memory")

constexpr int BATCH = 8, SEQ = 2048, D = 2048, M = BATCH * SEQ;
constexpr int NIN = 3632, NINP = 3840;
constexpr int OFF_U = 0, OFF_Q = 1024, OFF_KC = 2048, OFF_VC = 2304, OFF_KS = 2560, OFF_VS = 2816, OFF_KW = 3072, OFF_VW = 3328, OFF_G = 3584;
constexpr int NCMP = 127, NCROWS = BATCH * NCMP * 4;
constexpr float RMS_EPS = 1e-6f;
constexpr float LOG2E = 1.4426950408889634f;

constexpr size_t MiB = 1u << 20;
constexpr size_t WS_CTL = 0, CTL_ZERO_BYTES = 1 * MiB;
constexpr size_t WS_WIN = 2 * MiB, WS_WOUT = 17 * MiB, WS_WQ = 25 * MiB, WS_WG = 33 * MiB, WS_WPJ = 41 * MiB, WS_W1C = 42 * MiB, WS_POOLT = 44 * MiB, WS_KEYS = 45 * MiB;
constexpr size_t WS_CBIAS = 46 * MiB, WS_GATES = 47 * MiB, WS_HC = 50 * MiB, WS_KCMP = 54 * MiB, WS_VCMPT = 54 * MiB + 512 * 1024, WS_P16 = 56 * MiB;
constexpr size_t WS_XN = 64 * MiB;
constexpr size_t WS_Y = 128 * MiB, WS_QP = 128 * MiB, WS_PJ = 192 * MiB;
constexpr size_t WS_MIXED = 256 * MiB, WS_CAT = 288 * MiB, WS_KN = 352 * MiB, WS_VT = 368 * MiB, WS_FLATA = 384 * MiB;
constexpr size_t WS_U6 = 256 * MiB, WS_V6 = 288 * MiB, WS_SU = 320 * MiB, WS_SV = 321 * MiB;
constexpr size_t WS_LIDX = 322 * MiB, WS_LG = 330 * MiB, WS_SSP = 338 * MiB, WS_PD = 340 * MiB, WS_HW = 404 * MiB;
constexpr size_t SLICE6 = (size_t)16384 * 192;
constexpr size_t WS_XR = 416 * MiB;
constexpr size_t WS_SS0 = 768 * 1024, WS_SS1 = 256 * 1024, WS_SS2 = 512 * 1024;
constexpr size_t WS_QN = 480 * MiB;
constexpr size_t WS_END = 512 * MiB;
constexpr int CW_TMO = 0, CW_CODE = 1, CW_BAR = 4096;

constexpr int RING_BYTES = 131072;
constexpr int LDSCTL_OFF = RING_BYTES, MISC_OFF = LDSCTL_OFF + 320;
constexpr int LDS_BYTES = 147456;
constexpr int NWAVES = 8;

__device__ __forceinline__ unsigned pk_f16(float lo, float hi) { f16x2 v; v.x = (f16)lo; v.y = (f16)hi; return __builtin_bit_cast(unsigned, v); }
__device__ __forceinline__ unsigned pk_fp8(float a, float b, float c, float d) { int r = __builtin_amdgcn_cvt_pk_fp8_f32(a, b, 0, false); r = __builtin_amdgcn_cvt_pk_fp8_f32(c, d, r, true); return (unsigned)r; }
__device__ __forceinline__ long as_i64(unsigned lo, unsigned hi) { return (long)(((unsigned long long)hi << 32) | lo); }
__device__ __forceinline__ f16x2 ash2(unsigned u) { return __builtin_bit_cast(f16x2, u); }
template <int CTRL> __device__ __forceinline__ float dpp_f(float v) { return __int_as_float(__builtin_amdgcn_update_dpp(0, __float_as_int(v), CTRL, 0xF, 0xF, true)); }
__device__ __forceinline__ float rl_f(float v, int l) { return __int_as_float(__builtin_amdgcn_readlane(__float_as_int(v), l)); }
__device__ __forceinline__ float sum8(float v) { v += dpp_f<0x141>(v); v += dpp_f<0xB1>(v); v += dpp_f<0x4E>(v); return v; }
__device__ __forceinline__ float wave_sum(float v) { v = sum8(v); v += dpp_f<0x140>(v); return (rl_f(v, 0) + rl_f(v, 16)) + (rl_f(v, 32) + rl_f(v, 48)); }
__device__ __forceinline__ float wave_max(float v) { v = fmaxf(v, dpp_f<0x141>(v)); v = fmaxf(v, dpp_f<0xB1>(v)); v = fmaxf(v, dpp_f<0x4E>(v)); v = fmaxf(v, dpp_f<0x140>(v));
    return fmaxf(fmaxf(rl_f(v, 0), rl_f(v, 16)), fmaxf(rl_f(v, 32), rl_f(v, 48))); }

__device__ __forceinline__ unsigned other8u(unsigned x) { return (unsigned)__builtin_amdgcn_update_dpp(0, (int)x, 0x128, 0xF, 0xF, true); }
__device__ __forceinline__ unsigned other16u(unsigned x, bool b4) { const auto r = __builtin_amdgcn_permlane16_swap(x, x, false, false); return b4 ? r[0] : r[1]; }
__device__ __forceinline__ unsigned other32u(unsigned x, bool b5) { const auto r = __builtin_amdgcn_permlane32_swap(x, x, false, false); return b5 ? r[0] : r[1]; }
namespace pg8 {
constexpr int BM = 256, BK = 64, HALF = 128, HTB = HALF * BK * 2, STAGE_BYTES = 8 * HTB, NXCD = 8, WGM = 8;
__host__ __device__ __forceinline__ int lds_byte(int r, int c) { const int st = (r >> 4) * 2 + (c >> 5), rr = r & 15, cc = c & 31, ob = rr * 64 + cc * 2; return st * 1024 + (ob ^ (((ob >> 9) & 1) << 5)); }
__host__ __device__ __forceinline__ void stage_rc(int b, int& R, int& C) { const int st = b / 1024, sb = b % 1024, swz = sb ^ (((sb >> 9) & 1) << 5); R = (st >> 1) * 16 + swz / 64; C = (st & 1) * 32 + (swz % 64) / 2; }
__host__ __device__ __forceinline__ int perm32(int rho) { const int n = rho >> 4, i = rho & 15; return 8 * (i >> 2) + 4 * n + (i & 3); }

struct Unit { int pm, pn; };
struct Gemm { const f16* A; const f16* Bt; int M, N, K, lda, ldb; int a_pn_off; int b_pm_split; size_t b_split_off; int b_pn_k = 0;
    __device__ __forceinline__ const char* aptr(const Unit& u) const { return (const char*)A + ((size_t)u.pm * BM * lda + (size_t)u.pn * a_pn_off) * 2; }
    __device__ __forceinline__ const char* bptr(const Unit& u) const { return (const char*)Bt + (b_pn_k ? (size_t)u.pn * b_pn_k * 2 : (size_t)u.pn * BM * ldb * 2) + (u.pm >= b_pm_split ? b_split_off : (size_t)0); }
};
struct StaticOrder {
    int nM, nN, nwg, G, c;
    __host__ __device__ void init(int M_, int N_, int G_, int c_) { nM = M_ / BM; nN = N_ / BM; nwg = nM * nN; G = G_; c = c_; }
    __host__ __device__ bool next(int i, Unit& u) const {
        const long L = (long)i * G + c; if (L >= nwg) return false;
        int wgid = (int)L; { const int q = nwg / NXCD, r = nwg % NXCD, xcd = wgid % NXCD, off = wgid / NXCD; wgid = (xcd < r ? xcd * (q + 1) : r * (q + 1) + (xcd - r) * q) + off; }
        const int nig = WGM * nN, gid = wgid / nig, fm = gid * WGM, gsz = (nM - fm) < WGM ? (nM - fm) : WGM;
        u.pm = fm + ((wgid % nig) % gsz); u.pn = (wgid % nig) / gsz; return true;
    }
};

__device__ __forceinline__ f32x2 gelu_pk(f32x2 v) {
    const f32x2 av = __builtin_elementwise_abs(v), d = av * 0.2316418882f + 1.0f;
    f32x2 t; t.x = __builtin_amdgcn_rcpf(d.x); t.y = __builtin_amdgcn_rcpf(d.y);
    f32x2 q = t * 0.5307027145f + (-0.7265760135f); q = q * t + 0.7107068705f; q = q * t + (-0.142248368f); q = q * t + 0.127414796f; q = q * t;
    const f32x2 s = (v * v) * (-0.72134752044f);
    f32x2 e; e.x = __builtin_amdgcn_exp2f(s.x); e.y = __builtin_amdgcn_exp2f(s.y);
    const f32x2 m = v * (q * e), r = v - m;
    f32x2 o; o.x = v.x < 0.f ? m.x : r.x; o.y = v.y < 0.f ? m.y : r.y; return o;
}
__device__ __forceinline__ float gelu1(float v) { f32x2 r = gelu_pk((f32x2){v, v}); return r.x; }

template <int ACT> struct EpiF16 {
    static constexpr bool PERM = true;
    f16* O; int ldc; const float* bias; int bias_pm_split; int bias_split_off;
    __device__ __forceinline__ void operator()(const f32x4 (&acc)[2][2][4][2], const Unit& u, int wr, int wc, int fr, int fq) const {
        const int row0 = u.pm * BM + wr * 64 + fr; const int col0 = u.pn * BM + wc * 32 + 8 * fq;
        const float* bp = bias ? bias + (u.pm >= bias_pm_split ? bias_split_off : 0) : nullptr;
        f32x4 bv[2][2];
#pragma unroll
        for (int bj = 0; bj < 2; ++bj)
#pragma unroll
            for (int n = 0; n < 2; ++n) bv[bj][n] = bp ? *(const f32x4*)(bp + col0 + bj * HALF + 4 * n) : (f32x4){0.f, 0.f, 0.f, 0.f};
#pragma unroll
        for (int ai = 0; ai < 2; ++ai)
#pragma unroll
            for (int m = 0; m < 4; ++m) { f16* rowp = O + (size_t)(row0 + ai * HALF + m * 16) * ldc + col0;
#pragma unroll
                for (int bj = 0; bj < 2; ++bj) { f32x4 v0 = acc[ai][bj][m][0] + bv[bj][0], v1 = acc[ai][bj][m][1] + bv[bj][1];
                    if (ACT == 1) { f32x2 a = gelu_pk((f32x2){v0[0], v0[1]}), b = gelu_pk((f32x2){v0[2], v0[3]}), c = gelu_pk((f32x2){v1[0], v1[1]}), d = gelu_pk((f32x2){v1[2], v1[3]});
                        v0 = (f32x4){a.x, a.y, b.x, b.y}; v1 = (f32x4){c.x, c.y, d.x, d.y}; }
                    u32x4 w; w.x = pk_f16(v0[0], v0[1]); w.y = pk_f16(v0[2], v0[3]); w.z = pk_f16(v1[0], v1[1]); w.w = pk_f16(v1[2], v1[3]);
                    *(u32x4*)(rowp + bj * HALF) = w; } }
    }
};
struct EpiRawF32 {
    static constexpr bool PERM = false;
    float* C; int ldc;
    __device__ __forceinline__ void operator()(const f32x4 (&acc)[2][2][4][2], const Unit& u, int wr, int wc, int fr, int fq) const {
        const int row0 = u.pm * BM + wr * 64 + fr, col0 = u.pn * BM + wc * 32 + 4 * fq;
#pragma unroll
        for (int ai = 0; ai < 2; ++ai)
#pragma unroll
            for (int m = 0; m < 4; ++m) { float* rowp = C + (size_t)(row0 + ai * HALF + m * 16) * ldc + col0;
#pragma unroll
                for (int bj = 0; bj < 2; ++bj)
#pragma unroll
                    for (int n = 0; n < 2; ++n) *(f32x4*)(rowp + bj * HALF + n * 16) = acc[ai][bj][m][n]; }
    }
};
struct EpiRes16 {
    static constexpr bool PERM = true;
    f16* XR; float* SS;
    __device__ __forceinline__ void operator()(const f32x4 (&acc)[2][2][4][2], const Unit& u, int wr, int wc, int fr, int fq) const {
        const int row0 = u.pm * BM + wr * 64 + fr; const int col0 = u.pn * BM + wc * 32 + 8 * fq;
#pragma unroll
        for (int ai = 0; ai < 2; ++ai) {
            f16x8 xb[4][2];
#pragma unroll
            for (int m = 0; m < 4; ++m)
#pragma unroll
                for (int bj = 0; bj < 2; ++bj) xb[m][bj] = *(const f16x8*)(XR + (size_t)(row0 + ai * HALF + m * 16) * D + col0 + bj * HALF);
            asm volatile("" ::: "memory");
#pragma unroll
            for (int m = 0; m < 4; ++m) { const int row = row0 + ai * HALF + m * 16; const size_t off = (size_t)row * D + col0; float ss = 0.f;
#pragma unroll
                for (int bj = 0; bj < 2; ++bj) { const f16x8 xv = xb[m][bj];
                    f32x4 v0 = acc[ai][bj][m][0], v1 = acc[ai][bj][m][1];
                    v0[0] += (float)xv[0]; v0[1] += (float)xv[1]; v0[2] += (float)xv[2]; v0[3] += (float)xv[3]; v1[0] += (float)xv[4]; v1[1] += (float)xv[5]; v1[2] += (float)xv[6]; v1[3] += (float)xv[7];
                    ss += ((v0[0] * v0[0] + v0[1] * v0[1]) + (v0[2] * v0[2] + v0[3] * v0[3])) + ((v1[0] * v1[0] + v1[1] * v1[1]) + (v1[2] * v1[2] + v1[3] * v1[3]));
                    u32x4 o; o.x = pk_f16(v0[0], v0[1]); o.y = pk_f16(v0[2], v0[3]); o.z = pk_f16(v1[0], v1[1]); o.w = pk_f16(v1[2], v1[3]);
                    *(u32x4*)(XR + off + bj * HALF) = o; }
                ss += __shfl_xor(ss, 16); ss += __shfl_xor(ss, 32);
                if (fq == 0) atomicAdd(SS + row, ss); }
            asm volatile("" ::: "memory"); }
    }
};
struct EpiF16Row {
    static constexpr bool PERM = true;
    f16* O; int ldc; const float* SS;
    __device__ __forceinline__ void operator()(const f32x4 (&acc)[2][2][4][2], const Unit& u, int wr, int wc, int fr, int fq) const {
        const int row0 = u.pm * BM + wr * 64 + fr; const int col0 = u.pn * BM + wc * 32 + 8 * fq;
#pragma unroll
        for (int ai = 0; ai < 2; ++ai)
#pragma unroll
            for (int m = 0; m < 4; ++m) { const int row = row0 + ai * HALF + m * 16; f16* rowp = O + (size_t)row * ldc + col0;
                const float rs = 1.f / sqrtf(SS[row] * (1.f / D) + RMS_EPS);
#pragma unroll
                for (int bj = 0; bj < 2; ++bj) { const f32x4 v0 = acc[ai][bj][m][0] * rs, v1 = acc[ai][bj][m][1] * rs;
                    u32x4 o; o.x = pk_f16(v0[0], v0[1]); o.y = pk_f16(v0[2], v0[3]); o.z = pk_f16(v1[0], v1[1]); o.w = pk_f16(v1[2], v1[3]);
                    *(u32x4*)(rowp + bj * HALF) = o; } }
    }
};
struct EpiFinal {
    static constexpr bool PERM = true;
    const f16* XR; const f16* PJ; float* C; const float* SS;
    __device__ __forceinline__ void operator()(const f32x4 (&acc)[2][2][4][2], const Unit& u, int wr, int wc, int fr, int fq) const {
        const int row0 = u.pm * BM + wr * 64 + fr; const int col0 = u.pn * BM + wc * 32 + 8 * fq;
#pragma unroll
        for (int ai = 0; ai < 2; ++ai)
#pragma unroll
            for (int mh = 0; mh < 2; ++mh) {
                f16x8 xb[2][2], pb[2][2]; float ssv[2];
#pragma unroll
                for (int mm = 0; mm < 2; ++mm) { const int row = row0 + ai * HALF + (2 * mh + mm) * 16; ssv[mm] = SS[row];
#pragma unroll
                    for (int bj = 0; bj < 2; ++bj) { xb[mm][bj] = *(const f16x8*)(XR + (size_t)row * D + col0 + bj * HALF); pb[mm][bj] = *(const f16x8*)(PJ + (size_t)row * D + col0 + bj * HALF); } }
                asm volatile("" ::: "memory");
#pragma unroll
                for (int mm = 0; mm < 2; ++mm) { const int m = 2 * mh + mm; const int row = row0 + ai * HALF + m * 16; const size_t off = (size_t)row * D + col0;
                    const float nrs = -LOG2E / sqrtf(ssv[mm] * (1.f / D) + RMS_EPS);
#pragma unroll
                    for (int bj = 0; bj < 2; ++bj) { const f16x8 xv = xb[mm][bj], pv = pb[mm][bj];
                        const f32x4 a0 = acc[ai][bj][m][0], a1 = acc[ai][bj][m][1]; f32x4 o0, o1;
#pragma unroll
                        for (int j = 0; j < 4; ++j) { o0[j] = (float)xv[j] + (float)pv[j] * __builtin_amdgcn_rcpf(1.0f + __builtin_amdgcn_exp2f(nrs * a0[j]));
                            o1[j] = (float)xv[4 + j] + (float)pv[4 + j] * __builtin_amdgcn_rcpf(1.0f + __builtin_amdgcn_exp2f(nrs * a1[j])); }
                        *(f32x4*)(C + off + bj * HALF) = o0; *(f32x4*)(C + off + bj * HALF + 4) = o1; } }
                asm volatile("" ::: "memory"); }
    }
};
template <int MODE> struct EpiF32 {
    static constexpr bool PERM = false;
    const float* base; float* C; int ldc; const f16* pj; const float* ssp;
    __device__ __forceinline__ void operator()(const f32x4 (&acc)[2][2][4][2], const Unit& u, int wr, int wc, int fr, int fq) const {
        const int row0 = u.pm * BM + wr * 64 + fr, col0 = u.pn * BM + wc * 32 + 4 * fq;
#pragma unroll
        for (int ai = 0; ai < 2; ++ai)
#pragma unroll
            for (int m = 0; m < 4; ++m) { const size_t off = (size_t)(row0 + ai * HALF + m * 16) * ldc + col0;
                float nrs = -LOG2E;
                if (MODE == 1) { const f32x4 s0 = *(const f32x4*)(ssp + (size_t)(row0 + ai * HALF + m * 16) * 8), s1 = *(const f32x4*)(ssp + (size_t)(row0 + ai * HALF + m * 16) * 8 + 4);
                    nrs = -LOG2E / sqrtf((((s0.x + s0.y) + (s0.z + s0.w)) + ((s1.x + s1.y) + (s1.z + s1.w))) * (1.f / D) + RMS_EPS); }
#pragma unroll
                for (int bj = 0; bj < 2; ++bj)
#pragma unroll
                    for (int n = 0; n < 2; ++n) { const size_t o2 = off + bj * HALF + n * 16; const f32x4 bs = *(const f32x4*)(base + o2); f32x4 a = acc[ai][bj][m][n];
                        if (MODE == 1) { const f16x4 pv = *(const f16x4*)(pj + o2);
#pragma unroll
                            for (int j = 0; j < 4; ++j) a[j] = (float)pv[j] * __builtin_amdgcn_rcpf(1.0f + __builtin_amdgcn_exp2f(nrs * a[j])); }
                        *(f32x4*)(C + o2) = bs + a; }
                asm volatile("" ::: "memory"); }
    }
};

template <class Epi, class Sched>
__device__ __forceinline__ void gemm_phase(LAS unsigned char* lds, const Gemm g, const Sched& S, const Epi& E) {
    int tid = threadIdx.x; asm volatile("" : "+v"(tid));
    const int wid = __builtin_amdgcn_readfirstlane(tid >> 6), lane = tid & 63, wr = wid >> 2, wc = wid & 3, fr = lane & 15, fq = lane >> 4;
    const int K = g.K, nt = K / BK;
    unsigned voffA[2], voffB[2];
#pragma unroll
    for (int i = 0; i < 2; ++i) { int R, C; stage_rc(tid * 16 + i * 8192, R, C); const int Rb = Epi::PERM ? ((R & ~31) + perm32(R & 31)) : R;
        voffA[i] = (unsigned)(R * g.lda + C) * 2u; voffB[i] = (unsigned)(Rb * g.ldb + C) * 2u; }
    const size_t kstep = (size_t)(BK * 2);
    const size_t hstepA = (size_t)HALF * g.lda * 2, hstepB = (size_t)HALF * g.ldb * 2;
    const unsigned ldsw = (unsigned)wid * 1024u;
    const int aoff = lds_byte(wr * 64 + fr, fq * 8), boff = lds_byte(wc * 32 + fr, fq * 8);
#define PG8_SA(b, h) (((b) * 2 + (h)) * HTB)
#define PG8_SB(b, h) ((4 + (b) * 2 + (h)) * HTB)
#define PG8_STAGE(bufoff, gbase, voff) do { _Pragma("unroll") for (int _i = 0; _i < 2; ++_i) \
        __builtin_amdgcn_global_load_lds((const unsigned*)((const char*)(gbase) + (voff)[_i]), (LAS unsigned*)(lds + (bufoff) + ldsw + _i * 8192), 16, 0, 0); } while (0)
#define PG8_LDA(dst, b, h) do { _Pragma("unroll") for (int m = 0; m < 4; ++m) _Pragma("unroll") for (int k = 0; k < 2; ++k) dst[m][k] = *(const LAS f16x8*)(lds + PG8_SA(b, h) + aoff + m * 2048 + k * 1024); } while (0)
#define PG8_LDB(dst, b, h) do { _Pragma("unroll") for (int n = 0; n < 2; ++n) _Pragma("unroll") for (int k = 0; k < 2; ++k) dst[n][k] = *(const LAS f16x8*)(lds + PG8_SB(b, h) + boff + n * 2048 + k * 1024); } while (0)
#define PG8_MMA(ai, bj, At, Bt) do { __builtin_amdgcn_s_setprio(1); _Pragma("unroll") for (int m = 0; m < 4; ++m) _Pragma("unroll") for (int n = 0; n < 2; ++n) _Pragma("unroll") for (int k = 0; k < 2; ++k) \
        acc[ai][bj][m][n] = __builtin_amdgcn_mfma_f32_16x16x32_f16(Bt[n][k], At[m][k], acc[ai][bj][m][n], 0, 0, 0); __builtin_amdgcn_s_setprio(0); } while (0)
#define PG8_WAIT_V(n) asm volatile("s_waitcnt vmcnt(" #n ")" ::: "memory")
#define PG8_WAIT_L(n) asm volatile("s_waitcnt lgkmcnt(" #n ")" ::: "memory")
#define PG8_BAR __builtin_amdgcn_s_barrier()
#define PG8_SCHED __builtin_amdgcn_sched_barrier(0)
    Unit cur, nxt; int ui = 0;
    if (!S.next(0, cur)) return;
    f32x4 acc[2][2][4][2];
#pragma unroll
    for (int a = 0; a < 2; ++a)
#pragma unroll
        for (int b = 0; b < 2; ++b)
#pragma unroll
            for (int m = 0; m < 4; ++m)
#pragma unroll
                for (int n = 0; n < 2; ++n) acc[a][b][m][n] = (f32x4){0.f, 0.f, 0.f, 0.f};
    f16x8 At[4][2], B0[2][2], B1[2][2];
    const char* cA = g.aptr(cur); const char* cB = g.bptr(cur);
    PG8_STAGE(PG8_SB(0, 0), cB, voffB); PG8_STAGE(PG8_SB(0, 1), cB + hstepB, voffB); PG8_STAGE(PG8_SA(0, 0), cA, voffA); PG8_STAGE(PG8_SA(0, 1), cA + hstepA, voffA);
    if (wr == 1) PG8_BAR;
    PG8_WAIT_V(2); PG8_BAR;
    PG8_STAGE(PG8_SB(1, 0), cB + kstep, voffB); PG8_STAGE(PG8_SA(1, 0), cA + kstep, voffA); PG8_STAGE(PG8_SB(1, 1), cB + hstepB + kstep, voffB);
    PG8_WAIT_V(6); PG8_BAR;
    for (;;) {
        const bool has_next = S.next(ui + 1, nxt);
        const char* nA = has_next ? g.aptr(nxt) : cA; const char* nB = has_next ? g.bptr(nxt) : cB;
#pragma clang loop unroll(disable)
        for (int t = 0; t < nt; t += 2) {
            const bool last = (t == nt - 2);
            const char* a1 = cA + (size_t)(t + 1) * kstep;
            const char* a2 = last ? nA : cA + (size_t)(t + 2) * kstep; const char* b2 = last ? nB : cB + (size_t)(t + 2) * kstep;
            const char* a3 = a2 + kstep; const char* b3 = b2 + kstep;
            PG8_LDB(B0, 0, 0); PG8_LDB(B1, 0, 1); PG8_SCHED; PG8_LDA(At, 0, 0); PG8_STAGE(PG8_SA(1, 1), a1 + hstepA, voffA);
            PG8_WAIT_V(8); PG8_WAIT_L(0); PG8_BAR; PG8_MMA(0, 0, At, B0); PG8_MMA(0, 1, At, B1); PG8_BAR; PG8_SCHED;
            PG8_LDA(At, 0, 1); PG8_STAGE(PG8_SB(0, 0), b2, voffB); PG8_STAGE(PG8_SB(0, 1), b2 + hstepB, voffB); PG8_STAGE(PG8_SA(0, 0), a2, voffA);
            PG8_WAIT_V(8); PG8_WAIT_L(0); PG8_BAR; PG8_MMA(1, 0, At, B0); PG8_MMA(1, 1, At, B1); PG8_BAR; PG8_SCHED;
            PG8_LDB(B0, 1, 0); PG8_LDB(B1, 1, 1); PG8_SCHED; PG8_LDA(At, 1, 0); PG8_STAGE(PG8_SA(0, 1), a2 + hstepA, voffA);
            PG8_WAIT_V(8); PG8_WAIT_L(0); PG8_BAR; PG8_MMA(0, 0, At, B0); PG8_MMA(0, 1, At, B1); PG8_BAR; PG8_SCHED;
            PG8_LDA(At, 1, 1); PG8_STAGE(PG8_SB(1, 0), b3, voffB); PG8_STAGE(PG8_SB(1, 1), b3 + hstepB, voffB); PG8_STAGE(PG8_SA(1, 0), a3, voffA);
            PG8_WAIT_V(8); PG8_WAIT_L(0); PG8_BAR; PG8_MMA(1, 0, At, B0); PG8_MMA(1, 1, At, B1); PG8_BAR; PG8_SCHED;
        }
        if (wr == 0) PG8_BAR;
        E(acc, cur, wr, wc, fr, fq);
        if (!has_next) break;
#pragma unroll
        for (int a = 0; a < 2; ++a)
#pragma unroll
            for (int b = 0; b < 2; ++b)
#pragma unroll
                for (int m = 0; m < 4; ++m)
#pragma unroll
                    for (int n = 0; n < 2; ++n) acc[a][b][m][n] = (f32x4){0.f, 0.f, 0.f, 0.f};
        cur = nxt; cA = nA; cB = nB; ++ui;
        if (wr == 1) PG8_BAR;
    }
    PG8_WAIT_V(0);
    PG8_BAR;
#undef PG8_SA
#undef PG8_SB
#undef PG8_STAGE
#undef PG8_LDA
#undef PG8_LDB
#undef PG8_MMA
#undef PG8_WAIT_V
#undef PG8_WAIT_L
#undef PG8_BAR
#undef PG8_SCHED
}
}

#define XB_TMO      128
#define XB_XCNT(j)  (256  + 64 * (j))
#define XB_XSUB(j)  (1280 + 64 * (j))
#define XB_XGEN(j)  (2304 + 64 * (j))
#define XB_TOP      3328
#define XB_TOPGEN   3392
#define XCD_BAR_WORDS 3456
#define XB_SPIN_CAP (1u << 18)
__device__ __forceinline__ unsigned xb_ld(unsigned* p)              { return __hip_atomic_load(p, __ATOMIC_RELAXED, __HIP_MEMORY_SCOPE_AGENT); }
__device__ __forceinline__ unsigned xb_add(unsigned* p, unsigned v) { return __hip_atomic_fetch_add(p, v, __ATOMIC_RELAXED, __HIP_MEMORY_SCOPE_AGENT); }
__device__ __forceinline__ unsigned xb_xcc_id() { return (unsigned)__builtin_amdgcn_s_getreg((3 << 11) | 20) & 0xFu; }
#define XB_SPIN(cond, bar) do { unsigned _sp = 0; while (cond) { __builtin_amdgcn_s_sleep(1); \
    if ((++_sp & 255u) == 0u) { if (xb_ld(&(bar)[XB_TMO])) break; if (_sp > XB_SPIN_CAP) { atomicAdd(&(bar)[XB_TMO], 1u); break; } } } } while (0)
struct XcdBarrier { unsigned* bar; unsigned x; volatile LAS unsigned* st; };
__device__ __forceinline__ XcdBarrier xcd_barrier_post(unsigned* bar, volatile LAS unsigned* st) {
    XcdBarrier b; b.bar = bar; b.x = xb_xcc_id(); b.st = st;
    if (threadIdx.x == 0) (void)xb_add(&bar[XB_XCNT(b.x)], 1u);
    return b;
}
__device__ __forceinline__ void xcd_barrier_complete(unsigned* bar, unsigned x, unsigned& nloc, unsigned& nx) {
    const unsigned G = gridDim.x * gridDim.y * gridDim.z;
    unsigned sum, cnt, mine, sp = 0u;
    for (;;) {
        sum = 0u; cnt = 0u; mine = 0u;
#pragma unroll
        for (unsigned j = 0; j < 16; ++j) { const unsigned c = xb_ld(&bar[XB_XCNT(j)]); sum += c; cnt += (c > 0u) ? 1u : 0u; mine = (j == x) ? c : mine; }
        if (sum == G) break;
        __builtin_amdgcn_s_sleep(1);
        if ((++sp & 255u) == 0u) { if (xb_ld(&bar[XB_TMO])) break; if (sp > XB_SPIN_CAP) { atomicAdd(&bar[XB_TMO], 1u); break; } }
    }
    nloc = mine > 0u ? mine : 1u; nx = cnt > 0u ? cnt : 1u;
}
__device__ __forceinline__ void xcd_barrier(const XcdBarrier& b) {
    asm volatile("s_waitcnt vmcnt(0)" ::: "memory");
    __syncthreads();
    if (threadIdx.x == 0) {
        unsigned* bar = b.bar;
        __builtin_amdgcn_s_waitcnt(0);
        unsigned nloc = b.st[0], nx = b.st[1];
        if (nloc == 0u) { xcd_barrier_complete(bar, b.x, nloc, nx); b.st[0] = nloc; b.st[1] = nx; }
        const unsigned old = xb_add(&bar[XB_XSUB(b.x)], 1u);
        const unsigned gen = old / nloc;
        if (old + 1u == (gen + 1u) * nloc) {
            __builtin_amdgcn_fence(__ATOMIC_RELEASE, "agent");
            asm volatile("s_waitcnt vmcnt(0)" ::: "memory");
            const unsigned og = xb_add(&bar[XB_TOP], 1u);
            const unsigned tg = og / nx;
            if (og + 1u == (tg + 1u) * nx) xb_add(&bar[XB_TOPGEN], 1u);
            else XB_SPIN(xb_ld(&bar[XB_TOPGEN]) == tg, bar);
            __builtin_amdgcn_fence(__ATOMIC_ACQUIRE, "agent");
            xb_add(&bar[XB_XGEN(b.x)], 1u);
            asm volatile("s_waitcnt vmcnt(0)" ::: "memory");
        } else {
            XB_SPIN(xb_ld(&bar[XB_XGEN(b.x)]) == gen, bar);
            __builtin_amdgcn_fence(__ATOMIC_ACQUIRE, "agent");
            asm volatile("s_waitcnt vmcnt(0)" ::: "memory");
        }
    }
    __syncthreads();
}

struct Frame {
    LAS unsigned char* lds;
    volatile LAS unsigned* MISC;
    int tid, lane, wave;
    int vcu, G;
    const float* in[26];
    float* out;
    unsigned char* ws;
};
enum { I_X = 0, I_P, I_RELB, I_MIXNW, I_WIN, I_QNW, I_KNW, I_CKPOS, I_CKW1, I_CKB1, I_CKW2, I_CVPOS, I_CVW1, I_CVB1, I_CVW2, I_POOLW, I_POOLS, I_WOUT, I_FFNNW, I_PWQ, I_PKEYS, I_PU, I_PV, I_PLENW, I_PLEWG, I_PLEWP };

__device__ __forceinline__ void p0_transpose_item(const float* W, int K, int N, int Npad, const float* colscale, f16* WT, LAS float* scr, int item, int lane, const float* kscale = nullptr) {
    const int nblk = Npad / 32, kb = item / nblk, nb = item % nblk, k0 = 64 * kb, n0 = 32 * nb;
    const int nn = n0 + (lane & 31); const bool ok = nn < N;
#pragma unroll
    for (int hgrp = 0; hgrp < 2; ++hgrp) { float wv[16];
#pragma unroll
        for (int i = 0; i < 16; ++i) { const int kk = 2 * (16 * hgrp + i) + (lane >> 5); wv[i] = ok ? W[(size_t)(k0 + kk) * N + nn] : 0.f; }
        if (kscale) {
#pragma unroll
            for (int i = 0; i < 16; ++i) wv[i] *= kscale[k0 + 2 * (16 * hgrp + i) + (lane >> 5)]; }
#pragma unroll
        for (int i = 0; i < 16; ++i) { const int kk = 2 * (16 * hgrp + i) + (lane >> 5); scr[kk * 33 + (lane & 31)] = wv[i]; }
        asm volatile("" ::: "memory"); }
    LDS_WAIT(); asm volatile("" ::: "memory");
    const int c = lane & 7;
#pragma unroll
    for (int j = 0; j < 4; ++j) { const int n = (lane >> 3) + 8 * j; const LAS float* s = scr + (8 * c) * 33 + n; const float sc = (colscale && n0 + n < N) ? colscale[n0 + n] : 1.f;
        u32x4 o; o.x = pk_f16(s[0 * 33] * sc, s[1 * 33] * sc); o.y = pk_f16(s[2 * 33] * sc, s[3 * 33] * sc); o.z = pk_f16(s[4 * 33] * sc, s[5 * 33] * sc); o.w = pk_f16(s[6 * 33] * sc, s[7 * 33] * sc);
        *(GAS u32x4*)(WT + (size_t)(n0 + n) * K + k0 + 8 * c) = o; }
    LDS_WAIT(); asm volatile("" ::: "memory");
}
__device__ __forceinline__ void rms_row_to_f16(const float* xrow, const float* w, f16* orow, int lane, f16* x16row = nullptr) {
    const GAS f32x4* xr = (const GAS f32x4*)xrow + lane; const GAS f32x4* wr = (const GAS f32x4*)w + lane;
    f32x4 v[8]; float s = 0.f;
#pragma unroll
    for (int j = 0; j < 8; ++j) { v[j] = xr[64 * j]; s += (v[j].x * v[j].x + v[j].y * v[j].y) + (v[j].z * v[j].z + v[j].w * v[j].w); }
    const float rstd = 1.f / sqrtf(wave_sum(s) * (1.f / D) + RMS_EPS);
    GAS u32x2* o8 = (GAS u32x2*)orow + lane;
#pragma unroll
    for (int j = 0; j < 8; ++j) { const f32x4 g = wr[64 * j]; u32x2 o; o.x = pk_f16(v[j].x * rstd * g.x, v[j].y * rstd * g.y); o.y = pk_f16(v[j].z * rstd * g.z, v[j].w * rstd * g.w); o8[64 * j] = o; }
    if (x16row) { GAS u32x2* x8 = (GAS u32x2*)x16row + lane;
#pragma unroll
        for (int j = 0; j < 8; ++j) { u32x2 o; o.x = pk_f16(v[j].x, v[j].y); o.y = pk_f16(v[j].z, v[j].w); x8[64 * j] = o; } }
}
__device__ __forceinline__ void rms_2rows_to_f16(const float* x0, const float* x1, const float* w, f16* o0, f16* o1, f16* h0, f16* h1, int lane) {
    const GAS f32x4* xa = (const GAS f32x4*)x0 + lane; const GAS f32x4* xb = (const GAS f32x4*)x1 + lane; const GAS f32x4* wr = (const GAS f32x4*)w + lane;
    f32x4 va[8], vb[8]; float sa = 0.f, sb = 0.f;
#pragma unroll
    for (int j = 0; j < 8; ++j) { va[j] = __builtin_nontemporal_load(xa + 64 * j); vb[j] = __builtin_nontemporal_load(xb + 64 * j); }
#pragma unroll
    for (int j = 0; j < 8; ++j) { sa += (va[j].x * va[j].x + va[j].y * va[j].y) + (va[j].z * va[j].z + va[j].w * va[j].w); sb += (vb[j].x * vb[j].x + vb[j].y * vb[j].y) + (vb[j].z * vb[j].z + vb[j].w * vb[j].w); }
    const float ra = 1.f / sqrtf(wave_sum(sa) * (1.f / D) + RMS_EPS), rb = 1.f / sqrtf(wave_sum(sb) * (1.f / D) + RMS_EPS);
    GAS u32x2* pa = (GAS u32x2*)o0 + lane; GAS u32x2* pb = (GAS u32x2*)o1 + lane; GAS u32x2* qa = (GAS u32x2*)h0 + lane; GAS u32x2* qb = (GAS u32x2*)h1 + lane;
#pragma unroll
    for (int j = 0; j < 8; ++j) { const f32x4 g = wr[64 * j]; u32x2 o;
        o.x = pk_f16(va[j].x * ra * g.x, va[j].y * ra * g.y); o.y = pk_f16(va[j].z * ra * g.z, va[j].w * ra * g.w); pa[64 * j] = o;
        o.x = pk_f16(vb[j].x * rb * g.x, vb[j].y * rb * g.y); o.y = pk_f16(vb[j].z * rb * g.z, vb[j].w * rb * g.w); pb[64 * j] = o;
        o.x = pk_f16(va[j].x, va[j].y); o.y = pk_f16(va[j].z, va[j].w); qa[64 * j] = o;
        o.x = pk_f16(vb[j].x, vb[j].y); o.y = pk_f16(vb[j].z, vb[j].w); qb[64 * j] = o; }
}
__device__ __forceinline__ void x16_2rows(const float* x0, const float* x1, f16* h0, f16* h1, float* ss0, float* ss1, int lane) {
    const GAS f32x4* xa = (const GAS f32x4*)x0 + lane; const GAS f32x4* xb = (const GAS f32x4*)x1 + lane;
    f32x4 va[8], vb[8]; float sa = 0.f, sb = 0.f;
#pragma unroll
    for (int j = 0; j < 8; ++j) { va[j] = __builtin_nontemporal_load(xa + 64 * j); vb[j] = __builtin_nontemporal_load(xb + 64 * j); }
    GAS u32x2* qa = (GAS u32x2*)h0 + lane; GAS u32x2* qb = (GAS u32x2*)h1 + lane;
#pragma unroll
    for (int j = 0; j < 8; ++j) { sa += (va[j].x * va[j].x + va[j].y * va[j].y) + (va[j].z * va[j].z + va[j].w * va[j].w); sb += (vb[j].x * vb[j].x + vb[j].y * vb[j].y) + (vb[j].z * vb[j].z + vb[j].w * vb[j].w);
        u32x2 o; o.x = pk_f16(va[j].x, va[j].y); o.y = pk_f16(va[j].z, va[j].w); qa[64 * j] = o;
        o.x = pk_f16(vb[j].x, vb[j].y); o.y = pk_f16(vb[j].z, vb[j].w); qb[64 * j] = o; }
    sa = wave_sum(sa); sb = wave_sum(sb);
    if (lane == 0) { *ss0 = sa; *ss1 = sb; }
}
__device__ __forceinline__ void cvt_f32_f16(Frame& F, const float* src, f16* dst, size_t n) {
    const size_t gt = (size_t)F.vcu * 512 + F.tid, GT = (size_t)F.G * 512;
    for (size_t i = gt; i < n / 8; i += GT) { const f32x4 a = *(const GAS f32x4*)(src + i * 8), b = *(const GAS f32x4*)(src + i * 8 + 4);
        u32x4 o; o.x = pk_f16(a.x, a.y); o.y = pk_f16(a.z, a.w); o.z = pk_f16(b.x, b.y); o.w = pk_f16(b.z, b.w); *(GAS u32x4*)(dst + i * 8) = o; }
}

__device__ __forceinline__ void p0_prologue(Frame& F) {
    LAS float* scr = (LAS float*)(F.lds + F.wave * 16384);
    const int gw = F.vcu * NWAVES + F.wave, NGW = F.G * NWAVES;
    unsigned char* ws = F.ws;
    constexpr int I_IN = (D / 64) * (NINP / 32), I_SQ = (D / 64) * (D / 32), I_PJ = (256 / 64) * (D / 32), I_C1 = (D / 64) * (256 / 32), I_PL = (256 / 64) * (256 / 32);
    constexpr int NITEMS = I_IN + 3 * I_SQ + I_PJ + 2 * I_C1 + 4 * I_PL;
    for (int it = gw; it < NITEMS; it += NGW) {
        int r = it;
        if (r < I_IN) { p0_transpose_item(F.in[I_WIN], D, NIN, NINP, nullptr, (f16*)(ws + WS_WIN), scr, r, F.lane, F.in[I_MIXNW]); continue; } r -= I_IN;
        if (r < I_SQ) { p0_transpose_item(F.in[I_WOUT], D, D, D, nullptr, (f16*)(ws + WS_WOUT), scr, r, F.lane); continue; } r -= I_SQ;
        if (r < I_SQ) { p0_transpose_item(F.in[I_PWQ], D, D, D, nullptr, (f16*)(ws + WS_WQ), scr, r, F.lane, F.in[I_FFNNW]); continue; } r -= I_SQ;
        if (r < I_SQ) { p0_transpose_item(F.in[I_PLEWG], D, D, D, nullptr, (f16*)(ws + WS_WG), scr, r, F.lane, F.in[I_PLENW]); continue; } r -= I_SQ;
        if (r < I_PJ) { p0_transpose_item(F.in[I_PLEWP], 256, D, D, nullptr, (f16*)(ws + WS_WPJ), scr, r, F.lane); continue; } r -= I_PJ;
        if (r < I_C1) { p0_transpose_item(F.in[I_CKW1], D, 256, 256, nullptr, (f16*)(ws + WS_W1C), scr, r, F.lane); continue; } r -= I_C1;
        if (r < I_C1) { p0_transpose_item(F.in[I_CVW1], D, 256, 256, nullptr, (f16*)(ws + WS_W1C) + 256 * D, scr, r, F.lane); continue; } r -= I_C1;
        { const int g = r / I_PL; r -= g * I_PL;
          p0_transpose_item(F.in[I_POOLW] + (size_t)g * 65536, 256, 256, 256, F.in[I_POOLS] + g * 256, (f16*)(ws + WS_POOLT) + (size_t)g * 65536, scr, r, F.lane); }
    }
    { float* SS0 = (float*)(ws + WS_SS0); f16* XR = (f16*)(ws + WS_XR);
      for (int m = gw; m < M; m += 2 * NGW) { const int m2 = m + NGW < M ? m + NGW : m;
          x16_2rows(F.in[I_X] + (size_t)m * D, F.in[I_X] + (size_t)m2 * D, XR + (size_t)m * D, XR + (size_t)m2 * D, SS0 + m, SS0 + m2, F.lane); } }
    cvt_f32_f16(F, F.in[I_P], (f16*)(ws + WS_P16), (size_t)M * 256);
    cvt_f32_f16(F, F.in[I_PKEYS], (f16*)(ws + WS_KEYS), (size_t)8 * 2 * 128 * 128);
    for (int task = gw; task < 512; task += NGW) { const int mat = task >> 8, n = task & 255;
        const float* pos = F.in[mat ? I_CVPOS : I_CKPOS]; const float* w1 = F.in[mat ? I_CVW1 : I_CKW1]; float s = 0.f;
#pragma unroll
        for (int i = 0; i < 32; ++i) { const int k = F.lane + 64 * i; s += pos[k] * w1[(size_t)k * 256 + n]; }
        s = wave_sum(s);
        if (F.lane == 0) ((float*)(ws + WS_CBIAS))[task] = s + F.in[mat ? I_CVB1 : I_CKB1][n]; }
}

template <int W> __device__ __forceinline__ void pool_mix_tile(const f16* up, f16* mp, size_t mb, int s0) {
    f16x2 prev[16], cur[16]; f32x2 sum = {0.f, 0.f};
#pragma unroll
    for (int i = 0; i < 16; ++i) { const int sp = s0 - 16 + i; prev[i] = sp >= 0 ? *(const GAS f16x2*)(up + (mb + sp) * NINP) : (f16x2){(f16)0.f, (f16)0.f}; }
#pragma unroll
    for (int i = 16 - W; i < 16; ++i) { sum.x += (float)prev[i].x; sum.y += (float)prev[i].y; }
#pragma unroll 1
    for (int blk = 0; blk < 4; ++blk) { const int sb = s0 + blk * 16;
#pragma unroll
        for (int i = 0; i < 16; ++i) cur[i] = *(const GAS f16x2*)(up + (mb + sb + i) * NINP);
#pragma unroll
        for (int i = 0; i < 16; ++i) { const int s = sb + i; const f16x2 o = (i - W >= 0) ? cur[(i - W >= 0) ? i - W : 0] : prev[(i - W >= 0) ? 0 : 16 + i - W];
            sum.x += (float)cur[i].x - (float)o.x; sum.y += (float)cur[i].y - (float)o.y;
            const float ic = 1.f / (float)(s + 1 < W ? s + 1 : W);
            *(GAS unsigned*)(mp + (mb + s) * 1024) = pk_f16(sum.x * ic - (float)cur[i].x, sum.y * ic - (float)cur[i].y); }
#pragma unroll
        for (int i = 0; i < 16; ++i) prev[i] = cur[i]; }
}
__device__ __forceinline__ void p2_post(Frame& F) {
    unsigned char* ws = F.ws;
    f16* Y = (f16*)(ws + WS_Y);
    const float* qnw = F.in[I_QNW]; const float* knw = F.in[I_KNW];
    LAS f16* vl = (LAS f16*)F.lds;
    constexpr int VLP = 264;
    for (int tt = F.vcu; tt < M / 64; tt += F.G) {
        const int b = tt >> 5, s0 = (tt & 31) * 64, m0 = tt * 64;
        for (int tk = F.wave; tk < 64; tk += NWAVES) {
            const int m = m0 + tk, s = s0 + tk; f16* yr = Y + (size_t)m * NINP;
#pragma unroll
            for (int pass = 0; pass < 2; ++pass) { const int ch = pass * 64 + F.lane; f16* pq = yr + OFF_Q + ch * 8; const f16x8 v = *(const GAS f16x8*)pq;
                float ss = 0.f;
#pragma unroll
                for (int e = 0; e < 8; ++e) ss += (float)v[e] * (float)v[e];
                ss = sum8(ss);
                const float rs = (1.f / sqrtf(ss * (1.f / 64.f) + RMS_EPS)) * (0.125f * LOG2E); const float* w = qnw + (ch & 7) * 8;
                u32x4 o; o.x = pk_f16((float)v[0] * rs * w[0], (float)v[1] * rs * w[1]); o.y = pk_f16((float)v[2] * rs * w[2], (float)v[3] * rs * w[3]);
                o.z = pk_f16((float)v[4] * rs * w[4], (float)v[5] * rs * w[5]); o.w = pk_f16((float)v[6] * rs * w[6], (float)v[7] * rs * w[7]);
                *(GAS u32x4*)((f16*)(ws + WS_QN) + (size_t)m * 1024 + ch * 8) = o; }
            { const int br = F.lane >> 5, ch = F.lane & 31, g = ch >> 3, dc = ch & 7; const f16x8 v = *(const GAS f16x8*)(yr + (br ? OFF_KW : OFF_KS) + ch * 8);
                float ss = 0.f;
#pragma unroll
                for (int e = 0; e < 8; ++e) ss += (float)v[e] * (float)v[e];
                ss = sum8(ss);
                const float rs = 1.f / sqrtf(ss * (1.f / 64.f) + RMS_EPS); const float* w = knw + dc * 8;
                u32x2 o; o.x = pk_fp8((float)v[0] * rs * w[0], (float)v[1] * rs * w[1], (float)v[2] * rs * w[2], (float)v[3] * rs * w[3]);
                o.y = pk_fp8((float)v[4] * rs * w[4], (float)v[5] * rs * w[5], (float)v[6] * rs * w[6], (float)v[7] * rs * w[7]);
                *(GAS u32x2*)(ws + WS_KN + (size_t)br * (BATCH * 4 * SEQ * 64) + ((size_t)(b * 4 + g) * 64 + (s >> 5)) * 2048 + (dc >> 2) * 1024 + ((dc & 1) * 32 + (s & 31)) * 16 + ((dc >> 1) & 1) * 8) = o; }
            { const int mat = F.lane >> 5, ch = F.lane & 31, g = ch >> 3, dc = ch & 7; const u32x4 v = *(const GAS u32x4*)(yr + (mat ? OFF_VC : OFF_KC) + ch * 8);
                const int i1 = s >> 4, jj = s & 15; f16* fa = (f16*)(ws + WS_FLATA) + (size_t)mat * 4096 * 2048;
                if (i1 <= NCMP - 1) *(GAS u32x4*)(fa + (size_t)((b * NCMP + i1) * 4 + g) * 2048 + jj * 64 + dc * 8) = v;
                if (i1 >= 1) *(GAS u32x4*)(fa + (size_t)((b * NCMP + i1 - 1) * 4 + g) * 2048 + (16 + jj) * 64 + dc * 8) = v; }
        }
        for (int idx = F.tid; idx < 64 * 48; idx += 512) { const int tk = idx / 48, c = idx - tk * 48; const float v = (float)Y[(size_t)(m0 + tk) * NINP + OFF_G + c];
            ((float*)(ws + WS_GATES))[(size_t)(m0 + tk) * 48 + c] = 1.f / (1.f + __expf(-v)); }
        { const int gg = F.tid >> 7;
          if (gg == 0) pool_mix_tile<2>(Y + OFF_U + F.tid * 2, (f16*)(ws + WS_MIXED) + F.tid * 2, (size_t)b * SEQ, s0);
          else if (gg == 1) pool_mix_tile<4>(Y + OFF_U + F.tid * 2, (f16*)(ws + WS_MIXED) + F.tid * 2, (size_t)b * SEQ, s0);
          else if (gg == 2) pool_mix_tile<8>(Y + OFF_U + F.tid * 2, (f16*)(ws + WS_MIXED) + F.tid * 2, (size_t)b * SEQ, s0);
          else pool_mix_tile<16>(Y + OFF_U + F.tid * 2, (f16*)(ws + WS_MIXED) + F.tid * 2, (size_t)b * SEQ, s0); }
        __syncthreads();
        for (int idx = F.tid; idx < 2 * 64 * 32; idx += 512) { const int br = idx >> 11, tk = (idx >> 5) & 63, ch = idx & 31;
            *(LAS u32x4*)(vl + (br * 64 + tk) * VLP + ch * 8) = *(const GAS u32x4*)(Y + (size_t)(m0 + tk) * NINP + (br ? OFF_VW : OFF_VS) + ch * 8); }
        __syncthreads();
        for (int idx = F.tid; idx < 2 * 256 * 8; idx += 512) { const int br = idx >> 11, row = (idx >> 3) & 255, cc = idx & 7, grp = cc >> 1, hh = cc & 1;
            float o[8];
#pragma unroll
            for (int j = 0; j < 8; ++j) { const int kap = 16 * grp + 8 * (j >> 2) + 4 * hh + (j & 3); o[j] = (float)vl[(br * 64 + kap) * VLP + row]; }
            const int g = row >> 6, d = row & 63;
            u32x2 o8; o8.x = pk_fp8(o[0], o[1], o[2], o[3]); o8.y = pk_fp8(o[4], o[5], o[6], o[7]);
            *(GAS u32x2*)(ws + WS_VT + (size_t)br * (BATCH * 4 * 64 * SEQ) + ((size_t)(b * 4 + g) * 64 + (s0 >> 5) + (cc >> 2)) * 2048 + (d >> 5) * 1024 + ((cc & 1) * 32 + (d & 31)) * 16 + ((cc >> 1) & 1) * 8) = o8; }
        __syncthreads();
    }
}

__device__ __forceinline__ void p4_compress2(Frame& F) {
    unsigned char* ws = F.ws;
    f16* kc = (f16*)(ws + WS_KCMP); f16* vt = (f16*)(ws + WS_VCMPT);
    const int nhalf = F.G >> 1, mat = F.vcu & 1, wgr = F.vcu >> 1;
    if (nhalf == 0) return;
    LAS float* w2l = (LAS float*)F.lds;
    { const float* w2g = F.in[mat ? I_CVW2 : I_CKW2];
      for (int idx = F.tid; idx < 256 * 16; idx += 512) { const int k = idx >> 4, d4 = (idx & 15) * 4; const f32x4 v = *(const GAS f32x4*)(w2g + (size_t)k * 64 + d4);
          LAS float* q = w2l + ((k >> 2) * 64 + d4) * 4 + (k & 3); q[0] = v.x; q[4] = v.y; q[8] = v.z; q[12] = v.w; } }
    __syncthreads();
    const int rstep = nhalf * NWAVES, r0 = (F.vcu >= 2 * nhalf ? 4096 : wgr * NWAVES + F.wave);
#pragma unroll 1
    for (int rb = r0; rb < 4096; rb += 4 * rstep) {
        f32x4 hs[4];
#pragma unroll
        for (int q = 0; q < 4; ++q) { const int r = rb + q * rstep < 4096 ? rb + q * rstep : rb; const int bg = r >> 7, i = r & 127, ic = i < NCMP ? i : 0;
            const float* hp = (const float*)(ws + WS_Y) + ((size_t)mat * 4096 + (size_t)((bg >> 2) * NCMP + ic) * 4 + (bg & 3)) * 1024 + F.lane * 4;
            hs[q] = *(const GAS f32x4*)(((const float*)(ws + WS_CBIAS)) + mat * 256 + F.lane * 4);
#pragma unroll
            for (int ks = 0; ks < 4; ++ks) hs[q] = hs[q] + *(const GAS f32x4*)(hp + ks * 256); }
        float hh_[4][4], ac[4][4];
#pragma unroll
        for (int q = 0; q < 4; ++q) { const f32x2 ga = pg8::gelu_pk((f32x2){hs[q].x, hs[q].y}), gb = pg8::gelu_pk((f32x2){hs[q].z, hs[q].w});
            hh_[q][0] = ga.x; hh_[q][1] = ga.y; hh_[q][2] = gb.x; hh_[q][3] = gb.y; ac[q][0] = 0.f; ac[q][1] = 0.f; ac[q][2] = 0.f; ac[q][3] = 0.f; }
#pragma unroll 8
        for (int kk = 0; kk < 64; ++kk) { const f32x4 wv = *(const LAS f32x4*)(w2l + (kk * 64 + F.lane) * 4);
#pragma unroll
            for (int q = 0; q < 4; ++q) { ac[q][0] += rl_f(hh_[q][0], kk) * wv.x; ac[q][1] += rl_f(hh_[q][1], kk) * wv.y; ac[q][2] += rl_f(hh_[q][2], kk) * wv.z; ac[q][3] += rl_f(hh_[q][3], kk) * wv.w; } }
#pragma unroll
        for (int q = 0; q < 4; ++q) { const int r = rb + q * rstep; if (r < 4096) {
            const int bg = r >> 7, i = r & 127;
            const float acc = i < NCMP ? (ac[q][0] + ac[q][1]) + (ac[q][2] + ac[q][3]) : 0.f;
            if (mat == 0) { const float ss = wave_sum(acc * acc); const float rs = 1.f / sqrtf(ss * (1.f / 64.f) + RMS_EPS);
                const int d = F.lane, dc = d >> 3;
                kc[((size_t)bg * 4 + (i >> 5)) * 2048 + (dc >> 1) * 512 + ((dc & 1) * 32 + (i & 31)) * 8 + (d & 7)] = (f16)(i < NCMP ? acc * rs * F.in[I_KNW][F.lane] : 0.f); }
            else { const int kap = i & 15, pp = ((kap >> 2) & 1) * 8 + (kap >> 3) * 4 + (kap & 3);
                const int d = F.lane;
                vt[((size_t)bg * 4 + (i >> 5)) * 2048 + ((d >> 5) * 2 + ((i >> 4) & 1)) * 512 + ((pp >> 3) * 32 + (d & 31)) * 8 + (pp & 7)] = (f16)acc; } } }
    }
    __syncthreads();
}

__device__ __forceinline__ int t5_bucket(int rel) {
    if (rel < 16) return rel;
    int b = 16;
    b += rel >= 19; b += rel >= 21; b += rel >= 24; b += rel >= 27; b += rel >= 31; b += rel >= 35; b += rel >= 40; b += rel >= 46;
    b += rel >= 52; b += rel >= 59; b += rel >= 67; b += rel >= 77; b += rel >= 87; b += rel >= 99; b += rel >= 113;
    return b;
}
__device__ __forceinline__ int med3i(int a, int lo, int hi) { return a < lo ? lo : (a > hi ? hi : a); }
__device__ __forceinline__ float other_half_max(float x) { const auto r = __builtin_amdgcn_permlane32_swap(__float_as_uint(x), __float_as_uint(x), false, false); return fmaxf(__uint_as_float(r[0]), __uint_as_float(r[1])); }
__device__ __forceinline__ float both_halves_sum(float x) { const auto r = __builtin_amdgcn_permlane32_swap(__float_as_uint(x), __float_as_uint(x), false, false); return __uint_as_float(r[0]) + __uint_as_float(r[1]); }
struct AFrag { u32x4 k[2]; u32x4 v[2]; };
__device__ __forceinline__ void attn_load(AFrag& f, const unsigned char* Kp, const unsigned char* Vp, int kt, int r31, int hh) {
    const unsigned char* kp = Kp + (size_t)kt * 2048 + (hh * 32 + r31) * 16; const unsigned char* vp = Vp + (size_t)kt * 2048 + (hh * 32 + r31) * 16;
#pragma unroll
    for (int j = 0; j < 2; ++j) f.k[j] = *(const GAS u32x4*)(kp + j * 1024);
#pragma unroll
    for (int dt = 0; dt < 2; ++dt) f.v[dt] = *(const GAS u32x4*)(vp + dt * 1024);
}
__device__ __forceinline__ f16x8 pack8(const f32x16& c, int s2) {
    f16x8 o;
#pragma unroll
    for (int j = 0; j < 8; ++j) o[j] = (f16)c[8 * s2 + j];
    return o;
}
__device__ __forceinline__ void attn_tile(const AFrag& f, const long (&bq8)[4], int kt, int t0, int t, int hh, int wlim, unsigned selm, float cfar, const LAS float* lutr,
                                          float& mrun, float& lrun, f32x16& O0, f32x16& O1) {
    f32x16 S;
#pragma unroll
    for (int i = 0; i < 16; ++i) S[i] = 0.f;
#pragma unroll
    for (int ks = 0; ks < 4; ++ks) S = __builtin_amdgcn_mfma_f32_32x32x16_fp8_fp8((ks & 1) ? as_i64(f.k[ks >> 1].z, f.k[ks >> 1].w) : as_i64(f.k[ks >> 1].x, f.k[ks >> 1].y), bq8[ks], S, 0, 0, 0);
    const int k0 = kt * 32, minrel = t0 - (k0 + 31), maxrel = t0 + 7 - k0;
    const bool selbit = ((selm >> (kt >> 1)) & 1u) != 0u;
    float addc = 0.f;
    if (minrel >= 113 && maxrel < wlim) addc = selbit ? cfar : -2e30f;
    else {
        const unsigned wl = selbit ? (unsigned)wlim : 0u; const int relb = t - k0 - 4 * hh;
        float bias[16];
#pragma unroll
        for (int i = 0; i < 16; ++i) bias[i] = lutr[med3i(relb - ((i & 3) + 8 * (i >> 2)), 0, 127)];
#pragma unroll
        for (int i = 0; i < 16; ++i) asm volatile("" : "+v"(bias[i]));
#pragma unroll
        for (int i = 0; i < 16; ++i) { const int rel = relb - ((i & 3) + 8 * (i >> 2)); S[i] = ((unsigned)rel < wl) ? __builtin_fmaf(bias[i], 8.f, S[i]) : -2e30f; }
    }
    float tmax = S[0];
#pragma unroll
    for (int i = 1; i < 16; ++i) tmax = fmaxf(tmax, S[i]);
    tmax = other_half_max(tmax) * 0.125f + addc;
    const float mnew = fmaxf(mrun, tmax), alpha = __builtin_amdgcn_exp2f(mrun - mnew);
    mrun = mnew; lrun *= alpha;
    if (__builtin_amdgcn_ballot_w64(alpha != 1.0f) != 0ull) {
#pragma unroll
        for (int i = 0; i < 16; ++i) { O0[i] = mul_np(O0[i], alpha); O1[i] = mul_np(O1[i], alpha); } }
    const float mm = mnew - addc;
#pragma unroll
    for (int i = 0; i < 16; ++i) { const float pv = __builtin_amdgcn_exp2f(__builtin_fmaf(S[i], 0.125f, -mm)); lrun += pv; S[i] = pv; }
#pragma unroll
    for (int s2 = 0; s2 < 2; ++s2) { const long pb = as_i64(pk_fp8(S[8 * s2], S[8 * s2 + 1], S[8 * s2 + 2], S[8 * s2 + 3]), pk_fp8(S[8 * s2 + 4], S[8 * s2 + 5], S[8 * s2 + 6], S[8 * s2 + 7]));
        O0 = __builtin_amdgcn_mfma_f32_32x32x16_fp8_fp8(s2 ? as_i64(f.v[0].z, f.v[0].w) : as_i64(f.v[0].x, f.v[0].y), pb, O0, 0, 0, 0);
        O1 = __builtin_amdgcn_mfma_f32_32x32x16_fp8_fp8(s2 ? as_i64(f.v[1].z, f.v[1].w) : as_i64(f.v[1].x, f.v[1].y), pb, O1, 0, 0, 0); }
}
__device__ __forceinline__ void attn_branch(const unsigned char* Kp, const unsigned char* Vp, unsigned long long tm, const long (&bq)[4], int t0, int t, int r31, int hh, int wlim, unsigned selm, float cfar,
                                            const LAS float* lutr, float gate, LAS float* TL) {
    float mrun = -1e30f, lrun = 0.f; f32x16 O0, O1;
#pragma unroll
    for (int i = 0; i < 16; ++i) { O0[i] = 0.f; O1[i] = 0.f; }
    AFrag fA, fB;
    int ktA = __builtin_ctzll(tm), ktB;
    attn_load(fA, Kp, Vp, ktA, r31, hh);
    for (;;) {
        tm &= tm - 1; const bool hasB = tm != 0ull; ktB = hasB ? __builtin_ctzll(tm) : ktA; attn_load(fB, Kp, Vp, ktB, r31, hh);
        attn_tile(fA, bq, ktA, t0, t, hh, wlim, selm, cfar, lutr, mrun, lrun, O0, O1);
        if (!hasB) break;
        tm &= tm - 1; const bool hasA = tm != 0ull; ktA = hasA ? __builtin_ctzll(tm) : ktB; attn_load(fA, Kp, Vp, ktA, r31, hh);
        attn_tile(fB, bq, ktB, t0, t, hh, wlim, selm, cfar, lutr, mrun, lrun, O0, O1);
        if (!hasA) break;
    }
    lrun = both_halves_sum(lrun);
    const float sc = gate / fmaxf(lrun, 1e-30f);
#pragma unroll
    for (int i = 0; i < 16; ++i) { TL[i * 64] += O0[i] * sc; TL[(16 + i) * 64] += O1[i] * sc; }
}
__device__ __forceinline__ void p5_attention(Frame& F) {
    unsigned char* ws = F.ws;
    const f16* Y = (const f16*)(ws + WS_Y);
    const float* gates = (const float*)(ws + WS_GATES);
    f16* CAT = (f16*)(ws + WS_CAT);
    LAS float* wl = (LAS float*)(F.lds + F.wave * 8192);
    LAS float* LUT = wl;
    const int gw = F.vcu * NWAVES + F.wave, NW = F.G * NWAVES;
    const bool snake = (8192 % (2 * NW)) == 0, bal = (NW == 2048);
    int lut_g = -1;
    LAS unsigned* SELM = (LAS unsigned*)(wl + 1280);
    for (int it = gw, rr = 0; it < 8192; it += NW, ++rr) {
        int n = (snake && (rr & 1)) ? (rr * NW + (NW - 1 - gw)) : it;
        if (bal) {
            const int xq = gw >> 8, u = gw & 255;
            if (rr < 3) { const int f = rr * 256 + u, q = f / 192; n = (q * 8 + xq) * 256 + 64 + (f - q * 192); }
            else { const int c = u >> 3, w = u & 7, k = (c & 7) * 4 + (w & 3); n = ((c >> 3) * 8 + xq) * 256 + ((w & 4) ? 63 - k : k); } }
        const int bg = n >> 8, pos = n & 255, b = bg >> 2, g = bg & 3, t0 = pos * 8;
        int lane = F.lane; asm volatile("" : "+v"(lane));
        const int r31 = lane & 31, hh = lane >> 5, tok8 = r31 >> 2, r = r31 & 3;
        const LAS float* lutr = LUT + r * 128;
        if (g != lut_g) {
            LDS_WAIT(); asm volatile("" ::: "memory");
#pragma unroll
            for (int e = 0; e < 2; ++e) { const int rel = lane + 64 * e, bk = t5_bucket(rel);
#pragma unroll
                for (int r4 = 0; r4 < 4; ++r4) LUT[r4 * 128 + rel] = F.in[I_RELB][bk * 16 + 4 * g + r4] * LOG2E; }
            LDS_WAIT(); asm volatile("" ::: "memory");
            lut_g = g;
        }
        const int t = t0 + tok8, head = 4 * g + r; const size_t m = (size_t)b * SEQ + t;
        f16x8 bq[4];
#pragma unroll
        for (int ks = 0; ks < 4; ++ks) bq[ks] = *(const GAS f16x8*)((const f16*)(ws + WS_QN) + m * 1024 + head * 64 + ks * 16 + hh * 8);
        long bq8[4];
#pragma unroll
        for (int ks = 0; ks < 4; ++ks) bq8[ks] = as_i64(pk_fp8((float)bq[ks][0] * 8.f, (float)bq[ks][1] * 8.f, (float)bq[ks][2] * 8.f, (float)bq[ks][3] * 8.f),
                                                        pk_fp8((float)bq[ks][4] * 8.f, (float)bq[ks][5] * 8.f, (float)bq[ks][6] * 8.f, (float)bq[ks][7] * 8.f));
        const float g_c = gates[m * 48 + head * 3 + 0], g_s = gates[m * 48 + head * 3 + 1], g_w = gates[m * 48 + head * 3 + 2];
        const float cfar = lutr[127];
        LAS float* TL = (LAS float*)(F.lds + 65536 + F.wave * 8192) + lane;
        {
            const f16* kc = (const f16*)(ws + WS_KCMP) + (size_t)bg * 128 * 64;
            const f16* vc = (const f16*)(ws + WS_VCMPT) + (size_t)bg * 64 * 128;
            f32x16 c[4];
#pragma unroll
            for (int kt = 0; kt < 4; ++kt) {
#pragma unroll
                for (int i = 0; i < 16; ++i) c[kt][i] = 0.f;
#pragma unroll
                for (int ks = 0; ks < 4; ++ks) { const f16x8 a = *(const GAS f16x8*)(kc + kt * 2048 + ks * 512 + (hh * 32 + r31) * 8); c[kt] = __builtin_amdgcn_mfma_f32_32x32x16_f16(a, bq[ks], c[kt], 0, 0, 0); }
                asm volatile("" ::: "memory");
            }
            const int relb = t - 31 - 64 * hh; float mx = -1e30f;
#pragma unroll
            for (int kt = 0; kt < 4; ++kt) { float bias[16];
#pragma unroll
                for (int i = 0; i < 16; ++i) { const int rel = relb - 16 * (kt * 32 + (i & 3) + 8 * (i >> 2)); bias[i] = lutr[med3i(rel, 0, 127)]; }
#pragma unroll
                for (int i = 0; i < 16; ++i) asm volatile("" : "+v"(bias[i]));
#pragma unroll
                for (int i = 0; i < 16; ++i) { const int rel = relb - 16 * (kt * 32 + (i & 3) + 8 * (i >> 2));
                    const float sv = rel >= 0 ? c[kt][i] + bias[i] : -2e30f; c[kt][i] = sv; mx = fmaxf(mx, sv); }
                asm volatile("" ::: "memory"); }
            mx = other_half_max(mx);
            float l = 0.f;
#pragma unroll
            for (int kt = 0; kt < 4; ++kt)
#pragma unroll
                for (int i = 0; i < 16; ++i) { const float pv = __builtin_amdgcn_exp2f(c[kt][i] - mx); c[kt][i] = pv; l += pv; }
            l = both_halves_sum(l);
            const float inv = 1.f / fmaxf(l, 1e-30f);
#pragma unroll
            for (int kt = 0; kt < 4; ++kt)
#pragma unroll
                for (int jj = 0; jj < 4; ++jj) { float own = (2.f * (c[kt][4 * jj] + c[kt][4 * jj + 1] + c[kt][4 * jj + 2]) + c[kt][4 * jj + 3]) * inv, p3 = c[kt][4 * jj + 3] * inv;
                    own += dpp_f<0xB1>(own); own += dpp_f<0x4E>(own); p3 += dpp_f<0xB1>(p3); p3 += dpp_f<0x4E>(p3);
                    if (r == 0) { const int j = kt * 8 + 2 * jj + hh; wl[512 + tok8 * 32 + j] = own; wl[768 + tok8 * 32 + j] = p3; } }
            f32x16 O0, O1;
#pragma unroll
            for (int i = 0; i < 16; ++i) { O0[i] = 0.f; O1[i] = 0.f; }
#pragma unroll
            for (int kt = 0; kt < 4; ++kt)
#pragma unroll
                for (int s2 = 0; s2 < 2; ++s2) { const f16x8 pb = pack8(c[kt], s2);
                    const f16x8 a0 = *(const GAS f16x8*)(vc + kt * 2048 + s2 * 512 + (hh * 32 + r31) * 8), a1 = *(const GAS f16x8*)(vc + kt * 2048 + (2 + s2) * 512 + (hh * 32 + r31) * 8);
                    O0 = __builtin_amdgcn_mfma_f32_32x32x16_f16(a0, pb, O0, 0, 0, 0); O1 = __builtin_amdgcn_mfma_f32_32x32x16_f16(a1, pb, O1, 0, 0, 0); asm volatile("" ::: "memory"); }
            const float sc = inv * g_c;
#pragma unroll
            for (int i = 0; i < 16; ++i) { TL[i * 64] = O0[i] * sc; TL[(16 + i) * 64] = O1[i] * sc; }
        }
        LDS_WAIT(); asm volatile("" ::: "memory");
        int lane2 = lane; asm volatile("" : "+v"(lane2));
        LAS float* OWN = wl + 512 + (lane2 >> 5) * 32 + (lane2 & 31); LAS float* P3 = OWN + 256; LAS float* VAL = OWN + 512;
#pragma unroll
        for (int pp = 0; pp < 4; ++pp) { const int tk = 2 * pp + hh, j = r31, cur = (t0 + tk) >> 6;
            const float impv = OWN[pp * 64] + (j > 0 ? P3[pp * 64 - (j > 0 ? 1 : 0)] : 0.f);
            VAL[pp * 64] = (j == 0 || j == cur || j == cur - 1) ? 1e4f : (j <= cur ? impv : -1e30f); }
        LDS_WAIT(); asm volatile("" ::: "memory");
#pragma unroll
        for (int pp = 0; pp < 4; ++pp) { const int tk = 2 * pp + hh, j = r31, cur = (t0 + tk) >> 6; const float v = VAL[pp * 64]; int cnt = 0; const LAS float* vrow = VAL + pp * 64 - j;
#pragma unroll
            for (int j2 = 0; j2 < 32; ++j2) { const float o = vrow[j2]; cnt += (o > v || (o == v && j2 < j)) ? 1 : 0; }
            const unsigned long long bm = __ballot(cnt < 8 && j <= cur);
            const unsigned mym = hh ? (unsigned)(bm >> 32) : (unsigned)bm;
            if (j == 0) SELM[tk] = mym; }
        LDS_WAIT(); asm volatile("" ::: "memory");
        const unsigned selm = SELM[tok8];
        unsigned um = 0u;
#pragma unroll
        for (int i = 0; i < 8; ++i) um |= SELM[i];
        um = (unsigned)__builtin_amdgcn_readfirstlane((int)um);
        const int kthi = (t0 + 7) >> 5;
        const unsigned long long causal = (kthi >= 63) ? ~0ull : ((1ull << (kthi + 1)) - 1ull);
        {
            unsigned long long x = um;
            x = (x | (x << 16)) & 0x0000FFFF0000FFFFull; x = (x | (x << 8)) & 0x00FF00FF00FF00FFull; x = (x | (x << 4)) & 0x0F0F0F0F0F0F0F0Full;
            x = (x | (x << 2)) & 0x3333333333333333ull; x = (x | (x << 1)) & 0x5555555555555555ull;
            const unsigned long long tm = (x | (x << 1)) & causal;
            attn_branch(ws + WS_KN + (size_t)bg * SEQ * 64, ws + WS_VT + (size_t)bg * 64 * SEQ, tm, bq8, t0, t, r31, hh, 1 << 30, selm, cfar, lutr, g_s, TL);
        }
        {
            const int lo = t0 - 511 > 0 ? (t0 - 511) >> 5 : 0;
            const unsigned long long tm = causal & ~((1ull << lo) - 1ull);
            attn_branch(ws + WS_KN + (size_t)(BATCH * 4 + bg) * SEQ * 64, ws + WS_VT + (size_t)(BATCH * 4 + bg) * 64 * SEQ, tm, bq8, t0, t, r31, hh, 512, 0xFFFFFFFFu, cfar, lutr, g_w, TL);
        }
        f16* orow = CAT + m * D + 1024 + head * 64 + 4 * hh;
#pragma unroll
        for (int jj = 0; jj < 4; ++jj) {
            u32x2 o0; o0.x = pk_f16(TL[(4 * jj) * 64], TL[(4 * jj + 1) * 64]); o0.y = pk_f16(TL[(4 * jj + 2) * 64], TL[(4 * jj + 3) * 64]); *(GAS u32x2*)(orow + 8 * jj) = o0;
            u32x2 o1; o1.x = pk_f16(TL[(16 + 4 * jj) * 64], TL[(16 + 4 * jj + 1) * 64]); o1.y = pk_f16(TL[(16 + 4 * jj + 2) * 64], TL[(16 + 4 * jj + 3) * 64]); *(GAS u32x2*)(orow + 32 + 8 * jj) = o1; }
    }
}

__device__ __forceinline__ void cvt_row_fp6(const f32x4 (&v)[8], int row, unsigned char* dst6, float* scales, int lane) {
    float amax = 0.f;
#pragma unroll
    for (int c = 0; c < 8; ++c) amax = fmaxf(amax, fmaxf(fmaxf(fabsf(v[c].x), fabsf(v[c].y)), fmaxf(fabsf(v[c].z), fabsf(v[c].w))));
    amax = wave_max(amax);
    const float scale = amax > 0.f ? amax * (1.f / 7.5f) : 1.f, inv = 1.f / scale;
    f16x32 h;
#pragma unroll
    for (int c = 0; c < 8; ++c) { h[4 * c] = (f16)(v[c].x * inv); h[4 * c + 1] = (f16)(v[c].y * inv); h[4 * c + 2] = (f16)(v[c].z * inv); h[4 * c + 3] = (f16)(v[c].w * inv); }
    const u32x6 pk = __builtin_amdgcn_cvt_scalef32_pk32_fp6_f16(h, 1.0f);
    unsigned char* d = dst6 + (size_t)(lane >> 3) * SLICE6;
    *(GAS u32x4*)(d + (size_t)row * 128 + (lane & 7) * 16) = (u32x4){pk[0], pk[1], pk[2], pk[3]}; *(GAS u32x2*)(d + 2097152 + (size_t)row * 64 + (lane & 7) * 8) = (u32x2){pk[4], pk[5]};
    if (lane == 0) scales[row] = scale;
}
__device__ __forceinline__ void cvt_table_fp6(Frame& F, const float* src, unsigned char* dst6, float* scales, const float* colw) {
    const int gw = F.vcu * NWAVES + F.wave, NGW = F.G * NWAVES, lane = F.lane;
    int row = gw;
    for (; row + NGW < 16384; row += 2 * NGW) {
        f32x4 va[8], vb[8];
#pragma unroll
        for (int c = 0; c < 8; ++c) { va[c] = __builtin_nontemporal_load((const GAS f32x4*)(src + (size_t)row * D + c * 256 + lane * 4)); vb[c] = __builtin_nontemporal_load((const GAS f32x4*)(src + (size_t)(row + NGW) * D + c * 256 + lane * 4)); }
        if (colw) {
#pragma unroll
            for (int c = 0; c < 8; ++c) { const f32x4 wv = *(const GAS f32x4*)(colw + c * 256 + lane * 4); va[c] = va[c] * wv; vb[c] = vb[c] * wv; } }
        cvt_row_fp6(va, row, dst6, scales, lane); cvt_row_fp6(vb, row + NGW, dst6, scales, lane);
    }
    for (; row < 16384; row += NGW) { f32x4 va[8];
#pragma unroll
        for (int c = 0; c < 8; ++c) { va[c] = *(const GAS f32x4*)(src + (size_t)row * D + c * 256 + lane * 4); if (colw) va[c] = va[c] * *(const GAS f32x4*)(colw + c * 256 + lane * 4); }
        cvt_row_fp6(va, row, dst6, scales, lane); }
}
__device__ __forceinline__ void p7_tables(Frame& F) {
    cvt_table_fp6(F, F.in[I_PU], F.ws + WS_U6, (float*)(F.ws + WS_SU), F.in[I_FFNNW]);
    cvt_table_fp6(F, F.in[I_PV], F.ws + WS_V6, (float*)(F.ws + WS_SV), nullptr);
}

__device__ __forceinline__ void bitonic_sort16_desc(float (&a)[16]) {
#pragma unroll
    for (int k = 2; k <= 16; k <<= 1)
#pragma unroll
        for (int j = k >> 1; j > 0; j >>= 1)
#pragma unroll
            for (int i = 0; i < 16; ++i) { const int l = i ^ j; if (l > i) { const float hi = fmaxf(a[i], a[l]), lo = fminf(a[i], a[l]); if ((i & k) == 0) { a[i] = hi; a[l] = lo; } else { a[i] = lo; a[l] = hi; } } }
}
__device__ __forceinline__ void bitonic_merge16_desc(float (&a)[16]) {
#pragma unroll
    for (int dist = 8; dist >= 1; dist >>= 1)
#pragma unroll
        for (int i = 0; i < 16; ++i) if ((i & dist) == 0) { const float hi = fmaxf(a[i], a[i + dist]), lo = fminf(a[i], a[i + dist]); a[i] = hi; a[i + dist] = lo; }
}
#define INS16(top, v) do { _Pragma("unroll") for (int _j = 0; _j < 16; ++_j) { const float _h = fmaxf(top[_j], v); v = fminf(top[_j], v); top[_j] = _h; } } while (0)
#define INS16P(tv, ti, v, i) do { _Pragma("unroll") for (int _j = 0; _j < 16; ++_j) { const bool _c = v > tv[_j]; const float _nv = _c ? tv[_j] : v; const unsigned _ni = _c ? ti[_j] : i; \
        tv[_j] = _c ? v : tv[_j]; ti[_j] = _c ? i : ti[_j]; v = _nv; i = _ni; } } while (0)
typedef unsigned v4u_t __attribute__((__vector_size__(16)));
typedef unsigned v2u_t __attribute__((__vector_size__(8)));
__device__ __forceinline__ void p9a_topk(Frame& F) {
    unsigned char* ws = F.ws;
    const f16* QP = (const f16*)(ws + WS_QP); const f16* KEYS = (const f16*)(ws + WS_KEYS);
    unsigned* LIDX = (unsigned*)(ws + WS_LIDX); float* LG = (float*)(ws + WS_LG);
    const int lane = F.lane, r31 = lane & 31, hh = lane >> 5;
    const float NINF = -__builtin_inff();
    for (int unit = F.vcu; unit < M / 32; unit += F.G) {
        const int m0 = unit * 32;
        {
            const int h = F.wave;
            float sl[2][16];
            f16x8 bq[8], ka[8];
#pragma unroll
            for (int ks = 0; ks < 8; ++ks) { bq[ks] = *(const GAS f16x8*)(QP + (size_t)(m0 + r31) * D + (h * 2) * 128 + ks * 16 + hh * 8);
                ka[ks] = *(const GAS f16x8*)(KEYS + ((size_t)((h * 2) * 128 + r31)) * 128 + hh * 8 + ks * 16); }
            float top[16];
#pragma unroll
            for (int st = 0; st < 8; ++st) { const int p = st >> 2, kt = st & 3;
                if (kt == 0) {
#pragma unroll
                    for (int j = 0; j < 16; ++j) top[j] = NINF; }
                f32x16 c;
#pragma unroll
                for (int i = 0; i < 16; ++i) c[i] = 0.f;
#pragma unroll
                for (int ks = 0; ks < 8; ++ks) c = __builtin_amdgcn_mfma_f32_32x32x16_f16(ka[ks], bq[ks], c, 0, 0, 0);
                if (st + 1 < 8) { const int pn = (st + 1) >> 2, ktn = (st + 1) & 3;
#pragma unroll
                    for (int ks = 0; ks < 8; ++ks) ka[ks] = *(const GAS f16x8*)(KEYS + ((size_t)((h * 2 + pn) * 128 + ktn * 32 + r31)) * 128 + hh * 8 + ks * 16);
                    if (st == 3) {
#pragma unroll
                        for (int ks = 0; ks < 8; ++ks) bq[ks] = *(const GAS f16x8*)(QP + (size_t)(m0 + r31) * D + (h * 2 + 1) * 128 + ks * 16 + hh * 8); } }
                const unsigned k4 = (unsigned)(kt * 32 + 4 * hh);
                float nv[16];
#pragma unroll
                for (int reg = 0; reg < 16; ++reg) { const unsigned key = k4 + (unsigned)((reg & 3) + 8 * (reg >> 2)); nv[reg] = __uint_as_float((__float_as_uint(c[reg]) & ~127u) | key); }
                bitonic_sort16_desc(nv);
#pragma unroll
                for (int j = 0; j < 16; ++j) top[j] = fmaxf(top[j], nv[15 - j]);
                bitonic_merge16_desc(top);
                if (kt == 3) {
                    float cm[16];
#pragma unroll
                    for (int j = 0; j < 16; ++j) cm[j] = fmaxf(top[j], __uint_as_float(other32u(__float_as_uint(top[15 - j]), hh != 0)));
                    bitonic_merge16_desc(cm);
#pragma unroll
                    for (int j = 0; j < 16; ++j) sl[p][j] = cm[j]; }
            }
            float vx[16], vy[16]; unsigned ix[16], iy[16];
#pragma unroll
            for (int j = 0; j < 16; ++j) { const unsigned bx = __float_as_uint(hh ? sl[1][j] : sl[0][j]), by = __float_as_uint(hh ? sl[0][j] : sl[1][j]);
                vx[j] = __uint_as_float(bx & ~127u); vy[j] = __uint_as_float(by & ~127u); ix[j] = (bx & 127u) * (hh ? 1u : 128u); iy[j] = (by & 127u) * (hh ? 128u : 1u); }
            float tv[16]; unsigned ti[16];
#pragma unroll
            for (int j = 0; j < 16; ++j) { const int jb = j + 1 < 16 ? j + 1 : 15;
                const float v0 = vx[0] + vy[j], v1 = (j < 15) ? vx[0] + vy[jb] : NINF; const unsigned i0 = ix[0] + iy[j], i1 = ix[0] + iy[jb];
                tv[j] = hh ? v1 : v0; ti[j] = hh ? i1 : i0; }
#pragma unroll
            for (int a = 1; a < 4; ++a) { const int bmax = (a == 1) ? 7 : (a == 2 ? 4 : 3);
#pragma unroll
                for (int b = a; b <= bmax; ++b) { float v = vx[a] + vy[b]; if (a == b) v = hh ? NINF : v; unsigned i = ix[a] + iy[b]; INS16P(tv, ti, v, i); } }
            float mv[16]; unsigned mi[16];
#pragma unroll
            for (int j = 0; j < 16; ++j) { const float pv = __uint_as_float(other32u(__float_as_uint(tv[15 - j]), hh != 0)); const unsigned pi = other32u(ti[15 - j], hh != 0); const bool c = pv > tv[j]; mv[j] = c ? pv : tv[j]; mi[j] = c ? pi : ti[j]; }
            float mx = mv[0];
#pragma unroll
            for (int j = 1; j < 16; ++j) mx = fmaxf(mx, mv[j]);
            float sum = 0.f;
#pragma unroll
            for (int j = 0; j < 16; ++j) { mv[j] = __builtin_amdgcn_exp2f((mv[j] - mx) * LOG2E); sum += mv[j]; }
            const float inv = 1.f / sum;
#pragma unroll
            for (int j = 0; j < 8; ++j) { { const int e_ = h * 16 + hh * 8 + j, pos_ = (e_ & 63) * 2 + (e_ >> 6); LIDX[(size_t)(m0 + r31) * 128 + pos_] = mi[j]; LG[(size_t)(m0 + r31) * 128 + pos_] = mv[j] * inv; } }
        }
    }
}
struct Seg6 { v4u_t a; v2u_t b; };
__device__ __forceinline__ f16x32 seg6_decode(const Seg6& r) { const u32x6 p = {r.a[0], r.a[1], r.a[2], r.a[3], r.b[0], r.b[1]}; return __builtin_amdgcn_cvt_scalef32_pk32_f16_fp6(p, 1.0f); }
__device__ __forceinline__ f16x32 seg6_dec2(const v4u_t& a, const v2u_t& b) { const u32x6 p = {a[0], a[1], a[2], a[3], b[0], b[1]}; return __builtin_amdgcn_cvt_scalef32_pk32_f16_fp6(p, 1.0f); }
#define SEG_DECL(P) v4u_t P##a0, P##a1, P##a2, P##a3, P##a4, P##a5, P##a6, P##a7; v2u_t P##b0, P##b1, P##b2, P##b3, P##b4, P##b5, P##b6, P##b7
#define SEG_L1(P, G, idxv) do { const int e_ = __shfl(idxv, 8 * G + sub); P##a##G = __builtin_amdgcn_raw_buffer_load_b128(rs, e_ * 128 + ch * 16, 0, 0); P##b##G = __builtin_amdgcn_raw_buffer_load_b64(rs, 2097152 + e_ * 64 + ch * 8, 0, 0); } while (0)
#define SEG_LOAD(P, idxv) do { SEG_L1(P, 0, idxv); SEG_L1(P, 1, idxv); SEG_L1(P, 2, idxv); SEG_L1(P, 3, idxv); SEG_L1(P, 4, idxv); SEG_L1(P, 5, idxv); SEG_L1(P, 6, idxv); SEG_L1(P, 7, idxv); } while (0)
__device__ __forceinline__ float u_one(const v4u_t& a, const v2u_t& b, const f16x2 (&xp)[16]) {
    const f16x32 hv = seg6_dec2(a, b); float sdot = 0.f;
#pragma unroll
    for (int k = 0; k < 16; ++k) { f16x2 hp; hp.x = hv[2 * k]; hp.y = hv[2 * k + 1]; sdot = __builtin_amdgcn_fdot2(hp, xp[k], sdot, false); }
    return sum8(sdot);
}
#define SEG_LE(P, G, ev) do { const int e_ = (ev); P##a##G = __builtin_amdgcn_raw_buffer_load_b128(rs, e_ * 128 + ch * 16, 0, 0); P##b##G = __builtin_amdgcn_raw_buffer_load_b64(rs, 2097152 + e_ * 64 + ch * 8, 0, 0); } while (0)
#define EN_GATHER(en, iA, iB) do { _Pragma("unroll") for (int g_ = 0; g_ < 8; ++g_) { en[g_] = __shfl(iA, 8 * g_ + sub); en[8 + g_] = __shfl(iB, 8 * g_ + sub); } } while (0)
#define U_ROLL1(P, G, res, eo) do { const float d_ = u_one(P##a##G, P##b##G, xp); res = (ch == G) ? d_ : res; SEG_LE(P, G, en[(eo) + G]); } while (0)
#define U_ROLL(P, res, idxn) do { U_ROLL1(P, 0, res, idxn); U_ROLL1(P, 1, res, idxn); U_ROLL1(P, 2, res, idxn); U_ROLL1(P, 3, res, idxn); U_ROLL1(P, 4, res, idxn); U_ROLL1(P, 5, res, idxn); U_ROLL1(P, 6, res, idxn); U_ROLL1(P, 7, res, idxn); } while (0)
#define V_ROLL1(P, G, hwv, eo) do { v_one(P##a##G, P##b##G, acc, hq[(eo) + G]); SEG_LE(P, G, en[(eo) + G]); } while (0)
#define V_ROLL(P, hwv, idxn) do { V_ROLL1(P, 0, hwv, idxn); V_ROLL1(P, 1, hwv, idxn); V_ROLL1(P, 2, hwv, idxn); V_ROLL1(P, 3, hwv, idxn); V_ROLL1(P, 4, hwv, idxn); V_ROLL1(P, 5, hwv, idxn); V_ROLL1(P, 6, hwv, idxn); V_ROLL1(P, 7, hwv, idxn); } while (0)
#define FMIXV_LO(a, h, w) asm("v_fma_mix_f32 %0, %1, %2, %0 op_sel_hi:[1,0,0]" : "+v"(a) : "v"(h), "v"(w))
#define FMIXV_HI(a, h, w) asm("v_fma_mix_f32 %0, %1, %2, %0 op_sel:[1,0,0] op_sel_hi:[1,0,0]" : "+v"(a) : "v"(h), "v"(w))
__device__ __forceinline__ void v_one(const v4u_t& a, const v2u_t& b, f16x2 (&acc)[16], f16x2 wq) {
    const f16x32 hv = seg6_dec2(a, b);
#pragma unroll
    for (int k = 0; k < 16; ++k) { f16x2 hp; hp.x = hv[2 * k]; hp.y = hv[2 * k + 1]; acc[k] = __builtin_elementwise_fma(hp, wq, acc[k]); }
}
#define V_HALF(P, hwv) do { v_one(P##a0, P##b0, acc, hwv, sub); v_one(P##a1, P##b1, acc, hwv, 8 + sub); v_one(P##a2, P##b2, acc, hwv, 16 + sub); v_one(P##a3, P##b3, acc, hwv, 24 + sub); \
        v_one(P##a4, P##b4, acc, hwv, 32 + sub); v_one(P##a5, P##b5, acc, hwv, 40 + sub); v_one(P##a6, P##b6, acc, hwv, 48 + sub); v_one(P##a7, P##b7, acc, hwv, 56 + sub); } while (0)
__device__ __forceinline__ void p9b_upass(Frame& F, bool probe_slice0) {
    unsigned char* ws = F.ws;
    const int x = blockIdx.x & 7, rank = blockIdx.x >> 3, cnt = (F.G - x + 7) >> 3;
    const int lane = F.lane, sub = lane >> 3, ch = lane & 7;
    const __amdgpu_buffer_rsrc_t rs = __builtin_amdgcn_make_buffer_rsrc((void*)(ws + WS_U6 + (size_t)(probe_slice0 ? 0 : x) * SLICE6), 0, (int)SLICE6, 0x00020000);
    const f16* XN = (const f16*)(ws + WS_XR) + x * 32 + (lane >> 3) * 256 + (lane & 7) * 4;
    const u32x2* LI2 = (const u32x2*)(ws + WS_LIDX); LAS unsigned char* xl = F.lds + F.wave * 512;
    const int tstep = cnt * NWAVES; int t = rank * NWAVES + F.wave;
    if (t >= M) return;
    int cA, cB, nA, nB; { const u32x2 c2 = LI2[(size_t)t * 64 + lane]; cA = (int)c2.x; cB = (int)c2.y; }
    const int t1c = (t + tstep < M) ? t + tstep : t;
    { const u32x2 n2 = LI2[(size_t)t1c * 64 + lane]; nA = (int)n2.x; nB = (int)n2.y; }
    u32x2 xcur = *(const GAS u32x2*)(XN + (size_t)t * D);
    f16x2 xp[16];
    SEG_DECL(bA); SEG_DECL(bB);
    { const int li_ = cA; SEG_LOAD(bA, li_); } { const int li_ = cB; SEG_LOAD(bB, li_); }
#pragma unroll 1
    for (;;) {
        const int tn = t + tstep, tnn = tn + tstep; const bool hn = tn < M, hnn = tnn < M;
        const int tnc = hn ? tn : t, tnnc = hnn ? tnn : t;
        const u32x2 m2 = LI2[(size_t)tnnc * 64 + lane]; const int mA = (int)m2.x, mB = (int)m2.y;
        const u32x2 xnext = *(const GAS u32x2*)(XN + (size_t)tnc * D);
        *(LAS u32x2*)(xl + ((lane & 7) * 8 + (lane >> 3)) * 8) = xcur;
        LDS_WAIT(); asm volatile("" ::: "memory");
#pragma unroll
        for (int q = 0; q < 4; ++q) { const u32x4 tv = *(const LAS u32x4*)(xl + ch * 64 + q * 16); xp[4 * q] = ash2(tv.x); xp[4 * q + 1] = ash2(tv.y); xp[4 * q + 2] = ash2(tv.z); xp[4 * q + 3] = ash2(tv.w); }
        LDS_WAIT(); asm volatile("" ::: "memory");
        { const int lA_ = hn ? nA : cA, lB_ = hn ? nB : cB; int en[16]; EN_GATHER(en, lA_, lB_);
          float rA = 0.f, rB = 0.f; U_ROLL(bA, rA, 0); U_ROLL(bB, rB, 8);
          float* pd = (float*)(ws + WS_PD) + ((size_t)t * 8 + x) * 128 + 8 * ch + sub; pd[0] = rA; pd[64] = rB; }
        if (!hn) break;
        xcur = xnext;
        cA = nA; cB = nB; nA = mA; nB = mB; t = tn;
    }
}
__device__ __forceinline__ void p9h_weights(Frame& F) {
    unsigned char* ws = F.ws;
    const unsigned* LIDX = (const unsigned*)(ws + WS_LIDX); const float* LG = (const float*)(ws + WS_LG); const float* PD = (const float*)(ws + WS_PD);
    const float* SU = (const float*)(ws + WS_SU); const float* SV = (const float*)(ws + WS_SV); float* HW = (float*)(ws + WS_HW);
    const int gw = F.vcu * NWAVES + F.wave, NGW = F.G * NWAVES, lane = F.lane;
#pragma unroll 1
    for (int t0 = gw; t0 < M; t0 += 2 * NGW) {
        const int t1 = t0 + NGW < M ? t0 + NGW : t0;
        int iA[2], iB[2]; float pa[2][8], pb[2][8], lgA[2], lgB[2], s1[2];
#pragma unroll
        for (int q = 0; q < 2; ++q) { const int t = q ? t1 : t0; { const u32x2 i2 = ((const u32x2*)LIDX)[(size_t)t * 64 + lane]; iA[q] = (int)i2.x; iB[q] = (int)i2.y; }
#pragma unroll
            for (int xs = 0; xs < 8; ++xs) { pa[q][xs] = PD[((size_t)t * 8 + xs) * 128 + lane]; pb[q][xs] = PD[((size_t)t * 8 + xs) * 128 + 64 + lane]; }
            { const f32x2 g2 = ((const f32x2*)LG)[(size_t)t * 64 + lane]; lgA[q] = g2.x; lgB[q] = g2.y; } s1[q] = ((const float*)(ws + WS_SS1))[t]; }
#pragma unroll
        for (int q = 0; q < 2; ++q) { const int t = q ? t1 : t0; float zA = 0.f, zB = 0.f;
#pragma unroll
            for (int xs = 0; xs < 8; ++xs) { zA += pa[q][xs]; zB += pb[q][xs]; }
            const float rs1 = 1.f / sqrtf(s1[q] * (1.f / D) + RMS_EPS);
            ((f32x2*)HW)[(size_t)t * 64 + lane] = (f32x2){pg8::gelu1(zA * rs1 * SU[iA[q]]) * lgA[q] * SV[iA[q]], pg8::gelu1(zB * rs1 * SU[iB[q]]) * lgB[q] * SV[iB[q]]}; }
    }
}
__device__ __forceinline__ void p9c_vpass(Frame& F) {
    unsigned char* ws = F.ws;
    const int x = blockIdx.x & 7, rank = blockIdx.x >> 3, cnt = (F.G - x + 7) >> 3;
    const int lane = F.lane, sub = lane >> 3, ch = lane & 7;
    const __amdgpu_buffer_rsrc_t rs = __builtin_amdgcn_make_buffer_rsrc((void*)(ws + WS_V6 + (size_t)x * SLICE6), 0, (int)SLICE6, 0x00020000);
    const u32x2* LI2 = (const u32x2*)(ws + WS_LIDX);
    f16* XR = (f16*)(ws + WS_XR); float* SS2 = (float*)(ws + WS_SS2);
    const bool b3 = (lane & 8) != 0, b4 = (lane & 16) != 0, b5 = (lane & 32) != 0;
    const int col = ((b3 ? 4 : 0) + (b4 ? 2 : 0) + (b5 ? 1 : 0)) * 256 + x * 32 + ch * 4;
    const int tstep = cnt * NWAVES; int t = rank * NWAVES + F.wave;
    if (t >= M) return;
    int cA, cB, nA, nB; { const u32x2 c2 = LI2[(size_t)t * 64 + lane]; cA = (int)c2.x; cB = (int)c2.y; }
    const int t1c = (t + tstep < M) ? t + tstep : t;
    { const u32x2 n2 = LI2[(size_t)t1c * 64 + lane]; nA = (int)n2.x; nB = (int)n2.y; }
    const f32x2* HW2 = (const f32x2*)(ws + WS_HW);
    float hwA, hwB; { const f32x2 h2 = HW2[(size_t)t * 64 + lane]; hwA = h2.x; hwB = h2.y; }
    SEG_DECL(bA); SEG_DECL(bB);
    { const int li_ = cA; SEG_LOAD(bA, li_); } { const int li_ = cB; SEG_LOAD(bB, li_); }
#pragma unroll 1
    for (;;) {
        const int tn = t + tstep, tnn = tn + tstep; const bool hn = tn < M, hnn = tnn < M;
        const int tnc = hn ? tn : t, tnnc = hnn ? tnn : t;
        const u32x2 m2 = LI2[(size_t)tnnc * 64 + lane]; const int mA = (int)m2.x, mB = (int)m2.y;
        const f32x2 hn2 = HW2[(size_t)tnc * 64 + lane]; const float hwAn = hn2.x, hwBn = hn2.y;
        f16* orow = XR + (size_t)t * D + col; const u32x2 x1r = *(const GAS u32x2*)orow;
        f16x2 acc[16];
#pragma unroll
        for (int i = 0; i < 16; ++i) { acc[i].x = (f16)0.f; acc[i].y = (f16)0.f; }
        { const int lA_ = hn ? nA : cA, lB_ = hn ? nB : cB; int en[16]; EN_GATHER(en, lA_, lB_); f16x2 hq[16];
#pragma unroll
          for (int g_ = 0; g_ < 8; ++g_) { const float qa = __shfl(hwA, 8 * g_ + sub) * 64.f, qb = __shfl(hwB, 8 * g_ + sub) * 64.f;
              hq[g_].x = (f16)qa; hq[g_].y = (f16)qa; hq[8 + g_].x = (f16)qb; hq[8 + g_].y = (f16)qb; }
          V_ROLL(bA, hwA, 0); V_ROLL(bB, hwB, 8); }
        f16x2 q8[8];
#pragma unroll
        for (int i = 0; i < 8; ++i) { const f16x2 keep = b3 ? acc[8 + i] : acc[i], send = b3 ? acc[i] : acc[8 + i]; q8[i] = keep + ash2(other8u(__builtin_bit_cast(unsigned, send))); }
        f16x2 q4[4];
#pragma unroll
        for (int i = 0; i < 4; ++i) { const f16x2 keep = b4 ? q8[4 + i] : q8[i], send = b4 ? q8[i] : q8[4 + i]; q4[i] = keep + ash2(other16u(__builtin_bit_cast(unsigned, send), b4)); }
        float r4[4];
        { const f16x2 k0 = b5 ? q4[2] : q4[0], k1 = b5 ? q4[3] : q4[1], s0 = b5 ? q4[0] : q4[2], s1 = b5 ? q4[1] : q4[3];
          const f16x2 p0 = ash2(other32u(__builtin_bit_cast(unsigned, s0), b5)), p1 = ash2(other32u(__builtin_bit_cast(unsigned, s1), b5));
          r4[0] = ((float)k0.x + (float)p0.x) * (1.f / 64.f); r4[1] = ((float)k0.y + (float)p0.y) * (1.f / 64.f); r4[2] = ((float)k1.x + (float)p1.x) * (1.f / 64.f); r4[3] = ((float)k1.y + (float)p1.y) * (1.f / 64.f); }
        const f16x2 x1a = ash2(x1r.x), x1b = ash2(x1r.y);
        const f32x4 x2 = {(float)x1a.x + r4[0], (float)x1a.y + r4[1], (float)x1b.x + r4[2], (float)x1b.y + r4[3]};
        { u32x2 o2; o2.x = pk_f16(x2.x, x2.y); o2.y = pk_f16(x2.z, x2.w); *(GAS u32x2*)orow = o2; }
        const float ss = wave_sum((x2.x * x2.x + x2.y * x2.y) + (x2.z * x2.z + x2.w * x2.w));
        if (lane == 0) atomicAdd(SS2 + t, ss);
        if (!hn) break;
        cA = nA; cB = nB; nA = mA; nB = mB; t = tn; hwA = hwAn; hwB = hwBn;
    }
}
#undef FMIXV_LO
#undef FMIXV_HI

constexpr int NPH = 13;
struct Args { const float* in[26]; float* out; unsigned char* ws; int ph_lo, ph_hi; int rep[16]; };
__global__ void __launch_bounds__(NWAVES * 64, 2) fwd_kernel(Args args) {
    extern __shared__ __attribute__((aligned(16))) unsigned char lds[];
    Frame F;
    F.lds = (LAS unsigned char*)lds;
    F.MISC = (volatile LAS unsigned*)(F.lds + MISC_OFF);
    F.tid = threadIdx.x; F.lane = F.tid & 63; F.wave = __builtin_amdgcn_readfirstlane(F.tid >> 6);
#define PHASE_LANES() do { int t_ = threadIdx.x; asm volatile("" : "+v"(t_)); F.tid = t_; F.lane = t_ & 63; } while (0)
    F.G = gridDim.x; { const int bx = blockIdx.x; F.vcu = (F.G % 8 == 0) ? (bx % 8) * (F.G / 8) + bx / 8 : bx; }
#pragma unroll
    for (int i = 0; i < 26; ++i) F.in[i] = args.in[i];
    F.out = args.out; F.ws = args.ws;
    unsigned char* ws = args.ws;
    gu32* ctl = (gu32*)(ws + WS_CTL);
    for (int u = F.tid; u < (LDS_BYTES - LDSCTL_OFF) / 4; u += NWAVES * 64) ((LAS unsigned*)(F.lds + LDSCTL_OFF))[u] = 0u;
    __syncthreads();
    XcdBarrier bar; bar.bar = (unsigned*)(ctl + CW_BAR); bar.x = 0; bar.st = nullptr;
    if (MK_ONE_LAUNCH) bar = xcd_barrier_post((unsigned*)(ctl + CW_BAR), F.MISC + 8);
#define GRID_BAR() do { if (MK_ONE_LAUNCH) xcd_barrier(bar); } while (0)
    const int lo = args.ph_lo, hi = args.ph_hi;
#define IN(k) (lo <= (k) && (k) < hi)
#define BOTH(k) (IN(k) && IN((k) + 1))

    if (IN(0)) { PHASE_LANES(); for (int rp = 0; rp < args.rep[0]; ++rp) p0_prologue(F); if (BOTH(0)) GRID_BAR(); }

    if (IN(1)) {
        pg8::Gemm g{(const f16*)(ws + WS_XR), (const f16*)(ws + WS_WIN), M, NINP, D, D, D, 0, 1 << 30, 0};
        pg8::StaticOrder S; S.init(M, NINP, F.G, (int)blockIdx.x);
        pg8::EpiF16Row E{(f16*)(ws + WS_Y), NINP, (const float*)(ws + WS_SS0)};
        pg8::gemm_phase(F.lds, g, S, E);
        if (BOTH(1)) GRID_BAR();
    }

    if (IN(2)) { PHASE_LANES(); for (int rp = 0; rp < PROBE_REP2; ++rp) p2_post(F); if (BOTH(2)) GRID_BAR(); }

    if (IN(3)) {
        { pg8::Gemm g{(const f16*)(ws + WS_FLATA), (const f16*)(ws + WS_W1C), 8192, 1024, 512, D, D, 512, 16, (size_t)256 * D * 2, 512};
          pg8::StaticOrder S; S.init(8192, 1024, F.G, (int)blockIdx.x);
          pg8::EpiRawF32 E{(float*)(ws + WS_Y), 1024};
          pg8::gemm_phase(F.lds, g, S, E); }
        { pg8::Gemm g{(const f16*)(ws + WS_MIXED), (const f16*)(ws + WS_POOLT), M, 1024, 256, 1024, 256, 256, 1 << 30, 0};
          pg8::StaticOrder S; S.init(M, 1024, F.G, (int)((blockIdx.x + 128) % F.G));
          pg8::EpiF16<0> E{(f16*)(ws + WS_CAT), D, nullptr, 1 << 30, 0};
          pg8::gemm_phase(F.lds, g, S, E); }
        if (BOTH(3)) GRID_BAR();
    }

    if (IN(4)) { PHASE_LANES(); p4_compress2(F); if (BOTH(4)) GRID_BAR(); }

    if (IN(5)) { PHASE_LANES(); for (int rp = 0; rp < args.rep[5]; ++rp) p5_attention(F); if (BOTH(5)) GRID_BAR(); }

    if (IN(6)) {
        pg8::Gemm g{(const f16*)(ws + WS_CAT), (const f16*)(ws + WS_WOUT), M, D, D, D, D, 0, 1 << 30, 0};
        pg8::StaticOrder S; S.init(M, D, F.G, (int)blockIdx.x);
        pg8::EpiRes16 E{(f16*)(ws + WS_XR), (float*)(ws + WS_SS1)};
        pg8::gemm_phase(F.lds, g, S, E);
        if (BOTH(6)) GRID_BAR();
    }

    if (IN(7)) {
        { pg8::Gemm g{(const f16*)(ws + WS_XR), (const f16*)(ws + WS_WQ), M, D, D, D, D, 0, 1 << 30, 0};
          pg8::StaticOrder S; S.init(M, D, F.G, (int)blockIdx.x);
          pg8::EpiF16Row E{(f16*)(ws + WS_QP), D, (const float*)(ws + WS_SS1)};
          pg8::gemm_phase(F.lds, g, S, E); }
        { pg8::Gemm g{(const f16*)(ws + WS_P16), (const f16*)(ws + WS_WPJ), M, D, 256, 256, 256, 0, 1 << 30, 0};
          pg8::StaticOrder S; S.init(M, D, F.G, (int)blockIdx.x);
          pg8::EpiF16<0> E{(f16*)(ws + WS_PJ), D, nullptr, 1 << 30, 0};
          pg8::gemm_phase(F.lds, g, S, E); }
        PHASE_LANES();
        for (int rp = 0; rp < args.rep[7]; ++rp) p7_tables(F);
        if (BOTH(7)) GRID_BAR();
    }

    if (IN(8)) { PHASE_LANES(); p9a_topk(F); if (BOTH(8)) GRID_BAR(); }
    if (IN(9)) { PHASE_LANES(); if (PROBE_DUPU) p9b_upass(F, false); p9b_upass(F, false); if (BOTH(9)) GRID_BAR(); }
    if (IN(10)) { PHASE_LANES(); p9h_weights(F); if (BOTH(10)) GRID_BAR(); }
    if (IN(11)) { PHASE_LANES(); p9c_vpass(F); if (BOTH(11)) GRID_BAR(); }

    if (IN(12)) {
        pg8::Gemm g{(const f16*)(ws + WS_XR), (const f16*)(ws + WS_WG), M, D, D, D, D, 0, 1 << 30, 0};
        pg8::StaticOrder S; S.init(M, D, F.G, (int)blockIdx.x);
        pg8::EpiFinal E{(const f16*)(ws + WS_XR), (const f16*)(ws + WS_PJ), F.out, (const float*)(ws + WS_SS2)};
        pg8::gemm_phase(F.lds, g, S, E);
    }
#undef IN
#undef BOTH
}

extern "C" void kernel_launch(void* const* d_in, const int* in_sizes, int n_in, void* d_out, int out_size, void* d_ws, size_t ws_size, hipStream_t stream) {
    static int grid = 0;
    if (grid == 0) {
        if (n_in != 26 || out_size != M * D || ws_size < WS_END) { fprintf(stderr, "kernel_launch: unexpected sizes n_in %d out %d ws %zu\n", n_in, out_size, ws_size); grid = -1; return; }
        int dev = 0, cus = 0, per_cu = 0;
        if (hipGetDevice(&dev) != hipSuccess || hipDeviceGetAttribute(&cus, hipDeviceAttributeMultiprocessorCount, dev) != hipSuccess) { grid = -1; return; }
        if (hipFuncSetAttribute((const void*)fwd_kernel, hipFuncAttributeMaxDynamicSharedMemorySize, LDS_BYTES) != hipSuccess) { fprintf(stderr, "kernel_launch: hipFuncSetAttribute failed\n"); grid = -1; return; }
        if (hipOccupancyMaxActiveBlocksPerMultiprocessor(&per_cu, (const void*)fwd_kernel, NWAVES * 64, LDS_BYTES) != hipSuccess || per_cu < 1)
            fprintf(stderr, "kernel_launch: occupancy query reports %d\n", per_cu);
        (void)hipGetLastError();
        grid = cus;
    }
    if (grid < 0) return;
    (void)hipMemsetAsync((char*)d_ws + WS_CTL, 0, CTL_ZERO_BYTES, stream);
    Args a{};
    for (int i = 0; i < 16; ++i) a.rep[i] = 1;
    a.rep[5] = PROBE_REP5; a.rep[0] = PROBE_REP0; a.rep[7] = PROBE_REP7;
    for (int i = 0; i < 26; ++i) a.in[i] = (const float*)d_in[i];
    a.out = (float*)d_out; a.ws = (unsigned char*)d_ws;
    if (MK_ONE_LAUNCH) { a.ph_lo = 0; a.ph_hi = NPH; hipLaunchKernelGGL(fwd_kernel, dim3(grid), dim3(NWAVES * 64), LDS_BYTES, stream, a); }
    else for (int p = 0; p < NPH; ++p) { a.ph_lo = p; a.ph_hi = p + 1; hipLaunchKernelGGL(fwd_kernel, dim3(grid), dim3(NWAVES * 64), LDS_BYTES, stream, a); }
}
```

```cpp
#include <hip/hip_runtime.h>
#include <cstdio>
#include <cstdint>

#define PROBE_REP0 1
#define PROBE_REP2 1
#define PROBE_DUPU 0
#define PROBE_REP5 1
#define PROBE_REP7 1
#define PROBE_REP9 1
#ifndef MK_ONE_LAUNCH
#define MK_ONE_LAUNCH 1
#endif

#define GAS __attribute__((address_space(1)))
#define LAS __attribute__((address_space(3)))
typedef _Float16 f16;
typedef _Float16 f16x8 __attribute__((ext_vector_type(8)));
typedef _Float16 f16x4 __attribute__((ext_vector_type(4)));
typedef _Float16 f16x2 __attribute__((ext_vector_type(2)));
typedef float f32x2 __attribute__((ext_vector_type(2)));
typedef float f32x4 __attribute__((ext_vector_type(4)));
typedef float f32x16 __attribute__((ext_vector_type(16)));
typedef unsigned u32x2 __attribute__((ext_vector_type(2)));
typedef unsigned u32x4 __attribute__((ext_vector_type(4)));
typedef GAS unsigned gu32;
typedef _Float16 f16x32 __attribute__((ext_vector_type(32)));
typedef unsigned u32x6 __attribute__((ext_vector_type(6)));
#define RLX_AGENT __ATOMIC_RELAXED, __HIP_MEMORY_SCOPE_AGENT
#define LDS_WAIT() asm volatile("s_waitcnt lgkmcnt(0)" ::: "memory")
__device__ __forceinline__ float mul_np(float a, float b) { float o; asm("v_mul_f32 %0, %1, %2" : "=v"(o) : "v"(a), "v"(b)); return o; }
__device__ __forceinline__ float add_np(float a, float b) { float o; asm("v_add_f32 %0, %1, %2" : "=v"(o) : "v"(a), "v"(b)); return o; }
#define VM_WAIT() asm volatile("s_waitcnt vmcnt(0)" ::: "memory")

constexpr int BATCH = 8, SEQ = 2048, D = 2048, M = BATCH * SEQ;
constexpr int NIN = 3632, NINP = 3840;
constexpr int OFF_U = 0, OFF_Q = 1024, OFF_KC = 2048, OFF_VC = 2304, OFF_KS = 2560, OFF_VS = 2816, OFF_KW = 3072, OFF_VW = 3328, OFF_G = 3584;
constexpr int NCMP = 127, NCROWS = BATCH * NCMP * 4;
constexpr float RMS_EPS = 1e-6f;
constexpr float LOG2E = 1.4426950408889634f;

constexpr size_t MiB = 1u << 20;
constexpr size_t WS_CTL = 0, CTL_ZERO_BYTES = 1 * MiB;
constexpr size_t WS_WIN = 2 * MiB, WS_WOUT = 17 * MiB, WS_WQ = 25 * MiB, WS_WG = 33 * MiB, WS_WPJ = 41 * MiB, WS_W1C = 42 * MiB, WS_POOLT = 44 * MiB, WS_KEYS = 45 * MiB;
constexpr size_t WS_CBIAS = 46 * MiB, WS_GATES = 47 * MiB, WS_HC = 50 * MiB, WS_KCMP = 54 * MiB, WS_VCMPT = 54 * MiB + 512 * 1024, WS_P16 = 56 * MiB;
constexpr size_t WS_XN = 64 * MiB, WS_X8 = 64 * MiB;
constexpr float W8SCALE = 64.f;
constexpr size_t WS_Y = 128 * MiB, WS_QP = 128 * MiB, WS_PJ = 192 * MiB;
constexpr size_t WS_MIXED = 256 * MiB, WS_CAT = 288 * MiB, WS_KN = 352 * MiB, WS_VT = 368 * MiB, WS_FLATA = 384 * MiB;
constexpr size_t WS_U6 = 256 * MiB, WS_V6 = 288 * MiB, WS_SU = 320 * MiB, WS_SV = 321 * MiB;
constexpr size_t WS_LIDX = 322 * MiB, WS_LG = 330 * MiB, WS_SSP = 338 * MiB, WS_PD = 340 * MiB, WS_HW = 404 * MiB;
constexpr size_t SLICE6 = (size_t)16384 * 192;
constexpr size_t WS_XR = 416 * MiB;
constexpr size_t WS_SS0 = 768 * 1024, WS_SS1 = 256 * 1024, WS_SS2 = 512 * 1024;
constexpr size_t WS_QN = 480 * MiB;
constexpr size_t WS_END = 512 * MiB;
constexpr int CW_TMO = 0, CW_CODE = 1, CW_BAR = 4096;

constexpr int RING_BYTES = 131072;
constexpr int LDSCTL_OFF = RING_BYTES, MISC_OFF = LDSCTL_OFF + 320;
constexpr int LDS_BYTES = 147456;
constexpr int NWAVES = 8;

__device__ __forceinline__ unsigned pk_f16(float lo, float hi) { f16x2 v; v.x = (f16)lo; v.y = (f16)hi; return __builtin_bit_cast(unsigned, v); }
__device__ __forceinline__ unsigned pk_fp8(float a, float b, float c, float d) { int r = __builtin_amdgcn_cvt_pk_fp8_f32(a, b, 0, false); r = __builtin_amdgcn_cvt_pk_fp8_f32(c, d, r, true); return (unsigned)r; }
__device__ __forceinline__ long as_i64(unsigned lo, unsigned hi) { return (long)(((unsigned long long)hi << 32) | lo); }
__device__ __forceinline__ f16x2 ash2(unsigned u) { return __builtin_bit_cast(f16x2, u); }
template <int CTRL> __device__ __forceinline__ float dpp_f(float v) { return __int_as_float(__builtin_amdgcn_update_dpp(0, __float_as_int(v), CTRL, 0xF, 0xF, true)); }
__device__ __forceinline__ float rl_f(float v, int l) { return __int_as_float(__builtin_amdgcn_readlane(__float_as_int(v), l)); }
__device__ __forceinline__ float sum8(float v) { v += dpp_f<0x141>(v); v += dpp_f<0xB1>(v); v += dpp_f<0x4E>(v); return v; }
__device__ __forceinline__ float wave_sum(float v) { v = sum8(v); v += dpp_f<0x140>(v); return (rl_f(v, 0) + rl_f(v, 16)) + (rl_f(v, 32) + rl_f(v, 48)); }
__device__ __forceinline__ float wave_max(float v) { v = fmaxf(v, dpp_f<0x141>(v)); v = fmaxf(v, dpp_f<0xB1>(v)); v = fmaxf(v, dpp_f<0x4E>(v)); v = fmaxf(v, dpp_f<0x140>(v));
    return fmaxf(fmaxf(rl_f(v, 0), rl_f(v, 16)), fmaxf(rl_f(v, 32), rl_f(v, 48))); }

__device__ __forceinline__ unsigned other8u(unsigned x) { return (unsigned)__builtin_amdgcn_update_dpp(0, (int)x, 0x128, 0xF, 0xF, true); }
__device__ __forceinline__ unsigned other16u(unsigned x, bool b4) { const auto r = __builtin_amdgcn_permlane16_swap(x, x, false, false); return b4 ? r[0] : r[1]; }
__device__ __forceinline__ unsigned other32u(unsigned x, bool b5) { const auto r = __builtin_amdgcn_permlane32_swap(x, x, false, false); return b5 ? r[0] : r[1]; }
namespace pg8 {
constexpr int BM = 256, BK = 64, HALF = 128, HTB = HALF * BK * 2, STAGE_BYTES = 8 * HTB, NXCD = 8, WGM = 8;
__host__ __device__ __forceinline__ int lds_byte(int r, int c) { const int st = (r >> 4) * 2 + (c >> 5), rr = r & 15, cc = c & 31, ob = rr * 64 + cc * 2; return st * 1024 + (ob ^ (((ob >> 9) & 1) << 5)); }
__host__ __device__ __forceinline__ void stage_rc(int b, int& R, int& C) { const int st = b / 1024, sb = b % 1024, swz = sb ^ (((sb >> 9) & 1) << 5); R = (st >> 1) * 16 + swz / 64; C = (st & 1) * 32 + (swz % 64) / 2; }
__host__ __device__ __forceinline__ int perm32(int rho) { const int n = rho >> 4, i = rho & 15; return 8 * (i >> 2) + 4 * n + (i & 3); }

struct Unit { int pm, pn; };
struct Gemm { const void* A; const void* Bt; int M, N, K, lda, ldb; int a_pn_off; int b_pm_split; size_t b_split_off; int b_pn_k = 0; int esz = 2;
    __device__ __forceinline__ const char* aptr(const Unit& u) const { return (const char*)A + ((size_t)u.pm * BM * lda + (size_t)u.pn * a_pn_off) * esz; }
    __device__ __forceinline__ const char* bptr(const Unit& u) const { return (const char*)Bt + (b_pn_k ? (size_t)u.pn * b_pn_k * esz : (size_t)u.pn * BM * ldb * esz) + (u.pm >= b_pm_split ? b_split_off : (size_t)0); }
};
struct StaticOrder {
    int nM, nN, nwg, G, c;
    __host__ __device__ void init(int M_, int N_, int G_, int c_) { nM = M_ / BM; nN = N_ / BM; nwg = nM * nN; G = G_; c = c_; }
    __host__ __device__ bool next(int i, Unit& u) const {
        const long L = (long)i * G + c; if (L >= nwg) return false;
        int wgid = (int)L; { const int q = nwg / NXCD, r = nwg % NXCD, xcd = wgid % NXCD, off = wgid / NXCD; wgid = (xcd < r ? xcd * (q + 1) : r * (q + 1) + (xcd - r) * q) + off; }
        const int nig = WGM * nN, gid = wgid / nig, fm = gid * WGM, gsz = (nM - fm) < WGM ? (nM - fm) : WGM;
        u.pm = fm + ((wgid % nig) % gsz); u.pn = (wgid % nig) / gsz; return true;
    }
};

__device__ __forceinline__ f32x2 gelu_pk(f32x2 v) {
    const f32x2 av = __builtin_elementwise_abs(v), d = av * 0.2316418882f + 1.0f;
    f32x2 t; t.x = __builtin_amdgcn_rcpf(d.x); t.y = __builtin_amdgcn_rcpf(d.y);
    f32x2 q = t * 0.5307027145f + (-0.7265760135f); q = q * t + 0.7107068705f; q = q * t + (-0.142248368f); q = q * t + 0.127414796f; q = q * t;
    const f32x2 s = (v * v) * (-0.72134752044f);
    f32x2 e; e.x = __builtin_amdgcn_exp2f(s.x); e.y = __builtin_amdgcn_exp2f(s.y);
    const f32x2 m = v * (q * e), r = v - m;
    f32x2 o; o.x = v.x < 0.f ? m.x : r.x; o.y = v.y < 0.f ? m.y : r.y; return o;
}
__device__ __forceinline__ float gelu1(float v) { f32x2 r = gelu_pk((f32x2){v, v}); return r.x; }

template <int ACT> struct EpiF16 {
    static constexpr bool PERM = true;
    f16* O; int ldc; const float* bias; int bias_pm_split; int bias_split_off;
    __device__ __forceinline__ void operator()(const f32x4 (&acc)[2][2][4][2], const Unit& u, int wr, int wc, int fr, int fq) const {
        const int row0 = u.pm * BM + wr * 64 + fr; const int col0 = u.pn * BM + wc * 32 + 8 * fq;
        const float* bp = bias ? bias + (u.pm >= bias_pm_split ? bias_split_off : 0) : nullptr;
        f32x4 bv[2][2];
#pragma unroll
        for (int bj = 0; bj < 2; ++bj)
#pragma unroll
            for (int n = 0; n < 2; ++n) bv[bj][n] = bp ? *(const f32x4*)(bp + col0 + bj * HALF + 4 * n) : (f32x4){0.f, 0.f, 0.f, 0.f};
#pragma unroll
        for (int ai = 0; ai < 2; ++ai)
#pragma unroll
            for (int m = 0; m < 4; ++m) { f16* rowp = O + (size_t)(row0 + ai * HALF + m * 16) * ldc + col0;
#pragma unroll
                for (int bj = 0; bj < 2; ++bj) { f32x4 v0 = acc[ai][bj][m][0] + bv[bj][0], v1 = acc[ai][bj][m][1] + bv[bj][1];
                    if (ACT == 1) { f32x2 a = gelu_pk((f32x2){v0[0], v0[1]}), b = gelu_pk((f32x2){v0[2], v0[3]}), c = gelu_pk((f32x2){v1[0], v1[1]}), d = gelu_pk((f32x2){v1[2], v1[3]});
                        v0 = (f32x4){a.x, a.y, b.x, b.y}; v1 = (f32x4){c.x, c.y, d.x, d.y}; }
                    u32x4 w; w.x = pk_f16(v0[0], v0[1]); w.y = pk_f16(v0[2], v0[3]); w.z = pk_f16(v1[0], v1[1]); w.w = pk_f16(v1[2], v1[3]);
                    *(u32x4*)(rowp + bj * HALF) = w; } }
    }
};
struct EpiRawF32 {
    static constexpr bool PERM = false;
    float* C; int ldc;
    __device__ __forceinline__ void operator()(const f32x4 (&acc)[2][2][4][2], const Unit& u, int wr, int wc, int fr, int fq) const {
        const int row0 = u.pm * BM + wr * 64 + fr, col0 = u.pn * BM + wc * 32 + 4 * fq;
#pragma unroll
        for (int ai = 0; ai < 2; ++ai)
#pragma unroll
            for (int m = 0; m < 4; ++m) { float* rowp = C + (size_t)(row0 + ai * HALF + m * 16) * ldc + col0;
#pragma unroll
                for (int bj = 0; bj < 2; ++bj)
#pragma unroll
                    for (int n = 0; n < 2; ++n) *(f32x4*)(rowp + bj * HALF + n * 16) = acc[ai][bj][m][n]; }
    }
};
struct EpiRes16 {
    static constexpr bool PERM = true;
    f16* XR; float* SS;
    __device__ __forceinline__ void operator()(const f32x4 (&acc)[2][2][4][2], const Unit& u, int wr, int wc, int fr, int fq) const {
        const int row0 = u.pm * BM + wr * 64 + fr; const int col0 = u.pn * BM + wc * 32 + 8 * fq;
#pragma unroll
        for (int ai = 0; ai < 2; ++ai) {
            f16x8 xb[4][2];
#pragma unroll
            for (int m = 0; m < 4; ++m)
#pragma unroll
                for (int bj = 0; bj < 2; ++bj) xb[m][bj] = *(const f16x8*)(XR + (size_t)(row0 + ai * HALF + m * 16) * D + col0 + bj * HALF);
            asm volatile("" ::: "memory");
#pragma unroll
            for (int m = 0; m < 4; ++m) { const int row = row0 + ai * HALF + m * 16; const size_t off = (size_t)row * D + col0; float ss = 0.f;
#pragma unroll
                for (int bj = 0; bj < 2; ++bj) { const f16x8 xv = xb[m][bj];
                    f32x4 v0 = acc[ai][bj][m][0], v1 = acc[ai][bj][m][1];
                    v0[0] += (float)xv[0]; v0[1] += (float)xv[1]; v0[2] += (float)xv[2]; v0[3] += (float)xv[3]; v1[0] += (float)xv[4]; v1[1] += (float)xv[5]; v1[2] += (float)xv[6]; v1[3] += (float)xv[7];
                    ss += ((v0[0] * v0[0] + v0[1] * v0[1]) + (v0[2] * v0[2] + v0[3] * v0[3])) + ((v1[0] * v1[0] + v1[1] * v1[1]) + (v1[2] * v1[2] + v1[3] * v1[3]));
                    u32x4 o; o.x = pk_f16(v0[0], v0[1]); o.y = pk_f16(v0[2], v0[3]); o.z = pk_f16(v1[0], v1[1]); o.w = pk_f16(v1[2], v1[3]);
                    *(u32x4*)(XR + off + bj * HALF) = o; }
                ss += __shfl_xor(ss, 16); ss += __shfl_xor(ss, 32);
                if (fq == 0) atomicAdd(SS + row, ss); }
            asm volatile("" ::: "memory"); }
    }
};
struct EpiF16Row {
    static constexpr bool PERM = true;
    f16* O; int ldc; const float* SS;
    __device__ __forceinline__ void operator()(const f32x4 (&acc)[2][2][4][2], const Unit& u, int wr, int wc, int fr, int fq) const {
        const int row0 = u.pm * BM + wr * 64 + fr; const int col0 = u.pn * BM + wc * 32 + 8 * fq;
#pragma unroll
        for (int ai = 0; ai < 2; ++ai)
#pragma unroll
            for (int m = 0; m < 4; ++m) { const int row = row0 + ai * HALF + m * 16; f16* rowp = O + (size_t)row * ldc + col0;
                const float rs = 1.f / sqrtf(SS[row] * (1.f / D) + RMS_EPS);
#pragma unroll
                for (int bj = 0; bj < 2; ++bj) { const f32x4 v0 = acc[ai][bj][m][0] * rs, v1 = acc[ai][bj][m][1] * rs;
                    u32x4 o; o.x = pk_f16(v0[0], v0[1]); o.y = pk_f16(v0[2], v0[3]); o.z = pk_f16(v1[0], v1[1]); o.w = pk_f16(v1[2], v1[3]);
                    *(u32x4*)(rowp + bj * HALF) = o; } }
    }
};
struct EpiFinal {
    static constexpr bool PERM = true;
    const f16* XR; const f16* PJ; float* C; const float* SS; float as;
    __device__ __forceinline__ void operator()(const f32x4 (&acc)[2][2][4][2], const Unit& u, int wr, int wc, int fr, int fq) const {
        const int row0 = u.pm * BM + wr * 64 + fr; const int col0 = u.pn * BM + wc * 32 + 8 * fq;
#pragma unroll
        for (int ai = 0; ai < 2; ++ai)
#pragma unroll
            for (int mh = 0; mh < 2; ++mh) {
                f16x8 xb[2][2], pb[2][2]; float ssv[2];
#pragma unroll
                for (int mm = 0; mm < 2; ++mm) { const int row = row0 + ai * HALF + (2 * mh + mm) * 16; ssv[mm] = SS[row];
#pragma unroll
                    for (int bj = 0; bj < 2; ++bj) { xb[mm][bj] = *(const f16x8*)(XR + (size_t)row * D + col0 + bj * HALF); pb[mm][bj] = *(const f16x8*)(PJ + (size_t)row * D + col0 + bj * HALF); } }
                asm volatile("" ::: "memory");
#pragma unroll
                for (int mm = 0; mm < 2; ++mm) { const int m = 2 * mh + mm; const int row = row0 + ai * HALF + m * 16; const size_t off = (size_t)row * D + col0;
                    const float nrs = -LOG2E * as / sqrtf(ssv[mm] * (1.f / D) + RMS_EPS);
#pragma unroll
                    for (int bj = 0; bj < 2; ++bj) { const f16x8 xv = xb[mm][bj], pv = pb[mm][bj];
                        const f32x4 a0 = acc[ai][bj][m][0], a1 = acc[ai][bj][m][1]; f32x4 o0, o1;
#pragma unroll
                        for (int j = 0; j < 4; ++j) { o0[j] = (float)xv[j] + (float)pv[j] * __builtin_amdgcn_rcpf(1.0f + __builtin_amdgcn_exp2f(nrs * a0[j]));
                            o1[j] = (float)xv[4 + j] + (float)pv[4 + j] * __builtin_amdgcn_rcpf(1.0f + __builtin_amdgcn_exp2f(nrs * a1[j])); }
                        *(f32x4*)(C + off + bj * HALF) = o0; *(f32x4*)(C + off + bj * HALF + 4) = o1; } }
                asm volatile("" ::: "memory"); }
    }
};
template <int MODE> struct EpiF32 {
    static constexpr bool PERM = false;
    const float* base; float* C; int ldc; const f16* pj; const float* ssp;
    __device__ __forceinline__ void operator()(const f32x4 (&acc)[2][2][4][2], const Unit& u, int wr, int wc, int fr, int fq) const {
        const int row0 = u.pm * BM + wr * 64 + fr, col0 = u.pn * BM + wc * 32 + 4 * fq;
#pragma unroll
        for (int ai = 0; ai < 2; ++ai)
#pragma unroll
            for (int m = 0; m < 4; ++m) { const size_t off = (size_t)(row0 + ai * HALF + m * 16) * ldc + col0;
                float nrs = -LOG2E;
                if (MODE == 1) { const f32x4 s0 = *(const f32x4*)(ssp + (size_t)(row0 + ai * HALF + m * 16) * 8), s1 = *(const f32x4*)(ssp + (size_t)(row0 + ai * HALF + m * 16) * 8 + 4);
                    nrs = -LOG2E / sqrtf((((s0.x + s0.y) + (s0.z + s0.w)) + ((s1.x + s1.y) + (s1.z + s1.w))) * (1.f / D) + RMS_EPS); }
#pragma unroll
                for (int bj = 0; bj < 2; ++bj)
#pragma unroll
                    for (int n = 0; n < 2; ++n) { const size_t o2 = off + bj * HALF + n * 16; const f32x4 bs = *(const f32x4*)(base + o2); f32x4 a = acc[ai][bj][m][n];
                        if (MODE == 1) { const f16x4 pv = *(const f16x4*)(pj + o2);
#pragma unroll
                            for (int j = 0; j < 4; ++j) a[j] = (float)pv[j] * __builtin_amdgcn_rcpf(1.0f + __builtin_amdgcn_exp2f(nrs * a[j])); }
                        *(f32x4*)(C + o2) = bs + a; }
                asm volatile("" ::: "memory"); }
    }
};

typedef int i32x4v __attribute__((ext_vector_type(4)));
typedef int i32x8v __attribute__((ext_vector_type(8)));
__device__ __forceinline__ i32x8v cat16(const f16x8 a, const f16x8 b) { const i32x4v x = __builtin_bit_cast(i32x4v, a), y = __builtin_bit_cast(i32x4v, b); return __builtin_shufflevector(x, y, 0, 1, 2, 3, 4, 5, 6, 7); }
__device__ __forceinline__ f16x8 half16(const i32x8v& v, int k) { const i32x4v h = k ? __builtin_shufflevector(v, v, 4, 5, 6, 7) : __builtin_shufflevector(v, v, 0, 1, 2, 3); return __builtin_bit_cast(f16x8, h); }
template <class Epi, class Sched, bool F8 = false>
__device__ __forceinline__ void gemm_phase(LAS unsigned char* lds, const Gemm g, const Sched& S, const Epi& E) {
    int tid = threadIdx.x; asm volatile("" : "+v"(tid));
    const int wid = __builtin_amdgcn_readfirstlane(tid >> 6), lane = tid & 63, wr = wid >> 2, wc = wid & 3, fr = lane & 15, fq = lane >> 4;
    const int K = g.K, nt = K * g.esz / (BK * 2);
    unsigned voffA[2], voffB[2];
#pragma unroll
    for (int i = 0; i < 2; ++i) { int R, C; stage_rc(tid * 16 + i * 8192, R, C); const int Rb = Epi::PERM ? ((R & ~31) + perm32(R & 31)) : R;
        voffA[i] = (unsigned)(R * g.lda * g.esz + C * 2); voffB[i] = (unsigned)(Rb * g.ldb * g.esz + C * 2); }
    const size_t kstep = (size_t)(BK * 2);
    const size_t hstepA = (size_t)HALF * g.lda * g.esz, hstepB = (size_t)HALF * g.ldb * g.esz;
    const unsigned ldsw = (unsigned)wid * 1024u;
    const int aoff = lds_byte(wr * 64 + fr, fq * 8), boff = lds_byte(wc * 32 + fr, fq * 8);
#define PG8_SA(b, h) (((b) * 2 + (h)) * HTB)
#define PG8_SB(b, h) ((4 + (b) * 2 + (h)) * HTB)
#define PG8_STAGE(bufoff, gbase, voff) do { _Pragma("unroll") for (int _i = 0; _i < 2; ++_i) \
        __builtin_amdgcn_global_load_lds((const unsigned*)((const char*)(gbase) + (voff)[_i]), (LAS unsigned*)(lds + (bufoff) + ldsw + _i * 8192), 16, 0, 0); } while (0)
#define PG8_LDA(dst, b, h) do { _Pragma("unroll") for (int m = 0; m < 4; ++m) dst[m] = cat16(*(const LAS f16x8*)(lds + PG8_SA(b, h) + aoff + m * 2048), *(const LAS f16x8*)(lds + PG8_SA(b, h) + aoff + m * 2048 + 1024)); } while (0)
#define PG8_LDB(dst, b, h) do { _Pragma("unroll") for (int n = 0; n < 2; ++n) dst[n] = cat16(*(const LAS f16x8*)(lds + PG8_SB(b, h) + boff + n * 2048), *(const LAS f16x8*)(lds + PG8_SB(b, h) + boff + n * 2048 + 1024)); } while (0)
#define PG8_MMA(ai, bj, At, Bt) do { __builtin_amdgcn_s_setprio(1); \
        if (F8) { _Pragma("unroll") for (int m = 0; m < 4; ++m) _Pragma("unroll") for (int n = 0; n < 2; ++n) \
            asm volatile("v_mfma_scale_f32_16x16x128_f8f6f4 %0, %1, %2, %0, %3, %3 op_sel_hi:[0,0,0]" : "+v"(acc[ai][bj][m][n]) : "v"(Bt[n]), "v"(At[m]), "v"(0x7F7F7F7F)); } \
        else { _Pragma("unroll") for (int m = 0; m < 4; ++m) _Pragma("unroll") for (int n = 0; n < 2; ++n) _Pragma("unroll") for (int k = 0; k < 2; ++k) \
            acc[ai][bj][m][n] = __builtin_amdgcn_mfma_f32_16x16x32_f16(half16(Bt[n], k), half16(At[m], k), acc[ai][bj][m][n], 0, 0, 0); } \
        __builtin_amdgcn_s_setprio(0); } while (0)
#define PG8_WAIT_V(n) asm volatile("s_waitcnt vmcnt(" #n ")" ::: "memory")
#define PG8_WAIT_L(n) asm volatile("s_waitcnt lgkmcnt(" #n ")" ::: "memory")
#define PG8_BAR __builtin_amdgcn_s_barrier()
#define PG8_SCHED __builtin_amdgcn_sched_barrier(0)
    Unit cur, nxt; int ui = 0;
    if (!S.next(0, cur)) return;
    f32x4 acc[2][2][4][2];
#pragma unroll
    for (int a = 0; a < 2; ++a)
#pragma unroll
        for (int b = 0; b < 2; ++b)
#pragma unroll
            for (int m = 0; m < 4; ++m)
#pragma unroll
                for (int n = 0; n < 2; ++n) acc[a][b][m][n] = (f32x4){0.f, 0.f, 0.f, 0.f};
    i32x8v At[4], B0[2], B1[2];
    const char* cA = g.aptr(cur); const char* cB = g.bptr(cur);
    PG8_STAGE(PG8_SB(0, 0), cB, voffB); PG8_STAGE(PG8_SB(0, 1), cB + hstepB, voffB); PG8_STAGE(PG8_SA(0, 0), cA, voffA); PG8_STAGE(PG8_SA(0, 1), cA + hstepA, voffA);
    if (wr == 1) PG8_BAR;
    PG8_WAIT_V(2); PG8_BAR;
    PG8_STAGE(PG8_SB(1, 0), cB + kstep, voffB); PG8_STAGE(PG8_SA(1, 0), cA + kstep, voffA); PG8_STAGE(PG8_SB(1, 1), cB + hstepB + kstep, voffB);
    PG8_WAIT_V(6); PG8_BAR;
    for (;;) {
        const bool has_next = S.next(ui + 1, nxt);
        const char* nA = has_next ? g.aptr(nxt) : cA; const char* nB = has_next ? g.bptr(nxt) : cB;
#pragma clang loop unroll(disable)
        for (int t = 0; t < nt; t += 2) {
            const bool last = (t == nt - 2);
            const char* a1 = cA + (size_t)(t + 1) * kstep;
            const char* a2 = last ? nA : cA + (size_t)(t + 2) * kstep; const char* b2 = last ? nB : cB + (size_t)(t + 2) * kstep;
            const char* a3 = a2 + kstep; const char* b3 = b2 + kstep;
            PG8_LDB(B0, 0, 0); PG8_LDB(B1, 0, 1); PG8_SCHED; PG8_LDA(At, 0, 0); PG8_STAGE(PG8_SA(1, 1), a1 + hstepA, voffA);
            PG8_WAIT_V(8); PG8_WAIT_L(0); PG8_BAR; PG8_MMA(0, 0, At, B0); PG8_MMA(0, 1, At, B1); PG8_BAR; PG8_SCHED;
            PG8_LDA(At, 0, 1); PG8_STAGE(PG8_SB(0, 0), b2, voffB); PG8_STAGE(PG8_SB(0, 1), b2 + hstepB, voffB); PG8_STAGE(PG8_SA(0, 0), a2, voffA);
            PG8_WAIT_V(8); PG8_WAIT_L(0); PG8_BAR; PG8_MMA(1, 0, At, B0); PG8_MMA(1, 1, At, B1); PG8_BAR; PG8_SCHED;
            PG8_LDB(B0, 1, 0); PG8_LDB(B1, 1, 1); PG8_SCHED; PG8_LDA(At, 1, 0); PG8_STAGE(PG8_SA(0, 1), a2 + hstepA, voffA);
            PG8_WAIT_V(8); PG8_WAIT_L(0); PG8_BAR; PG8_MMA(0, 0, At, B0); PG8_MMA(0, 1, At, B1); PG8_BAR; PG8_SCHED;
            PG8_LDA(At, 1, 1); PG8_STAGE(PG8_SB(1, 0), b3, voffB); PG8_STAGE(PG8_SB(1, 1), b3 + hstepB, voffB); PG8_STAGE(PG8_SA(1, 0), a3, voffA);
            PG8_WAIT_V(8); PG8_WAIT_L(0); PG8_BAR; PG8_MMA(1, 0, At, B0); PG8_MMA(1, 1, At, B1); PG8_BAR; PG8_SCHED;
        }
        if (F8) asm volatile("s_nop 15\n\ts_nop 15" ::: "memory");
        if (wr == 0) PG8_BAR;
        E(acc, cur, wr, wc, fr, fq);
        if (!has_next) break;
#pragma unroll
        for (int a = 0; a < 2; ++a)
#pragma unroll
            for (int b = 0; b < 2; ++b)
#pragma unroll
                for (int m = 0; m < 4; ++m)
#pragma unroll
                    for (int n = 0; n < 2; ++n) acc[a][b][m][n] = (f32x4){0.f, 0.f, 0.f, 0.f};
        cur = nxt; cA = nA; cB = nB; ++ui;
        if (wr == 1) PG8_BAR;
    }
    PG8_WAIT_V(0);
    PG8_BAR;
#undef PG8_SA
#undef PG8_SB
#undef PG8_STAGE
#undef PG8_LDA
#undef PG8_LDB
#undef PG8_MMA
#undef PG8_WAIT_V
#undef PG8_WAIT_L
#undef PG8_BAR
#undef PG8_SCHED
}
}

#define XB_TMO      128
#define XB_XCNT(j)  (256  + 64 * (j))
#define XB_XSUB(j)  (1280 + 64 * (j))
#define XB_XGEN(j)  (2304 + 64 * (j))
#define XB_TOP      3328
#define XB_TOPGEN   3392
#define XCD_BAR_WORDS 3456
#define XB_SPIN_CAP (1u << 18)
__device__ __forceinline__ unsigned xb_ld(unsigned* p)              { return __hip_atomic_load(p, __ATOMIC_RELAXED, __HIP_MEMORY_SCOPE_AGENT); }
__device__ __forceinline__ unsigned xb_add(unsigned* p, unsigned v) { return __hip_atomic_fetch_add(p, v, __ATOMIC_RELAXED, __HIP_MEMORY_SCOPE_AGENT); }
__device__ __forceinline__ unsigned xb_xcc_id() { return (unsigned)__builtin_amdgcn_s_getreg((3 << 11) | 20) & 0xFu; }
#define XB_SPIN(cond, bar) do { unsigned _sp = 0; while (cond) { __builtin_amdgcn_s_sleep(1); \
    if ((++_sp & 255u) == 0u) { if (xb_ld(&(bar)[XB_TMO])) break; if (_sp > XB_SPIN_CAP) { atomicAdd(&(bar)[XB_TMO], 1u); break; } } } } while (0)
struct XcdBarrier { unsigned* bar; unsigned x; volatile LAS unsigned* st; };
__device__ __forceinline__ XcdBarrier xcd_barrier_post(unsigned* bar, volatile LAS unsigned* st) {
    XcdBarrier b; b.bar = bar; b.x = xb_xcc_id(); b.st = st;
    if (threadIdx.x == 0) (void)xb_add(&bar[XB_XCNT(b.x)], 1u);
    return b;
}
__device__ __forceinline__ void xcd_barrier_complete(unsigned* bar, unsigned x, unsigned& nloc, unsigned& nx) {
    const unsigned G = gridDim.x * gridDim.y * gridDim.z;
    unsigned sum, cnt, mine, sp = 0u;
    for (;;) {
        sum = 0u; cnt = 0u; mine = 0u;
#pragma unroll
        for (unsigned j = 0; j < 16; ++j) { const unsigned c = xb_ld(&bar[XB_XCNT(j)]); sum += c; cnt += (c > 0u) ? 1u : 0u; mine = (j == x) ? c : mine; }
        if (sum == G) break;
        __builtin_amdgcn_s_sleep(1);
        if ((++sp & 255u) == 0u) { if (xb_ld(&bar[XB_TMO])) break; if (sp > XB_SPIN_CAP) { atomicAdd(&bar[XB_TMO], 1u); break; } }
    }
    nloc = mine > 0u ? mine : 1u; nx = cnt > 0u ? cnt : 1u;
}
__device__ __forceinline__ void xcd_barrier(const XcdBarrier& b) {
    asm volatile("s_waitcnt vmcnt(0)" ::: "memory");
    __syncthreads();
    if (threadIdx.x == 0) {
        unsigned* bar = b.bar;
        __builtin_amdgcn_s_waitcnt(0);
        unsigned nloc = b.st[0], nx = b.st[1];
        if (nloc == 0u) { xcd_barrier_complete(bar, b.x, nloc, nx); b.st[0] = nloc; b.st[1] = nx; }
        const unsigned old = xb_add(&bar[XB_XSUB(b.x)], 1u);
        const unsigned gen = old / nloc;
        if (old + 1u == (gen + 1u) * nloc) {
            __builtin_amdgcn_fence(__ATOMIC_RELEASE, "agent");
            asm volatile("s_waitcnt vmcnt(0)" ::: "memory");
            const unsigned og = xb_add(&bar[XB_TOP], 1u);
            const unsigned tg = og / nx;
            if (og + 1u == (tg + 1u) * nx) xb_add(&bar[XB_TOPGEN], 1u);
            else XB_SPIN(xb_ld(&bar[XB_TOPGEN]) == tg, bar);
            __builtin_amdgcn_fence(__ATOMIC_ACQUIRE, "agent");
            xb_add(&bar[XB_XGEN(b.x)], 1u);
            asm volatile("s_waitcnt vmcnt(0)" ::: "memory");
        } else {
            XB_SPIN(xb_ld(&bar[XB_XGEN(b.x)]) == gen, bar);
            __builtin_amdgcn_fence(__ATOMIC_ACQUIRE, "agent");
            asm volatile("s_waitcnt vmcnt(0)" ::: "memory");
        }
    }
    __syncthreads();
}

struct Frame {
    LAS unsigned char* lds;
    volatile LAS unsigned* MISC;
    int tid, lane, wave;
    int vcu, G;
    const float* in[26];
    float* out;
    unsigned char* ws;
};
enum { I_X = 0, I_P, I_RELB, I_MIXNW, I_WIN, I_QNW, I_KNW, I_CKPOS, I_CKW1, I_CKB1, I_CKW2, I_CVPOS, I_CVW1, I_CVB1, I_CVW2, I_POOLW, I_POOLS, I_WOUT, I_FFNNW, I_PWQ, I_PKEYS, I_PU, I_PV, I_PLENW, I_PLEWG, I_PLEWP };

__device__ __forceinline__ void p0_transpose_item(const float* W, int K, int N, int Npad, const float* colscale, f16* WT, LAS float* scr, int item, int lane, const float* kscale = nullptr, bool f8 = false, float wscale = 1.f) {
    const int nblk = Npad / 32, kb = item / nblk, nb = item % nblk, k0 = 64 * kb, n0 = 32 * nb;
    const int nn = n0 + (lane & 31); const bool ok = nn < N;
#pragma unroll
    for (int hgrp = 0; hgrp < 2; ++hgrp) { float wv[16];
#pragma unroll
        for (int i = 0; i < 16; ++i) { const int kk = 2 * (16 * hgrp + i) + (lane >> 5); wv[i] = ok ? W[(size_t)(k0 + kk) * N + nn] : 0.f; }
        if (kscale) {
#pragma unroll
            for (int i = 0; i < 16; ++i) wv[i] *= kscale[k0 + 2 * (16 * hgrp + i) + (lane >> 5)]; }
#pragma unroll
        for (int i = 0; i < 16; ++i) { const int kk = 2 * (16 * hgrp + i) + (lane >> 5); scr[kk * 33 + (lane & 31)] = wv[i]; }
        asm volatile("" ::: "memory"); }
    LDS_WAIT(); asm volatile("" ::: "memory");
    const int c = lane & 7;
#pragma unroll
    for (int j = 0; j < 4; ++j) { const int n = (lane >> 3) + 8 * j; const LAS float* s = scr + (8 * c) * 33 + n; const float sc = (colscale && n0 + n < N) ? colscale[n0 + n] : 1.f;
        if (f8) { const float s8 = sc * wscale; u32x2 o; o.x = pk_fp8(s[0 * 33] * s8, s[1 * 33] * s8, s[2 * 33] * s8, s[3 * 33] * s8); o.y = pk_fp8(s[4 * 33] * s8, s[5 * 33] * s8, s[6 * 33] * s8, s[7 * 33] * s8);
            *(GAS u32x2*)((unsigned char*)WT + (size_t)(n0 + n) * K + k0 + 8 * c) = o; }
        else { u32x4 o; o.x = pk_f16(s[0 * 33] * sc, s[1 * 33] * sc); o.y = pk_f16(s[2 * 33] * sc, s[3 * 33] * sc); o.z = pk_f16(s[4 * 33] * sc, s[5 * 33] * sc); o.w = pk_f16(s[6 * 33] * sc, s[7 * 33] * sc);
            *(GAS u32x4*)(WT + (size_t)(n0 + n) * K + k0 + 8 * c) = o; } }
    LDS_WAIT(); asm volatile("" ::: "memory");
}
__device__ __forceinline__ void rms_row_to_f16(const float* xrow, const float* w, f16* orow, int lane, f16* x16row = nullptr) {
    const GAS f32x4* xr = (const GAS f32x4*)xrow + lane; const GAS f32x4* wr = (const GAS f32x4*)w + lane;
    f32x4 v[8]; float s = 0.f;
#pragma unroll
    for (int j = 0; j < 8; ++j) { v[j] = xr[64 * j]; s += (v[j].x * v[j].x + v[j].y * v[j].y) + (v[j].z * v[j].z + v[j].w * v[j].w); }
    const float rstd = 1.f / sqrtf(wave_sum(s) * (1.f / D) + RMS_EPS);
    GAS u32x2* o8 = (GAS u32x2*)orow + lane;
#pragma unroll
    for (int j = 0; j < 8; ++j) { const f32x4 g = wr[64 * j]; u32x2 o; o.x = pk_f16(v[j].x * rstd * g.x, v[j].y * rstd * g.y); o.y = pk_f16(v[j].z * rstd * g.z, v[j].w * rstd * g.w); o8[64 * j] = o; }
    if (x16row) { GAS u32x2* x8 = (GAS u32x2*)x16row + lane;
#pragma unroll
        for (int j = 0; j < 8; ++j) { u32x2 o; o.x = pk_f16(v[j].x, v[j].y); o.y = pk_f16(v[j].z, v[j].w); x8[64 * j] = o; } }
}
__device__ __forceinline__ void rms_2rows_to_f16(const float* x0, const float* x1, const float* w, f16* o0, f16* o1, f16* h0, f16* h1, int lane) {
    const GAS f32x4* xa = (const GAS f32x4*)x0 + lane; const GAS f32x4* xb = (const GAS f32x4*)x1 + lane; const GAS f32x4* wr = (const GAS f32x4*)w + lane;
    f32x4 va[8], vb[8]; float sa = 0.f, sb = 0.f;
#pragma unroll
    for (int j = 0; j < 8; ++j) { va[j] = __builtin_nontemporal_load(xa + 64 * j); vb[j] = __builtin_nontemporal_load(xb + 64 * j); }
#pragma unroll
    for (int j = 0; j < 8; ++j) { sa += (va[j].x * va[j].x + va[j].y * va[j].y) + (va[j].z * va[j].z + va[j].w * va[j].w); sb += (vb[j].x * vb[j].x + vb[j].y * vb[j].y) + (vb[j].z * vb[j].z + vb[j].w * vb[j].w); }
    const float ra = 1.f / sqrtf(wave_sum(sa) * (1.f / D) + RMS_EPS), rb = 1.f / sqrtf(wave_sum(sb) * (1.f / D) + RMS_EPS);
    GAS u32x2* pa = (GAS u32x2*)o0 + lane; GAS u32x2* pb = (GAS u32x2*)o1 + lane; GAS u32x2* qa = (GAS u32x2*)h0 + lane; GAS u32x2* qb = (GAS u32x2*)h1 + lane;
#pragma unroll
    for (int j = 0; j < 8; ++j) { const f32x4 g = wr[64 * j]; u32x2 o;
        o.x = pk_f16(va[j].x * ra * g.x, va[j].y * ra * g.y); o.y = pk_f16(va[j].z * ra * g.z, va[j].w * ra * g.w); pa[64 * j] = o;
        o.x = pk_f16(vb[j].x * rb * g.x, vb[j].y * rb * g.y); o.y = pk_f16(vb[j].z * rb * g.z, vb[j].w * rb * g.w); pb[64 * j] = o;
        o.x = pk_f16(va[j].x, va[j].y); o.y = pk_f16(va[j].z, va[j].w); qa[64 * j] = o;
        o.x = pk_f16(vb[j].x, vb[j].y); o.y = pk_f16(vb[j].z, vb[j].w); qb[64 * j] = o; }
}
__device__ __forceinline__ void x16_2rows(const float* x0, const float* x1, f16* h0, f16* h1, float* ss0, float* ss1, int lane) {
    const GAS f32x4* xa = (const GAS f32x4*)x0 + lane; const GAS f32x4* xb = (const GAS f32x4*)x1 + lane;
    f32x4 va[8], vb[8]; float sa = 0.f, sb = 0.f;
#pragma unroll
    for (int j = 0; j < 8; ++j) { va[j] = __builtin_nontemporal_load(xa + 64 * j); vb[j] = __builtin_nontemporal_load(xb + 64 * j); }
    GAS u32x2* qa = (GAS u32x2*)h0 + lane; GAS u32x2* qb = (GAS u32x2*)h1 + lane;
#pragma unroll
    for (int j = 0; j < 8; ++j) { sa += (va[j].x * va[j].x + va[j].y * va[j].y) + (va[j].z * va[j].z + va[j].w * va[j].w); sb += (vb[j].x * vb[j].x + vb[j].y * vb[j].y) + (vb[j].z * vb[j].z + vb[j].w * vb[j].w);
        u32x2 o; o.x = pk_f16(va[j].x, va[j].y); o.y = pk_f16(va[j].z, va[j].w); qa[64 * j] = o;
        o.x = pk_f16(vb[j].x, vb[j].y); o.y = pk_f16(vb[j].z, vb[j].w); qb[64 * j] = o; }
    sa = wave_sum(sa); sb = wave_sum(sb);
    if (lane == 0) { *ss0 = sa; *ss1 = sb; }
}
__device__ __forceinline__ void cvt_f32_f16(Frame& F, const float* src, f16* dst, size_t n) {
    const size_t gt = (size_t)F.vcu * 512 + F.tid, GT = (size_t)F.G * 512;
    for (size_t i = gt; i < n / 8; i += GT) { const f32x4 a = *(const GAS f32x4*)(src + i * 8), b = *(const GAS f32x4*)(src + i * 8 + 4);
        u32x4 o; o.x = pk_f16(a.x, a.y); o.y = pk_f16(a.z, a.w); o.z = pk_f16(b.x, b.y); o.w = pk_f16(b.z, b.w); *(GAS u32x4*)(dst + i * 8) = o; }
}

__device__ __forceinline__ void p0_prologue(Frame& F) {
    LAS float* scr = (LAS float*)(F.lds + F.wave * 16384);
    const int gw = F.vcu * NWAVES + F.wave, NGW = F.G * NWAVES;
    unsigned char* ws = F.ws;
    constexpr int I_IN = (D / 64) * (NINP / 32), I_SQ = (D / 64) * (D / 32), I_PJ = (256 / 64) * (D / 32), I_C1 = (D / 64) * (256 / 32), I_PL = (256 / 64) * (256 / 32);
    constexpr int NITEMS = I_IN + 3 * I_SQ + I_PJ + 2 * I_C1 + 4 * I_PL;
    for (int it = gw; it < NITEMS; it += NGW) {
        int r = it;
        if (r < I_IN) { p0_transpose_item(F.in[I_WIN], D, NIN, NINP, nullptr, (f16*)(ws + WS_WIN), scr, r, F.lane, F.in[I_MIXNW]); continue; } r -= I_IN;
        if (r < I_SQ) { p0_transpose_item(F.in[I_WOUT], D, D, D, nullptr, (f16*)(ws + WS_WOUT), scr, r, F.lane); continue; } r -= I_SQ;
        if (r < I_SQ) { p0_transpose_item(F.in[I_PWQ], D, D, D, nullptr, (f16*)(ws + WS_WQ), scr, r, F.lane, F.in[I_FFNNW]); continue; } r -= I_SQ;
        if (r < I_SQ) { p0_transpose_item(F.in[I_PLEWG], D, D, D, nullptr, (f16*)(ws + WS_WG), scr, r, F.lane, F.in[I_PLENW], true, W8SCALE); continue; } r -= I_SQ;
        if (r < I_PJ) { p0_transpose_item(F.in[I_PLEWP], 256, D, D, nullptr, (f16*)(ws + WS_WPJ), scr, r, F.lane); continue; } r -= I_PJ;
        if (r < I_C1) { p0_transpose_item(F.in[I_CKW1], D, 256, 256, nullptr, (f16*)(ws + WS_W1C), scr, r, F.lane); continue; } r -= I_C1;
        if (r < I_C1) { p0_transpose_item(F.in[I_CVW1], D, 256, 256, nullptr, (f16*)(ws + WS_W1C) + 256 * D, scr, r, F.lane); continue; } r -= I_C1;
        { const int g = r / I_PL; r -= g * I_PL;
          p0_transpose_item(F.in[I_POOLW] + (size_t)g * 65536, 256, 256, 256, F.in[I_POOLS] + g * 256, (f16*)(ws + WS_POOLT) + (size_t)g * 65536, scr, r, F.lane); }
    }
    { float* SS0 = (float*)(ws + WS_SS0); f16* XR = (f16*)(ws + WS_XR);
      for (int m = gw; m < M; m += 2 * NGW) { const int m2 = m + NGW < M ? m + NGW : m;
          x16_2rows(F.in[I_X] + (size_t)m * D, F.in[I_X] + (size_t)m2 * D, XR + (size_t)m * D, XR + (size_t)m2 * D, SS0 + m, SS0 + m2, F.lane); } }
    cvt_f32_f16(F, F.in[I_P], (f16*)(ws + WS_P16), (size_t)M * 256);
    cvt_f32_f16(F, F.in[I_PKEYS], (f16*)(ws + WS_KEYS), (size_t)8 * 2 * 128 * 128);
    for (int task = gw; task < 512; task += NGW) { const int mat = task >> 8, n = task & 255;
        const float* pos = F.in[mat ? I_CVPOS : I_CKPOS]; const float* w1 = F.in[mat ? I_CVW1 : I_CKW1]; float s = 0.f;
#pragma unroll
        for (int i = 0; i < 32; ++i) { const int k = F.lane + 64 * i; s += pos[k] * w1[(size_t)k * 256 + n]; }
        s = wave_sum(s);
        if (F.lane == 0) ((float*)(ws + WS_CBIAS))[task] = s + F.in[mat ? I_CVB1 : I_CKB1][n]; }
}

template <int W> __device__ __forceinline__ void pool_mix_tile(const f16* up, f16* mp, size_t mb, int s0) {
    f16x2 prev[16], cur[16]; f32x2 sum = {0.f, 0.f};
#pragma unroll
    for (int i = 0; i < 16; ++i) { const int sp = s0 - 16 + i; prev[i] = sp >= 0 ? *(const GAS f16x2*)(up + (mb + sp) * NINP) : (f16x2){(f16)0.f, (f16)0.f}; }
#pragma unroll
    for (int i = 16 - W; i < 16; ++i) { sum.x += (float)prev[i].x; sum.y += (float)prev[i].y; }
#pragma unroll 1
    for (int blk = 0; blk < 4; ++blk) { const int sb = s0 + blk * 16;
#pragma unroll
        for (int i = 0; i < 16; ++i) cur[i] = *(const GAS f16x2*)(up + (mb + sb + i) * NINP);
#pragma unroll
        for (int i = 0; i < 16; ++i) { const int s = sb + i; const f16x2 o = (i - W >= 0) ? cur[(i - W >= 0) ? i - W : 0] : prev[(i - W >= 0) ? 0 : 16 + i - W];
            sum.x += (float)cur[i].x - (float)o.x; sum.y += (float)cur[i].y - (float)o.y;
            const float ic = 1.f / (float)(s + 1 < W ? s + 1 : W);
            *(GAS unsigned*)(mp + (mb + s) * 1024) = pk_f16(sum.x * ic - (float)cur[i].x, sum.y * ic - (float)cur[i].y); }
#pragma unroll
        for (int i = 0; i < 16; ++i) prev[i] = cur[i]; }
}
__device__ __forceinline__ void p2_post(Frame& F) {
    unsigned char* ws = F.ws;
    f16* Y = (f16*)(ws + WS_Y);
    const float* qnw = F.in[I_QNW]; const float* knw = F.in[I_KNW];
    LAS f16* vl = (LAS f16*)F.lds;
    constexpr int VLP = 264;
    for (int tt = F.vcu; tt < M / 64; tt += F.G) {
        const int b = tt >> 5, s0 = (tt & 31) * 64, m0 = tt * 64;
        for (int tk = F.wave; tk < 64; tk += NWAVES) {
            const int m = m0 + tk, s = s0 + tk; f16* yr = Y + (size_t)m * NINP;
#pragma unroll
            for (int pass = 0; pass < 2; ++pass) { const int ch = pass * 64 + F.lane; f16* pq = yr + OFF_Q + ch * 8; const f16x8 v = *(const GAS f16x8*)pq;
                float ss = 0.f;
#pragma unroll
                for (int e = 0; e < 8; ++e) ss += (float)v[e] * (float)v[e];
                ss = sum8(ss);
                const float rs = (1.f / sqrtf(ss * (1.f / 64.f) + RMS_EPS)) * (0.125f * LOG2E); const float* w = qnw + (ch & 7) * 8;
                u32x4 o; o.x = pk_f16((float)v[0] * rs * w[0], (float)v[1] * rs * w[1]); o.y = pk_f16((float)v[2] * rs * w[2], (float)v[3] * rs * w[3]);
                o.z = pk_f16((float)v[4] * rs * w[4], (float)v[5] * rs * w[5]); o.w = pk_f16((float)v[6] * rs * w[6], (float)v[7] * rs * w[7]);
                *(GAS u32x4*)((f16*)(ws + WS_QN) + (size_t)m * 1024 + ch * 8) = o; }
            { const int br = F.lane >> 5, ch = F.lane & 31, g = ch >> 3, dc = ch & 7; const f16x8 v = *(const GAS f16x8*)(yr + (br ? OFF_KW : OFF_KS) + ch * 8);
                float ss = 0.f;
#pragma unroll
                for (int e = 0; e < 8; ++e) ss += (float)v[e] * (float)v[e];
                ss = sum8(ss);
                const float rs = 1.f / sqrtf(ss * (1.f / 64.f) + RMS_EPS); const float* w = knw + dc * 8;
                u32x2 o; o.x = pk_fp8((float)v[0] * rs * w[0], (float)v[1] * rs * w[1], (float)v[2] * rs * w[2], (float)v[3] * rs * w[3]);
                o.y = pk_fp8((float)v[4] * rs * w[4], (float)v[5] * rs * w[5], (float)v[6] * rs * w[6], (float)v[7] * rs * w[7]);
                *(GAS u32x2*)(ws + WS_KN + (size_t)br * (BATCH * 4 * SEQ * 64) + ((size_t)(b * 4 + g) * 64 + (s >> 5)) * 2048 + (dc >> 2) * 1024 + ((dc & 1) * 32 + (s & 31)) * 16 + ((dc >> 1) & 1) * 8) = o; }
            { const int mat = F.lane >> 5, ch = F.lane & 31, g = ch >> 3, dc = ch & 7; const u32x4 v = *(const GAS u32x4*)(yr + (mat ? OFF_VC : OFF_KC) + ch * 8);
                const int i1 = s >> 4, jj = s & 15; f16* fa = (f16*)(ws + WS_FLATA) + (size_t)mat * 4096 * 2048;
                if (i1 <= NCMP - 1) *(GAS u32x4*)(fa + (size_t)((b * NCMP + i1) * 4 + g) * 2048 + jj * 64 + dc * 8) = v;
                if (i1 >= 1) *(GAS u32x4*)(fa + (size_t)((b * NCMP + i1 - 1) * 4 + g) * 2048 + (16 + jj) * 64 + dc * 8) = v; }
        }
        for (int idx = F.tid; idx < 64 * 48; idx += 512) { const int tk = idx / 48, c = idx - tk * 48; const float v = (float)Y[(size_t)(m0 + tk) * NINP + OFF_G + c];
            ((float*)(ws + WS_GATES))[(size_t)(m0 + tk) * 48 + c] = 1.f / (1.f + __expf(-v)); }
        { const int gg = F.tid >> 7;
          if (gg == 0) pool_mix_tile<2>(Y + OFF_U + F.tid * 2, (f16*)(ws + WS_MIXED) + F.tid * 2, (size_t)b * SEQ, s0);
          else if (gg == 1) pool_mix_tile<4>(Y + OFF_U + F.tid * 2, (f16*)(ws + WS_MIXED) + F.tid * 2, (size_t)b * SEQ, s0);
          else if (gg == 2) pool_mix_tile<8>(Y + OFF_U + F.tid * 2, (f16*)(ws + WS_MIXED) + F.tid * 2, (size_t)b * SEQ, s0);
          else pool_mix_tile<16>(Y + OFF_U + F.tid * 2, (f16*)(ws + WS_MIXED) + F.tid * 2, (size_t)b * SEQ, s0); }
        __syncthreads();
        for (int idx = F.tid; idx < 2 * 64 * 32; idx += 512) { const int br = idx >> 11, tk = (idx >> 5) & 63, ch = idx & 31;
            *(LAS u32x4*)(vl + (br * 64 + tk) * VLP + ch * 8) = *(const GAS u32x4*)(Y + (size_t)(m0 + tk) * NINP + (br ? OFF_VW : OFF_VS) + ch * 8); }
        __syncthreads();
        for (int idx = F.tid; idx < 2 * 256 * 8; idx += 512) { const int br = idx >> 11, row = (idx >> 3) & 255, cc = idx & 7, grp = cc >> 1, hh = cc & 1;
            float o[8];
#pragma unroll
            for (int j = 0; j < 8; ++j) { const int kap = 16 * grp + 8 * (j >> 2) + 4 * hh + (j & 3); o[j] = (float)vl[(br * 64 + kap) * VLP + row]; }
            const int g = row >> 6, d = row & 63;
            u32x2 o8; o8.x = pk_fp8(o[0], o[1], o[2], o[3]); o8.y = pk_fp8(o[4], o[5], o[6], o[7]);
            *(GAS u32x2*)(ws + WS_VT + (size_t)br * (BATCH * 4 * 64 * SEQ) + ((size_t)(b * 4 + g) * 64 + (s0 >> 5) + (cc >> 2)) * 2048 + (d >> 5) * 1024 + ((cc & 1) * 32 + (d & 31)) * 16 + ((cc >> 1) & 1) * 8) = o8; }
        __syncthreads();
    }
}

__device__ __forceinline__ void p4_compress2(Frame& F) {
    unsigned char* ws = F.ws;
    f16* kc = (f16*)(ws + WS_KCMP); f16* vt = (f16*)(ws + WS_VCMPT);
    const int nhalf = F.G >> 1, mat = F.vcu & 1, wgr = F.vcu >> 1;
    if (nhalf == 0) return;
    LAS float* w2l = (LAS float*)F.lds;
    { const float* w2g = F.in[mat ? I_CVW2 : I_CKW2];
      for (int idx = F.tid; idx < 256 * 16; idx += 512) { const int k = idx >> 4, d4 = (idx & 15) * 4; const f32x4 v = *(const GAS f32x4*)(w2g + (size_t)k * 64 + d4);
          LAS float* q = w2l + ((k >> 2) * 64 + d4) * 4 + (k & 3); q[0] = v.x; q[4] = v.y; q[8] = v.z; q[12] = v.w; } }
    __syncthreads();
    const int rstep = nhalf * NWAVES, r0 = (F.vcu >= 2 * nhalf ? 4096 : wgr * NWAVES + F.wave);
#pragma unroll 1
    for (int rb = r0; rb < 4096; rb += 4 * rstep) {
        f32x4 hs[4];
#pragma unroll
        for (int q = 0; q < 4; ++q) { const int r = rb + q * rstep < 4096 ? rb + q * rstep : rb; const int bg = r >> 7, i = r & 127, ic = i < NCMP ? i : 0;
            const float* hp = (const float*)(ws + WS_Y) + ((size_t)mat * 4096 + (size_t)((bg >> 2) * NCMP + ic) * 4 + (bg & 3)) * 1024 + F.lane * 4;
            hs[q] = *(const GAS f32x4*)(((const float*)(ws + WS_CBIAS)) + mat * 256 + F.lane * 4);
#pragma unroll
            for (int ks = 0; ks < 4; ++ks) hs[q] = hs[q] + *(const GAS f32x4*)(hp + ks * 256); }
        float hh_[4][4], ac[4][4];
#pragma unroll
        for (int q = 0; q < 4; ++q) { const f32x2 ga = pg8::gelu_pk((f32x2){hs[q].x, hs[q].y}), gb = pg8::gelu_pk((f32x2){hs[q].z, hs[q].w});
            hh_[q][0] = ga.x; hh_[q][1] = ga.y; hh_[q][2] = gb.x; hh_[q][3] = gb.y; ac[q][0] = 0.f; ac[q][1] = 0.f; ac[q][2] = 0.f; ac[q][3] = 0.f; }
#pragma unroll 8
        for (int kk = 0; kk < 64; ++kk) { const f32x4 wv = *(const LAS f32x4*)(w2l + (kk * 64 + F.lane) * 4);
#pragma unroll
            for (int q = 0; q < 4; ++q) { ac[q][0] += rl_f(hh_[q][0], kk) * wv.x; ac[q][1] += rl_f(hh_[q][1], kk) * wv.y; ac[q][2] += rl_f(hh_[q][2], kk) * wv.z; ac[q][3] += rl_f(hh_[q][3], kk) * wv.w; } }
#pragma unroll
        for (int q = 0; q < 4; ++q) { const int r = rb + q * rstep; if (r < 4096) {
            const int bg = r >> 7, i = r & 127;
            const float acc = i < NCMP ? (ac[q][0] + ac[q][1]) + (ac[q][2] + ac[q][3]) : 0.f;
            if (mat == 0) { const float ss = wave_sum(acc * acc); const float rs = 1.f / sqrtf(ss * (1.f / 64.f) + RMS_EPS);
                const int d = F.lane, dc = d >> 3;
                kc[((size_t)bg * 4 + (i >> 5)) * 2048 + (dc >> 1) * 512 + ((dc & 1) * 32 + (i & 31)) * 8 + (d & 7)] = (f16)(i < NCMP ? acc * rs * F.in[I_KNW][F.lane] : 0.f); }
            else { const int kap = i & 15, pp = ((kap >> 2) & 1) * 8 + (kap >> 3) * 4 + (kap & 3);
                const int d = F.lane;
                vt[((size_t)bg * 4 + (i >> 5)) * 2048 + ((d >> 5) * 2 + ((i >> 4) & 1)) * 512 + ((pp >> 3) * 32 + (d & 31)) * 8 + (pp & 7)] = (f16)acc; } } }
    }
    __syncthreads();
}

__device__ __forceinline__ int t5_bucket(int rel) {
    if (rel < 16) return rel;
    int b = 16;
    b += rel >= 19; b += rel >= 21; b += rel >= 24; b += rel >= 27; b += rel >= 31; b += rel >= 35; b += rel >= 40; b += rel >= 46;
    b += rel >= 52; b += rel >= 59; b += rel >= 67; b += rel >= 77; b += rel >= 87; b += rel >= 99; b += rel >= 113;
    return b;
}
__device__ __forceinline__ int med3i(int a, int lo, int hi) { return a < lo ? lo : (a > hi ? hi : a); }
__device__ __forceinline__ float other_half_max(float x) { const auto r = __builtin_amdgcn_permlane32_swap(__float_as_uint(x), __float_as_uint(x), false, false); return fmaxf(__uint_as_float(r[0]), __uint_as_float(r[1])); }
__device__ __forceinline__ float both_halves_sum(float x) { const auto r = __builtin_amdgcn_permlane32_swap(__float_as_uint(x), __float_as_uint(x), false, false); return __uint_as_float(r[0]) + __uint_as_float(r[1]); }
struct AFrag { u32x4 k[2]; u32x4 v[2]; };
__device__ __forceinline__ void attn_load(AFrag& f, const unsigned char* Kp, const unsigned char* Vp, int kt, int r31, int hh) {
    const unsigned char* kp = Kp + (size_t)kt * 2048 + (hh * 32 + r31) * 16; const unsigned char* vp = Vp + (size_t)kt * 2048 + (hh * 32 + r31) * 16;
#pragma unroll
    for (int j = 0; j < 2; ++j) f.k[j] = *(const GAS u32x4*)(kp + j * 1024);
#pragma unroll
    for (int dt = 0; dt < 2; ++dt) f.v[dt] = *(const GAS u32x4*)(vp + dt * 1024);
}
__device__ __forceinline__ f16x8 pack8(const f32x16& c, int s2) {
    f16x8 o;
#pragma unroll
    for (int j = 0; j < 8; ++j) o[j] = (f16)c[8 * s2 + j];
    return o;
}
__device__ __forceinline__ void attn_tile(const AFrag& f, const long (&bq8)[4], int kt, int t0, int t, int hh, int wlim, unsigned selm, float cfar, const LAS float* lutr,
                                          float& mrun, float& lrun, f32x16& O0, f32x16& O1) {
    f32x16 S;
#pragma unroll
    for (int i = 0; i < 16; ++i) S[i] = 0.f;
#pragma unroll
    for (int ks = 0; ks < 4; ++ks) S = __builtin_amdgcn_mfma_f32_32x32x16_fp8_fp8((ks & 1) ? as_i64(f.k[ks >> 1].z, f.k[ks >> 1].w) : as_i64(f.k[ks >> 1].x, f.k[ks >> 1].y), bq8[ks], S, 0, 0, 0);
    const int k0 = kt * 32, minrel = t0 - (k0 + 31), maxrel = t0 + 7 - k0;
    const bool selbit = ((selm >> (kt >> 1)) & 1u) != 0u;
    float addc = 0.f;
    if (minrel >= 113 && maxrel < wlim) addc = selbit ? cfar : -2e30f;
    else {
        const unsigned wl = selbit ? (unsigned)wlim : 0u; const int relb = t - k0 - 4 * hh;
        float bias[16];
#pragma unroll
        for (int i = 0; i < 16; ++i) bias[i] = lutr[med3i(relb - ((i & 3) + 8 * (i >> 2)), 0, 127)];
#pragma unroll
        for (int i = 0; i < 16; ++i) asm volatile("" : "+v"(bias[i]));
#pragma unroll
        for (int i = 0; i < 16; ++i) { const int rel = relb - ((i & 3) + 8 * (i >> 2)); S[i] = ((unsigned)rel < wl) ? __builtin_fmaf(bias[i], 8.f, S[i]) : -2e30f; }
    }
    float tmax = S[0];
#pragma unroll
    for (int i = 1; i < 16; ++i) tmax = fmaxf(tmax, S[i]);
    tmax = other_half_max(tmax) * 0.125f + addc;
    const float mnew = fmaxf(mrun, tmax), alpha = __builtin_amdgcn_exp2f(mrun - mnew);
    mrun = mnew; lrun *= alpha;
    if (__builtin_amdgcn_ballot_w64(alpha != 1.0f) != 0ull) {
#pragma unroll
        for (int i = 0; i < 16; ++i) { O0[i] = mul_np(O0[i], alpha); O1[i] = mul_np(O1[i], alpha); } }
    const float mm = mnew - addc;
#pragma unroll
    for (int i = 0; i < 16; ++i) { const float pv = __builtin_amdgcn_exp2f(__builtin_fmaf(S[i], 0.125f, -mm)); lrun += pv; S[i] = pv; }
#pragma unroll
    for (int s2 = 0; s2 < 2; ++s2) { const long pb = as_i64(pk_fp8(S[8 * s2], S[8 * s2 + 1], S[8 * s2 + 2], S[8 * s2 + 3]), pk_fp8(S[8 * s2 + 4], S[8 * s2 + 5], S[8 * s2 + 6], S[8 * s2 + 7]));
        O0 = __builtin_amdgcn_mfma_f32_32x32x16_fp8_fp8(s2 ? as_i64(f.v[0].z, f.v[0].w) : as_i64(f.v[0].x, f.v[0].y), pb, O0, 0, 0, 0);
        O1 = __builtin_amdgcn_mfma_f32_32x32x16_fp8_fp8(s2 ? as_i64(f.v[1].z, f.v[1].w) : as_i64(f.v[1].x, f.v[1].y), pb, O1, 0, 0, 0); }
}
__device__ __forceinline__ void attn_branch(const unsigned char* Kp, const unsigned char* Vp, unsigned long long tm, const long (&bq)[4], int t0, int t, int r31, int hh, int wlim, unsigned selm, float cfar,
                                            const LAS float* lutr, float gate, LAS float* TL) {
    float mrun = -1e30f, lrun = 0.f; f32x16 O0, O1;
#pragma unroll
    for (int i = 0; i < 16; ++i) { O0[i] = 0.f; O1[i] = 0.f; }
    AFrag fA, fB;
    int ktA = __builtin_ctzll(tm), ktB;
    attn_load(fA, Kp, Vp, ktA, r31, hh);
    for (;;) {
        tm &= tm - 1; const bool hasB = tm != 0ull; ktB = hasB ? __builtin_ctzll(tm) : ktA; attn_load(fB, Kp, Vp, ktB, r31, hh);
        attn_tile(fA, bq, ktA, t0, t, hh, wlim, selm, cfar, lutr, mrun, lrun, O0, O1);
        if (!hasB) break;
        tm &= tm - 1; const bool hasA = tm != 0ull; ktA = hasA ? __builtin_ctzll(tm) : ktB; attn_load(fA, Kp, Vp, ktA, r31, hh);
        attn_tile(fB, bq, ktB, t0, t, hh, wlim, selm, cfar, lutr, mrun, lrun, O0, O1);
        if (!hasA) break;
    }
    lrun = both_halves_sum(lrun);
    const float sc = gate / fmaxf(lrun, 1e-30f);
#pragma unroll
    for (int i = 0; i < 16; ++i) { TL[i * 64] += O0[i] * sc; TL[(16 + i) * 64] += O1[i] * sc; }
}
__device__ __forceinline__ void p5_attention(Frame& F) {
    unsigned char* ws = F.ws;
    const f16* Y = (const f16*)(ws + WS_Y);
    const float* gates = (const float*)(ws + WS_GATES);
    f16* CAT = (f16*)(ws + WS_CAT);
    LAS float* wl = (LAS float*)(F.lds + F.wave * 8192);
    LAS float* LUT = wl;
    const int gw = F.vcu * NWAVES + F.wave, NW = F.G * NWAVES;
    const bool snake = (8192 % (2 * NW)) == 0, bal = (NW == 2048);
    int lut_g = -1;
    LAS unsigned* SELM = (LAS unsigned*)(wl + 1280);
    for (int it = gw, rr = 0; it < 8192; it += NW, ++rr) {
        int n = (snake && (rr & 1)) ? (rr * NW + (NW - 1 - gw)) : it;
        if (bal) {
            const int xq = gw >> 8, u = gw & 255;
            if (rr < 3) { const int f = rr * 256 + u, q = f / 192; n = (q * 8 + xq) * 256 + 64 + (f - q * 192); }
            else { const int c = u >> 3, w = u & 7, k = (c & 7) * 4 + (w & 3); n = ((c >> 3) * 8 + xq) * 256 + ((w & 4) ? 63 - k : k); } }
        const int bg = n >> 8, pos = n & 255, b = bg >> 2, g = bg & 3, t0 = pos * 8;
        int lane = F.lane; asm volatile("" : "+v"(lane));
        const int r31 = lane & 31, hh = lane >> 5, tok8 = r31 >> 2, r = r31 & 3;
        const LAS float* lutr = LUT + r * 128;
        if (g != lut_g) {
            LDS_WAIT(); asm volatile("" ::: "memory");
#pragma unroll
            for (int e = 0; e < 2; ++e) { const int rel = lane + 64 * e, bk = t5_bucket(rel);
#pragma unroll
                for (int r4 = 0; r4 < 4; ++r4) LUT[r4 * 128 + rel] = F.in[I_RELB][bk * 16 + 4 * g + r4] * LOG2E; }
            LDS_WAIT(); asm volatile("" ::: "memory");
            lut_g = g;
        }
        const int t = t0 + tok8, head = 4 * g + r; const size_t m = (size_t)b * SEQ + t;
        f16x8 bq[4];
#pragma unroll
        for (int ks = 0; ks < 4; ++ks) bq[ks] = *(const GAS f16x8*)((const f16*)(ws + WS_QN) + m * 1024 + head * 64 + ks * 16 + hh * 8);
        long bq8[4];
#pragma unroll
        for (int ks = 0; ks < 4; ++ks) bq8[ks] = as_i64(pk_fp8((float)bq[ks][0] * 8.f, (float)bq[ks][1] * 8.f, (float)bq[ks][2] * 8.f, (float)bq[ks][3] * 8.f),
                                                        pk_fp8((float)bq[ks][4] * 8.f, (float)bq[ks][5] * 8.f, (float)bq[ks][6] * 8.f, (float)bq[ks][7] * 8.f));
        const float g_c = gates[m * 48 + head * 3 + 0], g_s = gates[m * 48 + head * 3 + 1], g_w = gates[m * 48 + head * 3 + 2];
        const float cfar = lutr[127];
        LAS float* TL = (LAS float*)(F.lds + 65536 + F.wave * 8192) + lane;
        {
            const f16* kc = (const f16*)(ws + WS_KCMP) + (size_t)bg * 128 * 64;
            const f16* vc = (const f16*)(ws + WS_VCMPT) + (size_t)bg * 64 * 128;
            f32x16 c[4];
#pragma unroll
            for (int kt = 0; kt < 4; ++kt) {
#pragma unroll
                for (int i = 0; i < 16; ++i) c[kt][i] = 0.f;
#pragma unroll
                for (int ks = 0; ks < 4; ++ks) { const f16x8 a = *(const GAS f16x8*)(kc + kt * 2048 + ks * 512 + (hh * 32 + r31) * 8); c[kt] = __builtin_amdgcn_mfma_f32_32x32x16_f16(a, bq[ks], c[kt], 0, 0, 0); }
                asm volatile("" ::: "memory");
            }
            const int relb = t - 31 - 64 * hh; float mx = -1e30f;
#pragma unroll
            for (int kt = 0; kt < 4; ++kt) { float bias[16];
#pragma unroll
                for (int i = 0; i < 16; ++i) { const int rel = relb - 16 * (kt * 32 + (i & 3) + 8 * (i >> 2)); bias[i] = lutr[med3i(rel, 0, 127)]; }
#pragma unroll
                for (int i = 0; i < 16; ++i) asm volatile("" : "+v"(bias[i]));
#pragma unroll
                for (int i = 0; i < 16; ++i) { const int rel = relb - 16 * (kt * 32 + (i & 3) + 8 * (i >> 2));
                    const float sv = rel >= 0 ? c[kt][i] + bias[i] : -2e30f; c[kt][i] = sv; mx = fmaxf(mx, sv); }
                asm volatile("" ::: "memory"); }
            mx = other_half_max(mx);
            float l = 0.f;
#pragma unroll
            for (int kt = 0; kt < 4; ++kt)
#pragma unroll
                for (int i = 0; i < 16; ++i) { const float pv = __builtin_amdgcn_exp2f(c[kt][i] - mx); c[kt][i] = pv; l += pv; }
            l = both_halves_sum(l);
            const float inv = 1.f / fmaxf(l, 1e-30f);
#pragma unroll
            for (int kt = 0; kt < 4; ++kt)
#pragma unroll
                for (int jj = 0; jj < 4; ++jj) { float own = (2.f * (c[kt][4 * jj] + c[kt][4 * jj + 1] + c[kt][4 * jj + 2]) + c[kt][4 * jj + 3]) * inv, p3 = c[kt][4 * jj + 3] * inv;
                    own += dpp_f<0xB1>(own); own += dpp_f<0x4E>(own); p3 += dpp_f<0xB1>(p3); p3 += dpp_f<0x4E>(p3);
                    if (r == 0) { const int j = kt * 8 + 2 * jj + hh; wl[512 + tok8 * 32 + j] = own; wl[768 + tok8 * 32 + j] = p3; } }
            f32x16 O0, O1;
#pragma unroll
            for (int i = 0; i < 16; ++i) { O0[i] = 0.f; O1[i] = 0.f; }
#pragma unroll
            for (int kt = 0; kt < 4; ++kt)
#pragma unroll
                for (int s2 = 0; s2 < 2; ++s2) { const f16x8 pb = pack8(c[kt], s2);
                    const f16x8 a0 = *(const GAS f16x8*)(vc + kt * 2048 + s2 * 512 + (hh * 32 + r31) * 8), a1 = *(const GAS f16x8*)(vc + kt * 2048 + (2 + s2) * 512 + (hh * 32 + r31) * 8);
                    O0 = __builtin_amdgcn_mfma_f32_32x32x16_f16(a0, pb, O0, 0, 0, 0); O1 = __builtin_amdgcn_mfma_f32_32x32x16_f16(a1, pb, O1, 0, 0, 0); asm volatile("" ::: "memory"); }
            const float sc = inv * g_c;
#pragma unroll
            for (int i = 0; i < 16; ++i) { TL[i * 64] = O0[i] * sc; TL[(16 + i) * 64] = O1[i] * sc; }
        }
        LDS_WAIT(); asm volatile("" ::: "memory");
        int lane2 = lane; asm volatile("" : "+v"(lane2));
        LAS float* OWN = wl + 512 + (lane2 >> 5) * 32 + (lane2 & 31); LAS float* P3 = OWN + 256; LAS float* VAL = OWN + 512;
#pragma unroll
        for (int pp = 0; pp < 4; ++pp) { const int tk = 2 * pp + hh, j = r31, cur = (t0 + tk) >> 6;
            const float impv = OWN[pp * 64] + (j > 0 ? P3[pp * 64 - (j > 0 ? 1 : 0)] : 0.f);
            VAL[pp * 64] = (j == 0 || j == cur || j == cur - 1) ? 1e4f : (j <= cur ? impv : -1e30f); }
        LDS_WAIT(); asm volatile("" ::: "memory");
#pragma unroll
        for (int pp = 0; pp < 4; ++pp) { const int tk = 2 * pp + hh, j = r31, cur = (t0 + tk) >> 6; const float v = VAL[pp * 64]; int cnt = 0; const LAS float* vrow = VAL + pp * 64 - j;
#pragma unroll
            for (int j2 = 0; j2 < 32; ++j2) { const float o = vrow[j2]; cnt += (o > v || (o == v && j2 < j)) ? 1 : 0; }
            const unsigned long long bm = __ballot(cnt < 8 && j <= cur);
            const unsigned mym = hh ? (unsigned)(bm >> 32) : (unsigned)bm;
            if (j == 0) SELM[tk] = mym; }
        LDS_WAIT(); asm volatile("" ::: "memory");
        const unsigned selm = SELM[tok8];
        unsigned um = 0u;
#pragma unroll
        for (int i = 0; i < 8; ++i) um |= SELM[i];
        um = (unsigned)__builtin_amdgcn_readfirstlane((int)um);
        const int kthi = (t0 + 7) >> 5;
        const unsigned long long causal = (kthi >= 63) ? ~0ull : ((1ull << (kthi + 1)) - 1ull);
        {
            unsigned long long x = um;
            x = (x | (x << 16)) & 0x0000FFFF0000FFFFull; x = (x | (x << 8)) & 0x00FF00FF00FF00FFull; x = (x | (x << 4)) & 0x0F0F0F0F0F0F0F0Full;
            x = (x | (x << 2)) & 0x3333333333333333ull; x = (x | (x << 1)) & 0x5555555555555555ull;
            const unsigned long long tm = (x | (x << 1)) & causal;
            attn_branch(ws + WS_KN + (size_t)bg * SEQ * 64, ws + WS_VT + (size_t)bg * 64 * SEQ, tm, bq8, t0, t, r31, hh, 1 << 30, selm, cfar, lutr, g_s, TL);
        }
        {
            const int lo = t0 - 511 > 0 ? (t0 - 511) >> 5 : 0;
            const unsigned long long tm = causal & ~((1ull << lo) - 1ull);
            attn_branch(ws + WS_KN + (size_t)(BATCH * 4 + bg) * SEQ * 64, ws + WS_VT + (size_t)(BATCH * 4 + bg) * 64 * SEQ, tm, bq8, t0, t, r31, hh, 512, 0xFFFFFFFFu, cfar, lutr, g_w, TL);
        }
        f16* orow = CAT + m * D + 1024 + head * 64 + 4 * hh;
#pragma unroll
        for (int jj = 0; jj < 4; ++jj) {
            u32x2 o0; o0.x = pk_f16(TL[(4 * jj) * 64], TL[(4 * jj + 1) * 64]); o0.y = pk_f16(TL[(4 * jj + 2) * 64], TL[(4 * jj + 3) * 64]); *(GAS u32x2*)(orow + 8 * jj) = o0;
            u32x2 o1; o1.x = pk_f16(TL[(16 + 4 * jj) * 64], TL[(16 + 4 * jj + 1) * 64]); o1.y = pk_f16(TL[(16 + 4 * jj + 2) * 64], TL[(16 + 4 * jj + 3) * 64]); *(GAS u32x2*)(orow + 32 + 8 * jj) = o1; }
    }
}

__device__ __forceinline__ void cvt_row_fp6(const f32x4 (&v)[8], int row, unsigned char* dst6, float* scales, int lane) {
    float amax = 0.f;
#pragma unroll
    for (int c = 0; c < 8; ++c) amax = fmaxf(amax, fmaxf(fmaxf(fabsf(v[c].x), fabsf(v[c].y)), fmaxf(fabsf(v[c].z), fabsf(v[c].w))));
    amax = wave_max(amax);
    const float scale = amax > 0.f ? amax * (1.f / 7.5f) : 1.f, inv = 1.f / scale;
    f16x32 h;
#pragma unroll
    for (int c = 0; c < 8; ++c) { h[4 * c] = (f16)(v[c].x * inv); h[4 * c + 1] = (f16)(v[c].y * inv); h[4 * c + 2] = (f16)(v[c].z * inv); h[4 * c + 3] = (f16)(v[c].w * inv); }
    const u32x6 pk = __builtin_amdgcn_cvt_scalef32_pk32_fp6_f16(h, 1.0f);
    unsigned char* d = dst6 + (size_t)(lane >> 3) * SLICE6;
    *(GAS u32x4*)(d + (size_t)row * 128 + (lane & 7) * 16) = (u32x4){pk[0], pk[1], pk[2], pk[3]}; *(GAS u32x2*)(d + 2097152 + (size_t)row * 64 + (lane & 7) * 8) = (u32x2){pk[4], pk[5]};
    if (lane == 0) scales[row] = scale;
}
__device__ __forceinline__ void cvt_table_fp6(Frame& F, const float* src, unsigned char* dst6, float* scales, const float* colw) {
    const int gw = F.vcu * NWAVES + F.wave, NGW = F.G * NWAVES, lane = F.lane;
    int row = gw;
    for (; row + NGW < 16384; row += 2 * NGW) {
        f32x4 va[8], vb[8];
#pragma unroll
        for (int c = 0; c < 8; ++c) { va[c] = __builtin_nontemporal_load((const GAS f32x4*)(src + (size_t)row * D + c * 256 + lane * 4)); vb[c] = __builtin_nontemporal_load((const GAS f32x4*)(src + (size_t)(row + NGW) * D + c * 256 + lane * 4)); }
        if (colw) {
#pragma unroll
            for (int c = 0; c < 8; ++c) { const f32x4 wv = *(const GAS f32x4*)(colw + c * 256 + lane * 4); va[c] = va[c] * wv; vb[c] = vb[c] * wv; } }
        cvt_row_fp6(va, row, dst6, scales, lane); cvt_row_fp6(vb, row + NGW, dst6, scales, lane);
    }
    for (; row < 16384; row += NGW) { f32x4 va[8];
#pragma unroll
        for (int c = 0; c < 8; ++c) { va[c] = *(const GAS f32x4*)(src + (size_t)row * D + c * 256 + lane * 4); if (colw) va[c] = va[c] * *(const GAS f32x4*)(colw + c * 256 + lane * 4); }
        cvt_row_fp6(va, row, dst6, scales, lane); }
}
__device__ __forceinline__ void p7_tables(Frame& F) {
    cvt_table_fp6(F, F.in[I_PU], F.ws + WS_U6, (float*)(F.ws + WS_SU), F.in[I_FFNNW]);
    cvt_table_fp6(F, F.in[I_PV], F.ws + WS_V6, (float*)(F.ws + WS_SV), nullptr);
}

__device__ __forceinline__ void bitonic_sort16_desc(float (&a)[16]) {
#pragma unroll
    for (int k = 2; k <= 16; k <<= 1)
#pragma unroll
        for (int j = k >> 1; j > 0; j >>= 1)
#pragma unroll
            for (int i = 0; i < 16; ++i) { const int l = i ^ j; if (l > i) { const float hi = fmaxf(a[i], a[l]), lo = fminf(a[i], a[l]); if ((i & k) == 0) { a[i] = hi; a[l] = lo; } else { a[i] = lo; a[l] = hi; } } }
}
__device__ __forceinline__ void bitonic_merge16_desc(float (&a)[16]) {
#pragma unroll
    for (int dist = 8; dist >= 1; dist >>= 1)
#pragma unroll
        for (int i = 0; i < 16; ++i) if ((i & dist) == 0) { const float hi = fmaxf(a[i], a[i + dist]), lo = fminf(a[i], a[i + dist]); a[i] = hi; a[i + dist] = lo; }
}
#define INS16(top, v) do { _Pragma("unroll") for (int _j = 0; _j < 16; ++_j) { const float _h = fmaxf(top[_j], v); v = fminf(top[_j], v); top[_j] = _h; } } while (0)
#define INS16P(tv, ti, v, i) do { _Pragma("unroll") for (int _j = 0; _j < 16; ++_j) { const bool _c = v > tv[_j]; const float _nv = _c ? tv[_j] : v; const unsigned _ni = _c ? ti[_j] : i; \
        tv[_j] = _c ? v : tv[_j]; ti[_j] = _c ? i : ti[_j]; v = _nv; i = _ni; } } while (0)
typedef unsigned v4u_t __attribute__((__vector_size__(16)));
typedef unsigned v2u_t __attribute__((__vector_size__(8)));
__device__ __forceinline__ void p9a_topk(Frame& F) {
    unsigned char* ws = F.ws;
    const f16* QP = (const f16*)(ws + WS_QP); const f16* KEYS = (const f16*)(ws + WS_KEYS);
    unsigned* LIDX = (unsigned*)(ws + WS_LIDX); float* LG = (float*)(ws + WS_LG);
    const int lane = F.lane, r31 = lane & 31, hh = lane >> 5;
    const float NINF = -__builtin_inff();
    for (int unit = F.vcu; unit < M / 32; unit += F.G) {
        const int m0 = unit * 32;
        {
            const int h = F.wave;
            float sl[2][16];
            f16x8 bq[8], ka[8];
#pragma unroll
            for (int ks = 0; ks < 8; ++ks) { bq[ks] = *(const GAS f16x8*)(QP + (size_t)(m0 + r31) * D + (h * 2) * 128 + ks * 16 + hh * 8);
                ka[ks] = *(const GAS f16x8*)(KEYS + ((size_t)((h * 2) * 128 + r31)) * 128 + hh * 8 + ks * 16); }
            float top[16];
#pragma unroll
            for (int st = 0; st < 8; ++st) { const int p = st >> 2, kt = st & 3;
                if (kt == 0) {
#pragma unroll
                    for (int j = 0; j < 16; ++j) top[j] = NINF; }
                f32x16 c;
#pragma unroll
                for (int i = 0; i < 16; ++i) c[i] = 0.f;
#pragma unroll
                for (int ks = 0; ks < 8; ++ks) c = __builtin_amdgcn_mfma_f32_32x32x16_f16(ka[ks], bq[ks], c, 0, 0, 0);
                if (st + 1 < 8) { const int pn = (st + 1) >> 2, ktn = (st + 1) & 3;
#pragma unroll
                    for (int ks = 0; ks < 8; ++ks) ka[ks] = *(const GAS f16x8*)(KEYS + ((size_t)((h * 2 + pn) * 128 + ktn * 32 + r31)) * 128 + hh * 8 + ks * 16);
                    if (st == 3) {
#pragma unroll
                        for (int ks = 0; ks < 8; ++ks) bq[ks] = *(const GAS f16x8*)(QP + (size_t)(m0 + r31) * D + (h * 2 + 1) * 128 + ks * 16 + hh * 8); } }
                const unsigned k4 = (unsigned)(kt * 32 + 4 * hh);
                float nv[16];
#pragma unroll
                for (int reg = 0; reg < 16; ++reg) { const unsigned key = k4 + (unsigned)((reg & 3) + 8 * (reg >> 2)); nv[reg] = __uint_as_float((__float_as_uint(c[reg]) & ~127u) | key); }
                bitonic_sort16_desc(nv);
#pragma unroll
                for (int j = 0; j < 16; ++j) top[j] = fmaxf(top[j], nv[15 - j]);
                bitonic_merge16_desc(top);
                if (kt == 3) {
                    float cm[16];
#pragma unroll
                    for (int j = 0; j < 16; ++j) cm[j] = fmaxf(top[j], __uint_as_float(other32u(__float_as_uint(top[15 - j]), hh != 0)));
                    bitonic_merge16_desc(cm);
#pragma unroll
                    for (int j = 0; j < 16; ++j) sl[p][j] = cm[j]; }
            }
            float vx[16], vy[16]; unsigned ix[16], iy[16];
#pragma unroll
            for (int j = 0; j < 16; ++j) { const unsigned bx = __float_as_uint(hh ? sl[1][j] : sl[0][j]), by = __float_as_uint(hh ? sl[0][j] : sl[1][j]);
                vx[j] = __uint_as_float(bx & ~127u); vy[j] = __uint_as_float(by & ~127u); ix[j] = (bx & 127u) * (hh ? 1u : 128u); iy[j] = (by & 127u) * (hh ? 128u : 1u); }
            float tv[16]; unsigned ti[16];
#pragma unroll
            for (int j = 0; j < 16; ++j) { const int jb = j + 1 < 16 ? j + 1 : 15;
                const float v0 = vx[0] + vy[j], v1 = (j < 15) ? vx[0] + vy[jb] : NINF; const unsigned i0 = ix[0] + iy[j], i1 = ix[0] + iy[jb];
                tv[j] = hh ? v1 : v0; ti[j] = hh ? i1 : i0; }
#pragma unroll
            for (int a = 1; a < 4; ++a) { const int bmax = (a == 1) ? 7 : (a == 2 ? 4 : 3);
#pragma unroll
                for (int b = a; b <= bmax; ++b) { float v = vx[a] + vy[b]; if (a == b) v = hh ? NINF : v; unsigned i = ix[a] + iy[b]; INS16P(tv, ti, v, i); } }
            float mv[16]; unsigned mi[16];
#pragma unroll
            for (int j = 0; j < 16; ++j) { const float pv = __uint_as_float(other32u(__float_as_uint(tv[15 - j]), hh != 0)); const unsigned pi = other32u(ti[15 - j], hh != 0); const bool c = pv > tv[j]; mv[j] = c ? pv : tv[j]; mi[j] = c ? pi : ti[j]; }
            float mx = mv[0];
#pragma unroll
            for (int j = 1; j < 16; ++j) mx = fmaxf(mx, mv[j]);
            float sum = 0.f;
#pragma unroll
            for (int j = 0; j < 16; ++j) { mv[j] = __builtin_amdgcn_exp2f((mv[j] - mx) * LOG2E); sum += mv[j]; }
            const float inv = 1.f / sum;
#pragma unroll
            for (int j = 0; j < 8; ++j) { { const int e_ = h * 16 + hh * 8 + j, pos_ = (e_ & 63) * 2 + (e_ >> 6); LIDX[(size_t)(m0 + r31) * 128 + pos_] = mi[j]; LG[(size_t)(m0 + r31) * 128 + pos_] = mv[j] * inv; } }
        }
    }
}
struct Seg6 { v4u_t a; v2u_t b; };
__device__ __forceinline__ f16x32 seg6_decode(const Seg6& r) { const u32x6 p = {r.a[0], r.a[1], r.a[2], r.a[3], r.b[0], r.b[1]}; return __builtin_amdgcn_cvt_scalef32_pk32_f16_fp6(p, 1.0f); }
__device__ __forceinline__ f16x32 seg6_dec2(const v4u_t& a, const v2u_t& b) { const u32x6 p = {a[0], a[1], a[2], a[3], b[0], b[1]}; return __builtin_amdgcn_cvt_scalef32_pk32_f16_fp6(p, 1.0f); }
#define SEG_DECL(P) v4u_t P##a0, P##a1, P##a2, P##a3, P##a4, P##a5, P##a6, P##a7; v2u_t P##b0, P##b1, P##b2, P##b3, P##b4, P##b5, P##b6, P##b7
#define SEG_L1(P, G, idxv) do { const int e_ = __shfl(idxv, 8 * G + sub); P##a##G = __builtin_amdgcn_raw_buffer_load_b128(rs, e_ * 128 + ch * 16, 0, 0); P##b##G = __builtin_amdgcn_raw_buffer_load_b64(rs, 2097152 + e_ * 64 + ch * 8, 0, 0); } while (0)
#define SEG_LOAD(P, idxv) do { SEG_L1(P, 0, idxv); SEG_L1(P, 1, idxv); SEG_L1(P, 2, idxv); SEG_L1(P, 3, idxv); SEG_L1(P, 4, idxv); SEG_L1(P, 5, idxv); SEG_L1(P, 6, idxv); SEG_L1(P, 7, idxv); } while (0)
__device__ __forceinline__ float u_one(const v4u_t& a, const v2u_t& b, const f16x2 (&xp)[16]) {
    const f16x32 hv = seg6_dec2(a, b); float sdot = 0.f;
#pragma unroll
    for (int k = 0; k < 16; ++k) { f16x2 hp; hp.x = hv[2 * k]; hp.y = hv[2 * k + 1]; sdot = __builtin_amdgcn_fdot2(hp, xp[k], sdot, false); }
    return sum8(sdot);
}
#define SEG_LE(P, G, ev) do { const int e_ = (ev); P##a##G = __builtin_amdgcn_raw_buffer_load_b128(rs, e_ * 128 + ch * 16, 0, 0); P##b##G = __builtin_amdgcn_raw_buffer_load_b64(rs, 2097152 + e_ * 64 + ch * 8, 0, 0); } while (0)
#define EN_GATHER(en, iA, iB) do { _Pragma("unroll") for (int g_ = 0; g_ < 8; ++g_) { en[g_] = __shfl(iA, 8 * g_ + sub); en[8 + g_] = __shfl(iB, 8 * g_ + sub); } } while (0)
#define U_ROLL1(P, G, res, eo) do { const float d_ = u_one(P##a##G, P##b##G, xp); res = (ch == G) ? d_ : res; SEG_LE(P, G, en[(eo) + G]); } while (0)
#define U_ROLL(P, res, idxn) do { U_ROLL1(P, 0, res, idxn); U_ROLL1(P, 1, res, idxn); U_ROLL1(P, 2, res, idxn); U_ROLL1(P, 3, res, idxn); U_ROLL1(P, 4, res, idxn); U_ROLL1(P, 5, res, idxn); U_ROLL1(P, 6, res, idxn); U_ROLL1(P, 7, res, idxn); } while (0)
#define V_ROLL1(P, G, hwv, eo) do { v_one(P##a##G, P##b##G, acc, hq[(eo) + G]); SEG_LE(P, G, en[(eo) + G]); } while (0)
#define V_ROLL(P, hwv, idxn) do { V_ROLL1(P, 0, hwv, idxn); V_ROLL1(P, 1, hwv, idxn); V_ROLL1(P, 2, hwv, idxn); V_ROLL1(P, 3, hwv, idxn); V_ROLL1(P, 4, hwv, idxn); V_ROLL1(P, 5, hwv, idxn); V_ROLL1(P, 6, hwv, idxn); V_ROLL1(P, 7, hwv, idxn); } while (0)
#define FMIXV_LO(a, h, w) asm("v_fma_mix_f32 %0, %1, %2, %0 op_sel_hi:[1,0,0]" : "+v"(a) : "v"(h), "v"(w))
#define FMIXV_HI(a, h, w) asm("v_fma_mix_f32 %0, %1, %2, %0 op_sel:[1,0,0] op_sel_hi:[1,0,0]" : "+v"(a) : "v"(h), "v"(w))
__device__ __forceinline__ void v_one(const v4u_t& a, const v2u_t& b, f16x2 (&acc)[16], f16x2 wq) {
    const f16x32 hv = seg6_dec2(a, b);
#pragma unroll
    for (int k = 0; k < 16; ++k) { f16x2 hp; hp.x = hv[2 * k]; hp.y = hv[2 * k + 1]; acc[k] = __builtin_elementwise_fma(hp, wq, acc[k]); }
}
#define V_HALF(P, hwv) do { v_one(P##a0, P##b0, acc, hwv, sub); v_one(P##a1, P##b1, acc, hwv, 8 + sub); v_one(P##a2, P##b2, acc, hwv, 16 + sub); v_one(P##a3, P##b3, acc, hwv, 24 + sub); \
        v_one(P##a4, P##b4, acc, hwv, 32 + sub); v_one(P##a5, P##b5, acc, hwv, 40 + sub); v_one(P##a6, P##b6, acc, hwv, 48 + sub); v_one(P##a7, P##b7, acc, hwv, 56 + sub); } while (0)
__device__ __forceinline__ void p9b_upass(Frame& F, bool probe_slice0) {
    unsigned char* ws = F.ws;
    const int x = blockIdx.x & 7, rank = blockIdx.x >> 3, cnt = (F.G - x + 7) >> 3;
    const int lane = F.lane, sub = lane >> 3, ch = lane & 7;
    const __amdgpu_buffer_rsrc_t rs = __builtin_amdgcn_make_buffer_rsrc((void*)(ws + WS_U6 + (size_t)(probe_slice0 ? 0 : x) * SLICE6), 0, (int)SLICE6, 0x00020000);
    const f16* XN = (const f16*)(ws + WS_XR) + x * 32 + (lane >> 3) * 256 + (lane & 7) * 4;
    const u32x2* LI2 = (const u32x2*)(ws + WS_LIDX); LAS unsigned char* xl = F.lds + F.wave * 512;
    const int tstep = cnt * NWAVES; int t = rank * NWAVES + F.wave;
    if (t >= M) return;
    int cA, cB, nA, nB; { const u32x2 c2 = LI2[(size_t)t * 64 + lane]; cA = (int)c2.x; cB = (int)c2.y; }
    const int t1c = (t + tstep < M) ? t + tstep : t;
    { const u32x2 n2 = LI2[(size_t)t1c * 64 + lane]; nA = (int)n2.x; nB = (int)n2.y; }
    u32x2 xcur = *(const GAS u32x2*)(XN + (size_t)t * D);
    f16x2 xp[16];
    SEG_DECL(bA); SEG_DECL(bB);
    { const int li_ = cA; SEG_LOAD(bA, li_); } { const int li_ = cB; SEG_LOAD(bB, li_); }
#pragma unroll 1
    for (;;) {
        const int tn = t + tstep, tnn = tn + tstep; const bool hn = tn < M, hnn = tnn < M;
        const int tnc = hn ? tn : t, tnnc = hnn ? tnn : t;
        const u32x2 m2 = LI2[(size_t)tnnc * 64 + lane]; const int mA = (int)m2.x, mB = (int)m2.y;
        const u32x2 xnext = *(const GAS u32x2*)(XN + (size_t)tnc * D);
        *(LAS u32x2*)(xl + ((lane & 7) * 8 + (lane >> 3)) * 8) = xcur;
        LDS_WAIT(); asm volatile("" ::: "memory");
#pragma unroll
        for (int q = 0; q < 4; ++q) { const u32x4 tv = *(const LAS u32x4*)(xl + ch * 64 + q * 16); xp[4 * q] = ash2(tv.x); xp[4 * q + 1] = ash2(tv.y); xp[4 * q + 2] = ash2(tv.z); xp[4 * q + 3] = ash2(tv.w); }
        LDS_WAIT(); asm volatile("" ::: "memory");
        { const int lA_ = hn ? nA : cA, lB_ = hn ? nB : cB; int en[16]; EN_GATHER(en, lA_, lB_);
          float rA = 0.f, rB = 0.f; U_ROLL(bA, rA, 0); U_ROLL(bB, rB, 8);
          float* pd = (float*)(ws + WS_PD) + ((size_t)t * 8 + x) * 128 + 8 * ch + sub; pd[0] = rA; pd[64] = rB; }
        if (!hn) break;
        xcur = xnext;
        cA = nA; cB = nB; nA = mA; nB = mB; t = tn;
    }
}
__device__ __forceinline__ void p9h_weights(Frame& F) {
    unsigned char* ws = F.ws;
    const unsigned* LIDX = (const unsigned*)(ws + WS_LIDX); const float* LG = (const float*)(ws + WS_LG); const float* PD = (const float*)(ws + WS_PD);
    const float* SU = (const float*)(ws + WS_SU); const float* SV = (const float*)(ws + WS_SV); float* HW = (float*)(ws + WS_HW);
    const int gw = F.vcu * NWAVES + F.wave, NGW = F.G * NWAVES, lane = F.lane;
#pragma unroll 1
    for (int t0 = gw; t0 < M; t0 += 2 * NGW) {
        const int t1 = t0 + NGW < M ? t0 + NGW : t0;
        int iA[2], iB[2]; float pa[2][8], pb[2][8], lgA[2], lgB[2], s1[2];
#pragma unroll
        for (int q = 0; q < 2; ++q) { const int t = q ? t1 : t0; { const u32x2 i2 = ((const u32x2*)LIDX)[(size_t)t * 64 + lane]; iA[q] = (int)i2.x; iB[q] = (int)i2.y; }
#pragma unroll
            for (int xs = 0; xs < 8; ++xs) { pa[q][xs] = PD[((size_t)t * 8 + xs) * 128 + lane]; pb[q][xs] = PD[((size_t)t * 8 + xs) * 128 + 64 + lane]; }
            { const f32x2 g2 = ((const f32x2*)LG)[(size_t)t * 64 + lane]; lgA[q] = g2.x; lgB[q] = g2.y; } s1[q] = ((const float*)(ws + WS_SS1))[t]; }
#pragma unroll
        for (int q = 0; q < 2; ++q) { const int t = q ? t1 : t0; float zA = 0.f, zB = 0.f;
#pragma unroll
            for (int xs = 0; xs < 8; ++xs) { zA += pa[q][xs]; zB += pb[q][xs]; }
            const float rs1 = 1.f / sqrtf(s1[q] * (1.f / D) + RMS_EPS);
            ((f32x2*)HW)[(size_t)t * 64 + lane] = (f32x2){pg8::gelu1(zA * rs1 * SU[iA[q]]) * lgA[q] * SV[iA[q]], pg8::gelu1(zB * rs1 * SU[iB[q]]) * lgB[q] * SV[iB[q]]}; }
    }
}
__device__ __forceinline__ void p9c_vpass(Frame& F) {
    unsigned char* ws = F.ws;
    const int x = blockIdx.x & 7, rank = blockIdx.x >> 3, cnt = (F.G - x + 7) >> 3;
    const int lane = F.lane, sub = lane >> 3, ch = lane & 7;
    const __amdgpu_buffer_rsrc_t rs = __builtin_amdgcn_make_buffer_rsrc((void*)(ws + WS_V6 + (size_t)x * SLICE6), 0, (int)SLICE6, 0x00020000);
    const u32x2* LI2 = (const u32x2*)(ws + WS_LIDX);
    f16* XR = (f16*)(ws + WS_XR); float* SS2 = (float*)(ws + WS_SS2);
    const bool b3 = (lane & 8) != 0, b4 = (lane & 16) != 0, b5 = (lane & 32) != 0;
    const int col = ((b3 ? 4 : 0) + (b4 ? 2 : 0) + (b5 ? 1 : 0)) * 256 + x * 32 + ch * 4;
    const int tstep = cnt * NWAVES; int t = rank * NWAVES + F.wave;
    if (t >= M) return;
    int cA, cB, nA, nB; { const u32x2 c2 = LI2[(size_t)t * 64 + lane]; cA = (int)c2.x; cB = (int)c2.y; }
    const int t1c = (t + tstep < M) ? t + tstep : t;
    { const u32x2 n2 = LI2[(size_t)t1c * 64 + lane]; nA = (int)n2.x; nB = (int)n2.y; }
    const f32x2* HW2 = (const f32x2*)(ws + WS_HW);
    float hwA, hwB; { const f32x2 h2 = HW2[(size_t)t * 64 + lane]; hwA = h2.x; hwB = h2.y; }
    SEG_DECL(bA); SEG_DECL(bB);
    { const int li_ = cA; SEG_LOAD(bA, li_); } { const int li_ = cB; SEG_LOAD(bB, li_); }
#pragma unroll 1
    for (;;) {
        const int tn = t + tstep, tnn = tn + tstep; const bool hn = tn < M, hnn = tnn < M;
        const int tnc = hn ? tn : t, tnnc = hnn ? tnn : t;
        const u32x2 m2 = LI2[(size_t)tnnc * 64 + lane]; const int mA = (int)m2.x, mB = (int)m2.y;
        const f32x2 hn2 = HW2[(size_t)tnc * 64 + lane]; const float hwAn = hn2.x, hwBn = hn2.y;
        f16* orow = XR + (size_t)t * D + col; const u32x2 x1r = *(const GAS u32x2*)orow;
        f16x2 acc[16];
#pragma unroll
        for (int i = 0; i < 16; ++i) { acc[i].x = (f16)0.f; acc[i].y = (f16)0.f; }
        { const int lA_ = hn ? nA : cA, lB_ = hn ? nB : cB; int en[16]; EN_GATHER(en, lA_, lB_); f16x2 hq[16];
#pragma unroll
          for (int g_ = 0; g_ < 8; ++g_) { const float qa = __shfl(hwA, 8 * g_ + sub) * 64.f, qb = __shfl(hwB, 8 * g_ + sub) * 64.f;
              hq[g_].x = (f16)qa; hq[g_].y = (f16)qa; hq[8 + g_].x = (f16)qb; hq[8 + g_].y = (f16)qb; }
          V_ROLL(bA, hwA, 0); V_ROLL(bB, hwB, 8); }
        f16x2 q8[8];
#pragma unroll
        for (int i = 0; i < 8; ++i) { const f16x2 keep = b3 ? acc[8 + i] : acc[i], send = b3 ? acc[i] : acc[8 + i]; q8[i] = keep + ash2(other8u(__builtin_bit_cast(unsigned, send))); }
        f16x2 q4[4];
#pragma unroll
        for (int i = 0; i < 4; ++i) { const f16x2 keep = b4 ? q8[4 + i] : q8[i], send = b4 ? q8[i] : q8[4 + i]; q4[i] = keep + ash2(other16u(__builtin_bit_cast(unsigned, send), b4)); }
        float r4[4];
        { const f16x2 k0 = b5 ? q4[2] : q4[0], k1 = b5 ? q4[3] : q4[1], s0 = b5 ? q4[0] : q4[2], s1 = b5 ? q4[1] : q4[3];
          const f16x2 p0 = ash2(other32u(__builtin_bit_cast(unsigned, s0), b5)), p1 = ash2(other32u(__builtin_bit_cast(unsigned, s1), b5));
          r4[0] = ((float)k0.x + (float)p0.x) * (1.f / 64.f); r4[1] = ((float)k0.y + (float)p0.y) * (1.f / 64.f); r4[2] = ((float)k1.x + (float)p1.x) * (1.f / 64.f); r4[3] = ((float)k1.y + (float)p1.y) * (1.f / 64.f); }
        const f16x2 x1a = ash2(x1r.x), x1b = ash2(x1r.y);
        const f32x4 x2 = {(float)x1a.x + r4[0], (float)x1a.y + r4[1], (float)x1b.x + r4[2], (float)x1b.y + r4[3]};
        { u32x2 o2; o2.x = pk_f16(x2.x, x2.y); o2.y = pk_f16(x2.z, x2.w); *(GAS u32x2*)orow = o2; }
        *(GAS unsigned*)(ws + WS_X8 + (size_t)t * D + col) = pk_fp8(x2.x, x2.y, x2.z, x2.w);
        const float ss = wave_sum((x2.x * x2.x + x2.y * x2.y) + (x2.z * x2.z + x2.w * x2.w));
        if (lane == 0) atomicAdd(SS2 + t, ss);
        if (!hn) break;
        cA = nA; cB = nB; nA = mA; nB = mB; t = tn; hwA = hwAn; hwB = hwBn;
    }
}
#undef FMIXV_LO
#undef FMIXV_HI

constexpr int NPH = 13;
struct Args { const float* in[26]; float* out; unsigned char* ws; int ph_lo, ph_hi; int rep[16]; };
__global__ void __launch_bounds__(NWAVES * 64, 2) fwd_kernel(Args args) {
    extern __shared__ __attribute__((aligned(16))) unsigned char lds[];
    Frame F;
    F.lds = (LAS unsigned char*)lds;
    F.MISC = (volatile LAS unsigned*)(F.lds + MISC_OFF);
    F.tid = threadIdx.x; F.lane = F.tid & 63; F.wave = __builtin_amdgcn_readfirstlane(F.tid >> 6);
#define PHASE_LANES() do { int t_ = threadIdx.x; asm volatile("" : "+v"(t_)); F.tid = t_; F.lane = t_ & 63; } while (0)
    F.G = gridDim.x; { const int bx = blockIdx.x; F.vcu = (F.G % 8 == 0) ? (bx % 8) * (F.G / 8) + bx / 8 : bx; }
#pragma unroll
    for (int i = 0; i < 26; ++i) F.in[i] = args.in[i];
    F.out = args.out; F.ws = args.ws;
    unsigned char* ws = args.ws;
    gu32* ctl = (gu32*)(ws + WS_CTL);
    for (int u = F.tid; u < (LDS_BYTES - LDSCTL_OFF) / 4; u += NWAVES * 64) ((LAS unsigned*)(F.lds + LDSCTL_OFF))[u] = 0u;
    __syncthreads();
    XcdBarrier bar; bar.bar = (unsigned*)(ctl + CW_BAR); bar.x = 0; bar.st = nullptr;
    if (MK_ONE_LAUNCH) bar = xcd_barrier_post((unsigned*)(ctl + CW_BAR), F.MISC + 8);
#define GRID_BAR() do { if (MK_ONE_LAUNCH) xcd_barrier(bar); } while (0)
    const int lo = args.ph_lo, hi = args.ph_hi;
#define IN(k) (lo <= (k) && (k) < hi)
#define BOTH(k) (IN(k) && IN((k) + 1))

    if (IN(0)) { PHASE_LANES(); for (int rp = 0; rp < args.rep[0]; ++rp) p0_prologue(F); if (BOTH(0)) GRID_BAR(); }

    if (IN(1)) {
        pg8::Gemm g{(const f16*)(ws + WS_XR), (const f16*)(ws + WS_WIN), M, NINP, D, D, D, 0, 1 << 30, 0};
        pg8::StaticOrder S; S.init(M, NINP, F.G, (int)blockIdx.x);
        pg8::EpiF16Row E{(f16*)(ws + WS_Y), NINP, (const float*)(ws + WS_SS0)};
        pg8::gemm_phase(F.lds, g, S, E);
        if (BOTH(1)) GRID_BAR();
    }

    if (IN(2)) { PHASE_LANES(); for (int rp = 0; rp < PROBE_REP2; ++rp) p2_post(F); if (BOTH(2)) GRID_BAR(); }

    if (IN(3)) {
        { pg8::Gemm g{(const f16*)(ws + WS_FLATA), (const f16*)(ws + WS_W1C), 8192, 1024, 512, D, D, 512, 16, (size_t)256 * D * 2, 512};
          pg8::StaticOrder S; S.init(8192, 1024, F.G, (int)blockIdx.x);
          pg8::EpiRawF32 E{(float*)(ws + WS_Y), 1024};
          pg8::gemm_phase(F.lds, g, S, E); }
        { pg8::Gemm g{(const f16*)(ws + WS_MIXED), (const f16*)(ws + WS_POOLT), M, 1024, 256, 1024, 256, 256, 1 << 30, 0};
          pg8::StaticOrder S; S.init(M, 1024, F.G, (int)((blockIdx.x + 128) % F.G));
          pg8::EpiF16<0> E{(f16*)(ws + WS_CAT), D, nullptr, 1 << 30, 0};
          pg8::gemm_phase(F.lds, g, S, E); }
        if (BOTH(3)) GRID_BAR();
    }

    if (IN(4)) { PHASE_LANES(); p4_compress2(F); if (BOTH(4)) GRID_BAR(); }

    if (IN(5)) { PHASE_LANES(); for (int rp = 0; rp < args.rep[5]; ++rp) p5_attention(F); if (BOTH(5)) GRID_BAR(); }

    if (IN(6)) {
        pg8::Gemm g{(const f16*)(ws + WS_CAT), (const f16*)(ws + WS_WOUT), M, D, D, D, D, 0, 1 << 30, 0};
        pg8::StaticOrder S; S.init(M, D, F.G, (int)blockIdx.x);
        pg8::EpiRes16 E{(f16*)(ws + WS_XR), (float*)(ws + WS_SS1)};
        pg8::gemm_phase(F.lds, g, S, E);
        if (BOTH(6)) GRID_BAR();
    }

    if (IN(7)) {
        { pg8::Gemm g{(const f16*)(ws + WS_XR), (const f16*)(ws + WS_WQ), M, D, D, D, D, 0, 1 << 30, 0};
          pg8::StaticOrder S; S.init(M, D, F.G, (int)blockIdx.x);
          pg8::EpiF16Row E{(f16*)(ws + WS_QP), D, (const float*)(ws + WS_SS1)};
          pg8::gemm_phase(F.lds, g, S, E); }
        { pg8::Gemm g{(const f16*)(ws + WS_P16), (const f16*)(ws + WS_WPJ), M, D, 256, 256, 256, 0, 1 << 30, 0};
          pg8::StaticOrder S; S.init(M, D, F.G, (int)blockIdx.x);
          pg8::EpiF16<0> E{(f16*)(ws + WS_PJ), D, nullptr, 1 << 30, 0};
          pg8::gemm_phase(F.lds, g, S, E); }
        PHASE_LANES();
        for (int rp = 0; rp < args.rep[7]; ++rp) p7_tables(F);
        if (BOTH(7)) GRID_BAR();
    }

    if (IN(8)) { PHASE_LANES(); p9a_topk(F); if (BOTH(8)) GRID_BAR(); }
    if (IN(9)) { PHASE_LANES(); if (PROBE_DUPU) p9b_upass(F, false); p9b_upass(F, false); if (BOTH(9)) GRID_BAR(); }
    if (IN(10)) { PHASE_LANES(); p9h_weights(F); if (BOTH(10)) GRID_BAR(); }
    if (IN(11)) { PHASE_LANES(); p9c_vpass(F); if (BOTH(11)) GRID_BAR(); }

    if (IN(12)) {
        pg8::Gemm g{ws + WS_X8, ws + WS_WG, M, D, D, D, D, 0, 1 << 30, 0, 0, 1};
        pg8::StaticOrder S; S.init(M, D, F.G, (int)blockIdx.x);
        pg8::EpiFinal E{(const f16*)(ws + WS_XR), (const f16*)(ws + WS_PJ), F.out, (const float*)(ws + WS_SS2), 1.f / W8SCALE};
        pg8::gemm_phase<pg8::EpiFinal, pg8::StaticOrder, true>(F.lds, g, S, E);
    }
#undef IN
#undef BOTH
}

extern "C" void kernel_launch(void* const* d_in, const int* in_sizes, int n_in, void* d_out, int out_size, void* d_ws, size_t ws_size, hipStream_t stream) {
    static int grid = 0;
    if (grid == 0) {
        if (n_in != 26 || out_size != M * D || ws_size < WS_END) { fprintf(stderr, "kernel_launch: unexpected sizes n_in %d out %d ws %zu\n", n_in, out_size, ws_size); grid = -1; return; }
        int dev = 0, cus = 0, per_cu = 0;
        if (hipGetDevice(&dev) != hipSuccess || hipDeviceGetAttribute(&cus, hipDeviceAttributeMultiprocessorCount, dev) != hipSuccess) { grid = -1; return; }
        if (hipFuncSetAttribute((const void*)fwd_kernel, hipFuncAttributeMaxDynamicSharedMemorySize, LDS_BYTES) != hipSuccess) { fprintf(stderr, "kernel_launch: hipFuncSetAttribute failed\n"); grid = -1; return; }
        if (hipOccupancyMaxActiveBlocksPerMultiprocessor(&per_cu, (const void*)fwd_kernel, NWAVES * 64, LDS_BYTES) != hipSuccess || per_cu < 1)
            fprintf(stderr, "kernel_launch: occupancy query reports %d\n", per_cu);
        (void)hipGetLastError();
        grid = cus;
    }
    if (grid < 0) return;
    (void)hipMemsetAsync((char*)d_ws + WS_CTL, 0, CTL_ZERO_BYTES, stream);
    Args a{};
    for (int i = 0; i < 16; ++i) a.rep[i] = 1;
    a.rep[5] = PROBE_REP5; a.rep[0] = PROBE_REP0; a.rep[7] = PROBE_REP7;
    for (int i = 0; i < 26; ++i) a.in[i] = (const float*)d_in[i];
    a.out = (float*)d_out; a.ws = (unsigned char*)d_ws;
    if (MK_ONE_LAUNCH) { a.ph_lo = 0; a.ph_hi = NPH; hipLaunchKernelGGL(fwd_kernel, dim3(grid), dim3(NWAVES * 64), LDS_BYTES, stream, a); }
    else for (int p = 0; p < NPH; ++p) { a.ph_lo = p; a.ph_hi = p + 1; hipLaunchKernelGGL(fwd_kernel, dim3(grid), dim3(NWAVES * 64), LDS_BYTES, stream, a); }
}
```

```cpp
#include <hip/hip_runtime.h>
#include <cstdio>
#include <cstdint>

#define PROBE_REP0 1
#define PROBE_REP2 1
#define PROBE_DUPU 0
#define PROBE_REP5 1
#define PROBE_REP7 1
#define PROBE_REP9 1
#ifndef MK_ONE_LAUNCH
#define MK_ONE_LAUNCH 1
#endif

#define GAS __attribute__((address_space(1)))
#define LAS __attribute__((address_space(3)))
typedef _Float16 f16;
typedef _Float16 f16x8 __attribute__((ext_vector_type(8)));
typedef _Float16 f16x4 __attribute__((ext_vector_type(4)));
typedef _Float16 f16x2 __attribute__((ext_vector_type(2)));
typedef float f32x2 __attribute__((ext_vector_type(2)));
typedef float f32x4 __attribute__((ext_vector_type(4)));
typedef float f32x16 __attribute__((ext_vector_type(16)));
typedef unsigned u32x2 __attribute__((ext_vector_type(2)));
typedef unsigned u32x4 __attribute__((ext_vector_type(4)));
typedef GAS unsigned gu32;
typedef _Float16 f16x32 __attribute__((ext_vector_type(32)));
typedef unsigned u32x6 __attribute__((ext_vector_type(6)));
#define RLX_AGENT __ATOMIC_RELAXED, __HIP_MEMORY_SCOPE_AGENT
#define LDS_WAIT() asm volatile("s_waitcnt lgkmcnt(0)" ::: "memory")
__device__ __forceinline__ float mul_np(float a, float b) { float o; asm("v_mul_f32 %0, %1, %2" : "=v"(o) : "v"(a), "v"(b)); return o; }
__device__ __forceinline__ float add_np(float a, float b) { float o; asm("v_add_f32 %0, %1, %2" : "=v"(o) : "v"(a), "v"(b)); return o; }
#define VM_WAIT() asm volatile("s_waitcnt vmcnt(0)" ::: "memory")

constexpr int BATCH = 8, SEQ = 2048, D = 2048, M = BATCH * SEQ;
constexpr int NIN = 3632, NINP = 3840;
constexpr int OFF_U = 0, OFF_Q = 1024, OFF_KC = 2048, OFF_VC = 2304, OFF_KS = 2560, OFF_VS = 2816, OFF_KW = 3072, OFF_VW = 3328, OFF_G = 3584;
constexpr int NCMP = 127, NCROWS = BATCH * NCMP * 4;
constexpr float RMS_EPS = 1e-6f;
constexpr float LOG2E = 1.4426950408889634f;

constexpr size_t MiB = 1u << 20;
constexpr size_t WS_CTL = 0, CTL_ZERO_BYTES = 1 * MiB;
constexpr size_t WS_WIN = 2 * MiB, WS_WOUT = 17 * MiB, WS_WQ = 25 * MiB, WS_WG = 33 * MiB, WS_WPJ = 41 * MiB, WS_W1C = 42 * MiB, WS_POOLT = 44 * MiB, WS_KEYS = 45 * MiB;
constexpr size_t WS_CBIAS = 46 * MiB, WS_GATES = 47 * MiB, WS_HC = 50 * MiB, WS_KCMP = 54 * MiB, WS_VCMPT = 54 * MiB + 512 * 1024, WS_P16 = 56 * MiB;
constexpr size_t WS_XN = 64 * MiB, WS_X8 = 64 * MiB;
constexpr float CAT8SCALE = 8.f;
constexpr float W8SCALE = 64.f;
constexpr size_t WS_Y = 128 * MiB, WS_QP = 128 * MiB, WS_PJ = 192 * MiB;
constexpr size_t WS_MIXED = 256 * MiB, WS_CAT = 288 * MiB, WS_KN = 352 * MiB, WS_VT = 368 * MiB, WS_FLATA = 384 * MiB;
constexpr size_t WS_U6 = 256 * MiB, WS_V6 = 288 * MiB, WS_SU = 320 * MiB, WS_SV = 321 * MiB;
constexpr size_t WS_LIDX = 322 * MiB, WS_LG = 330 * MiB, WS_SSP = 338 * MiB, WS_PD = 340 * MiB, WS_HW = 404 * MiB;
constexpr size_t SLICE6 = (size_t)16384 * 192;
constexpr size_t WS_XR = 416 * MiB;
constexpr size_t WS_SS0 = 768 * 1024, WS_SS1 = 256 * 1024, WS_SS2 = 512 * 1024;
constexpr size_t WS_QN = 480 * MiB;
constexpr size_t WS_END = 512 * MiB;
constexpr int CW_TMO = 0, CW_CODE = 1, CW_BAR = 4096;

constexpr int RING_BYTES = 131072;
constexpr int LDSCTL_OFF = RING_BYTES, MISC_OFF = LDSCTL_OFF + 320;
constexpr int LDS_BYTES = 147456;
constexpr int NWAVES = 8;

__device__ __forceinline__ unsigned pk_f16(float lo, float hi) { f16x2 v; v.x = (f16)lo; v.y = (f16)hi; return __builtin_bit_cast(unsigned, v); }
__device__ __forceinline__ unsigned pk_fp8(float a, float b, float c, float d) { int r = __builtin_amdgcn_cvt_pk_fp8_f32(a, b, 0, false); r = __builtin_amdgcn_cvt_pk_fp8_f32(c, d, r, true); return (unsigned)r; }
__device__ __forceinline__ long as_i64(unsigned lo, unsigned hi) { return (long)(((unsigned long long)hi << 32) | lo); }
__device__ __forceinline__ f16x2 ash2(unsigned u) { return __builtin_bit_cast(f16x2, u); }
template <int CTRL> __device__ __forceinline__ float dpp_f(float v) { return __int_as_float(__builtin_amdgcn_update_dpp(0, __float_as_int(v), CTRL, 0xF, 0xF, true)); }
__device__ __forceinline__ float rl_f(float v, int l) { return __int_as_float(__builtin_amdgcn_readlane(__float_as_int(v), l)); }
__device__ __forceinline__ float sum8(float v) { v += dpp_f<0x141>(v); v += dpp_f<0xB1>(v); v += dpp_f<0x4E>(v); return v; }
__device__ __forceinline__ float wave_sum(float v) { v = sum8(v); v += dpp_f<0x140>(v); return (rl_f(v, 0) + rl_f(v, 16)) + (rl_f(v, 32) + rl_f(v, 48)); }
__device__ __forceinline__ float wave_max(float v) { v = fmaxf(v, dpp_f<0x141>(v)); v = fmaxf(v, dpp_f<0xB1>(v)); v = fmaxf(v, dpp_f<0x4E>(v)); v = fmaxf(v, dpp_f<0x140>(v));
    return fmaxf(fmaxf(rl_f(v, 0), rl_f(v, 16)), fmaxf(rl_f(v, 32), rl_f(v, 48))); }

__device__ __forceinline__ unsigned other8u(unsigned x) { return (unsigned)__builtin_amdgcn_update_dpp(0, (int)x, 0x128, 0xF, 0xF, true); }
__device__ __forceinline__ unsigned other16u(unsigned x, bool b4) { const auto r = __builtin_amdgcn_permlane16_swap(x, x, false, false); return b4 ? r[0] : r[1]; }
__device__ __forceinline__ unsigned other32u(unsigned x, bool b5) { const auto r = __builtin_amdgcn_permlane32_swap(x, x, false, false); return b5 ? r[0] : r[1]; }
namespace pg8 {
constexpr int BM = 256, BK = 64, HALF = 128, HTB = HALF * BK * 2, STAGE_BYTES = 8 * HTB, NXCD = 8, WGM = 8;
__host__ __device__ __forceinline__ int lds_byte(int r, int c) { const int st = (r >> 4) * 2 + (c >> 5), rr = r & 15, cc = c & 31, ob = rr * 64 + cc * 2; return st * 1024 + (ob ^ (((ob >> 9) & 1) << 5)); }
__host__ __device__ __forceinline__ void stage_rc(int b, int& R, int& C) { const int st = b / 1024, sb = b % 1024, swz = sb ^ (((sb >> 9) & 1) << 5); R = (st >> 1) * 16 + swz / 64; C = (st & 1) * 32 + (swz % 64) / 2; }
__host__ __device__ __forceinline__ int perm32(int rho) { const int n = rho >> 4, i = rho & 15; return 8 * (i >> 2) + 4 * n + (i & 3); }

struct Unit { int pm, pn; };
struct Gemm { const void* A; const void* Bt; int M, N, K, lda, ldb; int a_pn_off; int b_pm_split; size_t b_split_off; int b_pn_k = 0; int esz = 2;
    __device__ __forceinline__ const char* aptr(const Unit& u) const { return (const char*)A + ((size_t)u.pm * BM * lda + (size_t)u.pn * a_pn_off) * esz; }
    __device__ __forceinline__ const char* bptr(const Unit& u) const { return (const char*)Bt + (b_pn_k ? (size_t)u.pn * b_pn_k * esz : (size_t)u.pn * BM * ldb * esz) + (u.pm >= b_pm_split ? b_split_off : (size_t)0); }
};
struct StaticOrder {
    int nM, nN, nwg, G, c;
    __host__ __device__ void init(int M_, int N_, int G_, int c_) { nM = M_ / BM; nN = N_ / BM; nwg = nM * nN; G = G_; c = c_; }
    __host__ __device__ bool next(int i, Unit& u) const {
        const long L = (long)i * G + c; if (L >= nwg) return false;
        int wgid = (int)L; { const int q = nwg / NXCD, r = nwg % NXCD, xcd = wgid % NXCD, off = wgid / NXCD; wgid = (xcd < r ? xcd * (q + 1) : r * (q + 1) + (xcd - r) * q) + off; }
        const int nig = WGM * nN, gid = wgid / nig, fm = gid * WGM, gsz = (nM - fm) < WGM ? (nM - fm) : WGM;
        u.pm = fm + ((wgid % nig) % gsz); u.pn = (wgid % nig) / gsz; return true;
    }
};

__device__ __forceinline__ f32x2 gelu_pk(f32x2 v) {
    const f32x2 av = __builtin_elementwise_abs(v), d = av * 0.2316418882f + 1.0f;
    f32x2 t; t.x = __builtin_amdgcn_rcpf(d.x); t.y = __builtin_amdgcn_rcpf(d.y);
    f32x2 q = t * 0.5307027145f + (-0.7265760135f); q = q * t + 0.7107068705f; q = q * t + (-0.142248368f); q = q * t + 0.127414796f; q = q * t;
    const f32x2 s = (v * v) * (-0.72134752044f);
    f32x2 e; e.x = __builtin_amdgcn_exp2f(s.x); e.y = __builtin_amdgcn_exp2f(s.y);
    const f32x2 m = v * (q * e), r = v - m;
    f32x2 o; o.x = v.x < 0.f ? m.x : r.x; o.y = v.y < 0.f ? m.y : r.y; return o;
}
__device__ __forceinline__ float gelu1(float v) { f32x2 r = gelu_pk((f32x2){v, v}); return r.x; }

template <int ACT> struct EpiF16 {
    static constexpr bool PERM = true;
    f16* O; int ldc; const float* bias; int bias_pm_split; int bias_split_off;
    __device__ __forceinline__ void operator()(const f32x4 (&acc)[2][2][4][2], const Unit& u, int wr, int wc, int fr, int fq) const {
        const int row0 = u.pm * BM + wr * 64 + fr; const int col0 = u.pn * BM + wc * 32 + 8 * fq;
        const float* bp = bias ? bias + (u.pm >= bias_pm_split ? bias_split_off : 0) : nullptr;
        f32x4 bv[2][2];
#pragma unroll
        for (int bj = 0; bj < 2; ++bj)
#pragma unroll
            for (int n = 0; n < 2; ++n) bv[bj][n] = bp ? *(const f32x4*)(bp + col0 + bj * HALF + 4 * n) : (f32x4){0.f, 0.f, 0.f, 0.f};
#pragma unroll
        for (int ai = 0; ai < 2; ++ai)
#pragma unroll
            for (int m = 0; m < 4; ++m) { f16* rowp = O + (size_t)(row0 + ai * HALF + m * 16) * ldc + col0;
#pragma unroll
                for (int bj = 0; bj < 2; ++bj) { f32x4 v0 = acc[ai][bj][m][0] + bv[bj][0], v1 = acc[ai][bj][m][1] + bv[bj][1];
                    if (ACT == 1) { f32x2 a = gelu_pk((f32x2){v0[0], v0[1]}), b = gelu_pk((f32x2){v0[2], v0[3]}), c = gelu_pk((f32x2){v1[0], v1[1]}), d = gelu_pk((f32x2){v1[2], v1[3]});
                        v0 = (f32x4){a.x, a.y, b.x, b.y}; v1 = (f32x4){c.x, c.y, d.x, d.y}; }
                    u32x4 w; w.x = pk_f16(v0[0], v0[1]); w.y = pk_f16(v0[2], v0[3]); w.z = pk_f16(v1[0], v1[1]); w.w = pk_f16(v1[2], v1[3]);
                    *(u32x4*)(rowp + bj * HALF) = w; } }
    }
};
struct EpiRawF32 {
    static constexpr bool PERM = false;
    float* C; int ldc;
    __device__ __forceinline__ void operator()(const f32x4 (&acc)[2][2][4][2], const Unit& u, int wr, int wc, int fr, int fq) const {
        const int row0 = u.pm * BM + wr * 64 + fr, col0 = u.pn * BM + wc * 32 + 4 * fq;
#pragma unroll
        for (int ai = 0; ai < 2; ++ai)
#pragma unroll
            for (int m = 0; m < 4; ++m) { float* rowp = C + (size_t)(row0 + ai * HALF + m * 16) * ldc + col0;
#pragma unroll
                for (int bj = 0; bj < 2; ++bj)
#pragma unroll
                    for (int n = 0; n < 2; ++n) *(f32x4*)(rowp + bj * HALF + n * 16) = acc[ai][bj][m][n]; }
    }
};
struct EpiF8 {
    static constexpr bool PERM = true;
    unsigned char* O; int ldc; float sc;
    __device__ __forceinline__ void operator()(const f32x4 (&acc)[2][2][4][2], const Unit& u, int wr, int wc, int fr, int fq) const {
        const int row0 = u.pm * BM + wr * 64 + fr; const int col0 = u.pn * BM + wc * 32 + 8 * fq;
#pragma unroll
        for (int ai = 0; ai < 2; ++ai)
#pragma unroll
            for (int m = 0; m < 4; ++m) { unsigned char* rowp = O + (size_t)(row0 + ai * HALF + m * 16) * ldc + col0;
#pragma unroll
                for (int bj = 0; bj < 2; ++bj) { const f32x4 v0 = acc[ai][bj][m][0] * sc, v1 = acc[ai][bj][m][1] * sc;
                    u32x2 w; w.x = pk_fp8(v0[0], v0[1], v0[2], v0[3]); w.y = pk_fp8(v1[0], v1[1], v1[2], v1[3]);
                    *(u32x2*)(rowp + bj * HALF) = w; } }
    }
};
struct EpiRes16 {
    static constexpr bool PERM = true;
    f16* XR; float* SS; float as;
    __device__ __forceinline__ void operator()(const f32x4 (&acc)[2][2][4][2], const Unit& u, int wr, int wc, int fr, int fq) const {
        const int row0 = u.pm * BM + wr * 64 + fr; const int col0 = u.pn * BM + wc * 32 + 8 * fq;
#pragma unroll
        for (int ai = 0; ai < 2; ++ai) {
            f16x8 xb[4][2];
#pragma unroll
            for (int m = 0; m < 4; ++m)
#pragma unroll
                for (int bj = 0; bj < 2; ++bj) xb[m][bj] = *(const f16x8*)(XR + (size_t)(row0 + ai * HALF + m * 16) * D + col0 + bj * HALF);
            asm volatile("" ::: "memory");
#pragma unroll
            for (int m = 0; m < 4; ++m) { const int row = row0 + ai * HALF + m * 16; const size_t off = (size_t)row * D + col0; float ss = 0.f;
#pragma unroll
                for (int bj = 0; bj < 2; ++bj) { const f16x8 xv = xb[m][bj];
                    f32x4 v0 = acc[ai][bj][m][0] * as, v1 = acc[ai][bj][m][1] * as;
                    v0[0] += (float)xv[0]; v0[1] += (float)xv[1]; v0[2] += (float)xv[2]; v0[3] += (float)xv[3]; v1[0] += (float)xv[4]; v1[1] += (float)xv[5]; v1[2] += (float)xv[6]; v1[3] += (float)xv[7];
                    ss += ((v0[0] * v0[0] + v0[1] * v0[1]) + (v0[2] * v0[2] + v0[3] * v0[3])) + ((v1[0] * v1[0] + v1[1] * v1[1]) + (v1[2] * v1[2] + v1[3] * v1[3]));
                    u32x4 o; o.x = pk_f16(v0[0], v0[1]); o.y = pk_f16(v0[2], v0[3]); o.z = pk_f16(v1[0], v1[1]); o.w = pk_f16(v1[2], v1[3]);
                    *(u32x4*)(XR + off + bj * HALF) = o; }
                ss += __shfl_xor(ss, 16); ss += __shfl_xor(ss, 32);
                if (fq == 0) atomicAdd(SS + row, ss); }
            asm volatile("" ::: "memory"); }
    }
};
struct EpiF16Row {
    static constexpr bool PERM = true;
    f16* O; int ldc; const float* SS;
    __device__ __forceinline__ void operator()(const f32x4 (&acc)[2][2][4][2], const Unit& u, int wr, int wc, int fr, int fq) const {
        const int row0 = u.pm * BM + wr * 64 + fr; const int col0 = u.pn * BM + wc * 32 + 8 * fq;
#pragma unroll
        for (int ai = 0; ai < 2; ++ai)
#pragma unroll
            for (int m = 0; m < 4; ++m) { const int row = row0 + ai * HALF + m * 16; f16* rowp = O + (size_t)row * ldc + col0;
                const float rs = 1.f / sqrtf(SS[row] * (1.f / D) + RMS_EPS);
#pragma unroll
                for (int bj = 0; bj < 2; ++bj) { const f32x4 v0 = acc[ai][bj][m][0] * rs, v1 = acc[ai][bj][m][1] * rs;
                    u32x4 o; o.x = pk_f16(v0[0], v0[1]); o.y = pk_f16(v0[2], v0[3]); o.z = pk_f16(v1[0], v1[1]); o.w = pk_f16(v1[2], v1[3]);
                    *(u32x4*)(rowp + bj * HALF) = o; } }
    }
};
struct EpiFinal {
    static constexpr bool PERM = true;
    const f16* XR; const f16* PJ; float* C; const float* SS; float as;
    __device__ __forceinline__ void operator()(const f32x4 (&acc)[2][2][4][2], const Unit& u, int wr, int wc, int fr, int fq) const {
        const int row0 = u.pm * BM + wr * 64 + fr; const int col0 = u.pn * BM + wc * 32 + 8 * fq;
#pragma unroll
        for (int ai = 0; ai < 2; ++ai)
#pragma unroll
            for (int mh = 0; mh < 2; ++mh) {
                f16x8 xb[2][2], pb[2][2]; float ssv[2];
#pragma unroll
                for (int mm = 0; mm < 2; ++mm) { const int row = row0 + ai * HALF + (2 * mh + mm) * 16; ssv[mm] = SS[row];
#pragma unroll
                    for (int bj = 0; bj < 2; ++bj) { xb[mm][bj] = *(const f16x8*)(XR + (size_t)row * D + col0 + bj * HALF); pb[mm][bj] = *(const f16x8*)(PJ + (size_t)row * D + col0 + bj * HALF); } }
                asm volatile("" ::: "memory");
#pragma unroll
                for (int mm = 0; mm < 2; ++mm) { const int m = 2 * mh + mm; const int row = row0 + ai * HALF + m * 16; const size_t off = (size_t)row * D + col0;
                    const float nrs = -LOG2E * as / sqrtf(ssv[mm] * (1.f / D) + RMS_EPS);
#pragma unroll
                    for (int bj = 0; bj < 2; ++bj) { const f16x8 xv = xb[mm][bj], pv = pb[mm][bj];
                        const f32x4 a0 = acc[ai][bj][m][0], a1 = acc[ai][bj][m][1]; f32x4 o0, o1;
#pragma unroll
                        for (int j = 0; j < 4; ++j) { o0[j] = (float)xv[j] + (float)pv[j] * __builtin_amdgcn_rcpf(1.0f + __builtin_amdgcn_exp2f(nrs * a0[j]));
                            o1[j] = (float)xv[4 + j] + (float)pv[4 + j] * __builtin_amdgcn_rcpf(1.0f + __builtin_amdgcn_exp2f(nrs * a1[j])); }
                        *(f32x4*)(C + off + bj * HALF) = o0; *(f32x4*)(C + off + bj * HALF + 4) = o1; } }
                asm volatile("" ::: "memory"); }
    }
};
template <int MODE> struct EpiF32 {
    static constexpr bool PERM = false;
    const float* base; float* C; int ldc; const f16* pj; const float* ssp;
    __device__ __forceinline__ void operator()(const f32x4 (&acc)[2][2][4][2], const Unit& u, int wr, int wc, int fr, int fq) const {
        const int row0 = u.pm * BM + wr * 64 + fr, col0 = u.pn * BM + wc * 32 + 4 * fq;
#pragma unroll
        for (int ai = 0; ai < 2; ++ai)
#pragma unroll
            for (int m = 0; m < 4; ++m) { const size_t off = (size_t)(row0 + ai * HALF + m * 16) * ldc + col0;
                float nrs = -LOG2E;
                if (MODE == 1) { const f32x4 s0 = *(const f32x4*)(ssp + (size_t)(row0 + ai * HALF + m * 16) * 8), s1 = *(const f32x4*)(ssp + (size_t)(row0 + ai * HALF + m * 16) * 8 + 4);
                    nrs = -LOG2E / sqrtf((((s0.x + s0.y) + (s0.z + s0.w)) + ((s1.x + s1.y) + (s1.z + s1.w))) * (1.f / D) + RMS_EPS); }
#pragma unroll
                for (int bj = 0; bj < 2; ++bj)
#pragma unroll
                    for (int n = 0; n < 2; ++n) { const size_t o2 = off + bj * HALF + n * 16; const f32x4 bs = *(const f32x4*)(base + o2); f32x4 a = acc[ai][bj][m][n];
                        if (MODE == 1) { const f16x4 pv = *(const f16x4*)(pj + o2);
#pragma unroll
                            for (int j = 0; j < 4; ++j) a[j] = (float)pv[j] * __builtin_amdgcn_rcpf(1.0f + __builtin_amdgcn_exp2f(nrs * a[j])); }
                        *(f32x4*)(C + o2) = bs + a; }
                asm volatile("" ::: "memory"); }
    }
};

typedef int i32x4v __attribute__((ext_vector_type(4)));
typedef int i32x8v __attribute__((ext_vector_type(8)));
__device__ __forceinline__ i32x8v cat16(const f16x8 a, const f16x8 b) { const i32x4v x = __builtin_bit_cast(i32x4v, a), y = __builtin_bit_cast(i32x4v, b); return __builtin_shufflevector(x, y, 0, 1, 2, 3, 4, 5, 6, 7); }
__device__ __forceinline__ f16x8 half16(const i32x8v& v, int k) { const i32x4v h = k ? __builtin_shufflevector(v, v, 4, 5, 6, 7) : __builtin_shufflevector(v, v, 0, 1, 2, 3); return __builtin_bit_cast(f16x8, h); }
template <class Epi, class Sched, bool F8 = false>
__device__ __forceinline__ void gemm_phase(LAS unsigned char* lds, const Gemm g, const Sched& S, const Epi& E) {
    int tid = threadIdx.x; asm volatile("" : "+v"(tid));
    const int wid = __builtin_amdgcn_readfirstlane(tid >> 6), lane = tid & 63, wr = wid >> 2, wc = wid & 3, fr = lane & 15, fq = lane >> 4;
    const int K = g.K, nt = K * g.esz / (BK * 2);
    unsigned voffA[2], voffB[2];
#pragma unroll
    for (int i = 0; i < 2; ++i) { int R, C; stage_rc(tid * 16 + i * 8192, R, C); const int Rb = Epi::PERM ? ((R & ~31) + perm32(R & 31)) : R;
        voffA[i] = (unsigned)(R * g.lda * g.esz + C * 2); voffB[i] = (unsigned)(Rb * g.ldb * g.esz + C * 2); }
    const size_t kstep = (size_t)(BK * 2);
    const size_t hstepA = (size_t)HALF * g.lda * g.esz, hstepB = (size_t)HALF * g.ldb * g.esz;
    const unsigned ldsw = (unsigned)wid * 1024u;
    const int aoff = lds_byte(wr * 64 + fr, fq * 8), boff = lds_byte(wc * 32 + fr, fq * 8);
#define PG8_SA(b, h) (((b) * 2 + (h)) * HTB)
#define PG8_SB(b, h) ((4 + (b) * 2 + (h)) * HTB)
#define PG8_STAGE(bufoff, gbase, voff) do { _Pragma("unroll") for (int _i = 0; _i < 2; ++_i) \
        __builtin_amdgcn_global_load_lds((const unsigned*)((const char*)(gbase) + (voff)[_i]), (LAS unsigned*)(lds + (bufoff) + ldsw + _i * 8192), 16, 0, 0); } while (0)
#define PG8_LDA(dst, b, h) do { _Pragma("unroll") for (int m = 0; m < 4; ++m) dst[m] = cat16(*(const LAS f16x8*)(lds + PG8_SA(b, h) + aoff + m * 2048), *(const LAS f16x8*)(lds + PG8_SA(b, h) + aoff + m * 2048 + 1024)); } while (0)
#define PG8_LDB(dst, b, h) do { _Pragma("unroll") for (int n = 0; n < 2; ++n) dst[n] = cat16(*(const LAS f16x8*)(lds + PG8_SB(b, h) + boff + n * 2048), *(const LAS f16x8*)(lds + PG8_SB(b, h) + boff + n * 2048 + 1024)); } while (0)
#define PG8_MMA(ai, bj, At, Bt) do { __builtin_amdgcn_s_setprio(1); \
        if (F8) { _Pragma("unroll") for (int m = 0; m < 4; ++m) _Pragma("unroll") for (int n = 0; n < 2; ++n) \
            asm volatile("v_mfma_scale_f32_16x16x128_f8f6f4 %0, %1, %2, %0, %3, %3 op_sel_hi:[0,0,0]" : "+v"(acc[ai][bj][m][n]) : "v"(Bt[n]), "v"(At[m]), "v"(0x7F7F7F7F)); } \
        else { _Pragma("unroll") for (int m = 0; m < 4; ++m) _Pragma("unroll") for (int n = 0; n < 2; ++n) _Pragma("unroll") for (int k = 0; k < 2; ++k) \
            acc[ai][bj][m][n] = __builtin_amdgcn_mfma_f32_16x16x32_f16(half16(Bt[n], k), half16(At[m], k), acc[ai][bj][m][n], 0, 0, 0); } \
        __builtin_amdgcn_s_setprio(0); } while (0)
#define PG8_WAIT_V(n) asm volatile("s_waitcnt vmcnt(" #n ")" ::: "memory")
#define PG8_WAIT_L(n) asm volatile("s_waitcnt lgkmcnt(" #n ")" ::: "memory")
#define PG8_BAR __builtin_amdgcn_s_barrier()
#define PG8_SCHED __builtin_amdgcn_sched_barrier(0)
    Unit cur, nxt; int ui = 0;
    if (!S.next(0, cur)) return;
    f32x4 acc[2][2][4][2];
#pragma unroll
    for (int a = 0; a < 2; ++a)
#pragma unroll
        for (int b = 0; b < 2; ++b)
#pragma unroll
            for (int m = 0; m < 4; ++m)
#pragma unroll
                for (int n = 0; n < 2; ++n) acc[a][b][m][n] = (f32x4){0.f, 0.f, 0.f, 0.f};
    i32x8v At[4], B0[2], B1[2];
    const char* cA = g.aptr(cur); const char* cB = g.bptr(cur);
    PG8_STAGE(PG8_SB(0, 0), cB, voffB); PG8_STAGE(PG8_SB(0, 1), cB + hstepB, voffB); PG8_STAGE(PG8_SA(0, 0), cA, voffA); PG8_STAGE(PG8_SA(0, 1), cA + hstepA, voffA);
    if (wr == 1) PG8_BAR;
    PG8_WAIT_V(2); PG8_BAR;
    PG8_STAGE(PG8_SB(1, 0), cB + kstep, voffB); PG8_STAGE(PG8_SA(1, 0), cA + kstep, voffA); PG8_STAGE(PG8_SB(1, 1), cB + hstepB + kstep, voffB);
    PG8_WAIT_V(6); PG8_BAR;
    for (;;) {
        const bool has_next = S.next(ui + 1, nxt);
        const char* nA = has_next ? g.aptr(nxt) : cA; const char* nB = has_next ? g.bptr(nxt) : cB;
#pragma clang loop unroll(disable)
        for (int t = 0; t < nt; t += 2) {
            const bool last = (t == nt - 2);
            const char* a1 = cA + (size_t)(t + 1) * kstep;
            const char* a2 = last ? nA : cA + (size_t)(t + 2) * kstep; const char* b2 = last ? nB : cB + (size_t)(t + 2) * kstep;
            const char* a3 = a2 + kstep; const char* b3 = b2 + kstep;
            PG8_LDB(B0, 0, 0); PG8_LDB(B1, 0, 1); PG8_SCHED; PG8_LDA(At, 0, 0); PG8_STAGE(PG8_SA(1, 1), a1 + hstepA, voffA);
            PG8_WAIT_V(8); PG8_WAIT_L(0); PG8_BAR; PG8_MMA(0, 0, At, B0); PG8_MMA(0, 1, At, B1); PG8_BAR; PG8_SCHED;
            PG8_LDA(At, 0, 1); PG8_STAGE(PG8_SB(0, 0), b2, voffB); PG8_STAGE(PG8_SB(0, 1), b2 + hstepB, voffB); PG8_STAGE(PG8_SA(0, 0), a2, voffA);
            PG8_WAIT_V(8); PG8_WAIT_L(0); PG8_BAR; PG8_MMA(1, 0, At, B0); PG8_MMA(1, 1, At, B1); PG8_BAR; PG8_SCHED;
            PG8_LDB(B0, 1, 0); PG8_LDB(B1, 1, 1); PG8_SCHED; PG8_LDA(At, 1, 0); PG8_STAGE(PG8_SA(0, 1), a2 + hstepA, voffA);
            PG8_WAIT_V(8); PG8_WAIT_L(0); PG8_BAR; PG8_MMA(0, 0, At, B0); PG8_MMA(0, 1, At, B1); PG8_BAR; PG8_SCHED;
            PG8_LDA(At, 1, 1); PG8_STAGE(PG8_SB(1, 0), b3, voffB); PG8_STAGE(PG8_SB(1, 1), b3 + hstepB, voffB); PG8_STAGE(PG8_SA(1, 0), a3, voffA);
            PG8_WAIT_V(8); PG8_WAIT_L(0); PG8_BAR; PG8_MMA(1, 0, At, B0); PG8_MMA(1, 1, At, B1); PG8_BAR; PG8_SCHED;
        }
        if (F8) asm volatile("s_nop 15\n\ts_nop 15" ::: "memory");
        if (wr == 0) PG8_BAR;
        E(acc, cur, wr, wc, fr, fq);
        if (!has_next) break;
#pragma unroll
        for (int a = 0; a < 2; ++a)
#pragma unroll
            for (int b = 0; b < 2; ++b)
#pragma unroll
                for (int m = 0; m < 4; ++m)
#pragma unroll
                    for (int n = 0; n < 2; ++n) acc[a][b][m][n] = (f32x4){0.f, 0.f, 0.f, 0.f};
        cur = nxt; cA = nA; cB = nB; ++ui;
        if (wr == 1) PG8_BAR;
    }
    PG8_WAIT_V(0);
    PG8_BAR;
#undef PG8_SA
#undef PG8_SB
#undef PG8_STAGE
#undef PG8_LDA
#undef PG8_LDB
#undef PG8_MMA
#undef PG8_WAIT_V
#undef PG8_WAIT_L
#undef PG8_BAR
#undef PG8_SCHED
}
}

#define XB_TMO      128
#define XB_XCNT(j)  (256  + 64 * (j))
#define XB_XSUB(j)  (1280 + 64 * (j))
#define XB_XGEN(j)  (2304 + 64 * (j))
#define XB_TOP      3328
#define XB_TOPGEN   3392
#define XCD_BAR_WORDS 3456
#define XB_SPIN_CAP (1u << 18)
__device__ __forceinline__ unsigned xb_ld(unsigned* p)              { return __hip_atomic_load(p, __ATOMIC_RELAXED, __HIP_MEMORY_SCOPE_AGENT); }
__device__ __forceinline__ unsigned xb_add(unsigned* p, unsigned v) { return __hip_atomic_fetch_add(p, v, __ATOMIC_RELAXED, __HIP_MEMORY_SCOPE_AGENT); }
__device__ __forceinline__ unsigned xb_xcc_id() { return (unsigned)__builtin_amdgcn_s_getreg((3 << 11) | 20) & 0xFu; }
#define XB_SPIN(cond, bar) do { unsigned _sp = 0; while (cond) { __builtin_amdgcn_s_sleep(1); \
    if ((++_sp & 255u) == 0u) { if (xb_ld(&(bar)[XB_TMO])) break; if (_sp > XB_SPIN_CAP) { atomicAdd(&(bar)[XB_TMO], 1u); break; } } } } while (0)
struct XcdBarrier { unsigned* bar; unsigned x; volatile LAS unsigned* st; };
__device__ __forceinline__ XcdBarrier xcd_barrier_post(unsigned* bar, volatile LAS unsigned* st) {
    XcdBarrier b; b.bar = bar; b.x = xb_xcc_id(); b.st = st;
    if (threadIdx.x == 0) (void)xb_add(&bar[XB_XCNT(b.x)], 1u);
    return b;
}
__device__ __forceinline__ void xcd_barrier_complete(unsigned* bar, unsigned x, unsigned& nloc, unsigned& nx) {
    const unsigned G = gridDim.x * gridDim.y * gridDim.z;
    unsigned sum, cnt, mine, sp = 0u;
    for (;;) {
        sum = 0u; cnt = 0u; mine = 0u;
#pragma unroll
        for (unsigned j = 0; j < 16; ++j) { const unsigned c = xb_ld(&bar[XB_XCNT(j)]); sum += c; cnt += (c > 0u) ? 1u : 0u; mine = (j == x) ? c : mine; }
        if (sum == G) break;
        __builtin_amdgcn_s_sleep(1);
        if ((++sp & 255u) == 0u) { if (xb_ld(&bar[XB_TMO])) break; if (sp > XB_SPIN_CAP) { atomicAdd(&bar[XB_TMO], 1u); break; } }
    }
    nloc = mine > 0u ? mine : 1u; nx = cnt > 0u ? cnt : 1u;
}
__device__ __forceinline__ void xcd_barrier(const XcdBarrier& b) {
    asm volatile("s_waitcnt vmcnt(0)" ::: "memory");
    __syncthreads();
    if (threadIdx.x == 0) {
        unsigned* bar = b.bar;
        __builtin_amdgcn_s_waitcnt(0);
        unsigned nloc = b.st[0], nx = b.st[1];
        if (nloc == 0u) { xcd_barrier_complete(bar, b.x, nloc, nx); b.st[0] = nloc; b.st[1] = nx; }
        const unsigned old = xb_add(&bar[XB_XSUB(b.x)], 1u);
        const unsigned gen = old / nloc;
        if (old + 1u == (gen + 1u) * nloc) {
            __builtin_amdgcn_fence(__ATOMIC_RELEASE, "agent");
            asm volatile("s_waitcnt vmcnt(0)" ::: "memory");
            const unsigned og = xb_add(&bar[XB_TOP], 1u);
            const unsigned tg = og / nx;
            if (og + 1u == (tg + 1u) * nx) xb_add(&bar[XB_TOPGEN], 1u);
            else XB_SPIN(xb_ld(&bar[XB_TOPGEN]) == tg, bar);
            __builtin_amdgcn_fence(__ATOMIC_ACQUIRE, "agent");
            xb_add(&bar[XB_XGEN(b.x)], 1u);
            asm volatile("s_waitcnt vmcnt(0)" ::: "memory");
        } else {
            XB_SPIN(xb_ld(&bar[XB_XGEN(b.x)]) == gen, bar);
            __builtin_amdgcn_fence(__ATOMIC_ACQUIRE, "agent");
            asm volatile("s_waitcnt vmcnt(0)" ::: "memory");
        }
    }
    __syncthreads();
}

struct Frame {
    LAS unsigned char* lds;
    volatile LAS unsigned* MISC;
    int tid, lane, wave;
    int vcu, G;
    const float* in[26];
    float* out;
    unsigned char* ws;
};
enum { I_X = 0, I_P, I_RELB, I_MIXNW, I_WIN, I_QNW, I_KNW, I_CKPOS, I_CKW1, I_CKB1, I_CKW2, I_CVPOS, I_CVW1, I_CVB1, I_CVW2, I_POOLW, I_POOLS, I_WOUT, I_FFNNW, I_PWQ, I_PKEYS, I_PU, I_PV, I_PLENW, I_PLEWG, I_PLEWP };

__device__ __forceinline__ void p0_transpose_item(const float* W, int K, int N, int Npad, const float* colscale, f16* WT, LAS float* scr, int item, int lane, const float* kscale = nullptr, bool f8 = false, float wscale = 1.f) {
    const int nblk = Npad / 32, kb = item / nblk, nb = item % nblk, k0 = 64 * kb, n0 = 32 * nb;
    const int nn = n0 + (lane & 31); const bool ok = nn < N;
#pragma unroll
    for (int hgrp = 0; hgrp < 2; ++hgrp) { float wv[16];
#pragma unroll
        for (int i = 0; i < 16; ++i) { const int kk = 2 * (16 * hgrp + i) + (lane >> 5); wv[i] = ok ? W[(size_t)(k0 + kk) * N + nn] : 0.f; }
        if (kscale) {
#pragma unroll
            for (int i = 0; i < 16; ++i) wv[i] *= kscale[k0 + 2 * (16 * hgrp + i) + (lane >> 5)]; }
#pragma unroll
        for (int i = 0; i < 16; ++i) { const int kk = 2 * (16 * hgrp + i) + (lane >> 5); scr[kk * 33 + (lane & 31)] = wv[i]; }
        asm volatile("" ::: "memory"); }
    LDS_WAIT(); asm volatile("" ::: "memory");
    const int c = lane & 7;
#pragma unroll
    for (int j = 0; j < 4; ++j) { const int n = (lane >> 3) + 8 * j; const LAS float* s = scr + (8 * c) * 33 + n; const float sc = (colscale && n0 + n < N) ? colscale[n0 + n] : 1.f;
        if (f8) { const float s8 = sc * wscale; u32x2 o; o.x = pk_fp8(s[0 * 33] * s8, s[1 * 33] * s8, s[2 * 33] * s8, s[3 * 33] * s8); o.y = pk_fp8(s[4 * 33] * s8, s[5 * 33] * s8, s[6 * 33] * s8, s[7 * 33] * s8);
            *(GAS u32x2*)((unsigned char*)WT + (size_t)(n0 + n) * K + k0 + 8 * c) = o; }
        else { u32x4 o; o.x = pk_f16(s[0 * 33] * sc, s[1 * 33] * sc); o.y = pk_f16(s[2 * 33] * sc, s[3 * 33] * sc); o.z = pk_f16(s[4 * 33] * sc, s[5 * 33] * sc); o.w = pk_f16(s[6 * 33] * sc, s[7 * 33] * sc);
            *(GAS u32x4*)(WT + (size_t)(n0 + n) * K + k0 + 8 * c) = o; } }
    LDS_WAIT(); asm volatile("" ::: "memory");
}
__device__ __forceinline__ void rms_row_to_f16(const float* xrow, const float* w, f16* orow, int lane, f16* x16row = nullptr) {
    const GAS f32x4* xr = (const GAS f32x4*)xrow + lane; const GAS f32x4* wr = (const GAS f32x4*)w + lane;
    f32x4 v[8]; float s = 0.f;
#pragma unroll
    for (int j = 0; j < 8; ++j) { v[j] = xr[64 * j]; s += (v[j].x * v[j].x + v[j].y * v[j].y) + (v[j].z * v[j].z + v[j].w * v[j].w); }
    const float rstd = 1.f / sqrtf(wave_sum(s) * (1.f / D) + RMS_EPS);
    GAS u32x2* o8 = (GAS u32x2*)orow + lane;
#pragma unroll
    for (int j = 0; j < 8; ++j) { const f32x4 g = wr[64 * j]; u32x2 o; o.x = pk_f16(v[j].x * rstd * g.x, v[j].y * rstd * g.y); o.y = pk_f16(v[j].z * rstd * g.z, v[j].w * rstd * g.w); o8[64 * j] = o; }
    if (x16row) { GAS u32x2* x8 = (GAS u32x2*)x16row + lane;
#pragma unroll
        for (int j = 0; j < 8; ++j) { u32x2 o; o.x = pk_f16(v[j].x, v[j].y); o.y = pk_f16(v[j].z, v[j].w); x8[64 * j] = o; } }
}
__device__ __forceinline__ void rms_2rows_to_f16(const float* x0, const float* x1, const float* w, f16* o0, f16* o1, f16* h0, f16* h1, int lane) {
    const GAS f32x4* xa = (const GAS f32x4*)x0 + lane; const GAS f32x4* xb = (const GAS f32x4*)x1 + lane; const GAS f32x4* wr = (const GAS f32x4*)w + lane;
    f32x4 va[8], vb[8]; float sa = 0.f, sb = 0.f;
#pragma unroll
    for (int j = 0; j < 8; ++j) { va[j] = __builtin_nontemporal_load(xa + 64 * j); vb[j] = __builtin_nontemporal_load(xb + 64 * j); }
#pragma unroll
    for (int j = 0; j < 8; ++j) { sa += (va[j].x * va[j].x + va[j].y * va[j].y) + (va[j].z * va[j].z + va[j].w * va[j].w); sb += (vb[j].x * vb[j].x + vb[j].y * vb[j].y) + (vb[j].z * vb[j].z + vb[j].w * vb[j].w); }
    const float ra = 1.f / sqrtf(wave_sum(sa) * (1.f / D) + RMS_EPS), rb = 1.f / sqrtf(wave_sum(sb) * (1.f / D) + RMS_EPS);
    GAS u32x2* pa = (GAS u32x2*)o0 + lane; GAS u32x2* pb = (GAS u32x2*)o1 + lane; GAS u32x2* qa = (GAS u32x2*)h0 + lane; GAS u32x2* qb = (GAS u32x2*)h1 + lane;
#pragma unroll
    for (int j = 0; j < 8; ++j) { const f32x4 g = wr[64 * j]; u32x2 o;
        o.x = pk_f16(va[j].x * ra * g.x, va[j].y * ra * g.y); o.y = pk_f16(va[j].z * ra * g.z, va[j].w * ra * g.w); pa[64 * j] = o;
        o.x = pk_f16(vb[j].x * rb * g.x, vb[j].y * rb * g.y); o.y = pk_f16(vb[j].z * rb * g.z, vb[j].w * rb * g.w); pb[64 * j] = o;
        o.x = pk_f16(va[j].x, va[j].y); o.y = pk_f16(va[j].z, va[j].w); qa[64 * j] = o;
        o.x = pk_f16(vb[j].x, vb[j].y); o.y = pk_f16(vb[j].z, vb[j].w); qb[64 * j] = o; }
}
__device__ __forceinline__ void x16_2rows(const float* x0, const float* x1, f16* h0, f16* h1, float* ss0, float* ss1, int lane) {
    const GAS f32x4* xa = (const GAS f32x4*)x0 + lane; const GAS f32x4* xb = (const GAS f32x4*)x1 + lane;
    f32x4 va[8], vb[8]; float sa = 0.f, sb = 0.f;
#pragma unroll
    for (int j = 0; j < 8; ++j) { va[j] = __builtin_nontemporal_load(xa + 64 * j); vb[j] = __builtin_nontemporal_load(xb + 64 * j); }
    GAS u32x2* qa = (GAS u32x2*)h0 + lane; GAS u32x2* qb = (GAS u32x2*)h1 + lane;
#pragma unroll
    for (int j = 0; j < 8; ++j) { sa += (va[j].x * va[j].x + va[j].y * va[j].y) + (va[j].z * va[j].z + va[j].w * va[j].w); sb += (vb[j].x * vb[j].x + vb[j].y * vb[j].y) + (vb[j].z * vb[j].z + vb[j].w * vb[j].w);
        u32x2 o; o.x = pk_f16(va[j].x, va[j].y); o.y = pk_f16(va[j].z, va[j].w); qa[64 * j] = o;
        o.x = pk_f16(vb[j].x, vb[j].y); o.y = pk_f16(vb[j].z, vb[j].w); qb[64 * j] = o; }
    sa = wave_sum(sa); sb = wave_sum(sb);
    if (lane == 0) { *ss0 = sa; *ss1 = sb; }
}
__device__ __forceinline__ void cvt_f32_f16(Frame& F, const float* src, f16* dst, size_t n) {
    const size_t gt = (size_t)F.vcu * 512 + F.tid, GT = (size_t)F.G * 512;
    for (size_t i = gt; i < n / 8; i += GT) { const f32x4 a = *(const GAS f32x4*)(src + i * 8), b = *(const GAS f32x4*)(src + i * 8 + 4);
        u32x4 o; o.x = pk_f16(a.x, a.y); o.y = pk_f16(a.z, a.w); o.z = pk_f16(b.x, b.y); o.w = pk_f16(b.z, b.w); *(GAS u32x4*)(dst + i * 8) = o; }
}

__device__ __forceinline__ void p0_prologue(Frame& F) {
    LAS float* scr = (LAS float*)(F.lds + F.wave * 16384);
    const int gw = F.vcu * NWAVES + F.wave, NGW = F.G * NWAVES;
    unsigned char* ws = F.ws;
    constexpr int I_IN = (D / 64) * (NINP / 32), I_SQ = (D / 64) * (D / 32), I_PJ = (256 / 64) * (D / 32), I_C1 = (D / 64) * (256 / 32), I_PL = (256 / 64) * (256 / 32);
    constexpr int NITEMS = I_IN + 3 * I_SQ + I_PJ + 2 * I_C1 + 4 * I_PL;
    for (int it = gw; it < NITEMS; it += NGW) {
        int r = it;
        if (r < I_IN) { p0_transpose_item(F.in[I_WIN], D, NIN, NINP, nullptr, (f16*)(ws + WS_WIN), scr, r, F.lane, F.in[I_MIXNW]); continue; } r -= I_IN;
        if (r < I_SQ) { p0_transpose_item(F.in[I_WOUT], D, D, D, nullptr, (f16*)(ws + WS_WOUT), scr, r, F.lane, nullptr, true, W8SCALE); continue; } r -= I_SQ;
        if (r < I_SQ) { p0_transpose_item(F.in[I_PWQ], D, D, D, nullptr, (f16*)(ws + WS_WQ), scr, r, F.lane, F.in[I_FFNNW]); continue; } r -= I_SQ;
        if (r < I_SQ) { p0_transpose_item(F.in[I_PLEWG], D, D, D, nullptr, (f16*)(ws + WS_WG), scr, r, F.lane, F.in[I_PLENW], true, W8SCALE); continue; } r -= I_SQ;
        if (r < I_PJ) { p0_transpose_item(F.in[I_PLEWP], 256, D, D, nullptr, (f16*)(ws + WS_WPJ), scr, r, F.lane); continue; } r -= I_PJ;
        if (r < I_C1) { p0_transpose_item(F.in[I_CKW1], D, 256, 256, nullptr, (f16*)(ws + WS_W1C), scr, r, F.lane); continue; } r -= I_C1;
        if (r < I_C1) { p0_transpose_item(F.in[I_CVW1], D, 256, 256, nullptr, (f16*)(ws + WS_W1C) + 256 * D, scr, r, F.lane); continue; } r -= I_C1;
        { const int g = r / I_PL; r -= g * I_PL;
          p0_transpose_item(F.in[I_POOLW] + (size_t)g * 65536, 256, 256, 256, F.in[I_POOLS] + g * 256, (f16*)(ws + WS_POOLT) + (size_t)g * 65536, scr, r, F.lane); }
    }
    { float* SS0 = (float*)(ws + WS_SS0); f16* XR = (f16*)(ws + WS_XR);
      for (int m = gw; m < M; m += 2 * NGW) { const int m2 = m + NGW < M ? m + NGW : m;
          x16_2rows(F.in[I_X] + (size_t)m * D, F.in[I_X] + (size_t)m2 * D, XR + (size_t)m * D, XR + (size_t)m2 * D, SS0 + m, SS0 + m2, F.lane); } }
    cvt_f32_f16(F, F.in[I_P], (f16*)(ws + WS_P16), (size_t)M * 256);
    cvt_f32_f16(F, F.in[I_PKEYS], (f16*)(ws + WS_KEYS), (size_t)8 * 2 * 128 * 128);
    for (int task = gw; task < 512; task += NGW) { const int mat = task >> 8, n = task & 255;
        const float* pos = F.in[mat ? I_CVPOS : I_CKPOS]; const float* w1 = F.in[mat ? I_CVW1 : I_CKW1]; float s = 0.f;
#pragma unroll
        for (int i = 0; i < 32; ++i) { const int k = F.lane + 64 * i; s += pos[k] * w1[(size_t)k * 256 + n]; }
        s = wave_sum(s);
        if (F.lane == 0) ((float*)(ws + WS_CBIAS))[task] = s + F.in[mat ? I_CVB1 : I_CKB1][n]; }
}

template <int W> __device__ __forceinline__ void pool_mix_tile(const f16* up, f16* mp, size_t mb, int s0) {
    f16x2 prev[16], cur[16]; f32x2 sum = {0.f, 0.f};
#pragma unroll
    for (int i = 0; i < 16; ++i) { const int sp = s0 - 16 + i; prev[i] = sp >= 0 ? *(const GAS f16x2*)(up + (mb + sp) * NINP) : (f16x2){(f16)0.f, (f16)0.f}; }
#pragma unroll
    for (int i = 16 - W; i < 16; ++i) { sum.x += (float)prev[i].x; sum.y += (float)prev[i].y; }
#pragma unroll 1
    for (int blk = 0; blk < 4; ++blk) { const int sb = s0 + blk * 16;
#pragma unroll
        for (int i = 0; i < 16; ++i) cur[i] = *(const GAS f16x2*)(up + (mb + sb + i) * NINP);
#pragma unroll
        for (int i = 0; i < 16; ++i) { const int s = sb + i; const f16x2 o = (i - W >= 0) ? cur[(i - W >= 0) ? i - W : 0] : prev[(i - W >= 0) ? 0 : 16 + i - W];
            sum.x += (float)cur[i].x - (float)o.x; sum.y += (float)cur[i].y - (float)o.y;
            const float ic = 1.f / (float)(s + 1 < W ? s + 1 : W);
            *(GAS unsigned*)(mp + (mb + s) * 1024) = pk_f16(sum.x * ic - (float)cur[i].x, sum.y * ic - (float)cur[i].y); }
#pragma unroll
        for (int i = 0; i < 16; ++i) prev[i] = cur[i]; }
}
__device__ __forceinline__ void p2_post(Frame& F) {
    unsigned char* ws = F.ws;
    f16* Y = (f16*)(ws + WS_Y);
    const float* qnw = F.in[I_QNW]; const float* knw = F.in[I_KNW];
    LAS f16* vl = (LAS f16*)F.lds;
    constexpr int VLP = 264;
    for (int tt = F.vcu; tt < M / 64; tt += F.G) {
        const int b = tt >> 5, s0 = (tt & 31) * 64, m0 = tt * 64;
        for (int tk = F.wave; tk < 64; tk += NWAVES) {
            const int m = m0 + tk, s = s0 + tk; f16* yr = Y + (size_t)m * NINP;
#pragma unroll
            for (int pass = 0; pass < 2; ++pass) { const int ch = pass * 64 + F.lane; f16* pq = yr + OFF_Q + ch * 8; const f16x8 v = *(const GAS f16x8*)pq;
                float ss = 0.f;
#pragma unroll
                for (int e = 0; e < 8; ++e) ss += (float)v[e] * (float)v[e];
                ss = sum8(ss);
                const float rs = (1.f / sqrtf(ss * (1.f / 64.f) + RMS_EPS)) * (0.125f * LOG2E); const float* w = qnw + (ch & 7) * 8;
                u32x4 o; o.x = pk_f16((float)v[0] * rs * w[0], (float)v[1] * rs * w[1]); o.y = pk_f16((float)v[2] * rs * w[2], (float)v[3] * rs * w[3]);
                o.z = pk_f16((float)v[4] * rs * w[4], (float)v[5] * rs * w[5]); o.w = pk_f16((float)v[6] * rs * w[6], (float)v[7] * rs * w[7]);
                *(GAS u32x4*)((f16*)(ws + WS_QN) + (size_t)m * 1024 + ch * 8) = o; }
            { const int br = F.lane >> 5, ch = F.lane & 31, g = ch >> 3, dc = ch & 7; const f16x8 v = *(const GAS f16x8*)(yr + (br ? OFF_KW : OFF_KS) + ch * 8);
                float ss = 0.f;
#pragma unroll
                for (int e = 0; e < 8; ++e) ss += (float)v[e] * (float)v[e];
                ss = sum8(ss);
                const float rs = 1.f / sqrtf(ss * (1.f / 64.f) + RMS_EPS); const float* w = knw + dc * 8;
                u32x2 o; o.x = pk_fp8((float)v[0] * rs * w[0], (float)v[1] * rs * w[1], (float)v[2] * rs * w[2], (float)v[3] * rs * w[3]);
                o.y = pk_fp8((float)v[4] * rs * w[4], (float)v[5] * rs * w[5], (float)v[6] * rs * w[6], (float)v[7] * rs * w[7]);
                *(GAS u32x2*)(ws + WS_KN + (size_t)br * (BATCH * 4 * SEQ * 64) + ((size_t)(b * 4 + g) * 64 + (s >> 5)) * 2048 + (dc >> 2) * 1024 + ((dc & 1) * 32 + (s & 31)) * 16 + ((dc >> 1) & 1) * 8) = o; }
            { const int mat = F.lane >> 5, ch = F.lane & 31, g = ch >> 3, dc = ch & 7; const u32x4 v = *(const GAS u32x4*)(yr + (mat ? OFF_VC : OFF_KC) + ch * 8);
                const int i1 = s >> 4, jj = s & 15; f16* fa = (f16*)(ws + WS_FLATA) + (size_t)mat * 4096 * 2048;
                if (i1 <= NCMP - 1) *(GAS u32x4*)(fa + (size_t)((b * NCMP + i1) * 4 + g) * 2048 + jj * 64 + dc * 8) = v;
                if (i1 >= 1) *(GAS u32x4*)(fa + (size_t)((b * NCMP + i1 - 1) * 4 + g) * 2048 + (16 + jj) * 64 + dc * 8) = v; }
        }
        for (int idx = F.tid; idx < 64 * 48; idx += 512) { const int tk = idx / 48, c = idx - tk * 48; const float v = (float)Y[(size_t)(m0 + tk) * NINP + OFF_G + c];
            ((float*)(ws + WS_GATES))[(size_t)(m0 + tk) * 48 + c] = 1.f / (1.f + __expf(-v)); }
        { const int gg = F.tid >> 7;
          if (gg == 0) pool_mix_tile<2>(Y + OFF_U + F.tid * 2, (f16*)(ws + WS_MIXED) + F.tid * 2, (size_t)b * SEQ, s0);
          else if (gg == 1) pool_mix_tile<4>(Y + OFF_U + F.tid * 2, (f16*)(ws + WS_MIXED) + F.tid * 2, (size_t)b * SEQ, s0);
          else if (gg == 2) pool_mix_tile<8>(Y + OFF_U + F.tid * 2, (f16*)(ws + WS_MIXED) + F.tid * 2, (size_t)b * SEQ, s0);
          else pool_mix_tile<16>(Y + OFF_U + F.tid * 2, (f16*)(ws + WS_MIXED) + F.tid * 2, (size_t)b * SEQ, s0); }
        __syncthreads();
        for (int idx = F.tid; idx < 2 * 64 * 32; idx += 512) { const int br = idx >> 11, tk = (idx >> 5) & 63, ch = idx & 31;
            *(LAS u32x4*)(vl + (br * 64 + tk) * VLP + ch * 8) = *(const GAS u32x4*)(Y + (size_t)(m0 + tk) * NINP + (br ? OFF_VW : OFF_VS) + ch * 8); }
        __syncthreads();
        for (int idx = F.tid; idx < 2 * 256 * 8; idx += 512) { const int br = idx >> 11, row = (idx >> 3) & 255, cc = idx & 7, grp = cc >> 1, hh = cc & 1;
            float o[8];
#pragma unroll
            for (int j = 0; j < 8; ++j) { const int kap = 16 * grp + 8 * (j >> 2) + 4 * hh + (j & 3); o[j] = (float)vl[(br * 64 + kap) * VLP + row]; }
            const int g = row >> 6, d = row & 63;
            u32x2 o8; o8.x = pk_fp8(o[0], o[1], o[2], o[3]); o8.y = pk_fp8(o[4], o[5], o[6], o[7]);
            *(GAS u32x2*)(ws + WS_VT + (size_t)br * (BATCH * 4 * 64 * SEQ) + ((size_t)(b * 4 + g) * 64 + (s0 >> 5) + (cc >> 2)) * 2048 + (d >> 5) * 1024 + ((cc & 1) * 32 + (d & 31)) * 16 + ((cc >> 1) & 1) * 8) = o8; }
        __syncthreads();
    }
}

__device__ __forceinline__ void p4_compress2(Frame& F) {
    unsigned char* ws = F.ws;
    f16* kc = (f16*)(ws + WS_KCMP); f16* vt = (f16*)(ws + WS_VCMPT);
    const int nhalf = F.G >> 1, mat = F.vcu & 1, wgr = F.vcu >> 1;
    if (nhalf == 0) return;
    LAS float* w2l = (LAS float*)F.lds;
    { const float* w2g = F.in[mat ? I_CVW2 : I_CKW2];
      for (int idx = F.tid; idx < 256 * 16; idx += 512) { const int k = idx >> 4, d4 = (idx & 15) * 4; const f32x4 v = *(const GAS f32x4*)(w2g + (size_t)k * 64 + d4);
          LAS float* q = w2l + ((k >> 2) * 64 + d4) * 4 + (k & 3); q[0] = v.x; q[4] = v.y; q[8] = v.z; q[12] = v.w; } }
    __syncthreads();
    const int rstep = nhalf * NWAVES, r0 = (F.vcu >= 2 * nhalf ? 4096 : wgr * NWAVES + F.wave);
#pragma unroll 1
    for (int rb = r0; rb < 4096; rb += 4 * rstep) {
        f32x4 hs[4];
#pragma unroll
        for (int q = 0; q < 4; ++q) { const int r = rb + q * rstep < 4096 ? rb + q * rstep : rb; const int bg = r >> 7, i = r & 127, ic = i < NCMP ? i : 0;
            const float* hp = (const float*)(ws + WS_Y) + ((size_t)mat * 4096 + (size_t)((bg >> 2) * NCMP + ic) * 4 + (bg & 3)) * 1024 + F.lane * 4;
            hs[q] = *(const GAS f32x4*)(((const float*)(ws + WS_CBIAS)) + mat * 256 + F.lane * 4);
#pragma unroll
            for (int ks = 0; ks < 4; ++ks) hs[q] = hs[q] + *(const GAS f32x4*)(hp + ks * 256); }
        float hh_[4][4], ac[4][4];
#pragma unroll
        for (int q = 0; q < 4; ++q) { const f32x2 ga = pg8::gelu_pk((f32x2){hs[q].x, hs[q].y}), gb = pg8::gelu_pk((f32x2){hs[q].z, hs[q].w});
            hh_[q][0] = ga.x; hh_[q][1] = ga.y; hh_[q][2] = gb.x; hh_[q][3] = gb.y; ac[q][0] = 0.f; ac[q][1] = 0.f; ac[q][2] = 0.f; ac[q][3] = 0.f; }
#pragma unroll 8
        for (int kk = 0; kk < 64; ++kk) { const f32x4 wv = *(const LAS f32x4*)(w2l + (kk * 64 + F.lane) * 4);
#pragma unroll
            for (int q = 0; q < 4; ++q) { ac[q][0] += rl_f(hh_[q][0], kk) * wv.x; ac[q][1] += rl_f(hh_[q][1], kk) * wv.y; ac[q][2] += rl_f(hh_[q][2], kk) * wv.z; ac[q][3] += rl_f(hh_[q][3], kk) * wv.w; } }
#pragma unroll
        for (int q = 0; q < 4; ++q) { const int r = rb + q * rstep; if (r < 4096) {
            const int bg = r >> 7, i = r & 127;
            const float acc = i < NCMP ? (ac[q][0] + ac[q][1]) + (ac[q][2] + ac[q][3]) : 0.f;
            if (mat == 0) { const float ss = wave_sum(acc * acc); const float rs = 1.f / sqrtf(ss * (1.f / 64.f) + RMS_EPS);
                const int d = F.lane, dc = d >> 3;
                kc[((size_t)bg * 4 + (i >> 5)) * 2048 + (dc >> 1) * 512 + ((dc & 1) * 32 + (i & 31)) * 8 + (d & 7)] = (f16)(i < NCMP ? acc * rs * F.in[I_KNW][F.lane] : 0.f); }
            else { const int kap = i & 15, pp = ((kap >> 2) & 1) * 8 + (kap >> 3) * 4 + (kap & 3);
                const int d = F.lane;
                vt[((size_t)bg * 4 + (i >> 5)) * 2048 + ((d >> 5) * 2 + ((i >> 4) & 1)) * 512 + ((pp >> 3) * 32 + (d & 31)) * 8 + (pp & 7)] = (f16)acc; } } }
    }
    __syncthreads();
}

__device__ __forceinline__ int t5_bucket(int rel) {
    if (rel < 16) return rel;
    int b = 16;
    b += rel >= 19; b += rel >= 21; b += rel >= 24; b += rel >= 27; b += rel >= 31; b += rel >= 35; b += rel >= 40; b += rel >= 46;
    b += rel >= 52; b += rel >= 59; b += rel >= 67; b += rel >= 77; b += rel >= 87; b += rel >= 99; b += rel >= 113;
    return b;
}
__device__ __forceinline__ int med3i(int a, int lo, int hi) { return a < lo ? lo : (a > hi ? hi : a); }
__device__ __forceinline__ float other_half_max(float x) { const auto r = __builtin_amdgcn_permlane32_swap(__float_as_uint(x), __float_as_uint(x), false, false); return fmaxf(__uint_as_float(r[0]), __uint_as_float(r[1])); }
__device__ __forceinline__ float both_halves_sum(float x) { const auto r = __builtin_amdgcn_permlane32_swap(__float_as_uint(x), __float_as_uint(x), false, false); return __uint_as_float(r[0]) + __uint_as_float(r[1]); }
struct AFrag { u32x4 k[2]; u32x4 v[2]; };
__device__ __forceinline__ void attn_load(AFrag& f, const unsigned char* Kp, const unsigned char* Vp, int kt, int r31, int hh) {
    const unsigned char* kp = Kp + (size_t)kt * 2048 + (hh * 32 + r31) * 16; const unsigned char* vp = Vp + (size_t)kt * 2048 + (hh * 32 + r31) * 16;
#pragma unroll
    for (int j = 0; j < 2; ++j) f.k[j] = *(const GAS u32x4*)(kp + j * 1024);
#pragma unroll
    for (int dt = 0; dt < 2; ++dt) f.v[dt] = *(const GAS u32x4*)(vp + dt * 1024);
}
__device__ __forceinline__ f16x8 pack8(const f32x16& c, int s2) {
    f16x8 o;
#pragma unroll
    for (int j = 0; j < 8; ++j) o[j] = (f16)c[8 * s2 + j];
    return o;
}
__device__ __forceinline__ void attn_tile(const AFrag& f, const long (&bq8)[4], int kt, int t0, int t, int hh, int wlim, unsigned selm, float cfar, const LAS float* lutr,
                                          float& mrun, float& lrun, f32x16& O0, f32x16& O1) {
    f32x16 S;
#pragma unroll
    for (int i = 0; i < 16; ++i) S[i] = 0.f;
#pragma unroll
    for (int ks = 0; ks < 4; ++ks) S = __builtin_amdgcn_mfma_f32_32x32x16_fp8_fp8((ks & 1) ? as_i64(f.k[ks >> 1].z, f.k[ks >> 1].w) : as_i64(f.k[ks >> 1].x, f.k[ks >> 1].y), bq8[ks], S, 0, 0, 0);
    const int k0 = kt * 32, minrel = t0 - (k0 + 31), maxrel = t0 + 7 - k0;
    const bool selbit = ((selm >> (kt >> 1)) & 1u) != 0u;
    float addc = 0.f;
    if (minrel >= 113 && maxrel < wlim) addc = selbit ? cfar : -2e30f;
    else {
        const unsigned wl = selbit ? (unsigned)wlim : 0u; const int relb = t - k0 - 4 * hh;
        float bias[16];
#pragma unroll
        for (int i = 0; i < 16; ++i) bias[i] = lutr[med3i(relb - ((i & 3) + 8 * (i >> 2)), 0, 127)];
#pragma unroll
        for (int i = 0; i < 16; ++i) asm volatile("" : "+v"(bias[i]));
#pragma unroll
        for (int i = 0; i < 16; ++i) { const int rel = relb - ((i & 3) + 8 * (i >> 2)); S[i] = ((unsigned)rel < wl) ? __builtin_fmaf(bias[i], 8.f, S[i]) : -2e30f; }
    }
    float tmax = S[0];
#pragma unroll
    for (int i = 1; i < 16; ++i) tmax = fmaxf(tmax, S[i]);
    tmax = other_half_max(tmax) * 0.125f + addc;
    const float mnew = fmaxf(mrun, tmax), alpha = __builtin_amdgcn_exp2f(mrun - mnew);
    mrun = mnew; lrun *= alpha;
    if (__builtin_amdgcn_ballot_w64(alpha != 1.0f) != 0ull) {
#pragma unroll
        for (int i = 0; i < 16; ++i) { O0[i] = mul_np(O0[i], alpha); O1[i] = mul_np(O1[i], alpha); } }
    const float mm = mnew - addc;
#pragma unroll
    for (int i = 0; i < 16; ++i) { const float pv = __builtin_amdgcn_exp2f(__builtin_fmaf(S[i], 0.125f, -mm)); lrun += pv; S[i] = pv; }
#pragma unroll
    for (int s2 = 0; s2 < 2; ++s2) { const long pb = as_i64(pk_fp8(S[8 * s2], S[8 * s2 + 1], S[8 * s2 + 2], S[8 * s2 + 3]), pk_fp8(S[8 * s2 + 4], S[8 * s2 + 5], S[8 * s2 + 6], S[8 * s2 + 7]));
        O0 = __builtin_amdgcn_mfma_f32_32x32x16_fp8_fp8(s2 ? as_i64(f.v[0].z, f.v[0].w) : as_i64(f.v[0].x, f.v[0].y), pb, O0, 0, 0, 0);
        O1 = __builtin_amdgcn_mfma_f32_32x32x16_fp8_fp8(s2 ? as_i64(f.v[1].z, f.v[1].w) : as_i64(f.v[1].x, f.v[1].y), pb, O1, 0, 0, 0); }
}
__device__ __forceinline__ void attn_branch(const unsigned char* Kp, const unsigned char* Vp, unsigned long long tm, const long (&bq)[4], int t0, int t, int r31, int hh, int wlim, unsigned selm, float cfar,
                                            const LAS float* lutr, float gate, LAS float* TL) {
    float mrun = -1e30f, lrun = 0.f; f32x16 O0, O1;
#pragma unroll
    for (int i = 0; i < 16; ++i) { O0[i] = 0.f; O1[i] = 0.f; }
    AFrag fA, fB;
    int ktA = __builtin_ctzll(tm), ktB;
    attn_load(fA, Kp, Vp, ktA, r31, hh);
    for (;;) {
        tm &= tm - 1; const bool hasB = tm != 0ull; ktB = hasB ? __builtin_ctzll(tm) : ktA; attn_load(fB, Kp, Vp, ktB, r31, hh);
        attn_tile(fA, bq, ktA, t0, t, hh, wlim, selm, cfar, lutr, mrun, lrun, O0, O1);
        if (!hasB) break;
        tm &= tm - 1; const bool hasA = tm != 0ull; ktA = hasA ? __builtin_ctzll(tm) : ktB; attn_load(fA, Kp, Vp, ktA, r31, hh);
        attn_tile(fB, bq, ktB, t0, t, hh, wlim, selm, cfar, lutr, mrun, lrun, O0, O1);
        if (!hasA) break;
    }
    lrun = both_halves_sum(lrun);
    const float sc = gate / fmaxf(lrun, 1e-30f);
#pragma unroll
    for (int i = 0; i < 16; ++i) { TL[i * 64] += O0[i] * sc; TL[(16 + i) * 64] += O1[i] * sc; }
}
__device__ __forceinline__ void p5_attention(Frame& F) {
    unsigned char* ws = F.ws;
    const f16* Y = (const f16*)(ws + WS_Y);
    const float* gates = (const float*)(ws + WS_GATES);
    f16* CAT = (f16*)(ws + WS_CAT);
    LAS float* wl = (LAS float*)(F.lds + F.wave * 8192);
    LAS float* LUT = wl;
    const int gw = F.vcu * NWAVES + F.wave, NW = F.G * NWAVES;
    const bool snake = (8192 % (2 * NW)) == 0, bal = (NW == 2048);
    int lut_g = -1;
    LAS unsigned* SELM = (LAS unsigned*)(wl + 1280);
    for (int it = gw, rr = 0; it < 8192; it += NW, ++rr) {
        int n = (snake && (rr & 1)) ? (rr * NW + (NW - 1 - gw)) : it;
        if (bal) {
            const int xq = gw >> 8, u = gw & 255;
            if (rr < 3) { const int f = rr * 256 + u, q = f / 192; n = (q * 8 + xq) * 256 + 64 + (f - q * 192); }
            else { const int c = u >> 3, w = u & 7, k = (c & 7) * 4 + (w & 3); n = ((c >> 3) * 8 + xq) * 256 + ((w & 4) ? 63 - k : k); } }
        const int bg = n >> 8, pos = n & 255, b = bg >> 2, g = bg & 3, t0 = pos * 8;
        int lane = F.lane; asm volatile("" : "+v"(lane));
        const int r31 = lane & 31, hh = lane >> 5, tok8 = r31 >> 2, r = r31 & 3;
        const LAS float* lutr = LUT + r * 128;
        if (g != lut_g) {
            LDS_WAIT(); asm volatile("" ::: "memory");
#pragma unroll
            for (int e = 0; e < 2; ++e) { const int rel = lane + 64 * e, bk = t5_bucket(rel);
#pragma unroll
                for (int r4 = 0; r4 < 4; ++r4) LUT[r4 * 128 + rel] = F.in[I_RELB][bk * 16 + 4 * g + r4] * LOG2E; }
            LDS_WAIT(); asm volatile("" ::: "memory");
            lut_g = g;
        }
        const int t = t0 + tok8, head = 4 * g + r; const size_t m = (size_t)b * SEQ + t;
        f16x8 bq[4];
#pragma unroll
        for (int ks = 0; ks < 4; ++ks) bq[ks] = *(const GAS f16x8*)((const f16*)(ws + WS_QN) + m * 1024 + head * 64 + ks * 16 + hh * 8);
        long bq8[4];
#pragma unroll
        for (int ks = 0; ks < 4; ++ks) bq8[ks] = as_i64(pk_fp8((float)bq[ks][0] * 8.f, (float)bq[ks][1] * 8.f, (float)bq[ks][2] * 8.f, (float)bq[ks][3] * 8.f),
                                                        pk_fp8((float)bq[ks][4] * 8.f, (float)bq[ks][5] * 8.f, (float)bq[ks][6] * 8.f, (float)bq[ks][7] * 8.f));
        const float g_c = gates[m * 48 + head * 3 + 0], g_s = gates[m * 48 + head * 3 + 1], g_w = gates[m * 48 + head * 3 + 2];
        const float cfar = lutr[127];
        LAS float* TL = (LAS float*)(F.lds + 65536 + F.wave * 8192) + lane;
        {
            const f16* kc = (const f16*)(ws + WS_KCMP) + (size_t)bg * 128 * 64;
            const f16* vc = (const f16*)(ws + WS_VCMPT) + (size_t)bg * 64 * 128;
            f32x16 c[4];
#pragma unroll
            for (int kt = 0; kt < 4; ++kt) {
#pragma unroll
                for (int i = 0; i < 16; ++i) c[kt][i] = 0.f;
#pragma unroll
                for (int ks = 0; ks < 4; ++ks) { const f16x8 a = *(const GAS f16x8*)(kc + kt * 2048 + ks * 512 + (hh * 32 + r31) * 8); c[kt] = __builtin_amdgcn_mfma_f32_32x32x16_f16(a, bq[ks], c[kt], 0, 0, 0); }
                asm volatile("" ::: "memory");
            }
            const int relb = t - 31 - 64 * hh; float mx = -1e30f;
#pragma unroll
            for (int kt = 0; kt < 4; ++kt) { float bias[16];
#pragma unroll
                for (int i = 0; i < 16; ++i) { const int rel = relb - 16 * (kt * 32 + (i & 3) + 8 * (i >> 2)); bias[i] = lutr[med3i(rel, 0, 127)]; }
#pragma unroll
                for (int i = 0; i < 16; ++i) asm volatile("" : "+v"(bias[i]));
#pragma unroll
                for (int i = 0; i < 16; ++i) { const int rel = relb - 16 * (kt * 32 + (i & 3) + 8 * (i >> 2));
                    const float sv = rel >= 0 ? c[kt][i] + bias[i] : -2e30f; c[kt][i] = sv; mx = fmaxf(mx, sv); }
                asm volatile("" ::: "memory"); }
            mx = other_half_max(mx);
            float l = 0.f;
#pragma unroll
            for (int kt = 0; kt < 4; ++kt)
#pragma unroll
                for (int i = 0; i < 16; ++i) { const float pv = __builtin_amdgcn_exp2f(c[kt][i] - mx); c[kt][i] = pv; l += pv; }
            l = both_halves_sum(l);
            const float inv = 1.f / fmaxf(l, 1e-30f);
#pragma unroll
            for (int kt = 0; kt < 4; ++kt)
#pragma unroll
                for (int jj = 0; jj < 4; ++jj) { float own = (2.f * (c[kt][4 * jj] + c[kt][4 * jj + 1] + c[kt][4 * jj + 2]) + c[kt][4 * jj + 3]) * inv, p3 = c[kt][4 * jj + 3] * inv;
                    own += dpp_f<0xB1>(own); own += dpp_f<0x4E>(own); p3 += dpp_f<0xB1>(p3); p3 += dpp_f<0x4E>(p3);
                    if (r == 0) { const int j = kt * 8 + 2 * jj + hh; wl[512 + tok8 * 32 + j] = own; wl[768 + tok8 * 32 + j] = p3; } }
            f32x16 O0, O1;
#pragma unroll
            for (int i = 0; i < 16; ++i) { O0[i] = 0.f; O1[i] = 0.f; }
#pragma unroll
            for (int kt = 0; kt < 4; ++kt)
#pragma unroll
                for (int s2 = 0; s2 < 2; ++s2) { const f16x8 pb = pack8(c[kt], s2);
                    const f16x8 a0 = *(const GAS f16x8*)(vc + kt * 2048 + s2 * 512 + (hh * 32 + r31) * 8), a1 = *(const GAS f16x8*)(vc + kt * 2048 + (2 + s2) * 512 + (hh * 32 + r31) * 8);
                    O0 = __builtin_amdgcn_mfma_f32_32x32x16_f16(a0, pb, O0, 0, 0, 0); O1 = __builtin_amdgcn_mfma_f32_32x32x16_f16(a1, pb, O1, 0, 0, 0); asm volatile("" ::: "memory"); }
            const float sc = inv * g_c;
#pragma unroll
            for (int i = 0; i < 16; ++i) { TL[i * 64] = O0[i] * sc; TL[(16 + i) * 64] = O1[i] * sc; }
        }
        LDS_WAIT(); asm volatile("" ::: "memory");
        int lane2 = lane; asm volatile("" : "+v"(lane2));
        LAS float* OWN = wl + 512 + (lane2 >> 5) * 32 + (lane2 & 31); LAS float* P3 = OWN + 256; LAS float* VAL = OWN + 512;
#pragma unroll
        for (int pp = 0; pp < 4; ++pp) { const int tk = 2 * pp + hh, j = r31, cur = (t0 + tk) >> 6;
            const float impv = OWN[pp * 64] + (j > 0 ? P3[pp * 64 - (j > 0 ? 1 : 0)] : 0.f);
            VAL[pp * 64] = (j == 0 || j == cur || j == cur - 1) ? 1e4f : (j <= cur ? impv : -1e30f); }
        LDS_WAIT(); asm volatile("" ::: "memory");
#pragma unroll
        for (int pp = 0; pp < 4; ++pp) { const int tk = 2 * pp + hh, j = r31, cur = (t0 + tk) >> 6; const float v = VAL[pp * 64]; int cnt = 0; const LAS float* vrow = VAL + pp * 64 - j;
#pragma unroll
            for (int j2 = 0; j2 < 32; ++j2) { const float o = vrow[j2]; cnt += (o > v || (o == v && j2 < j)) ? 1 : 0; }
            const unsigned long long bm = __ballot(cnt < 8 && j <= cur);
            const unsigned mym = hh ? (unsigned)(bm >> 32) : (unsigned)bm;
            if (j == 0) SELM[tk] = mym; }
        LDS_WAIT(); asm volatile("" ::: "memory");
        const unsigned selm = SELM[tok8];
        unsigned um = 0u;
#pragma unroll
        for (int i = 0; i < 8; ++i) um |= SELM[i];
        um = (unsigned)__builtin_amdgcn_readfirstlane((int)um);
        const int kthi = (t0 + 7) >> 5;
        const unsigned long long causal = (kthi >= 63) ? ~0ull : ((1ull << (kthi + 1)) - 1ull);
        {
            unsigned long long x = um;
            x = (x | (x << 16)) & 0x0000FFFF0000FFFFull; x = (x | (x << 8)) & 0x00FF00FF00FF00FFull; x = (x | (x << 4)) & 0x0F0F0F0F0F0F0F0Full;
            x = (x | (x << 2)) & 0x3333333333333333ull; x = (x | (x << 1)) & 0x5555555555555555ull;
            const unsigned long long tm = (x | (x << 1)) & causal;
            attn_branch(ws + WS_KN + (size_t)bg * SEQ * 64, ws + WS_VT + (size_t)bg * 64 * SEQ, tm, bq8, t0, t, r31, hh, 1 << 30, selm, cfar, lutr, g_s, TL);
        }
        {
            const int lo = t0 - 511 > 0 ? (t0 - 511) >> 5 : 0;
            const unsigned long long tm = causal & ~((1ull << lo) - 1ull);
            attn_branch(ws + WS_KN + (size_t)(BATCH * 4 + bg) * SEQ * 64, ws + WS_VT + (size_t)(BATCH * 4 + bg) * 64 * SEQ, tm, bq8, t0, t, r31, hh, 512, 0xFFFFFFFFu, cfar, lutr, g_w, TL);
        }
        unsigned char* orow = ws + WS_CAT + m * D + 1024 + head * 64 + 4 * hh;
#pragma unroll
        for (int jj = 0; jj < 4; ++jj) {
            *(GAS unsigned*)(orow + 8 * jj) = pk_fp8(TL[(4 * jj) * 64] * CAT8SCALE, TL[(4 * jj + 1) * 64] * CAT8SCALE, TL[(4 * jj + 2) * 64] * CAT8SCALE, TL[(4 * jj + 3) * 64] * CAT8SCALE);
            *(GAS unsigned*)(orow + 32 + 8 * jj) = pk_fp8(TL[(16 + 4 * jj) * 64] * CAT8SCALE, TL[(16 + 4 * jj + 1) * 64] * CAT8SCALE, TL[(16 + 4 * jj + 2) * 64] * CAT8SCALE, TL[(16 + 4 * jj + 3) * 64] * CAT8SCALE); }
    }
}

__device__ __forceinline__ void cvt_row_fp6(const f32x4 (&v)[8], int row, unsigned char* dst6, float* scales, int lane) {
    float amax = 0.f;
#pragma unroll
    for (int c = 0; c < 8; ++c) amax = fmaxf(amax, fmaxf(fmaxf(fabsf(v[c].x), fabsf(v[c].y)), fmaxf(fabsf(v[c].z), fabsf(v[c].w))));
    amax = wave_max(amax);
    const float scale = amax > 0.f ? amax * (1.f / 7.5f) : 1.f, inv = 1.f / scale;
    f16x32 h;
#pragma unroll
    for (int c = 0; c < 8; ++c) { h[4 * c] = (f16)(v[c].x * inv); h[4 * c + 1] = (f16)(v[c].y * inv); h[4 * c + 2] = (f16)(v[c].z * inv); h[4 * c + 3] = (f16)(v[c].w * inv); }
    const u32x6 pk = __builtin_amdgcn_cvt_scalef32_pk32_fp6_f16(h, 1.0f);
    unsigned char* d = dst6 + (size_t)(lane >> 3) * SLICE6;
    *(GAS u32x4*)(d + (size_t)row * 128 + (lane & 7) * 16) = (u32x4){pk[0], pk[1], pk[2], pk[3]}; *(GAS u32x2*)(d + 2097152 + (size_t)row * 64 + (lane & 7) * 8) = (u32x2){pk[4], pk[5]};
    if (lane == 0) scales[row] = scale;
}
__device__ __forceinline__ void cvt_table_fp6(Frame& F, const float* src, unsigned char* dst6, float* scales, const float* colw) {
    const int gw = F.vcu * NWAVES + F.wave, NGW = F.G * NWAVES, lane = F.lane;
    int row = gw;
    for (; row + NGW < 16384; row += 2 * NGW) {
        f32x4 va[8], vb[8];
#pragma unroll
        for (int c = 0; c < 8; ++c) { va[c] = __builtin_nontemporal_load((const GAS f32x4*)(src + (size_t)row * D + c * 256 + lane * 4)); vb[c] = __builtin_nontemporal_load((const GAS f32x4*)(src + (size_t)(row + NGW) * D + c * 256 + lane * 4)); }
        if (colw) {
#pragma unroll
            for (int c = 0; c < 8; ++c) { const f32x4 wv = *(const GAS f32x4*)(colw + c * 256 + lane * 4); va[c] = va[c] * wv; vb[c] = vb[c] * wv; } }
        cvt_row_fp6(va, row, dst6, scales, lane); cvt_row_fp6(vb, row + NGW, dst6, scales, lane);
    }
    for (; row < 16384; row += NGW) { f32x4 va[8];
#pragma unroll
        for (int c = 0; c < 8; ++c) { va[c] = *(const GAS f32x4*)(src + (size_t)row * D + c * 256 + lane * 4); if (colw) va[c] = va[c] * *(const GAS f32x4*)(colw + c * 256 + lane * 4); }
        cvt_row_fp6(va, row, dst6, scales, lane); }
}
__device__ __forceinline__ void p7_tables(Frame& F) {
    cvt_table_fp6(F, F.in[I_PU], F.ws + WS_U6, (float*)(F.ws + WS_SU), F.in[I_FFNNW]);
    cvt_table_fp6(F, F.in[I_PV], F.ws + WS_V6, (float*)(F.ws + WS_SV), nullptr);
}

__device__ __forceinline__ void bitonic_sort16_desc(float (&a)[16]) {
#pragma unroll
    for (int k = 2; k <= 16; k <<= 1)
#pragma unroll
        for (int j = k >> 1; j > 0; j >>= 1)
#pragma unroll
            for (int i = 0; i < 16; ++i) { const int l = i ^ j; if (l > i) { const float hi = fmaxf(a[i], a[l]), lo = fminf(a[i], a[l]); if ((i & k) == 0) { a[i] = hi; a[l] = lo; } else { a[i] = lo; a[l] = hi; } } }
}
__device__ __forceinline__ void bitonic_merge16_desc(float (&a)[16]) {
#pragma unroll
    for (int dist = 8; dist >= 1; dist >>= 1)
#pragma unroll
        for (int i = 0; i < 16; ++i) if ((i & dist) == 0) { const float hi = fmaxf(a[i], a[i + dist]), lo = fminf(a[i], a[i + dist]); a[i] = hi; a[i + dist] = lo; }
}
#define INS16(top, v) do { _Pragma("unroll") for (int _j = 0; _j < 16; ++_j) { const float _h = fmaxf(top[_j], v); v = fminf(top[_j], v); top[_j] = _h; } } while (0)
#define INS16P(tv, ti, v, i) do { _Pragma("unroll") for (int _j = 0; _j < 16; ++_j) { const bool _c = v > tv[_j]; const float _nv = _c ? tv[_j] : v; const unsigned _ni = _c ? ti[_j] : i; \
        tv[_j] = _c ? v : tv[_j]; ti[_j] = _c ? i : ti[_j]; v = _nv; i = _ni; } } while (0)
typedef unsigned v4u_t __attribute__((__vector_size__(16)));
typedef unsigned v2u_t __attribute__((__vector_size__(8)));
__device__ __forceinline__ void p9a_topk(Frame& F) {
    unsigned char* ws = F.ws;
    const f16* QP = (const f16*)(ws + WS_QP); const f16* KEYS = (const f16*)(ws + WS_KEYS);
    unsigned* LIDX = (unsigned*)(ws + WS_LIDX); float* LG = (float*)(ws + WS_LG);
    const int lane = F.lane, r31 = lane & 31, hh = lane >> 5;
    const float NINF = -__builtin_inff();
    for (int unit = F.vcu; unit < M / 32; unit += F.G) {
        const int m0 = unit * 32;
        {
            const int h = F.wave;
            float sl[2][16];
            f16x8 bq[8], ka[8];
#pragma unroll
            for (int ks = 0; ks < 8; ++ks) { bq[ks] = *(const GAS f16x8*)(QP + (size_t)(m0 + r31) * D + (h * 2) * 128 + ks * 16 + hh * 8);
                ka[ks] = *(const GAS f16x8*)(KEYS + ((size_t)((h * 2) * 128 + r31)) * 128 + hh * 8 + ks * 16); }
            float top[16];
#pragma unroll
            for (int st = 0; st < 8; ++st) { const int p = st >> 2, kt = st & 3;
                if (kt == 0) {
#pragma unroll
                    for (int j = 0; j < 16; ++j) top[j] = NINF; }
                f32x16 c;
#pragma unroll
                for (int i = 0; i < 16; ++i) c[i] = 0.f;
#pragma unroll
                for (int ks = 0; ks < 8; ++ks) c = __builtin_amdgcn_mfma_f32_32x32x16_f16(ka[ks], bq[ks], c, 0, 0, 0);
                if (st + 1 < 8) { const int pn = (st + 1) >> 2, ktn = (st + 1) & 3;
#pragma unroll
                    for (int ks = 0; ks < 8; ++ks) ka[ks] = *(const GAS f16x8*)(KEYS + ((size_t)((h * 2 + pn) * 128 + ktn * 32 + r31)) * 128 + hh * 8 + ks * 16);
                    if (st == 3) {
#pragma unroll
                        for (int ks = 0; ks < 8; ++ks) bq[ks] = *(const GAS f16x8*)(QP + (size_t)(m0 + r31) * D + (h * 2 + 1) * 128 + ks * 16 + hh * 8); } }
                const unsigned k4 = (unsigned)(kt * 32 + 4 * hh);
                float nv[16];
#pragma unroll
                for (int reg = 0; reg < 16; ++reg) { const unsigned key = k4 + (unsigned)((reg & 3) + 8 * (reg >> 2)); nv[reg] = __uint_as_float((__float_as_uint(c[reg]) & ~127u) | key); }
                bitonic_sort16_desc(nv);
#pragma unroll
                for (int j = 0; j < 16; ++j) top[j] = fmaxf(top[j], nv[15 - j]);
                bitonic_merge16_desc(top);
                if (kt == 3) {
                    float cm[16];
#pragma unroll
                    for (int j = 0; j < 16; ++j) cm[j] = fmaxf(top[j], __uint_as_float(other32u(__float_as_uint(top[15 - j]), hh != 0)));
                    bitonic_merge16_desc(cm);
#pragma unroll
                    for (int j = 0; j < 16; ++j) sl[p][j] = cm[j]; }
            }
            float vx[16], vy[16]; unsigned ix[16], iy[16];
#pragma unroll
            for (int j = 0; j < 16; ++j) { const unsigned bx = __float_as_uint(hh ? sl[1][j] : sl[0][j]), by = __float_as_uint(hh ? sl[0][j] : sl[1][j]);
                vx[j] = __uint_as_float(bx & ~127u); vy[j] = __uint_as_float(by & ~127u); ix[j] = (bx & 127u) * (hh ? 1u : 128u); iy[j] = (by & 127u) * (hh ? 128u : 1u); }
            float tv[16]; unsigned ti[16];
#pragma unroll
            for (int j = 0; j < 16; ++j) { const int jb = j + 1 < 16 ? j + 1 : 15;
                const float v0 = vx[0] + vy[j], v1 = (j < 15) ? vx[0] + vy[jb] : NINF; const unsigned i0 = ix[0] + iy[j], i1 = ix[0] + iy[jb];
                tv[j] = hh ? v1 : v0; ti[j] = hh ? i1 : i0; }
#pragma unroll
            for (int a = 1; a < 4; ++a) { const int bmax = (a == 1) ? 7 : (a == 2 ? 4 : 3);
#pragma unroll
                for (int b = a; b <= bmax; ++b) { float v = vx[a] + vy[b]; if (a == b) v = hh ? NINF : v; unsigned i = ix[a] + iy[b]; INS16P(tv, ti, v, i); } }
            float mv[16]; unsigned mi[16];
#pragma unroll
            for (int j = 0; j < 16; ++j) { const float pv = __uint_as_float(other32u(__float_as_uint(tv[15 - j]), hh != 0)); const unsigned pi = other32u(ti[15 - j], hh != 0); const bool c = pv > tv[j]; mv[j] = c ? pv : tv[j]; mi[j] = c ? pi : ti[j]; }
            float mx = mv[0];
#pragma unroll
            for (int j = 1; j < 16; ++j) mx = fmaxf(mx, mv[j]);
            float sum = 0.f;
#pragma unroll
            for (int j = 0; j < 16; ++j) { mv[j] = __builtin_amdgcn_exp2f((mv[j] - mx) * LOG2E); sum += mv[j]; }
            const float inv = 1.f / sum;
#pragma unroll
            for (int j = 0; j < 8; ++j) { { const int e_ = h * 16 + hh * 8 + j, pos_ = (e_ & 63) * 2 + (e_ >> 6); LIDX[(size_t)(m0 + r31) * 128 + pos_] = mi[j]; LG[(size_t)(m0 + r31) * 128 + pos_] = mv[j] * inv; } }
        }
    }
}
struct Seg6 { v4u_t a; v2u_t b; };
__device__ __forceinline__ f16x32 seg6_decode(const Seg6& r) { const u32x6 p = {r.a[0], r.a[1], r.a[2], r.a[3], r.b[0], r.b[1]}; return __builtin_amdgcn_cvt_scalef32_pk32_f16_fp6(p, 1.0f); }
__device__ __forceinline__ f16x32 seg6_dec2(const v4u_t& a, const v2u_t& b) { const u32x6 p = {a[0], a[1], a[2], a[3], b[0], b[1]}; return __builtin_amdgcn_cvt_scalef32_pk32_f16_fp6(p, 1.0f); }
#define SEG_DECL(P) v4u_t P##a0, P##a1, P##a2, P##a3, P##a4, P##a5, P##a6, P##a7; v2u_t P##b0, P##b1, P##b2, P##b3, P##b4, P##b5, P##b6, P##b7
#define SEG_L1(P, G, idxv) do { const int e_ = __shfl(idxv, 8 * G + sub); P##a##G = __builtin_amdgcn_raw_buffer_load_b128(rs, e_ * 128 + ch * 16, 0, 0); P##b##G = __builtin_amdgcn_raw_buffer_load_b64(rs, 2097152 + e_ * 64 + ch * 8, 0, 0); } while (0)
#define SEG_LOAD(P, idxv) do { SEG_L1(P, 0, idxv); SEG_L1(P, 1, idxv); SEG_L1(P, 2, idxv); SEG_L1(P, 3, idxv); SEG_L1(P, 4, idxv); SEG_L1(P, 5, idxv); SEG_L1(P, 6, idxv); SEG_L1(P, 7, idxv); } while (0)
__device__ __forceinline__ float u_one(const v4u_t& a, const v2u_t& b, const f16x2 (&xp)[16]) {
    const f16x32 hv = seg6_dec2(a, b); float sdot = 0.f;
#pragma unroll
    for (int k = 0; k < 16; ++k) { f16x2 hp; hp.x = hv[2 * k]; hp.y = hv[2 * k + 1]; sdot = __builtin_amdgcn_fdot2(hp, xp[k], sdot, false); }
    return sum8(sdot);
}
#define SEG_LE(P, G, ev) do { const int e_ = (ev); P##a##G = __builtin_amdgcn_raw_buffer_load_b128(rs, e_ * 128 + ch * 16, 0, 0); P##b##G = __builtin_amdgcn_raw_buffer_load_b64(rs, 2097152 + e_ * 64 + ch * 8, 0, 0); } while (0)
#define EN_GATHER(en, iA, iB) do { _Pragma("unroll") for (int g_ = 0; g_ < 8; ++g_) { en[g_] = __shfl(iA, 8 * g_ + sub); en[8 + g_] = __shfl(iB, 8 * g_ + sub); } } while (0)
#define U_ROLL1(P, G, res, eo) do { const float d_ = u_one(P##a##G, P##b##G, xp); res = (ch == G) ? d_ : res; SEG_LE(P, G, en[(eo) + G]); } while (0)
#define U_ROLL(P, res, idxn) do { U_ROLL1(P, 0, res, idxn); U_ROLL1(P, 1, res, idxn); U_ROLL1(P, 2, res, idxn); U_ROLL1(P, 3, res, idxn); U_ROLL1(P, 4, res, idxn); U_ROLL1(P, 5, res, idxn); U_ROLL1(P, 6, res, idxn); U_ROLL1(P, 7, res, idxn); } while (0)
#define V_ROLL1(P, G, hwv, eo) do { v_one(P##a##G, P##b##G, acc, hq[(eo) + G]); SEG_LE(P, G, en[(eo) + G]); } while (0)
#define V_ROLL(P, hwv, idxn) do { V_ROLL1(P, 0, hwv, idxn); V_ROLL1(P, 1, hwv, idxn); V_ROLL1(P, 2, hwv, idxn); V_ROLL1(P, 3, hwv, idxn); V_ROLL1(P, 4, hwv, idxn); V_ROLL1(P, 5, hwv, idxn); V_ROLL1(P, 6, hwv, idxn); V_ROLL1(P, 7, hwv, idxn); } while (0)
#define FMIXV_LO(a, h, w) asm("v_fma_mix_f32 %0, %1, %2, %0 op_sel_hi:[1,0,0]" : "+v"(a) : "v"(h), "v"(w))
#define FMIXV_HI(a, h, w) asm("v_fma_mix_f32 %0, %1, %2, %0 op_sel:[1,0,0] op_sel_hi:[1,0,0]" : "+v"(a) : "v"(h), "v"(w))
__device__ __forceinline__ void v_one(const v4u_t& a, const v2u_t& b, f16x2 (&acc)[16], f16x2 wq) {
    const f16x32 hv = seg6_dec2(a, b);
#pragma unroll
    for (int k = 0; k < 16; ++k) { f16x2 hp; hp.x = hv[2 * k]; hp.y = hv[2 * k + 1]; acc[k] = __builtin_elementwise_fma(hp, wq, acc[k]); }
}
#define V_HALF(P, hwv) do { v_one(P##a0, P##b0, acc, hwv, sub); v_one(P##a1, P##b1, acc, hwv, 8 + sub); v_one(P##a2, P##b2, acc, hwv, 16 + sub); v_one(P##a3, P##b3, acc, hwv, 24 + sub); \
        v_one(P##a4, P##b4, acc, hwv, 32 + sub); v_one(P##a5, P##b5, acc, hwv, 40 + sub); v_one(P##a6, P##b6, acc, hwv, 48 + sub); v_one(P##a7, P##b7, acc, hwv, 56 + sub); } while (0)
__device__ __forceinline__ void p9b_upass(Frame& F, bool probe_slice0) {
    unsigned char* ws = F.ws;
    const int x = blockIdx.x & 7, rank = blockIdx.x >> 3, cnt = (F.G - x + 7) >> 3;
    const int lane = F.lane, sub = lane >> 3, ch = lane & 7;
    const __amdgpu_buffer_rsrc_t rs = __builtin_amdgcn_make_buffer_rsrc((void*)(ws + WS_U6 + (size_t)(probe_slice0 ? 0 : x) * SLICE6), 0, (int)SLICE6, 0x00020000);
    const f16* XN = (const f16*)(ws + WS_XR) + x * 32 + (lane >> 3) * 256 + (lane & 7) * 4;
    const u32x2* LI2 = (const u32x2*)(ws + WS_LIDX); LAS unsigned char* xl = F.lds + F.wave * 512;
    const int tstep = cnt * NWAVES; int t = rank * NWAVES + F.wave;
    if (t >= M) return;
    int cA, cB, nA, nB; { const u32x2 c2 = LI2[(size_t)t * 64 + lane]; cA = (int)c2.x; cB = (int)c2.y; }
    const int t1c = (t + tstep < M) ? t + tstep : t;
    { const u32x2 n2 = LI2[(size_t)t1c * 64 + lane]; nA = (int)n2.x; nB = (int)n2.y; }
    u32x2 xcur = *(const GAS u32x2*)(XN + (size_t)t * D);
    f16x2 xp[16];
    SEG_DECL(bA); SEG_DECL(bB);
    { const int li_ = cA; SEG_LOAD(bA, li_); } { const int li_ = cB; SEG_LOAD(bB, li_); }
#pragma unroll 1
    for (;;) {
        const int tn = t + tstep, tnn = tn + tstep; const bool hn = tn < M, hnn = tnn < M;
        const int tnc = hn ? tn : t, tnnc = hnn ? tnn : t;
        const u32x2 m2 = LI2[(size_t)tnnc * 64 + lane]; const int mA = (int)m2.x, mB = (int)m2.y;
        const u32x2 xnext = *(const GAS u32x2*)(XN + (size_t)tnc * D);
        *(LAS u32x2*)(xl + ((lane & 7) * 8 + (lane >> 3)) * 8) = xcur;
        LDS_WAIT(); asm volatile("" ::: "memory");
#pragma unroll
        for (int q = 0; q < 4; ++q) { const u32x4 tv = *(const LAS u32x4*)(xl + ch * 64 + q * 16); xp[4 * q] = ash2(tv.x); xp[4 * q + 1] = ash2(tv.y); xp[4 * q + 2] = ash2(tv.z); xp[4 * q + 3] = ash2(tv.w); }
        LDS_WAIT(); asm volatile("" ::: "memory");
        { const int lA_ = hn ? nA : cA, lB_ = hn ? nB : cB; int en[16]; EN_GATHER(en, lA_, lB_);
          float rA = 0.f, rB = 0.f; U_ROLL(bA, rA, 0); U_ROLL(bB, rB, 8);
          float* pd = (float*)(ws + WS_PD) + ((size_t)t * 8 + x) * 128 + 8 * ch + sub; pd[0] = rA; pd[64] = rB; }
        if (!hn) break;
        xcur = xnext;
        cA = nA; cB = nB; nA = mA; nB = mB; t = tn;
    }
}
__device__ __forceinline__ void p9h_weights(Frame& F) {
    unsigned char* ws = F.ws;
    const unsigned* LIDX = (const unsigned*)(ws + WS_LIDX); const float* LG = (const float*)(ws + WS_LG); const float* PD = (const float*)(ws + WS_PD);
    const float* SU = (const float*)(ws + WS_SU); const float* SV = (const float*)(ws + WS_SV); float* HW = (float*)(ws + WS_HW);
    const int gw = F.vcu * NWAVES + F.wave, NGW = F.G * NWAVES, lane = F.lane;
#pragma unroll 1
    for (int t0 = gw; t0 < M; t0 += 2 * NGW) {
        const int t1 = t0 + NGW < M ? t0 + NGW : t0;
        int iA[2], iB[2]; float pa[2][8], pb[2][8], lgA[2], lgB[2], s1[2];
#pragma unroll
        for (int q = 0; q < 2; ++q) { const int t = q ? t1 : t0; { const u32x2 i2 = ((const u32x2*)LIDX)[(size_t)t * 64 + lane]; iA[q] = (int)i2.x; iB[q] = (int)i2.y; }
#pragma unroll
            for (int xs = 0; xs < 8; ++xs) { pa[q][xs] = PD[((size_t)t * 8 + xs) * 128 + lane]; pb[q][xs] = PD[((size_t)t * 8 + xs) * 128 + 64 + lane]; }
            { const f32x2 g2 = ((const f32x2*)LG)[(size_t)t * 64 + lane]; lgA[q] = g2.x; lgB[q] = g2.y; } s1[q] = ((const float*)(ws + WS_SS1))[t]; }
#pragma unroll
        for (int q = 0; q < 2; ++q) { const int t = q ? t1 : t0; float zA = 0.f, zB = 0.f;
#pragma unroll
            for (int xs = 0; xs < 8; ++xs) { zA += pa[q][xs]; zB += pb[q][xs]; }
            const float rs1 = 1.f / sqrtf(s1[q] * (1.f / D) + RMS_EPS);
            ((f32x2*)HW)[(size_t)t * 64 + lane] = (f32x2){pg8::gelu1(zA * rs1 * SU[iA[q]]) * lgA[q] * SV[iA[q]], pg8::gelu1(zB * rs1 * SU[iB[q]]) * lgB[q] * SV[iB[q]]}; }
    }
}
__device__ __forceinline__ void p9c_vpass(Frame& F) {
    unsigned char* ws = F.ws;
    const int x = blockIdx.x & 7, rank = blockIdx.x >> 3, cnt = (F.G - x + 7) >> 3;
    const int lane = F.lane, sub = lane >> 3, ch = lane & 7;
    const __amdgpu_buffer_rsrc_t rs = __builtin_amdgcn_make_buffer_rsrc((void*)(ws + WS_V6 + (size_t)x * SLICE6), 0, (int)SLICE6, 0x00020000);
    const u32x2* LI2 = (const u32x2*)(ws + WS_LIDX);
    f16* XR = (f16*)(ws + WS_XR); float* SS2 = (float*)(ws + WS_SS2);
    const bool b3 = (lane & 8) != 0, b4 = (lane & 16) != 0, b5 = (lane & 32) != 0;
    const int col = ((b3 ? 4 : 0) + (b4 ? 2 : 0) + (b5 ? 1 : 0)) * 256 + x * 32 + ch * 4;
    const int tstep = cnt * NWAVES; int t = rank * NWAVES + F.wave;
    if (t >= M) return;
    int cA, cB, nA, nB; { const u32x2 c2 = LI2[(size_t)t * 64 + lane]; cA = (int)c2.x; cB = (int)c2.y; }
    const int t1c = (t + tstep < M) ? t + tstep : t;
    { const u32x2 n2 = LI2[(size_t)t1c * 64 + lane]; nA = (int)n2.x; nB = (int)n2.y; }
    const f32x2* HW2 = (const f32x2*)(ws + WS_HW);
    float hwA, hwB; { const f32x2 h2 = HW2[(size_t)t * 64 + lane]; hwA = h2.x; hwB = h2.y; }
    SEG_DECL(bA); SEG_DECL(bB);
    { const int li_ = cA; SEG_LOAD(bA, li_); } { const int li_ = cB; SEG_LOAD(bB, li_); }
#pragma unroll 1
    for (;;) {
        const int tn = t + tstep, tnn = tn + tstep; const bool hn = tn < M, hnn = tnn < M;
        const int tnc = hn ? tn : t, tnnc = hnn ? tnn : t;
        const u32x2 m2 = LI2[(size_t)tnnc * 64 + lane]; const int mA = (int)m2.x, mB = (int)m2.y;
        const f32x2 hn2 = HW2[(size_t)tnc * 64 + lane]; const float hwAn = hn2.x, hwBn = hn2.y;
        f16* orow = XR + (size_t)t * D + col; const u32x2 x1r = *(const GAS u32x2*)orow;
        f16x2 acc[16];
#pragma unroll
        for (int i = 0; i < 16; ++i) { acc[i].x = (f16)0.f; acc[i].y = (f16)0.f; }
        { const int lA_ = hn ? nA : cA, lB_ = hn ? nB : cB; int en[16]; EN_GATHER(en, lA_, lB_); f16x2 hq[16];
#pragma unroll
          for (int g_ = 0; g_ < 8; ++g_) { const float qa = __shfl(hwA, 8 * g_ + sub) * 64.f, qb = __shfl(hwB, 8 * g_ + sub) * 64.f;
              hq[g_].x = (f16)qa; hq[g_].y = (f16)qa; hq[8 + g_].x = (f16)qb; hq[8 + g_].y = (f16)qb; }
          V_ROLL(bA, hwA, 0); V_ROLL(bB, hwB, 8); }
        f16x2 q8[8];
#pragma unroll
        for (int i = 0; i < 8; ++i) { const f16x2 keep = b3 ? acc[8 + i] : acc[i], send = b3 ? acc[i] : acc[8 + i]; q8[i] = keep + ash2(other8u(__builtin_bit_cast(unsigned, send))); }
        f16x2 q4[4];
#pragma unroll
        for (int i = 0; i < 4; ++i) { const f16x2 keep = b4 ? q8[4 + i] : q8[i], send = b4 ? q8[i] : q8[4 + i]; q4[i] = keep + ash2(other16u(__builtin_bit_cast(unsigned, send), b4)); }
        float r4[4];
        { const f16x2 k0 = b5 ? q4[2] : q4[0], k1 = b5 ? q4[3] : q4[1], s0 = b5 ? q4[0] : q4[2], s1 = b5 ? q4[1] : q4[3];
          const f16x2 p0 = ash2(other32u(__builtin_bit_cast(unsigned, s0), b5)), p1 = ash2(other32u(__builtin_bit_cast(unsigned, s1), b5));
          r4[0] = ((float)k0.x + (float)p0.x) * (1.f / 64.f); r4[1] = ((float)k0.y + (float)p0.y) * (1.f / 64.f); r4[2] = ((float)k1.x + (float)p1.x) * (1.f / 64.f); r4[3] = ((float)k1.y + (float)p1.y) * (1.f / 64.f); }
        const f16x2 x1a = ash2(x1r.x), x1b = ash2(x1r.y);
        const f32x4 x2 = {(float)x1a.x + r4[0], (float)x1a.y + r4[1], (float)x1b.x + r4[2], (float)x1b.y + r4[3]};
        { u32x2 o2; o2.x = pk_f16(x2.x, x2.y); o2.y = pk_f16(x2.z, x2.w); *(GAS u32x2*)orow = o2; }
        *(GAS unsigned*)(ws + WS_X8 + (size_t)t * D + col) = pk_fp8(x2.x, x2.y, x2.z, x2.w);
        const float ss = wave_sum((x2.x * x2.x + x2.y * x2.y) + (x2.z * x2.z + x2.w * x2.w));
        if (lane == 0) atomicAdd(SS2 + t, ss);
        if (!hn) break;
        cA = nA; cB = nB; nA = mA; nB = mB; t = tn; hwA = hwAn; hwB = hwBn;
    }
}
#undef FMIXV_LO
#undef FMIXV_HI

constexpr int NPH = 13;
struct Args { const float* in[26]; float* out; unsigned char* ws; int ph_lo, ph_hi; int rep[16]; };
__global__ void __launch_bounds__(NWAVES * 64, 2) fwd_kernel(Args args) {
    extern __shared__ __attribute__((aligned(16))) unsigned char lds[];
    Frame F;
    F.lds = (LAS unsigned char*)lds;
    F.MISC = (volatile LAS unsigned*)(F.lds + MISC_OFF);
    F.tid = threadIdx.x; F.lane = F.tid & 63; F.wave = __builtin_amdgcn_readfirstlane(F.tid >> 6);
#define PHASE_LANES() do { int t_ = threadIdx.x; asm volatile("" : "+v"(t_)); F.tid = t_; F.lane = t_ & 63; } while (0)
    F.G = gridDim.x; { const int bx = blockIdx.x; F.vcu = (F.G % 8 == 0) ? (bx % 8) * (F.G / 8) + bx / 8 : bx; }
#pragma unroll
    for (int i = 0; i < 26; ++i) F.in[i] = args.in[i];
    F.out = args.out; F.ws = args.ws;
    unsigned char* ws = args.ws;
    gu32* ctl = (gu32*)(ws + WS_CTL);
    for (int u = F.tid; u < (LDS_BYTES - LDSCTL_OFF) / 4; u += NWAVES * 64) ((LAS unsigned*)(F.lds + LDSCTL_OFF))[u] = 0u;
    __syncthreads();
    XcdBarrier bar; bar.bar = (unsigned*)(ctl + CW_BAR); bar.x = 0; bar.st = nullptr;
    if (MK_ONE_LAUNCH) bar = xcd_barrier_post((unsigned*)(ctl + CW_BAR), F.MISC + 8);
#define GRID_BAR() do { if (MK_ONE_LAUNCH) xcd_barrier(bar); } while (0)
    const int lo = args.ph_lo, hi = args.ph_hi;
#define IN(k) (lo <= (k) && (k) < hi)
#define BOTH(k) (IN(k) && IN((k) + 1))

    if (IN(0)) { PHASE_LANES(); for (int rp = 0; rp < args.rep[0]; ++rp) p0_prologue(F); if (BOTH(0)) GRID_BAR(); }

    if (IN(1)) {
        pg8::Gemm g{(const f16*)(ws + WS_XR), (const f16*)(ws + WS_WIN), M, NINP, D, D, D, 0, 1 << 30, 0};
        pg8::StaticOrder S; S.init(M, NINP, F.G, (int)blockIdx.x);
        pg8::EpiF16Row E{(f16*)(ws + WS_Y), NINP, (const float*)(ws + WS_SS0)};
        pg8::gemm_phase(F.lds, g, S, E);
        if (BOTH(1)) GRID_BAR();
    }

    if (IN(2)) { PHASE_LANES(); for (int rp = 0; rp < PROBE_REP2; ++rp) p2_post(F); if (BOTH(2)) GRID_BAR(); }

    if (IN(3)) {
        { pg8::Gemm g{(const f16*)(ws + WS_FLATA), (const f16*)(ws + WS_W1C), 8192, 1024, 512, D, D, 512, 16, (size_t)256 * D * 2, 512};
          pg8::StaticOrder S; S.init(8192, 1024, F.G, (int)blockIdx.x);
          pg8::EpiRawF32 E{(float*)(ws + WS_Y), 1024};
          pg8::gemm_phase(F.lds, g, S, E); }
        { pg8::Gemm g{(const f16*)(ws + WS_MIXED), (const f16*)(ws + WS_POOLT), M, 1024, 256, 1024, 256, 256, 1 << 30, 0};
          pg8::StaticOrder S; S.init(M, 1024, F.G, (int)((blockIdx.x + 128) % F.G));
          pg8::EpiF8 E{ws + WS_CAT, D, CAT8SCALE};
          pg8::gemm_phase(F.lds, g, S, E); }
        if (BOTH(3)) GRID_BAR();
    }

    if (IN(4)) { PHASE_LANES(); p4_compress2(F); if (BOTH(4)) GRID_BAR(); }

    if (IN(5)) { PHASE_LANES(); for (int rp = 0; rp < args.rep[5]; ++rp) p5_attention(F); if (BOTH(5)) GRID_BAR(); }

    if (IN(6)) {
        pg8::Gemm g{ws + WS_CAT, ws + WS_WOUT, M, D, D, D, D, 0, 1 << 30, 0, 0, 1};
        pg8::StaticOrder S; S.init(M, D, F.G, (int)blockIdx.x);
        pg8::EpiRes16 E{(f16*)(ws + WS_XR), (float*)(ws + WS_SS1), 1.f / (W8SCALE * CAT8SCALE)};
        pg8::gemm_phase<pg8::EpiRes16, pg8::StaticOrder, true>(F.lds, g, S, E);
        if (BOTH(6)) GRID_BAR();
    }

    if (IN(7)) {
        { pg8::Gemm g{(const f16*)(ws + WS_XR), (const f16*)(ws + WS_WQ), M, D, D, D, D, 0, 1 << 30, 0};
          pg8::StaticOrder S; S.init(M, D, F.G, (int)blockIdx.x);
          pg8::EpiF16Row E{(f16*)(ws + WS_QP), D, (const float*)(ws + WS_SS1)};
          pg8::gemm_phase(F.lds, g, S, E); }
        { pg8::Gemm g{(const f16*)(ws + WS_P16), (const f16*)(ws + WS_WPJ), M, D, 256, 256, 256, 0, 1 << 30, 0};
          pg8::StaticOrder S; S.init(M, D, F.G, (int)blockIdx.x);
          pg8::EpiF16<0> E{(f16*)(ws + WS_PJ), D, nullptr, 1 << 30, 0};
          pg8::gemm_phase(F.lds, g, S, E); }
        PHASE_LANES();
        for (int rp = 0; rp < args.rep[7]; ++rp) p7_tables(F);
        if (BOTH(7)) GRID_BAR();
    }

    if (IN(8)) { PHASE_LANES(); p9a_topk(F); if (BOTH(8)) GRID_BAR(); }
    if (IN(9)) { PHASE_LANES(); if (PROBE_DUPU) p9b_upass(F, false); p9b_upass(F, false); if (BOTH(9)) GRID_BAR(); }
    if (IN(10)) { PHASE_LANES(); p9h_weights(F); if (BOTH(10)) GRID_BAR(); }
    if (IN(11)) { PHASE_LANES(); p9c_vpass(F); if (BOTH(11)) GRID_BAR(); }

    if (IN(12)) {
        pg8::Gemm g{ws + WS_X8, ws + WS_WG, M, D, D, D, D, 0, 1 << 30, 0, 0, 1};
        pg8::StaticOrder S; S.init(M, D, F.G, (int)blockIdx.x);
        pg8::EpiFinal E{(const f16*)(ws + WS_XR), (const f16*)(ws + WS_PJ), F.out, (const float*)(ws + WS_SS2), 1.f / W8SCALE};
        pg8::gemm_phase<pg8::EpiFinal, pg8::StaticOrder, true>(F.lds, g, S, E);
    }
#undef IN
#undef BOTH
}

extern "C" void kernel_launch(void* const* d_in, const int* in_sizes, int n_in, void* d_out, int out_size, void* d_ws, size_t ws_size, hipStream_t stream) {
    static int grid = 0;
    if (grid == 0) {
        if (n_in != 26 || out_size != M * D || ws_size < WS_END) { fprintf(stderr, "kernel_launch: unexpected sizes n_in %d out %d ws %zu\n", n_in, out_size, ws_size); grid = -1; return; }
        int dev = 0, cus = 0, per_cu = 0;
        if (hipGetDevice(&dev) != hipSuccess || hipDeviceGetAttribute(&cus, hipDeviceAttributeMultiprocessorCount, dev) != hipSuccess) { grid = -1; return; }
        if (hipFuncSetAttribute((const void*)fwd_kernel, hipFuncAttributeMaxDynamicSharedMemorySize, LDS_BYTES) != hipSuccess) { fprintf(stderr, "kernel_launch: hipFuncSetAttribute failed\n"); grid = -1; return; }
        if (hipOccupancyMaxActiveBlocksPerMultiprocessor(&per_cu, (const void*)fwd_kernel, NWAVES * 64, LDS_BYTES) != hipSuccess || per_cu < 1)
            fprintf(stderr, "kernel_launch: occupancy query reports %d\n", per_cu);
        (void)hipGetLastError();
        grid = cus;
    }
    if (grid < 0) return;
    (void)hipMemsetAsync((char*)d_ws + WS_CTL, 0, CTL_ZERO_BYTES, stream);
    Args a{};
    for (int i = 0; i < 16; ++i) a.rep[i] = 1;
    a.rep[5] = PROBE_REP5; a.rep[0] = PROBE_REP0; a.rep[7] = PROBE_REP7;
    for (int i = 0; i < 26; ++i) a.in[i] = (const float*)d_in[i];
    a.out = (float*)d_out; a.ws = (unsigned char*)d_ws;
    if (MK_ONE_LAUNCH) { a.ph_lo = 0; a.ph_hi = NPH; hipLaunchKernelGGL(fwd_kernel, dim3(grid), dim3(NWAVES * 64), LDS_BYTES, stream, a); }
    else for (int p = 0; p < NPH; ++p) { a.ph_lo = p; a.ph_hi = p + 1; hipLaunchKernelGGL(fwd_kernel, dim3(grid), dim3(NWAVES * 64), LDS_BYTES, stream, a); }
}
```

```cpp
#include <hip/hip_runtime.h>
#include <cstdio>
#include <cstdint>

#define PROBE_REP0 1
#define PROBE_REP2 1
#define PROBE_DUPU 0
#define PROBE_REP5 1
#define PROBE_REP7 1
#define PROBE_REP9 1
#ifndef MK_ONE_LAUNCH
#define MK_ONE_LAUNCH 1
#endif

#define GAS __attribute__((address_space(1)))
#define LAS __attribute__((address_space(3)))
typedef _Float16 f16;
typedef _Float16 f16x8 __attribute__((ext_vector_type(8)));
typedef _Float16 f16x4 __attribute__((ext_vector_type(4)));
typedef _Float16 f16x2 __attribute__((ext_vector_type(2)));
typedef float f32x2 __attribute__((ext_vector_type(2)));
typedef float f32x4 __attribute__((ext_vector_type(4)));
typedef float f32x16 __attribute__((ext_vector_type(16)));
typedef unsigned u32x2 __attribute__((ext_vector_type(2)));
typedef unsigned u32x4 __attribute__((ext_vector_type(4)));
typedef GAS unsigned gu32;
typedef _Float16 f16x32 __attribute__((ext_vector_type(32)));
typedef unsigned u32x6 __attribute__((ext_vector_type(6)));
#define RLX_AGENT __ATOMIC_RELAXED, __HIP_MEMORY_SCOPE_AGENT
#define LDS_WAIT() asm volatile("s_waitcnt lgkmcnt(0)" ::: "memory")
__device__ __forceinline__ float mul_np(float a, float b) { float o; asm("v_mul_f32 %0, %1, %2" : "=v"(o) : "v"(a), "v"(b)); return o; }
__device__ __forceinline__ float add_np(float a, float b) { float o; asm("v_add_f32 %0, %1, %2" : "=v"(o) : "v"(a), "v"(b)); return o; }
#define VM_WAIT() asm volatile("s_waitcnt vmcnt(0)" ::: "memory")

constexpr int BATCH = 8, SEQ = 2048, D = 2048, M = BATCH * SEQ;
constexpr int NIN = 3632, NINP = 3840;
constexpr int OFF_U = 0, OFF_Q = 1024, OFF_KC = 2048, OFF_VC = 2304, OFF_KS = 2560, OFF_VS = 2816, OFF_KW = 3072, OFF_VW = 3328, OFF_G = 3584;
constexpr int NCMP = 127, NCROWS = BATCH * NCMP * 4;
constexpr float RMS_EPS = 1e-6f;
constexpr float LOG2E = 1.4426950408889634f;

constexpr size_t MiB = 1u << 20;
constexpr size_t WS_CTL = 0, CTL_ZERO_BYTES = 1 * MiB;
constexpr size_t WS_WIN = 2 * MiB, WS_WOUT = 17 * MiB, WS_WQ = 25 * MiB, WS_WG = 33 * MiB, WS_WPJ = 41 * MiB, WS_W1C = 42 * MiB, WS_POOLT = 44 * MiB, WS_KEYS = 45 * MiB;
constexpr size_t WS_CBIAS = 46 * MiB, WS_GATES = 47 * MiB, WS_HC = 50 * MiB, WS_KCMP = 54 * MiB, WS_VCMPT = 54 * MiB + 512 * 1024, WS_P16 = 56 * MiB;
constexpr size_t WS_XN = 64 * MiB, WS_X8 = 64 * MiB;
constexpr float CAT8SCALE = 8.f;
constexpr float W8SCALE = 64.f;
constexpr size_t WS_Y = 128 * MiB, WS_QP = 128 * MiB, WS_PJ = 192 * MiB;
constexpr size_t WS_MIXED = 256 * MiB, WS_CAT = 288 * MiB, WS_KN = 352 * MiB, WS_VT = 368 * MiB, WS_FLATA = 384 * MiB;
constexpr size_t WS_U6 = 256 * MiB, WS_V6 = 288 * MiB, WS_SU = 320 * MiB, WS_SV = 321 * MiB;
constexpr size_t WS_LIDX = 322 * MiB, WS_LG = 330 * MiB, WS_SSP = 338 * MiB, WS_PD = 340 * MiB, WS_HW = 404 * MiB;
constexpr size_t SLICE6 = (size_t)16384 * 192;
constexpr size_t WS_XR = 416 * MiB;
constexpr size_t WS_SS0 = 768 * 1024, WS_SS1 = 256 * 1024, WS_SS2 = 512 * 1024;
constexpr size_t WS_QN = 480 * MiB;
constexpr size_t WS_END = 512 * MiB;
constexpr int CW_TMO = 0, CW_CODE = 1, CW_BAR = 4096;

constexpr int RING_BYTES = 131072;
constexpr int LDSCTL_OFF = RING_BYTES, MISC_OFF = LDSCTL_OFF + 320;
constexpr int LDS_BYTES = 147456;
constexpr int NWAVES = 8;

__device__ __forceinline__ unsigned pk_f16(float lo, float hi) { f16x2 v; v.x = (f16)lo; v.y = (f16)hi; return __builtin_bit_cast(unsigned, v); }
__device__ __forceinline__ unsigned pk_fp8(float a, float b, float c, float d) { int r = __builtin_amdgcn_cvt_pk_fp8_f32(a, b, 0, false); r = __builtin_amdgcn_cvt_pk_fp8_f32(c, d, r, true); return (unsigned)r; }
__device__ __forceinline__ long as_i64(unsigned lo, unsigned hi) { return (long)(((unsigned long long)hi << 32) | lo); }
__device__ __forceinline__ f16x2 ash2(unsigned u) { return __builtin_bit_cast(f16x2, u); }
template <int CTRL> __device__ __forceinline__ float dpp_f(float v) { return __int_as_float(__builtin_amdgcn_update_dpp(0, __float_as_int(v), CTRL, 0xF, 0xF, true)); }
__device__ __forceinline__ float rl_f(float v, int l) { return __int_as_float(__builtin_amdgcn_readlane(__float_as_int(v), l)); }
__device__ __forceinline__ float sum8(float v) { v += dpp_f<0x141>(v); v += dpp_f<0xB1>(v); v += dpp_f<0x4E>(v); return v; }
__device__ __forceinline__ float wave_sum(float v) { v = sum8(v); v += dpp_f<0x140>(v); return (rl_f(v, 0) + rl_f(v, 16)) + (rl_f(v, 32) + rl_f(v, 48)); }
__device__ __forceinline__ float wave_max(float v) { v = fmaxf(v, dpp_f<0x141>(v)); v = fmaxf(v, dpp_f<0xB1>(v)); v = fmaxf(v, dpp_f<0x4E>(v)); v = fmaxf(v, dpp_f<0x140>(v));
    return fmaxf(fmaxf(rl_f(v, 0), rl_f(v, 16)), fmaxf(rl_f(v, 32), rl_f(v, 48))); }

__device__ __forceinline__ unsigned other8u(unsigned x) { return (unsigned)__builtin_amdgcn_update_dpp(0, (int)x, 0x128, 0xF, 0xF, true); }
__device__ __forceinline__ unsigned other16u(unsigned x, bool b4) { const auto r = __builtin_amdgcn_permlane16_swap(x, x, false, false); return b4 ? r[0] : r[1]; }
__device__ __forceinline__ unsigned other32u(unsigned x, bool b5) { const auto r = __builtin_amdgcn_permlane32_swap(x, x, false, false); return b5 ? r[0] : r[1]; }
namespace pg8 {
constexpr int BM = 256, BK = 64, HALF = 128, HTB = HALF * BK * 2, STAGE_BYTES = 8 * HTB, NXCD = 8, WGM = 8;
__host__ __device__ __forceinline__ int lds_byte(int r, int c) { const int st = (r >> 4) * 2 + (c >> 5), rr = r & 15, cc = c & 31, ob = rr * 64 + cc * 2; return st * 1024 + (ob ^ (((ob >> 9) & 1) << 5)); }
__host__ __device__ __forceinline__ void stage_rc(int b, int& R, int& C) { const int st = b / 1024, sb = b % 1024, swz = sb ^ (((sb >> 9) & 1) << 5); R = (st >> 1) * 16 + swz / 64; C = (st & 1) * 32 + (swz % 64) / 2; }
__host__ __device__ __forceinline__ int perm32(int rho) { const int n = rho >> 4, i = rho & 15; return 8 * (i >> 2) + 4 * n + (i & 3); }

struct Unit { int pm, pn; };
struct Gemm { const void* A; const void* Bt; int M, N, K, lda, ldb; int a_pn_off; int b_pm_split; size_t b_split_off; int b_pn_k = 0; int esz = 2;
    __device__ __forceinline__ const char* aptr(const Unit& u) const { return (const char*)A + ((size_t)u.pm * BM * lda + (size_t)u.pn * a_pn_off) * esz; }
    __device__ __forceinline__ const char* bptr(const Unit& u) const { return (const char*)Bt + (b_pn_k ? (size_t)u.pn * b_pn_k * esz : (size_t)u.pn * BM * ldb * esz) + (u.pm >= b_pm_split ? b_split_off : (size_t)0); }
};
struct StaticOrder {
    int nM, nN, nwg, G, c;
    __host__ __device__ void init(int M_, int N_, int G_, int c_) { nM = M_ / BM; nN = N_ / BM; nwg = nM * nN; G = G_; c = c_; }
    __host__ __device__ bool next(int i, Unit& u) const {
        const long L = (long)i * G + c; if (L >= nwg) return false;
        int wgid = (int)L; { const int q = nwg / NXCD, r = nwg % NXCD, xcd = wgid % NXCD, off = wgid / NXCD; wgid = (xcd < r ? xcd * (q + 1) : r * (q + 1) + (xcd - r) * q) + off; }
        const int nig = WGM * nN, gid = wgid / nig, fm = gid * WGM, gsz = (nM - fm) < WGM ? (nM - fm) : WGM;
        u.pm = fm + ((wgid % nig) % gsz); u.pn = (wgid % nig) / gsz; return true;
    }
};

__device__ __forceinline__ f32x2 gelu_pk(f32x2 v) {
    const f32x2 av = __builtin_elementwise_abs(v), d = av * 0.2316418882f + 1.0f;
    f32x2 t; t.x = __builtin_amdgcn_rcpf(d.x); t.y = __builtin_amdgcn_rcpf(d.y);
    f32x2 q = t * 0.5307027145f + (-0.7265760135f); q = q * t + 0.7107068705f; q = q * t + (-0.142248368f); q = q * t + 0.127414796f; q = q * t;
    const f32x2 s = (v * v) * (-0.72134752044f);
    f32x2 e; e.x = __builtin_amdgcn_exp2f(s.x); e.y = __builtin_amdgcn_exp2f(s.y);
    const f32x2 m = v * (q * e), r = v - m;
    f32x2 o; o.x = v.x < 0.f ? m.x : r.x; o.y = v.y < 0.f ? m.y : r.y; return o;
}
__device__ __forceinline__ float gelu1(float v) { f32x2 r = gelu_pk((f32x2){v, v}); return r.x; }

template <int ACT> struct EpiF16 {
    static constexpr bool PERM = true;
    f16* O; int ldc; const float* bias; int bias_pm_split; int bias_split_off;
    __device__ __forceinline__ void operator()(const f32x4 (&acc)[2][2][4][2], const Unit& u, int wr, int wc, int fr, int fq) const {
        const int row0 = u.pm * BM + wr * 64 + fr; const int col0 = u.pn * BM + wc * 32 + 8 * fq;
        const float* bp = bias ? bias + (u.pm >= bias_pm_split ? bias_split_off : 0) : nullptr;
        f32x4 bv[2][2];
#pragma unroll
        for (int bj = 0; bj < 2; ++bj)
#pragma unroll
            for (int n = 0; n < 2; ++n) bv[bj][n] = bp ? *(const f32x4*)(bp + col0 + bj * HALF + 4 * n) : (f32x4){0.f, 0.f, 0.f, 0.f};
#pragma unroll
        for (int ai = 0; ai < 2; ++ai)
#pragma unroll
            for (int m = 0; m < 4; ++m) { f16* rowp = O + (size_t)(row0 + ai * HALF + m * 16) * ldc + col0;
#pragma unroll
                for (int bj = 0; bj < 2; ++bj) { f32x4 v0 = acc[ai][bj][m][0] + bv[bj][0], v1 = acc[ai][bj][m][1] + bv[bj][1];
                    if (ACT == 1) { f32x2 a = gelu_pk((f32x2){v0[0], v0[1]}), b = gelu_pk((f32x2){v0[2], v0[3]}), c = gelu_pk((f32x2){v1[0], v1[1]}), d = gelu_pk((f32x2){v1[2], v1[3]});
                        v0 = (f32x4){a.x, a.y, b.x, b.y}; v1 = (f32x4){c.x, c.y, d.x, d.y}; }
                    u32x4 w; w.x = pk_f16(v0[0], v0[1]); w.y = pk_f16(v0[2], v0[3]); w.z = pk_f16(v1[0], v1[1]); w.w = pk_f16(v1[2], v1[3]);
                    *(u32x4*)(rowp + bj * HALF) = w; } }
    }
};
struct EpiRawF32 {
    static constexpr bool PERM = false;
    float* C; int ldc;
    __device__ __forceinline__ void operator()(const f32x4 (&acc)[2][2][4][2], const Unit& u, int wr, int wc, int fr, int fq) const {
        const int row0 = u.pm * BM + wr * 64 + fr, col0 = u.pn * BM + wc * 32 + 4 * fq;
#pragma unroll
        for (int ai = 0; ai < 2; ++ai)
#pragma unroll
            for (int m = 0; m < 4; ++m) { float* rowp = C + (size_t)(row0 + ai * HALF + m * 16) * ldc + col0;
#pragma unroll
                for (int bj = 0; bj < 2; ++bj)
#pragma unroll
                    for (int n = 0; n < 2; ++n) *(f32x4*)(rowp + bj * HALF + n * 16) = acc[ai][bj][m][n]; }
    }
};
struct EpiF8 {
    static constexpr bool PERM = true;
    unsigned char* O; int ldc; float sc;
    __device__ __forceinline__ void operator()(const f32x4 (&acc)[2][2][4][2], const Unit& u, int wr, int wc, int fr, int fq) const {
        const int row0 = u.pm * BM + wr * 64 + fr; const int col0 = u.pn * BM + wc * 32 + 8 * fq;
#pragma unroll
        for (int ai = 0; ai < 2; ++ai)
#pragma unroll
            for (int m = 0; m < 4; ++m) { unsigned char* rowp = O + (size_t)(row0 + ai * HALF + m * 16) * ldc + col0;
#pragma unroll
                for (int bj = 0; bj < 2; ++bj) { const f32x4 v0 = acc[ai][bj][m][0] * sc, v1 = acc[ai][bj][m][1] * sc;
                    u32x2 w; w.x = pk_fp8(v0[0], v0[1], v0[2], v0[3]); w.y = pk_fp8(v1[0], v1[1], v1[2], v1[3]);
                    *(u32x2*)(rowp + bj * HALF) = w; } }
    }
};
struct EpiRes16 {
    static constexpr bool PERM = true;
    f16* XR; float* SS; float as;
    __device__ __forceinline__ void operator()(const f32x4 (&acc)[2][2][4][2], const Unit& u, int wr, int wc, int fr, int fq) const {
        const int row0 = u.pm * BM + wr * 64 + fr; const int col0 = u.pn * BM + wc * 32 + 8 * fq;
#pragma unroll
        for (int ai = 0; ai < 2; ++ai) {
            f16x8 xb[4][2];
#pragma unroll
            for (int m = 0; m < 4; ++m)
#pragma unroll
                for (int bj = 0; bj < 2; ++bj) xb[m][bj] = *(const f16x8*)(XR + (size_t)(row0 + ai * HALF + m * 16) * D + col0 + bj * HALF);
            asm volatile("" ::: "memory");
#pragma unroll
            for (int m = 0; m < 4; ++m) { const int row = row0 + ai * HALF + m * 16; const size_t off = (size_t)row * D + col0; float ss = 0.f;
#pragma unroll
                for (int bj = 0; bj < 2; ++bj) { const f16x8 xv = xb[m][bj];
                    f32x4 v0 = acc[ai][bj][m][0] * as, v1 = acc[ai][bj][m][1] * as;
                    v0[0] += (float)xv[0]; v0[1] += (float)xv[1]; v0[2] += (float)xv[2]; v0[3] += (float)xv[3]; v1[0] += (float)xv[4]; v1[1] += (float)xv[5]; v1[2] += (float)xv[6]; v1[3] += (float)xv[7];
                    ss += ((v0[0] * v0[0] + v0[1] * v0[1]) + (v0[2] * v0[2] + v0[3] * v0[3])) + ((v1[0] * v1[0] + v1[1] * v1[1]) + (v1[2] * v1[2] + v1[3] * v1[3]));
                    u32x4 o; o.x = pk_f16(v0[0], v0[1]); o.y = pk_f16(v0[2], v0[3]); o.z = pk_f16(v1[0], v1[1]); o.w = pk_f16(v1[2], v1[3]);
                    *(u32x4*)(XR + off + bj * HALF) = o; }
                ss += __shfl_xor(ss, 16); ss += __shfl_xor(ss, 32);
                if (fq == 0) atomicAdd(SS + row, ss); }
            asm volatile("" ::: "memory"); }
    }
};
struct EpiF16Row {
    static constexpr bool PERM = true;
    f16* O; int ldc; const float* SS;
    __device__ __forceinline__ void operator()(const f32x4 (&acc)[2][2][4][2], const Unit& u, int wr, int wc, int fr, int fq) const {
        const int row0 = u.pm * BM + wr * 64 + fr; const int col0 = u.pn * BM + wc * 32 + 8 * fq;
#pragma unroll
        for (int ai = 0; ai < 2; ++ai)
#pragma unroll
            for (int m = 0; m < 4; ++m) { const int row = row0 + ai * HALF + m * 16; f16* rowp = O + (size_t)row * ldc + col0;
                const float rs = 1.f / sqrtf(SS[row] * (1.f / D) + RMS_EPS);
#pragma unroll
                for (int bj = 0; bj < 2; ++bj) { const f32x4 v0 = acc[ai][bj][m][0] * rs, v1 = acc[ai][bj][m][1] * rs;
                    u32x4 o; o.x = pk_f16(v0[0], v0[1]); o.y = pk_f16(v0[2], v0[3]); o.z = pk_f16(v1[0], v1[1]); o.w = pk_f16(v1[2], v1[3]);
                    *(u32x4*)(rowp + bj * HALF) = o; } }
    }
};
struct EpiFinal {
    static constexpr bool PERM = true;
    const f16* XR; const f16* PJ; float* C; const float* SS; float as;
    __device__ __forceinline__ void operator()(const f32x4 (&acc)[2][2][4][2], const Unit& u, int wr, int wc, int fr, int fq) const {
        const int row0 = u.pm * BM + wr * 64 + fr; const int col0 = u.pn * BM + wc * 32 + 8 * fq;
#pragma unroll
        for (int ai = 0; ai < 2; ++ai)
#pragma unroll
            for (int mh = 0; mh < 2; ++mh) {
                f16x8 xb[2][2], pb[2][2]; float ssv[2];
#pragma unroll
                for (int mm = 0; mm < 2; ++mm) { const int row = row0 + ai * HALF + (2 * mh + mm) * 16; ssv[mm] = SS[row];
#pragma unroll
                    for (int bj = 0; bj < 2; ++bj) { xb[mm][bj] = *(const f16x8*)(XR + (size_t)row * D + col0 + bj * HALF); pb[mm][bj] = *(const f16x8*)(PJ + (size_t)row * D + col0 + bj * HALF); } }
                asm volatile("" ::: "memory");
#pragma unroll
                for (int mm = 0; mm < 2; ++mm) { const int m = 2 * mh + mm; const int row = row0 + ai * HALF + m * 16; const size_t off = (size_t)row * D + col0;
                    const float nrs = -LOG2E * as / sqrtf(ssv[mm] * (1.f / D) + RMS_EPS);
#pragma unroll
                    for (int bj = 0; bj < 2; ++bj) { const f16x8 xv = xb[mm][bj], pv = pb[mm][bj];
                        const f32x4 a0 = acc[ai][bj][m][0], a1 = acc[ai][bj][m][1]; f32x4 o0, o1;
#pragma unroll
                        for (int j = 0; j < 4; ++j) { o0[j] = (float)xv[j] + (float)pv[j] * __builtin_amdgcn_rcpf(1.0f + __builtin_amdgcn_exp2f(nrs * a0[j]));
                            o1[j] = (float)xv[4 + j] + (float)pv[4 + j] * __builtin_amdgcn_rcpf(1.0f + __builtin_amdgcn_exp2f(nrs * a1[j])); }
                        *(f32x4*)(C + off + bj * HALF) = o0; *(f32x4*)(C + off + bj * HALF + 4) = o1; } }
                asm volatile("" ::: "memory"); }
    }
};
template <int MODE> struct EpiF32 {
    static constexpr bool PERM = false;
    const float* base; float* C; int ldc; const f16* pj; const float* ssp;
    __device__ __forceinline__ void operator()(const f32x4 (&acc)[2][2][4][2], const Unit& u, int wr, int wc, int fr, int fq) const {
        const int row0 = u.pm * BM + wr * 64 + fr, col0 = u.pn * BM + wc * 32 + 4 * fq;
#pragma unroll
        for (int ai = 0; ai < 2; ++ai)
#pragma unroll
            for (int m = 0; m < 4; ++m) { const size_t off = (size_t)(row0 + ai * HALF + m * 16) * ldc + col0;
                float nrs = -LOG2E;
                if (MODE == 1) { const f32x4 s0 = *(const f32x4*)(ssp + (size_t)(row0 + ai * HALF + m * 16) * 8), s1 = *(const f32x4*)(ssp + (size_t)(row0 + ai * HALF + m * 16) * 8 + 4);
                    nrs = -LOG2E / sqrtf((((s0.x + s0.y) + (s0.z + s0.w)) + ((s1.x + s1.y) + (s1.z + s1.w))) * (1.f / D) + RMS_EPS); }
#pragma unroll
                for (int bj = 0; bj < 2; ++bj)
#pragma unroll
                    for (int n = 0; n < 2; ++n) { const size_t o2 = off + bj * HALF + n * 16; const f32x4 bs = *(const f32x4*)(base + o2); f32x4 a = acc[ai][bj][m][n];
                        if (MODE == 1) { const f16x4 pv = *(const f16x4*)(pj + o2);
#pragma unroll
                            for (int j = 0; j < 4; ++j) a[j] = (float)pv[j] * __builtin_amdgcn_rcpf(1.0f + __builtin_amdgcn_exp2f(nrs * a[j])); }
                        *(f32x4*)(C + o2) = bs + a; }
                asm volatile("" ::: "memory"); }
    }
};

typedef int i32x4v __attribute__((ext_vector_type(4)));
typedef int i32x8v __attribute__((ext_vector_type(8)));
__device__ __forceinline__ i32x8v cat16(const f16x8 a, const f16x8 b) { const i32x4v x = __builtin_bit_cast(i32x4v, a), y = __builtin_bit_cast(i32x4v, b); return __builtin_shufflevector(x, y, 0, 1, 2, 3, 4, 5, 6, 7); }
__device__ __forceinline__ f16x8 half16(const i32x8v& v, int k) { const i32x4v h = k ? __builtin_shufflevector(v, v, 4, 5, 6, 7) : __builtin_shufflevector(v, v, 0, 1, 2, 3); return __builtin_bit_cast(f16x8, h); }
template <class Epi, class Sched, bool F8 = false>
__device__ __forceinline__ void gemm_phase(LAS unsigned char* lds, const Gemm g, const Sched& S, const Epi& E) {
    int tid = threadIdx.x; asm volatile("" : "+v"(tid));
    const int wid = __builtin_amdgcn_readfirstlane(tid >> 6), lane = tid & 63, wr = wid >> 2, wc = wid & 3, fr = lane & 15, fq = lane >> 4;
    const int K = g.K, nt = K * g.esz / (BK * 2);
    unsigned voffA[2], voffB[2];
#pragma unroll
    for (int i = 0; i < 2; ++i) { int R, C; stage_rc(tid * 16 + i * 8192, R, C); const int Rb = Epi::PERM ? ((R & ~31) + perm32(R & 31)) : R;
        voffA[i] = (unsigned)(R * g.lda * g.esz + C * 2); voffB[i] = (unsigned)(Rb * g.ldb * g.esz + C * 2); }
    const size_t kstep = (size_t)(BK * 2);
    const size_t hstepA = (size_t)HALF * g.lda * g.esz, hstepB = (size_t)HALF * g.ldb * g.esz;
    const unsigned ldsw = (unsigned)wid * 1024u;
    const int aoff = lds_byte(wr * 64 + fr, fq * 8), boff = lds_byte(wc * 32 + fr, fq * 8);
#define PG8_SA(b, h) (((b) * 2 + (h)) * HTB)
#define PG8_SB(b, h) ((4 + (b) * 2 + (h)) * HTB)
#define PG8_STAGE(bufoff, gbase, voff) do { _Pragma("unroll") for (int _i = 0; _i < 2; ++_i) \
        __builtin_amdgcn_global_load_lds((const unsigned*)((const char*)(gbase) + (voff)[_i]), (LAS unsigned*)(lds + (bufoff) + ldsw + _i * 8192), 16, 0, 0); } while (0)
#define PG8_LDA(dst, b, h) do { _Pragma("unroll") for (int m = 0; m < 4; ++m) dst[m] = cat16(*(const LAS f16x8*)(lds + PG8_SA(b, h) + aoff + m * 2048), *(const LAS f16x8*)(lds + PG8_SA(b, h) + aoff + m * 2048 + 1024)); } while (0)
#define PG8_LDB(dst, b, h) do { _Pragma("unroll") for (int n = 0; n < 2; ++n) dst[n] = cat16(*(const LAS f16x8*)(lds + PG8_SB(b, h) + boff + n * 2048), *(const LAS f16x8*)(lds + PG8_SB(b, h) + boff + n * 2048 + 1024)); } while (0)
#define PG8_MMA(ai, bj, At, Bt) do { __builtin_amdgcn_s_setprio(1); \
        if (F8) { _Pragma("unroll") for (int m = 0; m < 4; ++m) _Pragma("unroll") for (int n = 0; n < 2; ++n) \
            asm volatile("v_mfma_scale_f32_16x16x128_f8f6f4 %0, %1, %2, %0, %3, %3 op_sel_hi:[0,0,0]" : "+v"(acc[ai][bj][m][n]) : "v"(Bt[n]), "v"(At[m]), "v"(0x7F7F7F7F)); } \
        else { _Pragma("unroll") for (int m = 0; m < 4; ++m) _Pragma("unroll") for (int n = 0; n < 2; ++n) _Pragma("unroll") for (int k = 0; k < 2; ++k) \
            acc[ai][bj][m][n] = __builtin_amdgcn_mfma_f32_16x16x32_f16(half16(Bt[n], k), half16(At[m], k), acc[ai][bj][m][n], 0, 0, 0); } \
        __builtin_amdgcn_s_setprio(0); } while (0)
#define PG8_WAIT_V(n) asm volatile("s_waitcnt vmcnt(" #n ")" ::: "memory")
#define PG8_WAIT_L(n) asm volatile("s_waitcnt lgkmcnt(" #n ")" ::: "memory")
#define PG8_BAR __builtin_amdgcn_s_barrier()
#define PG8_SCHED __builtin_amdgcn_sched_barrier(0)
    Unit cur, nxt; int ui = 0;
    if (!S.next(0, cur)) return;
    f32x4 acc[2][2][4][2];
#pragma unroll
    for (int a = 0; a < 2; ++a)
#pragma unroll
        for (int b = 0; b < 2; ++b)
#pragma unroll
            for (int m = 0; m < 4; ++m)
#pragma unroll
                for (int n = 0; n < 2; ++n) acc[a][b][m][n] = (f32x4){0.f, 0.f, 0.f, 0.f};
    i32x8v At[4], B0[2], B1[2];
    const char* cA = g.aptr(cur); const char* cB = g.bptr(cur);
    PG8_STAGE(PG8_SB(0, 0), cB, voffB); PG8_STAGE(PG8_SB(0, 1), cB + hstepB, voffB); PG8_STAGE(PG8_SA(0, 0), cA, voffA); PG8_STAGE(PG8_SA(0, 1), cA + hstepA, voffA);
    if (wr == 1) PG8_BAR;
    PG8_WAIT_V(2); PG8_BAR;
    PG8_STAGE(PG8_SB(1, 0), cB + kstep, voffB); PG8_STAGE(PG8_SA(1, 0), cA + kstep, voffA); PG8_STAGE(PG8_SB(1, 1), cB + hstepB + kstep, voffB);
    PG8_WAIT_V(6); PG8_BAR;
    for (;;) {
        const bool has_next = S.next(ui + 1, nxt);
        const char* nA = has_next ? g.aptr(nxt) : cA; const char* nB = has_next ? g.bptr(nxt) : cB;
#pragma clang loop unroll(disable)
        for (int t = 0; t < nt; t += 2) {
            const bool last = (t == nt - 2);
            const char* a1 = cA + (size_t)(t + 1) * kstep;
            const char* a2 = last ? nA : cA + (size_t)(t + 2) * kstep; const char* b2 = last ? nB : cB + (size_t)(t + 2) * kstep;
            const char* a3 = a2 + kstep; const char* b3 = b2 + kstep;
            PG8_LDB(B0, 0, 0); PG8_LDB(B1, 0, 1); PG8_SCHED; PG8_LDA(At, 0, 0); PG8_STAGE(PG8_SA(1, 1), a1 + hstepA, voffA);
            PG8_WAIT_V(8); PG8_WAIT_L(0); PG8_BAR; PG8_MMA(0, 0, At, B0); PG8_MMA(0, 1, At, B1); PG8_BAR; PG8_SCHED;
            PG8_LDA(At, 0, 1); PG8_STAGE(PG8_SB(0, 0), b2, voffB); PG8_STAGE(PG8_SB(0, 1), b2 + hstepB, voffB); PG8_STAGE(PG8_SA(0, 0), a2, voffA);
            PG8_WAIT_V(8); PG8_WAIT_L(0); PG8_BAR; PG8_MMA(1, 0, At, B0); PG8_MMA(1, 1, At, B1); PG8_BAR; PG8_SCHED;
            PG8_LDB(B0, 1, 0); PG8_LDB(B1, 1, 1); PG8_SCHED; PG8_LDA(At, 1, 0); PG8_STAGE(PG8_SA(0, 1), a2 + hstepA, voffA);
            PG8_WAIT_V(8); PG8_WAIT_L(0); PG8_BAR; PG8_MMA(0, 0, At, B0); PG8_MMA(0, 1, At, B1); PG8_BAR; PG8_SCHED;
            PG8_LDA(At, 1, 1); PG8_STAGE(PG8_SB(1, 0), b3, voffB); PG8_STAGE(PG8_SB(1, 1), b3 + hstepB, voffB); PG8_STAGE(PG8_SA(1, 0), a3, voffA);
            PG8_WAIT_V(8); PG8_WAIT_L(0); PG8_BAR; PG8_MMA(1, 0, At, B0); PG8_MMA(1, 1, At, B1); PG8_BAR; PG8_SCHED;
        }
        if (F8) asm volatile("s_nop 15\n\ts_nop 15" ::: "memory");
        if (wr == 0) PG8_BAR;
        E(acc, cur, wr, wc, fr, fq);
        if (!has_next) break;
#pragma unroll
        for (int a = 0; a < 2; ++a)
#pragma unroll
            for (int b = 0; b < 2; ++b)
#pragma unroll
                for (int m = 0; m < 4; ++m)
#pragma unroll
                    for (int n = 0; n < 2; ++n) acc[a][b][m][n] = (f32x4){0.f, 0.f, 0.f, 0.f};
        cur = nxt; cA = nA; cB = nB; ++ui;
        if (wr == 1) PG8_BAR;
    }
    PG8_WAIT_V(0);
    PG8_BAR;
#undef PG8_SA
#undef PG8_SB
#undef PG8_STAGE
#undef PG8_LDA
#undef PG8_LDB
#undef PG8_MMA
#undef PG8_WAIT_V
#undef PG8_WAIT_L
#undef PG8_BAR
#undef PG8_SCHED
}
}

#define XB_TMO      128
#define XB_XCNT(j)  (256  + 64 * (j))
#define XB_XSUB(j)  (1280 + 64 * (j))
#define XB_XGEN(j)  (2304 + 64 * (j))
#define XB_TOP      3328
#define XB_TOPGEN   3392
#define XCD_BAR_WORDS 3456
#define XB_SPIN_CAP (1u << 18)
__device__ __forceinline__ unsigned xb_ld(unsigned* p)              { return __hip_atomic_load(p, __ATOMIC_RELAXED, __HIP_MEMORY_SCOPE_AGENT); }
__device__ __forceinline__ unsigned xb_add(unsigned* p, unsigned v) { return __hip_atomic_fetch_add(p, v, __ATOMIC_RELAXED, __HIP_MEMORY_SCOPE_AGENT); }
__device__ __forceinline__ unsigned xb_xcc_id() { return (unsigned)__builtin_amdgcn_s_getreg((3 << 11) | 20) & 0xFu; }
#define XB_SPIN(cond, bar) do { unsigned _sp = 0; while (cond) { __builtin_amdgcn_s_sleep(1); \
    if ((++_sp & 255u) == 0u) { if (xb_ld(&(bar)[XB_TMO])) break; if (_sp > XB_SPIN_CAP) { atomicAdd(&(bar)[XB_TMO], 1u); break; } } } } while (0)
struct XcdBarrier { unsigned* bar; unsigned x; volatile LAS unsigned* st; };
__device__ __forceinline__ XcdBarrier xcd_barrier_post(unsigned* bar, volatile LAS unsigned* st) {
    XcdBarrier b; b.bar = bar; b.x = xb_xcc_id(); b.st = st;
    if (threadIdx.x == 0) (void)xb_add(&bar[XB_XCNT(b.x)], 1u);
    return b;
}
__device__ __forceinline__ void xcd_barrier_complete(unsigned* bar, unsigned x, unsigned& nloc, unsigned& nx) {
    const unsigned G = gridDim.x * gridDim.y * gridDim.z;
    unsigned sum, cnt, mine, sp = 0u;
    for (;;) {
        sum = 0u; cnt = 0u; mine = 0u;
#pragma unroll
        for (unsigned j = 0; j < 16; ++j) { const unsigned c = xb_ld(&bar[XB_XCNT(j)]); sum += c; cnt += (c > 0u) ? 1u : 0u; mine = (j == x) ? c : mine; }
        if (sum == G) break;
        __builtin_amdgcn_s_sleep(1);
        if ((++sp & 255u) == 0u) { if (xb_ld(&bar[XB_TMO])) break; if (sp > XB_SPIN_CAP) { atomicAdd(&bar[XB_TMO], 1u); break; } }
    }
    nloc = mine > 0u ? mine : 1u; nx = cnt > 0u ? cnt : 1u;
}
__device__ __forceinline__ void xcd_barrier(const XcdBarrier& b) {
    asm volatile("s_waitcnt vmcnt(0)" ::: "memory");
    __syncthreads();
    if (threadIdx.x == 0) {
        unsigned* bar = b.bar;
        __builtin_amdgcn_s_waitcnt(0);
        unsigned nloc = b.st[0], nx = b.st[1];
        if (nloc == 0u) { xcd_barrier_complete(bar, b.x, nloc, nx); b.st[0] = nloc; b.st[1] = nx; }
        const unsigned old = xb_add(&bar[XB_XSUB(b.x)], 1u);
        const unsigned gen = old / nloc;
        if (old + 1u == (gen + 1u) * nloc) {
            __builtin_amdgcn_fence(__ATOMIC_RELEASE, "agent");
            asm volatile("s_waitcnt vmcnt(0)" ::: "memory");
            const unsigned og = xb_add(&bar[XB_TOP], 1u);
            const unsigned tg = og / nx;
            if (og + 1u == (tg + 1u) * nx) xb_add(&bar[XB_TOPGEN], 1u);
            else XB_SPIN(xb_ld(&bar[XB_TOPGEN]) == tg, bar);
            __builtin_amdgcn_fence(__ATOMIC_ACQUIRE, "agent");
            xb_add(&bar[XB_XGEN(b.x)], 1u);
            asm volatile("s_waitcnt vmcnt(0)" ::: "memory");
        } else {
            XB_SPIN(xb_ld(&bar[XB_XGEN(b.x)]) == gen, bar);
            __builtin_amdgcn_fence(__ATOMIC_ACQUIRE, "agent");
            asm volatile("s_waitcnt vmcnt(0)" ::: "memory");
        }
    }
    __syncthreads();
}

struct Frame {
    LAS unsigned char* lds;
    volatile LAS unsigned* MISC;
    int tid, lane, wave;
    int vcu, G;
    const float* in[26];
    float* out;
    unsigned char* ws;
};
enum { I_X = 0, I_P, I_RELB, I_MIXNW, I_WIN, I_QNW, I_KNW, I_CKPOS, I_CKW1, I_CKB1, I_CKW2, I_CVPOS, I_CVW1, I_CVB1, I_CVW2, I_POOLW, I_POOLS, I_WOUT, I_FFNNW, I_PWQ, I_PKEYS, I_PU, I_PV, I_PLENW, I_PLEWG, I_PLEWP };

__device__ __forceinline__ void p0_transpose_item(const float* W, int K, int N, int Npad, const float* colscale, f16* WT, LAS float* scr, int item, int lane, const float* kscale = nullptr, bool f8 = false, float wscale = 1.f) {
    const int nblk = Npad / 32, kb = item / nblk, nb = item % nblk, k0 = 64 * kb, n0 = 32 * nb;
    const int nn = n0 + (lane & 31); const bool ok = nn < N;
#pragma unroll
    for (int hgrp = 0; hgrp < 2; ++hgrp) { float wv[16];
#pragma unroll
        for (int i = 0; i < 16; ++i) { const int kk = 2 * (16 * hgrp + i) + (lane >> 5); wv[i] = ok ? W[(size_t)(k0 + kk) * N + nn] : 0.f; }
        if (kscale) {
#pragma unroll
            for (int i = 0; i < 16; ++i) wv[i] *= kscale[k0 + 2 * (16 * hgrp + i) + (lane >> 5)]; }
#pragma unroll
        for (int i = 0; i < 16; ++i) { const int kk = 2 * (16 * hgrp + i) + (lane >> 5); scr[kk * 33 + (lane & 31)] = wv[i]; }
        asm volatile("" ::: "memory"); }
    LDS_WAIT(); asm volatile("" ::: "memory");
    const int c = lane & 7;
#pragma unroll
    for (int j = 0; j < 4; ++j) { const int n = (lane >> 3) + 8 * j; const LAS float* s = scr + (8 * c) * 33 + n; const float sc = (colscale && n0 + n < N) ? colscale[n0 + n] : 1.f;
        if (f8) { const float s8 = sc * wscale; u32x2 o; o.x = pk_fp8(s[0 * 33] * s8, s[1 * 33] * s8, s[2 * 33] * s8, s[3 * 33] * s8); o.y = pk_fp8(s[4 * 33] * s8, s[5 * 33] * s8, s[6 * 33] * s8, s[7 * 33] * s8);
            *(GAS u32x2*)((unsigned char*)WT + (size_t)(n0 + n) * K + k0 + 8 * c) = o; }
        else { u32x4 o; o.x = pk_f16(s[0 * 33] * sc, s[1 * 33] * sc); o.y = pk_f16(s[2 * 33] * sc, s[3 * 33] * sc); o.z = pk_f16(s[4 * 33] * sc, s[5 * 33] * sc); o.w = pk_f16(s[6 * 33] * sc, s[7 * 33] * sc);
            *(GAS u32x4*)(WT + (size_t)(n0 + n) * K + k0 + 8 * c) = o; } }
    LDS_WAIT(); asm volatile("" ::: "memory");
}
__device__ __forceinline__ void rms_row_to_f16(const float* xrow, const float* w, f16* orow, int lane, f16* x16row = nullptr) {
    const GAS f32x4* xr = (const GAS f32x4*)xrow + lane; const GAS f32x4* wr = (const GAS f32x4*)w + lane;
    f32x4 v[8]; float s = 0.f;
#pragma unroll
    for (int j = 0; j < 8; ++j) { v[j] = xr[64 * j]; s += (v[j].x * v[j].x + v[j].y * v[j].y) + (v[j].z * v[j].z + v[j].w * v[j].w); }
    const float rstd = 1.f / sqrtf(wave_sum(s) * (1.f / D) + RMS_EPS);
    GAS u32x2* o8 = (GAS u32x2*)orow + lane;
#pragma unroll
    for (int j = 0; j < 8; ++j) { const f32x4 g = wr[64 * j]; u32x2 o; o.x = pk_f16(v[j].x * rstd * g.x, v[j].y * rstd * g.y); o.y = pk_f16(v[j].z * rstd * g.z, v[j].w * rstd * g.w); o8[64 * j] = o; }
    if (x16row) { GAS u32x2* x8 = (GAS u32x2*)x16row + lane;
#pragma unroll
        for (int j = 0; j < 8; ++j) { u32x2 o; o.x = pk_f16(v[j].x, v[j].y); o.y = pk_f16(v[j].z, v[j].w); x8[64 * j] = o; } }
}
__device__ __forceinline__ void rms_2rows_to_f16(const float* x0, const float* x1, const float* w, f16* o0, f16* o1, f16* h0, f16* h1, int lane) {
    const GAS f32x4* xa = (const GAS f32x4*)x0 + lane; const GAS f32x4* xb = (const GAS f32x4*)x1 + lane; const GAS f32x4* wr = (const GAS f32x4*)w + lane;
    f32x4 va[8], vb[8]; float sa = 0.f, sb = 0.f;
#pragma unroll
    for (int j = 0; j < 8; ++j) { va[j] = __builtin_nontemporal_load(xa + 64 * j); vb[j] = __builtin_nontemporal_load(xb + 64 * j); }
#pragma unroll
    for (int j = 0; j < 8; ++j) { sa += (va[j].x * va[j].x + va[j].y * va[j].y) + (va[j].z * va[j].z + va[j].w * va[j].w); sb += (vb[j].x * vb[j].x + vb[j].y * vb[j].y) + (vb[j].z * vb[j].z + vb[j].w * vb[j].w); }
    const float ra = 1.f / sqrtf(wave_sum(sa) * (1.f / D) + RMS_EPS), rb = 1.f / sqrtf(wave_sum(sb) * (1.f / D) + RMS_EPS);
    GAS u32x2* pa = (GAS u32x2*)o0 + lane; GAS u32x2* pb = (GAS u32x2*)o1 + lane; GAS u32x2* qa = (GAS u32x2*)h0 + lane; GAS u32x2* qb = (GAS u32x2*)h1 + lane;
#pragma unroll
    for (int j = 0; j < 8; ++j) { const f32x4 g = wr[64 * j]; u32x2 o;
        o.x = pk_f16(va[j].x * ra * g.x, va[j].y * ra * g.y); o.y = pk_f16(va[j].z * ra * g.z, va[j].w * ra * g.w); pa[64 * j] = o;
        o.x = pk_f16(vb[j].x * rb * g.x, vb[j].y * rb * g.y); o.y = pk_f16(vb[j].z * rb * g.z, vb[j].w * rb * g.w); pb[64 * j] = o;
        o.x = pk_f16(va[j].x, va[j].y); o.y = pk_f16(va[j].z, va[j].w); qa[64 * j] = o;
        o.x = pk_f16(vb[j].x, vb[j].y); o.y = pk_f16(vb[j].z, vb[j].w); qb[64 * j] = o; }
}
__device__ __forceinline__ void x16_2rows(const float* x0, const float* x1, f16* h0, f16* h1, float* ss0, float* ss1, int lane) {
    const GAS f32x4* xa = (const GAS f32x4*)x0 + lane; const GAS f32x4* xb = (const GAS f32x4*)x1 + lane;
    f32x4 va[8], vb[8]; float sa = 0.f, sb = 0.f;
#pragma unroll
    for (int j = 0; j < 8; ++j) { va[j] = __builtin_nontemporal_load(xa + 64 * j); vb[j] = __builtin_nontemporal_load(xb + 64 * j); }
    GAS u32x2* qa = (GAS u32x2*)h0 + lane; GAS u32x2* qb = (GAS u32x2*)h1 + lane;
#pragma unroll
    for (int j = 0; j < 8; ++j) { sa += (va[j].x * va[j].x + va[j].y * va[j].y) + (va[j].z * va[j].z + va[j].w * va[j].w); sb += (vb[j].x * vb[j].x + vb[j].y * vb[j].y) + (vb[j].z * vb[j].z + vb[j].w * vb[j].w);
        u32x2 o; o.x = pk_f16(va[j].x, va[j].y); o.y = pk_f16(va[j].z, va[j].w); qa[64 * j] = o;
        o.x = pk_f16(vb[j].x, vb[j].y); o.y = pk_f16(vb[j].z, vb[j].w); qb[64 * j] = o; }
    sa = wave_sum(sa); sb = wave_sum(sb);
    if (lane == 0) { *ss0 = sa; *ss1 = sb; }
}
__device__ __forceinline__ void cvt_f32_f16(Frame& F, const float* src, f16* dst, size_t n) {
    const size_t gt = (size_t)F.vcu * 512 + F.tid, GT = (size_t)F.G * 512;
    for (size_t i = gt; i < n / 8; i += GT) { const f32x4 a = *(const GAS f32x4*)(src + i * 8), b = *(const GAS f32x4*)(src + i * 8 + 4);
        u32x4 o; o.x = pk_f16(a.x, a.y); o.y = pk_f16(a.z, a.w); o.z = pk_f16(b.x, b.y); o.w = pk_f16(b.z, b.w); *(GAS u32x4*)(dst + i * 8) = o; }
}

__device__ __forceinline__ void p0_prologue(Frame& F) {
    LAS float* scr = (LAS float*)(F.lds + F.wave * 16384);
    const int gw = F.vcu * NWAVES + F.wave, NGW = F.G * NWAVES;
    unsigned char* ws = F.ws;
    constexpr int I_IN = (D / 64) * (NINP / 32), I_SQ = (D / 64) * (D / 32), I_PJ = (256 / 64) * (D / 32), I_C1 = (D / 64) * (256 / 32), I_PL = (256 / 64) * (256 / 32);
    constexpr int NITEMS = I_IN + 3 * I_SQ + I_PJ + 2 * I_C1 + 4 * I_PL;
    for (int it = gw; it < NITEMS; it += NGW) {
        int r = it;
        if (r < I_IN) { p0_transpose_item(F.in[I_WIN], D, NIN, NINP, nullptr, (f16*)(ws + WS_WIN), scr, r, F.lane, F.in[I_MIXNW]); continue; } r -= I_IN;
        if (r < I_SQ) { p0_transpose_item(F.in[I_WOUT], D, D, D, nullptr, (f16*)(ws + WS_WOUT), scr, r, F.lane, nullptr, true, W8SCALE); continue; } r -= I_SQ;
        if (r < I_SQ) { p0_transpose_item(F.in[I_PWQ], D, D, D, nullptr, (f16*)(ws + WS_WQ), scr, r, F.lane, F.in[I_FFNNW]); continue; } r -= I_SQ;
        if (r < I_SQ) { p0_transpose_item(F.in[I_PLEWG], D, D, D, nullptr, (f16*)(ws + WS_WG), scr, r, F.lane, F.in[I_PLENW], true, W8SCALE); continue; } r -= I_SQ;
        if (r < I_PJ) { p0_transpose_item(F.in[I_PLEWP], 256, D, D, nullptr, (f16*)(ws + WS_WPJ), scr, r, F.lane); continue; } r -= I_PJ;
        if (r < I_C1) { p0_transpose_item(F.in[I_CKW1], D, 256, 256, nullptr, (f16*)(ws + WS_W1C), scr, r, F.lane); continue; } r -= I_C1;
        if (r < I_C1) { p0_transpose_item(F.in[I_CVW1], D, 256, 256, nullptr, (f16*)(ws + WS_W1C) + 256 * D, scr, r, F.lane); continue; } r -= I_C1;
        { const int g = r / I_PL; r -= g * I_PL;
          p0_transpose_item(F.in[I_POOLW] + (size_t)g * 65536, 256, 256, 256, F.in[I_POOLS] + g * 256, (f16*)(ws + WS_POOLT) + (size_t)g * 65536, scr, r, F.lane); }
    }
    { float* SS0 = (float*)(ws + WS_SS0); f16* XR = (f16*)(ws + WS_XR);
      for (int m = gw; m < M; m += 2 * NGW) { const int m2 = m + NGW < M ? m + NGW : m;
          x16_2rows(F.in[I_X] + (size_t)m * D, F.in[I_X] + (size_t)m2 * D, XR + (size_t)m * D, XR + (size_t)m2 * D, SS0 + m, SS0 + m2, F.lane); } }
    cvt_f32_f16(F, F.in[I_P], (f16*)(ws + WS_P16), (size_t)M * 256);
    cvt_f32_f16(F, F.in[I_PKEYS], (f16*)(ws + WS_KEYS), (size_t)8 * 2 * 128 * 128);
    for (int task = gw; task < 512; task += NGW) { const int mat = task >> 8, n = task & 255;
        const float* pos = F.in[mat ? I_CVPOS : I_CKPOS]; const float* w1 = F.in[mat ? I_CVW1 : I_CKW1]; float s = 0.f;
#pragma unroll
        for (int i = 0; i < 32; ++i) { const int k = F.lane + 64 * i; s += pos[k] * w1[(size_t)k * 256 + n]; }
        s = wave_sum(s);
        if (F.lane == 0) ((float*)(ws + WS_CBIAS))[task] = s + F.in[mat ? I_CVB1 : I_CKB1][n]; }
}

template <int W> __device__ __forceinline__ void pool_mix_tile(const f16* up, f16* mp, size_t mb, int s0) {
    f16x2 prev[16], cur[16]; f32x2 sum = {0.f, 0.f};
#pragma unroll
    for (int i = 0; i < 16; ++i) { const int sp = s0 - 16 + i; prev[i] = sp >= 0 ? *(const GAS f16x2*)(up + (mb + sp) * NINP) : (f16x2){(f16)0.f, (f16)0.f}; }
#pragma unroll
    for (int i = 16 - W; i < 16; ++i) { sum.x += (float)prev[i].x; sum.y += (float)prev[i].y; }
#pragma unroll 1
    for (int blk = 0; blk < 4; ++blk) { const int sb = s0 + blk * 16;
#pragma unroll
        for (int i = 0; i < 16; ++i) cur[i] = *(const GAS f16x2*)(up + (mb + sb + i) * NINP);
#pragma unroll
        for (int i = 0; i < 16; ++i) { const int s = sb + i; const f16x2 o = (i - W >= 0) ? cur[(i - W >= 0) ? i - W : 0] : prev[(i - W >= 0) ? 0 : 16 + i - W];
            sum.x += (float)cur[i].x - (float)o.x; sum.y += (float)cur[i].y - (float)o.y;
            const float ic = 1.f / (float)(s + 1 < W ? s + 1 : W);
            *(GAS unsigned*)(mp + (mb + s) * 1024) = pk_f16(sum.x * ic - (float)cur[i].x, sum.y * ic - (float)cur[i].y); }
#pragma unroll
        for (int i = 0; i < 16; ++i) prev[i] = cur[i]; }
}
__device__ __forceinline__ void p2_post(Frame& F) {
    unsigned char* ws = F.ws;
    f16* Y = (f16*)(ws + WS_Y);
    const float* qnw = F.in[I_QNW]; const float* knw = F.in[I_KNW];
    LAS f16* vl = (LAS f16*)F.lds;
    constexpr int VLP = 264;
    for (int tt = F.vcu; tt < M / 64; tt += F.G) {
        const int b = tt >> 5, s0 = (tt & 31) * 64, m0 = tt * 64;
        for (int tk = F.wave; tk < 64; tk += NWAVES) {
            const int m = m0 + tk, s = s0 + tk; f16* yr = Y + (size_t)m * NINP;
#pragma unroll
            for (int pass = 0; pass < 2; ++pass) { const int ch = pass * 64 + F.lane; f16* pq = yr + OFF_Q + ch * 8; const f16x8 v = *(const GAS f16x8*)pq;
                float ss = 0.f;
#pragma unroll
                for (int e = 0; e < 8; ++e) ss += (float)v[e] * (float)v[e];
                ss = sum8(ss);
                const float rs = (1.f / sqrtf(ss * (1.f / 64.f) + RMS_EPS)) * (0.125f * LOG2E); const float* w = qnw + (ch & 7) * 8;
                u32x4 o; o.x = pk_f16((float)v[0] * rs * w[0], (float)v[1] * rs * w[1]); o.y = pk_f16((float)v[2] * rs * w[2], (float)v[3] * rs * w[3]);
                o.z = pk_f16((float)v[4] * rs * w[4], (float)v[5] * rs * w[5]); o.w = pk_f16((float)v[6] * rs * w[6], (float)v[7] * rs * w[7]);
                *(GAS u32x4*)((f16*)(ws + WS_QN) + (size_t)m * 1024 + ch * 8) = o; }
            { const int br = F.lane >> 5, ch = F.lane & 31, g = ch >> 3, dc = ch & 7; const f16x8 v = *(const GAS f16x8*)(yr + (br ? OFF_KW : OFF_KS) + ch * 8);
                float ss = 0.f;
#pragma unroll
                for (int e = 0; e < 8; ++e) ss += (float)v[e] * (float)v[e];
                ss = sum8(ss);
                const float rs = 1.f / sqrtf(ss * (1.f / 64.f) + RMS_EPS); const float* w = knw + dc * 8;
                u32x2 o; o.x = pk_fp8((float)v[0] * rs * w[0], (float)v[1] * rs * w[1], (float)v[2] * rs * w[2], (float)v[3] * rs * w[3]);
                o.y = pk_fp8((float)v[4] * rs * w[4], (float)v[5] * rs * w[5], (float)v[6] * rs * w[6], (float)v[7] * rs * w[7]);
                *(GAS u32x2*)(ws + WS_KN + (size_t)br * (BATCH * 4 * SEQ * 64) + ((size_t)(b * 4 + g) * 64 + (s >> 5)) * 2048 + (dc >> 2) * 1024 + ((dc & 1) * 32 + (s & 31)) * 16 + ((dc >> 1) & 1) * 8) = o; }
            { const int mat = F.lane >> 5, ch = F.lane & 31, g = ch >> 3, dc = ch & 7; const u32x4 v = *(const GAS u32x4*)(yr + (mat ? OFF_VC : OFF_KC) + ch * 8);
                const int i1 = s >> 4, jj = s & 15; f16* fa = (f16*)(ws + WS_FLATA) + (size_t)mat * 4096 * 2048;
                if (i1 <= NCMP - 1) *(GAS u32x4*)(fa + (size_t)((b * NCMP + i1) * 4 + g) * 2048 + jj * 64 + dc * 8) = v;
                if (i1 >= 1) *(GAS u32x4*)(fa + (size_t)((b * NCMP + i1 - 1) * 4 + g) * 2048 + (16 + jj) * 64 + dc * 8) = v; }
        }
        for (int idx = F.tid; idx < 64 * 48; idx += 512) { const int tk = idx / 48, c = idx - tk * 48; const float v = (float)Y[(size_t)(m0 + tk) * NINP + OFF_G + c];
            ((float*)(ws + WS_GATES))[(size_t)(m0 + tk) * 48 + c] = 1.f / (1.f + __expf(-v)); }
        { const int gg = F.tid >> 7;
          if (gg == 0) pool_mix_tile<2>(Y + OFF_U + F.tid * 2, (f16*)(ws + WS_MIXED) + F.tid * 2, (size_t)b * SEQ, s0);
          else if (gg == 1) pool_mix_tile<4>(Y + OFF_U + F.tid * 2, (f16*)(ws + WS_MIXED) + F.tid * 2, (size_t)b * SEQ, s0);
          else if (gg == 2) pool_mix_tile<8>(Y + OFF_U + F.tid * 2, (f16*)(ws + WS_MIXED) + F.tid * 2, (size_t)b * SEQ, s0);
          else pool_mix_tile<16>(Y + OFF_U + F.tid * 2, (f16*)(ws + WS_MIXED) + F.tid * 2, (size_t)b * SEQ, s0); }
        __syncthreads();
        for (int idx = F.tid; idx < 2 * 64 * 32; idx += 512) { const int br = idx >> 11, tk = (idx >> 5) & 63, ch = idx & 31;
            *(LAS u32x4*)(vl + (br * 64 + tk) * VLP + ch * 8) = *(const GAS u32x4*)(Y + (size_t)(m0 + tk) * NINP + (br ? OFF_VW : OFF_VS) + ch * 8); }
        __syncthreads();
        for (int idx = F.tid; idx < 2 * 256 * 8; idx += 512) { const int br = idx >> 11, row = (idx >> 3) & 255, cc = idx & 7, grp = cc >> 1, hh = cc & 1;
            float o[8];
#pragma unroll
            for (int j = 0; j < 8; ++j) { const int kap = 16 * grp + 8 * (j >> 2) + 4 * hh + (j & 3); o[j] = (float)vl[(br * 64 + kap) * VLP + row]; }
            const int g = row >> 6, d = row & 63;
            u32x2 o8; o8.x = pk_fp8(o[0], o[1], o[2], o[3]); o8.y = pk_fp8(o[4], o[5], o[6], o[7]);
            *(GAS u32x2*)(ws + WS_VT + (size_t)br * (BATCH * 4 * 64 * SEQ) + ((size_t)(b * 4 + g) * 64 + (s0 >> 5) + (cc >> 2)) * 2048 + (d >> 5) * 1024 + ((cc & 1) * 32 + (d & 31)) * 16 + ((cc >> 1) & 1) * 8) = o8; }
        __syncthreads();
    }
}

__device__ __forceinline__ void p4_compress2(Frame& F) {
    unsigned char* ws = F.ws;
    f16* kc = (f16*)(ws + WS_KCMP); f16* vt = (f16*)(ws + WS_VCMPT);
    const int nhalf = F.G >> 1, mat = F.vcu & 1, wgr = F.vcu >> 1;
    if (nhalf == 0) return;
    LAS float* w2l = (LAS float*)F.lds;
    { const float* w2g = F.in[mat ? I_CVW2 : I_CKW2];
      for (int idx = F.tid; idx < 256 * 16; idx += 512) { const int k = idx >> 4, d4 = (idx & 15) * 4; const f32x4 v = *(const GAS f32x4*)(w2g + (size_t)k * 64 + d4);
          LAS float* q = w2l + ((k >> 2) * 64 + d4) * 4 + (k & 3); q[0] = v.x; q[4] = v.y; q[8] = v.z; q[12] = v.w; } }
    __syncthreads();
    const int rstep = nhalf * NWAVES, r0 = (F.vcu >= 2 * nhalf ? 4096 : wgr * NWAVES + F.wave);
#pragma unroll 1
    for (int rb = r0; rb < 4096; rb += 4 * rstep) {
        f32x4 hs[4];
#pragma unroll
        for (int q = 0; q < 4; ++q) { const int r = rb + q * rstep < 4096 ? rb + q * rstep : rb; const int bg = r >> 7, i = r & 127, ic = i < NCMP ? i : 0;
            const float* hp = (const float*)(ws + WS_Y) + ((size_t)mat * 4096 + (size_t)((bg >> 2) * NCMP + ic) * 4 + (bg & 3)) * 1024 + F.lane * 4;
            hs[q] = *(const GAS f32x4*)(((const float*)(ws + WS_CBIAS)) + mat * 256 + F.lane * 4);
#pragma unroll
            for (int ks = 0; ks < 4; ++ks) hs[q] = hs[q] + *(const GAS f32x4*)(hp + ks * 256); }
        float hh_[4][4], ac[4][4];
#pragma unroll
        for (int q = 0; q < 4; ++q) { const f32x2 ga = pg8::gelu_pk((f32x2){hs[q].x, hs[q].y}), gb = pg8::gelu_pk((f32x2){hs[q].z, hs[q].w});
            hh_[q][0] = ga.x; hh_[q][1] = ga.y; hh_[q][2] = gb.x; hh_[q][3] = gb.y; ac[q][0] = 0.f; ac[q][1] = 0.f; ac[q][2] = 0.f; ac[q][3] = 0.f; }
#pragma unroll 8
        for (int kk = 0; kk < 64; ++kk) { const f32x4 wv = *(const LAS f32x4*)(w2l + (kk * 64 + F.lane) * 4);
#pragma unroll
            for (int q = 0; q < 4; ++q) { ac[q][0] += rl_f(hh_[q][0], kk) * wv.x; ac[q][1] += rl_f(hh_[q][1], kk) * wv.y; ac[q][2] += rl_f(hh_[q][2], kk) * wv.z; ac[q][3] += rl_f(hh_[q][3], kk) * wv.w; } }
#pragma unroll
        for (int q = 0; q < 4; ++q) { const int r = rb + q * rstep; if (r < 4096) {
            const int bg = r >> 7, i = r & 127;
            const float acc = i < NCMP ? (ac[q][0] + ac[q][1]) + (ac[q][2] + ac[q][3]) : 0.f;
            if (mat == 0) { const float ss = wave_sum(acc * acc); const float rs = 1.f / sqrtf(ss * (1.f / 64.f) + RMS_EPS);
                const int d = F.lane, dc = d >> 3;
                kc[((size_t)bg * 4 + (i >> 5)) * 2048 + (dc >> 1) * 512 + ((dc & 1) * 32 + (i & 31)) * 8 + (d & 7)] = (f16)(i < NCMP ? acc * rs * F.in[I_KNW][F.lane] : 0.f); }
            else { const int kap = i & 15, pp = ((kap >> 2) & 1) * 8 + (kap >> 3) * 4 + (kap & 3);
                const int d = F.lane;
                vt[((size_t)bg * 4 + (i >> 5)) * 2048 + ((d >> 5) * 2 + ((i >> 4) & 1)) * 512 + ((pp >> 3) * 32 + (d & 31)) * 8 + (pp & 7)] = (f16)acc; } } }
    }
    __syncthreads();
}

__device__ __forceinline__ int t5_bucket(int rel) {
    if (rel < 16) return rel;
    int b = 16;
    b += rel >= 19; b += rel >= 21; b += rel >= 24; b += rel >= 27; b += rel >= 31; b += rel >= 35; b += rel >= 40; b += rel >= 46;
    b += rel >= 52; b += rel >= 59; b += rel >= 67; b += rel >= 77; b += rel >= 87; b += rel >= 99; b += rel >= 113;
    return b;
}
__device__ __forceinline__ int med3i(int a, int lo, int hi) { return a < lo ? lo : (a > hi ? hi : a); }
__device__ __forceinline__ float other_half_max(float x) { const auto r = __builtin_amdgcn_permlane32_swap(__float_as_uint(x), __float_as_uint(x), false, false); return fmaxf(__uint_as_float(r[0]), __uint_as_float(r[1])); }
__device__ __forceinline__ float both_halves_sum(float x) { const auto r = __builtin_amdgcn_permlane32_swap(__float_as_uint(x), __float_as_uint(x), false, false); return __uint_as_float(r[0]) + __uint_as_float(r[1]); }
struct AFrag { u32x4 k[2]; u32x4 v[2]; };
__device__ __forceinline__ void attn_load(AFrag& f, const unsigned char* Kp, const unsigned char* Vp, int kt, int r31, int hh) {
    const unsigned char* kp = Kp + (size_t)kt * 2048 + (hh * 32 + r31) * 16; const unsigned char* vp = Vp + (size_t)kt * 2048 + (hh * 32 + r31) * 16;
#pragma unroll
    for (int j = 0; j < 2; ++j) f.k[j] = *(const GAS u32x4*)(kp + j * 1024);
#pragma unroll
    for (int dt = 0; dt < 2; ++dt) f.v[dt] = *(const GAS u32x4*)(vp + dt * 1024);
}
__device__ __forceinline__ f16x8 pack8(const f32x16& c, int s2) {
    f16x8 o;
#pragma unroll
    for (int j = 0; j < 8; ++j) o[j] = (f16)c[8 * s2 + j];
    return o;
}
__device__ __forceinline__ void attn_tile(const AFrag& f, const long (&bq8)[4], int kt, int t0, int t, int hh, int wlim, unsigned selm, float cfar, const LAS float* lutr,
                                          float& mrun, float& lrun, f32x16& O0, f32x16& O1) {
    f32x16 S;
#pragma unroll
    for (int i = 0; i < 16; ++i) S[i] = 0.f;
#pragma unroll
    for (int ks = 0; ks < 4; ++ks) S = __builtin_amdgcn_mfma_f32_32x32x16_fp8_fp8((ks & 1) ? as_i64(f.k[ks >> 1].z, f.k[ks >> 1].w) : as_i64(f.k[ks >> 1].x, f.k[ks >> 1].y), bq8[ks], S, 0, 0, 0);
    const int k0 = kt * 32, minrel = t0 - (k0 + 31), maxrel = t0 + 7 - k0;
    const bool selbit = ((selm >> (kt >> 1)) & 1u) != 0u;
    float addc = 0.f;
    if (minrel >= 113 && maxrel < wlim) addc = selbit ? cfar : -2e30f;
    else {
        const unsigned wl = selbit ? (unsigned)wlim : 0u; const int relb = t - k0 - 4 * hh;
        float bias[16];
#pragma unroll
        for (int i = 0; i < 16; ++i) bias[i] = lutr[med3i(relb - ((i & 3) + 8 * (i >> 2)), 0, 127)];
#pragma unroll
        for (int i = 0; i < 16; ++i) asm volatile("" : "+v"(bias[i]));
#pragma unroll
        for (int i = 0; i < 16; ++i) { const int rel = relb - ((i & 3) + 8 * (i >> 2)); S[i] = ((unsigned)rel < wl) ? __builtin_fmaf(bias[i], 8.f, S[i]) : -2e30f; }
    }
    float tmax = S[0];
#pragma unroll
    for (int i = 1; i < 16; ++i) tmax = fmaxf(tmax, S[i]);
    tmax = other_half_max(tmax) * 0.125f + addc;
    const float mnew = fmaxf(mrun, tmax), alpha = __builtin_amdgcn_exp2f(mrun - mnew);
    mrun = mnew; lrun *= alpha;
    if (__builtin_amdgcn_ballot_w64(alpha != 1.0f) != 0ull) {
#pragma unroll
        for (int i = 0; i < 16; ++i) { O0[i] = mul_np(O0[i], alpha); O1[i] = mul_np(O1[i], alpha); } }
    const float mm = mnew - addc;
#pragma unroll
    for (int i = 0; i < 16; ++i) { const float pv = __builtin_amdgcn_exp2f(__builtin_fmaf(S[i], 0.125f, -mm)); lrun += pv; S[i] = pv; }
#pragma unroll
    for (int s2 = 0; s2 < 2; ++s2) { const long pb = as_i64(pk_fp8(S[8 * s2], S[8 * s2 + 1], S[8 * s2 + 2], S[8 * s2 + 3]), pk_fp8(S[8 * s2 + 4], S[8 * s2 + 5], S[8 * s2 + 6], S[8 * s2 + 7]));
        O0 = __builtin_amdgcn_mfma_f32_32x32x16_fp8_fp8(s2 ? as_i64(f.v[0].z, f.v[0].w) : as_i64(f.v[0].x, f.v[0].y), pb, O0, 0, 0, 0);
        O1 = __builtin_amdgcn_mfma_f32_32x32x16_fp8_fp8(s2 ? as_i64(f.v[1].z, f.v[1].w) : as_i64(f.v[1].x, f.v[1].y), pb, O1, 0, 0, 0); }
}
__device__ __forceinline__ void attn_branch(const unsigned char* Kp, const unsigned char* Vp, unsigned long long tm, const long (&bq)[4], int t0, int t, int r31, int hh, int wlim, unsigned selm, float cfar,
                                            const LAS float* lutr, float gate, LAS float* TL) {
    float mrun = -1e30f, lrun = 0.f; f32x16 O0, O1;
#pragma unroll
    for (int i = 0; i < 16; ++i) { O0[i] = 0.f; O1[i] = 0.f; }
    AFrag fA, fB;
    int ktA = __builtin_ctzll(tm), ktB;
    attn_load(fA, Kp, Vp, ktA, r31, hh);
    for (;;) {
        tm &= tm - 1; const bool hasB = tm != 0ull; ktB = hasB ? __builtin_ctzll(tm) : ktA; attn_load(fB, Kp, Vp, ktB, r31, hh);
        attn_tile(fA, bq, ktA, t0, t, hh, wlim, selm, cfar, lutr, mrun, lrun, O0, O1);
        if (!hasB) break;
        tm &= tm - 1; const bool hasA = tm != 0ull; ktA = hasA ? __builtin_ctzll(tm) : ktB; attn_load(fA, Kp, Vp, ktA, r31, hh);
        attn_tile(fB, bq, ktB, t0, t, hh, wlim, selm, cfar, lutr, mrun, lrun, O0, O1);
        if (!hasA) break;
    }
    lrun = both_halves_sum(lrun);
    const float sc = gate / fmaxf(lrun, 1e-30f);
#pragma unroll
    for (int i = 0; i < 16; ++i) { TL[i * 64] += O0[i] * sc; TL[(16 + i) * 64] += O1[i] * sc; }
}
__device__ __forceinline__ void p5_attention(Frame& F) {
    unsigned char* ws = F.ws;
    const f16* Y = (const f16*)(ws + WS_Y);
    const float* gates = (const float*)(ws + WS_GATES);
    f16* CAT = (f16*)(ws + WS_CAT);
    LAS float* wl = (LAS float*)(F.lds + F.wave * 8192);
    LAS float* LUT = wl;
    const int gw = F.vcu * NWAVES + F.wave, NW = F.G * NWAVES;
    const bool snake = (8192 % (2 * NW)) == 0, bal = (NW == 2048);
    int lut_g = -1;
    LAS unsigned* SELM = (LAS unsigned*)(wl + 1280);
    for (int it = gw, rr = 0; it < 8192; it += NW, ++rr) {
        int n = (snake && (rr & 1)) ? (rr * NW + (NW - 1 - gw)) : it;
        if (bal) {
            const int xq = gw >> 8, u = gw & 255;
            if (rr < 3) { const int f = rr * 256 + u, q = f / 192; n = (q * 8 + xq) * 256 + 64 + (f - q * 192); }
            else { const int c = u >> 3, w = u & 7, k = (c & 7) * 4 + (w & 3); n = ((c >> 3) * 8 + xq) * 256 + ((w & 4) ? 63 - k : k); } }
        const int bg = n >> 8, pos = n & 255, b = bg >> 2, g = bg & 3, t0 = pos * 8;
        int lane = F.lane; asm volatile("" : "+v"(lane));
        const int r31 = lane & 31, hh = lane >> 5, tok8 = r31 >> 2, r = r31 & 3;
        const LAS float* lutr = LUT + r * 128;
        if (g != lut_g) {
            LDS_WAIT(); asm volatile("" ::: "memory");
#pragma unroll
            for (int e = 0; e < 2; ++e) { const int rel = lane + 64 * e, bk = t5_bucket(rel);
#pragma unroll
                for (int r4 = 0; r4 < 4; ++r4) LUT[r4 * 128 + rel] = F.in[I_RELB][bk * 16 + 4 * g + r4] * LOG2E; }
            LDS_WAIT(); asm volatile("" ::: "memory");
            lut_g = g;
        }
        const int t = t0 + tok8, head = 4 * g + r; const size_t m = (size_t)b * SEQ + t;
        f16x8 bq[4];
#pragma unroll
        for (int ks = 0; ks < 4; ++ks) bq[ks] = *(const GAS f16x8*)((const f16*)(ws + WS_QN) + m * 1024 + head * 64 + ks * 16 + hh * 8);
        long bq8[4];
#pragma unroll
        for (int ks = 0; ks < 4; ++ks) bq8[ks] = as_i64(pk_fp8((float)bq[ks][0] * 8.f, (float)bq[ks][1] * 8.f, (float)bq[ks][2] * 8.f, (float)bq[ks][3] * 8.f),
                                                        pk_fp8((float)bq[ks][4] * 8.f, (float)bq[ks][5] * 8.f, (float)bq[ks][6] * 8.f, (float)bq[ks][7] * 8.f));
        const float g_c = gates[m * 48 + head * 3 + 0], g_s = gates[m * 48 + head * 3 + 1], g_w = gates[m * 48 + head * 3 + 2];
        const float cfar = lutr[127];
        LAS float* TL = (LAS float*)(F.lds + 65536 + F.wave * 8192) + lane;
        {
            const f16* kc = (const f16*)(ws + WS_KCMP) + (size_t)bg * 128 * 64;
            const f16* vc = (const f16*)(ws + WS_VCMPT) + (size_t)bg * 64 * 128;
            f32x16 c[4];
#pragma unroll
            for (int kt = 0; kt < 4; ++kt) {
#pragma unroll
                for (int i = 0; i < 16; ++i) c[kt][i] = 0.f;
#pragma unroll
                for (int ks = 0; ks < 4; ++ks) { const f16x8 a = *(const GAS f16x8*)(kc + kt * 2048 + ks * 512 + (hh * 32 + r31) * 8); c[kt] = __builtin_amdgcn_mfma_f32_32x32x16_f16(a, bq[ks], c[kt], 0, 0, 0); }
                asm volatile("" ::: "memory");
            }
            const int relb = t - 31 - 64 * hh; float mx = -1e30f;
#pragma unroll
            for (int kt = 0; kt < 4; ++kt) { float bias[16];
#pragma unroll
                for (int i = 0; i < 16; ++i) { const int rel = relb - 16 * (kt * 32 + (i & 3) + 8 * (i >> 2)); bias[i] = lutr[med3i(rel, 0, 127)]; }
#pragma unroll
                for (int i = 0; i < 16; ++i) asm volatile("" : "+v"(bias[i]));
#pragma unroll
                for (int i = 0; i < 16; ++i) { const int rel = relb - 16 * (kt * 32 + (i & 3) + 8 * (i >> 2));
                    const float sv = rel >= 0 ? c[kt][i] + bias[i] : -2e30f; c[kt][i] = sv; mx = fmaxf(mx, sv); }
                asm volatile("" ::: "memory"); }
            mx = other_half_max(mx);
            float l = 0.f;
#pragma unroll
            for (int kt = 0; kt < 4; ++kt)
#pragma unroll
                for (int i = 0; i < 16; ++i) { const float pv = __builtin_amdgcn_exp2f(c[kt][i] - mx); c[kt][i] = pv; l += pv; }
            l = both_halves_sum(l);
            const float inv = 1.f / fmaxf(l, 1e-30f);
#pragma unroll
            for (int kt = 0; kt < 4; ++kt)
#pragma unroll
                for (int jj = 0; jj < 4; ++jj) { float own = (2.f * (c[kt][4 * jj] + c[kt][4 * jj + 1] + c[kt][4 * jj + 2]) + c[kt][4 * jj + 3]) * inv, p3 = c[kt][4 * jj + 3] * inv;
                    own += dpp_f<0xB1>(own); own += dpp_f<0x4E>(own); p3 += dpp_f<0xB1>(p3); p3 += dpp_f<0x4E>(p3);
                    if (r == 0) { const int j = kt * 8 + 2 * jj + hh; wl[512 + tok8 * 32 + j] = own; wl[768 + tok8 * 32 + j] = p3; } }
            f32x16 O0, O1;
#pragma unroll
            for (int i = 0; i < 16; ++i) { O0[i] = 0.f; O1[i] = 0.f; }
#pragma unroll
            for (int kt = 0; kt < 4; ++kt)
#pragma unroll
                for (int s2 = 0; s2 < 2; ++s2) { const f16x8 pb = pack8(c[kt], s2);
                    const f16x8 a0 = *(const GAS f16x8*)(vc + kt * 2048 + s2 * 512 + (hh * 32 + r31) * 8), a1 = *(const GAS f16x8*)(vc + kt * 2048 + (2 + s2) * 512 + (hh * 32 + r31) * 8);
                    O0 = __builtin_amdgcn_mfma_f32_32x32x16_f16(a0, pb, O0, 0, 0, 0); O1 = __builtin_amdgcn_mfma_f32_32x32x16_f16(a1, pb, O1, 0, 0, 0); asm volatile("" ::: "memory"); }
            const float sc = inv * g_c;
#pragma unroll
            for (int i = 0; i < 16; ++i) { TL[i * 64] = O0[i] * sc; TL[(16 + i) * 64] = O1[i] * sc; }
        }
        LDS_WAIT(); asm volatile("" ::: "memory");
        int lane2 = lane; asm volatile("" : "+v"(lane2));
        LAS float* OWN = wl + 512 + (lane2 >> 5) * 32 + (lane2 & 31); LAS float* P3 = OWN + 256; LAS float* VAL = OWN + 512;
#pragma unroll
        for (int pp = 0; pp < 4; ++pp) { const int tk = 2 * pp + hh, j = r31, cur = (t0 + tk) >> 6;
            const float impv = OWN[pp * 64] + (j > 0 ? P3[pp * 64 - (j > 0 ? 1 : 0)] : 0.f);
            VAL[pp * 64] = (j == 0 || j == cur || j == cur - 1) ? 1e4f : (j <= cur ? impv : -1e30f); }
        LDS_WAIT(); asm volatile("" ::: "memory");
#pragma unroll
        for (int pp = 0; pp < 4; ++pp) { const int tk = 2 * pp + hh, j = r31, cur = (t0 + tk) >> 6; const float v = VAL[pp * 64]; int cnt = 0; const LAS float* vrow = VAL + pp * 64 - j;
#pragma unroll
            for (int j2 = 0; j2 < 32; ++j2) { const float o = vrow[j2]; cnt += (o > v || (o == v && j2 < j)) ? 1 : 0; }
            const unsigned long long bm = __ballot(cnt < 8 && j <= cur);
            const unsigned mym = hh ? (unsigned)(bm >> 32) : (unsigned)bm;
            if (j == 0) SELM[tk] = mym; }
        LDS_WAIT(); asm volatile("" ::: "memory");
        const unsigned selm = SELM[tok8];
        unsigned um = 0u;
#pragma unroll
        for (int i = 0; i < 8; ++i) um |= SELM[i];
        um = (unsigned)__builtin_amdgcn_readfirstlane((int)um);
        const int kthi = (t0 + 7) >> 5;
        const unsigned long long causal = (kthi >= 63) ? ~0ull : ((1ull << (kthi + 1)) - 1ull);
        {
            unsigned long long x = um;
            x = (x | (x << 16)) & 0x0000FFFF0000FFFFull; x = (x | (x << 8)) & 0x00FF00FF00FF00FFull; x = (x | (x << 4)) & 0x0F0F0F0F0F0F0F0Full;
            x = (x | (x << 2)) & 0x3333333333333333ull; x = (x | (x << 1)) & 0x5555555555555555ull;
            const unsigned long long tm = (x | (x << 1)) & causal;
            attn_branch(ws + WS_KN + (size_t)bg * SEQ * 64, ws + WS_VT + (size_t)bg * 64 * SEQ, tm, bq8, t0, t, r31, hh, 1 << 30, selm, cfar, lutr, g_s, TL);
        }
        {
            const int lo = t0 - 511 > 0 ? (t0 - 511) >> 5 : 0;
            const unsigned long long tm = causal & ~((1ull << lo) - 1ull);
            attn_branch(ws + WS_KN + (size_t)(BATCH * 4 + bg) * SEQ * 64, ws + WS_VT + (size_t)(BATCH * 4 + bg) * 64 * SEQ, tm, bq8, t0, t, r31, hh, 512, 0xFFFFFFFFu, cfar, lutr, g_w, TL);
        }
        unsigned char* orow = ws + WS_CAT + m * D + 1024 + head * 64 + 4 * hh;
#pragma unroll
        for (int jj = 0; jj < 4; ++jj) {
            *(GAS unsigned*)(orow + 8 * jj) = pk_fp8(TL[(4 * jj) * 64] * CAT8SCALE, TL[(4 * jj + 1) * 64] * CAT8SCALE, TL[(4 * jj + 2) * 64] * CAT8SCALE, TL[(4 * jj + 3) * 64] * CAT8SCALE);
            *(GAS unsigned*)(orow + 32 + 8 * jj) = pk_fp8(TL[(16 + 4 * jj) * 64] * CAT8SCALE, TL[(16 + 4 * jj + 1) * 64] * CAT8SCALE, TL[(16 + 4 * jj + 2) * 64] * CAT8SCALE, TL[(16 + 4 * jj + 3) * 64] * CAT8SCALE); }
    }
}

__device__ __forceinline__ void cvt_row_fp6(const f32x4 (&v)[8], int row, unsigned char* dst6, float* scales, int lane, bool pairt) {
    float amax = 0.f;
#pragma unroll
    for (int c = 0; c < 8; ++c) amax = fmaxf(amax, fmaxf(fmaxf(fabsf(v[c].x), fabsf(v[c].y)), fmaxf(fabsf(v[c].z), fabsf(v[c].w))));
    amax = wave_max(amax);
    const float scale = amax > 0.f ? amax * (1.f / 7.5f) : 1.f, inv = 1.f / scale;
    f16x32 h;
#pragma unroll
    for (int c = 0; c < 8; ++c) { h[4 * c] = (f16)(v[c].x * inv); h[4 * c + 1] = (f16)(v[c].y * inv); h[4 * c + 2] = (f16)(v[c].z * inv); h[4 * c + 3] = (f16)(v[c].w * inv); }
    const u32x6 pk = __builtin_amdgcn_cvt_scalef32_pk32_fp6_f16(h, 1.0f);
    unsigned char* d = dst6 + (size_t)(lane >> 3) * SLICE6;
    *(GAS u32x4*)(d + (size_t)row * 128 + (lane & 7) * 16) = (u32x4){pk[0], pk[1], pk[2], pk[3]}; *(GAS u32x2*)(d + 2097152 + (size_t)row * 64 + (pairt ? (lane & 3) * 16 + ((lane >> 2) & 1) * 8 : (lane & 7) * 8)) = (u32x2){pk[4], pk[5]};
    if (lane == 0) scales[row] = scale;
}
__device__ __forceinline__ void cvt_table_fp6(Frame& F, const float* src, unsigned char* dst6, float* scales, const float* colw, bool pairt) {
    const int gw = F.vcu * NWAVES + F.wave, NGW = F.G * NWAVES, lane = F.lane;
    int row = gw;
    for (; row + NGW < 16384; row += 2 * NGW) {
        f32x4 va[8], vb[8];
#pragma unroll
        for (int c = 0; c < 8; ++c) { va[c] = __builtin_nontemporal_load((const GAS f32x4*)(src + (size_t)row * D + c * 256 + lane * 4)); vb[c] = __builtin_nontemporal_load((const GAS f32x4*)(src + (size_t)(row + NGW) * D + c * 256 + lane * 4)); }
        if (colw) {
#pragma unroll
            for (int c = 0; c < 8; ++c) { const f32x4 wv = *(const GAS f32x4*)(colw + c * 256 + lane * 4); va[c] = va[c] * wv; vb[c] = vb[c] * wv; } }
        cvt_row_fp6(va, row, dst6, scales, lane, pairt); cvt_row_fp6(vb, row + NGW, dst6, scales, lane, pairt);
    }
    for (; row < 16384; row += NGW) { f32x4 va[8];
#pragma unroll
        for (int c = 0; c < 8; ++c) { va[c] = *(const GAS f32x4*)(src + (size_t)row * D + c * 256 + lane * 4); if (colw) va[c] = va[c] * *(const GAS f32x4*)(colw + c * 256 + lane * 4); }
        cvt_row_fp6(va, row, dst6, scales, lane, pairt); }
}
__device__ __forceinline__ void p7_tables(Frame& F) {
    cvt_table_fp6(F, F.in[I_PU], F.ws + WS_U6, (float*)(F.ws + WS_SU), F.in[I_FFNNW], true);
    cvt_table_fp6(F, F.in[I_PV], F.ws + WS_V6, (float*)(F.ws + WS_SV), nullptr, false);
}

__device__ __forceinline__ void bitonic_sort16_desc(float (&a)[16]) {
#pragma unroll
    for (int k = 2; k <= 16; k <<= 1)
#pragma unroll
        for (int j = k >> 1; j > 0; j >>= 1)
#pragma unroll
            for (int i = 0; i < 16; ++i) { const int l = i ^ j; if (l > i) { const float hi = fmaxf(a[i], a[l]), lo = fminf(a[i], a[l]); if ((i & k) == 0) { a[i] = hi; a[l] = lo; } else { a[i] = lo; a[l] = hi; } } }
}
__device__ __forceinline__ void bitonic_merge16_desc(float (&a)[16]) {
#pragma unroll
    for (int dist = 8; dist >= 1; dist >>= 1)
#pragma unroll
        for (int i = 0; i < 16; ++i) if ((i & dist) == 0) { const float hi = fmaxf(a[i], a[i + dist]), lo = fminf(a[i], a[i + dist]); a[i] = hi; a[i + dist] = lo; }
}
#define INS16(top, v) do { _Pragma("unroll") for (int _j = 0; _j < 16; ++_j) { const float _h = fmaxf(top[_j], v); v = fminf(top[_j], v); top[_j] = _h; } } while (0)
#define INS16P(tv, ti, v, i) do { _Pragma("unroll") for (int _j = 0; _j < 16; ++_j) { const bool _c = v > tv[_j]; const float _nv = _c ? tv[_j] : v; const unsigned _ni = _c ? ti[_j] : i; \
        tv[_j] = _c ? v : tv[_j]; ti[_j] = _c ? i : ti[_j]; v = _nv; i = _ni; } } while (0)
typedef unsigned v4u_t __attribute__((__vector_size__(16)));
typedef unsigned v2u_t __attribute__((__vector_size__(8)));
__device__ __forceinline__ void p9a_topk(Frame& F) {
    unsigned char* ws = F.ws;
    const f16* QP = (const f16*)(ws + WS_QP); const f16* KEYS = (const f16*)(ws + WS_KEYS);
    unsigned* LIDX = (unsigned*)(ws + WS_LIDX); float* LG = (float*)(ws + WS_LG);
    const int lane = F.lane, r31 = lane & 31, hh = lane >> 5;
    const float NINF = -__builtin_inff();
    for (int unit = F.vcu; unit < M / 32; unit += F.G) {
        const int m0 = unit * 32;
        {
            const int h = F.wave;
            float sl[2][16];
            f16x8 bq[8], ka[8];
#pragma unroll
            for (int ks = 0; ks < 8; ++ks) { bq[ks] = *(const GAS f16x8*)(QP + (size_t)(m0 + r31) * D + (h * 2) * 128 + ks * 16 + hh * 8);
                ka[ks] = *(const GAS f16x8*)(KEYS + ((size_t)((h * 2) * 128 + r31)) * 128 + hh * 8 + ks * 16); }
            float top[16];
#pragma unroll
            for (int st = 0; st < 8; ++st) { const int p = st >> 2, kt = st & 3;
                if (kt == 0) {
#pragma unroll
                    for (int j = 0; j < 16; ++j) top[j] = NINF; }
                f32x16 c;
#pragma unroll
                for (int i = 0; i < 16; ++i) c[i] = 0.f;
#pragma unroll
                for (int ks = 0; ks < 8; ++ks) c = __builtin_amdgcn_mfma_f32_32x32x16_f16(ka[ks], bq[ks], c, 0, 0, 0);
                if (st + 1 < 8) { const int pn = (st + 1) >> 2, ktn = (st + 1) & 3;
#pragma unroll
                    for (int ks = 0; ks < 8; ++ks) ka[ks] = *(const GAS f16x8*)(KEYS + ((size_t)((h * 2 + pn) * 128 + ktn * 32 + r31)) * 128 + hh * 8 + ks * 16);
                    if (st == 3) {
#pragma unroll
                        for (int ks = 0; ks < 8; ++ks) bq[ks] = *(const GAS f16x8*)(QP + (size_t)(m0 + r31) * D + (h * 2 + 1) * 128 + ks * 16 + hh * 8); } }
                const unsigned k4 = (unsigned)(kt * 32 + 4 * hh);
                float nv[16];
#pragma unroll
                for (int reg = 0; reg < 16; ++reg) { const unsigned key = k4 + (unsigned)((reg & 3) + 8 * (reg >> 2)); nv[reg] = __uint_as_float((__float_as_uint(c[reg]) & ~127u) | key); }
                bitonic_sort16_desc(nv);
#pragma unroll
                for (int j = 0; j < 16; ++j) top[j] = fmaxf(top[j], nv[15 - j]);
                bitonic_merge16_desc(top);
                if (kt == 3) {
                    float cm[16];
#pragma unroll
                    for (int j = 0; j < 16; ++j) cm[j] = fmaxf(top[j], __uint_as_float(other32u(__float_as_uint(top[15 - j]), hh != 0)));
                    bitonic_merge16_desc(cm);
#pragma unroll
                    for (int j = 0; j < 16; ++j) sl[p][j] = cm[j]; }
            }
            float vx[16], vy[16]; unsigned ix[16], iy[16];
#pragma unroll
            for (int j = 0; j < 16; ++j) { const unsigned bx = __float_as_uint(hh ? sl[1][j] : sl[0][j]), by = __float_as_uint(hh ? sl[0][j] : sl[1][j]);
                vx[j] = __uint_as_float(bx & ~127u); vy[j] = __uint_as_float(by & ~127u); ix[j] = (bx & 127u) * (hh ? 1u : 128u); iy[j] = (by & 127u) * (hh ? 128u : 1u); }
            float tv[16]; unsigned ti[16];
#pragma unroll
            for (int j = 0; j < 16; ++j) { const int jb = j + 1 < 16 ? j + 1 : 15;
                const float v0 = vx[0] + vy[j], v1 = (j < 15) ? vx[0] + vy[jb] : NINF; const unsigned i0 = ix[0] + iy[j], i1 = ix[0] + iy[jb];
                tv[j] = hh ? v1 : v0; ti[j] = hh ? i1 : i0; }
#pragma unroll
            for (int a = 1; a < 4; ++a) { const int bmax = (a == 1) ? 7 : (a == 2 ? 4 : 3);
#pragma unroll
                for (int b = a; b <= bmax; ++b) { float v = vx[a] + vy[b]; if (a == b) v = hh ? NINF : v; unsigned i = ix[a] + iy[b]; INS16P(tv, ti, v, i); } }
            float mv[16]; unsigned mi[16];
#pragma unroll
            for (int j = 0; j < 16; ++j) { const float pv = __uint_as_float(other32u(__float_as_uint(tv[15 - j]), hh != 0)); const unsigned pi = other32u(ti[15 - j], hh != 0); const bool c = pv > tv[j]; mv[j] = c ? pv : tv[j]; mi[j] = c ? pi : ti[j]; }
            float mx = mv[0];
#pragma unroll
            for (int j = 1; j < 16; ++j) mx = fmaxf(mx, mv[j]);
            float sum = 0.f;
#pragma unroll
            for (int j = 0; j < 16; ++j) { mv[j] = __builtin_amdgcn_exp2f((mv[j] - mx) * LOG2E); sum += mv[j]; }
            const float inv = 1.f / sum;
#pragma unroll
            for (int j = 0; j < 8; ++j) { { const int e_ = h * 16 + hh * 8 + j, pos_ = (e_ & 63) * 2 + (e_ >> 6); LIDX[(size_t)(m0 + r31) * 128 + pos_] = mi[j]; LG[(size_t)(m0 + r31) * 128 + pos_] = mv[j] * inv; } }
        }
    }
}
struct Seg6 { v4u_t a; v2u_t b; };
__device__ __forceinline__ f16x32 seg6_decode(const Seg6& r) { const u32x6 p = {r.a[0], r.a[1], r.a[2], r.a[3], r.b[0], r.b[1]}; return __builtin_amdgcn_cvt_scalef32_pk32_f16_fp6(p, 1.0f); }
__device__ __forceinline__ f16x32 seg6_dec2(const v4u_t& a, const v2u_t& b) { const u32x6 p = {a[0], a[1], a[2], a[3], b[0], b[1]}; return __builtin_amdgcn_cvt_scalef32_pk32_f16_fp6(p, 1.0f); }
#define SEG_DECL(P) v4u_t P##a0, P##a1, P##a2, P##a3, P##a4, P##a5, P##a6, P##a7; v2u_t P##b0, P##b1, P##b2, P##b3, P##b4, P##b5, P##b6, P##b7
#define SEG_L1(P, G, idxv) do { const int e_ = __shfl(idxv, 8 * G + sub); P##a##G = __builtin_amdgcn_raw_buffer_load_b128(rs, e_ * 128 + ch * 16, 0, 0); P##b##G = __builtin_amdgcn_raw_buffer_load_b64(rs, 2097152 + e_ * 64 + ch * 8, 0, 0); } while (0)
#define SEG_LOAD(P, idxv) do { SEG_L1(P, 0, idxv); SEG_L1(P, 1, idxv); SEG_L1(P, 2, idxv); SEG_L1(P, 3, idxv); SEG_L1(P, 4, idxv); SEG_L1(P, 5, idxv); SEG_L1(P, 6, idxv); SEG_L1(P, 7, idxv); } while (0)
__device__ __forceinline__ float u_one(const v4u_t& a, const v2u_t& b, const f16x2 (&xp)[16]) {
    const f16x32 hv = seg6_dec2(a, b); float sdot = 0.f;
#pragma unroll
    for (int k = 0; k < 16; ++k) { f16x2 hp; hp.x = hv[2 * k]; hp.y = hv[2 * k + 1]; sdot = __builtin_amdgcn_fdot2(hp, xp[k], sdot, false); }
    return sum8(sdot);
}
#define SEG_LE(P, G, ev) do { const int e_ = (ev); P##a##G = __builtin_amdgcn_raw_buffer_load_b128(rs, e_ * 128 + ch * 16, 0, 0); P##b##G = __builtin_amdgcn_raw_buffer_load_b64(rs, 2097152 + e_ * 64 + ch * 8, 0, 0); } while (0)
#define EN_GATHER(en, iA, iB) do { _Pragma("unroll") for (int g_ = 0; g_ < 8; ++g_) { en[g_] = __shfl(iA, 8 * g_ + sub); en[8 + g_] = __shfl(iB, 8 * g_ + sub); } } while (0)
#define U_ROLL1(P, G, res, eo) do { const float d_ = u_one(P##a##G, P##b##G, xp); res = (ch == G) ? d_ : res; SEG_LE(P, G, en[(eo) + G]); } while (0)
#define U_ROLL(P, res, idxn) do { U_ROLL1(P, 0, res, idxn); U_ROLL1(P, 1, res, idxn); U_ROLL1(P, 2, res, idxn); U_ROLL1(P, 3, res, idxn); U_ROLL1(P, 4, res, idxn); U_ROLL1(P, 5, res, idxn); U_ROLL1(P, 6, res, idxn); U_ROLL1(P, 7, res, idxn); } while (0)
#define V_ROLL1(P, G, hwv, eo) do { v_one(P##a##G, P##b##G, acc, hq[(eo) + G]); SEG_LE(P, G, en[(eo) + G]); } while (0)
#define V_ROLL(P, hwv, idxn) do { V_ROLL1(P, 0, hwv, idxn); V_ROLL1(P, 1, hwv, idxn); V_ROLL1(P, 2, hwv, idxn); V_ROLL1(P, 3, hwv, idxn); V_ROLL1(P, 4, hwv, idxn); V_ROLL1(P, 5, hwv, idxn); V_ROLL1(P, 6, hwv, idxn); V_ROLL1(P, 7, hwv, idxn); } while (0)
#define FMIXV_LO(a, h, w) asm("v_fma_mix_f32 %0, %1, %2, %0 op_sel_hi:[1,0,0]" : "+v"(a) : "v"(h), "v"(w))
#define FMIXV_HI(a, h, w) asm("v_fma_mix_f32 %0, %1, %2, %0 op_sel:[1,0,0] op_sel_hi:[1,0,0]" : "+v"(a) : "v"(h), "v"(w))
__device__ __forceinline__ void v_one(const v4u_t& a, const v2u_t& b, f16x2 (&acc)[16], f16x2 wq) {
    const f16x32 hv = seg6_dec2(a, b);
#pragma unroll
    for (int k = 0; k < 16; ++k) { f16x2 hp; hp.x = hv[2 * k]; hp.y = hv[2 * k + 1]; acc[k] = __builtin_elementwise_fma(hp, wq, acc[k]); }
}
#define V_HALF(P, hwv) do { v_one(P##a0, P##b0, acc, hwv, sub); v_one(P##a1, P##b1, acc, hwv, 8 + sub); v_one(P##a2, P##b2, acc, hwv, 16 + sub); v_one(P##a3, P##b3, acc, hwv, 24 + sub); \
        v_one(P##a4, P##b4, acc, hwv, 32 + sub); v_one(P##a5, P##b5, acc, hwv, 40 + sub); v_one(P##a6, P##b6, acc, hwv, 48 + sub); v_one(P##a7, P##b7, acc, hwv, 56 + sub); } while (0)
#define WSEG_DECL(P) v4u_t P##h0, P##h1, P##h2, P##h3, P##g0, P##g1, P##g2, P##g3, P##t0, P##t1, P##t2, P##t3
#define WSEG_LE(P, G, ev) do { const int e_ = (ev); P##h##G = __builtin_amdgcn_raw_buffer_load_b128(rs, e_ * 128 + q4 * 16, 0, 0); P##g##G = __builtin_amdgcn_raw_buffer_load_b128(rs, e_ * 128 + 64 + q4 * 16, 0, 0); \
        P##t##G = __builtin_amdgcn_raw_buffer_load_b128(rs, 2097152 + e_ * 64 + q4 * 16, 0, 0); } while (0)
#define WSEG_LOAD(P, idxv) do { WSEG_LE(P, 0, __shfl(idxv, sub16)); WSEG_LE(P, 1, __shfl(idxv, 16 + sub16)); WSEG_LE(P, 2, __shfl(idxv, 32 + sub16)); WSEG_LE(P, 3, __shfl(idxv, 48 + sub16)); } while (0)
#define WEN_GATHER(en, iA, iB) do { _Pragma("unroll") for (int g_ = 0; g_ < 4; ++g_) { en[g_] = __shfl(iA, 16 * g_ + sub16); en[4 + g_] = __shfl(iB, 16 * g_ + sub16); } } while (0)
__device__ __forceinline__ float u_one2(const v4u_t& h, const v4u_t& g, const v4u_t& t, const f16x2 (&xp)[32]) {
    const f16x32 h0 = seg6_dec2(h, (v2u_t){t[0], t[1]}), h1 = seg6_dec2(g, (v2u_t){t[2], t[3]}); float sdot = 0.f;
#pragma unroll
    for (int k = 0; k < 16; ++k) { f16x2 hp; hp.x = h0[2 * k]; hp.y = h0[2 * k + 1]; sdot = __builtin_amdgcn_fdot2(hp, xp[k], sdot, false); }
#pragma unroll
    for (int k = 0; k < 16; ++k) { f16x2 hp; hp.x = h1[2 * k]; hp.y = h1[2 * k + 1]; sdot = __builtin_amdgcn_fdot2(hp, xp[16 + k], sdot, false); }
    sdot += dpp_f<0xB1>(sdot); sdot += dpp_f<0x4E>(sdot);
    return sdot;
}
#define WU_ROLL1(P, G, res, eo) do { const float d_ = u_one2(P##h##G, P##g##G, P##t##G, xp); res = (q4 == G) ? d_ : res; WSEG_LE(P, G, en[(eo) + G]); __builtin_amdgcn_sched_barrier(0); } while (0)
#define WU_ROLL(P, res, idxn) do { WU_ROLL1(P, 0, res, idxn); WU_ROLL1(P, 1, res, idxn); WU_ROLL1(P, 2, res, idxn); WU_ROLL1(P, 3, res, idxn); } while (0)
__device__ __forceinline__ void p9b_upass(Frame& F, bool probe_slice0) {
    unsigned char* ws = F.ws;
    const int x = blockIdx.x & 7, rank = blockIdx.x >> 3, cnt = (F.G - x + 7) >> 3;
    const int lane = F.lane, sub16 = lane >> 2, q4 = lane & 3;
    const __amdgpu_buffer_rsrc_t rs = __builtin_amdgcn_make_buffer_rsrc((void*)(ws + WS_U6 + (size_t)(probe_slice0 ? 0 : x) * SLICE6), 0, (int)SLICE6, 0x00020000);
    const f16* XN = (const f16*)(ws + WS_XR) + x * 32 + (lane >> 3) * 256 + (lane & 7) * 4;
    const u32x2* LI2 = (const u32x2*)(ws + WS_LIDX); LAS unsigned char* xl = F.lds + F.wave * 512;
    const int tstep = cnt * NWAVES; int t = rank * NWAVES + F.wave;
    if (t >= M) return;
    int cA, cB, nA, nB; { const u32x2 c2 = LI2[(size_t)t * 64 + lane]; cA = (int)c2.x; cB = (int)c2.y; }
    const int t1c = (t + tstep < M) ? t + tstep : t;
    { const u32x2 n2 = LI2[(size_t)t1c * 64 + lane]; nA = (int)n2.x; nB = (int)n2.y; }
    u32x2 xcur = *(const GAS u32x2*)(XN + (size_t)t * D);
    f16x2 xp[32];
    WSEG_DECL(bA); WSEG_DECL(bB);
    { const int li_ = cA; WSEG_LOAD(bA, li_); } { const int li_ = cB; WSEG_LOAD(bB, li_); }
#pragma unroll 1
    for (;;) {
        const int tn = t + tstep, tnn = tn + tstep; const bool hn = tn < M, hnn = tnn < M;
        const int tnc = hn ? tn : t, tnnc = hnn ? tnn : t;
        const u32x2 m2 = LI2[(size_t)tnnc * 64 + lane]; const int mA = (int)m2.x, mB = (int)m2.y;
        const u32x2 xnext = *(const GAS u32x2*)(XN + (size_t)tnc * D);
        *(LAS u32x2*)(xl + ((lane & 7) * 8 + (lane >> 3)) * 8) = xcur;
        LDS_WAIT(); asm volatile("" ::: "memory");
#pragma unroll
        for (int hc = 0; hc < 2; ++hc)
#pragma unroll
            for (int q = 0; q < 4; ++q) { const u32x4 tv = *(const LAS u32x4*)(xl + (q4 + 4 * hc) * 64 + q * 16); xp[16 * hc + 4 * q] = ash2(tv.x); xp[16 * hc + 4 * q + 1] = ash2(tv.y); xp[16 * hc + 4 * q + 2] = ash2(tv.z); xp[16 * hc + 4 * q + 3] = ash2(tv.w); }
        LDS_WAIT(); asm volatile("" ::: "memory");
        { const int lA_ = hn ? nA : cA, lB_ = hn ? nB : cB; int en[8]; WEN_GATHER(en, lA_, lB_);
          float rA = 0.f, rB = 0.f; WU_ROLL(bA, rA, 0); WU_ROLL(bB, rB, 4);
          float* pd = (float*)(ws + WS_PD) + ((size_t)t * 8 + x) * 128 + 16 * q4 + sub16; pd[0] = rA; pd[64] = rB; }
        if (!hn) break;
        xcur = xnext;
        cA = nA; cB = nB; nA = mA; nB = mB; t = tn;
    }
}
__device__ __forceinline__ void p9h_weights(Frame& F) {
    unsigned char* ws = F.ws;
    const unsigned* LIDX = (const unsigned*)(ws + WS_LIDX); const float* LG = (const float*)(ws + WS_LG); const float* PD = (const float*)(ws + WS_PD);
    const float* SU = (const float*)(ws + WS_SU); const float* SV = (const float*)(ws + WS_SV); float* HW = (float*)(ws + WS_HW);
    const int gw = F.vcu * NWAVES + F.wave, NGW = F.G * NWAVES, lane = F.lane;
#pragma unroll 1
    for (int t0 = gw; t0 < M; t0 += 2 * NGW) {
        const int t1 = t0 + NGW < M ? t0 + NGW : t0;
        int iA[2], iB[2]; float pa[2][8], pb[2][8], lgA[2], lgB[2], s1[2];
#pragma unroll
        for (int q = 0; q < 2; ++q) { const int t = q ? t1 : t0; { const u32x2 i2 = ((const u32x2*)LIDX)[(size_t)t * 64 + lane]; iA[q] = (int)i2.x; iB[q] = (int)i2.y; }
#pragma unroll
            for (int xs = 0; xs < 8; ++xs) { pa[q][xs] = PD[((size_t)t * 8 + xs) * 128 + lane]; pb[q][xs] = PD[((size_t)t * 8 + xs) * 128 + 64 + lane]; }
            { const f32x2 g2 = ((const f32x2*)LG)[(size_t)t * 64 + lane]; lgA[q] = g2.x; lgB[q] = g2.y; } s1[q] = ((const float*)(ws + WS_SS1))[t]; }
#pragma unroll
        for (int q = 0; q < 2; ++q) { const int t = q ? t1 : t0; float zA = 0.f, zB = 0.f;
#pragma unroll
            for (int xs = 0; xs < 8; ++xs) { zA += pa[q][xs]; zB += pb[q][xs]; }
            const float rs1 = 1.f / sqrtf(s1[q] * (1.f / D) + RMS_EPS);
            ((f32x2*)HW)[(size_t)t * 64 + lane] = (f32x2){pg8::gelu1(zA * rs1 * SU[iA[q]]) * lgA[q] * SV[iA[q]], pg8::gelu1(zB * rs1 * SU[iB[q]]) * lgB[q] * SV[iB[q]]}; }
    }
}
__device__ __forceinline__ void p9c_vpass(Frame& F) {
    unsigned char* ws = F.ws;
    const int x = blockIdx.x & 7, rank = blockIdx.x >> 3, cnt = (F.G - x + 7) >> 3;
    const int lane = F.lane, sub = lane >> 3, ch = lane & 7;
    const __amdgpu_buffer_rsrc_t rs = __builtin_amdgcn_make_buffer_rsrc((void*)(ws + WS_V6 + (size_t)x * SLICE6), 0, (int)SLICE6, 0x00020000);
    const u32x2* LI2 = (const u32x2*)(ws + WS_LIDX);
    f16* XR = (f16*)(ws + WS_XR); float* SS2 = (float*)(ws + WS_SS2);
    const bool b3 = (lane & 8) != 0, b4 = (lane & 16) != 0, b5 = (lane & 32) != 0;
    const int col = ((b3 ? 4 : 0) + (b4 ? 2 : 0) + (b5 ? 1 : 0)) * 256 + x * 32 + ch * 4;
    const int tstep = cnt * NWAVES; int t = rank * NWAVES + F.wave;
    if (t >= M) return;
    int cA, cB, nA, nB; { const u32x2 c2 = LI2[(size_t)t * 64 + lane]; cA = (int)c2.x; cB = (int)c2.y; }
    const int t1c = (t + tstep < M) ? t + tstep : t;
    { const u32x2 n2 = LI2[(size_t)t1c * 64 + lane]; nA = (int)n2.x; nB = (int)n2.y; }
    const f32x2* HW2 = (const f32x2*)(ws + WS_HW);
    float hwA, hwB; { const f32x2 h2 = HW2[(size_t)t * 64 + lane]; hwA = h2.x; hwB = h2.y; }
    SEG_DECL(bA); SEG_DECL(bB);
    { const int li_ = cA; SEG_LOAD(bA, li_); } { const int li_ = cB; SEG_LOAD(bB, li_); }
#pragma unroll 1
    for (;;) {
        const int tn = t + tstep, tnn = tn + tstep; const bool hn = tn < M, hnn = tnn < M;
        const int tnc = hn ? tn : t, tnnc = hnn ? tnn : t;
        const u32x2 m2 = LI2[(size_t)tnnc * 64 + lane]; const int mA = (int)m2.x, mB = (int)m2.y;
        const f32x2 hn2 = HW2[(size_t)tnc * 64 + lane]; const float hwAn = hn2.x, hwBn = hn2.y;
        f16* orow = XR + (size_t)t * D + col; const u32x2 x1r = *(const GAS u32x2*)orow;
        f16x2 acc[16];
#pragma unroll
        for (int i = 0; i < 16; ++i) { acc[i].x = (f16)0.f; acc[i].y = (f16)0.f; }
        { const int lA_ = hn ? nA : cA, lB_ = hn ? nB : cB; int en[16]; EN_GATHER(en, lA_, lB_); f16x2 hq[16];
#pragma unroll
          for (int g_ = 0; g_ < 8; ++g_) { const float qa = __shfl(hwA, 8 * g_ + sub) * 64.f, qb = __shfl(hwB, 8 * g_ + sub) * 64.f;
              hq[g_].x = (f16)qa; hq[g_].y = (f16)qa; hq[8 + g_].x = (f16)qb; hq[8 + g_].y = (f16)qb; }
          V_ROLL(bA, hwA, 0); V_ROLL(bB, hwB, 8); }
        f16x2 q8[8];
#pragma unroll
        for (int i = 0; i < 8; ++i) { const f16x2 keep = b3 ? acc[8 + i] : acc[i], send = b3 ? acc[i] : acc[8 + i]; q8[i] = keep + ash2(other8u(__builtin_bit_cast(unsigned, send))); }
        f16x2 q4[4];
#pragma unroll
        for (int i = 0; i < 4; ++i) { const f16x2 keep = b4 ? q8[4 + i] : q8[i], send = b4 ? q8[i] : q8[4 + i]; q4[i] = keep + ash2(other16u(__builtin_bit_cast(unsigned, send), b4)); }
        float r4[4];
        { const f16x2 k0 = b5 ? q4[2] : q4[0], k1 = b5 ? q4[3] : q4[1], s0 = b5 ? q4[0] : q4[2], s1 = b5 ? q4[1] : q4[3];
          const f16x2 p0 = ash2(other32u(__builtin_bit_cast(unsigned, s0), b5)), p1 = ash2(other32u(__builtin_bit_cast(unsigned, s1), b5));
          r4[0] = ((float)k0.x + (float)p0.x) * (1.f / 64.f); r4[1] = ((float)k0.y + (float)p0.y) * (1.f / 64.f); r4[2] = ((float)k1.x + (float)p1.x) * (1.f / 64.f); r4[3] = ((float)k1.y + (float)p1.y) * (1.f / 64.f); }
        const f16x2 x1a = ash2(x1r.x), x1b = ash2(x1r.y);
        const f32x4 x2 = {(float)x1a.x + r4[0], (float)x1a.y + r4[1], (float)x1b.x + r4[2], (float)x1b.y + r4[3]};
        { u32x2 o2; o2.x = pk_f16(x2.x, x2.y); o2.y = pk_f16(x2.z, x2.w); *(GAS u32x2*)orow = o2; }
        *(GAS unsigned*)(ws + WS_X8 + (size_t)t * D + col) = pk_fp8(x2.x, x2.y, x2.z, x2.w);
        const float ss = wave_sum((x2.x * x2.x + x2.y * x2.y) + (x2.z * x2.z + x2.w * x2.w));
        if (lane == 0) atomicAdd(SS2 + t, ss);
        if (!hn) break;
        cA = nA; cB = nB; nA = mA; nB = mB; t = tn; hwA = hwAn; hwB = hwBn;
    }
}
#undef FMIXV_LO
#undef FMIXV_HI

constexpr int NPH = 13;
struct Args { const float* in[26]; float* out; unsigned char* ws; int ph_lo, ph_hi; int rep[16]; };
__global__ void __launch_bounds__(NWAVES * 64, 2) fwd_kernel(Args args) {
    extern __shared__ __attribute__((aligned(16))) unsigned char lds[];
    Frame F;
    F.lds = (LAS unsigned char*)lds;
    F.MISC = (volatile LAS unsigned*)(F.lds + MISC_OFF);
    F.tid = threadIdx.x; F.lane = F.tid & 63; F.wave = __builtin_amdgcn_readfirstlane(F.tid >> 6);
#define PHASE_LANES() do { int t_ = threadIdx.x; asm volatile("" : "+v"(t_)); F.tid = t_; F.lane = t_ & 63; } while (0)
    F.G = gridDim.x; { const int bx = blockIdx.x; F.vcu = (F.G % 8 == 0) ? (bx % 8) * (F.G / 8) + bx / 8 : bx; }
#pragma unroll
    for (int i = 0; i < 26; ++i) F.in[i] = args.in[i];
    F.out = args.out; F.ws = args.ws;
    unsigned char* ws = args.ws;
    gu32* ctl = (gu32*)(ws + WS_CTL);
    for (int u = F.tid; u < (LDS_BYTES - LDSCTL_OFF) / 4; u += NWAVES * 64) ((LAS unsigned*)(F.lds + LDSCTL_OFF))[u] = 0u;
    __syncthreads();
    XcdBarrier bar; bar.bar = (unsigned*)(ctl + CW_BAR); bar.x = 0; bar.st = nullptr;
    if (MK_ONE_LAUNCH) bar = xcd_barrier_post((unsigned*)(ctl + CW_BAR), F.MISC + 8);
#define GRID_BAR() do { if (MK_ONE_LAUNCH) xcd_barrier(bar); } while (0)
    const int lo = args.ph_lo, hi = args.ph_hi;
#define IN(k) (lo <= (k) && (k) < hi)
#define BOTH(k) (IN(k) && IN((k) + 1))

    if (IN(0)) { PHASE_LANES(); for (int rp = 0; rp < args.rep[0]; ++rp) p0_prologue(F); if (BOTH(0)) GRID_BAR(); }

    if (IN(1)) {
        pg8::Gemm g{(const f16*)(ws + WS_XR), (const f16*)(ws + WS_WIN), M, NINP, D, D, D, 0, 1 << 30, 0};
        pg8::StaticOrder S; S.init(M, NINP, F.G, (int)blockIdx.x);
        pg8::EpiF16Row E{(f16*)(ws + WS_Y), NINP, (const float*)(ws + WS_SS0)};
        pg8::gemm_phase(F.lds, g, S, E);
        if (BOTH(1)) GRID_BAR();
    }

    if (IN(2)) { PHASE_LANES(); for (int rp = 0; rp < PROBE_REP2; ++rp) p2_post(F); if (BOTH(2)) GRID_BAR(); }

    if (IN(3)) {
        { pg8::Gemm g{(const f16*)(ws + WS_FLATA), (const f16*)(ws + WS_W1C), 8192, 1024, 512, D, D, 512, 16, (size_t)256 * D * 2, 512};
          pg8::StaticOrder S; S.init(8192, 1024, F.G, (int)blockIdx.x);
          pg8::EpiRawF32 E{(float*)(ws + WS_Y), 1024};
          pg8::gemm_phase(F.lds, g, S, E); }
        { pg8::Gemm g{(const f16*)(ws + WS_MIXED), (const f16*)(ws + WS_POOLT), M, 1024, 256, 1024, 256, 256, 1 << 30, 0};
          pg8::StaticOrder S; S.init(M, 1024, F.G, (int)((blockIdx.x + 128) % F.G));
          pg8::EpiF8 E{ws + WS_CAT, D, CAT8SCALE};
          pg8::gemm_phase(F.lds, g, S, E); }
        if (BOTH(3)) GRID_BAR();
    }

    if (IN(4)) { PHASE_LANES(); p4_compress2(F); if (BOTH(4)) GRID_BAR(); }

    if (IN(5)) { PHASE_LANES(); for (int rp = 0; rp < args.rep[5]; ++rp) p5_attention(F); if (BOTH(5)) GRID_BAR(); }

    if (IN(6)) {
        pg8::Gemm g{ws + WS_CAT, ws + WS_WOUT, M, D, D, D, D, 0, 1 << 30, 0, 0, 1};
        pg8::StaticOrder S; S.init(M, D, F.G, (int)blockIdx.x);
        pg8::EpiRes16 E{(f16*)(ws + WS_XR), (float*)(ws + WS_SS1), 1.f / (W8SCALE * CAT8SCALE)};
        pg8::gemm_phase<pg8::EpiRes16, pg8::StaticOrder, true>(F.lds, g, S, E);
        if (BOTH(6)) GRID_BAR();
    }

    if (IN(7)) {
        { pg8::Gemm g{(const f16*)(ws + WS_XR), (const f16*)(ws + WS_WQ), M, D, D, D, D, 0, 1 << 30, 0};
          pg8::StaticOrder S; S.init(M, D, F.G, (int)blockIdx.x);
          pg8::EpiF16Row E{(f16*)(ws + WS_QP), D, (const float*)(ws + WS_SS1)};
          pg8::gemm_phase(F.lds, g, S, E); }
        { pg8::Gemm g{(const f16*)(ws + WS_P16), (const f16*)(ws + WS_WPJ), M, D, 256, 256, 256, 0, 1 << 30, 0};
          pg8::StaticOrder S; S.init(M, D, F.G, (int)blockIdx.x);
          pg8::EpiF16<0> E{(f16*)(ws + WS_PJ), D, nullptr, 1 << 30, 0};
          pg8::gemm_phase(F.lds, g, S, E); }
        PHASE_LANES();
        for (int rp = 0; rp < args.rep[7]; ++rp) p7_tables(F);
        if (BOTH(7)) GRID_BAR();
    }

    if (IN(8)) { PHASE_LANES(); p9a_topk(F); if (BOTH(8)) GRID_BAR(); }
    if (IN(9)) { PHASE_LANES(); if (PROBE_DUPU) p9b_upass(F, false); p9b_upass(F, false); if (BOTH(9)) GRID_BAR(); }
    if (IN(10)) { PHASE_LANES(); p9h_weights(F); if (BOTH(10)) GRID_BAR(); }
    if (IN(11)) { PHASE_LANES(); p9c_vpass(F); if (BOTH(11)) GRID_BAR(); }

    if (IN(12)) {
        pg8::Gemm g{ws + WS_X8, ws + WS_WG, M, D, D, D, D, 0, 1 << 30, 0, 0, 1};
        pg8::StaticOrder S; S.init(M, D, F.G, (int)blockIdx.x);
        pg8::EpiFinal E{(const f16*)(ws + WS_XR), (const f16*)(ws + WS_PJ), F.out, (const float*)(ws + WS_SS2), 1.f / W8SCALE};
        pg8::gemm_phase<pg8::EpiFinal, pg8::StaticOrder, true>(F.lds, g, S, E);
    }
#undef IN
#undef BOTH
}

extern "C" void kernel_launch(void* const* d_in, const int* in_sizes, int n_in, void* d_out, int out_size, void* d_ws, size_t ws_size, hipStream_t stream) {
    static int grid = 0;
    if (grid == 0) {
        if (n_in != 26 || out_size != M * D || ws_size < WS_END) { fprintf(stderr, "kernel_launch: unexpected sizes n_in %d out %d ws %zu\n", n_in, out_size, ws_size); grid = -1; return; }
        int dev = 0, cus = 0, per_cu = 0;
        if (hipGetDevice(&dev) != hipSuccess || hipDeviceGetAttribute(&cus, hipDeviceAttributeMultiprocessorCount, dev) != hipSuccess) { grid = -1; return; }
        if (hipFuncSetAttribute((const void*)fwd_kernel, hipFuncAttributeMaxDynamicSharedMemorySize, LDS_BYTES) != hipSuccess) { fprintf(stderr, "kernel_launch: hipFuncSetAttribute failed\n"); grid = -1; return; }
        if (hipOccupancyMaxActiveBlocksPerMultiprocessor(&per_cu, (const void*)fwd_kernel, NWAVES * 64, LDS_BYTES) != hipSuccess || per_cu < 1)
            fprintf(stderr, "kernel_launch: occupancy query reports %d\n", per_cu);
        (void)hipGetLastError();
        grid = cus;
    }
    if (grid < 0) return;
    (void)hipMemsetAsync((char*)d_ws + WS_CTL, 0, CTL_ZERO_BYTES, stream);
    Args a{};
    for (int i = 0; i < 16; ++i) a.rep[i] = 1;
    a.rep[5] = PROBE_REP5; a.rep[0] = PROBE_REP0; a.rep[7] = PROBE_REP7;
    for (int i = 0; i < 26; ++i) a.in[i] = (const float*)d_in[i];
    a.out = (float*)d_out; a.ws = (unsigned char*)d_ws;
    if (MK_ONE_LAUNCH) { a.ph_lo = 0; a.ph_hi = NPH; hipLaunchKernelGGL(fwd_kernel, dim3(grid), dim3(NWAVES * 64), LDS_BYTES, stream, a); }
    else for (int p = 0; p < NPH; ++p) { a.ph_lo = p; a.ph_hi = p + 1; hipLaunchKernelGGL(fwd_kernel, dim3(grid), dim3(NWAVES * 64), LDS_BYTES, stream, a); }
}
```

```cpp
#include <hip/hip_runtime.h>
#include <cstdio>
#include <cstdint>

#define PROBE_REP0 1
#define PROBE_REP2 1
#define PROBE_DUPU 0
#define PROBE_REP5 1
#define PROBE_REP7 1
#define PROBE_REP9 1
#ifndef MK_ONE_LAUNCH
#define MK_ONE_LAUNCH 1
#endif

#define GAS __attribute__((address_space(1)))
#define LAS __attribute__((address_space(3)))
typedef _Float16 f16;
typedef _Float16 f16x8 __attribute__((ext_vector_type(8)));
typedef _Float16 f16x4 __attribute__((ext_vector_type(4)));
typedef _Float16 f16x2 __attribute__((ext_vector_type(2)));
typedef float f32x2 __attribute__((ext_vector_type(2)));
typedef float f32x4 __attribute__((ext_vector_type(4)));
typedef float f32x16 __attribute__((ext_vector_type(16)));
typedef unsigned u32x2 __attribute__((ext_vector_type(2)));
typedef unsigned u32x4 __attribute__((ext_vector_type(4)));
typedef GAS unsigned gu32;
typedef _Float16 f16x32 __attribute__((ext_vector_type(32)));
typedef unsigned u32x6 __attribute__((ext_vector_type(6)));
#define RLX_AGENT __ATOMIC_RELAXED, __HIP_MEMORY_SCOPE_AGENT
#define LDS_WAIT() asm volatile("s_waitcnt lgkmcnt(0)" ::: "memory")
__device__ __forceinline__ float mul_np(float a, float b) { float o; asm("v_mul_f32 %0, %1, %2" : "=v"(o) : "v"(a), "v"(b)); return o; }
__device__ __forceinline__ float add_np(float a, float b) { float o; asm("v_add_f32 %0, %1, %2" : "=v"(o) : "v"(a), "v"(b)); return o; }
#define VM_WAIT() asm volatile("s_waitcnt vmcnt(0)" ::: "memory")

constexpr int BATCH = 8, SEQ = 2048, D = 2048, M = BATCH * SEQ;
constexpr int NIN = 3632, NINP = 3840;
constexpr int OFF_U = 0, OFF_Q = 1024, OFF_KC = 2048, OFF_VC = 2304, OFF_KS = 2560, OFF_VS = 2816, OFF_KW = 3072, OFF_VW = 3328, OFF_G = 3584;
constexpr int NCMP = 127, NCROWS = BATCH * NCMP * 4;
constexpr float RMS_EPS = 1e-6f;
constexpr float LOG2E = 1.4426950408889634f;

constexpr size_t MiB = 1u << 20;
constexpr size_t WS_CTL = 0, CTL_ZERO_BYTES = 1 * MiB;
constexpr size_t WS_WIN = 2 * MiB, WS_WOUT = 17 * MiB, WS_WQ = 25 * MiB, WS_WG = 33 * MiB, WS_WPJ = 41 * MiB, WS_W1C = 42 * MiB, WS_POOLT = 44 * MiB, WS_KEYS = 45 * MiB;
constexpr size_t WS_CBIAS = 46 * MiB, WS_GATES = 47 * MiB, WS_HC = 50 * MiB, WS_KCMP = 54 * MiB, WS_VCMPT = 54 * MiB + 512 * 1024, WS_P16 = 56 * MiB;
constexpr size_t WS_XN = 64 * MiB, WS_X8 = 64 * MiB;
constexpr float CAT8SCALE = 8.f;
constexpr float W8SCALE = 64.f;
constexpr size_t WS_Y = 128 * MiB, WS_QP = 128 * MiB, WS_PJ = 192 * MiB;
constexpr size_t WS_MIXED = 256 * MiB, WS_CAT = 288 * MiB, WS_KN = 352 * MiB, WS_VT = 368 * MiB, WS_FLATA = 384 * MiB;
constexpr size_t WS_U6 = 256 * MiB, WS_V6 = 288 * MiB, WS_SU = 320 * MiB, WS_SV = 321 * MiB;
constexpr size_t WS_LIDX = 322 * MiB, WS_LG = 330 * MiB, WS_SSP = 338 * MiB, WS_PD = 340 * MiB, WS_HW = 404 * MiB;
constexpr size_t SLICE6 = (size_t)16384 * 192;
constexpr size_t WS_XR = 416 * MiB;
constexpr size_t WS_SS0 = 768 * 1024, WS_SS1 = 256 * 1024, WS_SS2 = 512 * 1024;
constexpr size_t WS_QN = 480 * MiB;
constexpr size_t WS_END = 512 * MiB;
constexpr int CW_TMO = 0, CW_CODE = 1, CW_BAR = 4096;

constexpr int RING_BYTES = 131072;
constexpr int LDSCTL_OFF = RING_BYTES, MISC_OFF = LDSCTL_OFF + 320;
constexpr int LDS_BYTES = 147456;
constexpr int NWAVES = 8;

__device__ __forceinline__ unsigned pk_f16(float lo, float hi) { f16x2 v; v.x = (f16)lo; v.y = (f16)hi; return __builtin_bit_cast(unsigned, v); }
__device__ __forceinline__ unsigned pk_fp8(float a, float b, float c, float d) { int r = __builtin_amdgcn_cvt_pk_fp8_f32(a, b, 0, false); r = __builtin_amdgcn_cvt_pk_fp8_f32(c, d, r, true); return (unsigned)r; }
__device__ __forceinline__ long as_i64(unsigned lo, unsigned hi) { return (long)(((unsigned long long)hi << 32) | lo); }
__device__ __forceinline__ f16x2 ash2(unsigned u) { return __builtin_bit_cast(f16x2, u); }
template <int CTRL> __device__ __forceinline__ float dpp_f(float v) { return __int_as_float(__builtin_amdgcn_update_dpp(0, __float_as_int(v), CTRL, 0xF, 0xF, true)); }
__device__ __forceinline__ float rl_f(float v, int l) { return __int_as_float(__builtin_amdgcn_readlane(__float_as_int(v), l)); }
__device__ __forceinline__ float sum8(float v) { v += dpp_f<0x141>(v); v += dpp_f<0xB1>(v); v += dpp_f<0x4E>(v); return v; }
__device__ __forceinline__ float wave_sum(float v) { v = sum8(v); v += dpp_f<0x140>(v); return (rl_f(v, 0) + rl_f(v, 16)) + (rl_f(v, 32) + rl_f(v, 48)); }
__device__ __forceinline__ float wave_max(float v) { v = fmaxf(v, dpp_f<0x141>(v)); v = fmaxf(v, dpp_f<0xB1>(v)); v = fmaxf(v, dpp_f<0x4E>(v)); v = fmaxf(v, dpp_f<0x140>(v));
    return fmaxf(fmaxf(rl_f(v, 0), rl_f(v, 16)), fmaxf(rl_f(v, 32), rl_f(v, 48))); }

__device__ __forceinline__ unsigned other8u(unsigned x) { return (unsigned)__builtin_amdgcn_update_dpp(0, (int)x, 0x128, 0xF, 0xF, true); }
__device__ __forceinline__ unsigned other16u(unsigned x, bool b4) { const auto r = __builtin_amdgcn_permlane16_swap(x, x, false, false); return b4 ? r[0] : r[1]; }
__device__ __forceinline__ unsigned other32u(unsigned x, bool b5) { const auto r = __builtin_amdgcn_permlane32_swap(x, x, false, false); return b5 ? r[0] : r[1]; }
namespace pg8 {
constexpr int BM = 256, BK = 64, HALF = 128, HTB = HALF * BK * 2, STAGE_BYTES = 8 * HTB, NXCD = 8, WGM = 8;
__host__ __device__ __forceinline__ int lds_byte(int r, int c) { const int st = (r >> 4) * 2 + (c >> 5), rr = r & 15, cc = c & 31, ob = rr * 64 + cc * 2; return st * 1024 + (ob ^ (((ob >> 9) & 1) << 5)); }
__host__ __device__ __forceinline__ void stage_rc(int b, int& R, int& C) { const int st = b / 1024, sb = b % 1024, swz = sb ^ (((sb >> 9) & 1) << 5); R = (st >> 1) * 16 + swz / 64; C = (st & 1) * 32 + (swz % 64) / 2; }
__host__ __device__ __forceinline__ int perm32(int rho) { const int n = rho >> 4, i = rho & 15; return 8 * (i >> 2) + 4 * n + (i & 3); }

struct Unit { int pm, pn; };
struct Gemm { const void* A; const void* Bt; int M, N, K, lda, ldb; int a_pn_off; int b_pm_split; size_t b_split_off; int b_pn_k = 0; int esz = 2;
    __device__ __forceinline__ const char* aptr(const Unit& u) const { return (const char*)A + ((size_t)u.pm * BM * lda + (size_t)u.pn * a_pn_off) * esz; }
    __device__ __forceinline__ const char* bptr(const Unit& u) const { return (const char*)Bt + (b_pn_k ? (size_t)u.pn * b_pn_k * esz : (size_t)u.pn * BM * ldb * esz) + (u.pm >= b_pm_split ? b_split_off : (size_t)0); }
};
struct StaticOrder {
    int nM, nN, nwg, G, c;
    __host__ __device__ void init(int M_, int N_, int G_, int c_) { nM = M_ / BM; nN = N_ / BM; nwg = nM * nN; G = G_; c = c_; }
    __host__ __device__ bool next(int i, Unit& u) const {
        const long L = (long)i * G + c; if (L >= nwg) return false;
        int wgid = (int)L; { const int q = nwg / NXCD, r = nwg % NXCD, xcd = wgid % NXCD, off = wgid / NXCD; wgid = (xcd < r ? xcd * (q + 1) : r * (q + 1) + (xcd - r) * q) + off; }
        const int nig = WGM * nN, gid = wgid / nig, fm = gid * WGM, gsz = (nM - fm) < WGM ? (nM - fm) : WGM;
        u.pm = fm + ((wgid % nig) % gsz); u.pn = (wgid % nig) / gsz; return true;
    }
};

__device__ __forceinline__ f32x2 gelu_pk(f32x2 v) {
    const f32x2 av = __builtin_elementwise_abs(v), d = av * 0.2316418882f + 1.0f;
    f32x2 t; t.x = __builtin_amdgcn_rcpf(d.x); t.y = __builtin_amdgcn_rcpf(d.y);
    f32x2 q = t * 0.5307027145f + (-0.7265760135f); q = q * t + 0.7107068705f; q = q * t + (-0.142248368f); q = q * t + 0.127414796f; q = q * t;
    const f32x2 s = (v * v) * (-0.72134752044f);
    f32x2 e; e.x = __builtin_amdgcn_exp2f(s.x); e.y = __builtin_amdgcn_exp2f(s.y);
    const f32x2 m = v * (q * e), r = v - m;
    f32x2 o; o.x = v.x < 0.f ? m.x : r.x; o.y = v.y < 0.f ? m.y : r.y; return o;
}
__device__ __forceinline__ float gelu1(float v) { f32x2 r = gelu_pk((f32x2){v, v}); return r.x; }

template <int ACT> struct EpiF16 {
    static constexpr bool PERM = true;
    f16* O; int ldc; const float* bias; int bias_pm_split; int bias_split_off;
    __device__ __forceinline__ void operator()(const f32x4 (&acc)[2][2][4][2], const Unit& u, int wr, int wc, int fr, int fq) const {
        const int row0 = u.pm * BM + wr * 64 + fr; const int col0 = u.pn * BM + wc * 32 + 8 * fq;
        const float* bp = bias ? bias + (u.pm >= bias_pm_split ? bias_split_off : 0) : nullptr;
        f32x4 bv[2][2];
#pragma unroll
        for (int bj = 0; bj < 2; ++bj)
#pragma unroll
            for (int n = 0; n < 2; ++n) bv[bj][n] = bp ? *(const f32x4*)(bp + col0 + bj * HALF + 4 * n) : (f32x4){0.f, 0.f, 0.f, 0.f};
#pragma unroll
        for (int ai = 0; ai < 2; ++ai)
#pragma unroll
            for (int m = 0; m < 4; ++m) { f16* rowp = O + (size_t)(row0 + ai * HALF + m * 16) * ldc + col0;
#pragma unroll
                for (int bj = 0; bj < 2; ++bj) { f32x4 v0 = acc[ai][bj][m][0] + bv[bj][0], v1 = acc[ai][bj][m][1] + bv[bj][1];
                    if (ACT == 1) { f32x2 a = gelu_pk((f32x2){v0[0], v0[1]}), b = gelu_pk((f32x2){v0[2], v0[3]}), c = gelu_pk((f32x2){v1[0], v1[1]}), d = gelu_pk((f32x2){v1[2], v1[3]});
                        v0 = (f32x4){a.x, a.y, b.x, b.y}; v1 = (f32x4){c.x, c.y, d.x, d.y}; }
                    u32x4 w; w.x = pk_f16(v0[0], v0[1]); w.y = pk_f16(v0[2], v0[3]); w.z = pk_f16(v1[0], v1[1]); w.w = pk_f16(v1[2], v1[3]);
                    *(u32x4*)(rowp + bj * HALF) = w; } }
    }
};
struct EpiRawF32 {
    static constexpr bool PERM = false;
    float* C; int ldc;
    __device__ __forceinline__ void operator()(const f32x4 (&acc)[2][2][4][2], const Unit& u, int wr, int wc, int fr, int fq) const {
        const int row0 = u.pm * BM + wr * 64 + fr, col0 = u.pn * BM + wc * 32 + 4 * fq;
#pragma unroll
        for (int ai = 0; ai < 2; ++ai)
#pragma unroll
            for (int m = 0; m < 4; ++m) { float* rowp = C + (size_t)(row0 + ai * HALF + m * 16) * ldc + col0;
#pragma unroll
                for (int bj = 0; bj < 2; ++bj)
#pragma unroll
                    for (int n = 0; n < 2; ++n) *(f32x4*)(rowp + bj * HALF + n * 16) = acc[ai][bj][m][n]; }
    }
};
struct EpiF8 {
    static constexpr bool PERM = true;
    unsigned char* O; int ldc; float sc;
    __device__ __forceinline__ void operator()(const f32x4 (&acc)[2][2][4][2], const Unit& u, int wr, int wc, int fr, int fq) const {
        const int row0 = u.pm * BM + wr * 64 + fr; const int col0 = u.pn * BM + wc * 32 + 8 * fq;
#pragma unroll
        for (int ai = 0; ai < 2; ++ai)
#pragma unroll
            for (int m = 0; m < 4; ++m) { unsigned char* rowp = O + (size_t)(row0 + ai * HALF + m * 16) * ldc + col0;
#pragma unroll
                for (int bj = 0; bj < 2; ++bj) { const f32x4 v0 = acc[ai][bj][m][0] * sc, v1 = acc[ai][bj][m][1] * sc;
                    u32x2 w; w.x = pk_fp8(v0[0], v0[1], v0[2], v0[3]); w.y = pk_fp8(v1[0], v1[1], v1[2], v1[3]);
                    *(u32x2*)(rowp + bj * HALF) = w; } }
    }
};
struct EpiRes16 {
    static constexpr bool PERM = true;
    f16* XR; float* SS; float as;
    __device__ __forceinline__ void operator()(const f32x4 (&acc)[2][2][4][2], const Unit& u, int wr, int wc, int fr, int fq) const {
        const int row0 = u.pm * BM + wr * 64 + fr; const int col0 = u.pn * BM + wc * 32 + 8 * fq;
#pragma unroll
        for (int ai = 0; ai < 2; ++ai) {
            f16x8 xb[4][2];
#pragma unroll
            for (int m = 0; m < 4; ++m)
#pragma unroll
                for (int bj = 0; bj < 2; ++bj) xb[m][bj] = *(const f16x8*)(XR + (size_t)(row0 + ai * HALF + m * 16) * D + col0 + bj * HALF);
            asm volatile("" ::: "memory");
#pragma unroll
            for (int m = 0; m < 4; ++m) { const int row = row0 + ai * HALF + m * 16; const size_t off = (size_t)row * D + col0; float ss = 0.f;
#pragma unroll
                for (int bj = 0; bj < 2; ++bj) { const f16x8 xv = xb[m][bj];
                    f32x4 v0 = acc[ai][bj][m][0] * as, v1 = acc[ai][bj][m][1] * as;
                    v0[0] += (float)xv[0]; v0[1] += (float)xv[1]; v0[2] += (float)xv[2]; v0[3] += (float)xv[3]; v1[0] += (float)xv[4]; v1[1] += (float)xv[5]; v1[2] += (float)xv[6]; v1[3] += (float)xv[7];
                    ss += ((v0[0] * v0[0] + v0[1] * v0[1]) + (v0[2] * v0[2] + v0[3] * v0[3])) + ((v1[0] * v1[0] + v1[1] * v1[1]) + (v1[2] * v1[2] + v1[3] * v1[3]));
                    u32x4 o; o.x = pk_f16(v0[0], v0[1]); o.y = pk_f16(v0[2], v0[3]); o.z = pk_f16(v1[0], v1[1]); o.w = pk_f16(v1[2], v1[3]);
                    *(u32x4*)(XR + off + bj * HALF) = o; }
                ss += __shfl_xor(ss, 16); ss += __shfl_xor(ss, 32);
                if (fq == 0) atomicAdd(SS + row, ss); }
            asm volatile("" ::: "memory"); }
    }
};
struct EpiF16Row {
    static constexpr bool PERM = true;
    f16* O; int ldc; const float* SS;
    __device__ __forceinline__ void operator()(const f32x4 (&acc)[2][2][4][2], const Unit& u, int wr, int wc, int fr, int fq) const {
        const int row0 = u.pm * BM + wr * 64 + fr; const int col0 = u.pn * BM + wc * 32 + 8 * fq;
#pragma unroll
        for (int ai = 0; ai < 2; ++ai)
#pragma unroll
            for (int m = 0; m < 4; ++m) { const int row = row0 + ai * HALF + m * 16; f16* rowp = O + (size_t)row * ldc + col0;
                const float rs = 1.f / sqrtf(SS[row] * (1.f / D) + RMS_EPS);
#pragma unroll
                for (int bj = 0; bj < 2; ++bj) { const f32x4 v0 = acc[ai][bj][m][0] * rs, v1 = acc[ai][bj][m][1] * rs;
                    u32x4 o; o.x = pk_f16(v0[0], v0[1]); o.y = pk_f16(v0[2], v0[3]); o.z = pk_f16(v1[0], v1[1]); o.w = pk_f16(v1[2], v1[3]);
                    *(u32x4*)(rowp + bj * HALF) = o; } }
    }
};
struct EpiFinal {
    static constexpr bool PERM = true;
    const f16* XR; const f16* PJ; float* C; const float* SS; float as;
    __device__ __forceinline__ void operator()(const f32x4 (&acc)[2][2][4][2], const Unit& u, int wr, int wc, int fr, int fq) const {
        const int row0 = u.pm * BM + wr * 64 + fr; const int col0 = u.pn * BM + wc * 32 + 8 * fq;
#pragma unroll
        for (int ai = 0; ai < 2; ++ai)
#pragma unroll
            for (int mh = 0; mh < 2; ++mh) {
                f16x8 xb[2][2], pb[2][2]; float ssv[2];
#pragma unroll
                for (int mm = 0; mm < 2; ++mm) { const int row = row0 + ai * HALF + (2 * mh + mm) * 16; ssv[mm] = SS[row];
#pragma unroll
                    for (int bj = 0; bj < 2; ++bj) { xb[mm][bj] = *(const f16x8*)(XR + (size_t)row * D + col0 + bj * HALF); pb[mm][bj] = *(const f16x8*)(PJ + (size_t)row * D + col0 + bj * HALF); } }
                asm volatile("" ::: "memory");
#pragma unroll
                for (int mm = 0; mm < 2; ++mm) { const int m = 2 * mh + mm; const int row = row0 + ai * HALF + m * 16; const size_t off = (size_t)row * D + col0;
                    const float nrs = -LOG2E * as / sqrtf(ssv[mm] * (1.f / D) + RMS_EPS);
#pragma unroll
                    for (int bj = 0; bj < 2; ++bj) { const f16x8 xv = xb[mm][bj], pv = pb[mm][bj];
                        const f32x4 a0 = acc[ai][bj][m][0], a1 = acc[ai][bj][m][1]; f32x4 o0, o1;
#pragma unroll
                        for (int j = 0; j < 4; ++j) { o0[j] = (float)xv[j] + (float)pv[j] * __builtin_amdgcn_rcpf(1.0f + __builtin_amdgcn_exp2f(nrs * a0[j]));
                            o1[j] = (float)xv[4 + j] + (float)pv[4 + j] * __builtin_amdgcn_rcpf(1.0f + __builtin_amdgcn_exp2f(nrs * a1[j])); }
                        *(f32x4*)(C + off + bj * HALF) = o0; *(f32x4*)(C + off + bj * HALF + 4) = o1; } }
                asm volatile("" ::: "memory"); }
    }
};
template <int MODE> struct EpiF32 {
    static constexpr bool PERM = false;
    const float* base; float* C; int ldc; const f16* pj; const float* ssp;
    __device__ __forceinline__ void operator()(const f32x4 (&acc)[2][2][4][2], const Unit& u, int wr, int wc, int fr, int fq) const {
        const int row0 = u.pm * BM + wr * 64 + fr, col0 = u.pn * BM + wc * 32 + 4 * fq;
#pragma unroll
        for (int ai = 0; ai < 2; ++ai)
#pragma unroll
            for (int m = 0; m < 4; ++m) { const size_t off = (size_t)(row0 + ai * HALF + m * 16) * ldc + col0;
                float nrs = -LOG2E;
                if (MODE == 1) { const f32x4 s0 = *(const f32x4*)(ssp + (size_t)(row0 + ai * HALF + m * 16) * 8), s1 = *(const f32x4*)(ssp + (size_t)(row0 + ai * HALF + m * 16) * 8 + 4);
                    nrs = -LOG2E / sqrtf((((s0.x + s0.y) + (s0.z + s0.w)) + ((s1.x + s1.y) + (s1.z + s1.w))) * (1.f / D) + RMS_EPS); }
#pragma unroll
                for (int bj = 0; bj < 2; ++bj)
#pragma unroll
                    for (int n = 0; n < 2; ++n) { const size_t o2 = off + bj * HALF + n * 16; const f32x4 bs = *(const f32x4*)(base + o2); f32x4 a = acc[ai][bj][m][n];
                        if (MODE == 1) { const f16x4 pv = *(const f16x4*)(pj + o2);
#pragma unroll
                            for (int j = 0; j < 4; ++j) a[j] = (float)pv[j] * __builtin_amdgcn_rcpf(1.0f + __builtin_amdgcn_exp2f(nrs * a[j])); }
                        *(f32x4*)(C + o2) = bs + a; }
                asm volatile("" ::: "memory"); }
    }
};

typedef int i32x4v __attribute__((ext_vector_type(4)));
typedef int i32x8v __attribute__((ext_vector_type(8)));
__device__ __forceinline__ i32x8v cat16(const f16x8 a, const f16x8 b) { const i32x4v x = __builtin_bit_cast(i32x4v, a), y = __builtin_bit_cast(i32x4v, b); return __builtin_shufflevector(x, y, 0, 1, 2, 3, 4, 5, 6, 7); }
__device__ __forceinline__ f16x8 half16(const i32x8v& v, int k) { const i32x4v h = k ? __builtin_shufflevector(v, v, 4, 5, 6, 7) : __builtin_shufflevector(v, v, 0, 1, 2, 3); return __builtin_bit_cast(f16x8, h); }
template <class Epi, class Sched, bool F8 = false>
__device__ __forceinline__ void gemm_phase(LAS unsigned char* lds, const Gemm g, const Sched& S, const Epi& E) {
    int tid = threadIdx.x; asm volatile("" : "+v"(tid));
    const int wid = __builtin_amdgcn_readfirstlane(tid >> 6), lane = tid & 63, wr = wid >> 2, wc = wid & 3, fr = lane & 15, fq = lane >> 4;
    const int K = g.K, nt = K * g.esz / (BK * 2);
    unsigned voffA[2], voffB[2];
#pragma unroll
    for (int i = 0; i < 2; ++i) { int R, C; stage_rc(tid * 16 + i * 8192, R, C); const int Rb = Epi::PERM ? ((R & ~31) + perm32(R & 31)) : R;
        voffA[i] = (unsigned)(R * g.lda * g.esz + C * 2); voffB[i] = (unsigned)(Rb * g.ldb * g.esz + C * 2); }
    const size_t kstep = (size_t)(BK * 2);
    const size_t hstepA = (size_t)HALF * g.lda * g.esz, hstepB = (size_t)HALF * g.ldb * g.esz;
    const unsigned ldsw = (unsigned)wid * 1024u;
    const int aoff = lds_byte(wr * 64 + fr, fq * 8), boff = lds_byte(wc * 32 + fr, fq * 8);
#define PG8_SA(b, h) (((b) * 2 + (h)) * HTB)
#define PG8_SB(b, h) ((4 + (b) * 2 + (h)) * HTB)
#define PG8_STAGE(bufoff, gbase, voff) do { _Pragma("unroll") for (int _i = 0; _i < 2; ++_i) \
        __builtin_amdgcn_global_load_lds((const unsigned*)((const char*)(gbase) + (voff)[_i]), (LAS unsigned*)(lds + (bufoff) + ldsw + _i * 8192), 16, 0, 0); } while (0)
#define PG8_LDA(dst, b, h) do { _Pragma("unroll") for (int m = 0; m < 4; ++m) dst[m] = cat16(*(const LAS f16x8*)(lds + PG8_SA(b, h) + aoff + m * 2048), *(const LAS f16x8*)(lds + PG8_SA(b, h) + aoff + m * 2048 + 1024)); } while (0)
#define PG8_LDB(dst, b, h) do { _Pragma("unroll") for (int n = 0; n < 2; ++n) dst[n] = cat16(*(const LAS f16x8*)(lds + PG8_SB(b, h) + boff + n * 2048), *(const LAS f16x8*)(lds + PG8_SB(b, h) + boff + n * 2048 + 1024)); } while (0)
#define PG8_MMA(ai, bj, At, Bt) do { __builtin_amdgcn_s_setprio(1); \
        if (F8) { _Pragma("unroll") for (int m = 0; m < 4; ++m) _Pragma("unroll") for (int n = 0; n < 2; ++n) \
            asm volatile("v_mfma_scale_f32_16x16x128_f8f6f4 %0, %1, %2, %0, %3, %3 op_sel_hi:[0,0,0]" : "+v"(acc[ai][bj][m][n]) : "v"(Bt[n]), "v"(At[m]), "v"(0x7F7F7F7F)); } \
        else { _Pragma("unroll") for (int m = 0; m < 4; ++m) _Pragma("unroll") for (int n = 0; n < 2; ++n) _Pragma("unroll") for (int k = 0; k < 2; ++k) \
            acc[ai][bj][m][n] = __builtin_amdgcn_mfma_f32_16x16x32_f16(half16(Bt[n], k), half16(At[m], k), acc[ai][bj][m][n], 0, 0, 0); } \
        __builtin_amdgcn_s_setprio(0); } while (0)
#define PG8_WAIT_V(n) asm volatile("s_waitcnt vmcnt(" #n ")" ::: "memory")
#define PG8_WAIT_L(n) asm volatile("s_waitcnt lgkmcnt(" #n ")" ::: "memory")
#define PG8_BAR __builtin_amdgcn_s_barrier()
#define PG8_SCHED __builtin_amdgcn_sched_barrier(0)
    Unit cur, nxt; int ui = 0;
    if (!S.next(0, cur)) return;
    f32x4 acc[2][2][4][2];
#pragma unroll
    for (int a = 0; a < 2; ++a)
#pragma unroll
        for (int b = 0; b < 2; ++b)
#pragma unroll
            for (int m = 0; m < 4; ++m)
#pragma unroll
                for (int n = 0; n < 2; ++n) acc[a][b][m][n] = (f32x4){0.f, 0.f, 0.f, 0.f};
    i32x8v At[4], B0[2], B1[2];
    const char* cA = g.aptr(cur); const char* cB = g.bptr(cur);
    PG8_STAGE(PG8_SB(0, 0), cB, voffB); PG8_STAGE(PG8_SB(0, 1), cB + hstepB, voffB); PG8_STAGE(PG8_SA(0, 0), cA, voffA); PG8_STAGE(PG8_SA(0, 1), cA + hstepA, voffA);
    if (wr == 1) PG8_BAR;
    PG8_WAIT_V(2); PG8_BAR;
    PG8_STAGE(PG8_SB(1, 0), cB + kstep, voffB); PG8_STAGE(PG8_SA(1, 0), cA + kstep, voffA); PG8_STAGE(PG8_SB(1, 1), cB + hstepB + kstep, voffB);
    PG8_WAIT_V(6); PG8_BAR;
    for (;;) {
        const bool has_next = S.next(ui + 1, nxt);
        const char* nA = has_next ? g.aptr(nxt) : cA; const char* nB = has_next ? g.bptr(nxt) : cB;
#pragma clang loop unroll(disable)
        for (int t = 0; t < nt; t += 2) {
            const bool last = (t == nt - 2);
            const char* a1 = cA + (size_t)(t + 1) * kstep;
            const char* a2 = last ? nA : cA + (size_t)(t + 2) * kstep; const char* b2 = last ? nB : cB + (size_t)(t + 2) * kstep;
            const char* a3 = a2 + kstep; const char* b3 = b2 + kstep;
            PG8_LDB(B0, 0, 0); PG8_LDB(B1, 0, 1); PG8_SCHED; PG8_LDA(At, 0, 0); PG8_STAGE(PG8_SA(1, 1), a1 + hstepA, voffA);
            PG8_WAIT_V(8); PG8_WAIT_L(0); PG8_BAR; PG8_MMA(0, 0, At, B0); PG8_MMA(0, 1, At, B1); PG8_BAR; PG8_SCHED;
            PG8_LDA(At, 0, 1); PG8_STAGE(PG8_SB(0, 0), b2, voffB); PG8_STAGE(PG8_SB(0, 1), b2 + hstepB, voffB); PG8_STAGE(PG8_SA(0, 0), a2, voffA);
            PG8_WAIT_V(8); PG8_WAIT_L(0); PG8_BAR; PG8_MMA(1, 0, At, B0); PG8_MMA(1, 1, At, B1); PG8_BAR; PG8_SCHED;
            PG8_LDB(B0, 1, 0); PG8_LDB(B1, 1, 1); PG8_SCHED; PG8_LDA(At, 1, 0); PG8_STAGE(PG8_SA(0, 1), a2 + hstepA, voffA);
            PG8_WAIT_V(8); PG8_WAIT_L(0); PG8_BAR; PG8_MMA(0, 0, At, B0); PG8_MMA(0, 1, At, B1); PG8_BAR; PG8_SCHED;
            PG8_LDA(At, 1, 1); PG8_STAGE(PG8_SB(1, 0), b3, voffB); PG8_STAGE(PG8_SB(1, 1), b3 + hstepB, voffB); PG8_STAGE(PG8_SA(1, 0), a3, voffA);
            PG8_WAIT_V(8); PG8_WAIT_L(0); PG8_BAR; PG8_MMA(1, 0, At, B0); PG8_MMA(1, 1, At, B1); PG8_BAR; PG8_SCHED;
        }
        if (F8) asm volatile("s_nop 15\n\ts_nop 15" ::: "memory");
        if (wr == 0) PG8_BAR;
        E(acc, cur, wr, wc, fr, fq);
        if (!has_next) break;
#pragma unroll
        for (int a = 0; a < 2; ++a)
#pragma unroll
            for (int b = 0; b < 2; ++b)
#pragma unroll
                for (int m = 0; m < 4; ++m)
#pragma unroll
                    for (int n = 0; n < 2; ++n) acc[a][b][m][n] = (f32x4){0.f, 0.f, 0.f, 0.f};
        cur = nxt; cA = nA; cB = nB; ++ui;
        if (wr == 1) PG8_BAR;
    }
    PG8_WAIT_V(0);
    PG8_BAR;
#undef PG8_SA
#undef PG8_SB
#undef PG8_STAGE
#undef PG8_LDA
#undef PG8_LDB
#undef PG8_MMA
#undef PG8_WAIT_V
#undef PG8_WAIT_L
#undef PG8_BAR
#undef PG8_SCHED
}
}

#define XB_TMO      128
#define XB_XCNT(j)  (256  + 64 * (j))
#define XB_XSUB(j)  (1280 + 64 * (j))
#define XB_XGEN(j)  (2304 + 64 * (j))
#define XB_TOP      3328
#define XB_TOPGEN   3392
#define XCD_BAR_WORDS 3456
#define XB_SPIN_CAP (1u << 18)
__device__ __forceinline__ unsigned xb_ld(unsigned* p)              { return __hip_atomic_load(p, __ATOMIC_RELAXED, __HIP_MEMORY_SCOPE_AGENT); }
__device__ __forceinline__ unsigned xb_add(unsigned* p, unsigned v) { return __hip_atomic_fetch_add(p, v, __ATOMIC_RELAXED, __HIP_MEMORY_SCOPE_AGENT); }
__device__ __forceinline__ unsigned xb_xcc_id() { return (unsigned)__builtin_amdgcn_s_getreg((3 << 11) | 20) & 0xFu; }
#define XB_SPIN(cond, bar) do { unsigned _sp = 0; while (cond) { __builtin_amdgcn_s_sleep(1); \
    if ((++_sp & 255u) == 0u) { if (xb_ld(&(bar)[XB_TMO])) break; if (_sp > XB_SPIN_CAP) { atomicAdd(&(bar)[XB_TMO], 1u); break; } } } } while (0)
struct XcdBarrier { unsigned* bar; unsigned x; volatile LAS unsigned* st; };
__device__ __forceinline__ XcdBarrier xcd_barrier_post(unsigned* bar, volatile LAS unsigned* st) {
    XcdBarrier b; b.bar = bar; b.x = xb_xcc_id(); b.st = st;
    if (threadIdx.x == 0) (void)xb_add(&bar[XB_XCNT(b.x)], 1u);
    return b;
}
__device__ __forceinline__ void xcd_barrier_complete(unsigned* bar, unsigned x, unsigned& nloc, unsigned& nx) {
    const unsigned G = gridDim.x * gridDim.y * gridDim.z;
    unsigned sum, cnt, mine, sp = 0u;
    for (;;) {
        sum = 0u; cnt = 0u; mine = 0u;
#pragma unroll
        for (unsigned j = 0; j < 16; ++j) { const unsigned c = xb_ld(&bar[XB_XCNT(j)]); sum += c; cnt += (c > 0u) ? 1u : 0u; mine = (j == x) ? c : mine; }
        if (sum == G) break;
        __builtin_amdgcn_s_sleep(1);
        if ((++sp & 255u) == 0u) { if (xb_ld(&bar[XB_TMO])) break; if (sp > XB_SPIN_CAP) { atomicAdd(&bar[XB_TMO], 1u); break; } }
    }
    nloc = mine > 0u ? mine : 1u; nx = cnt > 0u ? cnt : 1u;
}
__device__ __forceinline__ void xcd_barrier(const XcdBarrier& b) {
    asm volatile("s_waitcnt vmcnt(0)" ::: "memory");
    __syncthreads();
    if (threadIdx.x == 0) {
        unsigned* bar = b.bar;
        __builtin_amdgcn_s_waitcnt(0);
        unsigned nloc = b.st[0], nx = b.st[1];
        if (nloc == 0u) { xcd_barrier_complete(bar, b.x, nloc, nx); b.st[0] = nloc; b.st[1] = nx; }
        const unsigned old = xb_add(&bar[XB_XSUB(b.x)], 1u);
        const unsigned gen = old / nloc;
        if (old + 1u == (gen + 1u) * nloc) {
            __builtin_amdgcn_fence(__ATOMIC_RELEASE, "agent");
            asm volatile("s_waitcnt vmcnt(0)" ::: "memory");
            const unsigned og = xb_add(&bar[XB_TOP], 1u);
            const unsigned tg = og / nx;
            if (og + 1u == (tg + 1u) * nx) xb_add(&bar[XB_TOPGEN], 1u);
            else XB_SPIN(xb_ld(&bar[XB_TOPGEN]) == tg, bar);
            __builtin_amdgcn_fence(__ATOMIC_ACQUIRE, "agent");
            xb_add(&bar[XB_XGEN(b.x)], 1u);
            asm volatile("s_waitcnt vmcnt(0)" ::: "memory");
        } else {
            XB_SPIN(xb_ld(&bar[XB_XGEN(b.x)]) == gen, bar);
            __builtin_amdgcn_fence(__ATOMIC_ACQUIRE, "agent");
            asm volatile("s_waitcnt vmcnt(0)" ::: "memory");
        }
    }
    __syncthreads();
}

struct Frame {
    LAS unsigned char* lds;
    volatile LAS unsigned* MISC;
    int tid, lane, wave;
    int vcu, G;
    const float* in[26];
    float* out;
    unsigned char* ws;
};
enum { I_X = 0, I_P, I_RELB, I_MIXNW, I_WIN, I_QNW, I_KNW, I_CKPOS, I_CKW1, I_CKB1, I_CKW2, I_CVPOS, I_CVW1, I_CVB1, I_CVW2, I_POOLW, I_POOLS, I_WOUT, I_FFNNW, I_PWQ, I_PKEYS, I_PU, I_PV, I_PLENW, I_PLEWG, I_PLEWP };

__device__ __forceinline__ void p0_transpose_item(const float* W, int K, int N, int Npad, const float* colscale, f16* WT, LAS float* scr, int item, int lane, const float* kscale = nullptr, bool f8 = false, float wscale = 1.f) {
    const int nblk = Npad / 32, kb = item / nblk, nb = item % nblk, k0 = 64 * kb, n0 = 32 * nb;
    const int nn = n0 + (lane & 31); const bool ok = nn < N;
#pragma unroll
    for (int hgrp = 0; hgrp < 2; ++hgrp) { float wv[16];
#pragma unroll
        for (int i = 0; i < 16; ++i) { const int kk = 2 * (16 * hgrp + i) + (lane >> 5); wv[i] = ok ? W[(size_t)(k0 + kk) * N + nn] : 0.f; }
        if (kscale) {
#pragma unroll
            for (int i = 0; i < 16; ++i) wv[i] *= kscale[k0 + 2 * (16 * hgrp + i) + (lane >> 5)]; }
#pragma unroll
        for (int i = 0; i < 16; ++i) { const int kk = 2 * (16 * hgrp + i) + (lane >> 5); scr[kk * 33 + (lane & 31)] = wv[i]; }
        asm volatile("" ::: "memory"); }
    LDS_WAIT(); asm volatile("" ::: "memory");
    const int c = lane & 7;
#pragma unroll
    for (int j = 0; j < 4; ++j) { const int n = (lane >> 3) + 8 * j; const LAS float* s = scr + (8 * c) * 33 + n; const float sc = (colscale && n0 + n < N) ? colscale[n0 + n] : 1.f;
        if (f8) { const float s8 = sc * wscale; u32x2 o; o.x = pk_fp8(s[0 * 33] * s8, s[1 * 33] * s8, s[2 * 33] * s8, s[3 * 33] * s8); o.y = pk_fp8(s[4 * 33] * s8, s[5 * 33] * s8, s[6 * 33] * s8, s[7 * 33] * s8);
            *(GAS u32x2*)((unsigned char*)WT + (size_t)(n0 + n) * K + k0 + 8 * c) = o; }
        else { u32x4 o; o.x = pk_f16(s[0 * 33] * sc, s[1 * 33] * sc); o.y = pk_f16(s[2 * 33] * sc, s[3 * 33] * sc); o.z = pk_f16(s[4 * 33] * sc, s[5 * 33] * sc); o.w = pk_f16(s[6 * 33] * sc, s[7 * 33] * sc);
            *(GAS u32x4*)(WT + (size_t)(n0 + n) * K + k0 + 8 * c) = o; } }
    LDS_WAIT(); asm volatile("" ::: "memory");
}
__device__ __forceinline__ void rms_row_to_f16(const float* xrow, const float* w, f16* orow, int lane, f16* x16row = nullptr) {
    const GAS f32x4* xr = (const GAS f32x4*)xrow + lane; const GAS f32x4* wr = (const GAS f32x4*)w + lane;
    f32x4 v[8]; float s = 0.f;
#pragma unroll
    for (int j = 0; j < 8; ++j) { v[j] = xr[64 * j]; s += (v[j].x * v[j].x + v[j].y * v[j].y) + (v[j].z * v[j].z + v[j].w * v[j].w); }
    const float rstd = 1.f / sqrtf(wave_sum(s) * (1.f / D) + RMS_EPS);
    GAS u32x2* o8 = (GAS u32x2*)orow + lane;
#pragma unroll
    for (int j = 0; j < 8; ++j) { const f32x4 g = wr[64 * j]; u32x2 o; o.x = pk_f16(v[j].x * rstd * g.x, v[j].y * rstd * g.y); o.y = pk_f16(v[j].z * rstd * g.z, v[j].w * rstd * g.w); o8[64 * j] = o; }
    if (x16row) { GAS u32x2* x8 = (GAS u32x2*)x16row + lane;
#pragma unroll
        for (int j = 0; j < 8; ++j) { u32x2 o; o.x = pk_f16(v[j].x, v[j].y); o.y = pk_f16(v[j].z, v[j].w); x8[64 * j] = o; } }
}
__device__ __forceinline__ void rms_2rows_to_f16(const float* x0, const float* x1, const float* w, f16* o0, f16* o1, f16* h0, f16* h1, int lane) {
    const GAS f32x4* xa = (const GAS f32x4*)x0 + lane; const GAS f32x4* xb = (const GAS f32x4*)x1 + lane; const GAS f32x4* wr = (const GAS f32x4*)w + lane;
    f32x4 va[8], vb[8]; float sa = 0.f, sb = 0.f;
#pragma unroll
    for (int j = 0; j < 8; ++j) { va[j] = __builtin_nontemporal_load(xa + 64 * j); vb[j] = __builtin_nontemporal_load(xb + 64 * j); }
#pragma unroll
    for (int j = 0; j < 8; ++j) { sa += (va[j].x * va[j].x + va[j].y * va[j].y) + (va[j].z * va[j].z + va[j].w * va[j].w); sb += (vb[j].x * vb[j].x + vb[j].y * vb[j].y) + (vb[j].z * vb[j].z + vb[j].w * vb[j].w); }
    const float ra = 1.f / sqrtf(wave_sum(sa) * (1.f / D) + RMS_EPS), rb = 1.f / sqrtf(wave_sum(sb) * (1.f / D) + RMS_EPS);
    GAS u32x2* pa = (GAS u32x2*)o0 + lane; GAS u32x2* pb = (GAS u32x2*)o1 + lane; GAS u32x2* qa = (GAS u32x2*)h0 + lane; GAS u32x2* qb = (GAS u32x2*)h1 + lane;
#pragma unroll
    for (int j = 0; j < 8; ++j) { const f32x4 g = wr[64 * j]; u32x2 o;
        o.x = pk_f16(va[j].x * ra * g.x, va[j].y * ra * g.y); o.y = pk_f16(va[j].z * ra * g.z, va[j].w * ra * g.w); pa[64 * j] = o;
        o.x = pk_f16(vb[j].x * rb * g.x, vb[j].y * rb * g.y); o.y = pk_f16(vb[j].z * rb * g.z, vb[j].w * rb * g.w); pb[64 * j] = o;
        o.x = pk_f16(va[j].x, va[j].y); o.y = pk_f16(va[j].z, va[j].w); qa[64 * j] = o;
        o.x = pk_f16(vb[j].x, vb[j].y); o.y = pk_f16(vb[j].z, vb[j].w); qb[64 * j] = o; }
}
__device__ __forceinline__ void x16_2rows(const float* x0, const float* x1, f16* h0, f16* h1, float* ss0, float* ss1, int lane) {
    const GAS f32x4* xa = (const GAS f32x4*)x0 + lane; const GAS f32x4* xb = (const GAS f32x4*)x1 + lane;
    f32x4 va[8], vb[8]; float sa = 0.f, sb = 0.f;
#pragma unroll
    for (int j = 0; j < 8; ++j) { va[j] = __builtin_nontemporal_load(xa + 64 * j); vb[j] = __builtin_nontemporal_load(xb + 64 * j); }
    GAS u32x2* qa = (GAS u32x2*)h0 + lane; GAS u32x2* qb = (GAS u32x2*)h1 + lane;
#pragma unroll
    for (int j = 0; j < 8; ++j) { sa += (va[j].x * va[j].x + va[j].y * va[j].y) + (va[j].z * va[j].z + va[j].w * va[j].w); sb += (vb[j].x * vb[j].x + vb[j].y * vb[j].y) + (vb[j].z * vb[j].z + vb[j].w * vb[j].w);
        u32x2 o; o.x = pk_f16(va[j].x, va[j].y); o.y = pk_f16(va[j].z, va[j].w); qa[64 * j] = o;
        o.x = pk_f16(vb[j].x, vb[j].y); o.y = pk_f16(vb[j].z, vb[j].w); qb[64 * j] = o; }
    sa = wave_sum(sa); sb = wave_sum(sb);
    if (lane == 0) { *ss0 = sa; *ss1 = sb; }
}
__device__ __forceinline__ void cvt_f32_f16(Frame& F, const float* src, f16* dst, size_t n) {
    const size_t gt = (size_t)F.vcu * 512 + F.tid, GT = (size_t)F.G * 512;
    for (size_t i = gt; i < n / 8; i += GT) { const f32x4 a = *(const GAS f32x4*)(src + i * 8), b = *(const GAS f32x4*)(src + i * 8 + 4);
        u32x4 o; o.x = pk_f16(a.x, a.y); o.y = pk_f16(a.z, a.w); o.z = pk_f16(b.x, b.y); o.w = pk_f16(b.z, b.w); *(GAS u32x4*)(dst + i * 8) = o; }
}

__device__ __forceinline__ void p0_prologue(Frame& F) {
    LAS float* scr = (LAS float*)(F.lds + F.wave * 16384);
    const int gw = F.vcu * NWAVES + F.wave, NGW = F.G * NWAVES;
    unsigned char* ws = F.ws;
    constexpr int I_IN = (D / 64) * (NINP / 32), I_SQ = (D / 64) * (D / 32), I_PJ = (256 / 64) * (D / 32), I_C1 = (D / 64) * (256 / 32), I_PL = (256 / 64) * (256 / 32);
    constexpr int NITEMS = I_IN + 3 * I_SQ + I_PJ + 2 * I_C1 + 4 * I_PL;
    for (int it = gw; it < NITEMS; it += NGW) {
        int r = it;
        if (r < I_IN) { p0_transpose_item(F.in[I_WIN], D, NIN, NINP, nullptr, (f16*)(ws + WS_WIN), scr, r, F.lane, F.in[I_MIXNW]); continue; } r -= I_IN;
        if (r < I_SQ) { p0_transpose_item(F.in[I_WOUT], D, D, D, nullptr, (f16*)(ws + WS_WOUT), scr, r, F.lane, nullptr, true, W8SCALE); continue; } r -= I_SQ;
        if (r < I_SQ) { p0_transpose_item(F.in[I_PWQ], D, D, D, nullptr, (f16*)(ws + WS_WQ), scr, r, F.lane, F.in[I_FFNNW]); continue; } r -= I_SQ;
        if (r < I_SQ) { p0_transpose_item(F.in[I_PLEWG], D, D, D, nullptr, (f16*)(ws + WS_WG), scr, r, F.lane, F.in[I_PLENW], true, W8SCALE); continue; } r -= I_SQ;
        if (r < I_PJ) { p0_transpose_item(F.in[I_PLEWP], 256, D, D, nullptr, (f16*)(ws + WS_WPJ), scr, r, F.lane); continue; } r -= I_PJ;
        if (r < I_C1) { p0_transpose_item(F.in[I_CKW1], D, 256, 256, nullptr, (f16*)(ws + WS_W1C), scr, r, F.lane); continue; } r -= I_C1;
        if (r < I_C1) { p0_transpose_item(F.in[I_CVW1], D, 256, 256, nullptr, (f16*)(ws + WS_W1C) + 256 * D, scr, r, F.lane); continue; } r -= I_C1;
        { const int g = r / I_PL; r -= g * I_PL;
          p0_transpose_item(F.in[I_POOLW] + (size_t)g * 65536, 256, 256, 256, F.in[I_POOLS] + g * 256, (f16*)(ws + WS_POOLT) + (size_t)g * 65536, scr, r, F.lane); }
    }
    { float* SS0 = (float*)(ws + WS_SS0); f16* XR = (f16*)(ws + WS_XR);
      for (int m = gw; m < M; m += 2 * NGW) { const int m2 = m + NGW < M ? m + NGW : m;
          x16_2rows(F.in[I_X] + (size_t)m * D, F.in[I_X] + (size_t)m2 * D, XR + (size_t)m * D, XR + (size_t)m2 * D, SS0 + m, SS0 + m2, F.lane); } }
    cvt_f32_f16(F, F.in[I_P], (f16*)(ws + WS_P16), (size_t)M * 256);
    cvt_f32_f16(F, F.in[I_PKEYS], (f16*)(ws + WS_KEYS), (size_t)8 * 2 * 128 * 128);
    for (int task = gw; task < 512; task += NGW) { const int mat = task >> 8, n = task & 255;
        const float* pos = F.in[mat ? I_CVPOS : I_CKPOS]; const float* w1 = F.in[mat ? I_CVW1 : I_CKW1]; float s = 0.f;
#pragma unroll
        for (int i = 0; i < 32; ++i) { const int k = F.lane + 64 * i; s += pos[k] * w1[(size_t)k * 256 + n]; }
        s = wave_sum(s);
        if (F.lane == 0) ((float*)(ws + WS_CBIAS))[task] = s + F.in[mat ? I_CVB1 : I_CKB1][n]; }
}

template <int W> __device__ __forceinline__ void pool_mix_tile(const f16* up, f16* mp, size_t mb, int s0) {
    f16x2 prev[16], cur[16]; f32x2 sum = {0.f, 0.f};
#pragma unroll
    for (int i = 0; i < 16; ++i) { const int sp = s0 - 16 + i; prev[i] = sp >= 0 ? *(const GAS f16x2*)(up + (mb + sp) * NINP) : (f16x2){(f16)0.f, (f16)0.f}; }
#pragma unroll
    for (int i = 16 - W; i < 16; ++i) { sum.x += (float)prev[i].x; sum.y += (float)prev[i].y; }
#pragma unroll 1
    for (int blk = 0; blk < 4; ++blk) { const int sb = s0 + blk * 16;
#pragma unroll
        for (int i = 0; i < 16; ++i) cur[i] = *(const GAS f16x2*)(up + (mb + sb + i) * NINP);
#pragma unroll
        for (int i = 0; i < 16; ++i) { const int s = sb + i; const f16x2 o = (i - W >= 0) ? cur[(i - W >= 0) ? i - W : 0] : prev[(i - W >= 0) ? 0 : 16 + i - W];
            sum.x += (float)cur[i].x - (float)o.x; sum.y += (float)cur[i].y - (float)o.y;
            const float ic = 1.f / (float)(s + 1 < W ? s + 1 : W);
            *(GAS unsigned*)(mp + (mb + s) * 1024) = pk_f16(sum.x * ic - (float)cur[i].x, sum.y * ic - (float)cur[i].y); }
#pragma unroll
        for (int i = 0; i < 16; ++i) prev[i] = cur[i]; }
}
__device__ __forceinline__ void p2_post(Frame& F) {
    unsigned char* ws = F.ws;
    f16* Y = (f16*)(ws + WS_Y);
    const float* qnw = F.in[I_QNW]; const float* knw = F.in[I_KNW];
    LAS f16* vl = (LAS f16*)F.lds;
    constexpr int VLP = 264;
    for (int tt = F.vcu; tt < M / 64; tt += F.G) {
        const int b = tt >> 5, s0 = (tt & 31) * 64, m0 = tt * 64;
        for (int tk = F.wave; tk < 64; tk += NWAVES) {
            const int m = m0 + tk, s = s0 + tk; f16* yr = Y + (size_t)m * NINP;
#pragma unroll
            for (int pass = 0; pass < 2; ++pass) { const int ch = pass * 64 + F.lane; f16* pq = yr + OFF_Q + ch * 8; const f16x8 v = *(const GAS f16x8*)pq;
                float ss = 0.f;
#pragma unroll
                for (int e = 0; e < 8; ++e) ss += (float)v[e] * (float)v[e];
                ss = sum8(ss);
                const float rs = (1.f / sqrtf(ss * (1.f / 64.f) + RMS_EPS)) * (0.125f * LOG2E); const float* w = qnw + (ch & 7) * 8;
                u32x4 o; o.x = pk_f16((float)v[0] * rs * w[0], (float)v[1] * rs * w[1]); o.y = pk_f16((float)v[2] * rs * w[2], (float)v[3] * rs * w[3]);
                o.z = pk_f16((float)v[4] * rs * w[4], (float)v[5] * rs * w[5]); o.w = pk_f16((float)v[6] * rs * w[6], (float)v[7] * rs * w[7]);
                *(GAS u32x4*)((f16*)(ws + WS_QN) + (size_t)m * 1024 + ch * 8) = o; }
            { const int br = F.lane >> 5, ch = F.lane & 31, g = ch >> 3, dc = ch & 7; const f16x8 v = *(const GAS f16x8*)(yr + (br ? OFF_KW : OFF_KS) + ch * 8);
                float ss = 0.f;
#pragma unroll
                for (int e = 0; e < 8; ++e) ss += (float)v[e] * (float)v[e];
                ss = sum8(ss);
                const float rs = 1.f / sqrtf(ss * (1.f / 64.f) + RMS_EPS); const float* w = knw + dc * 8;
                u32x2 o; o.x = pk_fp8((float)v[0] * rs * w[0], (float)v[1] * rs * w[1], (float)v[2] * rs * w[2], (float)v[3] * rs * w[3]);
                o.y = pk_fp8((float)v[4] * rs * w[4], (float)v[5] * rs * w[5], (float)v[6] * rs * w[6], (float)v[7] * rs * w[7]);
                *(GAS u32x2*)(ws + WS_KN + (size_t)br * (BATCH * 4 * SEQ * 64) + ((size_t)(b * 4 + g) * 64 + (s >> 5)) * 2048 + (dc >> 2) * 1024 + ((dc & 1) * 32 + (s & 31)) * 16 + ((dc >> 1) & 1) * 8) = o; }
            { const int mat = F.lane >> 5, ch = F.lane & 31, g = ch >> 3, dc = ch & 7; const u32x4 v = *(const GAS u32x4*)(yr + (mat ? OFF_VC : OFF_KC) + ch * 8);
                const int i1 = s >> 4, jj = s & 15; f16* fa = (f16*)(ws + WS_FLATA) + (size_t)mat * 4096 * 2048;
                if (i1 <= NCMP - 1) *(GAS u32x4*)(fa + (size_t)((b * NCMP + i1) * 4 + g) * 2048 + jj * 64 + dc * 8) = v;
                if (i1 >= 1) *(GAS u32x4*)(fa + (size_t)((b * NCMP + i1 - 1) * 4 + g) * 2048 + (16 + jj) * 64 + dc * 8) = v; }
        }
        for (int idx = F.tid; idx < 64 * 48; idx += 512) { const int tk = idx / 48, c = idx - tk * 48; const float v = (float)Y[(size_t)(m0 + tk) * NINP + OFF_G + c];
            ((float*)(ws + WS_GATES))[(size_t)(m0 + tk) * 48 + c] = 1.f / (1.f + __expf(-v)); }
        { const int gg = F.tid >> 7;
          if (gg == 0) pool_mix_tile<2>(Y + OFF_U + F.tid * 2, (f16*)(ws + WS_MIXED) + F.tid * 2, (size_t)b * SEQ, s0);
          else if (gg == 1) pool_mix_tile<4>(Y + OFF_U + F.tid * 2, (f16*)(ws + WS_MIXED) + F.tid * 2, (size_t)b * SEQ, s0);
          else if (gg == 2) pool_mix_tile<8>(Y + OFF_U + F.tid * 2, (f16*)(ws + WS_MIXED) + F.tid * 2, (size_t)b * SEQ, s0);
          else pool_mix_tile<16>(Y + OFF_U + F.tid * 2, (f16*)(ws + WS_MIXED) + F.tid * 2, (size_t)b * SEQ, s0); }
        __syncthreads();
        for (int idx = F.tid; idx < 2 * 64 * 32; idx += 512) { const int br = idx >> 11, tk = (idx >> 5) & 63, ch = idx & 31;
            *(LAS u32x4*)(vl + (br * 64 + tk) * VLP + ch * 8) = *(const GAS u32x4*)(Y + (size_t)(m0 + tk) * NINP + (br ? OFF_VW : OFF_VS) + ch * 8); }
        __syncthreads();
        for (int idx = F.tid; idx < 2 * 256 * 8; idx += 512) { const int br = idx >> 11, row = (idx >> 3) & 255, cc = idx & 7, grp = cc >> 1, hh = cc & 1;
            float o[8];
#pragma unroll
            for (int j = 0; j < 8; ++j) { const int kap = 16 * grp + 8 * (j >> 2) + 4 * hh + (j & 3); o[j] = (float)vl[(br * 64 + kap) * VLP + row]; }
            const int g = row >> 6, d = row & 63;
            u32x2 o8; o8.x = pk_fp8(o[0], o[1], o[2], o[3]); o8.y = pk_fp8(o[4], o[5], o[6], o[7]);
            *(GAS u32x2*)(ws + WS_VT + (size_t)br * (BATCH * 4 * 64 * SEQ) + ((size_t)(b * 4 + g) * 64 + (s0 >> 5) + (cc >> 2)) * 2048 + (d >> 5) * 1024 + ((cc & 1) * 32 + (d & 31)) * 16 + ((cc >> 1) & 1) * 8) = o8; }
        __syncthreads();
    }
}

__device__ __forceinline__ void p4_compress2(Frame& F) {
    unsigned char* ws = F.ws;
    f16* kc = (f16*)(ws + WS_KCMP); f16* vt = (f16*)(ws + WS_VCMPT);
    const int nhalf = F.G >> 1, mat = F.vcu & 1, wgr = F.vcu >> 1;
    if (nhalf == 0) return;
    LAS float* w2l = (LAS float*)F.lds;
    { const float* w2g = F.in[mat ? I_CVW2 : I_CKW2];
      for (int idx = F.tid; idx < 256 * 16; idx += 512) { const int k = idx >> 4, d4 = (idx & 15) * 4; const f32x4 v = *(const GAS f32x4*)(w2g + (size_t)k * 64 + d4);
          LAS float* q = w2l + ((k >> 2) * 64 + d4) * 4 + (k & 3); q[0] = v.x; q[4] = v.y; q[8] = v.z; q[12] = v.w; } }
    __syncthreads();
    const int rstep = nhalf * NWAVES, r0 = (F.vcu >= 2 * nhalf ? 4096 : wgr * NWAVES + F.wave);
#pragma unroll 1
    for (int rb = r0; rb < 4096; rb += 4 * rstep) {
        f32x4 hs[4];
#pragma unroll
        for (int q = 0; q < 4; ++q) { const int r = rb + q * rstep < 4096 ? rb + q * rstep : rb; const int bg = r >> 7, i = r & 127, ic = i < NCMP ? i : 0;
            const float* hp = (const float*)(ws + WS_Y) + ((size_t)mat * 4096 + (size_t)((bg >> 2) * NCMP + ic) * 4 + (bg & 3)) * 1024 + F.lane * 4;
            hs[q] = *(const GAS f32x4*)(((const float*)(ws + WS_CBIAS)) + mat * 256 + F.lane * 4);
#pragma unroll
            for (int ks = 0; ks < 4; ++ks) hs[q] = hs[q] + *(const GAS f32x4*)(hp + ks * 256); }
        float hh_[4][4], ac[4][4];
#pragma unroll
        for (int q = 0; q < 4; ++q) { const f32x2 ga = pg8::gelu_pk((f32x2){hs[q].x, hs[q].y}), gb = pg8::gelu_pk((f32x2){hs[q].z, hs[q].w});
            hh_[q][0] = ga.x; hh_[q][1] = ga.y; hh_[q][2] = gb.x; hh_[q][3] = gb.y; ac[q][0] = 0.f; ac[q][1] = 0.f; ac[q][2] = 0.f; ac[q][3] = 0.f; }
#pragma unroll 8
        for (int kk = 0; kk < 64; ++kk) { const f32x4 wv = *(const LAS f32x4*)(w2l + (kk * 64 + F.lane) * 4);
#pragma unroll
            for (int q = 0; q < 4; ++q) { ac[q][0] += rl_f(hh_[q][0], kk) * wv.x; ac[q][1] += rl_f(hh_[q][1], kk) * wv.y; ac[q][2] += rl_f(hh_[q][2], kk) * wv.z; ac[q][3] += rl_f(hh_[q][3], kk) * wv.w; } }
#pragma unroll
        for (int q = 0; q < 4; ++q) { const int r = rb + q * rstep; if (r < 4096) {
            const int bg = r >> 7, i = r & 127;
            const float acc = i < NCMP ? (ac[q][0] + ac[q][1]) + (ac[q][2] + ac[q][3]) : 0.f;
            if (mat == 0) { const float ss = wave_sum(acc * acc); const float rs = 1.f / sqrtf(ss * (1.f / 64.f) + RMS_EPS);
                const int d = F.lane, dc = d >> 3;
                kc[((size_t)bg * 4 + (i >> 5)) * 2048 + (dc >> 1) * 512 + ((dc & 1) * 32 + (i & 31)) * 8 + (d & 7)] = (f16)(i < NCMP ? acc * rs * F.in[I_KNW][F.lane] : 0.f); }
            else { const int kap = i & 15, pp = ((kap >> 2) & 1) * 8 + (kap >> 3) * 4 + (kap & 3);
                const int d = F.lane;
                vt[((size_t)bg * 4 + (i >> 5)) * 2048 + ((d >> 5) * 2 + ((i >> 4) & 1)) * 512 + ((pp >> 3) * 32 + (d & 31)) * 8 + (pp & 7)] = (f16)acc; } } }
    }
    __syncthreads();
}

__device__ __forceinline__ int t5_bucket(int rel) {
    if (rel < 16) return rel;
    int b = 16;
    b += rel >= 19; b += rel >= 21; b += rel >= 24; b += rel >= 27; b += rel >= 31; b += rel >= 35; b += rel >= 40; b += rel >= 46;
    b += rel >= 52; b += rel >= 59; b += rel >= 67; b += rel >= 77; b += rel >= 87; b += rel >= 99; b += rel >= 113;
    return b;
}
__device__ __forceinline__ int med3i(int a, int lo, int hi) { return a < lo ? lo : (a > hi ? hi : a); }
__device__ __forceinline__ float other_half_max(float x) { const auto r = __builtin_amdgcn_permlane32_swap(__float_as_uint(x), __float_as_uint(x), false, false); return fmaxf(__uint_as_float(r[0]), __uint_as_float(r[1])); }
__device__ __forceinline__ float both_halves_sum(float x) { const auto r = __builtin_amdgcn_permlane32_swap(__float_as_uint(x), __float_as_uint(x), false, false); return __uint_as_float(r[0]) + __uint_as_float(r[1]); }
struct AFrag { u32x4 k[2]; u32x4 v[2]; };
__device__ __forceinline__ void attn_load(AFrag& f, const unsigned char* Kp, const unsigned char* Vp, int kt, int r31, int hh) {
    const unsigned char* kp = Kp + (size_t)kt * 2048 + (hh * 32 + r31) * 16; const unsigned char* vp = Vp + (size_t)kt * 2048 + (hh * 32 + r31) * 16;
#pragma unroll
    for (int j = 0; j < 2; ++j) f.k[j] = *(const GAS u32x4*)(kp + j * 1024);
#pragma unroll
    for (int dt = 0; dt < 2; ++dt) f.v[dt] = *(const GAS u32x4*)(vp + dt * 1024);
}
__device__ __forceinline__ f16x8 pack8(const f32x16& c, int s2) {
    f16x8 o;
#pragma unroll
    for (int j = 0; j < 8; ++j) o[j] = (f16)c[8 * s2 + j];
    return o;
}
__device__ __forceinline__ void attn_tile(const AFrag& f, const long (&bq8)[4], int kt, int t0, int t, int hh, int wlim, unsigned selm, float cfar, const LAS float* lutr,
                                          float& mrun, float& lrun, f32x16& O0, f32x16& O1) {
    f32x16 S;
#pragma unroll
    for (int i = 0; i < 16; ++i) S[i] = 0.f;
#pragma unroll
    for (int ks = 0; ks < 4; ++ks) S = __builtin_amdgcn_mfma_f32_32x32x16_fp8_fp8((ks & 1) ? as_i64(f.k[ks >> 1].z, f.k[ks >> 1].w) : as_i64(f.k[ks >> 1].x, f.k[ks >> 1].y), bq8[ks], S, 0, 0, 0);
    const int k0 = kt * 32, minrel = t0 - (k0 + 31), maxrel = t0 + 7 - k0;
    const bool selbit = ((selm >> (kt >> 1)) & 1u) != 0u;
    float addc = 0.f;
    if (minrel >= 113 && maxrel < wlim) addc = selbit ? cfar : -2e30f;
    else {
        const unsigned wl = selbit ? (unsigned)wlim : 0u; const int relb = t - k0 - 4 * hh;
        float bias[16];
#pragma unroll
        for (int i = 0; i < 16; ++i) bias[i] = lutr[med3i(relb - ((i & 3) + 8 * (i >> 2)), 0, 127)];
#pragma unroll
        for (int i = 0; i < 16; ++i) asm volatile("" : "+v"(bias[i]));
#pragma unroll
        for (int i = 0; i < 16; ++i) { const int rel = relb - ((i & 3) + 8 * (i >> 2)); S[i] = ((unsigned)rel < wl) ? __builtin_fmaf(bias[i], 8.f, S[i]) : -2e30f; }
    }
    float tmax = S[0];
#pragma unroll
    for (int i = 1; i < 16; ++i) tmax = fmaxf(tmax, S[i]);
    tmax = other_half_max(tmax) * 0.125f + addc;
    const float mnew = fmaxf(mrun, tmax), alpha = __builtin_amdgcn_exp2f(mrun - mnew);
    mrun = mnew; lrun *= alpha;
    if (__builtin_amdgcn_ballot_w64(alpha != 1.0f) != 0ull) {
#pragma unroll
        for (int i = 0; i < 16; ++i) { O0[i] = mul_np(O0[i], alpha); O1[i] = mul_np(O1[i], alpha); } }
    const float mm = mnew - addc;
#pragma unroll
    for (int i = 0; i < 16; ++i) { const float pv = __builtin_amdgcn_exp2f(__builtin_fmaf(S[i], 0.125f, -mm)); lrun += pv; S[i] = pv; }
#pragma unroll
    for (int s2 = 0; s2 < 2; ++s2) { const long pb = as_i64(pk_fp8(S[8 * s2], S[8 * s2 + 1], S[8 * s2 + 2], S[8 * s2 + 3]), pk_fp8(S[8 * s2 + 4], S[8 * s2 + 5], S[8 * s2 + 6], S[8 * s2 + 7]));
        O0 = __builtin_amdgcn_mfma_f32_32x32x16_fp8_fp8(s2 ? as_i64(f.v[0].z, f.v[0].w) : as_i64(f.v[0].x, f.v[0].y), pb, O0, 0, 0, 0);
        O1 = __builtin_amdgcn_mfma_f32_32x32x16_fp8_fp8(s2 ? as_i64(f.v[1].z, f.v[1].w) : as_i64(f.v[1].x, f.v[1].y), pb, O1, 0, 0, 0); }
}
__device__ __forceinline__ void attn_branch(const unsigned char* Kp, const unsigned char* Vp, unsigned long long tm, const long (&bq)[4], int t0, int t, int r31, int hh, int wlim, unsigned selm, float cfar,
                                            const LAS float* lutr, float gate, LAS float* TL) {
    float mrun = -1e30f, lrun = 0.f; f32x16 O0, O1;
#pragma unroll
    for (int i = 0; i < 16; ++i) { O0[i] = 0.f; O1[i] = 0.f; }
    AFrag fA, fB;
    int ktA = __builtin_ctzll(tm), ktB;
    attn_load(fA, Kp, Vp, ktA, r31, hh);
    for (;;) {
        tm &= tm - 1; const bool hasB = tm != 0ull; ktB = hasB ? __builtin_ctzll(tm) : ktA; attn_load(fB, Kp, Vp, ktB, r31, hh);
        attn_tile(fA, bq, ktA, t0, t, hh, wlim, selm, cfar, lutr, mrun, lrun, O0, O1);
        if (!hasB) break;
        tm &= tm - 1; const bool hasA = tm != 0ull; ktA = hasA ? __builtin_ctzll(tm) : ktB; attn_load(fA, Kp, Vp, ktA, r31, hh);
        attn_tile(fB, bq, ktB, t0, t, hh, wlim, selm, cfar, lutr, mrun, lrun, O0, O1);
        if (!hasA) break;
    }
    lrun = both_halves_sum(lrun);
    const float sc = gate / fmaxf(lrun, 1e-30f);
#pragma unroll
    for (int i = 0; i < 16; ++i) { TL[i * 64] += O0[i] * sc; TL[(16 + i) * 64] += O1[i] * sc; }
}
__device__ __forceinline__ void p5_attention(Frame& F) {
    unsigned char* ws = F.ws;
    const f16* Y = (const f16*)(ws + WS_Y);
    const float* gates = (const float*)(ws + WS_GATES);
    f16* CAT = (f16*)(ws + WS_CAT);
    LAS float* wl = (LAS float*)(F.lds + F.wave * 8192);
    LAS float* LUT = wl;
    const int gw = F.vcu * NWAVES + F.wave, NW = F.G * NWAVES;
    const bool snake = (8192 % (2 * NW)) == 0, bal = (NW == 2048);
    int lut_g = -1;
    LAS unsigned* SELM = (LAS unsigned*)(wl + 1280);
    for (int it = gw, rr = 0; it < 8192; it += NW, ++rr) {
        int n = (snake && (rr & 1)) ? (rr * NW + (NW - 1 - gw)) : it;
        if (bal) {
            const int xq = gw >> 8, u = gw & 255;
            if (rr < 3) { const int f = rr * 256 + u, q = f / 192; n = (q * 8 + xq) * 256 + 64 + (f - q * 192); }
            else { const int c = u >> 3, w = u & 7, k = (c & 7) * 4 + (w & 3); n = ((c >> 3) * 8 + xq) * 256 + ((w & 4) ? 63 - k : k); } }
        const int bg = n >> 8, pos = n & 255, b = bg >> 2, g = bg & 3, t0 = pos * 8;
        int lane = F.lane; asm volatile("" : "+v"(lane));
        const int r31 = lane & 31, hh = lane >> 5, tok8 = r31 >> 2, r = r31 & 3;
        const LAS float* lutr = LUT + r * 128;
        if (g != lut_g) {
            LDS_WAIT(); asm volatile("" ::: "memory");
#pragma unroll
            for (int e = 0; e < 2; ++e) { const int rel = lane + 64 * e, bk = t5_bucket(rel);
#pragma unroll
                for (int r4 = 0; r4 < 4; ++r4) LUT[r4 * 128 + rel] = F.in[I_RELB][bk * 16 + 4 * g + r4] * LOG2E; }
            LDS_WAIT(); asm volatile("" ::: "memory");
            lut_g = g;
        }
        const int t = t0 + tok8, head = 4 * g + r; const size_t m = (size_t)b * SEQ + t;
        f16x8 bq[4];
#pragma unroll
        for (int ks = 0; ks < 4; ++ks) bq[ks] = *(const GAS f16x8*)((const f16*)(ws + WS_QN) + m * 1024 + head * 64 + ks * 16 + hh * 8);
        long bq8[4];
#pragma unroll
        for (int ks = 0; ks < 4; ++ks) bq8[ks] = as_i64(pk_fp8((float)bq[ks][0] * 8.f, (float)bq[ks][1] * 8.f, (float)bq[ks][2] * 8.f, (float)bq[ks][3] * 8.f),
                                                        pk_fp8((float)bq[ks][4] * 8.f, (float)bq[ks][5] * 8.f, (float)bq[ks][6] * 8.f, (float)bq[ks][7] * 8.f));
        const float g_c = gates[m * 48 + head * 3 + 0], g_s = gates[m * 48 + head * 3 + 1], g_w = gates[m * 48 + head * 3 + 2];
        const float cfar = lutr[127];
        LAS float* TL = (LAS float*)(F.lds + 65536 + F.wave * 8192) + lane;
        {
            const f16* kc = (const f16*)(ws + WS_KCMP) + (size_t)bg * 128 * 64;
            const f16* vc = (const f16*)(ws + WS_VCMPT) + (size_t)bg * 64 * 128;
            f32x16 c[4];
#pragma unroll
            for (int kt = 0; kt < 4; ++kt) {
#pragma unroll
                for (int i = 0; i < 16; ++i) c[kt][i] = 0.f;
#pragma unroll
                for (int ks = 0; ks < 4; ++ks) { const f16x8 a = *(const GAS f16x8*)(kc + kt * 2048 + ks * 512 + (hh * 32 + r31) * 8); c[kt] = __builtin_amdgcn_mfma_f32_32x32x16_f16(a, bq[ks], c[kt], 0, 0, 0); }
                asm volatile("" ::: "memory");
            }
            const int relb = t - 31 - 64 * hh; float mx = -1e30f;
#pragma unroll
            for (int kt = 0; kt < 4; ++kt) { float bias[16];
#pragma unroll
                for (int i = 0; i < 16; ++i) { const int rel = relb - 16 * (kt * 32 + (i & 3) + 8 * (i >> 2)); bias[i] = lutr[med3i(rel, 0, 127)]; }
#pragma unroll
                for (int i = 0; i < 16; ++i) asm volatile("" : "+v"(bias[i]));
#pragma unroll
                for (int i = 0; i < 16; ++i) { const int rel = relb - 16 * (kt * 32 + (i & 3) + 8 * (i >> 2));
                    const float sv = rel >= 0 ? c[kt][i] + bias[i] : -2e30f; c[kt][i] = sv; mx = fmaxf(mx, sv); }
                asm volatile("" ::: "memory"); }
            mx = other_half_max(mx);
            float l = 0.f;
#pragma unroll
            for (int kt = 0; kt < 4; ++kt)
#pragma unroll
                for (int i = 0; i < 16; ++i) { const float pv = __builtin_amdgcn_exp2f(c[kt][i] - mx); c[kt][i] = pv; l += pv; }
            l = both_halves_sum(l);
            const float inv = 1.f / fmaxf(l, 1e-30f);
#pragma unroll
            for (int kt = 0; kt < 4; ++kt)
#pragma unroll
                for (int jj = 0; jj < 4; ++jj) { float own = (2.f * (c[kt][4 * jj] + c[kt][4 * jj + 1] + c[kt][4 * jj + 2]) + c[kt][4 * jj + 3]) * inv, p3 = c[kt][4 * jj + 3] * inv;
                    own += dpp_f<0xB1>(own); own += dpp_f<0x4E>(own); p3 += dpp_f<0xB1>(p3); p3 += dpp_f<0x4E>(p3);
                    if (r == 0) { const int j = kt * 8 + 2 * jj + hh; wl[512 + tok8 * 32 + j] = own; wl[768 + tok8 * 32 + j] = p3; } }
            f32x16 O0, O1;
#pragma unroll
            for (int i = 0; i < 16; ++i) { O0[i] = 0.f; O1[i] = 0.f; }
#pragma unroll
            for (int kt = 0; kt < 4; ++kt)
#pragma unroll
                for (int s2 = 0; s2 < 2; ++s2) { const f16x8 pb = pack8(c[kt], s2);
                    const f16x8 a0 = *(const GAS f16x8*)(vc + kt * 2048 + s2 * 512 + (hh * 32 + r31) * 8), a1 = *(const GAS f16x8*)(vc + kt * 2048 + (2 + s2) * 512 + (hh * 32 + r31) * 8);
                    O0 = __builtin_amdgcn_mfma_f32_32x32x16_f16(a0, pb, O0, 0, 0, 0); O1 = __builtin_amdgcn_mfma_f32_32x32x16_f16(a1, pb, O1, 0, 0, 0); asm volatile("" ::: "memory"); }
            const float sc = inv * g_c;
#pragma unroll
            for (int i = 0; i < 16; ++i) { TL[i * 64] = O0[i] * sc; TL[(16 + i) * 64] = O1[i] * sc; }
        }
        LDS_WAIT(); asm volatile("" ::: "memory");
        int lane2 = lane; asm volatile("" : "+v"(lane2));
        LAS float* OWN = wl + 512 + (lane2 >> 5) * 32 + (lane2 & 31); LAS float* P3 = OWN + 256; LAS float* VAL = OWN + 512;
#pragma unroll
        for (int pp = 0; pp < 4; ++pp) { const int tk = 2 * pp + hh, j = r31, cur = (t0 + tk) >> 6;
            const float impv = OWN[pp * 64] + (j > 0 ? P3[pp * 64 - (j > 0 ? 1 : 0)] : 0.f);
            VAL[pp * 64] = (j == 0 || j == cur || j == cur - 1) ? 1e4f : (j <= cur ? impv : -1e30f); }
        LDS_WAIT(); asm volatile("" ::: "memory");
#pragma unroll
        for (int pp = 0; pp < 4; ++pp) { const int tk = 2 * pp + hh, j = r31, cur = (t0 + tk) >> 6; const float v = VAL[pp * 64]; int cnt = 0; const LAS float* vrow = VAL + pp * 64 - j;
#pragma unroll
            for (int j2 = 0; j2 < 32; ++j2) { const float o = vrow[j2]; cnt += (o > v || (o == v && j2 < j)) ? 1 : 0; }
            const unsigned long long bm = __ballot(cnt < 8 && j <= cur);
            const unsigned mym = hh ? (unsigned)(bm >> 32) : (unsigned)bm;
            if (j == 0) SELM[tk] = mym; }
        LDS_WAIT(); asm volatile("" ::: "memory");
        const unsigned selm = SELM[tok8];
        unsigned um = 0u;
#pragma unroll
        for (int i = 0; i < 8; ++i) um |= SELM[i];
        um = (unsigned)__builtin_amdgcn_readfirstlane((int)um);
        const int kthi = (t0 + 7) >> 5;
        const unsigned long long causal = (kthi >= 63) ? ~0ull : ((1ull << (kthi + 1)) - 1ull);
        {
            unsigned long long x = um;
            x = (x | (x << 16)) & 0x0000FFFF0000FFFFull; x = (x | (x << 8)) & 0x00FF00FF00FF00FFull; x = (x | (x << 4)) & 0x0F0F0F0F0F0F0F0Full;
            x = (x | (x << 2)) & 0x3333333333333333ull; x = (x | (x << 1)) & 0x5555555555555555ull;
            const unsigned long long tm = (x | (x << 1)) & causal;
            attn_branch(ws + WS_KN + (size_t)bg * SEQ * 64, ws + WS_VT + (size_t)bg * 64 * SEQ, tm, bq8, t0, t, r31, hh, 1 << 30, selm, cfar, lutr, g_s, TL);
        }
        {
            const int lo = t0 - 511 > 0 ? (t0 - 511) >> 5 : 0;
            const unsigned long long tm = causal & ~((1ull << lo) - 1ull);
            attn_branch(ws + WS_KN + (size_t)(BATCH * 4 + bg) * SEQ * 64, ws + WS_VT + (size_t)(BATCH * 4 + bg) * 64 * SEQ, tm, bq8, t0, t, r31, hh, 512, 0xFFFFFFFFu, cfar, lutr, g_w, TL);
        }
        unsigned char* orow = ws + WS_CAT + m * D + 1024 + head * 64 + 4 * hh;
#pragma unroll
        for (int jj = 0; jj < 4; ++jj) {
            *(GAS unsigned*)(orow + 8 * jj) = pk_fp8(TL[(4 * jj) * 64] * CAT8SCALE, TL[(4 * jj + 1) * 64] * CAT8SCALE, TL[(4 * jj + 2) * 64] * CAT8SCALE, TL[(4 * jj + 3) * 64] * CAT8SCALE);
            *(GAS unsigned*)(orow + 32 + 8 * jj) = pk_fp8(TL[(16 + 4 * jj) * 64] * CAT8SCALE, TL[(16 + 4 * jj + 1) * 64] * CAT8SCALE, TL[(16 + 4 * jj + 2) * 64] * CAT8SCALE, TL[(16 + 4 * jj + 3) * 64] * CAT8SCALE); }
    }
}

__device__ __forceinline__ void cvt_row_fp6(const f32x4 (&v)[8], int row, unsigned char* dst6, float* scales, int lane, bool pairt) {
    float amax = 0.f;
#pragma unroll
    for (int c = 0; c < 8; ++c) amax = fmaxf(amax, fmaxf(fmaxf(fabsf(v[c].x), fabsf(v[c].y)), fmaxf(fabsf(v[c].z), fabsf(v[c].w))));
    amax = wave_max(amax);
    const float scale = amax > 0.f ? amax * (1.f / 7.5f) : 1.f, inv = 1.f / scale;
    f16x32 h;
#pragma unroll
    for (int c = 0; c < 8; ++c) { h[4 * c] = (f16)(v[c].x * inv); h[4 * c + 1] = (f16)(v[c].y * inv); h[4 * c + 2] = (f16)(v[c].z * inv); h[4 * c + 3] = (f16)(v[c].w * inv); }
    const u32x6 pk = __builtin_amdgcn_cvt_scalef32_pk32_fp6_f16(h, 1.0f);
    unsigned char* d = dst6 + (size_t)(lane >> 3) * SLICE6;
    *(GAS u32x4*)(d + (size_t)row * 128 + (lane & 7) * 16) = (u32x4){pk[0], pk[1], pk[2], pk[3]}; *(GAS u32x2*)(d + 2097152 + (size_t)row * 64 + (pairt ? (lane & 3) * 16 + ((lane >> 2) & 1) * 8 : (lane & 7) * 8)) = (u32x2){pk[4], pk[5]};
    if (lane == 0) scales[row] = scale;
}
__device__ __forceinline__ void cvt_table_fp6(Frame& F, const float* src, unsigned char* dst6, float* scales, const float* colw, bool pairt) {
    const int gw = F.vcu * NWAVES + F.wave, NGW = F.G * NWAVES, lane = F.lane;
    int row = gw;
    for (; row + NGW < 16384; row += 2 * NGW) {
        f32x4 va[8], vb[8];
#pragma unroll
        for (int c = 0; c < 8; ++c) { va[c] = __builtin_nontemporal_load((const GAS f32x4*)(src + (size_t)row * D + c * 256 + lane * 4)); vb[c] = __builtin_nontemporal_load((const GAS f32x4*)(src + (size_t)(row + NGW) * D + c * 256 + lane * 4)); }
        if (colw) {
#pragma unroll
            for (int c = 0; c < 8; ++c) { const f32x4 wv = *(const GAS f32x4*)(colw + c * 256 + lane * 4); va[c] = va[c] * wv; vb[c] = vb[c] * wv; } }
        cvt_row_fp6(va, row, dst6, scales, lane, pairt); cvt_row_fp6(vb, row + NGW, dst6, scales, lane, pairt);
    }
    for (; row < 16384; row += NGW) { f32x4 va[8];
#pragma unroll
        for (int c = 0; c < 8; ++c) { va[c] = *(const GAS f32x4*)(src + (size_t)row * D + c * 256 + lane * 4); if (colw) va[c] = va[c] * *(const GAS f32x4*)(colw + c * 256 + lane * 4); }
        cvt_row_fp6(va, row, dst6, scales, lane, pairt); }
}
__device__ __forceinline__ void p7_tables(Frame& F) {
    cvt_table_fp6(F, F.in[I_PU], F.ws + WS_U6, (float*)(F.ws + WS_SU), F.in[I_FFNNW], true);
    cvt_table_fp6(F, F.in[I_PV], F.ws + WS_V6, (float*)(F.ws + WS_SV), nullptr, false);
}

__device__ __forceinline__ void bitonic_sort16_desc(float (&a)[16]) {
#pragma unroll
    for (int k = 2; k <= 16; k <<= 1)
#pragma unroll
        for (int j = k >> 1; j > 0; j >>= 1)
#pragma unroll
            for (int i = 0; i < 16; ++i) { const int l = i ^ j; if (l > i) { const float hi = fmaxf(a[i], a[l]), lo = fminf(a[i], a[l]); if ((i & k) == 0) { a[i] = hi; a[l] = lo; } else { a[i] = lo; a[l] = hi; } } }
}
__device__ __forceinline__ void bitonic_merge16_desc(float (&a)[16]) {
#pragma unroll
    for (int dist = 8; dist >= 1; dist >>= 1)
#pragma unroll
        for (int i = 0; i < 16; ++i) if ((i & dist) == 0) { const float hi = fmaxf(a[i], a[i + dist]), lo = fminf(a[i], a[i + dist]); a[i] = hi; a[i + dist] = lo; }
}
#define INS16(top, v) do { _Pragma("unroll") for (int _j = 0; _j < 16; ++_j) { const float _h = fmaxf(top[_j], v); v = fminf(top[_j], v); top[_j] = _h; } } while (0)
#define INS16P(tv, ti, v, i) do { _Pragma("unroll") for (int _j = 0; _j < 16; ++_j) { const bool _c = v > tv[_j]; const float _nv = _c ? tv[_j] : v; const unsigned _ni = _c ? ti[_j] : i; \
        tv[_j] = _c ? v : tv[_j]; ti[_j] = _c ? i : ti[_j]; v = _nv; i = _ni; } } while (0)
typedef unsigned v4u_t __attribute__((__vector_size__(16)));
typedef unsigned v2u_t __attribute__((__vector_size__(8)));
__device__ __forceinline__ void p9a_topk(Frame& F) {
    unsigned char* ws = F.ws;
    const f16* QP = (const f16*)(ws + WS_QP); const f16* KEYS = (const f16*)(ws + WS_KEYS);
    unsigned* LIDX = (unsigned*)(ws + WS_LIDX); float* LG = (float*)(ws + WS_LG);
    const int lane = F.lane, r31 = lane & 31, hh = lane >> 5;
    const float NINF = -__builtin_inff();
    for (int unit = F.vcu; unit < M / 32; unit += F.G) {
        const int m0 = unit * 32;
        {
            const int h = F.wave;
            float sl[2][16];
            f16x8 bq[8], ka[8];
#pragma unroll
            for (int ks = 0; ks < 8; ++ks) { bq[ks] = *(const GAS f16x8*)(QP + (size_t)(m0 + r31) * D + (h * 2) * 128 + ks * 16 + hh * 8);
                ka[ks] = *(const GAS f16x8*)(KEYS + ((size_t)((h * 2) * 128 + r31)) * 128 + hh * 8 + ks * 16); }
            float top[16];
#pragma unroll
            for (int st = 0; st < 8; ++st) { const int p = st >> 2, kt = st & 3;
                if (kt == 0) {
#pragma unroll
                    for (int j = 0; j < 16; ++j) top[j] = NINF; }
                f32x16 c;
#pragma unroll
                for (int i = 0; i < 16; ++i) c[i] = 0.f;
#pragma unroll
                for (int ks = 0; ks < 8; ++ks) c = __builtin_amdgcn_mfma_f32_32x32x16_f16(ka[ks], bq[ks], c, 0, 0, 0);
                if (st + 1 < 8) { const int pn = (st + 1) >> 2, ktn = (st + 1) & 3;
#pragma unroll
                    for (int ks = 0; ks < 8; ++ks) ka[ks] = *(const GAS f16x8*)(KEYS + ((size_t)((h * 2 + pn) * 128 + ktn * 32 + r31)) * 128 + hh * 8 + ks * 16);
                    if (st == 3) {
#pragma unroll
                        for (int ks = 0; ks < 8; ++ks) bq[ks] = *(const GAS f16x8*)(QP + (size_t)(m0 + r31) * D + (h * 2 + 1) * 128 + ks * 16 + hh * 8); } }
                const unsigned k4 = (unsigned)(kt * 32 + 4 * hh);
                float nv[16];
#pragma unroll
                for (int reg = 0; reg < 16; ++reg) { const unsigned key = k4 + (unsigned)((reg & 3) + 8 * (reg >> 2)); nv[reg] = __uint_as_float((__float_as_uint(c[reg]) & ~127u) | key); }
                bitonic_sort16_desc(nv);
#pragma unroll
                for (int j = 0; j < 16; ++j) top[j] = fmaxf(top[j], nv[15 - j]);
                bitonic_merge16_desc(top);
                if (kt == 3) {
                    float cm[16];
#pragma unroll
                    for (int j = 0; j < 16; ++j) cm[j] = fmaxf(top[j], __uint_as_float(other32u(__float_as_uint(top[15 - j]), hh != 0)));
                    bitonic_merge16_desc(cm);
#pragma unroll
                    for (int j = 0; j < 16; ++j) sl[p][j] = cm[j]; }
            }
            float vx[16], vy[16]; unsigned ix[16], iy[16];
#pragma unroll
            for (int j = 0; j < 16; ++j) { const unsigned bx = __float_as_uint(hh ? sl[1][j] : sl[0][j]), by = __float_as_uint(hh ? sl[0][j] : sl[1][j]);
                vx[j] = __uint_as_float(bx & ~127u); vy[j] = __uint_as_float(by & ~127u); ix[j] = (bx & 127u) * (hh ? 1u : 128u); iy[j] = (by & 127u) * (hh ? 128u : 1u); }
            float tv[16]; unsigned ti[16];
#pragma unroll
            for (int j = 0; j < 16; ++j) { const int jb = j + 1 < 16 ? j + 1 : 15;
                const float v0 = vx[0] + vy[j], v1 = (j < 15) ? vx[0] + vy[jb] : NINF; const unsigned i0 = ix[0] + iy[j], i1 = ix[0] + iy[jb];
                tv[j] = hh ? v1 : v0; ti[j] = hh ? i1 : i0; }
#pragma unroll
            for (int a = 1; a < 4; ++a) { const int bmax = (a == 1) ? 7 : (a == 2 ? 4 : 3);
#pragma unroll
                for (int b = a; b <= bmax; ++b) { float v = vx[a] + vy[b]; if (a == b) v = hh ? NINF : v; unsigned i = ix[a] + iy[b]; INS16P(tv, ti, v, i); } }
            float mv[16]; unsigned mi[16];
#pragma unroll
            for (int j = 0; j < 16; ++j) { const float pv = __uint_as_float(other32u(__float_as_uint(tv[15 - j]), hh != 0)); const unsigned pi = other32u(ti[15 - j], hh != 0); const bool c = pv > tv[j]; mv[j] = c ? pv : tv[j]; mi[j] = c ? pi : ti[j]; }
            float mx = mv[0];
#pragma unroll
            for (int j = 1; j < 16; ++j) mx = fmaxf(mx, mv[j]);
            float sum = 0.f;
#pragma unroll
            for (int j = 0; j < 16; ++j) { mv[j] = __builtin_amdgcn_exp2f((mv[j] - mx) * LOG2E); sum += mv[j]; }
            const float inv = 1.f / sum;
#pragma unroll
            for (int j = 0; j < 8; ++j) { { const int e_ = h * 16 + hh * 8 + j, pos_ = (e_ & 63) * 2 + (e_ >> 6); LIDX[(size_t)(m0 + r31) * 128 + pos_] = mi[j]; LG[(size_t)(m0 + r31) * 128 + pos_] = mv[j] * inv; } }
        }
    }
}
struct Seg6 { v4u_t a; v2u_t b; };
__device__ __forceinline__ f16x32 seg6_decode(const Seg6& r) { const u32x6 p = {r.a[0], r.a[1], r.a[2], r.a[3], r.b[0], r.b[1]}; return __builtin_amdgcn_cvt_scalef32_pk32_f16_fp6(p, 1.0f); }
__device__ __forceinline__ f16x32 seg6_dec2(const v4u_t& a, const v2u_t& b) { const u32x6 p = {a[0], a[1], a[2], a[3], b[0], b[1]}; return __builtin_amdgcn_cvt_scalef32_pk32_f16_fp6(p, 1.0f); }
#define SEG_DECL(P) v4u_t P##a0, P##a1, P##a2, P##a3, P##a4, P##a5, P##a6, P##a7; v2u_t P##b0, P##b1, P##b2, P##b3, P##b4, P##b5, P##b6, P##b7
#define SEG_L1(P, G, idxv) do { const int e_ = __shfl(idxv, 8 * G + sub); P##a##G = __builtin_amdgcn_raw_buffer_load_b128(rs, e_ * 128 + ch * 16, 0, 0); P##b##G = __builtin_amdgcn_raw_buffer_load_b64(rs, 2097152 + e_ * 64 + ch * 8, 0, 0); } while (0)
#define SEG_LOAD(P, idxv) do { SEG_L1(P, 0, idxv); SEG_L1(P, 1, idxv); SEG_L1(P, 2, idxv); SEG_L1(P, 3, idxv); SEG_L1(P, 4, idxv); SEG_L1(P, 5, idxv); SEG_L1(P, 6, idxv); SEG_L1(P, 7, idxv); } while (0)
__device__ __forceinline__ float u_one(const v4u_t& a, const v2u_t& b, const f16x2 (&xp)[16]) {
    const f16x32 hv = seg6_dec2(a, b); float sdot = 0.f;
#pragma unroll
    for (int k = 0; k < 16; ++k) { f16x2 hp; hp.x = hv[2 * k]; hp.y = hv[2 * k + 1]; sdot = __builtin_amdgcn_fdot2(hp, xp[k], sdot, false); }
    return sum8(sdot);
}
#define SEG_LE(P, G, ev) do { const int e_ = (ev); P##a##G = __builtin_amdgcn_raw_buffer_load_b128(rs, e_ * 128 + ch * 16, 0, 0); P##b##G = __builtin_amdgcn_raw_buffer_load_b64(rs, 2097152 + e_ * 64 + ch * 8, 0, 0); } while (0)
#define EN_GATHER(en, iA, iB) do { _Pragma("unroll") for (int g_ = 0; g_ < 8; ++g_) { en[g_] = __shfl(iA, 8 * g_ + sub); en[8 + g_] = __shfl(iB, 8 * g_ + sub); } } while (0)
#define U_ROLL1(P, G, res, eo) do { const float d_ = u_one(P##a##G, P##b##G, xp); res = (ch == G) ? d_ : res; SEG_LE(P, G, en[(eo) + G]); } while (0)
#define U_ROLL(P, res, idxn) do { U_ROLL1(P, 0, res, idxn); U_ROLL1(P, 1, res, idxn); U_ROLL1(P, 2, res, idxn); U_ROLL1(P, 3, res, idxn); U_ROLL1(P, 4, res, idxn); U_ROLL1(P, 5, res, idxn); U_ROLL1(P, 6, res, idxn); U_ROLL1(P, 7, res, idxn); } while (0)
#define V_ROLL1(P, G, hwv, eo) do { v_one(P##a##G, P##b##G, acc, hq[(eo) + G]); SEG_LE(P, G, en[(eo) + G]); } while (0)
#define V_ROLL(P, hwv, idxn) do { V_ROLL1(P, 0, hwv, idxn); V_ROLL1(P, 1, hwv, idxn); V_ROLL1(P, 2, hwv, idxn); V_ROLL1(P, 3, hwv, idxn); V_ROLL1(P, 4, hwv, idxn); V_ROLL1(P, 5, hwv, idxn); V_ROLL1(P, 6, hwv, idxn); V_ROLL1(P, 7, hwv, idxn); } while (0)
#define FMIXV_LO(a, h, w) asm("v_fma_mix_f32 %0, %1, %2, %0 op_sel_hi:[1,0,0]" : "+v"(a) : "v"(h), "v"(w))
#define FMIXV_HI(a, h, w) asm("v_fma_mix_f32 %0, %1, %2, %0 op_sel:[1,0,0] op_sel_hi:[1,0,0]" : "+v"(a) : "v"(h), "v"(w))
__device__ __forceinline__ void v_one(const v4u_t& a, const v2u_t& b, f16x2 (&acc)[16], f16x2 wq) {
    const f16x32 hv = seg6_dec2(a, b);
#pragma unroll
    for (int k = 0; k < 16; ++k) { f16x2 hp; hp.x = hv[2 * k]; hp.y = hv[2 * k + 1]; acc[k] = __builtin_elementwise_fma(hp, wq, acc[k]); }
}
#define V_HALF(P, hwv) do { v_one(P##a0, P##b0, acc, hwv, sub); v_one(P##a1, P##b1, acc, hwv, 8 + sub); v_one(P##a2, P##b2, acc, hwv, 16 + sub); v_one(P##a3, P##b3, acc, hwv, 24 + sub); \
        v_one(P##a4, P##b4, acc, hwv, 32 + sub); v_one(P##a5, P##b5, acc, hwv, 40 + sub); v_one(P##a6, P##b6, acc, hwv, 48 + sub); v_one(P##a7, P##b7, acc, hwv, 56 + sub); } while (0)
#define WSEG_DECL(P) v4u_t P##h0, P##h1, P##h2, P##h3, P##g0, P##g1, P##g2, P##g3, P##t0, P##t1, P##t2, P##t3
#define WSEG_LE(P, G, ev) do { const int e_ = (ev); P##h##G = __builtin_amdgcn_raw_buffer_load_b128(rs, e_ * 128 + q4 * 16, 0, 0); P##g##G = __builtin_amdgcn_raw_buffer_load_b128(rs, e_ * 128 + 64 + q4 * 16, 0, 0); \
        P##t##G = __builtin_amdgcn_raw_buffer_load_b128(rs, 2097152 + e_ * 64 + q4 * 16, 0, 0); } while (0)
#define WSEG_LOAD(P, idxv) do { WSEG_LE(P, 0, __shfl(idxv, sub16)); WSEG_LE(P, 1, __shfl(idxv, 16 + sub16)); WSEG_LE(P, 2, __shfl(idxv, 32 + sub16)); WSEG_LE(P, 3, __shfl(idxv, 48 + sub16)); } while (0)
#define WEN_GATHER(en, iA, iB) do { _Pragma("unroll") for (int g_ = 0; g_ < 4; ++g_) { en[g_] = __shfl(iA, 16 * g_ + sub16); en[4 + g_] = __shfl(iB, 16 * g_ + sub16); } } while (0)
__device__ __forceinline__ float u_one2(const v4u_t& h, const v4u_t& g, const v4u_t& t, const f16x2 (&xp)[32]) {
    const f16x32 h0 = seg6_dec2(h, (v2u_t){t[0], t[1]}), h1 = seg6_dec2(g, (v2u_t){t[2], t[3]}); float sdot = 0.f;
#pragma unroll
    for (int k = 0; k < 16; ++k) { f16x2 hp; hp.x = h0[2 * k]; hp.y = h0[2 * k + 1]; sdot = __builtin_amdgcn_fdot2(hp, xp[k], sdot, false); }
#pragma unroll
    for (int k = 0; k < 16; ++k) { f16x2 hp; hp.x = h1[2 * k]; hp.y = h1[2 * k + 1]; sdot = __builtin_amdgcn_fdot2(hp, xp[16 + k], sdot, false); }
    sdot += dpp_f<0xB1>(sdot); sdot += dpp_f<0x4E>(sdot);
    return sdot;
}
#define WU_ROLL1(P, G, res, eo) do { const float d_ = u_one2(P##h##G, P##g##G, P##t##G, xp); res = (q4 == G) ? d_ : res; WSEG_LE(P, G, en[(eo) + G]); __builtin_amdgcn_sched_barrier(0); } while (0)
#define WU_ROLL(P, res, idxn) do { WU_ROLL1(P, 0, res, idxn); WU_ROLL1(P, 1, res, idxn); WU_ROLL1(P, 2, res, idxn); WU_ROLL1(P, 3, res, idxn); } while (0)
__device__ __forceinline__ void p9b_upass(Frame& F, bool probe_slice0) {
    unsigned char* ws = F.ws;
    const int x = blockIdx.x & 7, rank = blockIdx.x >> 3, cnt = (F.G - x + 7) >> 3;
    const int lane = F.lane, sub16 = lane >> 2, q4 = lane & 3;
    const __amdgpu_buffer_rsrc_t rs = __builtin_amdgcn_make_buffer_rsrc((void*)(ws + WS_U6 + (size_t)(probe_slice0 ? 0 : x) * SLICE6), 0, (int)SLICE6, 0x00020000);
    const f16* XN = (const f16*)(ws + WS_XR) + x * 32 + (lane >> 3) * 256 + (lane & 7) * 4;
    const u32x2* LI2 = (const u32x2*)(ws + WS_LIDX); LAS unsigned char* xl = F.lds + F.wave * 512;
    const int tstep = cnt * NWAVES; int t = rank * NWAVES + F.wave;
    if (t >= M) return;
    int cA, cB, nA, nB; { const u32x2 c2 = LI2[(size_t)t * 64 + lane]; cA = (int)c2.x; cB = (int)c2.y; }
    const int t1c = (t + tstep < M) ? t + tstep : t;
    { const u32x2 n2 = LI2[(size_t)t1c * 64 + lane]; nA = (int)n2.x; nB = (int)n2.y; }
    u32x2 xcur = *(const GAS u32x2*)(XN + (size_t)t * D);
    f16x2 xp[32];
    WSEG_DECL(bA); WSEG_DECL(bB);
    { const int li_ = cA; WSEG_LOAD(bA, li_); } { const int li_ = cB; WSEG_LOAD(bB, li_); }
#pragma unroll 1
    for (;;) {
        const int tn = t + tstep, tnn = tn + tstep; const bool hn = tn < M, hnn = tnn < M;
        const int tnc = hn ? tn : t, tnnc = hnn ? tnn : t;
        const u32x2 m2 = LI2[(size_t)tnnc * 64 + lane]; const int mA = (int)m2.x, mB = (int)m2.y;
        const u32x2 xnext = *(const GAS u32x2*)(XN + (size_t)tnc * D);
        *(LAS u32x2*)(xl + ((lane & 7) * 8 + (lane >> 3)) * 8) = xcur;
        LDS_WAIT(); asm volatile("" ::: "memory");
#pragma unroll
        for (int hc = 0; hc < 2; ++hc)
#pragma unroll
            for (int q = 0; q < 4; ++q) { const u32x4 tv = *(const LAS u32x4*)(xl + (q4 + 4 * hc) * 64 + q * 16); xp[16 * hc + 4 * q] = ash2(tv.x); xp[16 * hc + 4 * q + 1] = ash2(tv.y); xp[16 * hc + 4 * q + 2] = ash2(tv.z); xp[16 * hc + 4 * q + 3] = ash2(tv.w); }
        LDS_WAIT(); asm volatile("" ::: "memory");
        { const int lA_ = hn ? nA : cA, lB_ = hn ? nB : cB; int en[8]; WEN_GATHER(en, lA_, lB_);
          float rA = 0.f, rB = 0.f; WU_ROLL(bA, rA, 0); WU_ROLL(bB, rB, 4);
          float* pd = (float*)(ws + WS_PD) + ((size_t)t * 8 + x) * 128 + 16 * q4 + sub16; pd[0] = rA; pd[64] = rB; }
        if (!hn) break;
        xcur = xnext;
        cA = nA; cB = nB; nA = mA; nB = mB; t = tn;
    }
}
__device__ __forceinline__ void p9h_weights(Frame& F) {
    unsigned char* ws = F.ws;
    const unsigned* LIDX = (const unsigned*)(ws + WS_LIDX); const float* LG = (const float*)(ws + WS_LG); const float* PD = (const float*)(ws + WS_PD);
    const float* SU = (const float*)(ws + WS_SU); const float* SV = (const float*)(ws + WS_SV); float* HW = (float*)(ws + WS_HW);
    const int gw = F.vcu * NWAVES + F.wave, NGW = F.G * NWAVES, lane = F.lane;
#pragma unroll 1
    for (int t0 = gw; t0 < M; t0 += 2 * NGW) {
        const int t1 = t0 + NGW < M ? t0 + NGW : t0;
        int iA[2], iB[2]; float pa[2][8], pb[2][8], lgA[2], lgB[2], s1[2];
#pragma unroll
        for (int q = 0; q < 2; ++q) { const int t = q ? t1 : t0; { const u32x2 i2 = ((const u32x2*)LIDX)[(size_t)t * 64 + lane]; iA[q] = (int)i2.x; iB[q] = (int)i2.y; }
#pragma unroll
            for (int xs = 0; xs < 8; ++xs) { pa[q][xs] = PD[((size_t)t * 8 + xs) * 128 + lane]; pb[q][xs] = PD[((size_t)t * 8 + xs) * 128 + 64 + lane]; }
            { const f32x2 g2 = ((const f32x2*)LG)[(size_t)t * 64 + lane]; lgA[q] = g2.x; lgB[q] = g2.y; } s1[q] = ((const float*)(ws + WS_SS1))[t]; }
#pragma unroll
        for (int q = 0; q < 2; ++q) { const int t = q ? t1 : t0; float zA = 0.f, zB = 0.f;
#pragma unroll
            for (int xs = 0; xs < 8; ++xs) { zA += pa[q][xs]; zB += pb[q][xs]; }
            const float rs1 = 1.f / sqrtf(s1[q] * (1.f / D) + RMS_EPS);
            ((f32x2*)HW)[(size_t)t * 64 + lane] = (f32x2){pg8::gelu1(zA * rs1 * SU[iA[q]]) * lgA[q] * SV[iA[q]], pg8::gelu1(zB * rs1 * SU[iB[q]]) * lgB[q] * SV[iB[q]]}; }
    }
}
__device__ __forceinline__ void p9c_vpass(Frame& F) {
    unsigned char* ws = F.ws;
    const int x = blockIdx.x & 7, rank = blockIdx.x >> 3, cnt = (F.G - x + 7) >> 3;
    const int lane = F.lane, sub = lane >> 3, ch = lane & 7;
    const __amdgpu_buffer_rsrc_t rs = __builtin_amdgcn_make_buffer_rsrc((void*)(ws + WS_V6 + (size_t)x * SLICE6), 0, (int)SLICE6, 0x00020000);
    const u32x2* LI2 = (const u32x2*)(ws + WS_LIDX);
    f16* XR = (f16*)(ws + WS_XR); float* SS2 = (float*)(ws + WS_SS2);
    const bool b3 = (lane & 8) != 0, b4 = (lane & 16) != 0, b5 = (lane & 32) != 0;
    const int col = ((b3 ? 4 : 0) + (b4 ? 2 : 0) + (b5 ? 1 : 0)) * 256 + x * 32 + ch * 4;
    const int tstep = cnt * NWAVES; int t = rank * NWAVES + F.wave;
    if (t >= M) return;
    int cA, cB, nA, nB; { const u32x2 c2 = LI2[(size_t)t * 64 + lane]; cA = (int)c2.x; cB = (int)c2.y; }
    const int t1c = (t + tstep < M) ? t + tstep : t;
    { const u32x2 n2 = LI2[(size_t)t1c * 64 + lane]; nA = (int)n2.x; nB = (int)n2.y; }
    const f32x2* HW2 = (const f32x2*)(ws + WS_HW);
    float hwA, hwB; { const f32x2 h2 = HW2[(size_t)t * 64 + lane]; hwA = h2.x; hwB = h2.y; }
    SEG_DECL(bA); SEG_DECL(bB);
    { const int li_ = cA; SEG_LOAD(bA, li_); } { const int li_ = cB; SEG_LOAD(bB, li_); }
#pragma unroll 1
    for (;;) {
        const int tn = t + tstep, tnn = tn + tstep; const bool hn = tn < M, hnn = tnn < M;
        const int tnc = hn ? tn : t, tnnc = hnn ? tnn : t;
        const u32x2 m2 = LI2[(size_t)tnnc * 64 + lane]; const int mA = (int)m2.x, mB = (int)m2.y;
        const f32x2 hn2 = HW2[(size_t)tnc * 64 + lane]; const float hwAn = hn2.x, hwBn = hn2.y;
        f16* orow = XR + (size_t)t * D + col; const u32x2 x1r = *(const GAS u32x2*)orow;
        f16x2 acc[16];
#pragma unroll
        for (int i = 0; i < 16; ++i) { acc[i].x = (f16)0.f; acc[i].y = (f16)0.f; }
        { const int lA_ = hn ? nA : cA, lB_ = hn ? nB : cB; int en[16]; EN_GATHER(en, lA_, lB_); f16x2 hq[16];
#pragma unroll
          for (int g_ = 0; g_ < 8; ++g_) { const float qa = __shfl(hwA, 8 * g_ + sub) * 64.f, qb = __shfl(hwB, 8 * g_ + sub) * 64.f;
              hq[g_].x = (f16)qa; hq[g_].y = (f16)qa; hq[8 + g_].x = (f16)qb; hq[8 + g_].y = (f16)qb; }
          V_ROLL(bA, hwA, 0); V_ROLL(bB, hwB, 8); }
        f16x2 q8[8];
#pragma unroll
        for (int i = 0; i < 8; ++i) { const f16x2 keep = b3 ? acc[8 + i] : acc[i], send = b3 ? acc[i] : acc[8 + i]; q8[i] = keep + ash2(other8u(__builtin_bit_cast(unsigned, send))); }
        f16x2 q4[4];
#pragma unroll
        for (int i = 0; i < 4; ++i) { const f16x2 keep = b4 ? q8[4 + i] : q8[i], send = b4 ? q8[i] : q8[4 + i]; q4[i] = keep + ash2(other16u(__builtin_bit_cast(unsigned, send), b4)); }
        float r4[4];
        { const f16x2 k0 = b5 ? q4[2] : q4[0], k1 = b5 ? q4[3] : q4[1], s0 = b5 ? q4[0] : q4[2], s1 = b5 ? q4[1] : q4[3];
          const f16x2 p0 = ash2(other32u(__builtin_bit_cast(unsigned, s0), b5)), p1 = ash2(other32u(__builtin_bit_cast(unsigned, s1), b5));
          r4[0] = ((float)k0.x + (float)p0.x) * (1.f / 64.f); r4[1] = ((float)k0.y + (float)p0.y) * (1.f / 64.f); r4[2] = ((float)k1.x + (float)p1.x) * (1.f / 64.f); r4[3] = ((float)k1.y + (float)p1.y) * (1.f / 64.f); }
        const f16x2 x1a = ash2(x1r.x), x1b = ash2(x1r.y);
        const f32x4 x2 = {(float)x1a.x + r4[0], (float)x1a.y + r4[1], (float)x1b.x + r4[2], (float)x1b.y + r4[3]};
        { u32x2 o2; o2.x = pk_f16(x2.x, x2.y); o2.y = pk_f16(x2.z, x2.w); *(GAS u32x2*)orow = o2; }
        *(GAS unsigned*)(ws + WS_X8 + (size_t)t * D + col) = pk_fp8(x2.x, x2.y, x2.z, x2.w);
        const float ss = wave_sum((x2.x * x2.x + x2.y * x2.y) + (x2.z * x2.z + x2.w * x2.w));
        if (lane == 0) atomicAdd(SS2 + t, ss);
        if (!hn) break;
        cA = nA; cB = nB; nA = mA; nB = mB; t = tn; hwA = hwAn; hwB = hwBn;
    }
}
#undef FMIXV_LO
#undef FMIXV_HI

constexpr int NPH = 13;
struct Args { const float* in[26]; float* out; unsigned char* ws; int ph_lo, ph_hi; int rep[16]; };
__global__ void __launch_bounds__(NWAVES * 64, 2) fwd_kernel(Args args) {
    extern __shared__ __attribute__((aligned(16))) unsigned char lds[];
    Frame F;
    F.lds = (LAS unsigned char*)lds;
    F.MISC = (volatile LAS unsigned*)(F.lds + MISC_OFF);
    F.tid = threadIdx.x; F.lane = F.tid & 63; F.wave = __builtin_amdgcn_readfirstlane(F.tid >> 6);
#define PHASE_LANES() do { int t_ = threadIdx.x; asm volatile("" : "+v"(t_)); F.tid = t_; F.lane = t_ & 63; } while (0)
    F.G = gridDim.x; { const int bx = blockIdx.x; F.vcu = (F.G % 8 == 0) ? (bx % 8) * (F.G / 8) + bx / 8 : bx; }
#pragma unroll
    for (int i = 0; i < 26; ++i) F.in[i] = args.in[i];
    F.out = args.out; F.ws = args.ws;
    unsigned char* ws = args.ws;
    gu32* ctl = (gu32*)(ws + WS_CTL);
    for (int u = F.tid; u < (LDS_BYTES - LDSCTL_OFF) / 4; u += NWAVES * 64) ((LAS unsigned*)(F.lds + LDSCTL_OFF))[u] = 0u;
    __syncthreads();
    XcdBarrier bar; bar.bar = (unsigned*)(ctl + CW_BAR); bar.x = 0; bar.st = nullptr;
    if (MK_ONE_LAUNCH) bar = xcd_barrier_post((unsigned*)(ctl + CW_BAR), F.MISC + 8);
#define GRID_BAR() do { if (MK_ONE_LAUNCH) xcd_barrier(bar); } while (0)
    const int lo = args.ph_lo, hi = args.ph_hi;
#define IN(k) (lo <= (k) && (k) < hi)
#define BOTH(k) (IN(k) && IN((k) + 1))

    if (IN(0)) { PHASE_LANES(); for (int rp = 0; rp < args.rep[0]; ++rp) p0_prologue(F); if (BOTH(0)) GRID_BAR(); }

    if (IN(1)) {
        pg8::Gemm g{(const f16*)(ws + WS_XR), (const f16*)(ws + WS_WIN), M, NINP, D, D, D, 0, 1 << 30, 0};
        pg8::StaticOrder S; S.init(M, NINP, F.G, (int)blockIdx.x);
        pg8::EpiF16Row E{(f16*)(ws + WS_Y), NINP, (const float*)(ws + WS_SS0)};
        pg8::gemm_phase(F.lds, g, S, E);
        if (BOTH(1)) GRID_BAR();
    }

    if (IN(2)) { PHASE_LANES(); for (int rp = 0; rp < PROBE_REP2; ++rp) p2_post(F); if (BOTH(2)) GRID_BAR(); }

    if (IN(3)) {
        { pg8::Gemm g{(const f16*)(ws + WS_FLATA), (const f16*)(ws + WS_W1C), 8192, 1024, 512, D, D, 512, 16, (size_t)256 * D * 2, 512};
          pg8::StaticOrder S; S.init(8192, 1024, F.G, (int)blockIdx.x);
          pg8::EpiRawF32 E{(float*)(ws + WS_Y), 1024};
          pg8::gemm_phase(F.lds, g, S, E); }
        { pg8::Gemm g{(const f16*)(ws + WS_MIXED), (const f16*)(ws + WS_POOLT), M, 1024, 256, 1024, 256, 256, 1 << 30, 0};
          pg8::StaticOrder S; S.init(M, 1024, F.G, (int)((blockIdx.x + 128) % F.G));
          pg8::EpiF8 E{ws + WS_CAT, D, CAT8SCALE};
          pg8::gemm_phase(F.lds, g, S, E); }
        if (BOTH(3)) GRID_BAR();
    }

    if (IN(4)) { PHASE_LANES(); p4_compress2(F); if (BOTH(4)) GRID_BAR(); }

    if (IN(5)) { PHASE_LANES(); for (int rp = 0; rp < args.rep[5]; ++rp) p5_attention(F); if (BOTH(5)) GRID_BAR(); }

    if (IN(6)) {
        pg8::Gemm g{ws + WS_CAT, ws + WS_WOUT, M, D, D, D, D, 0, 1 << 30, 0, 0, 1};
        pg8::StaticOrder S; S.init(M, D, F.G, (int)blockIdx.x);
        pg8::EpiRes16 E{(f16*)(ws + WS_XR), (float*)(ws + WS_SS1), 1.f / (W8SCALE * CAT8SCALE)};
        pg8::gemm_phase<pg8::EpiRes16, pg8::StaticOrder, true>(F.lds, g, S, E);
        if (BOTH(6)) GRID_BAR();
    }

    if (IN(7)) {
        { pg8::Gemm g{(const f16*)(ws + WS_XR), (const f16*)(ws + WS_WQ), M, D, D, D, D, 0, 1 << 30, 0};
          pg8::StaticOrder S; S.init(M, D, F.G, (int)blockIdx.x);
          pg8::EpiF16Row E{(f16*)(ws + WS_QP), D, (const float*)(ws + WS_SS1)};
          pg8::gemm_phase(F.lds, g, S, E); }
        { pg8::Gemm g{(const f16*)(ws + WS_P16), (const f16*)(ws + WS_WPJ), M, D, 256, 256, 256, 0, 1 << 30, 0};
          pg8::StaticOrder S; S.init(M, D, F.G, (int)blockIdx.x);
          pg8::EpiF16<0> E{(f16*)(ws + WS_PJ), D, nullptr, 1 << 30, 0};
          pg8::gemm_phase(F.lds, g, S, E); }
        if (BOTH(7)) GRID_BAR();
    }

    if (IN(8)) { PHASE_LANES();
#pragma unroll 1
        for (int step = 0; step < 2; ++step) { PHASE_LANES(); if ((step == 0) == (F.wave < 4)) p7_tables(F); else p9a_topk(F); }
        if (BOTH(8)) GRID_BAR(); }
    if (IN(9)) { PHASE_LANES(); if (PROBE_DUPU) p9b_upass(F, false); p9b_upass(F, false); if (BOTH(9)) GRID_BAR(); }
    if (IN(10)) { PHASE_LANES(); p9h_weights(F); if (BOTH(10)) GRID_BAR(); }
    if (IN(11)) { PHASE_LANES(); p9c_vpass(F); if (BOTH(11)) GRID_BAR(); }

    if (IN(12)) {
        pg8::Gemm g{ws + WS_X8, ws + WS_WG, M, D, D, D, D, 0, 1 << 30, 0, 0, 1};
        pg8::StaticOrder S; S.init(M, D, F.G, (int)blockIdx.x);
        pg8::EpiFinal E{(const f16*)(ws + WS_XR), (const f16*)(ws + WS_PJ), F.out, (const float*)(ws + WS_SS2), 1.f / W8SCALE};
        pg8::gemm_phase<pg8::EpiFinal, pg8::StaticOrder, true>(F.lds, g, S, E);
    }
#undef IN
#undef BOTH
}

extern "C" void kernel_launch(void* const* d_in, const int* in_sizes, int n_in, void* d_out, int out_size, void* d_ws, size_t ws_size, hipStream_t stream) {
    static int grid = 0;
    if (grid == 0) {
        if (n_in != 26 || out_size != M * D || ws_size < WS_END) { fprintf(stderr, "kernel_launch: unexpected sizes n_in %d out %d ws %zu\n", n_in, out_size, ws_size); grid = -1; return; }
        int dev = 0, cus = 0, per_cu = 0;
        if (hipGetDevice(&dev) != hipSuccess || hipDeviceGetAttribute(&cus, hipDeviceAttributeMultiprocessorCount, dev) != hipSuccess) { grid = -1; return; }
        if (hipFuncSetAttribute((const void*)fwd_kernel, hipFuncAttributeMaxDynamicSharedMemorySize, LDS_BYTES) != hipSuccess) { fprintf(stderr, "kernel_launch: hipFuncSetAttribute failed\n"); grid = -1; return; }
        if (hipOccupancyMaxActiveBlocksPerMultiprocessor(&per_cu, (const void*)fwd_kernel, NWAVES * 64, LDS_BYTES) != hipSuccess || per_cu < 1)
            fprintf(stderr, "kernel_launch: occupancy query reports %d\n", per_cu);
        (void)hipGetLastError();
        grid = cus;
    }
    if (grid < 0) return;
    (void)hipMemsetAsync((char*)d_ws + WS_CTL, 0, CTL_ZERO_BYTES, stream);
    Args a{};
    for (int i = 0; i < 16; ++i) a.rep[i] = 1;
    a.rep[5] = PROBE_REP5; a.rep[0] = PROBE_REP0; a.rep[7] = PROBE_REP7;
    for (int i = 0; i < 26; ++i) a.in[i] = (const float*)d_in[i];
    a.out = (float*)d_out; a.ws = (unsigned char*)d_ws;
    if (MK_ONE_LAUNCH) { a.ph_lo = 0; a.ph_hi = NPH; hipLaunchKernelGGL(fwd_kernel, dim3(grid), dim3(NWAVES * 64), LDS_BYTES, stream, a); }
    else for (int p = 0; p < NPH; ++p) { a.ph_lo = p; a.ph_hi = p + 1; hipLaunchKernelGGL(fwd_kernel, dim3(grid), dim3(NWAVES * 64), LDS_BYTES, stream, a); }
}
```

```cpp
#include <hip/hip_runtime.h>
#include <cstdio>
#include <cstdint>

#define PROBE_REP0 1
#define PROBE_REP2 1
#define PROBE_DUPU 0
#define PROBE_REP5 1
#define PROBE_REP7 1
#define PROBE_REP9 1
#ifndef MK_ONE_LAUNCH
#define MK_ONE_LAUNCH 1
#endif

#define GAS __attribute__((address_space(1)))
#define LAS __attribute__((address_space(3)))
typedef _Float16 f16;
typedef _Float16 f16x8 __attribute__((ext_vector_type(8)));
typedef _Float16 f16x4 __attribute__((ext_vector_type(4)));
typedef _Float16 f16x2 __attribute__((ext_vector_type(2)));
typedef float f32x2 __attribute__((ext_vector_type(2)));
typedef float f32x4 __attribute__((ext_vector_type(4)));
typedef float f32x16 __attribute__((ext_vector_type(16)));
typedef unsigned u32x2 __attribute__((ext_vector_type(2)));
typedef unsigned u32x4 __attribute__((ext_vector_type(4)));
typedef GAS unsigned gu32;
typedef _Float16 f16x32 __attribute__((ext_vector_type(32)));
typedef unsigned u32x6 __attribute__((ext_vector_type(6)));
#define RLX_AGENT __ATOMIC_RELAXED, __HIP_MEMORY_SCOPE_AGENT
#define LDS_WAIT() asm volatile("s_waitcnt lgkmcnt(0)" ::: "memory")
__device__ __forceinline__ float mul_np(float a, float b) { float o; asm("v_mul_f32 %0, %1, %2" : "=v"(o) : "v"(a), "v"(b)); return o; }
__device__ __forceinline__ float add_np(float a, float b) { float o; asm("v_add_f32 %0, %1, %2" : "=v"(o) : "v"(a), "v"(b)); return o; }
#define VM_WAIT() asm volatile("s_waitcnt vmcnt(0)" ::: "memory")

constexpr int BATCH = 8, SEQ = 2048, D = 2048, M = BATCH * SEQ;
constexpr int NIN = 3632, NINP = 3840;
constexpr int OFF_U = 0, OFF_Q = 1024, OFF_KC = 2048, OFF_VC = 2304, OFF_KS = 2560, OFF_VS = 2816, OFF_KW = 3072, OFF_VW = 3328, OFF_G = 3584;
constexpr int NCMP = 127, NCROWS = BATCH * NCMP * 4;
constexpr float RMS_EPS = 1e-6f;
constexpr float LOG2E = 1.4426950408889634f;

constexpr size_t MiB = 1u << 20;
constexpr size_t WS_CTL = 0, CTL_ZERO_BYTES = 1 * MiB;
constexpr size_t WS_WIN = 2 * MiB, WS_WOUT = 17 * MiB, WS_WQ = 25 * MiB, WS_WG = 33 * MiB, WS_WPJ = 41 * MiB, WS_W1C = 42 * MiB, WS_POOLT = 44 * MiB, WS_KEYS = 45 * MiB;
constexpr size_t WS_CBIAS = 46 * MiB, WS_GATES = 47 * MiB, WS_HC = 50 * MiB, WS_KCMP = 54 * MiB, WS_VCMPT = 54 * MiB + 512 * 1024, WS_P16 = 56 * MiB;
constexpr size_t WS_XN = 64 * MiB, WS_X8 = 64 * MiB;
constexpr float CAT8SCALE = 8.f;
constexpr float W8SCALE = 64.f;
constexpr size_t WS_Y = 128 * MiB, WS_QP = 128 * MiB, WS_PJ = 192 * MiB;
constexpr size_t WS_MIXED = 256 * MiB, WS_CAT = 288 * MiB, WS_KN = 352 * MiB, WS_VT = 368 * MiB, WS_FLATA = 384 * MiB;
constexpr size_t WS_U6 = 256 * MiB, WS_V6 = 288 * MiB, WS_SU = 320 * MiB, WS_SV = 321 * MiB;
constexpr size_t WS_LIDX = 322 * MiB, WS_LG = 330 * MiB, WS_SSP = 338 * MiB, WS_PD = 340 * MiB, WS_HW = 404 * MiB;
constexpr size_t SLICE6 = (size_t)16384 * 192;
constexpr size_t WS_XR = 416 * MiB;
constexpr size_t WS_SS0 = 768 * 1024, WS_SS1 = 256 * 1024, WS_SS2 = 512 * 1024;
constexpr size_t WS_QN = 480 * MiB;
constexpr size_t WS_END = 512 * MiB;
constexpr int CW_TMO = 0, CW_CODE = 1, CW_BAR = 4096;

constexpr int RING_BYTES = 131072;
constexpr int LDSCTL_OFF = RING_BYTES, MISC_OFF = LDSCTL_OFF + 320;
constexpr int LDS_BYTES = 147456;
constexpr int NWAVES = 8;

__device__ __forceinline__ unsigned pk_f16(float lo, float hi) { f16x2 v; v.x = (f16)lo; v.y = (f16)hi; return __builtin_bit_cast(unsigned, v); }
__device__ __forceinline__ unsigned pk_fp8(float a, float b, float c, float d) { int r = __builtin_amdgcn_cvt_pk_fp8_f32(a, b, 0, false); r = __builtin_amdgcn_cvt_pk_fp8_f32(c, d, r, true); return (unsigned)r; }
__device__ __forceinline__ long as_i64(unsigned lo, unsigned hi) { return (long)(((unsigned long long)hi << 32) | lo); }
__device__ __forceinline__ f16x2 ash2(unsigned u) { return __builtin_bit_cast(f16x2, u); }
template <int CTRL> __device__ __forceinline__ float dpp_f(float v) { return __int_as_float(__builtin_amdgcn_update_dpp(0, __float_as_int(v), CTRL, 0xF, 0xF, true)); }
__device__ __forceinline__ float rl_f(float v, int l) { return __int_as_float(__builtin_amdgcn_readlane(__float_as_int(v), l)); }
__device__ __forceinline__ float sum8(float v) { v += dpp_f<0x141>(v); v += dpp_f<0xB1>(v); v += dpp_f<0x4E>(v); return v; }
__device__ __forceinline__ float wave_sum(float v) { v = sum8(v); v += dpp_f<0x140>(v); return (rl_f(v, 0) + rl_f(v, 16)) + (rl_f(v, 32) + rl_f(v, 48)); }
__device__ __forceinline__ float wave_max(float v) { v = fmaxf(v, dpp_f<0x141>(v)); v = fmaxf(v, dpp_f<0xB1>(v)); v = fmaxf(v, dpp_f<0x4E>(v)); v = fmaxf(v, dpp_f<0x140>(v));
    return fmaxf(fmaxf(rl_f(v, 0), rl_f(v, 16)), fmaxf(rl_f(v, 32), rl_f(v, 48))); }

__device__ __forceinline__ unsigned other8u(unsigned x) { return (unsigned)__builtin_amdgcn_update_dpp(0, (int)x, 0x128, 0xF, 0xF, true); }
__device__ __forceinline__ unsigned other16u(unsigned x, bool b4) { const auto r = __builtin_amdgcn_permlane16_swap(x, x, false, false); return b4 ? r[0] : r[1]; }
__device__ __forceinline__ unsigned other32u(unsigned x, bool b5) { const auto r = __builtin_amdgcn_permlane32_swap(x, x, false, false); return b5 ? r[0] : r[1]; }
namespace pg8 {
constexpr int BM = 256, BK = 64, HALF = 128, HTB = HALF * BK * 2, STAGE_BYTES = 8 * HTB, NXCD = 8, WGM = 8;
__host__ __device__ __forceinline__ int lds_byte(int r, int c) { const int st = (r >> 4) * 2 + (c >> 5), rr = r & 15, cc = c & 31, ob = rr * 64 + cc * 2; return st * 1024 + (ob ^ (((ob >> 9) & 1) << 5)); }
__host__ __device__ __forceinline__ void stage_rc(int b, int& R, int& C) { const int st = b / 1024, sb = b % 1024, swz = sb ^ (((sb >> 9) & 1) << 5); R = (st >> 1) * 16 + swz / 64; C = (st & 1) * 32 + (swz % 64) / 2; }
__host__ __device__ __forceinline__ int perm32(int rho) { const int n = rho >> 4, i = rho & 15; return 8 * (i >> 2) + 4 * n + (i & 3); }

struct Unit { int pm, pn; };
struct Gemm { const void* A; const void* Bt; int M, N, K, lda, ldb; int a_pn_off; int b_pm_split; size_t b_split_off; int b_pn_k = 0; int esz = 2;
    __device__ __forceinline__ const char* aptr(const Unit& u) const { return (const char*)A + ((size_t)u.pm * BM * lda + (size_t)u.pn * a_pn_off) * esz; }
    __device__ __forceinline__ const char* bptr(const Unit& u) const { return (const char*)Bt + (b_pn_k ? (size_t)u.pn * b_pn_k * esz : (size_t)u.pn * BM * ldb * esz) + (u.pm >= b_pm_split ? b_split_off : (size_t)0); }
};
struct StaticOrder {
    int nM, nN, nwg, G, c;
    __host__ __device__ void init(int M_, int N_, int G_, int c_) { nM = M_ / BM; nN = N_ / BM; nwg = nM * nN; G = G_; c = c_; }
    __host__ __device__ bool next(int i, Unit& u) const {
        const long L = (long)i * G + c; if (L >= nwg) return false;
        int wgid = (int)L; { const int q = nwg / NXCD, r = nwg % NXCD, xcd = wgid % NXCD, off = wgid / NXCD; wgid = (xcd < r ? xcd * (q + 1) : r * (q + 1) + (xcd - r) * q) + off; }
        const int nig = WGM * nN, gid = wgid / nig, fm = gid * WGM, gsz = (nM - fm) < WGM ? (nM - fm) : WGM;
        u.pm = fm + ((wgid % nig) % gsz); u.pn = (wgid % nig) / gsz; return true;
    }
};

__device__ __forceinline__ f32x2 gelu_pk(f32x2 v) {
    const f32x2 av = __builtin_elementwise_abs(v), d = av * 0.2316418882f + 1.0f;
    f32x2 t; t.x = __builtin_amdgcn_rcpf(d.x); t.y = __builtin_amdgcn_rcpf(d.y);
    f32x2 q = t * 0.5307027145f + (-0.7265760135f); q = q * t + 0.7107068705f; q = q * t + (-0.142248368f); q = q * t + 0.127414796f; q = q * t;
    const f32x2 s = (v * v) * (-0.72134752044f);
    f32x2 e; e.x = __builtin_amdgcn_exp2f(s.x); e.y = __builtin_amdgcn_exp2f(s.y);
    const f32x2 m = v * (q * e), r = v - m;
    f32x2 o; o.x = v.x < 0.f ? m.x : r.x; o.y = v.y < 0.f ? m.y : r.y; return o;
}
__device__ __forceinline__ float gelu1(float v) { f32x2 r = gelu_pk((f32x2){v, v}); return r.x; }

template <int ACT> struct EpiF16 {
    static constexpr bool PERM = true;
    f16* O; int ldc; const float* bias; int bias_pm_split; int bias_split_off;
    __device__ __forceinline__ void operator()(const f32x4 (&acc)[2][2][4][2], const Unit& u, int wr, int wc, int fr, int fq) const {
        const int row0 = u.pm * BM + wr * 64 + fr; const int col0 = u.pn * BM + wc * 32 + 8 * fq;
        const float* bp = bias ? bias + (u.pm >= bias_pm_split ? bias_split_off : 0) : nullptr;
        f32x4 bv[2][2];
#pragma unroll
        for (int bj = 0; bj < 2; ++bj)
#pragma unroll
            for (int n = 0; n < 2; ++n) bv[bj][n] = bp ? *(const f32x4*)(bp + col0 + bj * HALF + 4 * n) : (f32x4){0.f, 0.f, 0.f, 0.f};
#pragma unroll
        for (int ai = 0; ai < 2; ++ai)
#pragma unroll
            for (int m = 0; m < 4; ++m) { f16* rowp = O + (size_t)(row0 + ai * HALF + m * 16) * ldc + col0;
#pragma unroll
                for (int bj = 0; bj < 2; ++bj) { f32x4 v0 = acc[ai][bj][m][0] + bv[bj][0], v1 = acc[ai][bj][m][1] + bv[bj][1];
                    if (ACT == 1) { f32x2 a = gelu_pk((f32x2){v0[0], v0[1]}), b = gelu_pk((f32x2){v0[2], v0[3]}), c = gelu_pk((f32x2){v1[0], v1[1]}), d = gelu_pk((f32x2){v1[2], v1[3]});
                        v0 = (f32x4){a.x, a.y, b.x, b.y}; v1 = (f32x4){c.x, c.y, d.x, d.y}; }
                    u32x4 w; w.x = pk_f16(v0[0], v0[1]); w.y = pk_f16(v0[2], v0[3]); w.z = pk_f16(v1[0], v1[1]); w.w = pk_f16(v1[2], v1[3]);
                    *(u32x4*)(rowp + bj * HALF) = w; } }
    }
};
struct EpiRawF32 {
    static constexpr bool PERM = false;
    float* C; int ldc;
    __device__ __forceinline__ void operator()(const f32x4 (&acc)[2][2][4][2], const Unit& u, int wr, int wc, int fr, int fq) const {
        const int row0 = u.pm * BM + wr * 64 + fr, col0 = u.pn * BM + wc * 32 + 4 * fq;
#pragma unroll
        for (int ai = 0; ai < 2; ++ai)
#pragma unroll
            for (int m = 0; m < 4; ++m) { float* rowp = C + (size_t)(row0 + ai * HALF + m * 16) * ldc + col0;
#pragma unroll
                for (int bj = 0; bj < 2; ++bj)
#pragma unroll
                    for (int n = 0; n < 2; ++n) *(f32x4*)(rowp + bj * HALF + n * 16) = acc[ai][bj][m][n]; }
    }
};
struct EpiF8 {
    static constexpr bool PERM = true;
    unsigned char* O; int ldc; float sc;
    __device__ __forceinline__ void operator()(const f32x4 (&acc)[2][2][4][2], const Unit& u, int wr, int wc, int fr, int fq) const {
        const int row0 = u.pm * BM + wr * 64 + fr; const int col0 = u.pn * BM + wc * 32 + 8 * fq;
#pragma unroll
        for (int ai = 0; ai < 2; ++ai)
#pragma unroll
            for (int m = 0; m < 4; ++m) { unsigned char* rowp = O + (size_t)(row0 + ai * HALF + m * 16) * ldc + col0;
#pragma unroll
                for (int bj = 0; bj < 2; ++bj) { const f32x4 v0 = acc[ai][bj][m][0] * sc, v1 = acc[ai][bj][m][1] * sc;
                    u32x2 w; w.x = pk_fp8(v0[0], v0[1], v0[2], v0[3]); w.y = pk_fp8(v1[0], v1[1], v1[2], v1[3]);
                    *(u32x2*)(rowp + bj * HALF) = w; } }
    }
};
struct EpiRes16 {
    static constexpr bool PERM = true;
    f16* XR; float* SS; float as;
    __device__ __forceinline__ void operator()(const f32x4 (&acc)[2][2][4][2], const Unit& u, int wr, int wc, int fr, int fq) const {
        const int row0 = u.pm * BM + wr * 64 + fr; const int col0 = u.pn * BM + wc * 32 + 8 * fq;
#pragma unroll
        for (int ai = 0; ai < 2; ++ai) {
            f16x8 xb[4][2];
#pragma unroll
            for (int m = 0; m < 4; ++m)
#pragma unroll
                for (int bj = 0; bj < 2; ++bj) xb[m][bj] = *(const f16x8*)(XR + (size_t)(row0 + ai * HALF + m * 16) * D + col0 + bj * HALF);
            asm volatile("" ::: "memory");
#pragma unroll
            for (int m = 0; m < 4; ++m) { const int row = row0 + ai * HALF + m * 16; const size_t off = (size_t)row * D + col0; float ss = 0.f;
#pragma unroll
                for (int bj = 0; bj < 2; ++bj) { const f16x8 xv = xb[m][bj];
                    f32x4 v0 = acc[ai][bj][m][0] * as, v1 = acc[ai][bj][m][1] * as;
                    v0[0] += (float)xv[0]; v0[1] += (float)xv[1]; v0[2] += (float)xv[2]; v0[3] += (float)xv[3]; v1[0] += (float)xv[4]; v1[1] += (float)xv[5]; v1[2] += (float)xv[6]; v1[3] += (float)xv[7];
                    ss += ((v0[0] * v0[0] + v0[1] * v0[1]) + (v0[2] * v0[2] + v0[3] * v0[3])) + ((v1[0] * v1[0] + v1[1] * v1[1]) + (v1[2] * v1[2] + v1[3] * v1[3]));
                    u32x4 o; o.x = pk_f16(v0[0], v0[1]); o.y = pk_f16(v0[2], v0[3]); o.z = pk_f16(v1[0], v1[1]); o.w = pk_f16(v1[2], v1[3]);
                    *(u32x4*)(XR + off + bj * HALF) = o; }
                ss += __shfl_xor(ss, 16); ss += __shfl_xor(ss, 32);
                if (fq == 0) atomicAdd(SS + row, ss); }
            asm volatile("" ::: "memory"); }
    }
};
struct EpiF16Row {
    static constexpr bool PERM = true;
    f16* O; int ldc; const float* SS;
    __device__ __forceinline__ void operator()(const f32x4 (&acc)[2][2][4][2], const Unit& u, int wr, int wc, int fr, int fq) const {
        const int row0 = u.pm * BM + wr * 64 + fr; const int col0 = u.pn * BM + wc * 32 + 8 * fq;
#pragma unroll
        for (int ai = 0; ai < 2; ++ai)
#pragma unroll
            for (int m = 0; m < 4; ++m) { const int row = row0 + ai * HALF + m * 16; f16* rowp = O + (size_t)row * ldc + col0;
                const float rs = 1.f / sqrtf(SS[row] * (1.f / D) + RMS_EPS);
#pragma unroll
                for (int bj = 0; bj < 2; ++bj) { const f32x4 v0 = acc[ai][bj][m][0] * rs, v1 = acc[ai][bj][m][1] * rs;
                    u32x4 o; o.x = pk_f16(v0[0], v0[1]); o.y = pk_f16(v0[2], v0[3]); o.z = pk_f16(v1[0], v1[1]); o.w = pk_f16(v1[2], v1[3]);
                    *(u32x4*)(rowp + bj * HALF) = o; } }
    }
};
struct EpiFinal {
    static constexpr bool PERM = true;
    const f16* XR; const f16* PJ; float* C; const float* SS; float as;
    __device__ __forceinline__ void operator()(const f32x4 (&acc)[2][2][4][2], const Unit& u, int wr, int wc, int fr, int fq) const {
        const int row0 = u.pm * BM + wr * 64 + fr; const int col0 = u.pn * BM + wc * 32 + 8 * fq;
#pragma unroll
        for (int ai = 0; ai < 2; ++ai)
#pragma unroll
            for (int mh = 0; mh < 2; ++mh) {
                f16x8 xb[2][2], pb[2][2]; float ssv[2];
#pragma unroll
                for (int mm = 0; mm < 2; ++mm) { const int row = row0 + ai * HALF + (2 * mh + mm) * 16; ssv[mm] = SS[row];
#pragma unroll
                    for (int bj = 0; bj < 2; ++bj) { xb[mm][bj] = *(const f16x8*)(XR + (size_t)row * D + col0 + bj * HALF); pb[mm][bj] = *(const f16x8*)(PJ + (size_t)row * D + col0 + bj * HALF); } }
                asm volatile("" ::: "memory");
#pragma unroll
                for (int mm = 0; mm < 2; ++mm) { const int m = 2 * mh + mm; const int row = row0 + ai * HALF + m * 16; const size_t off = (size_t)row * D + col0;
                    const float nrs = -LOG2E * as / sqrtf(ssv[mm] * (1.f / D) + RMS_EPS);
#pragma unroll
                    for (int bj = 0; bj < 2; ++bj) { const f16x8 xv = xb[mm][bj], pv = pb[mm][bj];
                        const f32x4 a0 = acc[ai][bj][m][0], a1 = acc[ai][bj][m][1]; f32x4 o0, o1;
#pragma unroll
                        for (int j = 0; j < 4; ++j) { o0[j] = (float)xv[j] + (float)pv[j] * __builtin_amdgcn_rcpf(1.0f + __builtin_amdgcn_exp2f(nrs * a0[j]));
                            o1[j] = (float)xv[4 + j] + (float)pv[4 + j] * __builtin_amdgcn_rcpf(1.0f + __builtin_amdgcn_exp2f(nrs * a1[j])); }
                        *(f32x4*)(C + off + bj * HALF) = o0; *(f32x4*)(C + off + bj * HALF + 4) = o1; } }
                asm volatile("" ::: "memory"); }
    }
};
template <int MODE> struct EpiF32 {
    static constexpr bool PERM = false;
    const float* base; float* C; int ldc; const f16* pj; const float* ssp;
    __device__ __forceinline__ void operator()(const f32x4 (&acc)[2][2][4][2], const Unit& u, int wr, int wc, int fr, int fq) const {
        const int row0 = u.pm * BM + wr * 64 + fr, col0 = u.pn * BM + wc * 32 + 4 * fq;
#pragma unroll
        for (int ai = 0; ai < 2; ++ai)
#pragma unroll
            for (int m = 0; m < 4; ++m) { const size_t off = (size_t)(row0 + ai * HALF + m * 16) * ldc + col0;
                float nrs = -LOG2E;
                if (MODE == 1) { const f32x4 s0 = *(const f32x4*)(ssp + (size_t)(row0 + ai * HALF + m * 16) * 8), s1 = *(const f32x4*)(ssp + (size_t)(row0 + ai * HALF + m * 16) * 8 + 4);
                    nrs = -LOG2E / sqrtf((((s0.x + s0.y) + (s0.z + s0.w)) + ((s1.x + s1.y) + (s1.z + s1.w))) * (1.f / D) + RMS_EPS); }
#pragma unroll
                for (int bj = 0; bj < 2; ++bj)
#pragma unroll
                    for (int n = 0; n < 2; ++n) { const size_t o2 = off + bj * HALF + n * 16; const f32x4 bs = *(const f32x4*)(base + o2); f32x4 a = acc[ai][bj][m][n];
                        if (MODE == 1) { const f16x4 pv = *(const f16x4*)(pj + o2);
#pragma unroll
                            for (int j = 0; j < 4; ++j) a[j] = (float)pv[j] * __builtin_amdgcn_rcpf(1.0f + __builtin_amdgcn_exp2f(nrs * a[j])); }
                        *(f32x4*)(C + o2) = bs + a; }
                asm volatile("" ::: "memory"); }
    }
};

typedef int i32x4v __attribute__((ext_vector_type(4)));
typedef int i32x8v __attribute__((ext_vector_type(8)));
__device__ __forceinline__ i32x8v cat16(const f16x8 a, const f16x8 b) { const i32x4v x = __builtin_bit_cast(i32x4v, a), y = __builtin_bit_cast(i32x4v, b); return __builtin_shufflevector(x, y, 0, 1, 2, 3, 4, 5, 6, 7); }
__device__ __forceinline__ f16x8 half16(const i32x8v& v, int k) { const i32x4v h = k ? __builtin_shufflevector(v, v, 4, 5, 6, 7) : __builtin_shufflevector(v, v, 0, 1, 2, 3); return __builtin_bit_cast(f16x8, h); }
template <class Epi, class Sched, bool F8 = false>
__device__ __forceinline__ void gemm_phase(LAS unsigned char* lds, const Gemm g, const Sched& S, const Epi& E) {
    int tid = threadIdx.x; asm volatile("" : "+v"(tid));
    const int wid = __builtin_amdgcn_readfirstlane(tid >> 6), lane = tid & 63, wr = wid >> 2, wc = wid & 3, fr = lane & 15, fq = lane >> 4;
    const int K = g.K, nt = K * g.esz / (BK * 2);
    unsigned voffA[2], voffB[2];
#pragma unroll
    for (int i = 0; i < 2; ++i) { int R, C; stage_rc(tid * 16 + i * 8192, R, C); const int Rb = Epi::PERM ? ((R & ~31) + perm32(R & 31)) : R;
        voffA[i] = (unsigned)(R * g.lda * g.esz + C * 2); voffB[i] = (unsigned)(Rb * g.ldb * g.esz + C * 2); }
    const size_t kstep = (size_t)(BK * 2);
    const size_t hstepA = (size_t)HALF * g.lda * g.esz, hstepB = (size_t)HALF * g.ldb * g.esz;
    const unsigned ldsw = (unsigned)wid * 1024u;
    const int aoff = lds_byte(wr * 64 + fr, fq * 8), boff = lds_byte(wc * 32 + fr, fq * 8);
#define PG8_SA(b, h) (((b) * 2 + (h)) * HTB)
#define PG8_SB(b, h) ((4 + (b) * 2 + (h)) * HTB)
#define PG8_STAGE(bufoff, gbase, voff) do { _Pragma("unroll") for (int _i = 0; _i < 2; ++_i) \
        __builtin_amdgcn_global_load_lds((const unsigned*)((const char*)(gbase) + (voff)[_i]), (LAS unsigned*)(lds + (bufoff) + ldsw + _i * 8192), 16, 0, 0); } while (0)
#define PG8_LDA(dst, b, h) do { _Pragma("unroll") for (int m = 0; m < 4; ++m) dst[m] = cat16(*(const LAS f16x8*)(lds + PG8_SA(b, h) + aoff + m * 2048), *(const LAS f16x8*)(lds + PG8_SA(b, h) + aoff + m * 2048 + 1024)); } while (0)
#define PG8_LDB(dst, b, h) do { _Pragma("unroll") for (int n = 0; n < 2; ++n) dst[n] = cat16(*(const LAS f16x8*)(lds + PG8_SB(b, h) + boff + n * 2048), *(const LAS f16x8*)(lds + PG8_SB(b, h) + boff + n * 2048 + 1024)); } while (0)
#define PG8_MMA(ai, bj, At, Bt) do { __builtin_amdgcn_s_setprio(1); \
        if (F8) { _Pragma("unroll") for (int m = 0; m < 4; ++m) _Pragma("unroll") for (int n = 0; n < 2; ++n) \
            asm volatile("v_mfma_scale_f32_16x16x128_f8f6f4 %0, %1, %2, %0, %3, %3 op_sel_hi:[0,0,0]" : "+v"(acc[ai][bj][m][n]) : "v"(Bt[n]), "v"(At[m]), "v"(0x7F7F7F7F)); } \
        else { _Pragma("unroll") for (int m = 0; m < 4; ++m) _Pragma("unroll") for (int n = 0; n < 2; ++n) _Pragma("unroll") for (int k = 0; k < 2; ++k) \
            acc[ai][bj][m][n] = __builtin_amdgcn_mfma_f32_16x16x32_f16(half16(Bt[n], k), half16(At[m], k), acc[ai][bj][m][n], 0, 0, 0); } \
        __builtin_amdgcn_s_setprio(0); } while (0)
#define PG8_WAIT_V(n) asm volatile("s_waitcnt vmcnt(" #n ")" ::: "memory")
#define PG8_WAIT_L(n) asm volatile("s_waitcnt lgkmcnt(" #n ")" ::: "memory")
#define PG8_BAR __builtin_amdgcn_s_barrier()
#define PG8_SCHED __builtin_amdgcn_sched_barrier(0)
    Unit cur, nxt; int ui = 0;
    if (!S.next(0, cur)) return;
    f32x4 acc[2][2][4][2];
#pragma unroll
    for (int a = 0; a < 2; ++a)
#pragma unroll
        for (int b = 0; b < 2; ++b)
#pragma unroll
            for (int m = 0; m < 4; ++m)
#pragma unroll
                for (int n = 0; n < 2; ++n) acc[a][b][m][n] = (f32x4){0.f, 0.f, 0.f, 0.f};
    i32x8v At[4], B0[2], B1[2];
    const char* cA = g.aptr(cur); const char* cB = g.bptr(cur);
    PG8_STAGE(PG8_SB(0, 0), cB, voffB); PG8_STAGE(PG8_SB(0, 1), cB + hstepB, voffB); PG8_STAGE(PG8_SA(0, 0), cA, voffA); PG8_STAGE(PG8_SA(0, 1), cA + hstepA, voffA);
    if (wr == 1) PG8_BAR;
    PG8_WAIT_V(2); PG8_BAR;
    PG8_STAGE(PG8_SB(1, 0), cB + kstep, voffB); PG8_STAGE(PG8_SA(1, 0), cA + kstep, voffA); PG8_STAGE(PG8_SB(1, 1), cB + hstepB + kstep, voffB);
    PG8_WAIT_V(6); PG8_BAR;
    for (;;) {
        const bool has_next = S.next(ui + 1, nxt);
        const char* nA = has_next ? g.aptr(nxt) : cA; const char* nB = has_next ? g.bptr(nxt) : cB;
#pragma clang loop unroll(disable)
        for (int t = 0; t < nt; t += 2) {
            const bool last = (t == nt - 2);
            const char* a1 = cA + (size_t)(t + 1) * kstep;
            const char* a2 = last ? nA : cA + (size_t)(t + 2) * kstep; const char* b2 = last ? nB : cB + (size_t)(t + 2) * kstep;
            const char* a3 = a2 + kstep; const char* b3 = b2 + kstep;
            PG8_LDB(B0, 0, 0); PG8_LDB(B1, 0, 1); PG8_SCHED; PG8_LDA(At, 0, 0); PG8_STAGE(PG8_SA(1, 1), a1 + hstepA, voffA);
            PG8_WAIT_V(8); PG8_WAIT_L(0); PG8_BAR; PG8_MMA(0, 0, At, B0); PG8_MMA(0, 1, At, B1); PG8_BAR; PG8_SCHED;
            PG8_LDA(At, 0, 1); PG8_STAGE(PG8_SB(0, 0), b2, voffB); PG8_STAGE(PG8_SB(0, 1), b2 + hstepB, voffB); PG8_STAGE(PG8_SA(0, 0), a2, voffA);
            PG8_WAIT_V(8); PG8_WAIT_L(0); PG8_BAR; PG8_MMA(1, 0, At, B0); PG8_MMA(1, 1, At, B1); PG8_BAR; PG8_SCHED;
            PG8_LDB(B0, 1, 0); PG8_LDB(B1, 1, 1); PG8_SCHED; PG8_LDA(At, 1, 0); PG8_STAGE(PG8_SA(0, 1), a2 + hstepA, voffA);
            PG8_WAIT_V(8); PG8_WAIT_L(0); PG8_BAR; PG8_MMA(0, 0, At, B0); PG8_MMA(0, 1, At, B1); PG8_BAR; PG8_SCHED;
            PG8_LDA(At, 1, 1); PG8_STAGE(PG8_SB(1, 0), b3, voffB); PG8_STAGE(PG8_SB(1, 1), b3 + hstepB, voffB); PG8_STAGE(PG8_SA(1, 0), a3, voffA);
            PG8_WAIT_V(8); PG8_WAIT_L(0); PG8_BAR; PG8_MMA(1, 0, At, B0); PG8_MMA(1, 1, At, B1); PG8_BAR; PG8_SCHED;
        }
        if (F8) asm volatile("s_nop 15\n\ts_nop 15" ::: "memory");
        if (wr == 0) PG8_BAR;
        E(acc, cur, wr, wc, fr, fq);
        if (!has_next) break;
#pragma unroll
        for (int a = 0; a < 2; ++a)
#pragma unroll
            for (int b = 0; b < 2; ++b)
#pragma unroll
                for (int m = 0; m < 4; ++m)
#pragma unroll
                    for (int n = 0; n < 2; ++n) acc[a][b][m][n] = (f32x4){0.f, 0.f, 0.f, 0.f};
        cur = nxt; cA = nA; cB = nB; ++ui;
        if (wr == 1) PG8_BAR;
    }
    PG8_WAIT_V(0);
    PG8_BAR;
#undef PG8_SA
#undef PG8_SB
#undef PG8_STAGE
#undef PG8_LDA
#undef PG8_LDB
#undef PG8_MMA
#undef PG8_WAIT_V
#undef PG8_WAIT_L
#undef PG8_BAR
#undef PG8_SCHED
}
}

#define XB_TMO      128
#define XB_XCNT(j)  (256  + 64 * (j))
#define XB_XSUB(j)  (1280 + 64 * (j))
#define XB_XGEN(j)  (2304 + 64 * (j))
#define XB_TOP      3328
#define XB_TOPGEN   3392
#define XCD_BAR_WORDS 3456
#define XB_SPIN_CAP (1u << 18)
__device__ __forceinline__ unsigned xb_ld(unsigned* p)              { return __hip_atomic_load(p, __ATOMIC_RELAXED, __HIP_MEMORY_SCOPE_AGENT); }
__device__ __forceinline__ unsigned xb_add(unsigned* p, unsigned v) { return __hip_atomic_fetch_add(p, v, __ATOMIC_RELAXED, __HIP_MEMORY_SCOPE_AGENT); }
__device__ __forceinline__ unsigned xb_xcc_id() { return (unsigned)__builtin_amdgcn_s_getreg((3 << 11) | 20) & 0xFu; }
#define XB_SPIN(cond, bar) do { unsigned _sp = 0; while (cond) { __builtin_amdgcn_s_sleep(1); \
    if ((++_sp & 255u) == 0u) { if (xb_ld(&(bar)[XB_TMO])) break; if (_sp > XB_SPIN_CAP) { atomicAdd(&(bar)[XB_TMO], 1u); break; } } } } while (0)
struct XcdBarrier { unsigned* bar; unsigned x; volatile LAS unsigned* st; };
__device__ __forceinline__ XcdBarrier xcd_barrier_post(unsigned* bar, volatile LAS unsigned* st) {
    XcdBarrier b; b.bar = bar; b.x = xb_xcc_id(); b.st = st;
    if (threadIdx.x == 0) (void)xb_add(&bar[XB_XCNT(b.x)], 1u);
    return b;
}
__device__ __forceinline__ void xcd_barrier_complete(unsigned* bar, unsigned x, unsigned& nloc, unsigned& nx) {
    const unsigned G = gridDim.x * gridDim.y * gridDim.z;
    unsigned sum, cnt, mine, sp = 0u;
    for (;;) {
        sum = 0u; cnt = 0u; mine = 0u;
#pragma unroll
        for (unsigned j = 0; j < 16; ++j) { const unsigned c = xb_ld(&bar[XB_XCNT(j)]); sum += c; cnt += (c > 0u) ? 1u : 0u; mine = (j == x) ? c : mine; }
        if (sum == G) break;
        __builtin_amdgcn_s_sleep(1);
        if ((++sp & 255u) == 0u) { if (xb_ld(&bar[XB_TMO])) break; if (sp > XB_SPIN_CAP) { atomicAdd(&bar[XB_TMO], 1u); break; } }
    }
    nloc = mine > 0u ? mine : 1u; nx = cnt > 0u ? cnt : 1u;
}
__device__ __forceinline__ void xcd_barrier(const XcdBarrier& b) {
    asm volatile("s_waitcnt vmcnt(0)" ::: "memory");
    __syncthreads();
    if (threadIdx.x == 0) {
        unsigned* bar = b.bar;
        __builtin_amdgcn_s_waitcnt(0);
        unsigned nloc = b.st[0], nx = b.st[1];
        if (nloc == 0u) { xcd_barrier_complete(bar, b.x, nloc, nx); b.st[0] = nloc; b.st[1] = nx; }
        const unsigned old = xb_add(&bar[XB_XSUB(b.x)], 1u);
        const unsigned gen = old / nloc;
        if (old + 1u == (gen + 1u) * nloc) {
            __builtin_amdgcn_fence(__ATOMIC_RELEASE, "agent");
            asm volatile("s_waitcnt vmcnt(0)" ::: "memory");
            const unsigned og = xb_add(&bar[XB_TOP], 1u);
            const unsigned tg = og / nx;
            if (og + 1u == (tg + 1u) * nx) xb_add(&bar[XB_TOPGEN], 1u);
            else XB_SPIN(xb_ld(&bar[XB_TOPGEN]) == tg, bar);
            __builtin_amdgcn_fence(__ATOMIC_ACQUIRE, "agent");
            xb_add(&bar[XB_XGEN(b.x)], 1u);
            asm volatile("s_waitcnt vmcnt(0)" ::: "memory");
        } else {
            XB_SPIN(xb_ld(&bar[XB_XGEN(b.x)]) == gen, bar);
            __builtin_amdgcn_fence(__ATOMIC_ACQUIRE, "agent");
            asm volatile("s_waitcnt vmcnt(0)" ::: "memory");
        }
    }
    __syncthreads();
}

struct Frame {
    LAS unsigned char* lds;
    volatile LAS unsigned* MISC;
    int tid, lane, wave;
    int vcu, G;
    const float* in[26];
    float* out;
    unsigned char* ws;
};
enum { I_X = 0, I_P, I_RELB, I_MIXNW, I_WIN, I_QNW, I_KNW, I_CKPOS, I_CKW1, I_CKB1, I_CKW2, I_CVPOS, I_CVW1, I_CVB1, I_CVW2, I_POOLW, I_POOLS, I_WOUT, I_FFNNW, I_PWQ, I_PKEYS, I_PU, I_PV, I_PLENW, I_PLEWG, I_PLEWP };

__device__ __forceinline__ void p0_transpose_item(const float* W, int K, int N, int Npad, const float* colscale, f16* WT, LAS float* scr, LAS float* scr2, int item, int lane, const float* kscale = nullptr, bool f8 = false, float wscale = 1.f) {
    const int nblk = Npad / 32, kb = item / nblk, nb = item % nblk, k0 = 64 * kb, n0 = 32 * nb;
    const int nn = n0 + (lane & 31); const bool ok = nn < N;
#pragma unroll
    for (int hgrp = 0; hgrp < 2; ++hgrp) { float wv[16];
#pragma unroll
        for (int i = 0; i < 16; ++i) { const int kk = 2 * (16 * hgrp + i) + (lane >> 5); wv[i] = ok ? W[(size_t)(k0 + kk) * N + nn] : 0.f; }
        if (kscale) {
#pragma unroll
            for (int i = 0; i < 16; ++i) wv[i] *= kscale[k0 + 2 * (16 * hgrp + i) + (lane >> 5)]; }
#pragma unroll
        for (int i = 0; i < 16; ++i) { const int kk = 2 * (16 * hgrp + i) + (lane >> 5); (kk < 62 ? scr + kk * 33 : scr2 + (kk - 62) * 33)[lane & 31] = wv[i]; }
        asm volatile("" ::: "memory"); }
    LDS_WAIT(); asm volatile("" ::: "memory");
    const int c = lane & 7;
#pragma unroll
    for (int j = 0; j < 4; ++j) { const int n = (lane >> 3) + 8 * j; const LAS float* s = scr + (8 * c) * 33 + n; const LAS float* sh = (c == 7 ? scr2 : scr + (8 * c + 6) * 33) + n; const float sc = (colscale && n0 + n < N) ? colscale[n0 + n] : 1.f;
        if (f8) { const float s8 = sc * wscale; u32x2 o; o.x = pk_fp8(s[0 * 33] * s8, s[1 * 33] * s8, s[2 * 33] * s8, s[3 * 33] * s8); o.y = pk_fp8(s[4 * 33] * s8, s[5 * 33] * s8, sh[0] * s8, sh[33] * s8);
            *(GAS u32x2*)((unsigned char*)WT + (size_t)(n0 + n) * K + k0 + 8 * c) = o; }
        else { u32x4 o; o.x = pk_f16(s[0 * 33] * sc, s[1 * 33] * sc); o.y = pk_f16(s[2 * 33] * sc, s[3 * 33] * sc); o.z = pk_f16(s[4 * 33] * sc, s[5 * 33] * sc); o.w = pk_f16(sh[0] * sc, sh[33] * sc);
            *(GAS u32x4*)(WT + (size_t)(n0 + n) * K + k0 + 8 * c) = o; } }
    LDS_WAIT(); asm volatile("" ::: "memory");
}
__device__ __forceinline__ void rms_row_to_f16(const float* xrow, const float* w, f16* orow, int lane, f16* x16row = nullptr) {
    const GAS f32x4* xr = (const GAS f32x4*)xrow + lane; const GAS f32x4* wr = (const GAS f32x4*)w + lane;
    f32x4 v[8]; float s = 0.f;
#pragma unroll
    for (int j = 0; j < 8; ++j) { v[j] = xr[64 * j]; s += (v[j].x * v[j].x + v[j].y * v[j].y) + (v[j].z * v[j].z + v[j].w * v[j].w); }
    const float rstd = 1.f / sqrtf(wave_sum(s) * (1.f / D) + RMS_EPS);
    GAS u32x2* o8 = (GAS u32x2*)orow + lane;
#pragma unroll
    for (int j = 0; j < 8; ++j) { const f32x4 g = wr[64 * j]; u32x2 o; o.x = pk_f16(v[j].x * rstd * g.x, v[j].y * rstd * g.y); o.y = pk_f16(v[j].z * rstd * g.z, v[j].w * rstd * g.w); o8[64 * j] = o; }
    if (x16row) { GAS u32x2* x8 = (GAS u32x2*)x16row + lane;
#pragma unroll
        for (int j = 0; j < 8; ++j) { u32x2 o; o.x = pk_f16(v[j].x, v[j].y); o.y = pk_f16(v[j].z, v[j].w); x8[64 * j] = o; } }
}
__device__ __forceinline__ void rms_2rows_to_f16(const float* x0, const float* x1, const float* w, f16* o0, f16* o1, f16* h0, f16* h1, int lane) {
    const GAS f32x4* xa = (const GAS f32x4*)x0 + lane; const GAS f32x4* xb = (const GAS f32x4*)x1 + lane; const GAS f32x4* wr = (const GAS f32x4*)w + lane;
    f32x4 va[8], vb[8]; float sa = 0.f, sb = 0.f;
#pragma unroll
    for (int j = 0; j < 8; ++j) { va[j] = __builtin_nontemporal_load(xa + 64 * j); vb[j] = __builtin_nontemporal_load(xb + 64 * j); }
#pragma unroll
    for (int j = 0; j < 8; ++j) { sa += (va[j].x * va[j].x + va[j].y * va[j].y) + (va[j].z * va[j].z + va[j].w * va[j].w); sb += (vb[j].x * vb[j].x + vb[j].y * vb[j].y) + (vb[j].z * vb[j].z + vb[j].w * vb[j].w); }
    const float ra = 1.f / sqrtf(wave_sum(sa) * (1.f / D) + RMS_EPS), rb = 1.f / sqrtf(wave_sum(sb) * (1.f / D) + RMS_EPS);
    GAS u32x2* pa = (GAS u32x2*)o0 + lane; GAS u32x2* pb = (GAS u32x2*)o1 + lane; GAS u32x2* qa = (GAS u32x2*)h0 + lane; GAS u32x2* qb = (GAS u32x2*)h1 + lane;
#pragma unroll
    for (int j = 0; j < 8; ++j) { const f32x4 g = wr[64 * j]; u32x2 o;
        o.x = pk_f16(va[j].x * ra * g.x, va[j].y * ra * g.y); o.y = pk_f16(va[j].z * ra * g.z, va[j].w * ra * g.w); pa[64 * j] = o;
        o.x = pk_f16(vb[j].x * rb * g.x, vb[j].y * rb * g.y); o.y = pk_f16(vb[j].z * rb * g.z, vb[j].w * rb * g.w); pb[64 * j] = o;
        o.x = pk_f16(va[j].x, va[j].y); o.y = pk_f16(va[j].z, va[j].w); qa[64 * j] = o;
        o.x = pk_f16(vb[j].x, vb[j].y); o.y = pk_f16(vb[j].z, vb[j].w); qb[64 * j] = o; }
}
__device__ __forceinline__ void x16_2rows(const float* x0, const float* x1, f16* h0, f16* h1, float* ss0, float* ss1, int lane) {
    const GAS f32x4* xa = (const GAS f32x4*)x0 + lane; const GAS f32x4* xb = (const GAS f32x4*)x1 + lane;
    f32x4 va[8], vb[8]; float sa = 0.f, sb = 0.f;
#pragma unroll
    for (int j = 0; j < 8; ++j) { va[j] = __builtin_nontemporal_load(xa + 64 * j); vb[j] = __builtin_nontemporal_load(xb + 64 * j); }
    GAS u32x2* qa = (GAS u32x2*)h0 + lane; GAS u32x2* qb = (GAS u32x2*)h1 + lane;
#pragma unroll
    for (int j = 0; j < 8; ++j) { sa += (va[j].x * va[j].x + va[j].y * va[j].y) + (va[j].z * va[j].z + va[j].w * va[j].w); sb += (vb[j].x * vb[j].x + vb[j].y * vb[j].y) + (vb[j].z * vb[j].z + vb[j].w * vb[j].w);
        u32x2 o; o.x = pk_f16(va[j].x, va[j].y); o.y = pk_f16(va[j].z, va[j].w); qa[64 * j] = o;
        o.x = pk_f16(vb[j].x, vb[j].y); o.y = pk_f16(vb[j].z, vb[j].w); qb[64 * j] = o; }
    sa = wave_sum(sa); sb = wave_sum(sb);
    if (lane == 0) { *ss0 = sa; *ss1 = sb; }
}
__device__ __forceinline__ void cvt_f32_f16(Frame& F, const float* src, f16* dst, size_t n) {
    const size_t gt = (size_t)F.vcu * 512 + F.tid, GT = (size_t)F.G * 512;
    for (size_t i = gt; i < n / 8; i += GT) { const f32x4 a = *(const GAS f32x4*)(src + i * 8), b = *(const GAS f32x4*)(src + i * 8 + 4);
        u32x4 o; o.x = pk_f16(a.x, a.y); o.y = pk_f16(a.z, a.w); o.z = pk_f16(b.x, b.y); o.w = pk_f16(b.z, b.w); *(GAS u32x4*)(dst + i * 8) = o; }
}

constexpr int P0_I_IN = (D / 64) * (NINP / 32), P0_I_SQ = (D / 64) * (D / 32), P0_I_PJ = (256 / 64) * (D / 32), P0_I_C1 = (D / 64) * (256 / 32), P0_I_PL = (256 / 64) * (256 / 32);
constexpr int P0_NITEMS = P0_I_IN + 3 * P0_I_SQ + P0_I_PJ + 2 * P0_I_C1 + 4 * P0_I_PL, P0_DEF_LO = P0_I_IN, P0_DEF_HI = P0_I_IN + 3 * P0_I_SQ + P0_I_PJ;
__device__ __forceinline__ void p0_items(Frame& F, LAS float* scr, LAS float* scr2, bool deferred) {
    const int gw = F.vcu * NWAVES + F.wave, NGW = F.G * NWAVES;
    unsigned char* ws = F.ws;
    constexpr int I_IN = P0_I_IN, I_SQ = P0_I_SQ, I_PJ = P0_I_PJ, I_C1 = P0_I_C1, I_PL = P0_I_PL;
    const int n = deferred ? P0_DEF_HI - P0_DEF_LO : P0_NITEMS - (P0_DEF_HI - P0_DEF_LO);
    for (int it = gw; it < n; it += NGW) {
        int r = deferred ? P0_DEF_LO + it : (it < P0_DEF_LO ? it : it + (P0_DEF_HI - P0_DEF_LO));
        if (r < I_IN) { p0_transpose_item(F.in[I_WIN], D, NIN, NINP, nullptr, (f16*)(ws + WS_WIN), scr, scr2, r, F.lane, F.in[I_MIXNW]); continue; } r -= I_IN;
        if (r < I_SQ) { p0_transpose_item(F.in[I_WOUT], D, D, D, nullptr, (f16*)(ws + WS_WOUT), scr, scr2, r, F.lane, nullptr, true, W8SCALE); continue; } r -= I_SQ;
        if (r < I_SQ) { p0_transpose_item(F.in[I_PWQ], D, D, D, nullptr, (f16*)(ws + WS_WQ), scr, scr2, r, F.lane, F.in[I_FFNNW]); continue; } r -= I_SQ;
        if (r < I_SQ) { p0_transpose_item(F.in[I_PLEWG], D, D, D, nullptr, (f16*)(ws + WS_WG), scr, scr2, r, F.lane, F.in[I_PLENW], true, W8SCALE); continue; } r -= I_SQ;
        if (r < I_PJ) { p0_transpose_item(F.in[I_PLEWP], 256, D, D, nullptr, (f16*)(ws + WS_WPJ), scr, scr2, r, F.lane); continue; } r -= I_PJ;
        if (r < I_C1) { p0_transpose_item(F.in[I_CKW1], D, 256, 256, nullptr, (f16*)(ws + WS_W1C), scr, scr2, r, F.lane); continue; } r -= I_C1;
        if (r < I_C1) { p0_transpose_item(F.in[I_CVW1], D, 256, 256, nullptr, (f16*)(ws + WS_W1C) + 256 * D, scr, scr2, r, F.lane); continue; } r -= I_C1;
        { const int g = r / I_PL; r -= g * I_PL;
          p0_transpose_item(F.in[I_POOLW] + (size_t)g * 65536, 256, 256, 256, F.in[I_POOLS] + g * 256, (f16*)(ws + WS_POOLT) + (size_t)g * 65536, scr, scr2, r, F.lane); }
    }
}
__device__ __forceinline__ void p0_deferred(Frame& F) {
    p0_items(F, (LAS float*)(F.lds + 65536 + F.wave * 8192), (LAS float*)(F.lds + F.wave * 8192), true);
    cvt_f32_f16(F, F.in[I_P], (f16*)(F.ws + WS_P16), (size_t)M * 256);
    LDS_WAIT(); asm volatile("" ::: "memory");
}
__device__ __forceinline__ void p0_prologue(Frame& F) {
    LAS float* scr = (LAS float*)(F.lds + F.wave * 16384);
    const int gw = F.vcu * NWAVES + F.wave, NGW = F.G * NWAVES;
    unsigned char* ws = F.ws;
    p0_items(F, scr, scr + 62 * 33, false);
    { float* SS0 = (float*)(ws + WS_SS0); f16* XR = (f16*)(ws + WS_XR);
      for (int m = gw; m < M; m += 2 * NGW) { const int m2 = m + NGW < M ? m + NGW : m;
          x16_2rows(F.in[I_X] + (size_t)m * D, F.in[I_X] + (size_t)m2 * D, XR + (size_t)m * D, XR + (size_t)m2 * D, SS0 + m, SS0 + m2, F.lane); } }
    cvt_f32_f16(F, F.in[I_PKEYS], (f16*)(ws + WS_KEYS), (size_t)8 * 2 * 128 * 128);
    for (int task = gw; task < 512; task += NGW) { const int mat = task >> 8, n = task & 255;
        const float* pos = F.in[mat ? I_CVPOS : I_CKPOS]; const float* w1 = F.in[mat ? I_CVW1 : I_CKW1]; float s = 0.f;
#pragma unroll
        for (int i = 0; i < 32; ++i) { const int k = F.lane + 64 * i; s += pos[k] * w1[(size_t)k * 256 + n]; }
        s = wave_sum(s);
        if (F.lane == 0) ((float*)(ws + WS_CBIAS))[task] = s + F.in[mat ? I_CVB1 : I_CKB1][n]; }
}

template <int W> __device__ __forceinline__ void pool_mix_tile(const f16* up, f16* mp, size_t mb, int s0) {
    f16x2 prev[16], cur[16]; f32x2 sum = {0.f, 0.f};
#pragma unroll
    for (int i = 0; i < 16; ++i) { const int sp = s0 - 16 + i; prev[i] = sp >= 0 ? *(const GAS f16x2*)(up + (mb + sp) * NINP) : (f16x2){(f16)0.f, (f16)0.f}; }
#pragma unroll
    for (int i = 16 - W; i < 16; ++i) { sum.x += (float)prev[i].x; sum.y += (float)prev[i].y; }
#pragma unroll 1
    for (int blk = 0; blk < 4; ++blk) { const int sb = s0 + blk * 16;
#pragma unroll
        for (int i = 0; i < 16; ++i) cur[i] = *(const GAS f16x2*)(up + (mb + sb + i) * NINP);
#pragma unroll
        for (int i = 0; i < 16; ++i) { const int s = sb + i; const f16x2 o = (i - W >= 0) ? cur[(i - W >= 0) ? i - W : 0] : prev[(i - W >= 0) ? 0 : 16 + i - W];
            sum.x += (float)cur[i].x - (float)o.x; sum.y += (float)cur[i].y - (float)o.y;
            const float ic = 1.f / (float)(s + 1 < W ? s + 1 : W);
            *(GAS unsigned*)(mp + (mb + s) * 1024) = pk_f16(sum.x * ic - (float)cur[i].x, sum.y * ic - (float)cur[i].y); }
#pragma unroll
        for (int i = 0; i < 16; ++i) prev[i] = cur[i]; }
}
__device__ __forceinline__ void p2_post(Frame& F) {
    unsigned char* ws = F.ws;
    f16* Y = (f16*)(ws + WS_Y);
    const float* qnw = F.in[I_QNW]; const float* knw = F.in[I_KNW];
    LAS f16* vl = (LAS f16*)F.lds;
    constexpr int VLP = 264;
    for (int tt = F.vcu; tt < M / 64; tt += F.G) {
        const int b = tt >> 5, s0 = (tt & 31) * 64, m0 = tt * 64;
        for (int tk = F.wave; tk < 64; tk += NWAVES) {
            const int m = m0 + tk, s = s0 + tk; f16* yr = Y + (size_t)m * NINP;
#pragma unroll
            for (int pass = 0; pass < 2; ++pass) { const int ch = pass * 64 + F.lane; f16* pq = yr + OFF_Q + ch * 8; const f16x8 v = *(const GAS f16x8*)pq;
                float ss = 0.f;
#pragma unroll
                for (int e = 0; e < 8; ++e) ss += (float)v[e] * (float)v[e];
                ss = sum8(ss);
                const float rs = (1.f / sqrtf(ss * (1.f / 64.f) + RMS_EPS)) * (0.125f * LOG2E); const float* w = qnw + (ch & 7) * 8;
                u32x4 o; o.x = pk_f16((float)v[0] * rs * w[0], (float)v[1] * rs * w[1]); o.y = pk_f16((float)v[2] * rs * w[2], (float)v[3] * rs * w[3]);
                o.z = pk_f16((float)v[4] * rs * w[4], (float)v[5] * rs * w[5]); o.w = pk_f16((float)v[6] * rs * w[6], (float)v[7] * rs * w[7]);
                *(GAS u32x4*)((f16*)(ws + WS_QN) + (size_t)m * 1024 + ch * 8) = o; }
            { const int br = F.lane >> 5, ch = F.lane & 31, g = ch >> 3, dc = ch & 7; const f16x8 v = *(const GAS f16x8*)(yr + (br ? OFF_KW : OFF_KS) + ch * 8);
                float ss = 0.f;
#pragma unroll
                for (int e = 0; e < 8; ++e) ss += (float)v[e] * (float)v[e];
                ss = sum8(ss);
                const float rs = 1.f / sqrtf(ss * (1.f / 64.f) + RMS_EPS); const float* w = knw + dc * 8;
                u32x2 o; o.x = pk_fp8((float)v[0] * rs * w[0], (float)v[1] * rs * w[1], (float)v[2] * rs * w[2], (float)v[3] * rs * w[3]);
                o.y = pk_fp8((float)v[4] * rs * w[4], (float)v[5] * rs * w[5], (float)v[6] * rs * w[6], (float)v[7] * rs * w[7]);
                *(GAS u32x2*)(ws + WS_KN + (size_t)br * (BATCH * 4 * SEQ * 64) + ((size_t)(b * 4 + g) * 64 + (s >> 5)) * 2048 + (dc >> 2) * 1024 + ((dc & 1) * 32 + (s & 31)) * 16 + ((dc >> 1) & 1) * 8) = o; }
            { const int mat = F.lane >> 5, ch = F.lane & 31, g = ch >> 3, dc = ch & 7; const u32x4 v = *(const GAS u32x4*)(yr + (mat ? OFF_VC : OFF_KC) + ch * 8);
                const int i1 = s >> 4, jj = s & 15; f16* fa = (f16*)(ws + WS_FLATA) + (size_t)mat * 4096 * 2048;
                if (i1 <= NCMP - 1) *(GAS u32x4*)(fa + (size_t)((b * NCMP + i1) * 4 + g) * 2048 + jj * 64 + dc * 8) = v;
                if (i1 >= 1) *(GAS u32x4*)(fa + (size_t)((b * NCMP + i1 - 1) * 4 + g) * 2048 + (16 + jj) * 64 + dc * 8) = v; }
        }
        for (int idx = F.tid; idx < 64 * 48; idx += 512) { const int tk = idx / 48, c = idx - tk * 48; const float v = (float)Y[(size_t)(m0 + tk) * NINP + OFF_G + c];
            ((float*)(ws + WS_GATES))[(size_t)(m0 + tk) * 48 + c] = 1.f / (1.f + __expf(-v)); }
        { const int gg = F.tid >> 7;
          if (gg == 0) pool_mix_tile<2>(Y + OFF_U + F.tid * 2, (f16*)(ws + WS_MIXED) + F.tid * 2, (size_t)b * SEQ, s0);
          else if (gg == 1) pool_mix_tile<4>(Y + OFF_U + F.tid * 2, (f16*)(ws + WS_MIXED) + F.tid * 2, (size_t)b * SEQ, s0);
          else if (gg == 2) pool_mix_tile<8>(Y + OFF_U + F.tid * 2, (f16*)(ws + WS_MIXED) + F.tid * 2, (size_t)b * SEQ, s0);
          else pool_mix_tile<16>(Y + OFF_U + F.tid * 2, (f16*)(ws + WS_MIXED) + F.tid * 2, (size_t)b * SEQ, s0); }
        __syncthreads();
        for (int idx = F.tid; idx < 2 * 64 * 32; idx += 512) { const int br = idx >> 11, tk = (idx >> 5) & 63, ch = idx & 31;
            *(LAS u32x4*)(vl + (br * 64 + tk) * VLP + ch * 8) = *(const GAS u32x4*)(Y + (size_t)(m0 + tk) * NINP + (br ? OFF_VW : OFF_VS) + ch * 8); }
        __syncthreads();
        for (int idx = F.tid; idx < 2 * 256 * 8; idx += 512) { const int br = idx >> 11, row = (idx >> 3) & 255, cc = idx & 7, grp = cc >> 1, hh = cc & 1;
            float o[8];
#pragma unroll
            for (int j = 0; j < 8; ++j) { const int kap = 16 * grp + 8 * (j >> 2) + 4 * hh + (j & 3); o[j] = (float)vl[(br * 64 + kap) * VLP + row]; }
            const int g = row >> 6, d = row & 63;
            u32x2 o8; o8.x = pk_fp8(o[0], o[1], o[2], o[3]); o8.y = pk_fp8(o[4], o[5], o[6], o[7]);
            *(GAS u32x2*)(ws + WS_VT + (size_t)br * (BATCH * 4 * 64 * SEQ) + ((size_t)(b * 4 + g) * 64 + (s0 >> 5) + (cc >> 2)) * 2048 + (d >> 5) * 1024 + ((cc & 1) * 32 + (d & 31)) * 16 + ((cc >> 1) & 1) * 8) = o8; }
        __syncthreads();
    }
}

__device__ __forceinline__ void p4_compress2(Frame& F) {
    unsigned char* ws = F.ws;
    f16* kc = (f16*)(ws + WS_KCMP); f16* vt = (f16*)(ws + WS_VCMPT);
    const int nhalf = F.G >> 1, mat = F.vcu & 1, wgr = F.vcu >> 1;
    if (nhalf == 0) return;
    LAS float* w2l = (LAS float*)F.lds;
    { const float* w2g = F.in[mat ? I_CVW2 : I_CKW2];
      for (int idx = F.tid; idx < 256 * 16; idx += 512) { const int k = idx >> 4, d4 = (idx & 15) * 4; const f32x4 v = *(const GAS f32x4*)(w2g + (size_t)k * 64 + d4);
          LAS float* q = w2l + ((k >> 2) * 64 + d4) * 4 + (k & 3); q[0] = v.x; q[4] = v.y; q[8] = v.z; q[12] = v.w; } }
    __syncthreads();
    const int rstep = nhalf * NWAVES, r0 = (F.vcu >= 2 * nhalf ? 4096 : wgr * NWAVES + F.wave);
#pragma unroll 1
    for (int rb = r0; rb < 4096; rb += 4 * rstep) {
        f32x4 hs[4];
#pragma unroll
        for (int q = 0; q < 4; ++q) { const int r = rb + q * rstep < 4096 ? rb + q * rstep : rb; const int bg = r >> 7, i = r & 127, ic = i < NCMP ? i : 0;
            const float* hp = (const float*)(ws + WS_Y) + ((size_t)mat * 4096 + (size_t)((bg >> 2) * NCMP + ic) * 4 + (bg & 3)) * 1024 + F.lane * 4;
            hs[q] = *(const GAS f32x4*)(((const float*)(ws + WS_CBIAS)) + mat * 256 + F.lane * 4);
#pragma unroll
            for (int ks = 0; ks < 4; ++ks) hs[q] = hs[q] + *(const GAS f32x4*)(hp + ks * 256); }
        float hh_[4][4], ac[4][4];
#pragma unroll
        for (int q = 0; q < 4; ++q) { const f32x2 ga = pg8::gelu_pk((f32x2){hs[q].x, hs[q].y}), gb = pg8::gelu_pk((f32x2){hs[q].z, hs[q].w});
            hh_[q][0] = ga.x; hh_[q][1] = ga.y; hh_[q][2] = gb.x; hh_[q][3] = gb.y; ac[q][0] = 0.f; ac[q][1] = 0.f; ac[q][2] = 0.f; ac[q][3] = 0.f; }
#pragma unroll 8
        for (int kk = 0; kk < 64; ++kk) { const f32x4 wv = *(const LAS f32x4*)(w2l + (kk * 64 + F.lane) * 4);
#pragma unroll
            for (int q = 0; q < 4; ++q) { ac[q][0] += rl_f(hh_[q][0], kk) * wv.x; ac[q][1] += rl_f(hh_[q][1], kk) * wv.y; ac[q][2] += rl_f(hh_[q][2], kk) * wv.z; ac[q][3] += rl_f(hh_[q][3], kk) * wv.w; } }
#pragma unroll
        for (int q = 0; q < 4; ++q) { const int r = rb + q * rstep; if (r < 4096) {
            const int bg = r >> 7, i = r & 127;
            const float acc = i < NCMP ? (ac[q][0] + ac[q][1]) + (ac[q][2] + ac[q][3]) : 0.f;
            if (mat == 0) { const float ss = wave_sum(acc * acc); const float rs = 1.f / sqrtf(ss * (1.f / 64.f) + RMS_EPS);
                const int d = F.lane, dc = d >> 3;
                kc[((size_t)bg * 4 + (i >> 5)) * 2048 + (dc >> 1) * 512 + ((dc & 1) * 32 + (i & 31)) * 8 + (d & 7)] = (f16)(i < NCMP ? acc * rs * F.in[I_KNW][F.lane] : 0.f); }
            else { const int kap = i & 15, pp = ((kap >> 2) & 1) * 8 + (kap >> 3) * 4 + (kap & 3);
                const int d = F.lane;
                vt[((size_t)bg * 4 + (i >> 5)) * 2048 + ((d >> 5) * 2 + ((i >> 4) & 1)) * 512 + ((pp >> 3) * 32 + (d & 31)) * 8 + (pp & 7)] = (f16)acc; } } }
    }
    __syncthreads();
}

__device__ __forceinline__ int t5_bucket(int rel) {
    if (rel < 16) return rel;
    int b = 16;
    b += rel >= 19; b += rel >= 21; b += rel >= 24; b += rel >= 27; b += rel >= 31; b += rel >= 35; b += rel >= 40; b += rel >= 46;
    b += rel >= 52; b += rel >= 59; b += rel >= 67; b += rel >= 77; b += rel >= 87; b += rel >= 99; b += rel >= 113;
    return b;
}
__device__ __forceinline__ int med3i(int a, int lo, int hi) { return a < lo ? lo : (a > hi ? hi : a); }
__device__ __forceinline__ float other_half_max(float x) { const auto r = __builtin_amdgcn_permlane32_swap(__float_as_uint(x), __float_as_uint(x), false, false); return fmaxf(__uint_as_float(r[0]), __uint_as_float(r[1])); }
__device__ __forceinline__ float both_halves_sum(float x) { const auto r = __builtin_amdgcn_permlane32_swap(__float_as_uint(x), __float_as_uint(x), false, false); return __uint_as_float(r[0]) + __uint_as_float(r[1]); }
struct AFrag { u32x4 k[2]; u32x4 v[2]; };
__device__ __forceinline__ void attn_load(AFrag& f, const unsigned char* Kp, const unsigned char* Vp, int kt, int r31, int hh) {
    const unsigned char* kp = Kp + (size_t)kt * 2048 + (hh * 32 + r31) * 16; const unsigned char* vp = Vp + (size_t)kt * 2048 + (hh * 32 + r31) * 16;
#pragma unroll
    for (int j = 0; j < 2; ++j) f.k[j] = *(const GAS u32x4*)(kp + j * 1024);
#pragma unroll
    for (int dt = 0; dt < 2; ++dt) f.v[dt] = *(const GAS u32x4*)(vp + dt * 1024);
}
__device__ __forceinline__ f16x8 pack8(const f32x16& c, int s2) {
    f16x8 o;
#pragma unroll
    for (int j = 0; j < 8; ++j) o[j] = (f16)c[8 * s2 + j];
    return o;
}
__device__ __forceinline__ void attn_tile(const AFrag& f, const long (&bq8)[4], int kt, int t0, int t, int hh, int wlim, unsigned selm, float cfar, const LAS float* lutr,
                                          float& mrun, float& lrun, f32x16& O0, f32x16& O1) {
    f32x16 S;
#pragma unroll
    for (int i = 0; i < 16; ++i) S[i] = 0.f;
#pragma unroll
    for (int ks = 0; ks < 4; ++ks) S = __builtin_amdgcn_mfma_f32_32x32x16_fp8_fp8((ks & 1) ? as_i64(f.k[ks >> 1].z, f.k[ks >> 1].w) : as_i64(f.k[ks >> 1].x, f.k[ks >> 1].y), bq8[ks], S, 0, 0, 0);
    const int k0 = kt * 32, minrel = t0 - (k0 + 31), maxrel = t0 + 7 - k0;
    const bool selbit = ((selm >> (kt >> 1)) & 1u) != 0u;
    float addc = 0.f;
    if (minrel >= 113 && maxrel < wlim) addc = selbit ? cfar : -2e30f;
    else {
        const unsigned wl = selbit ? (unsigned)wlim : 0u; const int relb = t - k0 - 4 * hh;
        float bias[16];
#pragma unroll
        for (int i = 0; i < 16; ++i) bias[i] = lutr[med3i(relb - ((i & 3) + 8 * (i >> 2)), 0, 127)];
#pragma unroll
        for (int i = 0; i < 16; ++i) asm volatile("" : "+v"(bias[i]));
#pragma unroll
        for (int i = 0; i < 16; ++i) { const int rel = relb - ((i & 3) + 8 * (i >> 2)); S[i] = ((unsigned)rel < wl) ? __builtin_fmaf(bias[i], 8.f, S[i]) : -2e30f; }
    }
    float tmax = S[0];
#pragma unroll
    for (int i = 1; i < 16; ++i) tmax = fmaxf(tmax, S[i]);
    tmax = other_half_max(tmax) * 0.125f + addc;
    const float mnew = fmaxf(mrun, tmax), alpha = __builtin_amdgcn_exp2f(mrun - mnew);
    mrun = mnew; lrun *= alpha;
    if (__builtin_amdgcn_ballot_w64(alpha != 1.0f) != 0ull) {
#pragma unroll
        for (int i = 0; i < 16; ++i) { O0[i] = mul_np(O0[i], alpha); O1[i] = mul_np(O1[i], alpha); } }
    const float mm = mnew - addc;
#pragma unroll
    for (int i = 0; i < 16; ++i) { const float pv = __builtin_amdgcn_exp2f(__builtin_fmaf(S[i], 0.125f, -mm)); lrun += pv; S[i] = pv; }
#pragma unroll
    for (int s2 = 0; s2 < 2; ++s2) { const long pb = as_i64(pk_fp8(S[8 * s2], S[8 * s2 + 1], S[8 * s2 + 2], S[8 * s2 + 3]), pk_fp8(S[8 * s2 + 4], S[8 * s2 + 5], S[8 * s2 + 6], S[8 * s2 + 7]));
        O0 = __builtin_amdgcn_mfma_f32_32x32x16_fp8_fp8(s2 ? as_i64(f.v[0].z, f.v[0].w) : as_i64(f.v[0].x, f.v[0].y), pb, O0, 0, 0, 0);
        O1 = __builtin_amdgcn_mfma_f32_32x32x16_fp8_fp8(s2 ? as_i64(f.v[1].z, f.v[1].w) : as_i64(f.v[1].x, f.v[1].y), pb, O1, 0, 0, 0); }
}
__device__ __forceinline__ void attn_branch(const unsigned char* Kp, const unsigned char* Vp, unsigned long long tm, const long (&bq)[4], int t0, int t, int r31, int hh, int wlim, unsigned selm, float cfar,
                                            const LAS float* lutr, float gate, LAS float* TL) {
    float mrun = -1e30f, lrun = 0.f; f32x16 O0, O1;
#pragma unroll
    for (int i = 0; i < 16; ++i) { O0[i] = 0.f; O1[i] = 0.f; }
    AFrag fA, fB;
    int ktA = __builtin_ctzll(tm), ktB;
    attn_load(fA, Kp, Vp, ktA, r31, hh);
    for (;;) {
        tm &= tm - 1; const bool hasB = tm != 0ull; ktB = hasB ? __builtin_ctzll(tm) : ktA; attn_load(fB, Kp, Vp, ktB, r31, hh);
        attn_tile(fA, bq, ktA, t0, t, hh, wlim, selm, cfar, lutr, mrun, lrun, O0, O1);
        if (!hasB) break;
        tm &= tm - 1; const bool hasA = tm != 0ull; ktA = hasA ? __builtin_ctzll(tm) : ktB; attn_load(fA, Kp, Vp, ktA, r31, hh);
        attn_tile(fB, bq, ktB, t0, t, hh, wlim, selm, cfar, lutr, mrun, lrun, O0, O1);
        if (!hasA) break;
    }
    lrun = both_halves_sum(lrun);
    const float sc = gate / fmaxf(lrun, 1e-30f);
#pragma unroll
    for (int i = 0; i < 16; ++i) { TL[i * 64] += O0[i] * sc; TL[(16 + i) * 64] += O1[i] * sc; }
}
__device__ __forceinline__ void p5_attention(Frame& F) {
    unsigned char* ws = F.ws;
    const f16* Y = (const f16*)(ws + WS_Y);
    const float* gates = (const float*)(ws + WS_GATES);
    f16* CAT = (f16*)(ws + WS_CAT);
    LAS float* wl = (LAS float*)(F.lds + F.wave * 8192);
    LAS float* LUT = wl;
    const int gw = F.vcu * NWAVES + F.wave, NW = F.G * NWAVES;
    const bool snake = (8192 % (2 * NW)) == 0, bal = (NW == 2048);
    int lut_g = -1;
    LAS unsigned* SELM = (LAS unsigned*)(wl + 1280);
    for (int it = gw, rr = 0; it < 8192; it += NW, ++rr) {
        int n = (snake && (rr & 1)) ? (rr * NW + (NW - 1 - gw)) : it;
        if (bal) {
            const int xq = gw >> 8, u = gw & 255;
            if (rr < 3) { const int f = rr * 256 + u, q = f / 192; n = (q * 8 + xq) * 256 + 64 + (f - q * 192); }
            else { const int c = u >> 3, w = u & 7, k = (c & 7) * 4 + (w & 3); n = ((c >> 3) * 8 + xq) * 256 + ((w & 4) ? 63 - k : k); } }
        const int bg = n >> 8, pos = n & 255, b = bg >> 2, g = bg & 3, t0 = pos * 8;
        int lane = F.lane; asm volatile("" : "+v"(lane));
        const int r31 = lane & 31, hh = lane >> 5, tok8 = r31 >> 2, r = r31 & 3;
        const LAS float* lutr = LUT + r * 128;
        if (g != lut_g) {
            LDS_WAIT(); asm volatile("" ::: "memory");
#pragma unroll
            for (int e = 0; e < 2; ++e) { const int rel = lane + 64 * e, bk = t5_bucket(rel);
#pragma unroll
                for (int r4 = 0; r4 < 4; ++r4) LUT[r4 * 128 + rel] = F.in[I_RELB][bk * 16 + 4 * g + r4] * LOG2E; }
            LDS_WAIT(); asm volatile("" ::: "memory");
            lut_g = g;
        }
        const int t = t0 + tok8, head = 4 * g + r; const size_t m = (size_t)b * SEQ + t;
        f16x8 bq[4];
#pragma unroll
        for (int ks = 0; ks < 4; ++ks) bq[ks] = *(const GAS f16x8*)((const f16*)(ws + WS_QN) + m * 1024 + head * 64 + ks * 16 + hh * 8);
        long bq8[4];
#pragma unroll
        for (int ks = 0; ks < 4; ++ks) bq8[ks] = as_i64(pk_fp8((float)bq[ks][0] * 8.f, (float)bq[ks][1] * 8.f, (float)bq[ks][2] * 8.f, (float)bq[ks][3] * 8.f),
                                                        pk_fp8((float)bq[ks][4] * 8.f, (float)bq[ks][5] * 8.f, (float)bq[ks][6] * 8.f, (float)bq[ks][7] * 8.f));
        const float g_c = gates[m * 48 + head * 3 + 0], g_s = gates[m * 48 + head * 3 + 1], g_w = gates[m * 48 + head * 3 + 2];
        const float cfar = lutr[127];
        LAS float* TL = (LAS float*)(F.lds + 65536 + F.wave * 8192) + lane;
        {
            const f16* kc = (const f16*)(ws + WS_KCMP) + (size_t)bg * 128 * 64;
            const f16* vc = (const f16*)(ws + WS_VCMPT) + (size_t)bg * 64 * 128;
            f32x16 c[4];
#pragma unroll
            for (int kt = 0; kt < 4; ++kt) {
#pragma unroll
                for (int i = 0; i < 16; ++i) c[kt][i] = 0.f;
#pragma unroll
                for (int ks = 0; ks < 4; ++ks) { const f16x8 a = *(const GAS f16x8*)(kc + kt * 2048 + ks * 512 + (hh * 32 + r31) * 8); c[kt] = __builtin_amdgcn_mfma_f32_32x32x16_f16(a, bq[ks], c[kt], 0, 0, 0); }
                asm volatile("" ::: "memory");
            }
            const int relb = t - 31 - 64 * hh; float mx = -1e30f;
#pragma unroll
            for (int kt = 0; kt < 4; ++kt) { float bias[16];
#pragma unroll
                for (int i = 0; i < 16; ++i) { const int rel = relb - 16 * (kt * 32 + (i & 3) + 8 * (i >> 2)); bias[i] = lutr[med3i(rel, 0, 127)]; }
#pragma unroll
                for (int i = 0; i < 16; ++i) asm volatile("" : "+v"(bias[i]));
#pragma unroll
                for (int i = 0; i < 16; ++i) { const int rel = relb - 16 * (kt * 32 + (i & 3) + 8 * (i >> 2));
                    const float sv = rel >= 0 ? c[kt][i] + bias[i] : -2e30f; c[kt][i] = sv; mx = fmaxf(mx, sv); }
                asm volatile("" ::: "memory"); }
            mx = other_half_max(mx);
            float l = 0.f;
#pragma unroll
            for (int kt = 0; kt < 4; ++kt)
#pragma unroll
                for (int i = 0; i < 16; ++i) { const float pv = __builtin_amdgcn_exp2f(c[kt][i] - mx); c[kt][i] = pv; l += pv; }
            l = both_halves_sum(l);
            const float inv = 1.f / fmaxf(l, 1e-30f);
#pragma unroll
            for (int kt = 0; kt < 4; ++kt)
#pragma unroll
                for (int jj = 0; jj < 4; ++jj) { float own = (2.f * (c[kt][4 * jj] + c[kt][4 * jj + 1] + c[kt][4 * jj + 2]) + c[kt][4 * jj + 3]) * inv, p3 = c[kt][4 * jj + 3] * inv;
                    own += dpp_f<0xB1>(own); own += dpp_f<0x4E>(own); p3 += dpp_f<0xB1>(p3); p3 += dpp_f<0x4E>(p3);
                    if (r == 0) { const int j = kt * 8 + 2 * jj + hh; wl[512 + tok8 * 32 + j] = own; wl[768 + tok8 * 32 + j] = p3; } }
            f32x16 O0, O1;
#pragma unroll
            for (int i = 0; i < 16; ++i) { O0[i] = 0.f; O1[i] = 0.f; }
#pragma unroll
            for (int kt = 0; kt < 4; ++kt)
#pragma unroll
                for (int s2 = 0; s2 < 2; ++s2) { const f16x8 pb = pack8(c[kt], s2);
                    const f16x8 a0 = *(const GAS f16x8*)(vc + kt * 2048 + s2 * 512 + (hh * 32 + r31) * 8), a1 = *(const GAS f16x8*)(vc + kt * 2048 + (2 + s2) * 512 + (hh * 32 + r31) * 8);
                    O0 = __builtin_amdgcn_mfma_f32_32x32x16_f16(a0, pb, O0, 0, 0, 0); O1 = __builtin_amdgcn_mfma_f32_32x32x16_f16(a1, pb, O1, 0, 0, 0); asm volatile("" ::: "memory"); }
            const float sc = inv * g_c;
#pragma unroll
            for (int i = 0; i < 16; ++i) { TL[i * 64] = O0[i] * sc; TL[(16 + i) * 64] = O1[i] * sc; }
        }
        LDS_WAIT(); asm volatile("" ::: "memory");
        int lane2 = lane; asm volatile("" : "+v"(lane2));
        LAS float* OWN = wl + 512 + (lane2 >> 5) * 32 + (lane2 & 31); LAS float* P3 = OWN + 256; LAS float* VAL = OWN + 512;
#pragma unroll
        for (int pp = 0; pp < 4; ++pp) { const int tk = 2 * pp + hh, j = r31, cur = (t0 + tk) >> 6;
            const float impv = OWN[pp * 64] + (j > 0 ? P3[pp * 64 - (j > 0 ? 1 : 0)] : 0.f);
            VAL[pp * 64] = (j == 0 || j == cur || j == cur - 1) ? 1e4f : (j <= cur ? impv : -1e30f); }
        LDS_WAIT(); asm volatile("" ::: "memory");
#pragma unroll
        for (int pp = 0; pp < 4; ++pp) { const int tk = 2 * pp + hh, j = r31, cur = (t0 + tk) >> 6; const float v = VAL[pp * 64]; int cnt = 0; const LAS float* vrow = VAL + pp * 64 - j;
#pragma unroll
            for (int j2 = 0; j2 < 32; ++j2) { const float o = vrow[j2]; cnt += (o > v || (o == v && j2 < j)) ? 1 : 0; }
            const unsigned long long bm = __ballot(cnt < 8 && j <= cur);
            const unsigned mym = hh ? (unsigned)(bm >> 32) : (unsigned)bm;
            if (j == 0) SELM[tk] = mym; }
        LDS_WAIT(); asm volatile("" ::: "memory");
        const unsigned selm = SELM[tok8];
        unsigned um = 0u;
#pragma unroll
        for (int i = 0; i < 8; ++i) um |= SELM[i];
        um = (unsigned)__builtin_amdgcn_readfirstlane((int)um);
        const int kthi = (t0 + 7) >> 5;
        const unsigned long long causal = (kthi >= 63) ? ~0ull : ((1ull << (kthi + 1)) - 1ull);
        {
            unsigned long long x = um;
            x = (x | (x << 16)) & 0x0000FFFF0000FFFFull; x = (x | (x << 8)) & 0x00FF00FF00FF00FFull; x = (x | (x << 4)) & 0x0F0F0F0F0F0F0F0Full;
            x = (x | (x << 2)) & 0x3333333333333333ull; x = (x | (x << 1)) & 0x5555555555555555ull;
            const unsigned long long tm = (x | (x << 1)) & causal;
            attn_branch(ws + WS_KN + (size_t)bg * SEQ * 64, ws + WS_VT + (size_t)bg * 64 * SEQ, tm, bq8, t0, t, r31, hh, 1 << 30, selm, cfar, lutr, g_s, TL);
        }
        {
            const int lo = t0 - 511 > 0 ? (t0 - 511) >> 5 : 0;
            const unsigned long long tm = causal & ~((1ull << lo) - 1ull);
            attn_branch(ws + WS_KN + (size_t)(BATCH * 4 + bg) * SEQ * 64, ws + WS_VT + (size_t)(BATCH * 4 + bg) * 64 * SEQ, tm, bq8, t0, t, r31, hh, 512, 0xFFFFFFFFu, cfar, lutr, g_w, TL);
        }
        unsigned char* orow = ws + WS_CAT + m * D + 1024 + head * 64 + 4 * hh;
#pragma unroll
        for (int jj = 0; jj < 4; ++jj) {
            *(GAS unsigned*)(orow + 8 * jj) = pk_fp8(TL[(4 * jj) * 64] * CAT8SCALE, TL[(4 * jj + 1) * 64] * CAT8SCALE, TL[(4 * jj + 2) * 64] * CAT8SCALE, TL[(4 * jj + 3) * 64] * CAT8SCALE);
            *(GAS unsigned*)(orow + 32 + 8 * jj) = pk_fp8(TL[(16 + 4 * jj) * 64] * CAT8SCALE, TL[(16 + 4 * jj + 1) * 64] * CAT8SCALE, TL[(16 + 4 * jj + 2) * 64] * CAT8SCALE, TL[(16 + 4 * jj + 3) * 64] * CAT8SCALE); }
    }
}

__device__ __forceinline__ void cvt_row_fp6(const f32x4 (&v)[8], int row, unsigned char* dst6, float* scales, int lane, bool pairt) {
    float amax = 0.f;
#pragma unroll
    for (int c = 0; c < 8; ++c) amax = fmaxf(amax, fmaxf(fmaxf(fabsf(v[c].x), fabsf(v[c].y)), fmaxf(fabsf(v[c].z), fabsf(v[c].w))));
    amax = wave_max(amax);
    const float scale = amax > 0.f ? amax * (1.f / 7.5f) : 1.f, inv = 1.f / scale;
    f16x32 h;
#pragma unroll
    for (int c = 0; c < 8; ++c) { h[4 * c] = (f16)(v[c].x * inv); h[4 * c + 1] = (f16)(v[c].y * inv); h[4 * c + 2] = (f16)(v[c].z * inv); h[4 * c + 3] = (f16)(v[c].w * inv); }
    const u32x6 pk = __builtin_amdgcn_cvt_scalef32_pk32_fp6_f16(h, 1.0f);
    unsigned char* d = dst6 + (size_t)(lane >> 3) * SLICE6;
    *(GAS u32x4*)(d + (size_t)row * 128 + (lane & 7) * 16) = (u32x4){pk[0], pk[1], pk[2], pk[3]}; *(GAS u32x2*)(d + 2097152 + (size_t)row * 64 + (pairt ? (lane & 3) * 16 + ((lane >> 2) & 1) * 8 : (lane & 7) * 8)) = (u32x2){pk[4], pk[5]};
    if (lane == 0) scales[row] = scale;
}
__device__ __forceinline__ void cvt_table_fp6(Frame& F, const float* src, unsigned char* dst6, float* scales, const float* colw, bool pairt) {
    const int gw = F.vcu * NWAVES + F.wave, NGW = F.G * NWAVES, lane = F.lane;
    int row = gw;
    for (; row + NGW < 16384; row += 2 * NGW) {
        f32x4 va[8], vb[8];
#pragma unroll
        for (int c = 0; c < 8; ++c) { va[c] = __builtin_nontemporal_load((const GAS f32x4*)(src + (size_t)row * D + c * 256 + lane * 4)); vb[c] = __builtin_nontemporal_load((const GAS f32x4*)(src + (size_t)(row + NGW) * D + c * 256 + lane * 4)); }
        if (colw) {
#pragma unroll
            for (int c = 0; c < 8; ++c) { const f32x4 wv = *(const GAS f32x4*)(colw + c * 256 + lane * 4); va[c] = va[c] * wv; vb[c] = vb[c] * wv; } }
        cvt_row_fp6(va, row, dst6, scales, lane, pairt); cvt_row_fp6(vb, row + NGW, dst6, scales, lane, pairt);
    }
    for (; row < 16384; row += NGW) { f32x4 va[8];
#pragma unroll
        for (int c = 0; c < 8; ++c) { va[c] = *(const GAS f32x4*)(src + (size_t)row * D + c * 256 + lane * 4); if (colw) va[c] = va[c] * *(const GAS f32x4*)(colw + c * 256 + lane * 4); }
        cvt_row_fp6(va, row, dst6, scales, lane, pairt); }
}
__device__ __forceinline__ void p7_tables(Frame& F) {
    cvt_table_fp6(F, F.in[I_PU], F.ws + WS_U6, (float*)(F.ws + WS_SU), F.in[I_FFNNW], true);
    cvt_table_fp6(F, F.in[I_PV], F.ws + WS_V6, (float*)(F.ws + WS_SV), nullptr, false);
}

__device__ __forceinline__ void bitonic_sort16_desc(float (&a)[16]) {
#pragma unroll
    for (int k = 2; k <= 16; k <<= 1)
#pragma unroll
        for (int j = k >> 1; j > 0; j >>= 1)
#pragma unroll
            for (int i = 0; i < 16; ++i) { const int l = i ^ j; if (l > i) { const float hi = fmaxf(a[i], a[l]), lo = fminf(a[i], a[l]); if ((i & k) == 0) { a[i] = hi; a[l] = lo; } else { a[i] = lo; a[l] = hi; } } }
}
__device__ __forceinline__ void bitonic_merge16_desc(float (&a)[16]) {
#pragma unroll
    for (int dist = 8; dist >= 1; dist >>= 1)
#pragma unroll
        for (int i = 0; i < 16; ++i) if ((i & dist) == 0) { const float hi = fmaxf(a[i], a[i + dist]), lo = fminf(a[i], a[i + dist]); a[i] = hi; a[i + dist] = lo; }
}
#define INS16(top, v) do { _Pragma("unroll") for (int _j = 0; _j < 16; ++_j) { const float _h = fmaxf(top[_j], v); v = fminf(top[_j], v); top[_j] = _h; } } while (0)
#define INS16P(tv, ti, v, i) do { _Pragma("unroll") for (int _j = 0; _j < 16; ++_j) { const bool _c = v > tv[_j]; const float _nv = _c ? tv[_j] : v; const unsigned _ni = _c ? ti[_j] : i; \
        tv[_j] = _c ? v : tv[_j]; ti[_j] = _c ? i : ti[_j]; v = _nv; i = _ni; } } while (0)
typedef unsigned v4u_t __attribute__((__vector_size__(16)));
typedef unsigned v2u_t __attribute__((__vector_size__(8)));
__device__ __forceinline__ void p9a_topk(Frame& F) {
    unsigned char* ws = F.ws;
    const f16* QP = (const f16*)(ws + WS_QP); const f16* KEYS = (const f16*)(ws + WS_KEYS);
    unsigned* LIDX = (unsigned*)(ws + WS_LIDX); float* LG = (float*)(ws + WS_LG);
    const int lane = F.lane, r31 = lane & 31, hh = lane >> 5;
    const float NINF = -__builtin_inff();
    for (int unit = F.vcu; unit < M / 32; unit += F.G) {
        const int m0 = unit * 32;
        {
            const int h = F.wave;
            float sl[2][16];
            f16x8 bq[8], ka[8];
#pragma unroll
            for (int ks = 0; ks < 8; ++ks) { bq[ks] = *(const GAS f16x8*)(QP + (size_t)(m0 + r31) * D + (h * 2) * 128 + ks * 16 + hh * 8);
                ka[ks] = *(const GAS f16x8*)(KEYS + ((size_t)((h * 2) * 128 + r31)) * 128 + hh * 8 + ks * 16); }
            float top[16];
#pragma unroll
            for (int st = 0; st < 8; ++st) { const int p = st >> 2, kt = st & 3;
                if (kt == 0) {
#pragma unroll
                    for (int j = 0; j < 16; ++j) top[j] = NINF; }
                f32x16 c;
#pragma unroll
                for (int i = 0; i < 16; ++i) c[i] = 0.f;
#pragma unroll
                for (int ks = 0; ks < 8; ++ks) c = __builtin_amdgcn_mfma_f32_32x32x16_f16(ka[ks], bq[ks], c, 0, 0, 0);
                if (st + 1 < 8) { const int pn = (st + 1) >> 2, ktn = (st + 1) & 3;
#pragma unroll
                    for (int ks = 0; ks < 8; ++ks) ka[ks] = *(const GAS f16x8*)(KEYS + ((size_t)((h * 2 + pn) * 128 + ktn * 32 + r31)) * 128 + hh * 8 + ks * 16);
                    if (st == 3) {
#pragma unroll
                        for (int ks = 0; ks < 8; ++ks) bq[ks] = *(const GAS f16x8*)(QP + (size_t)(m0 + r31) * D + (h * 2 + 1) * 128 + ks * 16 + hh * 8); } }
                const unsigned k4 = (unsigned)(kt * 32 + 4 * hh);
                float nv[16];
#pragma unroll
                for (int reg = 0; reg < 16; ++reg) { const unsigned key = k4 + (unsigned)((reg & 3) + 8 * (reg >> 2)); nv[reg] = __uint_as_float((__float_as_uint(c[reg]) & ~127u) | key); }
                bitonic_sort16_desc(nv);
#pragma unroll
                for (int j = 0; j < 16; ++j) top[j] = fmaxf(top[j], nv[15 - j]);
                bitonic_merge16_desc(top);
                if (kt == 3) {
                    float cm[16];
#pragma unroll
                    for (int j = 0; j < 16; ++j) cm[j] = fmaxf(top[j], __uint_as_float(other32u(__float_as_uint(top[15 - j]), hh != 0)));
                    bitonic_merge16_desc(cm);
#pragma unroll
                    for (int j = 0; j < 16; ++j) sl[p][j] = cm[j]; }
            }
            float vx[16], vy[16]; unsigned ix[16], iy[16];
#pragma unroll
            for (int j = 0; j < 16; ++j) { const unsigned bx = __float_as_uint(hh ? sl[1][j] : sl[0][j]), by = __float_as_uint(hh ? sl[0][j] : sl[1][j]);
                vx[j] = __uint_as_float(bx & ~127u); vy[j] = __uint_as_float(by & ~127u); ix[j] = (bx & 127u) * (hh ? 1u : 128u); iy[j] = (by & 127u) * (hh ? 128u : 1u); }
            float tv[16]; unsigned ti[16];
#pragma unroll
            for (int j = 0; j < 16; ++j) { const int jb = j + 1 < 16 ? j + 1 : 15;
                const float v0 = vx[0] + vy[j], v1 = (j < 15) ? vx[0] + vy[jb] : NINF; const unsigned i0 = ix[0] + iy[j], i1 = ix[0] + iy[jb];
                tv[j] = hh ? v1 : v0; ti[j] = hh ? i1 : i0; }
#pragma unroll
            for (int a = 1; a < 4; ++a) { const int bmax = (a == 1) ? 7 : (a == 2 ? 4 : 3);
#pragma unroll
                for (int b = a; b <= bmax; ++b) { float v = vx[a] + vy[b]; if (a == b) v = hh ? NINF : v; unsigned i = ix[a] + iy[b]; INS16P(tv, ti, v, i); } }
            float mv[16]; unsigned mi[16];
#pragma unroll
            for (int j = 0; j < 16; ++j) { const float pv = __uint_as_float(other32u(__float_as_uint(tv[15 - j]), hh != 0)); const unsigned pi = other32u(ti[15 - j], hh != 0); const bool c = pv > tv[j]; mv[j] = c ? pv : tv[j]; mi[j] = c ? pi : ti[j]; }
            float mx = mv[0];
#pragma unroll
            for (int j = 1; j < 16; ++j) mx = fmaxf(mx, mv[j]);
            float sum = 0.f;
#pragma unroll
            for (int j = 0; j < 16; ++j) { mv[j] = __builtin_amdgcn_exp2f((mv[j] - mx) * LOG2E); sum += mv[j]; }
            const float inv = 1.f / sum;
#pragma unroll
            for (int j = 0; j < 8; ++j) { { const int e_ = h * 16 + hh * 8 + j, pos_ = (e_ & 63) * 2 + (e_ >> 6); LIDX[(size_t)(m0 + r31) * 128 + pos_] = mi[j]; LG[(size_t)(m0 + r31) * 128 + pos_] = mv[j] * inv; } }
        }
    }
}
struct Seg6 { v4u_t a; v2u_t b; };
__device__ __forceinline__ f16x32 seg6_decode(const Seg6& r) { const u32x6 p = {r.a[0], r.a[1], r.a[2], r.a[3], r.b[0], r.b[1]}; return __builtin_amdgcn_cvt_scalef32_pk32_f16_fp6(p, 1.0f); }
__device__ __forceinline__ f16x32 seg6_dec2(const v4u_t& a, const v2u_t& b) { const u32x6 p = {a[0], a[1], a[2], a[3], b[0], b[1]}; return __builtin_amdgcn_cvt_scalef32_pk32_f16_fp6(p, 1.0f); }
#define SEG_DECL(P) v4u_t P##a0, P##a1, P##a2, P##a3, P##a4, P##a5, P##a6, P##a7; v2u_t P##b0, P##b1, P##b2, P##b3, P##b4, P##b5, P##b6, P##b7
#define SEG_L1(P, G, idxv) do { const int e_ = __shfl(idxv, 8 * G + sub); P##a##G = __builtin_amdgcn_raw_buffer_load_b128(rs, e_ * 128 + ch * 16, 0, 0); P##b##G = __builtin_amdgcn_raw_buffer_load_b64(rs, 2097152 + e_ * 64 + ch * 8, 0, 0); } while (0)
#define SEG_LOAD(P, idxv) do { SEG_L1(P, 0, idxv); SEG_L1(P, 1, idxv); SEG_L1(P, 2, idxv); SEG_L1(P, 3, idxv); SEG_L1(P, 4, idxv); SEG_L1(P, 5, idxv); SEG_L1(P, 6, idxv); SEG_L1(P, 7, idxv); } while (0)
__device__ __forceinline__ float u_one(const v4u_t& a, const v2u_t& b, const f16x2 (&xp)[16]) {
    const f16x32 hv = seg6_dec2(a, b); float sdot = 0.f;
#pragma unroll
    for (int k = 0; k < 16; ++k) { f16x2 hp; hp.x = hv[2 * k]; hp.y = hv[2 * k + 1]; sdot = __builtin_amdgcn_fdot2(hp, xp[k], sdot, false); }
    return sum8(sdot);
}
#define SEG_LE(P, G, ev) do { const int e_ = (ev); P##a##G = __builtin_amdgcn_raw_buffer_load_b128(rs, e_ * 128 + ch * 16, 0, 0); P##b##G = __builtin_amdgcn_raw_buffer_load_b64(rs, 2097152 + e_ * 64 + ch * 8, 0, 0); } while (0)
#define EN_GATHER(en, iA, iB) do { _Pragma("unroll") for (int g_ = 0; g_ < 8; ++g_) { en[g_] = __shfl(iA, 8 * g_ + sub); en[8 + g_] = __shfl(iB, 8 * g_ + sub); } } while (0)
#define U_ROLL1(P, G, res, eo) do { const float d_ = u_one(P##a##G, P##b##G, xp); res = (ch == G) ? d_ : res; SEG_LE(P, G, en[(eo) + G]); } while (0)
#define U_ROLL(P, res, idxn) do { U_ROLL1(P, 0, res, idxn); U_ROLL1(P, 1, res, idxn); U_ROLL1(P, 2, res, idxn); U_ROLL1(P, 3, res, idxn); U_ROLL1(P, 4, res, idxn); U_ROLL1(P, 5, res, idxn); U_ROLL1(P, 6, res, idxn); U_ROLL1(P, 7, res, idxn); } while (0)
#define V_ROLL1(P, G, hwv, eo) do { v_one(P##a##G, P##b##G, acc, hq[(eo) + G]); SEG_LE(P, G, en[(eo) + G]); } while (0)
#define V_ROLL(P, hwv, idxn) do { V_ROLL1(P, 0, hwv, idxn); V_ROLL1(P, 1, hwv, idxn); V_ROLL1(P, 2, hwv, idxn); V_ROLL1(P, 3, hwv, idxn); V_ROLL1(P, 4, hwv, idxn); V_ROLL1(P, 5, hwv, idxn); V_ROLL1(P, 6, hwv, idxn); V_ROLL1(P, 7, hwv, idxn); } while (0)
#define FMIXV_LO(a, h, w) asm("v_fma_mix_f32 %0, %1, %2, %0 op_sel_hi:[1,0,0]" : "+v"(a) : "v"(h), "v"(w))
#define FMIXV_HI(a, h, w) asm("v_fma_mix_f32 %0, %1, %2, %0 op_sel:[1,0,0] op_sel_hi:[1,0,0]" : "+v"(a) : "v"(h), "v"(w))
__device__ __forceinline__ void v_one(const v4u_t& a, const v2u_t& b, f16x2 (&acc)[16], f16x2 wq) {
    const f16x32 hv = seg6_dec2(a, b);
#pragma unroll
    for (int k = 0; k < 16; ++k) { f16x2 hp; hp.x = hv[2 * k]; hp.y = hv[2 * k + 1]; acc[k] = __builtin_elementwise_fma(hp, wq, acc[k]); }
}
#define V_HALF(P, hwv) do { v_one(P##a0, P##b0, acc, hwv, sub); v_one(P##a1, P##b1, acc, hwv, 8 + sub); v_one(P##a2, P##b2, acc, hwv, 16 + sub); v_one(P##a3, P##b3, acc, hwv, 24 + sub); \
        v_one(P##a4, P##b4, acc, hwv, 32 + sub); v_one(P##a5, P##b5, acc, hwv, 40 + sub); v_one(P##a6, P##b6, acc, hwv, 48 + sub); v_one(P##a7, P##b7, acc, hwv, 56 + sub); } while (0)
#define WSEG_DECL(P) v4u_t P##h0, P##h1, P##h2, P##h3, P##g0, P##g1, P##g2, P##g3, P##t0, P##t1, P##t2, P##t3
#define WSEG_LE(P, G, ev) do { const int e_ = (ev); P##h##G = __builtin_amdgcn_raw_buffer_load_b128(rs, e_ * 128 + q4 * 16, 0, 0); P##g##G = __builtin_amdgcn_raw_buffer_load_b128(rs, e_ * 128 + 64 + q4 * 16, 0, 0); \
        P##t##G = __builtin_amdgcn_raw_buffer_load_b128(rs, 2097152 + e_ * 64 + q4 * 16, 0, 0); } while (0)
#define WSEG_LOAD(P, idxv) do { WSEG_LE(P, 0, __shfl(idxv, sub16)); WSEG_LE(P, 1, __shfl(idxv, 16 + sub16)); WSEG_LE(P, 2, __shfl(idxv, 32 + sub16)); WSEG_LE(P, 3, __shfl(idxv, 48 + sub16)); } while (0)
#define WEN_GATHER(en, iA, iB) do { _Pragma("unroll") for (int g_ = 0; g_ < 4; ++g_) { en[g_] = __shfl(iA, 16 * g_ + sub16); en[4 + g_] = __shfl(iB, 16 * g_ + sub16); } } while (0)
__device__ __forceinline__ float u_one2(const v4u_t& h, const v4u_t& g, const v4u_t& t, const f16x2 (&xp)[32]) {
    const f16x32 h0 = seg6_dec2(h, (v2u_t){t[0], t[1]}), h1 = seg6_dec2(g, (v2u_t){t[2], t[3]}); float sdot = 0.f;
#pragma unroll
    for (int k = 0; k < 16; ++k) { f16x2 hp; hp.x = h0[2 * k]; hp.y = h0[2 * k + 1]; sdot = __builtin_amdgcn_fdot2(hp, xp[k], sdot, false); }
#pragma unroll
    for (int k = 0; k < 16; ++k) { f16x2 hp; hp.x = h1[2 * k]; hp.y = h1[2 * k + 1]; sdot = __builtin_amdgcn_fdot2(hp, xp[16 + k], sdot, false); }
    sdot += dpp_f<0xB1>(sdot); sdot += dpp_f<0x4E>(sdot);
    return sdot;
}
#define WU_ROLL1(P, G, res, eo) do { const float d_ = u_one2(P##h##G, P##g##G, P##t##G, xp); res = (q4 == G) ? d_ : res; WSEG_LE(P, G, en[(eo) + G]); __builtin_amdgcn_sched_barrier(0); } while (0)
#define WU_ROLL(P, res, idxn) do { WU_ROLL1(P, 0, res, idxn); WU_ROLL1(P, 1, res, idxn); WU_ROLL1(P, 2, res, idxn); WU_ROLL1(P, 3, res, idxn); } while (0)
__device__ __forceinline__ void p9b_upass(Frame& F, bool probe_slice0) {
    unsigned char* ws = F.ws;
    const int x = blockIdx.x & 7, rank = blockIdx.x >> 3, cnt = (F.G - x + 7) >> 3;
    const int lane = F.lane, sub16 = lane >> 2, q4 = lane & 3;
    const __amdgpu_buffer_rsrc_t rs = __builtin_amdgcn_make_buffer_rsrc((void*)(ws + WS_U6 + (size_t)(probe_slice0 ? 0 : x) * SLICE6), 0, (int)SLICE6, 0x00020000);
    const f16* XN = (const f16*)(ws + WS_XR) + x * 32 + (lane >> 3) * 256 + (lane & 7) * 4;
    const u32x2* LI2 = (const u32x2*)(ws + WS_LIDX); LAS unsigned char* xl = F.lds + F.wave * 512;
    const int tstep = cnt * NWAVES; int t = rank * NWAVES + F.wave;
    if (t >= M) return;
    int cA, cB, nA, nB; { const u32x2 c2 = LI2[(size_t)t * 64 + lane]; cA = (int)c2.x; cB = (int)c2.y; }
    const int t1c = (t + tstep < M) ? t + tstep : t;
    { const u32x2 n2 = LI2[(size_t)t1c * 64 + lane]; nA = (int)n2.x; nB = (int)n2.y; }
    u32x2 xcur = *(const GAS u32x2*)(XN + (size_t)t * D);
    f16x2 xp[32];
    WSEG_DECL(bA); WSEG_DECL(bB);
    { const int li_ = cA; WSEG_LOAD(bA, li_); } { const int li_ = cB; WSEG_LOAD(bB, li_); }
#pragma unroll 1
    for (;;) {
        const int tn = t + tstep, tnn = tn + tstep; const bool hn = tn < M, hnn = tnn < M;
        const int tnc = hn ? tn : t, tnnc = hnn ? tnn : t;
        const u32x2 m2 = LI2[(size_t)tnnc * 64 + lane]; const int mA = (int)m2.x, mB = (int)m2.y;
        const u32x2 xnext = *(const GAS u32x2*)(XN + (size_t)tnc * D);
        *(LAS u32x2*)(xl + ((lane & 7) * 8 + (lane >> 3)) * 8) = xcur;
        LDS_WAIT(); asm volatile("" ::: "memory");
#pragma unroll
        for (int hc = 0; hc < 2; ++hc)
#pragma unroll
            for (int q = 0; q < 4; ++q) { const u32x4 tv = *(const LAS u32x4*)(xl + (q4 + 4 * hc) * 64 + q * 16); xp[16 * hc + 4 * q] = ash2(tv.x); xp[16 * hc + 4 * q + 1] = ash2(tv.y); xp[16 * hc + 4 * q + 2] = ash2(tv.z); xp[16 * hc + 4 * q + 3] = ash2(tv.w); }
        LDS_WAIT(); asm volatile("" ::: "memory");
        { const int lA_ = hn ? nA : cA, lB_ = hn ? nB : cB; int en[8]; WEN_GATHER(en, lA_, lB_);
          float rA = 0.f, rB = 0.f; WU_ROLL(bA, rA, 0); WU_ROLL(bB, rB, 4);
          float* pd = (float*)(ws + WS_PD) + ((size_t)t * 8 + x) * 128 + 16 * q4 + sub16; pd[0] = rA; pd[64] = rB; }
        if (!hn) break;
        xcur = xnext;
        cA = nA; cB = nB; nA = mA; nB = mB; t = tn;
    }
}
__device__ __forceinline__ void p9h_weights(Frame& F) {
    unsigned char* ws = F.ws;
    const unsigned* LIDX = (const unsigned*)(ws + WS_LIDX); const float* LG = (const float*)(ws + WS_LG); const float* PD = (const float*)(ws + WS_PD);
    const float* SU = (const float*)(ws + WS_SU); const float* SV = (const float*)(ws + WS_SV); float* HW = (float*)(ws + WS_HW);
    const int gw = F.vcu * NWAVES + F.wave, NGW = F.G * NWAVES, lane = F.lane;
#pragma unroll 1
    for (int t0 = gw; t0 < M; t0 += 2 * NGW) {
        const int t1 = t0 + NGW < M ? t0 + NGW : t0;
        int iA[2], iB[2]; float pa[2][8], pb[2][8], lgA[2], lgB[2], s1[2];
#pragma unroll
        for (int q = 0; q < 2; ++q) { const int t = q ? t1 : t0; { const u32x2 i2 = ((const u32x2*)LIDX)[(size_t)t * 64 + lane]; iA[q] = (int)i2.x; iB[q] = (int)i2.y; }
#pragma unroll
            for (int xs = 0; xs < 8; ++xs) { pa[q][xs] = PD[((size_t)t * 8 + xs) * 128 + lane]; pb[q][xs] = PD[((size_t)t * 8 + xs) * 128 + 64 + lane]; }
            { const f32x2 g2 = ((const f32x2*)LG)[(size_t)t * 64 + lane]; lgA[q] = g2.x; lgB[q] = g2.y; } s1[q] = ((const float*)(ws + WS_SS1))[t]; }
#pragma unroll
        for (int q = 0; q < 2; ++q) { const int t = q ? t1 : t0; float zA = 0.f, zB = 0.f;
#pragma unroll
            for (int xs = 0; xs < 8; ++xs) { zA += pa[q][xs]; zB += pb[q][xs]; }
            const float rs1 = 1.f / sqrtf(s1[q] * (1.f / D) + RMS_EPS);
            ((f32x2*)HW)[(size_t)t * 64 + lane] = (f32x2){pg8::gelu1(zA * rs1 * SU[iA[q]]) * lgA[q] * SV[iA[q]], pg8::gelu1(zB * rs1 * SU[iB[q]]) * lgB[q] * SV[iB[q]]}; }
    }
}
__device__ __forceinline__ void p9c_vpass(Frame& F) {
    unsigned char* ws = F.ws;
    const int x = blockIdx.x & 7, rank = blockIdx.x >> 3, cnt = (F.G - x + 7) >> 3;
    const int lane = F.lane, sub = lane >> 3, ch = lane & 7;
    const __amdgpu_buffer_rsrc_t rs = __builtin_amdgcn_make_buffer_rsrc((void*)(ws + WS_V6 + (size_t)x * SLICE6), 0, (int)SLICE6, 0x00020000);
    const u32x2* LI2 = (const u32x2*)(ws + WS_LIDX);
    f16* XR = (f16*)(ws + WS_XR); float* SS2 = (float*)(ws + WS_SS2);
    const bool b3 = (lane & 8) != 0, b4 = (lane & 16) != 0, b5 = (lane & 32) != 0;
    const int col = ((b3 ? 4 : 0) + (b4 ? 2 : 0) + (b5 ? 1 : 0)) * 256 + x * 32 + ch * 4;
    const int tstep = cnt * NWAVES; int t = rank * NWAVES + F.wave;
    if (t >= M) return;
    int cA, cB, nA, nB; { const u32x2 c2 = LI2[(size_t)t * 64 + lane]; cA = (int)c2.x; cB = (int)c2.y; }
    const int t1c = (t + tstep < M) ? t + tstep : t;
    { const u32x2 n2 = LI2[(size_t)t1c * 64 + lane]; nA = (int)n2.x; nB = (int)n2.y; }
    const f32x2* HW2 = (const f32x2*)(ws + WS_HW);
    float hwA, hwB; { const f32x2 h2 = HW2[(size_t)t * 64 + lane]; hwA = h2.x; hwB = h2.y; }
    SEG_DECL(bA); SEG_DECL(bB);
    { const int li_ = cA; SEG_LOAD(bA, li_); } { const int li_ = cB; SEG_LOAD(bB, li_); }
#pragma unroll 1
    for (;;) {
        const int tn = t + tstep, tnn = tn + tstep; const bool hn = tn < M, hnn = tnn < M;
        const int tnc = hn ? tn : t, tnnc = hnn ? tnn : t;
        const u32x2 m2 = LI2[(size_t)tnnc * 64 + lane]; const int mA = (int)m2.x, mB = (int)m2.y;
        const f32x2 hn2 = HW2[(size_t)tnc * 64 + lane]; const float hwAn = hn2.x, hwBn = hn2.y;
        f16* orow = XR + (size_t)t * D + col; const u32x2 x1r = *(const GAS u32x2*)orow;
        f16x2 acc[16];
#pragma unroll
        for (int i = 0; i < 16; ++i) { acc[i].x = (f16)0.f; acc[i].y = (f16)0.f; }
        { const int lA_ = hn ? nA : cA, lB_ = hn ? nB : cB; int en[16]; EN_GATHER(en, lA_, lB_); f16x2 hq[16];
#pragma unroll
          for (int g_ = 0; g_ < 8; ++g_) { const float qa = __shfl(hwA, 8 * g_ + sub) * 64.f, qb = __shfl(hwB, 8 * g_ + sub) * 64.f;
              hq[g_].x = (f16)qa; hq[g_].y = (f16)qa; hq[8 + g_].x = (f16)qb; hq[8 + g_].y = (f16)qb; }
          V_ROLL(bA, hwA, 0); V_ROLL(bB, hwB, 8); }
        f16x2 q8[8];
#pragma unroll
        for (int i = 0; i < 8; ++i) { const f16x2 keep = b3 ? acc[8 + i] : acc[i], send = b3 ? acc[i] : acc[8 + i]; q8[i] = keep + ash2(other8u(__builtin_bit_cast(unsigned, send))); }
        f16x2 q4[4];
#pragma unroll
        for (int i = 0; i < 4; ++i) { const f16x2 keep = b4 ? q8[4 + i] : q8[i], send = b4 ? q8[i] : q8[4 + i]; q4[i] = keep + ash2(other16u(__builtin_bit_cast(unsigned, send), b4)); }
        float r4[4];
        { const f16x2 k0 = b5 ? q4[2] : q4[0], k1 = b5 ? q4[3] : q4[1], s0 = b5 ? q4[0] : q4[2], s1 = b5 ? q4[1] : q4[3];
          const f16x2 p0 = ash2(other32u(__builtin_bit_cast(unsigned, s0), b5)), p1 = ash2(other32u(__builtin_bit_cast(unsigned, s1), b5));
          r4[0] = ((float)k0.x + (float)p0.x) * (1.f / 64.f); r4[1] = ((float)k0.y + (float)p0.y) * (1.f / 64.f); r4[2] = ((float)k1.x + (float)p1.x) * (1.f / 64.f); r4[3] = ((float)k1.y + (float)p1.y) * (1.f / 64.f); }
        const f16x2 x1a = ash2(x1r.x), x1b = ash2(x1r.y);
        const f32x4 x2 = {(float)x1a.x + r4[0], (float)x1a.y + r4[1], (float)x1b.x + r4[2], (float)x1b.y + r4[3]};
        { u32x2 o2; o2.x = pk_f16(x2.x, x2.y); o2.y = pk_f16(x2.z, x2.w); *(GAS u32x2*)orow = o2; }
        *(GAS unsigned*)(ws + WS_X8 + (size_t)t * D + col) = pk_fp8(x2.x, x2.y, x2.z, x2.w);
        const float ss = wave_sum((x2.x * x2.x + x2.y * x2.y) + (x2.z * x2.z + x2.w * x2.w));
        if (lane == 0) atomicAdd(SS2 + t, ss);
        if (!hn) break;
        cA = nA; cB = nB; nA = mA; nB = mB; t = tn; hwA = hwAn; hwB = hwBn;
    }
}
#undef FMIXV_LO
#undef FMIXV_HI

constexpr int NPH = 13;
struct Args { const float* in[26]; float* out; unsigned char* ws; int ph_lo, ph_hi; int rep[16]; };
__global__ void __launch_bounds__(NWAVES * 64, 2) fwd_kernel(Args args) {
    extern __shared__ __attribute__((aligned(16))) unsigned char lds[];
    Frame F;
    F.lds = (LAS unsigned char*)lds;
    F.MISC = (volatile LAS unsigned*)(F.lds + MISC_OFF);
    F.tid = threadIdx.x; F.lane = F.tid & 63; F.wave = __builtin_amdgcn_readfirstlane(F.tid >> 6);
#define PHASE_LANES() do { int t_ = threadIdx.x; asm volatile("" : "+v"(t_)); F.tid = t_; F.lane = t_ & 63; } while (0)
    F.G = gridDim.x; { const int bx = blockIdx.x; F.vcu = (F.G % 8 == 0) ? (bx % 8) * (F.G / 8) + bx / 8 : bx; }
#pragma unroll
    for (int i = 0; i < 26; ++i) F.in[i] = args.in[i];
    F.out = args.out; F.ws = args.ws;
    unsigned char* ws = args.ws;
    gu32* ctl = (gu32*)(ws + WS_CTL);
    for (int u = F.tid; u < (LDS_BYTES - LDSCTL_OFF) / 4; u += NWAVES * 64) ((LAS unsigned*)(F.lds + LDSCTL_OFF))[u] = 0u;
    __syncthreads();
    XcdBarrier bar; bar.bar = (unsigned*)(ctl + CW_BAR); bar.x = 0; bar.st = nullptr;
    if (MK_ONE_LAUNCH) bar = xcd_barrier_post((unsigned*)(ctl + CW_BAR), F.MISC + 8);
#define GRID_BAR() do { if (MK_ONE_LAUNCH) xcd_barrier(bar); } while (0)
    const int lo = args.ph_lo, hi = args.ph_hi;
#define IN(k) (lo <= (k) && (k) < hi)
#define BOTH(k) (IN(k) && IN((k) + 1))

    if (IN(0)) { PHASE_LANES(); for (int rp = 0; rp < args.rep[0]; ++rp) p0_prologue(F); if (BOTH(0)) GRID_BAR(); }

    if (IN(1)) {
        pg8::Gemm g{(const f16*)(ws + WS_XR), (const f16*)(ws + WS_WIN), M, NINP, D, D, D, 0, 1 << 30, 0};
        pg8::StaticOrder S; S.init(M, NINP, F.G, (int)blockIdx.x);
        pg8::EpiF16Row E{(f16*)(ws + WS_Y), NINP, (const float*)(ws + WS_SS0)};
        pg8::gemm_phase(F.lds, g, S, E);
        if (BOTH(1)) GRID_BAR();
    }

    if (IN(2)) { PHASE_LANES(); for (int rp = 0; rp < PROBE_REP2; ++rp) p2_post(F); if (BOTH(2)) GRID_BAR(); }

    if (IN(3)) {
        { pg8::Gemm g{(const f16*)(ws + WS_FLATA), (const f16*)(ws + WS_W1C), 8192, 1024, 512, D, D, 512, 16, (size_t)256 * D * 2, 512};
          pg8::StaticOrder S; S.init(8192, 1024, F.G, (int)blockIdx.x);
          pg8::EpiRawF32 E{(float*)(ws + WS_Y), 1024};
          pg8::gemm_phase(F.lds, g, S, E); }
        { pg8::Gemm g{(const f16*)(ws + WS_MIXED), (const f16*)(ws + WS_POOLT), M, 1024, 256, 1024, 256, 256, 1 << 30, 0};
          pg8::StaticOrder S; S.init(M, 1024, F.G, (int)((blockIdx.x + 128) % F.G));
          pg8::EpiF8 E{ws + WS_CAT, D, CAT8SCALE};
          pg8::gemm_phase(F.lds, g, S, E); }
        if (BOTH(3)) GRID_BAR();
    }

    if (IN(4)) { PHASE_LANES(); p4_compress2(F); if (BOTH(4)) GRID_BAR(); }

    if (IN(5)) {
#pragma unroll 1
        for (int step = 0; step < 2; ++step) { PHASE_LANES(); if ((step == 0) == (F.wave < 4)) p0_deferred(F); else for (int rp = 0; rp < args.rep[5]; ++rp) p5_attention(F); }
        if (BOTH(5)) GRID_BAR(); }

    if (IN(6)) {
        pg8::Gemm g{ws + WS_CAT, ws + WS_WOUT, M, D, D, D, D, 0, 1 << 30, 0, 0, 1};
        pg8::StaticOrder S; S.init(M, D, F.G, (int)blockIdx.x);
        pg8::EpiRes16 E{(f16*)(ws + WS_XR), (float*)(ws + WS_SS1), 1.f / (W8SCALE * CAT8SCALE)};
        pg8::gemm_phase<pg8::EpiRes16, pg8::StaticOrder, true>(F.lds, g, S, E);
        if (BOTH(6)) GRID_BAR();
    }

    if (IN(7)) {
        { pg8::Gemm g{(const f16*)(ws + WS_XR), (const f16*)(ws + WS_WQ), M, D, D, D, D, 0, 1 << 30, 0};
          pg8::StaticOrder S; S.init(M, D, F.G, (int)blockIdx.x);
          pg8::EpiF16Row E{(f16*)(ws + WS_QP), D, (const float*)(ws + WS_SS1)};
          pg8::gemm_phase(F.lds, g, S, E); }
        { pg8::Gemm g{(const f16*)(ws + WS_P16), (const f16*)(ws + WS_WPJ), M, D, 256, 256, 256, 0, 1 << 30, 0};
          pg8::StaticOrder S; S.init(M, D, F.G, (int)blockIdx.x);
          pg8::EpiF16<0> E{(f16*)(ws + WS_PJ), D, nullptr, 1 << 30, 0};
          pg8::gemm_phase(F.lds, g, S, E); }
        if (BOTH(7)) GRID_BAR();
    }

    if (IN(8)) { PHASE_LANES();
#pragma unroll 1
        for (int step = 0; step < 2; ++step) { PHASE_LANES(); if ((step == 0) == (F.wave < 4)) p7_tables(F); else p9a_topk(F); }
        if (BOTH(8)) GRID_BAR(); }
    if (IN(9)) { PHASE_LANES(); if (PROBE_DUPU) p9b_upass(F, false); p9b_upass(F, false); if (BOTH(9)) GRID_BAR(); }
    if (IN(10)) { PHASE_LANES(); p9h_weights(F); if (BOTH(10)) GRID_BAR(); }
    if (IN(11)) { PHASE_LANES(); p9c_vpass(F); if (BOTH(11)) GRID_BAR(); }

    if (IN(12)) {
        pg8::Gemm g{ws + WS_X8, ws + WS_WG, M, D, D, D, D, 0, 1 << 30, 0, 0, 1};
        pg8::StaticOrder S; S.init(M, D, F.G, (int)blockIdx.x);
        pg8::EpiFinal E{(const f16*)(ws + WS_XR), (const f16*)(ws + WS_PJ), F.out, (const float*)(ws + WS_SS2), 1.f / W8SCALE};
        pg8::gemm_phase<pg8::EpiFinal, pg8::StaticOrder, true>(F.lds, g, S, E);
    }
#undef IN
#undef BOTH
}

extern "C" void kernel_launch(void* const* d_in, const int* in_sizes, int n_in, void* d_out, int out_size, void* d_ws, size_t ws_size, hipStream_t stream) {
    static int grid = 0;
    if (grid == 0) {
        if (n_in != 26 || out_size != M * D || ws_size < WS_END) { fprintf(stderr, "kernel_launch: unexpected sizes n_in %d out %d ws %zu\n", n_in, out_size, ws_size); grid = -1; return; }
        int dev = 0, cus = 0, per_cu = 0;
        if (hipGetDevice(&dev) != hipSuccess || hipDeviceGetAttribute(&cus, hipDeviceAttributeMultiprocessorCount, dev) != hipSuccess) { grid = -1; return; }
        if (hipFuncSetAttribute((const void*)fwd_kernel, hipFuncAttributeMaxDynamicSharedMemorySize, LDS_BYTES) != hipSuccess) { fprintf(stderr, "kernel_launch: hipFuncSetAttribute failed\n"); grid = -1; return; }
        if (hipOccupancyMaxActiveBlocksPerMultiprocessor(&per_cu, (const void*)fwd_kernel, NWAVES * 64, LDS_BYTES) != hipSuccess || per_cu < 1)
            fprintf(stderr, "kernel_launch: occupancy query reports %d\n", per_cu);
        (void)hipGetLastError();
        grid = cus;
    }
    if (grid < 0) return;
    (void)hipMemsetAsync((char*)d_ws + WS_CTL, 0, CTL_ZERO_BYTES, stream);
    Args a{};
    for (int i = 0; i < 16; ++i) a.rep[i] = 1;
    a.rep[5] = PROBE_REP5; a.rep[0] = PROBE_REP0; a.rep[7] = PROBE_REP7;
    for (int i = 0; i < 26; ++i) a.in[i] = (const float*)d_in[i];
    a.out = (float*)d_out; a.ws = (unsigned char*)d_ws;
    if (MK_ONE_LAUNCH) { a.ph_lo = 0; a.ph_hi = NPH; hipLaunchKernelGGL(fwd_kernel, dim3(grid), dim3(NWAVES * 64), LDS_BYTES, stream, a); }
    else for (int p = 0; p < NPH; ++p) { a.ph_lo = p; a.ph_hi = p + 1; hipLaunchKernelGGL(fwd_kernel, dim3(grid), dim3(NWAVES * 64), LDS_BYTES, stream, a); }
}
```

```cpp
#include <hip/hip_runtime.h>
#include <cstdio>
#include <cstdint>

#define PROBE_REP0 1
#define PROBE_REP2 1
#define PROBE_DUPU 0
#define PROBE_REP5 1
#define PROBE_REP7 1
#define PROBE_REP9 1
#ifndef MK_ONE_LAUNCH
#define MK_ONE_LAUNCH 1
#endif

#define GAS __attribute__((address_space(1)))
#define LAS __attribute__((address_space(3)))
typedef _Float16 f16;
typedef _Float16 f16x8 __attribute__((ext_vector_type(8)));
typedef _Float16 f16x4 __attribute__((ext_vector_type(4)));
typedef _Float16 f16x2 __attribute__((ext_vector_type(2)));
typedef float f32x2 __attribute__((ext_vector_type(2)));
typedef float f32x4 __attribute__((ext_vector_type(4)));
typedef float f32x16 __attribute__((ext_vector_type(16)));
typedef unsigned u32x2 __attribute__((ext_vector_type(2)));
typedef unsigned u32x4 __attribute__((ext_vector_type(4)));
typedef GAS unsigned gu32;
typedef _Float16 f16x32 __attribute__((ext_vector_type(32)));
typedef unsigned u32x6 __attribute__((ext_vector_type(6)));
#define RLX_AGENT __ATOMIC_RELAXED, __HIP_MEMORY_SCOPE_AGENT
#define LDS_WAIT() asm volatile("s_waitcnt lgkmcnt(0)" ::: "memory")
__device__ __forceinline__ float mul_np(float a, float b) { float o; asm("v_mul_f32 %0, %1, %2" : "=v"(o) : "v"(a), "v"(b)); return o; }
__device__ __forceinline__ float add_np(float a, float b) { float o; asm("v_add_f32 %0, %1, %2" : "=v"(o) : "v"(a), "v"(b)); return o; }
#define VM_WAIT() asm volatile("s_waitcnt vmcnt(0)" ::: "memory")

constexpr int BATCH = 8, SEQ = 2048, D = 2048, M = BATCH * SEQ;
constexpr int NIN = 3632, NINP = 3840;
constexpr int OFF_U = 0, OFF_Q = 1024, OFF_KC = 2048, OFF_VC = 2304, OFF_KS = 2560, OFF_VS = 2816, OFF_KW = 3072, OFF_VW = 3328, OFF_G = 3584;
constexpr int NCMP = 127, NCROWS = BATCH * NCMP * 4;
constexpr float RMS_EPS = 1e-6f;
constexpr float LOG2E = 1.4426950408889634f;

constexpr size_t MiB = 1u << 20;
constexpr size_t WS_CTL = 0, CTL_ZERO_BYTES = 1 * MiB;
constexpr size_t WS_WIN = 2 * MiB, WS_WOUT = 17 * MiB, WS_WQ = 25 * MiB, WS_WG = 33 * MiB, WS_WPJ = 41 * MiB, WS_W1C = 42 * MiB, WS_POOLT = 44 * MiB, WS_KEYS = 45 * MiB;
constexpr size_t WS_CBIAS = 46 * MiB, WS_GATES = 47 * MiB, WS_HC = 50 * MiB, WS_KCMP = 54 * MiB, WS_VCMPT = 54 * MiB + 512 * 1024, WS_P16 = 56 * MiB;
constexpr size_t WS_WIN8 = 96 * MiB;
constexpr size_t WS_XN = 64 * MiB, WS_X8 = 64 * MiB;
constexpr float CAT8SCALE = 8.f;
constexpr float W8SCALE = 64.f;
constexpr size_t WS_Y = 128 * MiB, WS_QP = 128 * MiB, WS_PJ = 192 * MiB;
constexpr size_t WS_MIXED = 256 * MiB, WS_CAT = 288 * MiB, WS_KN = 354 * MiB, WS_VT = 368 * MiB, WS_FLATA = 384 * MiB;
constexpr size_t WS_QF = 322 * MiB;
constexpr size_t WS_U6 = 256 * MiB, WS_V6 = 288 * MiB, WS_SU = 320 * MiB, WS_SV = 321 * MiB;
constexpr size_t WS_LIDX = 322 * MiB, WS_LG = 330 * MiB, WS_SSP = 338 * MiB, WS_PD = 340 * MiB, WS_HW = 404 * MiB;
constexpr size_t SLICE6 = (size_t)16384 * 192;
constexpr size_t WS_XR = 416 * MiB;
constexpr size_t WS_SS0 = 768 * 1024, WS_SS1 = 256 * 1024, WS_SS2 = 512 * 1024;
constexpr size_t WS_QN = 480 * MiB, WS_HP = 480 * MiB;
constexpr size_t WS_END = 512 * MiB;
constexpr int CW_TMO = 0, CW_CODE = 1, CW_BAR = 4096;

constexpr int RING_BYTES = 131072;
constexpr int LDSCTL_OFF = RING_BYTES, MISC_OFF = LDSCTL_OFF + 320;
constexpr int LDS_BYTES = 147456;
constexpr int NWAVES = 8;

__device__ __forceinline__ unsigned pk_f16(float lo, float hi) { f16x2 v; v.x = (f16)lo; v.y = (f16)hi; return __builtin_bit_cast(unsigned, v); }
__device__ __forceinline__ unsigned pk_fp8(float a, float b, float c, float d) { int r = __builtin_amdgcn_cvt_pk_fp8_f32(a, b, 0, false); r = __builtin_amdgcn_cvt_pk_fp8_f32(c, d, r, true); return (unsigned)r; }
__device__ __forceinline__ long as_i64(unsigned lo, unsigned hi) { return (long)(((unsigned long long)hi << 32) | lo); }
__device__ __forceinline__ f16x2 ash2(unsigned u) { return __builtin_bit_cast(f16x2, u); }
template <int CTRL> __device__ __forceinline__ float dpp_f(float v) { return __int_as_float(__builtin_amdgcn_update_dpp(0, __float_as_int(v), CTRL, 0xF, 0xF, true)); }
__device__ __forceinline__ float rl_f(float v, int l) { return __int_as_float(__builtin_amdgcn_readlane(__float_as_int(v), l)); }
__device__ __forceinline__ float sum8(float v) { v += dpp_f<0x141>(v); v += dpp_f<0xB1>(v); v += dpp_f<0x4E>(v); return v; }
__device__ __forceinline__ float wave_sum(float v) { v = sum8(v); v += dpp_f<0x140>(v); return (rl_f(v, 0) + rl_f(v, 16)) + (rl_f(v, 32) + rl_f(v, 48)); }
__device__ __forceinline__ float wave_max(float v) { v = fmaxf(v, dpp_f<0x141>(v)); v = fmaxf(v, dpp_f<0xB1>(v)); v = fmaxf(v, dpp_f<0x4E>(v)); v = fmaxf(v, dpp_f<0x140>(v));
    return fmaxf(fmaxf(rl_f(v, 0), rl_f(v, 16)), fmaxf(rl_f(v, 32), rl_f(v, 48))); }

__device__ __forceinline__ unsigned other8u(unsigned x) { return (unsigned)__builtin_amdgcn_update_dpp(0, (int)x, 0x128, 0xF, 0xF, true); }
__device__ __forceinline__ unsigned other16u(unsigned x, bool b4) { const auto r = __builtin_amdgcn_permlane16_swap(x, x, false, false); return b4 ? r[0] : r[1]; }
__device__ __forceinline__ unsigned other32u(unsigned x, bool b5) { const auto r = __builtin_amdgcn_permlane32_swap(x, x, false, false); return b5 ? r[0] : r[1]; }
namespace pg8 {
constexpr int BM = 256, BK = 64, HALF = 128, HTB = HALF * BK * 2, STAGE_BYTES = 8 * HTB, NXCD = 8, WGM = 8;
__host__ __device__ __forceinline__ int lds_byte(int r, int c) { const int st = (r >> 4) * 2 + (c >> 5), rr = r & 15, cc = c & 31, ob = rr * 64 + cc * 2; return st * 1024 + (ob ^ (((ob >> 9) & 1) << 5)); }
__host__ __device__ __forceinline__ void stage_rc(int b, int& R, int& C) { const int st = b / 1024, sb = b % 1024, swz = sb ^ (((sb >> 9) & 1) << 5); R = (st >> 1) * 16 + swz / 64; C = (st & 1) * 32 + (swz % 64) / 2; }
__host__ __device__ __forceinline__ int perm32(int rho) { const int n = rho >> 4, i = rho & 15; return 8 * (i >> 2) + 4 * n + (i & 3); }

struct Unit { int pm, pn; };
struct Gemm { const void* A; const void* Bt; int M, N, K, lda, ldb; int a_pn_off; int b_pm_split; size_t b_split_off; int b_pn_k = 0; int esz = 2;
    __device__ __forceinline__ const char* aptr(const Unit& u) const { return (const char*)A + ((size_t)u.pm * BM * lda + (size_t)u.pn * a_pn_off) * esz; }
    __device__ __forceinline__ const char* bptr(const Unit& u) const { return (const char*)Bt + (b_pn_k ? (size_t)u.pn * b_pn_k * esz : (size_t)u.pn * BM * ldb * esz) + (u.pm >= b_pm_split ? b_split_off : (size_t)0); }
};
struct StaticOrder {
    int nM, nN, nwg, G, c;
    __host__ __device__ void init(int M_, int N_, int G_, int c_) { nM = M_ / BM; nN = N_ / BM; nwg = nM * nN; G = G_; c = c_; }
    __host__ __device__ bool next(int i, Unit& u) const {
        const long L = (long)i * G + c; if (L >= nwg) return false;
        int wgid = (int)L; { const int q = nwg / NXCD, r = nwg % NXCD, xcd = wgid % NXCD, off = wgid / NXCD; wgid = (xcd < r ? xcd * (q + 1) : r * (q + 1) + (xcd - r) * q) + off; }
        const int nig = WGM * nN, gid = wgid / nig, fm = gid * WGM, gsz = (nM - fm) < WGM ? (nM - fm) : WGM;
        u.pm = fm + ((wgid % nig) % gsz); u.pn = (wgid % nig) / gsz; return true;
    }
};

struct MapOrder : StaticOrder { int mode;
    __host__ __device__ void init(int M_, int G_, int c_, int mode_) { mode = mode_; StaticOrder::init(M_, (mode_ ? 6 : 9) * BM, G_, c_); }
    __host__ __device__ bool next(int i, Unit& u) const { if (!StaticOrder::next(i, u)) return false; u.pn += mode ? 9 : 0; return true; }
};
__device__ __forceinline__ f32x2 gelu_pk(f32x2 v) {
    const f32x2 av = __builtin_elementwise_abs(v), d = av * 0.2316418882f + 1.0f;
    f32x2 t; t.x = __builtin_amdgcn_rcpf(d.x); t.y = __builtin_amdgcn_rcpf(d.y);
    f32x2 q = t * 0.5307027145f + (-0.7265760135f); q = q * t + 0.7107068705f; q = q * t + (-0.142248368f); q = q * t + 0.127414796f; q = q * t;
    const f32x2 s = (v * v) * (-0.72134752044f);
    f32x2 e; e.x = __builtin_amdgcn_exp2f(s.x); e.y = __builtin_amdgcn_exp2f(s.y);
    const f32x2 m = v * (q * e), r = v - m;
    f32x2 o; o.x = v.x < 0.f ? m.x : r.x; o.y = v.y < 0.f ? m.y : r.y; return o;
}
__device__ __forceinline__ float gelu1(float v) { f32x2 r = gelu_pk((f32x2){v, v}); return r.x; }

template <int ACT> struct EpiF16 {
    static constexpr bool PERM = true;
    f16* O; int ldc; const float* bias; int bias_pm_split; int bias_split_off;
    __device__ __forceinline__ void operator()(const f32x4 (&acc)[2][2][4][2], const Unit& u, int wr, int wc, int fr, int fq) const {
        const int row0 = u.pm * BM + wr * 64 + fr; const int col0 = u.pn * BM + wc * 32 + 8 * fq;
        const float* bp = bias ? bias + (u.pm >= bias_pm_split ? bias_split_off : 0) : nullptr;
        f32x4 bv[2][2];
#pragma unroll
        for (int bj = 0; bj < 2; ++bj)
#pragma unroll
            for (int n = 0; n < 2; ++n) bv[bj][n] = bp ? *(const f32x4*)(bp + col0 + bj * HALF + 4 * n) : (f32x4){0.f, 0.f, 0.f, 0.f};
#pragma unroll
        for (int ai = 0; ai < 2; ++ai)
#pragma unroll
            for (int m = 0; m < 4; ++m) { f16* rowp = O + (size_t)(row0 + ai * HALF + m * 16) * ldc + col0;
#pragma unroll
                for (int bj = 0; bj < 2; ++bj) { f32x4 v0 = acc[ai][bj][m][0] + bv[bj][0], v1 = acc[ai][bj][m][1] + bv[bj][1];
                    if (ACT == 1) { f32x2 a = gelu_pk((f32x2){v0[0], v0[1]}), b = gelu_pk((f32x2){v0[2], v0[3]}), c = gelu_pk((f32x2){v1[0], v1[1]}), d = gelu_pk((f32x2){v1[2], v1[3]});
                        v0 = (f32x4){a.x, a.y, b.x, b.y}; v1 = (f32x4){c.x, c.y, d.x, d.y}; }
                    u32x4 w; w.x = pk_f16(v0[0], v0[1]); w.y = pk_f16(v0[2], v0[3]); w.z = pk_f16(v1[0], v1[1]); w.w = pk_f16(v1[2], v1[3]);
                    *(u32x4*)(rowp + bj * HALF) = w; } }
    }
};
struct EpiRawF32 {
    static constexpr bool PERM = false;
    float* C; int ldc;
    __device__ __forceinline__ void operator()(const f32x4 (&acc)[2][2][4][2], const Unit& u, int wr, int wc, int fr, int fq) const {
        const int row0 = u.pm * BM + wr * 64 + fr, col0 = u.pn * BM + wc * 32 + 4 * fq;
#pragma unroll
        for (int ai = 0; ai < 2; ++ai)
#pragma unroll
            for (int m = 0; m < 4; ++m) { float* rowp = C + (size_t)(row0 + ai * HALF + m * 16) * ldc + col0;
#pragma unroll
                for (int bj = 0; bj < 2; ++bj)
#pragma unroll
                    for (int n = 0; n < 2; ++n) *(f32x4*)(rowp + bj * HALF + n * 16) = acc[ai][bj][m][n]; }
    }
};
struct EpiF8 {
    static constexpr bool PERM = true;
    unsigned char* O; int ldc; float sc;
    __device__ __forceinline__ void operator()(const f32x4 (&acc)[2][2][4][2], const Unit& u, int wr, int wc, int fr, int fq) const {
        const int row0 = u.pm * BM + wr * 64 + fr; const int col0 = u.pn * BM + wc * 32 + 8 * fq;
#pragma unroll
        for (int ai = 0; ai < 2; ++ai)
#pragma unroll
            for (int m = 0; m < 4; ++m) { unsigned char* rowp = O + (size_t)(row0 + ai * HALF + m * 16) * ldc + col0;
#pragma unroll
                for (int bj = 0; bj < 2; ++bj) { const f32x4 v0 = acc[ai][bj][m][0] * sc, v1 = acc[ai][bj][m][1] * sc;
                    u32x2 w; w.x = pk_fp8(v0[0], v0[1], v0[2], v0[3]); w.y = pk_fp8(v1[0], v1[1], v1[2], v1[3]);
                    *(u32x2*)(rowp + bj * HALF) = w; } }
    }
};
struct EpiRes16 {
    static constexpr bool PERM = true;
    f16* XR; float* SS; float as;
    __device__ __forceinline__ void operator()(const f32x4 (&acc)[2][2][4][2], const Unit& u, int wr, int wc, int fr, int fq) const {
        const int row0 = u.pm * BM + wr * 64 + fr; const int col0 = u.pn * BM + wc * 32 + 8 * fq;
#pragma unroll
        for (int ai = 0; ai < 2; ++ai) {
            f16x8 xb[4][2];
#pragma unroll
            for (int m = 0; m < 4; ++m)
#pragma unroll
                for (int bj = 0; bj < 2; ++bj) xb[m][bj] = *(const f16x8*)(XR + (size_t)(row0 + ai * HALF + m * 16) * D + col0 + bj * HALF);
            asm volatile("" ::: "memory");
#pragma unroll
            for (int m = 0; m < 4; ++m) { const int row = row0 + ai * HALF + m * 16; const size_t off = (size_t)row * D + col0; float ss = 0.f;
#pragma unroll
                for (int bj = 0; bj < 2; ++bj) { const f16x8 xv = xb[m][bj];
                    f32x4 v0 = acc[ai][bj][m][0] * as, v1 = acc[ai][bj][m][1] * as;
                    v0[0] += (float)xv[0]; v0[1] += (float)xv[1]; v0[2] += (float)xv[2]; v0[3] += (float)xv[3]; v1[0] += (float)xv[4]; v1[1] += (float)xv[5]; v1[2] += (float)xv[6]; v1[3] += (float)xv[7];
                    ss += ((v0[0] * v0[0] + v0[1] * v0[1]) + (v0[2] * v0[2] + v0[3] * v0[3])) + ((v1[0] * v1[0] + v1[1] * v1[1]) + (v1[2] * v1[2] + v1[3] * v1[3]));
                    u32x4 o; o.x = pk_f16(v0[0], v0[1]); o.y = pk_f16(v0[2], v0[3]); o.z = pk_f16(v1[0], v1[1]); o.w = pk_f16(v1[2], v1[3]);
                    *(u32x4*)(XR + off + bj * HALF) = o; }
                ss += __shfl_xor(ss, 16); ss += __shfl_xor(ss, 32);
                if (fq == 0) atomicAdd(SS + row, ss); }
            asm volatile("" ::: "memory"); }
    }
};
struct EpiF16Row {
    static constexpr bool PERM = true;
    f16* O; int ldc; const float* SS; float as = 1.f; bool qpf = false; f16* QF = nullptr;
    __device__ __forceinline__ void operator()(const f32x4 (&acc)[2][2][4][2], const Unit& u, int wr, int wc, int fr, int fq) const {
        const int row0 = u.pm * BM + wr * 64 + fr; const int col0 = u.pn * BM + wc * 32 + 8 * fq;
#pragma unroll
        for (int ai = 0; ai < 2; ++ai)
#pragma unroll
            for (int m = 0; m < 4; ++m) { const int row = row0 + ai * HALF + m * 16; f16* rowp = O + (size_t)row * ldc + col0;
                const float rs = as / sqrtf(SS[row] * (1.f / D) + RMS_EPS);
                f16* qrow = O + ((size_t)((row >> 5) * 8 + u.pn) * 16 + wc * 2 + (fq >> 1)) * 512 + ((fq & 1) * 32 + (row & 31)) * 8;
                f16* qfrow = QF + ((((size_t)(row >> 3) * 4 + (u.pn - 4)) * 4 + (wc & 1) * 2 + (fq >> 1)) * 512) + ((fq & 1) * 32 + (row & 7) * 4 + (wc >> 1)) * 8;
                const bool isq = QF != nullptr && u.pn >= 4 && u.pn < 8;
#pragma unroll
                for (int bj = 0; bj < 2; ++bj) { const f32x4 v0 = acc[ai][bj][m][0] * rs, v1 = acc[ai][bj][m][1] * rs;
                    u32x4 o; o.x = pk_f16(v0[0], v0[1]); o.y = pk_f16(v0[2], v0[3]); o.z = pk_f16(v1[0], v1[1]); o.w = pk_f16(v1[2], v1[3]);
                    *(u32x4*)(qpf ? qrow + bj * 4096 : (isq ? qfrow + bj * 16 : rowp + bj * HALF)) = o; } }
    }
};
struct P1Order { int kind, G, c;
    __device__ __forceinline__ bool next(int i, Unit& u) const {
        int L;
        if (G == 256) {
            const int x = c & 7, j = c >> 3;
            if (kind == 0) { if (j >= 8 || i >= 1) return false; u.pm = 8 * j + x; u.pn = 8; return true; }
            if (kind == 1) { if (j < 8 || i >= 4) return false; const int l = 4 * (j - 8) + i, a = l / 12, q = l - 12 * a; u.pm = 8 * a + x; u.pn = q < 8 ? q : (q == 8 ? 9 : (q == 9 ? 10 : (q == 10 ? 12 : 14))); return true; }
            if (j >= 8 || i >= 2) return false;
            u.pn = 8 * j + x; u.pm = 11 + 2 * i; return true;
        } else { L = i * G + c; if (L >= (kind == 0 ? 64 : (kind == 1 ? 768 : 128))) return false; }
        if (kind == 0) { u.pm = L; u.pn = 8; }
        else if (kind == 1) { u.pm = L / 12; const int q = L - 12 * u.pm; u.pn = q < 8 ? q : (q == 8 ? 9 : (q == 9 ? 10 : (q == 10 ? 12 : 14))); }
        else { u.pn = L >> 1; u.pm = 11 + 2 * (L & 1); }
        return true; }
};
struct EpiP1F8 {
    static constexpr bool PERM = true;
    f16* Y; const float* SS; unsigned char* KN; unsigned char* VT; const float* knw; const float* qnw; int ty; float as; float* GT; f16* QF;
    __device__ __forceinline__ void operator()(const f32x4 (&acc)[2][2][4][2], const Unit& u, int wr, int wc, int fr, int fq) const {
        if (ty == 0) {
            const int row0 = u.pm * BM + wr * 64 + fr;
            if (u.pn == 10 || u.pn == 12) {
                float wk[2][8];
#pragma unroll
                for (int bj = 0; bj < 2; ++bj) { const f32x4 k0 = *(const f32x4*)(knw + 32 * bj + 8 * fq), k1 = *(const f32x4*)(knw + 32 * bj + 8 * fq + 4), q0 = *(const f32x4*)(qnw + 32 * bj + 8 * fq), q1 = *(const f32x4*)(qnw + 32 * bj + 8 * fq + 4);
#pragma unroll
                    for (int j = 0; j < 4; ++j) { wk[bj][j] = k0[j] * q0[j]; wk[bj][4 + j] = k1[j] * q1[j]; } }
                unsigned char* kb = KN + (u.pn == 12 ? (size_t)BATCH * 4 * SEQ * 64 : (size_t)0) + (fq & 1) * 512 + (fq >> 1) * 8;
#pragma unroll
                for (int ai = 0; ai < 2; ++ai)
#pragma unroll
                    for (int m = 0; m < 4; ++m) { const int row = row0 + ai * HALF + m * 16, b = row / SEQ, s = row % SEQ;
                        const float rs0 = as / sqrtf(SS[row] * (1.f / D) + RMS_EPS);
                        float v[2][8]; float ss = 0.f;
#pragma unroll
                        for (int bj = 0; bj < 2; ++bj)
#pragma unroll
                            for (int e = 0; e < 8; ++e) { v[bj][e] = acc[ai][bj][m][e >> 2][e & 3] * rs0; ss += v[bj][e] * v[bj][e]; }
                        ss += __shfl_xor(ss, 16); ss += __shfl_xor(ss, 32);
                        const float rs = 1.f / sqrtf(ss * (1.f / 64.f) + RMS_EPS);
                        unsigned char* p = kb + ((size_t)(b * 4 + wc) * 64 + (s >> 5)) * 2048 + (s & 31) * 16;
#pragma unroll
                        for (int bj = 0; bj < 2; ++bj) { u32x2 o; o.x = pk_fp8(v[bj][0] * rs * wk[bj][0], v[bj][1] * rs * wk[bj][1], v[bj][2] * rs * wk[bj][2], v[bj][3] * rs * wk[bj][3]);
                            o.y = pk_fp8(v[bj][4] * rs * wk[bj][4], v[bj][5] * rs * wk[bj][5], v[bj][6] * rs * wk[bj][6], v[bj][7] * rs * wk[bj][7]);
                            *(u32x2*)(p + bj * 1024) = o; } }
            } else if (u.pn == 14) {
                const int c0 = wc * 32 + 8 * fq;
                if (c0 < 48) {
#pragma unroll
                    for (int ai = 0; ai < 2; ++ai)
#pragma unroll
                        for (int m = 0; m < 4; ++m) { const int row = row0 + ai * HALF + m * 16; const float rs = as / sqrtf(SS[row] * (1.f / D) + RMS_EPS);
                            const f32x4 v0 = acc[ai][0][m][0] * rs, v1 = acc[ai][0][m][1] * rs; f32x4 o0, o1;
#pragma unroll
                            for (int j = 0; j < 4; ++j) { o0[j] = 1.f / (1.f + __expf(-v0[j])); o1[j] = 1.f / (1.f + __expf(-v1[j])); }
                            *(f32x4*)(GT + (size_t)row * 48 + c0) = o0; *(f32x4*)(GT + (size_t)row * 48 + c0 + 4) = o1; } }
            } else {
                const int col0 = u.pn * BM + wc * 32 + 8 * fq;
#pragma unroll
                for (int ai = 0; ai < 2; ++ai)
#pragma unroll
                    for (int m = 0; m < 4; ++m) { const int row = row0 + ai * HALF + m * 16; f16* rowp = Y + (size_t)row * NINP + col0;
                        const float rs = as / sqrtf(SS[row] * (1.f / D) + RMS_EPS);
                        f16* qfrow = QF + ((((size_t)(row >> 3) * 4 + (u.pn - 4)) * 4 + (wc & 1) * 2 + (fq >> 1)) * 512) + ((fq & 1) * 32 + (row & 7) * 4 + (wc >> 1)) * 8;
                        const bool isq = u.pn >= 4 && u.pn < 8;
#pragma unroll
                        for (int bj = 0; bj < 2; ++bj) { const f32x4 v0 = acc[ai][bj][m][0] * rs, v1 = acc[ai][bj][m][1] * rs;
                            u32x4 o; o.x = pk_f16(v0[0], v0[1]); o.y = pk_f16(v0[2], v0[3]); o.z = pk_f16(v1[0], v1[1]); o.w = pk_f16(v1[2], v1[3]);
                            *(u32x4*)(isq ? qfrow + bj * 16 : rowp + bj * HALF) = o; } }
            }
        } else {
            const int tok0 = u.pn * BM + wc * 32 + 8 * fq;
            float rsv[2][8];
#pragma unroll
            for (int bj = 0; bj < 2; ++bj) { const f32x4 s0 = *(const f32x4*)(SS + tok0 + bj * HALF), s1 = *(const f32x4*)(SS + tok0 + bj * HALF + 4);
#pragma unroll
                for (int j = 0; j < 4; ++j) { rsv[bj][j] = as / sqrtf(s0[j] * (1.f / D) + RMS_EPS); rsv[bj][4 + j] = as / sqrtf(s1[j] * (1.f / D) + RMS_EPS); } }
            const int b = (u.pn * BM) / SEQ, sb = (u.pn * BM) % SEQ;
            unsigned char* vb = VT + (u.pm == 13 ? (size_t)BATCH * 4 * 64 * SEQ : (size_t)0) + ((size_t)(b * 4 + wr) * 64 + (sb >> 5) + wc) * 2048 + fr * 16 + (fq >> 1) * 8 + (fq & 1) * 4;
#pragma unroll
            for (int ai = 0; ai < 2; ++ai)
#pragma unroll
                for (int m = 0; m < 4; ++m) { unsigned char* p = vb + (size_t)(2 * ai) * 64 * 2048 + (m >> 1) * 1024 + (m & 1) * 256;
#pragma unroll
                    for (int bj = 0; bj < 2; ++bj) { const f32x4 a0 = acc[ai][bj][m][0], a1 = acc[ai][bj][m][1];
                        *(unsigned*)(p + bj * 4 * 2048) = pk_fp8(a0[0] * rsv[bj][0], a0[1] * rsv[bj][1], a0[2] * rsv[bj][2], a0[3] * rsv[bj][3]);
                        *(unsigned*)(p + bj * 4 * 2048 + 512) = pk_fp8(a1[0] * rsv[bj][4], a1[1] * rsv[bj][5], a1[2] * rsv[bj][6], a1[3] * rsv[bj][7]); } }
        }
    }
};
struct PoolOrder { int w, Gp;
    __device__ __forceinline__ bool next(int i, Unit& u) const { if (w < 0) return false; const int pair = w + (i >> 1) * Gp; if (pair >= 128) return false; u.pm = pair >> 1; u.pn = (pair & 1) * 2 + (i & 1); return true; } };
struct EpiFinal {
    static constexpr bool PERM = true;
    const f16* XR; const f16* PJ; float* C; const float* SS; float as;
    __device__ __forceinline__ void operator()(const f32x4 (&acc)[2][2][4][2], const Unit& u, int wr, int wc, int fr, int fq) const {
        const int row0 = u.pm * BM + wr * 64 + fr; const int col0 = u.pn * BM + wc * 32 + 8 * fq;
#pragma unroll
        for (int ai = 0; ai < 2; ++ai)
#pragma unroll
            for (int mh = 0; mh < 2; ++mh) {
                f16x8 xb[2][2], pb[2][2]; float ssv[2];
#pragma unroll
                for (int mm = 0; mm < 2; ++mm) { const int row = row0 + ai * HALF + (2 * mh + mm) * 16; ssv[mm] = SS[row];
#pragma unroll
                    for (int bj = 0; bj < 2; ++bj) { xb[mm][bj] = *(const f16x8*)(XR + (size_t)row * D + col0 + bj * HALF); pb[mm][bj] = *(const f16x8*)(PJ + (size_t)row * D + col0 + bj * HALF); } }
                asm volatile("" ::: "memory");
#pragma unroll
                for (int mm = 0; mm < 2; ++mm) { const int m = 2 * mh + mm; const int row = row0 + ai * HALF + m * 16; const size_t off = (size_t)row * D + col0;
                    const float nrs = -LOG2E * as / sqrtf(ssv[mm] * (1.f / D) + RMS_EPS);
#pragma unroll
                    for (int bj = 0; bj < 2; ++bj) { const f16x8 xv = xb[mm][bj], pv = pb[mm][bj];
                        const f32x4 a0 = acc[ai][bj][m][0], a1 = acc[ai][bj][m][1]; f32x4 o0, o1;
#pragma unroll
                        for (int j = 0; j < 4; ++j) { o0[j] = (float)xv[j] + (float)pv[j] * __builtin_amdgcn_rcpf(1.0f + __builtin_amdgcn_exp2f(nrs * a0[j]));
                            o1[j] = (float)xv[4 + j] + (float)pv[4 + j] * __builtin_amdgcn_rcpf(1.0f + __builtin_amdgcn_exp2f(nrs * a1[j])); }
                        *(f32x4*)(C + off + bj * HALF) = o0; *(f32x4*)(C + off + bj * HALF + 4) = o1; } }
                asm volatile("" ::: "memory"); }
    }
};
template <int MODE> struct EpiF32 {
    static constexpr bool PERM = false;
    const float* base; float* C; int ldc; const f16* pj; const float* ssp;
    __device__ __forceinline__ void operator()(const f32x4 (&acc)[2][2][4][2], const Unit& u, int wr, int wc, int fr, int fq) const {
        const int row0 = u.pm * BM + wr * 64 + fr, col0 = u.pn * BM + wc * 32 + 4 * fq;
#pragma unroll
        for (int ai = 0; ai < 2; ++ai)
#pragma unroll
            for (int m = 0; m < 4; ++m) { const size_t off = (size_t)(row0 + ai * HALF + m * 16) * ldc + col0;
                float nrs = -LOG2E;
                if (MODE == 1) { const f32x4 s0 = *(const f32x4*)(ssp + (size_t)(row0 + ai * HALF + m * 16) * 8), s1 = *(const f32x4*)(ssp + (size_t)(row0 + ai * HALF + m * 16) * 8 + 4);
                    nrs = -LOG2E / sqrtf((((s0.x + s0.y) + (s0.z + s0.w)) + ((s1.x + s1.y) + (s1.z + s1.w))) * (1.f / D) + RMS_EPS); }
#pragma unroll
                for (int bj = 0; bj < 2; ++bj)
#pragma unroll
                    for (int n = 0; n < 2; ++n) { const size_t o2 = off + bj * HALF + n * 16; const f32x4 bs = *(const f32x4*)(base + o2); f32x4 a = acc[ai][bj][m][n];
                        if (MODE == 1) { const f16x4 pv = *(const f16x4*)(pj + o2);
#pragma unroll
                            for (int j = 0; j < 4; ++j) a[j] = (float)pv[j] * __builtin_amdgcn_rcpf(1.0f + __builtin_amdgcn_exp2f(nrs * a[j])); }
                        *(f32x4*)(C + o2) = bs + a; }
                asm volatile("" ::: "memory"); }
    }
};

typedef int i32x4v __attribute__((ext_vector_type(4)));
typedef int i32x8v __attribute__((ext_vector_type(8)));
__device__ __forceinline__ i32x8v cat16(const f16x8 a, const f16x8 b) { const i32x4v x = __builtin_bit_cast(i32x4v, a), y = __builtin_bit_cast(i32x4v, b); return __builtin_shufflevector(x, y, 0, 1, 2, 3, 4, 5, 6, 7); }
__device__ __forceinline__ f16x8 half16(const i32x8v& v, int k) { const i32x4v h = k ? __builtin_shufflevector(v, v, 4, 5, 6, 7) : __builtin_shufflevector(v, v, 0, 1, 2, 3); return __builtin_bit_cast(f16x8, h); }
struct NoGather { static constexpr bool ON = false; static constexpr size_t KSTEP = 128; __device__ static __forceinline__ unsigned rowoff(int) { return 0u; } __device__ static __forceinline__ size_t base(const Unit&) { return 0; } };
struct CmpGather { static constexpr bool ON = true; static constexpr size_t KSTEP = (size_t)NINP * 2;
    __device__ static __forceinline__ unsigned rowoff(int rho) { const int mat = rho >> 12; int r = rho & 4095; r = r < NCROWS ? r : NCROWS - 1; const int b = r / (NCMP * 4), rem = r - b * (NCMP * 4), i1 = rem >> 2, gq = rem & 3;
        return (unsigned)(((b * SEQ + 16 * i1) * NINP + (mat ? OFF_VC : OFF_KC) + gq * 64) * 2); }
    __device__ static __forceinline__ size_t base(const Unit& u) { return (size_t)u.pn * 8 * NINP * 2; } };
template <class Epi, class Sched, bool F8 = false, class AG = NoGather>
__device__ __forceinline__ void gemm_phase(LAS unsigned char* lds, const Gemm g, const Sched& S, const Epi& E) {
    int tid = threadIdx.x; asm volatile("" : "+v"(tid));
    const int wid = __builtin_amdgcn_readfirstlane(tid >> 6), lane = tid & 63, wr = wid >> 2, wc = wid & 3, fr = lane & 15, fq = lane >> 4;
    const int K = g.K, nt = K * g.esz / (BK * 2);
    unsigned voffA[2], voffB[2];
#pragma unroll
    for (int i = 0; i < 2; ++i) { int R, C; stage_rc(tid * 16 + i * 8192, R, C); const int Rb = Epi::PERM ? ((R & ~31) + perm32(R & 31)) : R;
        voffA[i] = (unsigned)(R * g.lda * g.esz + C * 2); voffB[i] = (unsigned)(Rb * g.ldb * g.esz + C * 2); }
    const size_t kstep = (size_t)(BK * 2), kstepA = AG::ON ? AG::KSTEP : (size_t)(BK * 2);
    unsigned voffAg[2][2] = {{0u, 0u}, {0u, 0u}};
#define PG8_STAGE_A(b, h, base) PG8_STAGE(PG8_SA(b, h), (base) + (AG::ON ? (size_t)0 : (size_t)(h) * hstepA), (AG::ON ? voffAg[h] : voffA))
    const size_t hstepA = (size_t)HALF * g.lda * g.esz, hstepB = (size_t)HALF * g.ldb * g.esz;
    const unsigned ldsw = (unsigned)wid * 1024u;
    const int aoff = lds_byte(wr * 64 + fr, fq * 8), boff = lds_byte(wc * 32 + fr, fq * 8);
#define PG8_SA(b, h) (((b) * 2 + (h)) * HTB)
#define PG8_SB(b, h) ((4 + (b) * 2 + (h)) * HTB)
#define PG8_STAGE(bufoff, gbase, voff) do { _Pragma("unroll") for (int _i = 0; _i < 2; ++_i) \
        __builtin_amdgcn_global_load_lds((const unsigned*)((const char*)(gbase) + (voff)[_i]), (LAS unsigned*)(lds + (bufoff) + ldsw + _i * 8192), 16, 0, 0); } while (0)
#define PG8_LDA(dst, b, h) do { _Pragma("unroll") for (int m = 0; m < 4; ++m) dst[m] = cat16(*(const LAS f16x8*)(lds + PG8_SA(b, h) + aoff + m * 2048), *(const LAS f16x8*)(lds + PG8_SA(b, h) + aoff + m * 2048 + 1024)); } while (0)
#define PG8_LDB(dst, b, h) do { _Pragma("unroll") for (int n = 0; n < 2; ++n) dst[n] = cat16(*(const LAS f16x8*)(lds + PG8_SB(b, h) + boff + n * 2048), *(const LAS f16x8*)(lds + PG8_SB(b, h) + boff + n * 2048 + 1024)); } while (0)
#define PG8_MMA(ai, bj, At, Bt) do { __builtin_amdgcn_s_setprio(1); \
        if (F8) { _Pragma("unroll") for (int m = 0; m < 4; ++m) _Pragma("unroll") for (int n = 0; n < 2; ++n) \
            asm volatile("v_mfma_scale_f32_16x16x128_f8f6f4 %0, %1, %2, %0, %3, %3 op_sel_hi:[0,0,0]" : "+v"(acc[ai][bj][m][n]) : "v"(Bt[n]), "v"(At[m]), "v"(0x7F7F7F7F)); } \
        else { _Pragma("unroll") for (int m = 0; m < 4; ++m) _Pragma("unroll") for (int n = 0; n < 2; ++n) _Pragma("unroll") for (int k = 0; k < 2; ++k) \
            acc[ai][bj][m][n] = __builtin_amdgcn_mfma_f32_16x16x32_f16(half16(Bt[n], k), half16(At[m], k), acc[ai][bj][m][n], 0, 0, 0); } \
        __builtin_amdgcn_s_setprio(0); } while (0)
#define PG8_WAIT_V(n) asm volatile("s_waitcnt vmcnt(" #n ")" ::: "memory")
#define PG8_WAIT_L(n) asm volatile("s_waitcnt lgkmcnt(" #n ")" ::: "memory")
#define PG8_BAR __builtin_amdgcn_s_barrier()
#define PG8_SCHED __builtin_amdgcn_sched_barrier(0)
    Unit cur, nxt; int ui = 0;
    if (!S.next(0, cur)) return;
    f32x4 acc[2][2][4][2];
#pragma unroll
    for (int a = 0; a < 2; ++a)
#pragma unroll
        for (int b = 0; b < 2; ++b)
#pragma unroll
            for (int m = 0; m < 4; ++m)
#pragma unroll
                for (int n = 0; n < 2; ++n) acc[a][b][m][n] = (f32x4){0.f, 0.f, 0.f, 0.f};
    i32x8v At[4], B0[2], B1[2];
    if (AG::ON) {
#pragma unroll
        for (int i = 0; i < 2; ++i) { int R, C; stage_rc(tid * 16 + i * 8192, R, C);
#pragma unroll
            for (int h = 0; h < 2; ++h) voffAg[h][i] = AG::rowoff(cur.pm * BM + h * HALF + R) + (unsigned)(C * 2); } }
    const char* cA = AG::ON ? (const char*)g.A + AG::base(cur) : g.aptr(cur); const char* cB = g.bptr(cur);
    PG8_STAGE(PG8_SB(0, 0), cB, voffB); PG8_STAGE(PG8_SB(0, 1), cB + hstepB, voffB); PG8_STAGE_A(0, 0, cA); PG8_STAGE_A(0, 1, cA);
    if (wr == 1) PG8_BAR;
    PG8_WAIT_V(2); PG8_BAR;
    PG8_STAGE(PG8_SB(1, 0), cB + kstep, voffB); PG8_STAGE_A(1, 0, cA + kstepA); PG8_STAGE(PG8_SB(1, 1), cB + hstepB + kstep, voffB);
    PG8_WAIT_V(6); PG8_BAR;
    for (;;) {
        const bool has_next = S.next(ui + 1, nxt);
        const char* nA = has_next ? (AG::ON ? (const char*)g.A + AG::base(nxt) : g.aptr(nxt)) : cA; const char* nB = has_next ? g.bptr(nxt) : cB;
#pragma clang loop unroll(disable)
        for (int t = 0; t < nt; t += 2) {
            const bool last = (t == nt - 2);
            const char* a1 = cA + (size_t)(t + 1) * kstepA;
            const char* a2 = last ? nA : cA + (size_t)(t + 2) * kstepA; const char* b2 = last ? nB : cB + (size_t)(t + 2) * kstep;
            const char* a3 = a2 + kstepA; const char* b3 = b2 + kstep;
            PG8_LDB(B0, 0, 0); PG8_LDB(B1, 0, 1); PG8_SCHED; PG8_LDA(At, 0, 0); PG8_STAGE_A(1, 1, a1);
            PG8_WAIT_V(8); PG8_WAIT_L(0); PG8_BAR; PG8_MMA(0, 0, At, B0); PG8_MMA(0, 1, At, B1); PG8_BAR; PG8_SCHED;
            PG8_LDA(At, 0, 1); PG8_STAGE(PG8_SB(0, 0), b2, voffB); PG8_STAGE(PG8_SB(0, 1), b2 + hstepB, voffB); PG8_STAGE_A(0, 0, a2);
            PG8_WAIT_V(8); PG8_WAIT_L(0); PG8_BAR; PG8_MMA(1, 0, At, B0); PG8_MMA(1, 1, At, B1); PG8_BAR; PG8_SCHED;
            PG8_LDB(B0, 1, 0); PG8_LDB(B1, 1, 1); PG8_SCHED; PG8_LDA(At, 1, 0); PG8_STAGE_A(0, 1, a2);
            PG8_WAIT_V(8); PG8_WAIT_L(0); PG8_BAR; PG8_MMA(0, 0, At, B0); PG8_MMA(0, 1, At, B1); PG8_BAR; PG8_SCHED;
            PG8_LDA(At, 1, 1); PG8_STAGE(PG8_SB(1, 0), b3, voffB); PG8_STAGE(PG8_SB(1, 1), b3 + hstepB, voffB); PG8_STAGE_A(1, 0, a3);
            PG8_WAIT_V(8); PG8_WAIT_L(0); PG8_BAR; PG8_MMA(1, 0, At, B0); PG8_MMA(1, 1, At, B1); PG8_BAR; PG8_SCHED;
        }
        if (F8) asm volatile("s_nop 15\n\ts_nop 15" ::: "memory");
        if (wr == 0) PG8_BAR;
        E(acc, cur, wr, wc, fr, fq);
        if (!has_next) break;
#pragma unroll
        for (int a = 0; a < 2; ++a)
#pragma unroll
            for (int b = 0; b < 2; ++b)
#pragma unroll
                for (int m = 0; m < 4; ++m)
#pragma unroll
                    for (int n = 0; n < 2; ++n) acc[a][b][m][n] = (f32x4){0.f, 0.f, 0.f, 0.f};
        cur = nxt; cA = nA; cB = nB; ++ui;
        if (wr == 1) PG8_BAR;
    }
    PG8_WAIT_V(0);
    PG8_BAR;
#undef PG8_SA
#undef PG8_SB
#undef PG8_STAGE
#undef PG8_STAGE_A
#undef PG8_LDA
#undef PG8_LDB
#undef PG8_MMA
#undef PG8_WAIT_V
#undef PG8_WAIT_L
#undef PG8_BAR
#undef PG8_SCHED
}
}

#define XB_TMO      128
#define XB_XCNT(j)  (256  + 64 * (j))
#define XB_XSUB(j)  (1280 + 64 * (j))
#define XB_XGEN(j)  (2304 + 64 * (j))
#define XB_TOP      3328
#define XB_TOPGEN   3392
#define XCD_BAR_WORDS 3456
#define XB_SPIN_CAP (1u << 18)
__device__ __forceinline__ unsigned xb_ld(unsigned* p)              { return __hip_atomic_load(p, __ATOMIC_RELAXED, __HIP_MEMORY_SCOPE_AGENT); }
__device__ __forceinline__ unsigned xb_add(unsigned* p, unsigned v) { return __hip_atomic_fetch_add(p, v, __ATOMIC_RELAXED, __HIP_MEMORY_SCOPE_AGENT); }
__device__ __forceinline__ unsigned xb_xcc_id() { return (unsigned)__builtin_amdgcn_s_getreg((3 << 11) | 20) & 0xFu; }
#define XB_SPIN(cond, bar) do { unsigned _sp = 0; while (cond) { __builtin_amdgcn_s_sleep(1); \
    if ((++_sp & 255u) == 0u) { if (xb_ld(&(bar)[XB_TMO])) break; if (_sp > XB_SPIN_CAP) { atomicAdd(&(bar)[XB_TMO], 1u); break; } } } } while (0)
__device__ unsigned g_xbar[XCD_BAR_WORDS];
struct XcdBarrier { unsigned* bar; unsigned x; volatile LAS unsigned* st; };
__device__ __forceinline__ XcdBarrier xcd_barrier_post(unsigned* bar, volatile LAS unsigned* st) {
    XcdBarrier b; b.bar = bar; b.x = xb_xcc_id(); b.st = st;
    if (threadIdx.x == 0) (void)xb_add(&bar[XB_XCNT(b.x)], 1u);
    return b;
}
__device__ __forceinline__ void xcd_barrier_complete(unsigned* bar, unsigned x, unsigned& nloc, unsigned& nx) {
    const unsigned G = gridDim.x * gridDim.y * gridDim.z;
    unsigned sum, cnt, mine, sp = 0u;
    for (;;) {
        sum = 0u; cnt = 0u; mine = 0u;
#pragma unroll
        for (unsigned j = 0; j < 16; ++j) { const unsigned c = xb_ld(&bar[XB_XCNT(j)]); sum += c; cnt += (c > 0u) ? 1u : 0u; mine = (j == x) ? c : mine; }
        if (sum == G) break;
        __builtin_amdgcn_s_sleep(1);
        if ((++sp & 255u) == 0u) { if (xb_ld(&bar[XB_TMO])) break; if (sp > XB_SPIN_CAP) { atomicAdd(&bar[XB_TMO], 1u); break; } }
    }
    nloc = mine > 0u ? mine : 1u; nx = cnt > 0u ? cnt : 1u;
}
__device__ __forceinline__ void xcd_barrier(const XcdBarrier& b) {
    asm volatile("s_waitcnt vmcnt(0)" ::: "memory");
    __syncthreads();
    if (threadIdx.x == 0) {
        unsigned* bar = b.bar;
        __builtin_amdgcn_s_waitcnt(0);
        unsigned nloc = b.st[0], nx = b.st[1];
        if (nloc == 0u) { xcd_barrier_complete(bar, b.x, nloc, nx); b.st[0] = nloc; b.st[1] = nx; }
        const unsigned old = xb_add(&bar[XB_XSUB(b.x)], 1u);
        const unsigned gen = old / nloc;
        if (old + 1u == (gen + 1u) * nloc) {
            __builtin_amdgcn_fence(__ATOMIC_RELEASE, "agent");
            asm volatile("s_waitcnt vmcnt(0)" ::: "memory");
            const unsigned og = xb_add(&bar[XB_TOP], 1u);
            const unsigned tg = og / nx;
            if (og + 1u == (tg + 1u) * nx) xb_add(&bar[XB_TOPGEN], 1u);
            else XB_SPIN(xb_ld(&bar[XB_TOPGEN]) == tg, bar);
            __builtin_amdgcn_fence(__ATOMIC_ACQUIRE, "agent");
            xb_add(&bar[XB_XGEN(b.x)], 1u);
            asm volatile("s_waitcnt vmcnt(0)" ::: "memory");
        } else {
            XB_SPIN(xb_ld(&bar[XB_XGEN(b.x)]) == gen, bar);
            __builtin_amdgcn_fence(__ATOMIC_ACQUIRE, "agent");
            asm volatile("s_waitcnt vmcnt(0)" ::: "memory");
        }
    }
    __syncthreads();
}

struct Frame {
    LAS unsigned char* lds;
    volatile LAS unsigned* MISC;
    int tid, lane, wave;
    int vcu, G;
    const float* in[26];
    float* out;
    unsigned char* ws;
};
enum { I_X = 0, I_P, I_RELB, I_MIXNW, I_WIN, I_QNW, I_KNW, I_CKPOS, I_CKW1, I_CKB1, I_CKW2, I_CVPOS, I_CVW1, I_CVB1, I_CVW2, I_POOLW, I_POOLS, I_WOUT, I_FFNNW, I_PWQ, I_PKEYS, I_PU, I_PV, I_PLENW, I_PLEWG, I_PLEWP };

__device__ __forceinline__ void p0_transpose_item(const float* W, int K, int N, int Npad, const float* colscale, f16* WT, LAS float* scr, LAS float* scr2, int item, int lane, const float* kscale = nullptr, bool f8 = false, float wscale = 1.f, int dsh = 0) {
    const int nblk = Npad / 32, kb = item / nblk, nb = item % nblk, k0 = 64 * kb, n0 = 32 * nb;
    const int nn = n0 + (lane & 31); const bool ok = nn < N;
#pragma unroll
    for (int hgrp = 0; hgrp < 2; ++hgrp) { float wv[16];
#pragma unroll
        for (int i = 0; i < 16; ++i) { const int kk = 2 * (16 * hgrp + i) + (lane >> 5); wv[i] = ok ? W[(size_t)(k0 + kk) * N + nn] : 0.f; }
        if (kscale) {
#pragma unroll
            for (int i = 0; i < 16; ++i) wv[i] *= kscale[k0 + 2 * (16 * hgrp + i) + (lane >> 5)]; }
#pragma unroll
        for (int i = 0; i < 16; ++i) { const int kk = 2 * (16 * hgrp + i) + (lane >> 5); (kk < 62 ? scr + kk * 33 : scr2 + (kk - 62) * 33)[lane & 31] = wv[i]; }
        asm volatile("" ::: "memory"); }
    LDS_WAIT(); asm volatile("" ::: "memory");
    const int c = lane & 7;
#pragma unroll
    for (int j = 0; j < 4; ++j) { const int n = (lane >> 3) + 8 * j; const LAS float* s = scr + (8 * c) * 33 + n; const LAS float* sh = (c == 7 ? scr2 : scr + (8 * c + 6) * 33) + n; const float sc = (colscale && n0 + n < N) ? colscale[n0 + n] : 1.f;
        if (f8) { const float s8 = sc * wscale; u32x2 o; o.x = pk_fp8(s[0 * 33] * s8, s[1 * 33] * s8, s[2 * 33] * s8, s[3 * 33] * s8); o.y = pk_fp8(s[4 * 33] * s8, s[5 * 33] * s8, sh[0] * s8, sh[33] * s8);
            *(GAS u32x2*)((unsigned char*)WT + (size_t)(n0 + n + dsh) * K + k0 + 8 * c) = o; }
        else { u32x4 o; o.x = pk_f16(s[0 * 33] * sc, s[1 * 33] * sc); o.y = pk_f16(s[2 * 33] * sc, s[3 * 33] * sc); o.z = pk_f16(s[4 * 33] * sc, s[5 * 33] * sc); o.w = pk_f16(sh[0] * sc, sh[33] * sc);
            *(GAS u32x4*)(WT + (size_t)(n0 + n) * K + k0 + 8 * c) = o; } }
    LDS_WAIT(); asm volatile("" ::: "memory");
}
__device__ __forceinline__ void rms_row_to_f16(const float* xrow, const float* w, f16* orow, int lane, f16* x16row = nullptr) {
    const GAS f32x4* xr = (const GAS f32x4*)xrow + lane; const GAS f32x4* wr = (const GAS f32x4*)w + lane;
    f32x4 v[8]; float s = 0.f;
#pragma unroll
    for (int j = 0; j < 8; ++j) { v[j] = xr[64 * j]; s += (v[j].x * v[j].x + v[j].y * v[j].y) + (v[j].z * v[j].z + v[j].w * v[j].w); }
    const float rstd = 1.f / sqrtf(wave_sum(s) * (1.f / D) + RMS_EPS);
    GAS u32x2* o8 = (GAS u32x2*)orow + lane;
#pragma unroll
    for (int j = 0; j < 8; ++j) { const f32x4 g = wr[64 * j]; u32x2 o; o.x = pk_f16(v[j].x * rstd * g.x, v[j].y * rstd * g.y); o.y = pk_f16(v[j].z * rstd * g.z, v[j].w * rstd * g.w); o8[64 * j] = o; }
    if (x16row) { GAS u32x2* x8 = (GAS u32x2*)x16row + lane;
#pragma unroll
        for (int j = 0; j < 8; ++j) { u32x2 o; o.x = pk_f16(v[j].x, v[j].y); o.y = pk_f16(v[j].z, v[j].w); x8[64 * j] = o; } }
}
__device__ __forceinline__ void rms_2rows_to_f16(const float* x0, const float* x1, const float* w, f16* o0, f16* o1, f16* h0, f16* h1, int lane) {
    const GAS f32x4* xa = (const GAS f32x4*)x0 + lane; const GAS f32x4* xb = (const GAS f32x4*)x1 + lane; const GAS f32x4* wr = (const GAS f32x4*)w + lane;
    f32x4 va[8], vb[8]; float sa = 0.f, sb = 0.f;
#pragma unroll
    for (int j = 0; j < 8; ++j) { va[j] = __builtin_nontemporal_load(xa + 64 * j); vb[j] = __builtin_nontemporal_load(xb + 64 * j); }
#pragma unroll
    for (int j = 0; j < 8; ++j) { sa += (va[j].x * va[j].x + va[j].y * va[j].y) + (va[j].z * va[j].z + va[j].w * va[j].w); sb += (vb[j].x * vb[j].x + vb[j].y * vb[j].y) + (vb[j].z * vb[j].z + vb[j].w * vb[j].w); }
    const float ra = 1.f / sqrtf(wave_sum(sa) * (1.f / D) + RMS_EPS), rb = 1.f / sqrtf(wave_sum(sb) * (1.f / D) + RMS_EPS);
    GAS u32x2* pa = (GAS u32x2*)o0 + lane; GAS u32x2* pb = (GAS u32x2*)o1 + lane; GAS u32x2* qa = (GAS u32x2*)h0 + lane; GAS u32x2* qb = (GAS u32x2*)h1 + lane;
#pragma unroll
    for (int j = 0; j < 8; ++j) { const f32x4 g = wr[64 * j]; u32x2 o;
        o.x = pk_f16(va[j].x * ra * g.x, va[j].y * ra * g.y); o.y = pk_f16(va[j].z * ra * g.z, va[j].w * ra * g.w); pa[64 * j] = o;
        o.x = pk_f16(vb[j].x * rb * g.x, vb[j].y * rb * g.y); o.y = pk_f16(vb[j].z * rb * g.z, vb[j].w * rb * g.w); pb[64 * j] = o;
        o.x = pk_f16(va[j].x, va[j].y); o.y = pk_f16(va[j].z, va[j].w); qa[64 * j] = o;
        o.x = pk_f16(vb[j].x, vb[j].y); o.y = pk_f16(vb[j].z, vb[j].w); qb[64 * j] = o; }
}
__device__ __forceinline__ void x16_2rows(const float* x0, const float* x1, f16* h0, f16* h1, float* ss0, float* ss1, int lane, unsigned char* e0, unsigned char* e1) {
    const GAS f32x4* xa = (const GAS f32x4*)x0 + lane; const GAS f32x4* xb = (const GAS f32x4*)x1 + lane;
    f32x4 va[8], vb[8]; float sa = 0.f, sb = 0.f;
#pragma unroll
    for (int j = 0; j < 8; ++j) { va[j] = __builtin_nontemporal_load(xa + 64 * j); vb[j] = __builtin_nontemporal_load(xb + 64 * j); }
    GAS u32x2* qa = (GAS u32x2*)h0 + lane; GAS u32x2* qb = (GAS u32x2*)h1 + lane;
#pragma unroll
    for (int j = 0; j < 8; ++j) { sa += (va[j].x * va[j].x + va[j].y * va[j].y) + (va[j].z * va[j].z + va[j].w * va[j].w); sb += (vb[j].x * vb[j].x + vb[j].y * vb[j].y) + (vb[j].z * vb[j].z + vb[j].w * vb[j].w);
        u32x2 o; o.x = pk_f16(va[j].x, va[j].y); o.y = pk_f16(va[j].z, va[j].w); qa[64 * j] = o;
        o.x = pk_f16(vb[j].x, vb[j].y); o.y = pk_f16(vb[j].z, vb[j].w); qb[64 * j] = o;
        *(GAS unsigned*)(e0 + 256 * j + 4 * lane) = pk_fp8(va[j].x, va[j].y, va[j].z, va[j].w); *(GAS unsigned*)(e1 + 256 * j + 4 * lane) = pk_fp8(vb[j].x, vb[j].y, vb[j].z, vb[j].w); }
    sa = wave_sum(sa); sb = wave_sum(sb);
    if (lane == 0) { *ss0 = sa; *ss1 = sb; }
}
__device__ __forceinline__ void cvt_f32_f16(Frame& F, const float* src, f16* dst, size_t n) {
    const size_t gt = (size_t)F.vcu * 512 + F.tid, GT = (size_t)F.G * 512;
    for (size_t i = gt; i < n / 8; i += GT) { const f32x4 a = *(const GAS f32x4*)(src + i * 8), b = *(const GAS f32x4*)(src + i * 8 + 4);
        u32x4 o; o.x = pk_f16(a.x, a.y); o.y = pk_f16(a.z, a.w); o.z = pk_f16(b.x, b.y); o.w = pk_f16(b.z, b.w); *(GAS u32x4*)(dst + i * 8) = o; }
}

constexpr int P0_I_IN = (D / 64) * (NINP / 32), P0_I_SQ = (D / 64) * (D / 32), P0_I_PJ = (256 / 64) * (D / 32), P0_I_C1 = (D / 64) * (256 / 32), P0_I_PL = (256 / 64) * (256 / 32);
constexpr int P0_NITEMS = P0_I_IN + 3 * P0_I_SQ + P0_I_PJ + 2 * P0_I_C1 + 4 * P0_I_PL, P0_DEF_LO = P0_I_IN, P0_DEF_HI = P0_I_IN + 3 * P0_I_SQ + P0_I_PJ;
__device__ __forceinline__ void p0_items(Frame& F, LAS float* scr, LAS float* scr2, int lo, int hi, int gw, int NGW) {
    unsigned char* ws = F.ws;
    constexpr int I_IN = P0_I_IN, I_SQ = P0_I_SQ, I_PJ = P0_I_PJ, I_C1 = P0_I_C1, I_PL = P0_I_PL;
    for (int it = lo + gw; it < hi; it += NGW) {
        int r = it;
        if (r < I_IN) { const int tile = (r % (NINP / 32)) >> 3; const bool v8 = tile != 8;
            const int ob = r & 7; const int dsh = (tile == 10 || tile == 12) ? 32 * (4 * (ob & 1) + (ob >> 1) - ob) : 0;
            p0_transpose_item(F.in[I_WIN], D, NIN, NINP, nullptr, (f16*)(ws + (v8 ? WS_WIN8 : WS_WIN)), scr, scr2, r, F.lane, F.in[I_MIXNW], v8, v8 ? W8SCALE : 1.f, dsh); continue; } r -= I_IN;
        if (r < I_SQ) { p0_transpose_item(F.in[I_WOUT], D, D, D, nullptr, (f16*)(ws + WS_WOUT), scr, scr2, r, F.lane, nullptr, true, W8SCALE); continue; } r -= I_SQ;
        if (r < I_SQ) { p0_transpose_item(F.in[I_PWQ], D, D, D, nullptr, (f16*)(ws + WS_WQ), scr, scr2, r, F.lane, F.in[I_FFNNW]); continue; } r -= I_SQ;
        if (r < I_SQ) { p0_transpose_item(F.in[I_PLEWG], D, D, D, nullptr, (f16*)(ws + WS_WG), scr, scr2, r, F.lane, F.in[I_PLENW], true, W8SCALE); continue; } r -= I_SQ;
        if (r < I_PJ) { p0_transpose_item(F.in[I_PLEWP], 256, D, D, nullptr, (f16*)(ws + WS_WPJ), scr, scr2, r, F.lane); continue; } r -= I_PJ;
        if (r < I_C1) { p0_transpose_item(F.in[I_CKW1], D, 256, 256, nullptr, (f16*)(ws + WS_W1C), scr, scr2, r, F.lane); continue; } r -= I_C1;
        if (r < I_C1) { p0_transpose_item(F.in[I_CVW1], D, 256, 256, nullptr, (f16*)(ws + WS_W1C) + 256 * D, scr, scr2, r, F.lane); continue; } r -= I_C1;
        { const int g = r / I_PL; r -= g * I_PL;
          p0_transpose_item(F.in[I_POOLW] + (size_t)g * 65536, 256, 256, 256, F.in[I_POOLS] + g * 256, (f16*)(ws + WS_POOLT) + (size_t)g * 65536, scr, scr2, r, F.lane); }
    }
}
__device__ __forceinline__ void p0_deferred(Frame& F) {
    p0_items(F, (LAS float*)(F.lds + 65536 + F.wave * 8192), (LAS float*)(F.lds + F.wave * 8192), P0_DEF_LO, P0_DEF_HI, F.vcu * NWAVES + F.wave, F.G * NWAVES);
    cvt_f32_f16(F, F.in[I_P], (f16*)(F.ws + WS_P16), (size_t)M * 256);
    cvt_f32_f16(F, F.in[I_PKEYS], (f16*)(F.ws + WS_KEYS), (size_t)8 * 2 * 128 * 128);
    LDS_WAIT(); asm volatile("" ::: "memory");
}
__device__ __forceinline__ void p0_late(Frame& F, int gw, int NGW);
__device__ __forceinline__ void p0_prologue(Frame& F) {
    LAS float* scr = (LAS float*)(F.lds + F.wave * 16384);
    const int gw = F.vcu * NWAVES + F.wave, NGW = F.G * NWAVES;
    unsigned char* ws = F.ws;
    for (int i = F.vcu * (NWAVES * 64) + F.tid; i < M; i += F.G * (NWAVES * 64)) { ((float*)(ws + WS_SS1))[i] = 0.f; ((float*)(ws + WS_SS2))[i] = 0.f; }
    p0_items(F, scr, scr + 62 * 33, 0, P0_DEF_LO, gw, NGW);
    { float* SS0 = (float*)(ws + WS_SS0); f16* XR = (f16*)(ws + WS_XR);
      for (int m = gw; m < M; m += 2 * NGW) { const int m2 = m + NGW < M ? m + NGW : m;
          x16_2rows(F.in[I_X] + (size_t)m * D, F.in[I_X] + (size_t)m2 * D, XR + (size_t)m * D, XR + (size_t)m2 * D, SS0 + m, SS0 + m2, F.lane, ws + WS_X8 + (size_t)m * D, ws + WS_X8 + (size_t)m2 * D); } }
    if (F.G != 256) p0_late(F, gw, NGW);
}
__device__ __forceinline__ void p0_late(Frame& F, int gw, int NGW) {
    unsigned char* ws = F.ws;
    LAS float* scr = (LAS float*)(F.lds + F.wave * 16384);
    p0_items(F, scr, scr + 62 * 33, P0_DEF_HI, P0_NITEMS, gw, NGW);
    for (int task = gw; task < 512; task += NGW) { const int mat = task >> 8, n = task & 255;
        const float* pos = F.in[mat ? I_CVPOS : I_CKPOS]; const float* w1 = F.in[mat ? I_CVW1 : I_CKW1]; float s = 0.f;
#pragma unroll
        for (int i = 0; i < 32; ++i) { const int k = F.lane + 64 * i; s += pos[k] * w1[(size_t)k * 256 + n]; }
        s = wave_sum(s);
        if (F.lane == 0) ((float*)(ws + WS_CBIAS))[task] = s + F.in[mat ? I_CVB1 : I_CKB1][n]; }
}

template <int W> __device__ __forceinline__ void pool_mix_tile(const f16* up, f16* mp, size_t mb, int s0) {
    f16x2 prev[16], cur[16]; f32x2 sum = {0.f, 0.f};
#pragma unroll
    for (int i = 0; i < 16; ++i) { const int sp = s0 - 16 + i; prev[i] = sp >= 0 ? *(const GAS f16x2*)(up + (mb + sp) * NINP) : (f16x2){(f16)0.f, (f16)0.f}; }
#pragma unroll
    for (int i = 16 - W; i < 16; ++i) { sum.x += (float)prev[i].x; sum.y += (float)prev[i].y; }
#pragma unroll 1
    for (int blk = 0; blk < 4; ++blk) { const int sb = s0 + blk * 16;
#pragma unroll
        for (int i = 0; i < 16; ++i) cur[i] = *(const GAS f16x2*)(up + (mb + sb + i) * NINP);
#pragma unroll
        for (int i = 0; i < 16; ++i) { const int s = sb + i; const f16x2 o = (i - W >= 0) ? cur[(i - W >= 0) ? i - W : 0] : prev[(i - W >= 0) ? 0 : 16 + i - W];
            sum.x += (float)cur[i].x - (float)o.x; sum.y += (float)cur[i].y - (float)o.y;
            const float ic = 1.f / (float)(s + 1 < W ? s + 1 : W);
            *(GAS unsigned*)(mp + (mb + s) * 1024) = pk_f16(sum.x * ic - (float)cur[i].x, sum.y * ic - (float)cur[i].y); }
#pragma unroll
        for (int i = 0; i < 16; ++i) prev[i] = cur[i]; }
}
__device__ __forceinline__ void p3_pool_mix(unsigned char* ws, int pair, int tid) {
    const int tile = pair >> 1, half = pair & 1, b = tile >> 3, sbase = (tile & 7) * 256;
    const int ch = half * 512 + (tid & 255) * 2, win = half * 2 + ((tid >> 7) & 1);
    const f16* up = (const f16*)(ws + WS_Y) + OFF_U + ch; f16* mp = (f16*)(ws + WS_MIXED) + ch;
#pragma unroll 1
    for (int it = 0; it < 2; ++it) { const int s0 = sbase + (2 * it + (tid >> 8)) * 64;
        if (win == 0) pool_mix_tile<2>(up, mp, (size_t)b * SEQ, s0);
        else if (win == 1) pool_mix_tile<4>(up, mp, (size_t)b * SEQ, s0);
        else if (win == 2) pool_mix_tile<8>(up, mp, (size_t)b * SEQ, s0);
        else pool_mix_tile<16>(up, mp, (size_t)b * SEQ, s0); }
}
__device__ __forceinline__ void p2_post(Frame& F) {
    unsigned char* ws = F.ws;
    f16* Y = (f16*)(ws + WS_Y);
    for (int tt = F.vcu; tt < M / 64; tt += F.G) {
        const int b = tt >> 5, s0 = (tt & 31) * 64, m0 = tt * 64;
        if (F.G != 256) for (int tk = F.wave; tk < 64; tk += NWAVES) {
            const int m = m0 + tk, s = s0 + tk; f16* yr = Y + (size_t)m * NINP;
            if (F.G != 256)
            { const int mat = F.lane >> 5, ch = F.lane & 31, g = ch >> 3, dc = ch & 7; const u32x4 v = *(const GAS u32x4*)(yr + (mat ? OFF_VC : OFF_KC) + ch * 8);
                const int i1 = s >> 4, jj = s & 15; f16* fa = (f16*)(ws + WS_FLATA) + (size_t)mat * 4096 * 2048;
                if (i1 <= NCMP - 1) *(GAS u32x4*)(fa + (size_t)((b * NCMP + i1) * 4 + g) * 2048 + jj * 64 + dc * 8) = v;
                if (i1 >= 1) *(GAS u32x4*)(fa + (size_t)((b * NCMP + i1 - 1) * 4 + g) * 2048 + (16 + jj) * 64 + dc * 8) = v; }
        }
    }
}

__device__ __forceinline__ void p4_compress2(Frame& F) {
    unsigned char* ws = F.ws;
    f16* kc = (f16*)(ws + WS_KCMP); f16* vt = (f16*)(ws + WS_VCMPT);
    const int nhalf = F.G >> 1, mat = F.vcu & 1, wgr = F.vcu >> 1;
    if (nhalf == 0) return;
    LAS float* w2l = (LAS float*)F.lds;
    { const float* w2g = F.in[mat ? I_CVW2 : I_CKW2];
      for (int idx = F.tid; idx < 256 * 16; idx += 512) { const int k = idx >> 4, d4 = (idx & 15) * 4; const f32x4 v = *(const GAS f32x4*)(w2g + (size_t)k * 64 + d4);
          LAS float* q = w2l + ((k >> 2) * 64 + d4) * 4 + (k & 3); q[0] = v.x; q[4] = v.y; q[8] = v.z; q[12] = v.w; } }
    __syncthreads();
    const int rstep = nhalf * NWAVES, r0 = (F.vcu >= 2 * nhalf ? 4096 : wgr * NWAVES + F.wave);
#pragma unroll 1
    for (int rb = r0; rb < 4096; rb += 4 * rstep) {
        f32x4 hs[4];
#pragma unroll
        for (int q = 0; q < 4; ++q) { const int r = rb + q * rstep < 4096 ? rb + q * rstep : rb; const int bg = r >> 7, i = r & 127, ic = i < NCMP ? i : 0;
            const f16* hp = (const f16*)(ws + WS_HP) + ((size_t)mat * 4096 + (size_t)((bg >> 2) * NCMP + ic) * 4 + (bg & 3)) * 1024 + F.lane * 4;
            hs[q] = *(const GAS f32x4*)(((const float*)(ws + WS_CBIAS)) + mat * 256 + F.lane * 4);
#pragma unroll
            for (int ks = 0; ks < 4; ++ks) { const u32x2 pv = *(const GAS u32x2*)(hp + ks * 256); const f16x2 a = ash2(pv.x), b = ash2(pv.y); hs[q] = hs[q] + (f32x4){(float)a.x, (float)a.y, (float)b.x, (float)b.y}; } }
        float hh_[4][4], ac[4][4];
#pragma unroll
        for (int q = 0; q < 4; ++q) { const f32x2 ga = pg8::gelu_pk((f32x2){hs[q].x, hs[q].y}), gb = pg8::gelu_pk((f32x2){hs[q].z, hs[q].w});
            hh_[q][0] = ga.x; hh_[q][1] = ga.y; hh_[q][2] = gb.x; hh_[q][3] = gb.y; ac[q][0] = 0.f; ac[q][1] = 0.f; ac[q][2] = 0.f; ac[q][3] = 0.f; }
#pragma unroll 8
        for (int kk = 0; kk < 64; ++kk) { const f32x4 wv = *(const LAS f32x4*)(w2l + (kk * 64 + F.lane) * 4);
#pragma unroll
            for (int q = 0; q < 4; ++q) { ac[q][0] += rl_f(hh_[q][0], kk) * wv.x; ac[q][1] += rl_f(hh_[q][1], kk) * wv.y; ac[q][2] += rl_f(hh_[q][2], kk) * wv.z; ac[q][3] += rl_f(hh_[q][3], kk) * wv.w; } }
#pragma unroll
        for (int q = 0; q < 4; ++q) { const int r = rb + q * rstep; if (r < 4096) {
            const int bg = r >> 7, i = r & 127;
            const float acc = i < NCMP ? (ac[q][0] + ac[q][1]) + (ac[q][2] + ac[q][3]) : 0.f;
            if (mat == 0) { const float ss = wave_sum(acc * acc); const float rs = 1.f / sqrtf(ss * (1.f / 64.f) + RMS_EPS);
                const int d = F.lane, dc = d >> 3;
                kc[((size_t)bg * 4 + (i >> 5)) * 2048 + (dc >> 1) * 512 + ((dc & 1) * 32 + (i & 31)) * 8 + (d & 7)] = (f16)(i < NCMP ? acc * rs * F.in[I_KNW][F.lane] * F.in[I_QNW][F.lane] : 0.f); }
            else { const int kap = i & 15, pp = ((kap >> 2) & 1) * 8 + (kap >> 3) * 4 + (kap & 3);
                const int d = F.lane;
                vt[((size_t)bg * 4 + (i >> 5)) * 2048 + ((d >> 5) * 2 + ((i >> 4) & 1)) * 512 + ((pp >> 3) * 32 + (d & 31)) * 8 + (pp & 7)] = (f16)acc; } } }
    }
    __syncthreads();
}

__device__ __forceinline__ int t5_bucket(int rel) {
    if (rel < 16) return rel;
    int b = 16;
    b += rel >= 19; b += rel >= 21; b += rel >= 24; b += rel >= 27; b += rel >= 31; b += rel >= 35; b += rel >= 40; b += rel >= 46;
    b += rel >= 52; b += rel >= 59; b += rel >= 67; b += rel >= 77; b += rel >= 87; b += rel >= 99; b += rel >= 113;
    return b;
}
__device__ __forceinline__ int med3i(int a, int lo, int hi) { return a < lo ? lo : (a > hi ? hi : a); }
__device__ __forceinline__ float other_half_max(float x) { const auto r = __builtin_amdgcn_permlane32_swap(__float_as_uint(x), __float_as_uint(x), false, false); return fmaxf(__uint_as_float(r[0]), __uint_as_float(r[1])); }
__device__ __forceinline__ float both_halves_sum(float x) { const auto r = __builtin_amdgcn_permlane32_swap(__float_as_uint(x), __float_as_uint(x), false, false); return __uint_as_float(r[0]) + __uint_as_float(r[1]); }
struct AFrag { u32x4 k[2]; u32x4 v[2]; };
struct AttRs { __amdgpu_buffer_rsrc_t k, v; int lo16; };
__device__ __forceinline__ void attn_load(AFrag& f, const AttRs& R, int kt) {
    typedef unsigned v4u_a __attribute__((__vector_size__(16)));
#pragma unroll
    for (int j = 0; j < 2; ++j) { const v4u_a t = __builtin_amdgcn_raw_buffer_load_b128(R.k, R.lo16 + j * 1024, kt * 2048, 0); f.k[j] = (u32x4){t[0], t[1], t[2], t[3]}; }
#pragma unroll
    for (int dt = 0; dt < 2; ++dt) { const v4u_a t = __builtin_amdgcn_raw_buffer_load_b128(R.v, R.lo16 + dt * 1024, kt * 2048, 0); f.v[dt] = (u32x4){t[0], t[1], t[2], t[3]}; }
}
__device__ __forceinline__ f16x8 pack8(const f32x16& c, int s2) {
    f16x8 o;
#pragma unroll
    for (int j = 0; j < 8; ++j) o[j] = (f16)c[8 * s2 + j];
    return o;
}
__device__ __forceinline__ void attn_tile(const AFrag& f, const long (&bq8)[4], int kt, int t0, int t, int hh, int wlim, unsigned selm, float cfar, const LAS float* lutr,
                                          float& mrun, float& lrun, f32x16& O0, f32x16& O1) {
    f32x16 S;
#pragma unroll
    for (int i = 0; i < 16; ++i) S[i] = 0.f;
#pragma unroll
    for (int ks = 0; ks < 4; ++ks) S = __builtin_amdgcn_mfma_f32_32x32x16_fp8_fp8((ks & 1) ? as_i64(f.k[ks >> 1].z, f.k[ks >> 1].w) : as_i64(f.k[ks >> 1].x, f.k[ks >> 1].y), bq8[ks], S, 0, 0, 0);
    const int k0 = kt * 32, minrel = t0 - (k0 + 31), maxrel = t0 + 7 - k0;
    const bool selbit = ((selm >> (kt >> 1)) & 1u) != 0u;
    float addc = 0.f;
    if (minrel >= 113 && maxrel < wlim) addc = selbit ? cfar : -2e30f;
    else {
        const unsigned wl = selbit ? (unsigned)wlim : 0u; const int relb = t - k0 - 4 * hh;
        float bias[16];
#pragma unroll
        for (int i = 0; i < 16; ++i) bias[i] = lutr[med3i(relb - ((i & 3) + 8 * (i >> 2)), 0, 127)];
#pragma unroll
        for (int i = 0; i < 16; ++i) asm volatile("" : "+v"(bias[i]));
#pragma unroll
        for (int i = 0; i < 16; ++i) { const int rel = relb - ((i & 3) + 8 * (i >> 2)); S[i] = ((unsigned)rel < wl) ? __builtin_fmaf(bias[i], 8.f, S[i]) : -2e30f; }
    }
    float tmax = S[0];
#pragma unroll
    for (int i = 1; i < 16; ++i) tmax = fmaxf(tmax, S[i]);
    tmax = other_half_max(tmax) * 0.125f + addc;
    const float mnew = fmaxf(mrun, tmax), alpha = __builtin_amdgcn_exp2f(mrun - mnew);
    mrun = mnew; lrun *= alpha;
    if (__builtin_amdgcn_ballot_w64(alpha != 1.0f) != 0ull) {
#pragma unroll
        for (int i = 0; i < 16; ++i) { O0[i] = mul_np(O0[i], alpha); O1[i] = mul_np(O1[i], alpha); } }
    const float mm = mnew - addc;
#pragma unroll
    for (int i = 0; i < 16; ++i) { const float pv = __builtin_amdgcn_exp2f(__builtin_fmaf(S[i], 0.125f, -mm)); lrun += pv; S[i] = pv; }
#pragma unroll
    for (int s2 = 0; s2 < 2; ++s2) { const long pb = as_i64(pk_fp8(S[8 * s2], S[8 * s2 + 1], S[8 * s2 + 2], S[8 * s2 + 3]), pk_fp8(S[8 * s2 + 4], S[8 * s2 + 5], S[8 * s2 + 6], S[8 * s2 + 7]));
        O0 = __builtin_amdgcn_mfma_f32_32x32x16_fp8_fp8(s2 ? as_i64(f.v[0].z, f.v[0].w) : as_i64(f.v[0].x, f.v[0].y), pb, O0, 0, 0, 0);
        O1 = __builtin_amdgcn_mfma_f32_32x32x16_fp8_fp8(s2 ? as_i64(f.v[1].z, f.v[1].w) : as_i64(f.v[1].x, f.v[1].y), pb, O1, 0, 0, 0); }
}
__device__ __forceinline__ void attn_branch(const unsigned char* Kp, const unsigned char* Vp, unsigned long long tm, const long (&bq)[4], int t0, int t, int r31, int hh, int wlim, unsigned selm, float cfar,
                                            const LAS float* lutr, float gate, LAS float* TL) {
    float mrun = -1e30f, lrun = 0.f; f32x16 O0, O1;
#pragma unroll
    for (int i = 0; i < 16; ++i) { O0[i] = 0.f; O1[i] = 0.f; }
    AttRs R; R.k = __builtin_amdgcn_make_buffer_rsrc((void*)Kp, 0, SEQ * 64, 0x00020000); R.v = __builtin_amdgcn_make_buffer_rsrc((void*)Vp, 0, SEQ * 64, 0x00020000); R.lo16 = (hh * 32 + r31) * 16;
    AFrag f0, f1, f2, f3;
    int last = __builtin_ctzll(tm);
#define ATT_POP(k, v) do { tm &= tm - 1; v = tm != 0ull; k = v ? __builtin_ctzll(tm) : last; last = k; } while (0)
    int ka = last, kb, kc, kd; bool vb, vc, vd, va;
    attn_load(f0, R, ka);
    ATT_POP(kb, vb); attn_load(f1, R, kb);
    if (vb) ATT_POP(kc, vc); else { kc = last; vc = false; }
    attn_load(f2, R, kc);
    for (;;) {
        if (vc) ATT_POP(kd, vd); else { kd = last; vd = false; }
        attn_load(f3, R, kd);
        attn_tile(f0, bq, ka, t0, t, hh, wlim, selm, cfar, lutr, mrun, lrun, O0, O1);
        if (!vb) break;
        if (vd) ATT_POP(ka, va); else { ka = last; va = false; }
        attn_load(f0, R, ka);
        attn_tile(f1, bq, kb, t0, t, hh, wlim, selm, cfar, lutr, mrun, lrun, O0, O1);
        if (!vc) break;
        if (va) ATT_POP(kb, vb); else { kb = last; vb = false; }
        attn_load(f1, R, kb);
        attn_tile(f2, bq, kc, t0, t, hh, wlim, selm, cfar, lutr, mrun, lrun, O0, O1);
        if (!vd) break;
        if (vb) ATT_POP(kc, vc); else { kc = last; vc = false; }
        attn_load(f2, R, kc);
        attn_tile(f3, bq, kd, t0, t, hh, wlim, selm, cfar, lutr, mrun, lrun, O0, O1);
        if (!va) break;
    }
#undef ATT_POP
    lrun = both_halves_sum(lrun);
    const float sc = gate / fmaxf(lrun, 1e-30f);
#pragma unroll
    for (int i = 0; i < 16; ++i) { TL[i * 64] += O0[i] * sc; TL[(16 + i) * 64] += O1[i] * sc; }
}
__device__ __forceinline__ void p5_attention(Frame& F) {
    unsigned char* ws = F.ws;
    const f16* Y = (const f16*)(ws + WS_Y);
    const float* gates = (const float*)(ws + WS_GATES);
    f16* CAT = (f16*)(ws + WS_CAT);
    LAS float* wl = (LAS float*)(F.lds + F.wave * 8192);
    LAS float* LUT = wl;
    const int gw = F.vcu * NWAVES + F.wave, NW = F.G * NWAVES;
    const bool snake = (8192 % (2 * NW)) == 0, bal = (NW == 2048);
    int lut_g = -1;
    LAS unsigned* SELM = (LAS unsigned*)(wl + 1280);
    for (int it = gw, rr = 0; it < 8192; it += NW, ++rr) {
        int n = (snake && (rr & 1)) ? (rr * NW + (NW - 1 - gw)) : it;
        if (bal) {
            const int xq = gw >> 8, u = gw & 255;
            if (rr < 3) { const int f = rr * 256 + u, q = f / 192; n = (q * 8 + xq) * 256 + 64 + (f - q * 192); }
            else { const int c = u >> 3, w = u & 7, k = (c & 7) * 4 + (w & 3); n = ((c >> 3) * 8 + xq) * 256 + ((w & 4) ? 63 - k : k); } }
        const int bg = n >> 8, pos = n & 255, b = bg >> 2, g = bg & 3, t0 = pos * 8;
        int lane = F.lane; asm volatile("" : "+v"(lane));
        const int r31 = lane & 31, hh = lane >> 5, tok8 = r31 >> 2, r = r31 & 3;
        const LAS float* lutr = LUT + r * 128;
        if (g != lut_g) {
            LDS_WAIT(); asm volatile("" ::: "memory");
#pragma unroll
            for (int e = 0; e < 2; ++e) { const int rel = lane + 64 * e, bk = t5_bucket(rel);
#pragma unroll
                for (int r4 = 0; r4 < 4; ++r4) LUT[r4 * 128 + rel] = F.in[I_RELB][bk * 16 + 4 * g + r4] * LOG2E; }
            LDS_WAIT(); asm volatile("" ::: "memory");
            lut_g = g;
        }
        const int t = t0 + tok8, head = 4 * g + r; const size_t m = (size_t)b * SEQ + t;
        f16x8 bq[4];
#pragma unroll
        for (int ks = 0; ks < 4; ++ks) bq[ks] = *(const GAS f16x8*)((const f16*)(ws + WS_QF) + (((size_t)(m >> 3) * 4 + g) * 4 + ks) * 512 + (hh * 32 + r31) * 8);
        { float qss = 0.f;
#pragma unroll
          for (int ks = 0; ks < 4; ++ks)
#pragma unroll
              for (int j = 0; j < 8; ++j) qss += (float)bq[ks][j] * (float)bq[ks][j];
          qss = both_halves_sum(qss);
          const float qrs = (1.f / sqrtf(qss * (1.f / 64.f) + RMS_EPS)) * (0.125f * LOG2E);
#pragma unroll
          for (int ks = 0; ks < 4; ++ks)
#pragma unroll
              for (int j = 0; j < 8; ++j) bq[ks][j] = (f16)((float)bq[ks][j] * qrs); }
        long bq8[4];
#pragma unroll
        for (int ks = 0; ks < 4; ++ks) bq8[ks] = as_i64(pk_fp8((float)bq[ks][0] * 8.f, (float)bq[ks][1] * 8.f, (float)bq[ks][2] * 8.f, (float)bq[ks][3] * 8.f),
                                                        pk_fp8((float)bq[ks][4] * 8.f, (float)bq[ks][5] * 8.f, (float)bq[ks][6] * 8.f, (float)bq[ks][7] * 8.f));
        const float g_c = gates[m * 48 + head * 3 + 0], g_s = gates[m * 48 + head * 3 + 1], g_w = gates[m * 48 + head * 3 + 2];
        const float cfar = lutr[127];
        LAS float* TL = (LAS float*)(F.lds + 65536 + F.wave * 8192) + lane;
        {
            const f16* kc = (const f16*)(ws + WS_KCMP) + (size_t)bg * 128 * 64;
            const f16* vc = (const f16*)(ws + WS_VCMPT) + (size_t)bg * 64 * 128;
            f32x16 c[4];
#pragma unroll
            for (int kt = 0; kt < 4; ++kt) {
#pragma unroll
                for (int i = 0; i < 16; ++i) c[kt][i] = 0.f;
#pragma unroll
                for (int ks = 0; ks < 4; ++ks) { const f16x8 a = *(const GAS f16x8*)(kc + kt * 2048 + ks * 512 + (hh * 32 + r31) * 8); c[kt] = __builtin_amdgcn_mfma_f32_32x32x16_f16(a, bq[ks], c[kt], 0, 0, 0); }
                asm volatile("" ::: "memory");
            }
            const int relb = t - 31 - 64 * hh; float mx = -1e30f;
#pragma unroll
            for (int kt = 0; kt < 4; ++kt) { float bias[16];
#pragma unroll
                for (int i = 0; i < 16; ++i) { const int rel = relb - 16 * (kt * 32 + (i & 3) + 8 * (i >> 2)); bias[i] = lutr[med3i(rel, 0, 127)]; }
#pragma unroll
                for (int i = 0; i < 16; ++i) asm volatile("" : "+v"(bias[i]));
#pragma unroll
                for (int i = 0; i < 16; ++i) { const int rel = relb - 16 * (kt * 32 + (i & 3) + 8 * (i >> 2));
                    const float sv = rel >= 0 ? c[kt][i] + bias[i] : -2e30f; c[kt][i] = sv; mx = fmaxf(mx, sv); }
                asm volatile("" ::: "memory"); }
            mx = other_half_max(mx);
            float l = 0.f;
#pragma unroll
            for (int kt = 0; kt < 4; ++kt)
#pragma unroll
                for (int i = 0; i < 16; ++i) { const float pv = __builtin_amdgcn_exp2f(c[kt][i] - mx); c[kt][i] = pv; l += pv; }
            l = both_halves_sum(l);
            const float inv = 1.f / fmaxf(l, 1e-30f);
#pragma unroll
            for (int kt = 0; kt < 4; ++kt)
#pragma unroll
                for (int jj = 0; jj < 4; ++jj) { float own = (2.f * (c[kt][4 * jj] + c[kt][4 * jj + 1] + c[kt][4 * jj + 2]) + c[kt][4 * jj + 3]) * inv, p3 = c[kt][4 * jj + 3] * inv;
                    own += dpp_f<0xB1>(own); own += dpp_f<0x4E>(own); p3 += dpp_f<0xB1>(p3); p3 += dpp_f<0x4E>(p3);
                    if (r == 0) { const int j = kt * 8 + 2 * jj + hh; wl[512 + tok8 * 32 + j] = own; wl[768 + tok8 * 32 + j] = p3; } }
            f32x16 O0, O1;
#pragma unroll
            for (int i = 0; i < 16; ++i) { O0[i] = 0.f; O1[i] = 0.f; }
#pragma unroll
            for (int kt = 0; kt < 4; ++kt)
#pragma unroll
                for (int s2 = 0; s2 < 2; ++s2) { const f16x8 pb = pack8(c[kt], s2);
                    const f16x8 a0 = *(const GAS f16x8*)(vc + kt * 2048 + s2 * 512 + (hh * 32 + r31) * 8), a1 = *(const GAS f16x8*)(vc + kt * 2048 + (2 + s2) * 512 + (hh * 32 + r31) * 8);
                    O0 = __builtin_amdgcn_mfma_f32_32x32x16_f16(a0, pb, O0, 0, 0, 0); O1 = __builtin_amdgcn_mfma_f32_32x32x16_f16(a1, pb, O1, 0, 0, 0); asm volatile("" ::: "memory"); }
            const float sc = inv * g_c;
#pragma unroll
            for (int i = 0; i < 16; ++i) { TL[i * 64] = O0[i] * sc; TL[(16 + i) * 64] = O1[i] * sc; }
        }
        LDS_WAIT(); asm volatile("" ::: "memory");
        int lane2 = lane; asm volatile("" : "+v"(lane2));
        LAS float* OWN = wl + 512 + (lane2 >> 5) * 32 + (lane2 & 31); LAS float* P3 = OWN + 256; LAS float* VAL = OWN + 512;
#pragma unroll
        for (int pp = 0; pp < 4; ++pp) { const int tk = 2 * pp + hh, j = r31, cur = (t0 + tk) >> 6;
            const float impv = OWN[pp * 64] + (j > 0 ? P3[pp * 64 - (j > 0 ? 1 : 0)] : 0.f);
            VAL[pp * 64] = (j == 0 || j == cur || j == cur - 1) ? 1e4f : (j <= cur ? impv : -1e30f); }
        LDS_WAIT(); asm volatile("" ::: "memory");
#pragma unroll
        for (int pp = 0; pp < 4; ++pp) { const int tk = 2 * pp + hh, j = r31, cur = (t0 + tk) >> 6; const float v = VAL[pp * 64]; int cnt = 0; const LAS float* vrow = VAL + pp * 64 - j;
#pragma unroll
            for (int j2 = 0; j2 < 32; ++j2) { const float o = vrow[j2]; cnt += (o > v || (o == v && j2 < j)) ? 1 : 0; }
            const unsigned long long bm = __ballot(cnt < 8 && j <= cur);
            const unsigned mym = hh ? (unsigned)(bm >> 32) : (unsigned)bm;
            if (j == 0) SELM[tk] = mym; }
        LDS_WAIT(); asm volatile("" ::: "memory");
        const unsigned selm = SELM[tok8];
        unsigned um = 0u;
#pragma unroll
        for (int i = 0; i < 8; ++i) um |= SELM[i];
        um = (unsigned)__builtin_amdgcn_readfirstlane((int)um);
        const int kthi = (t0 + 7) >> 5;
        const unsigned long long causal = (kthi >= 63) ? ~0ull : ((1ull << (kthi + 1)) - 1ull);
        {
            unsigned long long x = um;
            x = (x | (x << 16)) & 0x0000FFFF0000FFFFull; x = (x | (x << 8)) & 0x00FF00FF00FF00FFull; x = (x | (x << 4)) & 0x0F0F0F0F0F0F0F0Full;
            x = (x | (x << 2)) & 0x3333333333333333ull; x = (x | (x << 1)) & 0x5555555555555555ull;
            const unsigned long long tm = (x | (x << 1)) & causal;
            attn_branch(ws + WS_KN + (size_t)bg * SEQ * 64, ws + WS_VT + (size_t)bg * 64 * SEQ, tm, bq8, t0, t, r31, hh, 1 << 30, selm, cfar, lutr, g_s, TL);
        }
        {
            const int lo = t0 - 511 > 0 ? (t0 - 511) >> 5 : 0;
            const unsigned long long tm = causal & ~((1ull << lo) - 1ull);
            attn_branch(ws + WS_KN + (size_t)(BATCH * 4 + bg) * SEQ * 64, ws + WS_VT + (size_t)(BATCH * 4 + bg) * 64 * SEQ, tm, bq8, t0, t, r31, hh, 512, 0xFFFFFFFFu, cfar, lutr, g_w, TL);
        }
        unsigned char* orow = ws + WS_CAT + m * D + 1024 + head * 64 + 4 * hh;
#pragma unroll
        for (int jj = 0; jj < 4; ++jj) {
            *(GAS unsigned*)(orow + 8 * jj) = pk_fp8(TL[(4 * jj) * 64] * CAT8SCALE, TL[(4 * jj + 1) * 64] * CAT8SCALE, TL[(4 * jj + 2) * 64] * CAT8SCALE, TL[(4 * jj + 3) * 64] * CAT8SCALE);
            *(GAS unsigned*)(orow + 32 + 8 * jj) = pk_fp8(TL[(16 + 4 * jj) * 64] * CAT8SCALE, TL[(16 + 4 * jj + 1) * 64] * CAT8SCALE, TL[(16 + 4 * jj + 2) * 64] * CAT8SCALE, TL[(16 + 4 * jj + 3) * 64] * CAT8SCALE); }
    }
}

__device__ __forceinline__ void cvt_row_fp6(const f32x4 (&v)[8], int row, unsigned char* dst6, float* scales, int lane, bool pairt) {
    float amax = 0.f;
#pragma unroll
    for (int c = 0; c < 8; ++c) amax = fmaxf(amax, fmaxf(fmaxf(fabsf(v[c].x), fabsf(v[c].y)), fmaxf(fabsf(v[c].z), fabsf(v[c].w))));
    amax = wave_max(amax);
    const float scale = amax > 0.f ? amax * (1.f / 7.5f) : 1.f, inv = 1.f / scale;
    f16x32 h;
#pragma unroll
    for (int c = 0; c < 8; ++c) { h[4 * c] = (f16)(v[c].x * inv); h[4 * c + 1] = (f16)(v[c].y * inv); h[4 * c + 2] = (f16)(v[c].z * inv); h[4 * c + 3] = (f16)(v[c].w * inv); }
    const u32x6 pk = __builtin_amdgcn_cvt_scalef32_pk32_fp6_f16(h, 1.0f);
    unsigned char* d = dst6 + (size_t)(lane >> 3) * SLICE6;
    *(GAS u32x4*)(d + (size_t)row * 128 + (lane & 7) * 16) = (u32x4){pk[0], pk[1], pk[2], pk[3]}; *(GAS u32x2*)(d + 2097152 + (size_t)row * 64 + (pairt ? (lane & 3) * 16 + ((lane >> 2) & 1) * 8 : (lane & 7) * 8)) = (u32x2){pk[4], pk[5]};
    if (lane == 0) scales[row] = scale;
}
__device__ __forceinline__ void cvt_table_fp6(Frame& F, const float* src, unsigned char* dst6, float* scales, const float* colw, bool pairt) {
    const int gw = F.vcu * NWAVES + F.wave, NGW = F.G * NWAVES, lane = F.lane;
    int row = gw;
    for (; row + NGW < 16384; row += 2 * NGW) {
        f32x4 va[8], vb[8];
#pragma unroll
        for (int c = 0; c < 8; ++c) { va[c] = __builtin_nontemporal_load((const GAS f32x4*)(src + (size_t)row * D + c * 256 + lane * 4)); vb[c] = __builtin_nontemporal_load((const GAS f32x4*)(src + (size_t)(row + NGW) * D + c * 256 + lane * 4)); }
        if (colw) {
#pragma unroll
            for (int c = 0; c < 8; ++c) { const f32x4 wv = *(const GAS f32x4*)(colw + c * 256 + lane * 4); va[c] = va[c] * wv; vb[c] = vb[c] * wv; } }
        cvt_row_fp6(va, row, dst6, scales, lane, pairt); cvt_row_fp6(vb, row + NGW, dst6, scales, lane, pairt);
    }
    for (; row < 16384; row += NGW) { f32x4 va[8];
#pragma unroll
        for (int c = 0; c < 8; ++c) { va[c] = *(const GAS f32x4*)(src + (size_t)row * D + c * 256 + lane * 4); if (colw) va[c] = va[c] * *(const GAS f32x4*)(colw + c * 256 + lane * 4); }
        cvt_row_fp6(va, row, dst6, scales, lane, pairt); }
}
__device__ __forceinline__ void p7_tables(Frame& F) {
    cvt_table_fp6(F, F.in[I_PU], F.ws + WS_U6, (float*)(F.ws + WS_SU), F.in[I_FFNNW], true);
    cvt_table_fp6(F, F.in[I_PV], F.ws + WS_V6, (float*)(F.ws + WS_SV), nullptr, false);
}

__device__ __forceinline__ void bitonic_sort16_desc(float (&a)[16]) {
#pragma unroll
    for (int k = 2; k <= 16; k <<= 1)
#pragma unroll
        for (int j = k >> 1; j > 0; j >>= 1)
#pragma unroll
            for (int i = 0; i < 16; ++i) { const int l = i ^ j; if (l > i) { const float hi = fmaxf(a[i], a[l]), lo = fminf(a[i], a[l]); if ((i & k) == 0) { a[i] = hi; a[l] = lo; } else { a[i] = lo; a[l] = hi; } } }
}
__device__ __forceinline__ void bitonic_merge16_desc(float (&a)[16]) {
#pragma unroll
    for (int dist = 8; dist >= 1; dist >>= 1)
#pragma unroll
        for (int i = 0; i < 16; ++i) if ((i & dist) == 0) { const float hi = fmaxf(a[i], a[i + dist]), lo = fminf(a[i], a[i + dist]); a[i] = hi; a[i + dist] = lo; }
}
#define INS16(top, v) do { _Pragma("unroll") for (int _j = 0; _j < 16; ++_j) { const float _h = fmaxf(top[_j], v); v = fminf(top[_j], v); top[_j] = _h; } } while (0)
#define INS16P(tv, ti, v, i) do { _Pragma("unroll") for (int _j = 0; _j < 16; ++_j) { const bool _c = v > tv[_j]; const float _nv = _c ? tv[_j] : v; const unsigned _ni = _c ? ti[_j] : i; \
        tv[_j] = _c ? v : tv[_j]; ti[_j] = _c ? i : ti[_j]; v = _nv; i = _ni; } } while (0)
typedef unsigned v4u_t __attribute__((__vector_size__(16)));
typedef unsigned v2u_t __attribute__((__vector_size__(8)));
__device__ __forceinline__ void p9a_topk(Frame& F) {
    unsigned char* ws = F.ws;
    const f16* QP = (const f16*)(ws + WS_QP); const f16* KEYS = (const f16*)(ws + WS_KEYS);
    unsigned* LIDX = (unsigned*)(ws + WS_LIDX); float* LG = (float*)(ws + WS_LG);
    const int lane = F.lane, r31 = lane & 31, hh = lane >> 5;
    const float NINF = -__builtin_inff();
    for (int unit = F.vcu; unit < M / 32; unit += F.G) {
        const int m0 = unit * 32;
        {
            const int h = F.wave;
            float sl[2][16];
            f16x8 bq[8], ka[8];
#pragma unroll
            for (int ks = 0; ks < 8; ++ks) { bq[ks] = *(const GAS f16x8*)(QP + ((size_t)((unit * 8 + h) * 2 + 0) * 8 + ks) * 512 + (hh * 32 + r31) * 8);
                ka[ks] = *(const GAS f16x8*)(KEYS + ((size_t)((h * 2) * 128 + r31)) * 128 + hh * 8 + ks * 16); }
            float top[16];
#pragma unroll
            for (int st = 0; st < 8; ++st) { const int p = st >> 2, kt = st & 3;
                if (kt == 0) {
#pragma unroll
                    for (int j = 0; j < 16; ++j) top[j] = NINF; }
                f32x16 c;
#pragma unroll
                for (int i = 0; i < 16; ++i) c[i] = 0.f;
#pragma unroll
                for (int ks = 0; ks < 8; ++ks) c = __builtin_amdgcn_mfma_f32_32x32x16_f16(ka[ks], bq[ks], c, 0, 0, 0);
                if (st + 1 < 8) { const int pn = (st + 1) >> 2, ktn = (st + 1) & 3;
#pragma unroll
                    for (int ks = 0; ks < 8; ++ks) ka[ks] = *(const GAS f16x8*)(KEYS + ((size_t)((h * 2 + pn) * 128 + ktn * 32 + r31)) * 128 + hh * 8 + ks * 16);
                    if (st == 3) {
#pragma unroll
                        for (int ks = 0; ks < 8; ++ks) bq[ks] = *(const GAS f16x8*)(QP + ((size_t)((unit * 8 + h) * 2 + 1) * 8 + ks) * 512 + (hh * 32 + r31) * 8); } }
                const unsigned k4 = (unsigned)(kt * 32 + 4 * hh);
                float nv[16];
#pragma unroll
                for (int reg = 0; reg < 16; ++reg) { const unsigned key = k4 + (unsigned)((reg & 3) + 8 * (reg >> 2)); nv[reg] = __uint_as_float((__float_as_uint(c[reg]) & ~127u) | key); }
                bitonic_sort16_desc(nv);
#pragma unroll
                for (int j = 0; j < 16; ++j) top[j] = fmaxf(top[j], nv[15 - j]);
                bitonic_merge16_desc(top);
                if (kt == 3) {
                    float cm[16];
#pragma unroll
                    for (int j = 0; j < 16; ++j) cm[j] = fmaxf(top[j], __uint_as_float(other32u(__float_as_uint(top[15 - j]), hh != 0)));
                    bitonic_merge16_desc(cm);
#pragma unroll
                    for (int j = 0; j < 16; ++j) sl[p][j] = cm[j]; }
            }
            float vx[16], vy[16]; unsigned ix[16], iy[16];
#pragma unroll
            for (int j = 0; j < 16; ++j) { const unsigned bx = __float_as_uint(hh ? sl[1][j] : sl[0][j]), by = __float_as_uint(hh ? sl[0][j] : sl[1][j]);
                vx[j] = __uint_as_float(bx & ~127u); vy[j] = __uint_as_float(by & ~127u); ix[j] = (bx & 127u) * (hh ? 1u : 128u); iy[j] = (by & 127u) * (hh ? 128u : 1u); }
            float tv[16]; unsigned ti[16];
#pragma unroll
            for (int j = 0; j < 16; ++j) { const int jb = j + 1 < 16 ? j + 1 : 15;
                const float v0 = vx[0] + vy[j], v1 = (j < 15) ? vx[0] + vy[jb] : NINF; const unsigned i0 = ix[0] + iy[j], i1 = ix[0] + iy[jb];
                tv[j] = hh ? v1 : v0; ti[j] = hh ? i1 : i0; }
#pragma unroll
            for (int a = 1; a < 4; ++a) { const int bmax = (a == 1) ? 7 : (a == 2 ? 4 : 3);
#pragma unroll
                for (int b = a; b <= bmax; ++b) { float v = vx[a] + vy[b]; if (a == b) v = hh ? NINF : v; unsigned i = ix[a] + iy[b]; INS16P(tv, ti, v, i); } }
            float mv[16]; unsigned mi[16];
#pragma unroll
            for (int j = 0; j < 16; ++j) { const float pv = __uint_as_float(other32u(__float_as_uint(tv[15 - j]), hh != 0)); const unsigned pi = other32u(ti[15 - j], hh != 0); const bool c = pv > tv[j]; mv[j] = c ? pv : tv[j]; mi[j] = c ? pi : ti[j]; }
            float mx = mv[0];
#pragma unroll
            for (int j = 1; j < 16; ++j) mx = fmaxf(mx, mv[j]);
            float sum = 0.f;
#pragma unroll
            for (int j = 0; j < 16; ++j) { mv[j] = __builtin_amdgcn_exp2f((mv[j] - mx) * LOG2E); sum += mv[j]; }
            const float inv = 1.f / sum;
#pragma unroll
            for (int j = 0; j < 8; ++j) { { const int e_ = h * 16 + hh * 8 + j, pos_ = (e_ & 63) * 2 + (e_ >> 6); LIDX[(size_t)(m0 + r31) * 128 + pos_] = mi[j]; LG[(size_t)(m0 + r31) * 128 + pos_] = mv[j] * inv; } }
        }
    }
}
struct Seg6 { v4u_t a; v2u_t b; };
__device__ __forceinline__ f16x32 seg6_decode(const Seg6& r) { const u32x6 p = {r.a[0], r.a[1], r.a[2], r.a[3], r.b[0], r.b[1]}; return __builtin_amdgcn_cvt_scalef32_pk32_f16_fp6(p, 1.0f); }
__device__ __forceinline__ f16x32 seg6_dec2(const v4u_t& a, const v2u_t& b) { const u32x6 p = {a[0], a[1], a[2], a[3], b[0], b[1]}; return __builtin_amdgcn_cvt_scalef32_pk32_f16_fp6(p, 1.0f); }
#define SEG_DECL(P) v4u_t P##a0, P##a1, P##a2, P##a3, P##a4, P##a5, P##a6, P##a7; v2u_t P##b0, P##b1, P##b2, P##b3, P##b4, P##b5, P##b6, P##b7
#define SEG_L1(P, G, idxv) do { const int e_ = __shfl(idxv, 8 * G + sub); P##a##G = __builtin_amdgcn_raw_buffer_load_b128(rs, e_ * 128 + ch * 16, 0, 0); P##b##G = __builtin_amdgcn_raw_buffer_load_b64(rs, 2097152 + e_ * 64 + ch * 8, 0, 0); } while (0)
#define SEG_LOAD(P, idxv) do { SEG_L1(P, 0, idxv); SEG_L1(P, 1, idxv); SEG_L1(P, 2, idxv); SEG_L1(P, 3, idxv); SEG_L1(P, 4, idxv); SEG_L1(P, 5, idxv); SEG_L1(P, 6, idxv); SEG_L1(P, 7, idxv); } while (0)
__device__ __forceinline__ float u_one(const v4u_t& a, const v2u_t& b, const f16x2 (&xp)[16]) {
    const f16x32 hv = seg6_dec2(a, b); float sdot = 0.f;
#pragma unroll
    for (int k = 0; k < 16; ++k) { f16x2 hp; hp.x = hv[2 * k]; hp.y = hv[2 * k + 1]; sdot = __builtin_amdgcn_fdot2(hp, xp[k], sdot, false); }
    return sum8(sdot);
}
#define SEG_LE(P, G, ev) do { const int e_ = (ev); P##a##G = __builtin_amdgcn_raw_buffer_load_b128(rs, e_ * 128 + ch * 16, 0, 0); P##b##G = __builtin_amdgcn_raw_buffer_load_b64(rs, 2097152 + e_ * 64 + ch * 8, 0, 0); } while (0)
#define EN_GATHER(en, iA, iB) do { _Pragma("unroll") for (int g_ = 0; g_ < 8; ++g_) { en[g_] = __shfl(iA, 8 * g_ + sub); en[8 + g_] = __shfl(iB, 8 * g_ + sub); } } while (0)
#define U_ROLL1(P, G, res, eo) do { const float d_ = u_one(P##a##G, P##b##G, xp); res = (ch == G) ? d_ : res; SEG_LE(P, G, en[(eo) + G]); } while (0)
#define U_ROLL(P, res, idxn) do { U_ROLL1(P, 0, res, idxn); U_ROLL1(P, 1, res, idxn); U_ROLL1(P, 2, res, idxn); U_ROLL1(P, 3, res, idxn); U_ROLL1(P, 4, res, idxn); U_ROLL1(P, 5, res, idxn); U_ROLL1(P, 6, res, idxn); U_ROLL1(P, 7, res, idxn); } while (0)
#define V_ROLL1(P, G, hwv, eo) do { v_one(P##a##G, P##b##G, acc, hq[(eo) + G]); SEG_LE(P, G, en[(eo) + G]); } while (0)
#define V_ROLL(P, hwv, idxn) do { V_ROLL1(P, 0, hwv, idxn); V_ROLL1(P, 1, hwv, idxn); V_ROLL1(P, 2, hwv, idxn); V_ROLL1(P, 3, hwv, idxn); V_ROLL1(P, 4, hwv, idxn); V_ROLL1(P, 5, hwv, idxn); V_ROLL1(P, 6, hwv, idxn); V_ROLL1(P, 7, hwv, idxn); } while (0)
#define FMIXV_LO(a, h, w) asm("v_fma_mix_f32 %0, %1, %2, %0 op_sel_hi:[1,0,0]" : "+v"(a) : "v"(h), "v"(w))
#define FMIXV_HI(a, h, w) asm("v_fma_mix_f32 %0, %1, %2, %0 op_sel:[1,0,0] op_sel_hi:[1,0,0]" : "+v"(a) : "v"(h), "v"(w))
__device__ __forceinline__ void v_one(const v4u_t& a, const v2u_t& b, f16x2 (&acc)[16], f16x2 wq) {
    const f16x32 hv = seg6_dec2(a, b);
#pragma unroll
    for (int k = 0; k < 16; ++k) { f16x2 hp; hp.x = hv[2 * k]; hp.y = hv[2 * k + 1]; acc[k] = __builtin_elementwise_fma(hp, wq, acc[k]); }
}
#define V_HALF(P, hwv) do { v_one(P##a0, P##b0, acc, hwv, sub); v_one(P##a1, P##b1, acc, hwv, 8 + sub); v_one(P##a2, P##b2, acc, hwv, 16 + sub); v_one(P##a3, P##b3, acc, hwv, 24 + sub); \
        v_one(P##a4, P##b4, acc, hwv, 32 + sub); v_one(P##a5, P##b5, acc, hwv, 40 + sub); v_one(P##a6, P##b6, acc, hwv, 48 + sub); v_one(P##a7, P##b7, acc, hwv, 56 + sub); } while (0)
#define WSEG_DECL(P) v4u_t P##h0, P##h1, P##h2, P##h3, P##g0, P##g1, P##g2, P##g3, P##t0, P##t1, P##t2, P##t3
#define WSEG_LE(P, G, ev) do { const int e_ = (ev); P##h##G = __builtin_amdgcn_raw_buffer_load_b128(rs, e_ * 128 + q4 * 16, 0, 0); P##g##G = __builtin_amdgcn_raw_buffer_load_b128(rs, e_ * 128 + 64 + q4 * 16, 0, 0); \
        P##t##G = __builtin_amdgcn_raw_buffer_load_b128(rs, 2097152 + e_ * 64 + q4 * 16, 0, 0); } while (0)
#define WSEG_LOAD(P, idxv) do { WSEG_LE(P, 0, __shfl(idxv, sub16)); WSEG_LE(P, 1, __shfl(idxv, 16 + sub16)); WSEG_LE(P, 2, __shfl(idxv, 32 + sub16)); WSEG_LE(P, 3, __shfl(idxv, 48 + sub16)); } while (0)
#define WEN_GATHER(en, iA, iB) do { _Pragma("unroll") for (int g_ = 0; g_ < 4; ++g_) { en[g_] = __shfl(iA, 16 * g_ + sub16); en[4 + g_] = __shfl(iB, 16 * g_ + sub16); } } while (0)
__device__ __forceinline__ float u_one2(const v4u_t& h, const v4u_t& g, const v4u_t& t, const f16x2 (&xp)[32]) {
    const f16x32 h0 = seg6_dec2(h, (v2u_t){t[0], t[1]}), h1 = seg6_dec2(g, (v2u_t){t[2], t[3]}); float sdot = 0.f;
#pragma unroll
    for (int k = 0; k < 16; ++k) { f16x2 hp; hp.x = h0[2 * k]; hp.y = h0[2 * k + 1]; sdot = __builtin_amdgcn_fdot2(hp, xp[k], sdot, false); }
#pragma unroll
    for (int k = 0; k < 16; ++k) { f16x2 hp; hp.x = h1[2 * k]; hp.y = h1[2 * k + 1]; sdot = __builtin_amdgcn_fdot2(hp, xp[16 + k], sdot, false); }
    sdot += dpp_f<0xB1>(sdot); sdot += dpp_f<0x4E>(sdot);
    return sdot;
}
#define WU_ROLL1(P, G, res, eo) do { const float d_ = u_one2(P##h##G, P##g##G, P##t##G, xp); res = (q4 == G) ? d_ : res; WSEG_LE(P, G, en[(eo) + G]); __builtin_amdgcn_sched_barrier(0); } while (0)
#define WU_ROLL(P, res, idxn) do { WU_ROLL1(P, 0, res, idxn); WU_ROLL1(P, 1, res, idxn); WU_ROLL1(P, 2, res, idxn); WU_ROLL1(P, 3, res, idxn); } while (0)
__device__ __forceinline__ void p9b_upass(Frame& F, bool probe_slice0) {
    unsigned char* ws = F.ws;
    const int x = blockIdx.x & 7, rank = blockIdx.x >> 3, cnt = (F.G - x + 7) >> 3;
    const int lane = F.lane, sub16 = lane >> 2, q4 = lane & 3;
    const __amdgpu_buffer_rsrc_t rs = __builtin_amdgcn_make_buffer_rsrc((void*)(ws + WS_U6 + (size_t)(probe_slice0 ? 0 : x) * SLICE6), 0, (int)SLICE6, 0x00020000);
    const f16* XN = (const f16*)(ws + WS_XR) + x * 32 + (lane >> 3) * 256 + (lane & 7) * 4;
    const u32x2* LI2 = (const u32x2*)(ws + WS_LIDX); LAS unsigned char* xl = F.lds + F.wave * 512;
    const int tstep = cnt * NWAVES; int t = rank * NWAVES + F.wave;
    if (t >= M) return;
    int cA, cB, nA, nB; { const u32x2 c2 = LI2[(size_t)t * 64 + lane]; cA = (int)c2.x; cB = (int)c2.y; }
    const int t1c = (t + tstep < M) ? t + tstep : t;
    { const u32x2 n2 = LI2[(size_t)t1c * 64 + lane]; nA = (int)n2.x; nB = (int)n2.y; }
    u32x2 xcur = *(const GAS u32x2*)(XN + (size_t)t * D);
    f16x2 xp[32];
    WSEG_DECL(bA); WSEG_DECL(bB);
    { const int li_ = cA; WSEG_LOAD(bA, li_); } { const int li_ = cB; WSEG_LOAD(bB, li_); }
#pragma unroll 1
    for (;;) {
        const int tn = t + tstep, tnn = tn + tstep; const bool hn = tn < M, hnn = tnn < M;
        const int tnc = hn ? tn : t, tnnc = hnn ? tnn : t;
        const u32x2 m2 = LI2[(size_t)tnnc * 64 + lane]; const int mA = (int)m2.x, mB = (int)m2.y;
        const u32x2 xnext = *(const GAS u32x2*)(XN + (size_t)tnc * D);
        *(LAS u32x2*)(xl + ((lane & 7) * 8 + (lane >> 3)) * 8) = xcur;
        LDS_WAIT(); asm volatile("" ::: "memory");
#pragma unroll
        for (int hc = 0; hc < 2; ++hc)
#pragma unroll
            for (int q = 0; q < 4; ++q) { const u32x4 tv = *(const LAS u32x4*)(xl + (q4 + 4 * hc) * 64 + q * 16); xp[16 * hc + 4 * q] = ash2(tv.x); xp[16 * hc + 4 * q + 1] = ash2(tv.y); xp[16 * hc + 4 * q + 2] = ash2(tv.z); xp[16 * hc + 4 * q + 3] = ash2(tv.w); }
        LDS_WAIT(); asm volatile("" ::: "memory");
        { const int lA_ = hn ? nA : cA, lB_ = hn ? nB : cB; int en[8]; WEN_GATHER(en, lA_, lB_);
          float rA = 0.f, rB = 0.f; WU_ROLL(bA, rA, 0); WU_ROLL(bB, rB, 4);
          ((GAS unsigned*)(ws + WS_PD))[((size_t)t * 8 + x) * 64 + 16 * q4 + sub16] = pk_f16(rA, rB); }
        if (!hn) break;
        xcur = xnext;
        cA = nA; cB = nB; nA = mA; nB = mB; t = tn;
    }
}
__device__ __forceinline__ void p9h_weights(Frame& F) {
    unsigned char* ws = F.ws;
    const unsigned* LIDX = (const unsigned*)(ws + WS_LIDX); const float* LG = (const float*)(ws + WS_LG); const float* PD = (const float*)(ws + WS_PD);
    const float* SU = (const float*)(ws + WS_SU); const float* SV = (const float*)(ws + WS_SV); float* HW = (float*)(ws + WS_HW);
    const int gw = F.vcu * NWAVES + F.wave, NGW = F.G * NWAVES, lane = F.lane;
#pragma unroll 1
    for (int t0 = gw; t0 < M; t0 += 2 * NGW) {
        const int t1 = t0 + NGW < M ? t0 + NGW : t0;
        int iA[2], iB[2]; float pa[2][8], pb[2][8], lgA[2], lgB[2], s1[2];
#pragma unroll
        for (int q = 0; q < 2; ++q) { const int t = q ? t1 : t0; { const u32x2 i2 = ((const u32x2*)LIDX)[(size_t)t * 64 + lane]; iA[q] = (int)i2.x; iB[q] = (int)i2.y; }
#pragma unroll
            for (int xs = 0; xs < 8; ++xs) { const f16x2 p2 = ash2(((const GAS unsigned*)PD)[((size_t)t * 8 + xs) * 64 + lane]); pa[q][xs] = (float)p2.x; pb[q][xs] = (float)p2.y; }
            { const f32x2 g2 = ((const f32x2*)LG)[(size_t)t * 64 + lane]; lgA[q] = g2.x; lgB[q] = g2.y; } s1[q] = ((const float*)(ws + WS_SS1))[t]; }
#pragma unroll
        for (int q = 0; q < 2; ++q) { const int t = q ? t1 : t0; float zA = 0.f, zB = 0.f;
#pragma unroll
            for (int xs = 0; xs < 8; ++xs) { zA += pa[q][xs]; zB += pb[q][xs]; }
            const float rs1 = 1.f / sqrtf(s1[q] * (1.f / D) + RMS_EPS);
            ((u32x2*)HW)[(size_t)t * 64 + lane] = (u32x2){(unsigned)iA[q] | ((unsigned)iB[q] << 16), pk_f16(pg8::gelu1(zA * rs1 * SU[iA[q]]) * lgA[q] * SV[iA[q]] * 64.f, pg8::gelu1(zB * rs1 * SU[iB[q]]) * lgB[q] * SV[iB[q]] * 64.f)}; }
    }
}
__device__ __forceinline__ void p9c_vpass(Frame& F) {
    unsigned char* ws = F.ws;
    const int x = blockIdx.x & 7, rank = blockIdx.x >> 3, cnt = (F.G - x + 7) >> 3;
    const int lane = F.lane, sub = lane >> 3, ch = lane & 7;
    const __amdgpu_buffer_rsrc_t rs = __builtin_amdgcn_make_buffer_rsrc((void*)(ws + WS_V6 + (size_t)x * SLICE6), 0, (int)SLICE6, 0x00020000);
    const u32x2* LI2 = (const u32x2*)(ws + WS_LIDX);
    f16* XR = (f16*)(ws + WS_XR); float* SS2 = (float*)(ws + WS_SS2);
    const bool b3 = (lane & 8) != 0, b4 = (lane & 16) != 0, b5 = (lane & 32) != 0;
    const int col = ((b3 ? 4 : 0) + (b4 ? 2 : 0) + (b5 ? 1 : 0)) * 256 + x * 32 + ch * 4;
    const int tstep = cnt * NWAVES; int t = rank * NWAVES + F.wave;
    if (t >= M) return;
    const u32x2* VR = (const u32x2*)(ws + WS_HW);
    int cA, cB, nA, nB; unsigned hwC, hwN;
    { const u32x2 c2 = VR[(size_t)t * 64 + lane]; cA = (int)(c2.x & 0xFFFFu); cB = (int)(c2.x >> 16); hwC = c2.y; }
    const int t1c = (t + tstep < M) ? t + tstep : t;
    { const u32x2 n2 = VR[(size_t)t1c * 64 + lane]; nA = (int)(n2.x & 0xFFFFu); nB = (int)(n2.x >> 16); hwN = n2.y; }
    SEG_DECL(bA); SEG_DECL(bB);
    { const int li_ = cA; SEG_LOAD(bA, li_); } { const int li_ = cB; SEG_LOAD(bB, li_); }
#pragma unroll 1
    for (;;) {
        const int tn = t + tstep, tnn = tn + tstep; const bool hn = tn < M, hnn = tnn < M;
        const int tnc = hn ? tn : t, tnnc = hnn ? tnn : t;
        const u32x2 m2 = VR[(size_t)tnnc * 64 + lane]; const int mA = (int)(m2.x & 0xFFFFu), mB = (int)(m2.x >> 16); const unsigned hwM = m2.y;
        f16* orow = XR + (size_t)t * D + col; const u32x2 x1r = *(const GAS u32x2*)orow;
        f16x2 acc[16];
#pragma unroll
        for (int i = 0; i < 16; ++i) { acc[i].x = (f16)0.f; acc[i].y = (f16)0.f; }
        { const int lA_ = hn ? nA : cA, lB_ = hn ? nB : cB; int en[16]; EN_GATHER(en, lA_, lB_); f16x2 hq[16];
#pragma unroll
          for (int g_ = 0; g_ < 8; ++g_) { const f16x2 h2 = ash2((unsigned)__shfl((int)hwC, 8 * g_ + sub));
              hq[g_].x = h2.x; hq[g_].y = h2.x; hq[8 + g_].x = h2.y; hq[8 + g_].y = h2.y; }
          V_ROLL(bA, hwC, 0); V_ROLL(bB, hwC, 8); }
        f16x2 q8[8];
#pragma unroll
        for (int i = 0; i < 8; ++i) { const f16x2 keep = b3 ? acc[8 + i] : acc[i], send = b3 ? acc[i] : acc[8 + i]; q8[i] = keep + ash2(other8u(__builtin_bit_cast(unsigned, send))); }
        f16x2 q4[4];
#pragma unroll
        for (int i = 0; i < 4; ++i) { const f16x2 keep = b4 ? q8[4 + i] : q8[i], send = b4 ? q8[i] : q8[4 + i]; q4[i] = keep + ash2(other16u(__builtin_bit_cast(unsigned, send), b4)); }
        float r4[4];
        { const f16x2 k0 = b5 ? q4[2] : q4[0], k1 = b5 ? q4[3] : q4[1], s0 = b5 ? q4[0] : q4[2], s1 = b5 ? q4[1] : q4[3];
          const f16x2 p0 = ash2(other32u(__builtin_bit_cast(unsigned, s0), b5)), p1 = ash2(other32u(__builtin_bit_cast(unsigned, s1), b5));
          r4[0] = ((float)k0.x + (float)p0.x) * (1.f / 64.f); r4[1] = ((float)k0.y + (float)p0.y) * (1.f / 64.f); r4[2] = ((float)k1.x + (float)p1.x) * (1.f / 64.f); r4[3] = ((float)k1.y + (float)p1.y) * (1.f / 64.f); }
        const f16x2 x1a = ash2(x1r.x), x1b = ash2(x1r.y);
        const f32x4 x2 = {(float)x1a.x + r4[0], (float)x1a.y + r4[1], (float)x1b.x + r4[2], (float)x1b.y + r4[3]};
        { u32x2 o2; o2.x = pk_f16(x2.x, x2.y); o2.y = pk_f16(x2.z, x2.w); *(GAS u32x2*)orow = o2; }
        *(GAS unsigned*)(ws + WS_X8 + (size_t)t * D + col) = pk_fp8(x2.x, x2.y, x2.z, x2.w);
        const float ss = wave_sum((x2.x * x2.x + x2.y * x2.y) + (x2.z * x2.z + x2.w * x2.w));
        if (lane == 0) atomicAdd(SS2 + t, ss);
        if (!hn) break;
        cA = nA; cB = nB; nA = mA; nB = mB; t = tn; hwC = hwN; hwN = hwM;
    }
}
#undef FMIXV_LO
#undef FMIXV_HI

constexpr int NPH = 13;
struct Args { const float* in[26]; float* out; unsigned char* ws; int ph_lo, ph_hi; int rep[16]; };
__global__ void __launch_bounds__(NWAVES * 64, 2) fwd_kernel(Args args) {
    extern __shared__ __attribute__((aligned(16))) unsigned char lds[];
    Frame F;
    F.lds = (LAS unsigned char*)lds;
    F.MISC = (volatile LAS unsigned*)(F.lds + MISC_OFF);
    F.tid = threadIdx.x; F.lane = F.tid & 63; F.wave = __builtin_amdgcn_readfirstlane(F.tid >> 6);
#define PHASE_LANES() do { int t_ = threadIdx.x; asm volatile("" : "+v"(t_)); F.tid = t_; F.lane = t_ & 63; } while (0)
    F.G = gridDim.x; { const int bx = blockIdx.x; F.vcu = (F.G % 8 == 0) ? (bx % 8) * (F.G / 8) + bx / 8 : bx; }
#pragma unroll
    for (int i = 0; i < 26; ++i) F.in[i] = args.in[i];
    F.out = args.out; F.ws = args.ws;
    unsigned char* ws = args.ws;
    gu32* ctl = (gu32*)(ws + WS_CTL);
    for (int u = F.tid; u < (LDS_BYTES - LDSCTL_OFF) / 4; u += NWAVES * 64) ((LAS unsigned*)(F.lds + LDSCTL_OFF))[u] = 0u;
    __syncthreads();
    XcdBarrier bar; bar.bar = g_xbar; bar.x = (F.G % 8 == 0) ? (unsigned)(blockIdx.x & 7) : 0u; bar.st = F.MISC + 8;
    if (MK_ONE_LAUNCH && threadIdx.x == 0) { F.MISC[8] = (unsigned)((F.G % 8 == 0) ? F.G / 8 : F.G); F.MISC[9] = (F.G % 8 == 0) ? 8u : 1u; }
    (void)ctl;
#define GRID_BAR() do { if (MK_ONE_LAUNCH) xcd_barrier(bar); } while (0)
    const int lo = args.ph_lo, hi = args.ph_hi;
#define IN(k) (lo <= (k) && (k) < hi)
#define BOTH(k) (IN(k) && IN((k) + 1))

    if (IN(0)) { PHASE_LANES(); for (int rp = 0; rp < args.rep[0]; ++rp) p0_prologue(F); if (BOTH(0)) GRID_BAR(); }

    if (IN(1)) {
        { pg8::Gemm g{(const f16*)(ws + WS_XR), (const f16*)(ws + WS_WIN), M, NINP, D, D, D, 0, 1 << 30, 0};
          pg8::P1Order S{0, F.G, (int)blockIdx.x};
          pg8::EpiF16Row E{(f16*)(ws + WS_Y), NINP, (const float*)(ws + WS_SS0), 1.f, false, nullptr};
          pg8::gemm_phase<pg8::EpiF16Row, pg8::P1Order>(F.lds, g, S, E); }
        { pg8::EpiP1F8 E{(f16*)(ws + WS_Y), (const float*)(ws + WS_SS0), ws + WS_KN, ws + WS_VT, F.in[I_KNW], F.in[I_QNW], 0, 1.f / W8SCALE, (float*)(ws + WS_GATES), (f16*)(ws + WS_QF)};
#pragma unroll 1
          for (int ty = 0; ty < 2; ++ty) {
              pg8::Gemm g{ty ? ws + WS_WIN8 : ws + WS_X8, ty ? ws + WS_X8 : ws + WS_WIN8, M, NINP, D, D, D, 0, 1 << 30, 0, 0, 1};
              pg8::P1Order S{1 + ty, F.G, (int)blockIdx.x}; E.ty = ty;
              pg8::gemm_phase<pg8::EpiP1F8, pg8::P1Order, true>(F.lds, g, S, E); } }
        if (F.G == 256) { PHASE_LANES(); p0_late(F, (int)blockIdx.x * NWAVES + F.wave, 256 * NWAVES); }
        if (BOTH(1)) GRID_BAR();
    }

    if (IN(2) && F.G != 256) { PHASE_LANES(); p2_post(F); if (BOTH(2)) GRID_BAR(); }

    if (IN(3)) {
        { pg8::Gemm g{(const f16*)(ws + WS_FLATA), (const f16*)(ws + WS_W1C), 8192, 1024, 512, D, D, 512, 16, (size_t)256 * D * 2, 512};
          pg8::StaticOrder S; S.init(8192, 1024, F.G, (int)blockIdx.x);
          pg8::EpiF16<0> E{(f16*)(ws + WS_HP), 1024, nullptr, 1 << 30, 0};
          if (F.G == 256) { g.A = ws + WS_Y; pg8::gemm_phase<pg8::EpiF16<0>, pg8::StaticOrder, false, pg8::CmpGather>(F.lds, g, S, E); }
          else pg8::gemm_phase(F.lds, g, S, E); }
        { pg8::Gemm g{(const f16*)(ws + WS_MIXED), (const f16*)(ws + WS_POOLT), M, 1024, 256, 1024, 256, 256, 1 << 30, 0};
          pg8::PoolOrder S{F.G == 256 ? (int)blockIdx.x - 128 : (int)blockIdx.x, F.G == 256 ? 128 : F.G};
          if (S.w >= 0) { int t_ = threadIdx.x; asm volatile("" : "+v"(t_));
#pragma unroll 1
              for (int pair = S.w; pair < 128; pair += S.Gp) p3_pool_mix(ws, pair, t_);
              asm volatile("s_waitcnt vmcnt(0)" ::: "memory"); __syncthreads(); }
          pg8::EpiF8 E{ws + WS_CAT, D, CAT8SCALE};
          pg8::gemm_phase(F.lds, g, S, E); }
        if (BOTH(3)) GRID_BAR();
    }

    if (IN(4)) { PHASE_LANES(); p4_compress2(F); if (BOTH(4)) GRID_BAR(); }

    if (IN(5)) {
#pragma unroll 1
        for (int step = 0; step < 2; ++step) { PHASE_LANES(); if ((step == 0) == (F.wave < 4)) p0_deferred(F); else for (int rp = 0; rp < args.rep[5]; ++rp) p5_attention(F); }
        if (BOTH(5)) GRID_BAR(); }

    if (IN(6)) {
        pg8::Gemm g{ws + WS_CAT, ws + WS_WOUT, M, D, D, D, D, 0, 1 << 30, 0, 0, 1};
        pg8::StaticOrder S; S.init(M, D, F.G, (int)blockIdx.x);
        pg8::EpiRes16 E{(f16*)(ws + WS_XR), (float*)(ws + WS_SS1), 1.f / (W8SCALE * CAT8SCALE)};
        pg8::gemm_phase<pg8::EpiRes16, pg8::StaticOrder, true>(F.lds, g, S, E);
        if (BOTH(6)) GRID_BAR();
    }

    if (IN(7)) {
        { pg8::Gemm g{(const f16*)(ws + WS_XR), (const f16*)(ws + WS_WQ), M, D, D, D, D, 0, 1 << 30, 0};
          pg8::StaticOrder S; S.init(M, D, F.G, (int)blockIdx.x);
          pg8::EpiF16Row E{(f16*)(ws + WS_QP), D, (const float*)(ws + WS_SS1), 1.f, true};
          pg8::gemm_phase(F.lds, g, S, E); }
        { pg8::Gemm g{(const f16*)(ws + WS_P16), (const f16*)(ws + WS_WPJ), M, D, 256, 256, 256, 0, 1 << 30, 0};
          pg8::StaticOrder S; S.init(M, D, F.G, (int)blockIdx.x);
          pg8::EpiF16<0> E{(f16*)(ws + WS_PJ), D, nullptr, 1 << 30, 0};
          pg8::gemm_phase(F.lds, g, S, E); }
        if (BOTH(7)) GRID_BAR();
    }

    if (IN(8)) { PHASE_LANES();
#pragma unroll 1
        for (int step = 0; step < 2; ++step) { PHASE_LANES(); if ((step == 0) == (F.wave < 4)) p7_tables(F); else p9a_topk(F); }
        if (BOTH(8)) GRID_BAR(); }
    if (IN(9)) { PHASE_LANES(); if (PROBE_DUPU) p9b_upass(F, false); p9b_upass(F, false); if (BOTH(9)) GRID_BAR(); }
    if (IN(10)) { PHASE_LANES(); p9h_weights(F); if (BOTH(10)) GRID_BAR(); }
    if (IN(11)) { PHASE_LANES(); p9c_vpass(F); if (BOTH(11)) GRID_BAR(); }

    if (IN(12)) {
        pg8::Gemm g{ws + WS_X8, ws + WS_WG, M, D, D, D, D, 0, 1 << 30, 0, 0, 1};
        pg8::StaticOrder S; S.init(M, D, F.G, (int)blockIdx.x);
        pg8::EpiFinal E{(const f16*)(ws + WS_XR), (const f16*)(ws + WS_PJ), F.out, (const float*)(ws + WS_SS2), 1.f / W8SCALE};
        pg8::gemm_phase<pg8::EpiFinal, pg8::StaticOrder, true>(F.lds, g, S, E);
    }
#undef IN
#undef BOTH
}

extern "C" void kernel_launch(void* const* d_in, const int* in_sizes, int n_in, void* d_out, int out_size, void* d_ws, size_t ws_size, hipStream_t stream) {
    static int grid = 0;
    if (grid == 0) {
        if (n_in != 26 || out_size != M * D || ws_size < WS_END) { fprintf(stderr, "kernel_launch: unexpected sizes n_in %d out %d ws %zu\n", n_in, out_size, ws_size); grid = -1; return; }
        int dev = 0, cus = 0, per_cu = 0;
        if (hipGetDevice(&dev) != hipSuccess || hipDeviceGetAttribute(&cus, hipDeviceAttributeMultiprocessorCount, dev) != hipSuccess) { grid = -1; return; }
        if (hipFuncSetAttribute((const void*)fwd_kernel, hipFuncAttributeMaxDynamicSharedMemorySize, LDS_BYTES) != hipSuccess) { fprintf(stderr, "kernel_launch: hipFuncSetAttribute failed\n"); grid = -1; return; }
        if (hipOccupancyMaxActiveBlocksPerMultiprocessor(&per_cu, (const void*)fwd_kernel, NWAVES * 64, LDS_BYTES) != hipSuccess || per_cu < 1)
            fprintf(stderr, "kernel_launch: occupancy query reports %d\n", per_cu);
        (void)hipGetLastError();
        grid = cus;
    }
    if (grid < 0) return;
    Args a{};
    for (int i = 0; i < 16; ++i) a.rep[i] = 1;
    a.rep[5] = PROBE_REP5; a.rep[0] = PROBE_REP0; a.rep[7] = PROBE_REP7;
    for (int i = 0; i < 26; ++i) a.in[i] = (const float*)d_in[i];
    a.out = (float*)d_out; a.ws = (unsigned char*)d_ws;
    if (MK_ONE_LAUNCH) { a.ph_lo = 0; a.ph_hi = NPH; hipLaunchKernelGGL(fwd_kernel, dim3(grid), dim3(NWAVES * 64), LDS_BYTES, stream, a); }
    else for (int p = 0; p < NPH; ++p) { a.ph_lo = p; a.ph_hi = p + 1; hipLaunchKernelGGL(fwd_kernel, dim3(grid), dim3(NWAVES * 64), LDS_BYTES, stream, a); }
}
```
